# Optimizing an MI355X kernel written in HIP

```python
import math
import numpy as np
import jax
import jax.numpy as jnp
from jax import lax

D_MODEL = 1024
BATCH = 8
SEQ = 2048
DEPTH = 2

MLA_HEADS = 8
QK_NOPE_DIM = 64
QK_ROPE_DIM = 32
QK_HEAD_DIM = QK_NOPE_DIM + QK_ROPE_DIM
V_HEAD_DIM = 64
KV_LORA_RANK = 4 * V_HEAD_DIM
Q_LORA_RANK = 3 * KV_LORA_RANK
ROPE_THETA = 10000.0
ATTN_Q_BLOCK = 128

MLSTM_HEADS = 4
MLSTM_HEAD_DIM = 128
MLSTM_INNER = MLSTM_HEADS * MLSTM_HEAD_DIM
CONV_WIDTH = 4
MLSTM_CHUNK = 64

PEER_HEADS = 8
PEER_NKEYS = 128
PEER_N_EXPERTS = PEER_NKEYS * PEER_NKEYS
PEER_KEY_DIM = 128
PEER_HALF_DIM = PEER_KEY_DIM // 2
PEER_TOPK = 16
PEER_TOKEN_BLOCK = 128

RMS_EPS = 1e-6
N_ADA = 6

IN_SPLITS = (Q_LORA_RANK, KV_LORA_RANK, QK_ROPE_DIM, MLSTM_INNER, MLSTM_INNER,
             MLSTM_HEADS, MLSTM_HEADS, D_MODEL, D_MODEL)
IN_COLS = sum(IN_SPLITS)

kernel_name = "hybrid_mla_mlstm_peer_adaln"


def rms_norm(x, g):
    xf = x.astype(jnp.float32)
    y = xf * lax.rsqrt(jnp.mean(xf * xf, axis=-1, keepdims=True) + RMS_EPS)
    return (y * g.astype(jnp.float32)).astype(x.dtype)


def modulate(h, shift, scale):
    return h * (1.0 + scale[:, None, :]) + shift[:, None, :]


def rope_tables(positions):
    inv_freq = ROPE_THETA ** (-jnp.arange(0, QK_ROPE_DIM, 2, dtype=jnp.float32) / QK_ROPE_DIM)
    ang = positions.astype(jnp.float32)[..., None] * inv_freq
    return jnp.cos(ang)[:, :, None, :], jnp.sin(ang)[:, :, None, :]


def apply_rope(x, cos, sin):
    x1, x2 = jnp.split(x.astype(jnp.float32), 2, axis=-1)
    return jnp.concatenate([x1 * cos - x2 * sin, x2 * cos + x1 * sin], axis=-1).astype(x.dtype)


def block_causal_attention(q, k, v):
    B, S, H, Dq = q.shape
    Dv = v.shape[-1]
    nb = S // ATTN_Q_BLOCK
    scale = Dq ** -0.5
    qb = jnp.moveaxis(q.reshape(B, nb, ATTN_Q_BLOCK, H, Dq), 1, 0)
    kpos = jnp.arange(S)

    def one_block(args):
        q_blk, start = args
        s = jnp.einsum('bqhd,bkhd->bhqk', q_blk, k, preferred_element_type=jnp.float32) * scale
        qpos = start + jnp.arange(ATTN_Q_BLOCK)
        s = jnp.where(kpos[None, :] <= qpos[:, None], s, -jnp.inf)
        p = jax.nn.softmax(s, axis=-1).astype(v.dtype)
        return jnp.einsum('bhqk,bkhd->bqhd', p, v)

    out = lax.map(one_block, (qb, jnp.arange(nb) * ATTN_Q_BLOCK))
    return jnp.moveaxis(out, 0, 1).reshape(B, S, H * Dv)


def mla_branch(q_lat, kv_lat, k_rope, cos, sin, q_norm_g, w_q_up, kv_norm_g, w_kv_up):
    B, S, _ = q_lat.shape
    q = (rms_norm(q_lat, q_norm_g) @ w_q_up).reshape(B, S, MLA_HEADS, QK_HEAD_DIM)
    q = jnp.concatenate([q[..., :QK_NOPE_DIM], apply_rope(q[..., QK_NOPE_DIM:], cos, sin)], axis=-1)
    kv = (rms_norm(kv_lat, kv_norm_g) @ w_kv_up).reshape(B, S, MLA_HEADS, QK_NOPE_DIM + V_HEAD_DIM)
    k_nope, v = kv[..., :QK_NOPE_DIM], kv[..., QK_NOPE_DIM:]
    k_pe = apply_rope(k_rope[:, :, None, :], cos, sin)
    k = jnp.concatenate([k_nope, jnp.broadcast_to(k_pe, (B, S, MLA_HEADS, QK_ROPE_DIM))], axis=-1)
    return block_causal_attention(q, k, v)


def causal_depthwise_conv(u, w, b):
    y = lax.conv_general_dilated(u, w[:, None, :], window_strides=(1,),
                                 padding=((CONV_WIDTH - 1, 0),),
                                 dimension_numbers=('NWC', 'WIO', 'NWC'),
                                 feature_group_count=u.shape[-1])
    return y + b


def mlstm_chunkwise(q, k, v, log_i, log_f):
    B, H, S, d = q.shape
    L = MLSTM_CHUNK
    nc = S // L
    qc = q.reshape(B, H, nc, L, d)
    kc = k.reshape(B, H, nc, L, d)
    vc = v.reshape(B, H, nc, L, d)
    ic = log_i.reshape(B, H, nc, L)
    bcum = jnp.cumsum(log_f.reshape(B, H, nc, L), axis=-1)
    causal = jnp.tril(jnp.ones((L, L), dtype=bool))
    log_d = jnp.where(causal, bcum[..., :, None] - bcum[..., None, :] + ic[..., None, :], -jnp.inf)
    b_last = bcum[..., -1]
    log_a = b_last[..., None] - bcum + ic
    a_max = jnp.max(log_a, axis=-1)

    def step(carry, xs):
        C, n, m = carry
        k_j, v_j, la_j, amax_j, bl_j = xs
        m_new = jnp.maximum(bl_j + m, amax_j)
        decay = jnp.exp(bl_j + m - m_new)
        w = jnp.exp(la_j - m_new[..., None])
        vw = v_j * w[..., None]
        C_new = decay[..., None, None] * C + jnp.einsum('bhld,bhle->bhde', vw, k_j)
        n_new = decay[..., None] * n + jnp.einsum('bhl,bhle->bhe', w, k_j)
        return (C_new, n_new, m_new), (C, n, m)

    xs = (jnp.moveaxis(kc, 2, 0), jnp.moveaxis(vc, 2, 0), jnp.moveaxis(log_a, 2, 0),
          jnp.moveaxis(a_max, 2, 0), jnp.moveaxis(b_last, 2, 0))
    init = (jnp.zeros((B, H, d, d), jnp.float32), jnp.zeros((B, H, d), jnp.float32),
            jnp.zeros((B, H), jnp.float32))
    _, (C_prev, n_prev, m_prev) = lax.scan(step, init, xs)
    C_prev = jnp.moveaxis(C_prev, 0, 2)
    n_prev = jnp.moveaxis(n_prev, 0, 2)
    m_prev = jnp.moveaxis(m_prev, 0, 2)

    log_inter = bcum + m_prev[..., None]
    m_t = jnp.maximum(log_inter, jnp.max(log_d, axis=-1))
    inter_w = jnp.exp(log_inter - m_t)
    d_w = jnp.exp(log_d - m_t[..., None])
    s = jnp.einsum('bhcte,bhcse->bhcts', qc, kc) * d_w
    num = inter_w[..., None] * jnp.einsum('bhcde,bhcte->bhctd', C_prev, qc) \
        + jnp.einsum('bhcts,bhcsd->bhctd', s, vc)
    den = inter_w * jnp.einsum('bhce,bhcte->bhct', n_prev, qc) + jnp.sum(s, axis=-1)
    h = num / jnp.maximum(jnp.abs(den), jnp.exp(-m_t))[..., None]
    return h.reshape(B, H, S, d)


def mlstm_branch(u, o_pre, i_pre, f_pre, conv_w, conv_b, wq, wk, wv, b_i, b_f, norm_g, skip):
    B, S, _ = u.shape
    conv_act = jax.nn.silu(causal_depthwise_conv(u, conv_w, conv_b))
    ch = conv_act.reshape(B, S, MLSTM_HEADS, MLSTM_HEAD_DIM)
    uh = u.reshape(B, S, MLSTM_HEADS, MLSTM_HEAD_DIM)
    q = jnp.einsum('bshd,hde->bhse', ch, wq).astype(jnp.float32)
    k = jnp.einsum('bshd,hde->bhse', ch, wk).astype(jnp.float32) * (MLSTM_HEAD_DIM ** -0.5)
    v = jnp.einsum('bshd,hde->bhse', uh, wv).astype(jnp.float32)
    log_i = jnp.swapaxes((i_pre + b_i).astype(jnp.float32), 1, 2)
    log_f = jnp.swapaxes(jax.nn.log_sigmoid((f_pre + b_f).astype(jnp.float32)), 1, 2)
    h = jnp.swapaxes(mlstm_chunkwise(q, k, v, log_i, log_f), 1, 2)
    mu = jnp.mean(h, axis=-1, keepdims=True)
    var = jnp.mean(jnp.square(h - mu), axis=-1, keepdims=True)
    hn = ((h - mu) * lax.rsqrt(var + RMS_EPS)).reshape(B, S, MLSTM_INNER) * norm_g.astype(jnp.float32)
    out = jax.nn.sigmoid(o_pre.astype(jnp.float32)) * (hn + skip * conv_act)
    return out.astype(u.dtype)


def peer_ffn(h, w_q, sub_keys, u_tab, v_tab):
    B, S, D = h.shape
    T = B * S
    HK = PEER_HEADS * PEER_TOPK
    ht = h.reshape(T, D)
    q = (ht @ w_q).reshape(T, PEER_HEADS, 2, PEER_HALF_DIM)
    scores = jnp.einsum('thpd,hpnd->thpn', q, sub_keys, preferred_element_type=jnp.float32)
    s_top, i_top = lax.top_k(scores, PEER_TOPK)
    cand = (s_top[:, :, 0, :, None] + s_top[:, :, 1, None, :]).reshape(T, PEER_HEADS, PEER_TOPK * PEER_TOPK)
    cand_idx = (i_top[:, :, 0, :, None] * PEER_NKEYS + i_top[:, :, 1, None, :]).reshape(T, PEER_HEADS, PEER_TOPK * PEER_TOPK)
    best, pos = lax.top_k(cand, PEER_TOPK)
    expert_idx = jnp.take_along_axis(cand_idx, pos, axis=-1)
    gates = jax.nn.softmax(best, axis=-1)
    nb = T // PEER_TOKEN_BLOCK

    def one_block(args):
        x_b, idx_b, g_b = args
        u_sel = jnp.take(u_tab, idx_b, axis=0)
        act = jax.nn.gelu(jnp.einsum('td,ted->te', x_b, u_sel).astype(jnp.float32), approximate=False)
        w = (act * g_b).astype(x_b.dtype)
        v_sel = jnp.take(v_tab, idx_b, axis=0)
        return jnp.einsum('te,ted->td', w, v_sel)

    y = lax.map(one_block, (ht.reshape(nb, PEER_TOKEN_BLOCK, D),
                            expert_idx.reshape(nb, PEER_TOKEN_BLOCK, HK),
                            gates.reshape(nb, PEER_TOKEN_BLOCK, HK)))
    return y.reshape(B, S, D)


def setup_inputs(seed: int = 0) -> dict:
    key = jax.random.key(seed)
    ks = jax.random.split(key, 32)
    f32 = jnp.float32
    D = D_MODEL

    def nrm(k, shape, scale):
        return jax.random.normal(k, shape, f32) * scale

    x = nrm(ks[0], (BATCH, SEQ, D), 1.0)
    c = nrm(ks[1], (BATCH, D), 1.0)
    positions = jnp.broadcast_to(jnp.arange(SEQ, dtype=jnp.int32), (BATCH, SEQ))
    b_f = jnp.broadcast_to(jnp.linspace(3.0, 6.0, MLSTM_HEADS, dtype=f32), (DEPTH, MLSTM_HEADS)) \
        + nrm(ks[2], (DEPTH, MLSTM_HEADS), 0.1)
    return {
        "x": x,
        "c": c,
        "positions": positions,
        "w_ada": nrm(ks[3], (DEPTH, D, N_ADA * D), D ** -0.5),
        "b_ada": nrm(ks[4], (DEPTH, N_ADA * D), 0.02),
        "norm1_g": 1.0 + nrm(ks[5], (DEPTH, D), 0.02),
        "w_in": nrm(ks[6], (DEPTH, D, IN_COLS), D ** -0.5),
        "q_norm_g": 1.0 + nrm(ks[7], (DEPTH, Q_LORA_RANK), 0.02),
        "w_q_up": nrm(ks[8], (DEPTH, Q_LORA_RANK, MLA_HEADS * QK_HEAD_DIM), Q_LORA_RANK ** -0.5),
        "kv_norm_g": 1.0 + nrm(ks[9], (DEPTH, KV_LORA_RANK), 0.02),
        "w_kv_up": nrm(ks[10], (DEPTH, KV_LORA_RANK, MLA_HEADS * (QK_NOPE_DIM + V_HEAD_DIM)), KV_LORA_RANK ** -0.5),
        "w_branch_a": nrm(ks[11], (DEPTH, MLA_HEADS * V_HEAD_DIM, D), (MLA_HEADS * V_HEAD_DIM) ** -0.5),
        "conv_w": nrm(ks[12], (DEPTH, CONV_WIDTH, MLSTM_INNER), CONV_WIDTH ** -0.5),
        "conv_b": nrm(ks[13], (DEPTH, MLSTM_INNER), 0.02),
        "wq_m": nrm(ks[14], (DEPTH, MLSTM_HEADS, MLSTM_HEAD_DIM, MLSTM_HEAD_DIM), MLSTM_HEAD_DIM ** -0.5),
        "wk_m": nrm(ks[15], (DEPTH, MLSTM_HEADS, MLSTM_HEAD_DIM, MLSTM_HEAD_DIM), MLSTM_HEAD_DIM ** -0.5),
        "wv_m": nrm(ks[16], (DEPTH, MLSTM_HEADS, MLSTM_HEAD_DIM, MLSTM_HEAD_DIM), MLSTM_HEAD_DIM ** -0.5),
        "b_i": nrm(ks[17], (DEPTH, MLSTM_HEADS), 0.1),
        "b_f": b_f,
        "mh_norm_g": 1.0 + nrm(ks[18], (DEPTH, MLSTM_INNER), 0.02),
        "m_skip": 1.0 + nrm(ks[19], (DEPTH, MLSTM_INNER), 0.02),
        "w_branch_m": nrm(ks[20], (DEPTH, MLSTM_INNER, D), MLSTM_INNER ** -0.5),
        "w_out": nrm(ks[21], (DEPTH, D, D), D ** -0.5),
        "norm2_g": 1.0 + nrm(ks[22], (DEPTH, D), 0.02),
        "peer_wq": nrm(ks[23], (DEPTH, D, PEER_HEADS * PEER_KEY_DIM), D ** -0.5),
        "peer_keys": nrm(ks[24], (DEPTH, PEER_HEADS, 2, PEER_NKEYS, PEER_HALF_DIM), PEER_HALF_DIM ** -0.5),
        "peer_u": nrm(ks[25], (DEPTH, PEER_N_EXPERTS, D), D ** -0.5),
        "peer_v": nrm(ks[26], (DEPTH, PEER_N_EXPERTS, D), PEER_HEADS ** -0.5),
        "final_g": 1.0 + nrm(ks[27], (D,), 0.02),
    }


def reference(x, c, positions, w_ada, b_ada, norm1_g, w_in, q_norm_g, w_q_up, kv_norm_g, w_kv_up,
              w_branch_a, conv_w, conv_b, wq_m, wk_m, wv_m, b_i, b_f, mh_norm_g, m_skip,
              w_branch_m, w_out, norm2_g, peer_wq, peer_keys, peer_u, peer_v, final_g):
    cos, sin = rope_tables(positions)
    c_act = jax.nn.silu(c)
    split_points = np.cumsum(IN_SPLITS)[:-1].tolist()
    for l in range(DEPTH):
        ada = c_act @ w_ada[l] + b_ada[l]
        shift1, scale1, gate1, shift2, scale2, gate2 = jnp.split(ada, N_ADA, axis=-1)

        h = modulate(rms_norm(x, norm1_g[l]), shift1, scale1)
        proj = h @ w_in[l]
        q_lat, kv_lat, k_rope, u_m, o_pre, i_pre, f_pre, ga_pre, gm_pre = jnp.split(proj, split_points, axis=-1)
        y_a = mla_branch(q_lat, kv_lat, k_rope, cos, sin, q_norm_g[l], w_q_up[l],
                         kv_norm_g[l], w_kv_up[l]) @ w_branch_a[l]
        y_m = mlstm_branch(u_m, o_pre, i_pre, f_pre, conv_w[l], conv_b[l], wq_m[l], wk_m[l], wv_m[l],
                           b_i[l], b_f[l], mh_norm_g[l], m_skip[l]) @ w_branch_m[l]
        merged = jax.nn.sigmoid(ga_pre) * y_a + jax.nn.sigmoid(gm_pre) * y_m
        x = x + gate1[:, None, :] * (merged @ w_out[l])

        h2 = modulate(rms_norm(x, norm2_g[l]), shift2, scale2)
        x = x + gate2[:, None, :] * peer_ffn(h2, peer_wq[l], peer_keys[l], peer_u[l], peer_v[l])
    return rms_norm(x, final_g)
```

```cpp
#include <hip/hip_runtime.h>
#include <cstdio>
#include <cstdint>
namespace pg8 {
#define PG8_LAS __attribute__((address_space(3)))
typedef unsigned short bf16_t;
typedef short bf16x8 __attribute__((ext_vector_type(8)));
typedef float f32x4 __attribute__((ext_vector_type(4)));
typedef unsigned u32x4 __attribute__((ext_vector_type(4)));
constexpr int BM = 256, BK = 64, HALF = 128, HTB = HALF * BK * 2  , STAGE_BYTES = 8 * HTB, NXCD = 8, WGM = 8;

__host__ __device__ __forceinline__ int lds_byte(int r, int c) { const int st = (r >> 4) * 2 + (c >> 5), rr = r & 15, cc = c & 31, ob = rr * 64 + cc * 2; return st * 1024 + (ob ^ (((ob >> 9) & 1) << 5)); }
__host__ __device__ __forceinline__ void stage_rc(int b, int& R, int& C) { const int st = b / 1024, sb = b % 1024, swz = sb ^ (((sb >> 9) & 1) << 5); R = (st >> 1) * 16 + swz / 64; C = (st & 1) * 32 + (swz % 64) / 2; }
__host__ __device__ __forceinline__ int perm32(int rho) { const int n = rho >> 4, i = rho & 15; return 8 * (i >> 2) + 4 * n + (i & 3); }

struct Unit { int pm, pn; };
struct Gemm { const bf16_t* A; const bf16_t* Bt; int M, N, K; };

struct StaticOrder {
    int nM, nN, nwg, G, c;
    __host__ __device__ void init(int M, int N, int G_, int c_) { nM = M / BM; nN = N / BM; nwg = nM * nN; G = G_; c = c_; }
    __host__ __device__ bool next(int i, Unit& u) const {
        const long L = (long)i * G + c; if (L >= nwg) return false;
        int wgid = (int)L; { const int q = nwg / NXCD, r = nwg % NXCD, xcd = wgid % NXCD, off = wgid / NXCD; wgid = (xcd < r ? xcd * (q + 1) : r * (q + 1) + (xcd - r) * q) + off; }
        const int nig = WGM * nN, gid = wgid / nig, fm = gid * WGM, gsz = (nM - fm) < WGM ? (nM - fm) : WGM;
        u.pm = fm + ((wgid % nig) % gsz); u.pn = (wgid % nig) / gsz; return true;
    }
    __device__ __forceinline__ void a_ready(const Unit&) const {}
    __device__ __forceinline__ void done(const Unit&) const {}
};

__device__ __forceinline__ unsigned cvt_pk_bf16(float lo, float hi) { unsigned r; asm volatile("v_cvt_pk_bf16_f32 %0, %1, %2" : "=v"(r) : "v"(lo), "v"(hi)); return r; }
typedef float f32x2 __attribute__((ext_vector_type(2)));
__device__ __forceinline__ f32x2 gelu_pk(f32x2 v) {
    const f32x2 av = __builtin_elementwise_abs(v), d = av * 0.2316418882f + 1.0f;
    f32x2 t; t.x = __builtin_amdgcn_rcpf(d.x); t.y = __builtin_amdgcn_rcpf(d.y);
    f32x2 q = t * 0.5307027145f + (-0.7265760135f); q = q * t + 0.7107068705f; q = q * t + (-0.142248368f); q = q * t + 0.127414796f; q = q * t;
    const f32x2 s = (v * v) * (-0.72134752044f);
    f32x2 e; e.x = __builtin_amdgcn_exp2f(s.x); e.y = __builtin_amdgcn_exp2f(s.y);
    const f32x2 m = v * (q * e), r = v - m;
    f32x2 o; o.x = v.x < 0.f ? m.x : r.x; o.y = v.y < 0.f ? m.y : r.y; return o;
}

template <int ACT  > struct EpiBf16 {
    static constexpr bool PERM = true, AFTER_DRAIN = false; static_assert(ACT == 0 || ACT == 1, "EpiBf16: ACT is 0 (none) or 1 (gelu_pk)");
    bf16_t* O; int ldc; const float* bias; int split_cols; size_t split_stride; float scale0;
    __device__ __forceinline__ void operator()(const f32x4 (&acc)[2][2][4][2], const Unit& u, int wr, int wc, int fr, int fq) const {
        const int row0 = u.pm * BM + wr * 64 + fr; int colt = u.pn * BM; bf16_t* base = O;
        float sc = 1.f; if (split_cols) { const int t = colt / split_cols; base += (size_t)t * split_stride; colt -= t * split_cols; if (t == 0) sc = scale0; }
        const int col0 = colt + wc * 32 + 8 * fq, bcol0 = u.pn * BM + wc * 32 + 8 * fq;
        f32x4 bv[2][2];
#pragma unroll
        for (int bj = 0; bj < 2; ++bj)
#pragma unroll
            for (int n = 0; n < 2; ++n) bv[bj][n] = bias ? *(const f32x4*)(bias + bcol0 + bj * HALF + 4 * n) : (f32x4){0.f, 0.f, 0.f, 0.f};
#pragma unroll
        for (int ai = 0; ai < 2; ++ai)
#pragma unroll
            for (int m = 0; m < 4; ++m) { bf16_t* rowp = base + (size_t)(row0 + ai * HALF + m * 16) * ldc + col0;
#pragma unroll
                for (int bj = 0; bj < 2; ++bj) { f32x4 v0 = acc[ai][bj][m][0] + bv[bj][0], v1 = acc[ai][bj][m][1] + bv[bj][1];
                    if (ACT == 1) { f32x2 a = gelu_pk((f32x2){v0[0], v0[1]}), b = gelu_pk((f32x2){v0[2], v0[3]}), c = gelu_pk((f32x2){v1[0], v1[1]}), d = gelu_pk((f32x2){v1[2], v1[3]});
                        v0 = (f32x4){a.x, a.y, b.x, b.y}; v1 = (f32x4){c.x, c.y, d.x, d.y}; }
                    v0 = v0 * sc; v1 = v1 * sc; u32x4 w; w.x = cvt_pk_bf16(v0[0], v0[1]); w.y = cvt_pk_bf16(v0[2], v0[3]); w.z = cvt_pk_bf16(v1[0], v1[1]); w.w = cvt_pk_bf16(v1[2], v1[3]);
                    *(u32x4*)(rowp + bj * HALF) = w; } }
    }
};


template <class Epi, class Sched, bool ALIGN_EPI = false, bool SP2 = false>
__device__ __forceinline__ void gemm_phase(PG8_LAS unsigned char* lds, const Gemm g, const Sched& S, const Epi& E) {
    int tid_l = threadIdx.x; asm volatile("" : "+v"(tid_l));
    const int tid = tid_l, wid = __builtin_amdgcn_readfirstlane(tid >> 6), lane = tid & 63, wr = wid >> 2, wc = wid & 3, fr = lane & 15, fq = lane >> 4;
    const int K = g.K, nt = K / BK;
    unsigned voffA[2], voffB[2];
#pragma unroll
    for (int i = 0; i < 2; ++i) { int R, C; stage_rc(tid * 16 + i * 8192, R, C); const int Rb = Epi::PERM ? ((R & ~31) + perm32(R & 31)) : R;
        voffA[i] = (unsigned)(R * K + C) * 2u; voffB[i] = (unsigned)(Rb * K + C) * 2u; }
    const size_t kstep = (size_t)(BK * 2);
    const size_t hstep = (size_t)HALF * K * 2;
    const size_t tstep = 2 * hstep;
    const unsigned ldsw = (unsigned)wid * 1024u;
    const int aoff = lds_byte(wr * 64 + fr, fq * 8), boff = lds_byte(wc * 32 + fr, fq * 8);
#define PG8_SA(b, h) (((b) * 2 + (h)) * HTB)
#define PG8_SB(b, h) ((4 + (b) * 2 + (h)) * HTB)
#define PG8_STAGE(bufoff, gbase, voff) do { _Pragma("unroll") for (int _i = 0; _i < 2; ++_i) \
        __builtin_amdgcn_global_load_lds((const unsigned*)((const char*)(gbase) + (voff)[_i]), (PG8_LAS unsigned*)(lds + (bufoff) + ldsw + _i * 8192), 16, 0, 0); } while (0)
#define PG8_LDA(dst, b, h) do { _Pragma("unroll") for (int m = 0; m < 4; ++m) _Pragma("unroll") for (int k = 0; k < 2; ++k) dst[m][k] = *(const PG8_LAS bf16x8*)(lds + PG8_SA(b, h) + aoff + m * 2048 + k * 1024); } while (0)
#define PG8_LDB(dst, b, h) do { _Pragma("unroll") for (int n = 0; n < 2; ++n) _Pragma("unroll") for (int k = 0; k < 2; ++k) dst[n][k] = *(const PG8_LAS bf16x8*)(lds + PG8_SB(b, h) + boff + n * 2048 + k * 1024); } while (0)
#define PG8_MMA(ai, bj, At, Bt) do { __builtin_amdgcn_s_setprio(1); _Pragma("unroll") for (int m = 0; m < 4; ++m) _Pragma("unroll") for (int n = 0; n < 2; ++n) _Pragma("unroll") for (int k = 0; k < 2; ++k) \
        acc[ai][bj][m][n] = __builtin_amdgcn_mfma_f32_16x16x32_bf16(Bt[n][k], At[m][k], acc[ai][bj][m][n], 0, 0, 0); __builtin_amdgcn_s_setprio(0); } while (0)
#define PG8_WAIT_V(n) asm volatile("s_waitcnt vmcnt(" #n ")" ::: "memory")
#define PG8_WAIT_L(n) asm volatile("s_waitcnt lgkmcnt(" #n ")" ::: "memory")
#define PG8_BAR __builtin_amdgcn_s_barrier()
#define PG8_SCHED __builtin_amdgcn_sched_barrier(0)
    Unit cur, nxt; int ui = 0;
    if (!S.next(0, cur)) return;
    f32x4 acc[2][2][4][2];
#pragma unroll
    for (int a = 0; a < 2; ++a)
#pragma unroll
        for (int b = 0; b < 2; ++b)
#pragma unroll
            for (int m = 0; m < 4; ++m)
#pragma unroll
                for (int n = 0; n < 2; ++n) acc[a][b][m][n] = (f32x4){0.f, 0.f, 0.f, 0.f};
    bf16x8 At[4][2], B0[2][2], B1[2][2];
    const char* cA = (const char*)g.A + (size_t)cur.pm * tstep; const char* cB = (const char*)g.Bt + (size_t)cur.pn * tstep;
    S.a_ready(cur);
    if constexpr (SP2) {
        PG8_STAGE(PG8_SB(0, 0), cB, voffB); PG8_STAGE(PG8_SB(0, 1), cB + hstep, voffB); PG8_STAGE(PG8_SA(0, 0), cA, voffA); PG8_STAGE(PG8_SA(0, 1), cA + hstep, voffA);
        if (wr == 1) PG8_BAR;
        PG8_WAIT_V(2); PG8_BAR;
        PG8_STAGE(PG8_SB(1, 0), cB + kstep, voffB); PG8_STAGE(PG8_SA(1, 0), cA + kstep, voffA); PG8_STAGE(PG8_SB(1, 1), cB + hstep + kstep, voffB);
        PG8_WAIT_V(6); PG8_BAR;
    } else {
        PG8_STAGE(PG8_SB(0, 0), cB, voffB); PG8_STAGE(PG8_SA(0, 0), cA, voffA); PG8_STAGE(PG8_SB(0, 1), cB + hstep, voffB); PG8_STAGE(PG8_SA(0, 1), cA + hstep, voffA);
        if (wr == 1) PG8_BAR;
        PG8_WAIT_V(4); PG8_BAR;
        PG8_STAGE(PG8_SB(1, 0), cB + kstep, voffB); PG8_STAGE(PG8_SA(1, 0), cA + kstep, voffA); PG8_STAGE(PG8_SB(1, 1), cB + hstep + kstep, voffB);
        PG8_WAIT_V(6); PG8_BAR;
    }
    for (;;) {
        const bool has_next = S.next(ui + 1, nxt);
        const char* nA = has_next ? (const char*)g.A + (size_t)nxt.pm * tstep : cA; const char* nB = has_next ? (const char*)g.Bt + (size_t)nxt.pn * tstep : cB;
        for (int t = 0; t < nt; t += 2) {
            const bool last = (t == nt - 2);
            const char* a1 = cA + (size_t)(t + 1) * kstep;
            const char* a2 = last ? nA : cA + (size_t)(t + 2) * kstep; const char* b2 = last ? nB : cB + (size_t)(t + 2) * kstep;
            const char* a3 = a2 + kstep; const char* b3 = b2 + kstep;
            if (last && has_next) S.a_ready(nxt);
            if constexpr (SP2) {
            PG8_LDB(B0, 0, 0); PG8_LDB(B1, 0, 1); PG8_SCHED; PG8_LDA(At, 0, 0); PG8_STAGE(PG8_SA(1, 1), a1 + hstep, voffA);
            PG8_WAIT_V(8); PG8_WAIT_L(0); PG8_BAR; PG8_MMA(0, 0, At, B0); PG8_MMA(0, 1, At, B1); PG8_BAR; PG8_SCHED;
            PG8_LDA(At, 0, 1); PG8_STAGE(PG8_SB(0, 0), b2, voffB); PG8_STAGE(PG8_SB(0, 1), b2 + hstep, voffB); PG8_STAGE(PG8_SA(0, 0), a2, voffA);
            PG8_WAIT_V(8); PG8_WAIT_L(0); PG8_BAR; PG8_MMA(1, 0, At, B0); PG8_MMA(1, 1, At, B1); PG8_BAR; PG8_SCHED;
            PG8_LDB(B0, 1, 0); PG8_LDB(B1, 1, 1); PG8_SCHED; PG8_LDA(At, 1, 0); PG8_STAGE(PG8_SA(0, 1), a2 + hstep, voffA);
            PG8_WAIT_V(8); PG8_WAIT_L(0); PG8_BAR; PG8_MMA(0, 0, At, B0); PG8_MMA(0, 1, At, B1); PG8_BAR; PG8_SCHED;
            PG8_LDA(At, 1, 1); PG8_STAGE(PG8_SB(1, 0), b3, voffB); PG8_STAGE(PG8_SB(1, 1), b3 + hstep, voffB); PG8_STAGE(PG8_SA(1, 0), a3, voffA);
            PG8_WAIT_V(8); PG8_WAIT_L(0); PG8_BAR; PG8_MMA(1, 0, At, B0); PG8_MMA(1, 1, At, B1); PG8_BAR; PG8_SCHED;
            } else {
            PG8_LDB(B0, 0, 0); PG8_SCHED; PG8_LDA(At, 0, 0); PG8_STAGE(PG8_SA(1, 1), a1 + hstep, voffA);
            PG8_WAIT_L(8); PG8_BAR; PG8_WAIT_L(0); PG8_MMA(0, 0, At, B0); PG8_BAR; PG8_SCHED;
            PG8_LDB(B1, 0, 1); PG8_STAGE(PG8_SB(0, 0), b2, voffB);
            PG8_BAR; PG8_WAIT_L(0); PG8_MMA(0, 1, At, B1); PG8_BAR;
            PG8_LDA(At, 0, 1); PG8_STAGE(PG8_SA(0, 0), a2, voffA);
            PG8_BAR; PG8_WAIT_L(0); PG8_MMA(1, 0, At, B0); PG8_BAR; PG8_SCHED;
            PG8_STAGE(PG8_SB(0, 1), b2 + hstep, voffB);
            PG8_WAIT_V(6); PG8_BAR; PG8_MMA(1, 1, At, B1); PG8_BAR;
            PG8_LDB(B0, 1, 0); PG8_SCHED; PG8_LDA(At, 1, 0); PG8_STAGE(PG8_SA(0, 1), a2 + hstep, voffA);
            PG8_WAIT_L(8); PG8_BAR; PG8_WAIT_L(0); PG8_MMA(0, 0, At, B0); PG8_BAR; PG8_SCHED;
            PG8_LDB(B1, 1, 1); PG8_STAGE(PG8_SB(1, 0), b3, voffB);
            PG8_BAR; PG8_WAIT_L(0); PG8_MMA(0, 1, At, B1); PG8_BAR;
            PG8_LDA(At, 1, 1); PG8_STAGE(PG8_SA(1, 0), a3, voffA);
            PG8_BAR; PG8_WAIT_L(0); PG8_MMA(1, 0, At, B0); PG8_BAR; PG8_SCHED;
            PG8_STAGE(PG8_SB(1, 1), b3 + hstep, voffB);
            PG8_WAIT_V(6); PG8_BAR; PG8_MMA(1, 1, At, B1); PG8_BAR;
            }
        }
        if constexpr (ALIGN_EPI) { if (wr == 0) PG8_BAR; }
        if constexpr (!Epi::AFTER_DRAIN) { E(acc, cur, wr, wc, fr, fq); S.done(cur); }
        if (!has_next) break;
#pragma unroll
        for (int a = 0; a < 2; ++a)
#pragma unroll
            for (int b = 0; b < 2; ++b)
#pragma unroll
                for (int m = 0; m < 4; ++m)
#pragma unroll
                    for (int n = 0; n < 2; ++n) acc[a][b][m][n] = (f32x4){0.f, 0.f, 0.f, 0.f};
        cur = nxt; cA = nA; cB = nB; ++ui;
        if constexpr (ALIGN_EPI) { if (wr == 1) PG8_BAR; }
    }
    PG8_WAIT_V(0);
    if constexpr (!ALIGN_EPI) { if (wr == 0) PG8_BAR; }
    PG8_BAR;
    if constexpr (Epi::AFTER_DRAIN) { E.fused(acc, cur, wr, wc, fr, fq, lds, wid, lane); S.done(cur); }
#undef PG8_SA
#undef PG8_SB
#undef PG8_STAGE
#undef PG8_LDA
#undef PG8_LDB
#undef PG8_MMA
#undef PG8_WAIT_V
#undef PG8_WAIT_L
#undef PG8_BAR
#undef PG8_SCHED
}
}
#define GAS __attribute__((address_space(1)))
#define LAS __attribute__((address_space(3)))
typedef unsigned short bf16;
typedef unsigned v4u __attribute__((ext_vector_type(4)));
typedef float f32x4 __attribute__((ext_vector_type(4)));
typedef short bf16x8 __attribute__((ext_vector_type(8)));
typedef GAS unsigned gu32;
typedef GAS unsigned long long gu64;
#define RLX_AGENT __ATOMIC_RELAXED, __HIP_MEMORY_SCOPE_AGENT
#define LDS_WAIT() asm volatile("s_waitcnt lgkmcnt(0)" ::: "memory")
#define VM_WAIT() asm volatile("s_waitcnt vmcnt(0)" ::: "memory")
__device__ __forceinline__ unsigned long long rt() { return __builtin_amdgcn_s_memrealtime(); }
__device__ __forceinline__ unsigned f2bf(float f) { unsigned u = __builtin_bit_cast(unsigned, f); return (u + 0x7fffu + ((u >> 16) & 1u)) >> 16; }
__device__ __forceinline__ unsigned pk2(float lo, float hi) { return f2bf(lo) | (f2bf(hi) << 16); }

#define XB_TMO      128
#define XB_XCNT(j)  (256  + 64 * (j))
#define XB_XSUB(j)  (1280 + 64 * (j))
#define XB_XGEN(j)  (2304 + 64 * (j))
#define XB_TOP      3328
#define XB_TOPGEN   3392
#define XCD_BAR_WORDS 3456
#define XB_SPIN_CAP (1u << 18)

__device__ __forceinline__ unsigned xb_ld(unsigned* p)              { return __hip_atomic_load(p, __ATOMIC_RELAXED, __HIP_MEMORY_SCOPE_AGENT); }
__device__ __forceinline__ unsigned xb_add(unsigned* p, unsigned v) { return __hip_atomic_fetch_add(p, v, __ATOMIC_RELAXED, __HIP_MEMORY_SCOPE_AGENT); }
__device__ __forceinline__ unsigned xb_xcc_id() { return (unsigned)__builtin_amdgcn_s_getreg((3 << 11) | 20) & 0xFu; }
#define XB_SPIN(cond, bar) do { unsigned _sp = 0; while (cond) { __builtin_amdgcn_s_sleep(1); \
    if ((++_sp & 255u) == 0u) { if (xb_ld(&(bar)[XB_TMO])) break; if (_sp > XB_SPIN_CAP) { atomicAdd(&(bar)[XB_TMO], 1u); break; } } } } while (0)

struct XcdBarrier {
    unsigned* bar; unsigned x;
    volatile LAS unsigned* st;
};

__device__ __forceinline__ XcdBarrier xcd_barrier_post(unsigned* bar, volatile LAS unsigned* st) {
    XcdBarrier b; b.bar = bar; b.x = xb_xcc_id(); b.st = st;
    if (threadIdx.x == 0) (void)xb_add(&bar[XB_XCNT(b.x)], 1u);
    return b;
}
__device__ __forceinline__ void xcd_barrier_complete(unsigned* bar, unsigned x, unsigned& nloc, unsigned& nx) {
    const unsigned G = gridDim.x * gridDim.y * gridDim.z;
    unsigned sum, cnt, mine, sp = 0u;
    for (;;) {
        sum = 0u; cnt = 0u; mine = 0u;
#pragma unroll
        for (unsigned j = 0; j < 16; ++j) { const unsigned c = xb_ld(&bar[XB_XCNT(j)]); sum += c; cnt += (c > 0u) ? 1u : 0u; mine = (j == x) ? c : mine; }
        if (sum == G) break;
        __builtin_amdgcn_s_sleep(1);
        if ((++sp & 255u) == 0u) { if (xb_ld(&bar[XB_TMO])) break; if (sp > XB_SPIN_CAP) { atomicAdd(&bar[XB_TMO], 1u); break; } }
    }
    nloc = mine > 0u ? mine : 1u; nx = cnt > 0u ? cnt : 1u;
}

__device__ __forceinline__ void xcd_barrier(const XcdBarrier& b) {
    asm volatile("s_waitcnt vmcnt(0)" ::: "memory");
    __syncthreads();
    if (threadIdx.x == 0) {
        unsigned* bar = b.bar;
        __builtin_amdgcn_s_waitcnt(0);
        unsigned nloc = b.st[0], nx = b.st[1];
        if (nloc == 0u) { xcd_barrier_complete(bar, b.x, nloc, nx); b.st[0] = nloc; b.st[1] = nx; }
        const unsigned old = xb_add(&bar[XB_XSUB(b.x)], 1u);
        const unsigned gen = old / nloc;
        if (old + 1u == (gen + 1u) * nloc) {
            __builtin_amdgcn_fence(__ATOMIC_RELEASE, "agent");
            asm volatile("s_waitcnt vmcnt(0)" ::: "memory");
            const unsigned og = xb_add(&bar[XB_TOP], 1u);
            const unsigned tg = og / nx;
            if (og + 1u == (tg + 1u) * nx) xb_add(&bar[XB_TOPGEN], 1u);
            else XB_SPIN(xb_ld(&bar[XB_TOPGEN]) == tg, bar);
            __builtin_amdgcn_fence(__ATOMIC_ACQUIRE, "agent");
            xb_add(&bar[XB_XGEN(b.x)], 1u);
            asm volatile("s_waitcnt vmcnt(0)" ::: "memory");
        } else {
            XB_SPIN(xb_ld(&bar[XB_XGEN(b.x)]) == gen, bar);
            __builtin_amdgcn_fence(__ATOMIC_ACQUIRE, "agent");
            asm volatile("s_waitcnt vmcnt(0)" ::: "memory");
        }
    }
    __syncthreads();
}

#ifndef MK_ONE_LAUNCH
#define MK_ONE_LAUNCH 1
#endif
constexpr int NWAVES = 8, NTHREADS = NWAVES * 64;
constexpr int BATCH = 8, SEQ = 2048, T = BATCH * SEQ, D = 1024, DEPTH = 2;
constexpr int NPROJ = 4352;
constexpr int N_INPUTS = 29;
constexpr int NADA = 6144;
constexpr float RMS_EPS = 1e-6f;
constexpr float QSCALE = 0.10206207261596575f * 1.4426950408889634f;
enum { I_X = 0, I_C, I_POS, I_WADA, I_BADA, I_N1G, I_WIN, I_QNG, I_WQUP, I_KVNG, I_WKVUP, I_WBA, I_CONVW, I_CONVB, I_WQM, I_WKM, I_WVM, I_BI, I_BF, I_MHG, I_MSKIP,
       I_WBM, I_WOUT, I_N2G, I_PWQ, I_PKEYS, I_PU, I_PV, I_FG };

constexpr size_t MiB = 1u << 20;
constexpr size_t WS_CTL = 0, CTL_ZERO_BYTES = 1 * MiB;
constexpr int CW_BAR = 4096;
constexpr size_t ADA_OFF = 256 * 1024;
constexpr size_t WS_COS = 1 * MiB, WS_SIN = 2 * MiB;
constexpr size_t WS_W = 3 * MiB, W_LAYER = 18 * MiB;
constexpr size_t WO_WIN = 0, WO_WQ = 8912896, WO_WKV = WO_WQ + 1179648, WO_WA = WO_WKV + 524288, WO_WM = WO_WA + 1048576, WO_WO = WO_WM + 1048576,
                 WO_PWQ = WO_WO + 2097152, WO_WQK = WO_PWQ + 2097152, WO_WV = WO_WQK + 1048576;
static_assert(WO_WV + 524288 <= W_LAYER, "weights fit");
constexpr size_t WS_X = 40 * MiB, WS_H = 104 * MiB, WS_QLAT = 136 * MiB, WS_KVLAT = 160 * MiB, WS_UM = 168 * MiB, WS_OPRE = 184 * MiB, WS_GA = 200 * MiB, WS_GM = 232 * MiB,
                 WS_SMALL = 264 * MiB, WS_RQ = 268 * MiB, WS_RKV = WS_RQ + 65536, WS_LOGI = WS_RQ + 262144, WS_LOGF = WS_RQ + 524288, WS_Q = 269 * MiB, WS_K = 293 * MiB,
                 WS_V = 317 * MiB, WS_CONV = 333 * MiB, WS_QKM = 349 * MiB, WS_VM = 381 * MiB, WS_AO = 397 * MiB, WS_OUTM = 413 * MiB, WS_MERGED = 429 * MiB, WS_END = 461 * MiB;
constexpr size_t WS_PQ = WS_QLAT, WS_IDX = WS_UM, WS_GATE = WS_UM + 8 * MiB;

constexpr int RING_OFF = 0, RING_BYTES = 131072;
constexpr int LDSCTL_OFF = RING_BYTES, MISC_OFF = LDSCTL_OFF + 320;
constexpr int LDS_BYTES = 147456;

typedef float f32x2v __attribute__((ext_vector_type(2)));
typedef unsigned u32x2 __attribute__((ext_vector_type(2)));

__device__ __forceinline__ float wave_sum(float v) {
#pragma unroll
    for (int o = 1; o < 64; o <<= 1) v += __shfl_xor(v, o);
    return v;
}
__device__ __forceinline__ float bflo(unsigned u) { return __uint_as_float(u << 16); }
__device__ __forceinline__ float bfhi(unsigned u) { return __uint_as_float(u & 0xffff0000u); }
__device__ __forceinline__ float sigm(float x) { return 1.f / (1.f + __expf(-x)); }
__device__ __forceinline__ float dot4(f32x4 a, f32x4 b) { return (a.x * b.x + a.y * b.y) + (a.z * b.z + a.w * b.w); }
__device__ __forceinline__ float gelu_erf(float x) { return 0.5f * x * (1.f + erff(x * 0.70710678118654752f)); }

struct EpiProj {
    static constexpr bool PERM = true, AFTER_DRAIN = false;
    bf16 *qlat, *kvlat, *um, *opre, *ga, *gm; float* small;
    __device__ __forceinline__ void operator()(const f32x4 (&acc)[2][2][4][2], const pg8::Unit& u, int wr, int wc, int fr, int fq) const {
        const int pn = u.pn; bf16* dst; int ld, cb; int mode = 0;
        if (pn < 3) { dst = qlat; ld = 768; cb = pn * 256; }
        else if (pn == 3) { dst = kvlat; ld = 256; cb = 0; }
        else if (pn < 6) { dst = um; ld = 512; cb = (pn - 4) * 256; }
        else if (pn < 8) { dst = opre; ld = 512; cb = (pn - 6) * 256; }
        else if (pn < 12) { dst = ga; ld = 1024; cb = (pn - 8) * 256; mode = 1; }
        else if (pn < 16) { dst = gm; ld = 1024; cb = (pn - 12) * 256; mode = 1; }
        else { dst = nullptr; ld = 0; cb = 0; mode = 2; }
        const int row0 = u.pm * 256 + wr * 64 + fr;
        if (mode == 2) {
            if (wc < 2) {
#pragma unroll
                for (int ai = 0; ai < 2; ++ai)
#pragma unroll
                    for (int m = 0; m < 4; ++m) { float* p = small + (size_t)(row0 + ai * 128 + m * 16) * 64 + wc * 32 + 8 * fq;
                        *(f32x4*)p = acc[ai][0][m][0]; *(f32x4*)(p + 4) = acc[ai][0][m][1]; }
            }
        } else {
#pragma unroll
            for (int ai = 0; ai < 2; ++ai)
#pragma unroll
                for (int m = 0; m < 4; ++m) { bf16* rowp = dst + (size_t)(row0 + ai * 128 + m * 16) * ld + cb + wc * 32 + 8 * fq;
#pragma unroll
                    for (int bj = 0; bj < 2; ++bj) { f32x4 v0 = acc[ai][bj][m][0], v1 = acc[ai][bj][m][1];
                        if (mode == 1) { v0 = (f32x4){sigm(v0[0]), sigm(v0[1]), sigm(v0[2]), sigm(v0[3])}; v1 = (f32x4){sigm(v1[0]), sigm(v1[1]), sigm(v1[2]), sigm(v1[3])}; }
                        v4u w; w.x = pk2(v0[0], v0[1]); w.y = pk2(v0[2], v0[3]); w.z = pk2(v1[0], v1[1]); w.w = pk2(v1[2], v1[3]);
                        *(v4u*)(rowp + bj * 128) = w; } }
        }
    }
};
struct EpiQ {
    static constexpr bool PERM = true, AFTER_DRAIN = false;
    bf16* Q; const float* rq; const float* cosT; const float* sinT;
    __device__ __forceinline__ void operator()(const f32x4 (&acc)[2][2][4][2], const pg8::Unit& u, int wr, int wc, int fr, int fq) const {
        const int row0 = u.pm * 256 + wr * 64 + fr;
#pragma unroll
        for (int ai = 0; ai < 2; ++ai)
#pragma unroll
            for (int m = 0; m < 4; ++m) { const int row = row0 + ai * 128 + m * 16; const float r = rq[row];
#pragma unroll
                for (int bj = 0; bj < 2; ++bj) { const int c0 = u.pn * 256 + bj * 128 + wc * 32 + 8 * fq; const int d0 = c0 % 96;
                    f32x4 v0 = acc[ai][bj][m][0] * r, v1 = acc[ai][bj][m][1] * r;
                    if (d0 >= 64) { const int j0 = (d0 - 64) >> 1; const f32x4 cs = *(const f32x4*)(cosT + (size_t)row * 16 + j0), sn = *(const f32x4*)(sinT + (size_t)row * 16 + j0);
                        const f32x4 a0 = v0, a1 = v1;
                        v0[0] = a0[0] * cs[0] - a0[1] * sn[0]; v0[1] = a0[1] * cs[0] + a0[0] * sn[0];
                        v0[2] = a0[2] * cs[1] - a0[3] * sn[1]; v0[3] = a0[3] * cs[1] + a0[2] * sn[1];
                        v1[0] = a1[0] * cs[2] - a1[1] * sn[2]; v1[1] = a1[1] * cs[2] + a1[0] * sn[2];
                        v1[2] = a1[2] * cs[3] - a1[3] * sn[3]; v1[3] = a1[3] * cs[3] + a1[2] * sn[3]; }
                    v4u w; w.x = pk2(v0[0], v0[1]); w.y = pk2(v0[2], v0[3]); w.z = pk2(v1[0], v1[1]); w.w = pk2(v1[2], v1[3]);
                    *(v4u*)(Q + (size_t)row * 768 + c0) = w; } }
    }
};
struct EpiKV {
    static constexpr bool PERM = true, AFTER_DRAIN = false;
    bf16* K; bf16* V; const float* rkv;
    __device__ __forceinline__ void operator()(const f32x4 (&acc)[2][2][4][2], const pg8::Unit& u, int wr, int wc, int fr, int fq) const {
        const int row0 = u.pm * 256 + wr * 64 + fr;
#pragma unroll
        for (int ai = 0; ai < 2; ++ai)
#pragma unroll
            for (int m = 0; m < 4; ++m) { const int row = row0 + ai * 128 + m * 16; const float r = rkv[row];
#pragma unroll
                for (int bj = 0; bj < 2; ++bj) { const int c0 = u.pn * 256 + bj * 128 + wc * 32 + 8 * fq;
                    const f32x4 v0 = acc[ai][bj][m][0] * r, v1 = acc[ai][bj][m][1] * r;
                    bf16* dst = (c0 < 512) ? (K + (size_t)row * 768 + 96 * (c0 >> 6) + (c0 & 63)) : (V + (size_t)row * 512 + (c0 - 512));
                    v4u w; w.x = pk2(v0[0], v0[1]); w.y = pk2(v0[2], v0[3]); w.z = pk2(v1[0], v1[1]); w.w = pk2(v1[2], v1[3]);
                    *(v4u*)dst = w; } }
    }
};
struct EpiMerge {
    static constexpr bool PERM = true, AFTER_DRAIN = false;
    bf16* Mg; const bf16* gate; int first;
    __device__ __forceinline__ void operator()(const f32x4 (&acc)[2][2][4][2], const pg8::Unit& u, int wr, int wc, int fr, int fq) const {
        const int row0 = u.pm * 256 + wr * 64 + fr;
#pragma unroll
        for (int ai = 0; ai < 2; ++ai)
#pragma unroll
            for (int m = 0; m < 4; ++m) { const int row = row0 + ai * 128 + m * 16;
#pragma unroll
                for (int bj = 0; bj < 2; ++bj) { const int c0 = u.pn * 256 + bj * 128 + wc * 32 + 8 * fq; const size_t off = (size_t)row * 1024 + c0;
                    const v4u g = *(const v4u*)(gate + off);
                    f32x4 v0 = acc[ai][bj][m][0], v1 = acc[ai][bj][m][1];
                    v0[0] *= bflo(g.x); v0[1] *= bfhi(g.x); v0[2] *= bflo(g.y); v0[3] *= bfhi(g.y); v1[0] *= bflo(g.z); v1[1] *= bfhi(g.z); v1[2] *= bflo(g.w); v1[3] *= bfhi(g.w);
                    if (!first) { const v4u o = *(const v4u*)(Mg + off);
                        v0[0] += bflo(o.x); v0[1] += bfhi(o.x); v0[2] += bflo(o.y); v0[3] += bfhi(o.y); v1[0] += bflo(o.z); v1[1] += bfhi(o.z); v1[2] += bflo(o.w); v1[3] += bfhi(o.w); }
                    v4u w; w.x = pk2(v0[0], v0[1]); w.y = pk2(v0[2], v0[3]); w.z = pk2(v1[0], v1[1]); w.w = pk2(v1[2], v1[3]);
                    *(v4u*)(Mg + off) = w; } }
    }
};
struct EpiResid {
    static constexpr bool PERM = true, AFTER_DRAIN = false;
    const float* xin; float* xout; const float* gate;
    __device__ __forceinline__ void operator()(const f32x4 (&acc)[2][2][4][2], const pg8::Unit& u, int wr, int wc, int fr, int fq) const {
        const int row0 = u.pm * 256 + wr * 64 + fr;
#pragma unroll
        for (int ai = 0; ai < 2; ++ai)
#pragma unroll
            for (int m = 0; m < 4; ++m) { const int row = row0 + ai * 128 + m * 16; const int b = row >> 11;
#pragma unroll
                for (int bj = 0; bj < 2; ++bj) { const int c0 = u.pn * 256 + bj * 128 + wc * 32 + 8 * fq; const size_t off = (size_t)row * 1024 + c0;
                    const float* gp = gate + (size_t)b * NADA + c0;
                    const f32x4 g0 = *(const f32x4*)gp, g1 = *(const f32x4*)(gp + 4), x0 = *(const f32x4*)(xin + off), x1 = *(const f32x4*)(xin + off + 4);
                    *(f32x4*)(xout + off) = x0 + g0 * acc[ai][bj][m][0]; *(f32x4*)(xout + off + 4) = x1 + g1 * acc[ai][bj][m][1]; } }
    }
};

template <class Get> __device__ __forceinline__ void prep_tile(const Get& get, bf16* dst, int K, int k0, int n0, LAS float* scr, int lane) {
#pragma unroll 8
    for (int i = 0; i < 32; ++i) { const int kk = 2 * i + (lane >> 5); scr[kk * 33 + (lane & 31)] = get(k0 + kk, n0 + (lane & 31)); }
    LDS_WAIT(); asm volatile("" ::: "memory");
    const int c = lane & 7;
#pragma unroll
    for (int j = 0; j < 4; ++j) { const int n = (lane >> 3) + 8 * j; const LAS float* s = scr + (8 * c) * 33 + n;
        v4u o; o.x = pk2(s[0 * 33], s[1 * 33]); o.y = pk2(s[2 * 33], s[3 * 33]); o.z = pk2(s[4 * 33], s[5 * 33]); o.w = pk2(s[6 * 33], s[7 * 33]);
        *(GAS v4u*)(dst + (size_t)(n0 + n) * K + k0 + 8 * c) = o; }
    LDS_WAIT(); asm volatile("" ::: "memory");
}
struct GetWin { const float* w; __device__ __forceinline__ float operator()(int k, int n) const {
    int sc; if (n < 1024) sc = n; else if (n < 2048) sc = n + 32; else if (n < 4096) sc = n + 40; else if (n < 4128) sc = n - 3072; else if (n < 4136) sc = n - 2048; else sc = -1;
    return sc < 0 ? 0.f : w[(size_t)k * 4136 + sc]; } };
struct GetWq { const float* w; const float* g; __device__ __forceinline__ float operator()(int k, int n) const {
    const int h = n / 96, dd = n % 96; const int e = dd - 64; const int sd = dd < 64 ? dd : 64 + (e >> 1) + 16 * (e & 1);
    return w[(size_t)k * 768 + h * 96 + sd] * g[k] * QSCALE; } };
struct GetWkv { const float* w; const float* g; __device__ __forceinline__ float operator()(int k, int n) const {
    const int nn = n & 511, h = nn >> 6, c = nn & 63; const int sc = h * 128 + c + ((n >= 512) ? 64 : 0);
    return w[(size_t)k * 1024 + sc] * g[k]; } };
struct GetPlain { const float* w; int N; __device__ __forceinline__ float operator()(int k, int n) const { return w[(size_t)k * N + n]; } };
struct GetWqk { const float* wq; const float* wk; __device__ __forceinline__ float operator()(int k, int n) const {
    const int part = n >> 9, nn = n & 511, h = nn >> 7, e = nn & 127, kh = k >> 7, d = k & 127;
    if (kh != h) return 0.f;
    const size_t off = ((size_t)h * 128 + d) * 128 + e;
    return part ? wk[off] * 0.08838834764831845f : wq[off]; } };
struct GetWv { const float* wv; __device__ __forceinline__ float operator()(int k, int n) const {
    const int h = n >> 7, e = n & 127, kh = k >> 7, d = k & 127;
    return (kh != h) ? 0.f : wv[((size_t)h * 128 + d) * 128 + e]; } };

__device__ const float INV_FREQ[16] = { 1.0f, 0.5623413251903491f, 0.31622776601683794f, 0.1778279410038923f, 0.1f, 0.05623413251903491f, 0.031622776601683794f, 0.01778279410038923f,
    0.01f, 0.005623413251903491f, 0.0031622776601683794f, 0.001778279410038923f, 0.001f, 0.0005623413251903491f, 0.00031622776601683794f, 0.0001778279410038923f };

__device__ __forceinline__ void rowpass_norm_mod(const float* xin, const float* g, const float* ada_shift, const float* ada_scale, bf16* hout, int gw, int NGW, int lane) {
    for (int t = gw; t < T; t += NGW) {
        const int b = t >> 11;
        const f32x4* xr = (const f32x4*)(xin + (size_t)t * D) + lane;
        f32x4 v[4]; float s = 0.f;
#pragma unroll
        for (int j = 0; j < 4; ++j) { v[j] = xr[64 * j]; s += dot4(v[j], v[j]); }
        const float r = rsqrtf(wave_sum(s) * (1.f / D) + RMS_EPS);
        unsigned long long* o8 = (unsigned long long*)(hout + (size_t)t * D) + lane;
#pragma unroll
        for (int j = 0; j < 4; ++j) { const int col = 4 * lane + 256 * j;
            const f32x4 gg = *(const f32x4*)(g + col), sc = *(const f32x4*)(ada_scale + (size_t)b * NADA + col), sh = *(const f32x4*)(ada_shift + (size_t)b * NADA + col);
            const f32x4 o = v[j] * r * gg * (sc + 1.f) + sh;
            o8[64 * j] = (unsigned long long)pk2(o.x, o.y) | ((unsigned long long)pk2(o.z, o.w) << 32); }
    }
}
__device__ __forceinline__ void rowpass_final(const float* xin, const float* g, float* out, int gw, int NGW, int lane) {
    for (int t = gw; t < T; t += NGW) {
        const f32x4* xr = (const f32x4*)(xin + (size_t)t * D) + lane;
        f32x4 v[4]; float s = 0.f;
#pragma unroll
        for (int j = 0; j < 4; ++j) { v[j] = xr[64 * j]; s += dot4(v[j], v[j]); }
        const float r = rsqrtf(wave_sum(s) * (1.f / D) + RMS_EPS);
        f32x4* o = (f32x4*)(out + (size_t)t * D) + lane;
#pragma unroll
        for (int j = 0; j < 4; ++j) { const f32x4 gg = *(const f32x4*)(g + 4 * lane + 256 * j); o[64 * j] = v[j] * r * gg; }
    }
}
__device__ __forceinline__ void rowpass_mid(const bf16* qlat, const bf16* kvlat, const float* small, const float* cosT, const float* sinT, const bf16* um,
                                            const float* conv_w, const float* conv_b, const float* b_i, const float* b_f,
                                            float* RQ, float* RKV, bf16* K, float* LOGI, float* LOGF, bf16* CONV, int gw, int NGW, int lane) {
    for (int t = gw; t < T; t += NGW) {
        const int pos = t & (SEQ - 1);
        { float s = 0.f; const u32x2* p = (const u32x2*)(qlat + (size_t)t * 768);
#pragma unroll
          for (int j = 0; j < 3; ++j) { const u32x2 w = p[lane + 64 * j]; const float a = bflo(w.x), b2 = bfhi(w.x), c = bflo(w.y), d = bfhi(w.y); s += (a * a + b2 * b2) + (c * c + d * d); }
          const float rq = rsqrtf(wave_sum(s) * (1.f / 768.f) + RMS_EPS);
          const u32x2 w = ((const u32x2*)(kvlat + (size_t)t * 256))[lane]; const float a = bflo(w.x), b2 = bfhi(w.x), c = bflo(w.y), d = bfhi(w.y);
          const float rkv = rsqrtf(wave_sum((a * a + b2 * b2) + (c * c + d * d)) * (1.f / 256.f) + RMS_EPS);
          if (lane == 0) { RQ[t] = rq; RKV[t] = rkv; } }
        const float* sm = small + (size_t)t * 64;
        if (lane < 16) { const float x1 = sm[lane], x2 = sm[16 + lane], c = cosT[(size_t)t * 16 + lane], s = sinT[(size_t)t * 16 + lane];
            const unsigned pk = pk2(x1 * c - x2 * s, x2 * c + x1 * s);
#pragma unroll
            for (int h = 0; h < 8; ++h) ((unsigned*)(K + (size_t)t * 768 + 96 * h + 64))[lane] = pk; }
        else if (lane >= 32 && lane < 36) { const int h = lane - 32; LOGI[(size_t)t * 4 + h] = sm[32 + h] + b_i[h]; }
        else if (lane >= 36 && lane < 40) { const int h = lane - 36; const float x = sm[36 + h] + b_f[h]; LOGF[(size_t)t * 4 + h] = fminf(x, 0.f) - log1pf(expf(-fabsf(x))); }
        { const int c0 = 8 * lane; float a[8];
          const f32x4 b0 = *(const f32x4*)(conv_b + c0), b1 = *(const f32x4*)(conv_b + c0 + 4);
          a[0] = b0[0]; a[1] = b0[1]; a[2] = b0[2]; a[3] = b0[3]; a[4] = b1[0]; a[5] = b1[1]; a[6] = b1[2]; a[7] = b1[3];
#pragma unroll
          for (int j = 0; j < 4; ++j) { if (pos - 3 + j >= 0) { const v4u w = *(const v4u*)(um + (size_t)(t - 3 + j) * 512 + c0);
              const f32x4 w0 = *(const f32x4*)(conv_w + j * 512 + c0), w1 = *(const f32x4*)(conv_w + j * 512 + c0 + 4);
              a[0] += w0[0] * bflo(w.x); a[1] += w0[1] * bfhi(w.x); a[2] += w0[2] * bflo(w.y); a[3] += w0[3] * bfhi(w.y);
              a[4] += w1[0] * bflo(w.z); a[5] += w1[1] * bfhi(w.z); a[6] += w1[2] * bflo(w.w); a[7] += w1[3] * bfhi(w.w); } }
#pragma unroll
          for (int i = 0; i < 8; ++i) a[i] = a[i] * sigm(a[i]);
          v4u o; o.x = pk2(a[0], a[1]); o.y = pk2(a[2], a[3]); o.z = pk2(a[4], a[5]); o.w = pk2(a[6], a[7]);
          *(v4u*)(CONV + (size_t)t * 512 + c0) = o; }
    }
}

__device__ __forceinline__ void attn_naive(const bf16* Q, const bf16* K, const bf16* V, bf16* AO, int gw, int NGW, int lane) {
    for (int it = gw; it < (T / 64) * 8; it += NGW) {
        const int bh = it >> 5, qbi = it & 31, qb = ((qbi & 7) << 2) | (qbi >> 3), b = bh >> 3, h = bh & 7;
        const int qpos = qb * 64 + lane; const size_t trow = (size_t)b * SEQ + qpos;
        unsigned qp[48];
        { const v4u* qs = (const v4u*)(Q + trow * 768 + 96 * h);
#pragma unroll
          for (int i = 0; i < 12; ++i) { const v4u w = qs[i]; qp[4 * i] = w.x; qp[4 * i + 1] = w.y; qp[4 * i + 2] = w.z; qp[4 * i + 3] = w.w; } }
        float m = -INFINITY, l = 0.f; float acc[64];
#pragma unroll
        for (int i = 0; i < 64; ++i) acc[i] = 0.f;
        const int kend = qb * 64 + 63;
        for (int kk = 0; kk <= kend; ++kk) {
            const size_t krow = (size_t)b * SEQ + kk;
            const v4u* kp = (const v4u*)(K + krow * 768 + 96 * h);
            float s = 0.f;
#pragma unroll
            for (int i = 0; i < 12; ++i) { const v4u w = kp[i];
                s += bflo(qp[4 * i]) * bflo(w.x) + bfhi(qp[4 * i]) * bfhi(w.x) + bflo(qp[4 * i + 1]) * bflo(w.y) + bfhi(qp[4 * i + 1]) * bfhi(w.y)
                   + bflo(qp[4 * i + 2]) * bflo(w.z) + bfhi(qp[4 * i + 2]) * bfhi(w.z) + bflo(qp[4 * i + 3]) * bflo(w.w) + bfhi(qp[4 * i + 3]) * bfhi(w.w); }
            const bool ok = kk <= qpos;
            s = ok ? s : -INFINITY;
            const float mn = fmaxf(m, s);
            const float corr = __builtin_amdgcn_exp2f(m - mn), p = ok ? __builtin_amdgcn_exp2f(s - mn) : 0.f;
            l = l * corr + p; m = mn;
            const v4u* vp = (const v4u*)(V + krow * 512 + 64 * h);
#pragma unroll
            for (int i = 0; i < 8; ++i) { const v4u w = vp[i];
                acc[8 * i + 0] = acc[8 * i + 0] * corr + p * bflo(w.x); acc[8 * i + 1] = acc[8 * i + 1] * corr + p * bfhi(w.x);
                acc[8 * i + 2] = acc[8 * i + 2] * corr + p * bflo(w.y); acc[8 * i + 3] = acc[8 * i + 3] * corr + p * bfhi(w.y);
                acc[8 * i + 4] = acc[8 * i + 4] * corr + p * bflo(w.z); acc[8 * i + 5] = acc[8 * i + 5] * corr + p * bfhi(w.z);
                acc[8 * i + 6] = acc[8 * i + 6] * corr + p * bflo(w.w); acc[8 * i + 7] = acc[8 * i + 7] * corr + p * bfhi(w.w); }
        }
        const float inv = 1.f / l;
        v4u* op = (v4u*)(AO + trow * 512 + 64 * h);
#pragma unroll
        for (int i = 0; i < 8; ++i) { v4u o; o.x = pk2(acc[8 * i] * inv, acc[8 * i + 1] * inv); o.y = pk2(acc[8 * i + 2] * inv, acc[8 * i + 3] * inv);
            o.z = pk2(acc[8 * i + 4] * inv, acc[8 * i + 5] * inv); o.w = pk2(acc[8 * i + 6] * inv, acc[8 * i + 7] * inv); op[i] = o; }
    }
}

template <int HALF_>
__device__ __forceinline__ void mlstm_pass(const unsigned (&qp)[64], float (&acc)[64], float& den, const bf16* QKM, const bf16* VM, const float* LOGI, const float* LOGF,
                                           int b, int h, int send, int tau, float Ftau) {
    float Frun = 0.f; den = 0.f;
#pragma unroll
    for (int i = 0; i < 64; ++i) acc[i] = 0.f;
    for (int sg = 0; sg <= send; ++sg) {
        const size_t srow = (size_t)b * SEQ + sg;
        const float lf = LOGF[srow * 4 + h], li = LOGI[srow * 4 + h];
        Frun += lf;
        const v4u* kp = (const v4u*)(QKM + srow * 1024 + 512 + h * 128);
        float dot = 0.f;
#pragma unroll
        for (int i = 0; i < 16; ++i) { if ((i & 3) == 0) asm volatile("" ::: "memory");
            const v4u w = kp[i];
            dot += bflo(qp[4 * i]) * bflo(w.x) + bfhi(qp[4 * i]) * bfhi(w.x) + bflo(qp[4 * i + 1]) * bflo(w.y) + bfhi(qp[4 * i + 1]) * bfhi(w.y)
                 + bflo(qp[4 * i + 2]) * bflo(w.z) + bfhi(qp[4 * i + 2]) * bfhi(w.z) + bflo(qp[4 * i + 3]) * bflo(w.w) + bfhi(qp[4 * i + 3]) * bfhi(w.w); }
        const float wgt = (sg <= tau) ? __expf(li + Ftau - Frun) : 0.f;
        const float a = wgt * dot; den += a;
        const v4u* vp = (const v4u*)(VM + srow * 512 + h * 128 + HALF_ * 64);
        asm volatile("" ::: "memory");
#pragma unroll
        for (int i = 0; i < 8; ++i) { if (i == 4) asm volatile("" ::: "memory");
            const v4u w = vp[i];
            acc[8 * i + 0] += a * bflo(w.x); acc[8 * i + 1] += a * bfhi(w.x); acc[8 * i + 2] += a * bflo(w.y); acc[8 * i + 3] += a * bfhi(w.y);
            acc[8 * i + 4] += a * bflo(w.z); acc[8 * i + 5] += a * bfhi(w.z); acc[8 * i + 6] += a * bflo(w.w); acc[8 * i + 7] += a * bfhi(w.w); }
    }
}
__device__ __forceinline__ void mlstm_naive(const bf16* QKM, const bf16* VM, const float* LOGI, const float* LOGF, const bf16* CONV, const bf16* OPRE, const float* ng, const float* skip,
                                            bf16* OUTM, LAS float* scr  , int gw, int NGW, int lane) {
    for (int it = gw; it < 1024; it += NGW) {
        const int bh = it >> 5, qbi = it & 31, rb = ((qbi & 7) << 2) | (qbi >> 3), b = bh >> 2, h = bh & 3;
        const int tau = rb * 64 + lane; const size_t trow = (size_t)b * SEQ + tau;
        float ps = 0.f;
        for (int r = lane; r < rb * 64; r += 64) ps += LOGF[((size_t)b * SEQ + r) * 4 + h];
        scr[lane] = LOGF[trow * 4 + h]; scr[64 + lane] = ps;
        LDS_WAIT();
        float x = 0.f; ps = 0.f;
#pragma unroll 8
        for (int j = 0; j < 64; ++j) { const float y = scr[j]; x += (j <= lane) ? y : 0.f; ps += scr[64 + j]; }
        LDS_WAIT();
        const float Ftau = ps + x;
        unsigned qp[64];
        { const v4u* qs = (const v4u*)(QKM + trow * 1024 + h * 128);
#pragma unroll
          for (int i = 0; i < 16; ++i) { const v4u w = qs[i]; qp[4 * i] = w.x; qp[4 * i + 1] = w.y; qp[4 * i + 2] = w.z; qp[4 * i + 3] = w.w; } }
        float acc[64]; float den, den2;
        mlstm_pass<0>(qp, acc, den, QKM, VM, LOGI, LOGF, b, h, rb * 64 + 63, tau, Ftau);
#pragma unroll
        for (int d = 0; d < 64; ++d) scr[d * 64 + lane] = acc[d];
        mlstm_pass<1>(qp, acc, den2, QKM, VM, LOGI, LOGF, b, h, rb * 64 + 63, tau, Ftau);
        LDS_WAIT();
        const float inv = 1.f / fmaxf(fabsf(den), 1.f);
        float mu = 0.f;
#pragma unroll
        for (int d = 0; d < 64; ++d) mu += scr[d * 64 + lane] + acc[d];
        mu *= inv * (1.f / 128.f);
        float var = 0.f;
#pragma unroll
        for (int d = 0; d < 64; ++d) { const float a = scr[d * 64 + lane] * inv - mu, c = acc[d] * inv - mu; var += a * a + c * c; }
        const float rstd = rsqrtf(var * (1.f / 128.f) + RMS_EPS);
#pragma unroll
        for (int hf = 0; hf < 2; ++hf)
#pragma unroll
            for (int i = 0; i < 8; ++i) { const int c0 = h * 128 + hf * 64 + 8 * i; const size_t off = trow * 512 + c0;
                const v4u cv = *(const v4u*)(CONV + off), ov = *(const v4u*)(OPRE + off);
                float o[8];
#pragma unroll
                for (int e = 0; e < 8; ++e) { const float hv = hf == 0 ? scr[(8 * i + e) * 64 + lane] : acc[8 * i + e];
                    const unsigned cw = e < 2 ? cv.x : e < 4 ? cv.y : e < 6 ? cv.z : cv.w, ow = e < 2 ? ov.x : e < 4 ? ov.y : e < 6 ? ov.z : ov.w;
                    const float cvf = (e & 1) ? bfhi(cw) : bflo(cw), opf = (e & 1) ? bfhi(ow) : bflo(ow);
                    o[e] = sigm(opf) * ((hv * inv - mu) * rstd * ng[c0 + e] + skip[c0 + e] * cvf); }
                v4u w; w.x = pk2(o[0], o[1]); w.y = pk2(o[2], o[3]); w.z = pk2(o[4], o[5]); w.w = pk2(o[6], o[7]);
                *(v4u*)(OUTM + off) = w; }
        LDS_WAIT();
    }
}

__device__ __forceinline__ void peer_naive(const bf16* PQ, const bf16* H, const float* keys, const float* U, const float* Vt, const float* gate2, float* X,
                                           LAS float* scr  , int gw, int NGW, int lane) {
    LAS float* qs = scr; LAS float* tv = scr + 1024; LAS int* ti = (LAS int*)(scr + 1024 + 32); LAS int* eidx = (LAS int*)(scr + 1024 + 64); LAS float* egate = scr + 1024 + 64 + 128;
    for (int t = gw; t < T; t += NGW) {
        const int b = t >> 11;
        { const v4u* p = (const v4u*)(PQ + (size_t)t * 1024) + lane * 2; const v4u a = p[0], c = p[1]; LAS float* q = qs + 16 * lane;
          q[0] = bflo(a.x); q[1] = bfhi(a.x); q[2] = bflo(a.y); q[3] = bfhi(a.y); q[4] = bflo(a.z); q[5] = bfhi(a.z); q[6] = bflo(a.w); q[7] = bfhi(a.w);
          q[8] = bflo(c.x); q[9] = bfhi(c.x); q[10] = bflo(c.y); q[11] = bfhi(c.y); q[12] = bflo(c.z); q[13] = bfhi(c.z); q[14] = bflo(c.w); q[15] = bfhi(c.w); }
        LDS_WAIT();
        for (int h = 0; h < 8; ++h) {
            for (int p = 0; p < 2; ++p) {
                const float* kb = keys + ((size_t)(h * 2 + p) * 128) * 64;
                const LAS f32x4* qv = (const LAS f32x4*)(qs + h * 128 + p * 64);
                const f32x4* k0 = (const f32x4*)(kb + (size_t)lane * 64); const f32x4* k1 = (const f32x4*)(kb + (size_t)(lane + 64) * 64);
                float s0 = 0.f, s1 = 0.f;
#pragma unroll
                for (int i = 0; i < 16; ++i) { const f32x4 q4 = qv[i]; s0 += dot4(q4, k0[i]); s1 += dot4(q4, k1[i]); }
                for (int a = 0; a < 16; ++a) {
                    float bv = s0 >= s1 ? s0 : s1; int bi = s0 >= s1 ? lane : lane + 64;
#pragma unroll
                    for (int off = 32; off >= 1; off >>= 1) { const float ov = __shfl_xor(bv, off); const int oi = __shfl_xor(bi, off); if (ov > bv || (ov == bv && oi < bi)) { bv = ov; bi = oi; } }
                    if (lane == 0) { tv[p * 16 + a] = bv; ti[p * 16 + a] = bi; }
                    if (bi == lane) s0 = -INFINITY;
                    if (bi == lane + 64) s1 = -INFINITY;
                }
            }
            LDS_WAIT();
            float cv[4];
#pragma unroll
            for (int r = 0; r < 4; ++r) cv[r] = tv[r * 4 + (lane >> 4)] + tv[16 + (lane & 15)];
            float myv = 0.f; int myc = 0;
            for (int k = 0; k < 16; ++k) {
                float bv = cv[0]; int bc = lane;
#pragma unroll
                for (int r = 1; r < 4; ++r) if (cv[r] > bv) { bv = cv[r]; bc = r * 64 + lane; }
#pragma unroll
                for (int off = 32; off >= 1; off >>= 1) { const float ov = __shfl_xor(bv, off); const int oc = __shfl_xor(bc, off); if (ov > bv || (ov == bv && oc < bc)) { bv = ov; bc = oc; } }
                if (lane == k) { myv = bv; myc = bc; }
                if ((bc & 63) == lane) {
#pragma unroll
                    for (int r = 0; r < 4; ++r) if (r == (bc >> 6)) cv[r] = -INFINITY; }
            }
            const float mx = __shfl(myv, 0);
            const float pe = lane < 16 ? __expf(myv - mx) : 0.f;
            const float sum = wave_sum(pe);
            if (lane < 16) { eidx[h * 16 + lane] = ti[myc >> 4] * 128 + ti[16 + (myc & 15)]; egate[h * 16 + lane] = pe / sum; }
            LDS_WAIT();
        }
        f32x4 hx[4];
        { const u32x2* hp = (const u32x2*)(H + (size_t)t * 1024);
#pragma unroll
          for (int j = 0; j < 4; ++j) { const u32x2 w = hp[lane + 64 * j]; hx[j] = (f32x4){bflo(w.x), bfhi(w.x), bflo(w.y), bfhi(w.y)}; } }
        f32x4 y[4];
#pragma unroll
        for (int j = 0; j < 4; ++j) y[j] = (f32x4){0.f, 0.f, 0.f, 0.f};
#pragma unroll 2
        for (int ei = 0; ei < 128; ++ei) {
            const int e = eidx[ei]; const float g = egate[ei];
            const f32x4* up = (const f32x4*)(U + (size_t)e * 1024) + lane;
            const f32x4* vp = (const f32x4*)(Vt + (size_t)e * 1024) + lane;
            float d = 0.f;
#pragma unroll
            for (int j = 0; j < 4; ++j) d += dot4(hx[j], up[64 * j]);
            d = wave_sum(d);
            const float w = gelu_erf(d) * g;
#pragma unroll
            for (int j = 0; j < 4; ++j) y[j] += vp[64 * j] * w;
        }
#pragma unroll
        for (int j = 0; j < 4; ++j) { const int col = 4 * lane + 256 * j; const f32x4 g2 = *(const f32x4*)(gate2 + (size_t)b * NADA + col);
            f32x4* xp = (f32x4*)(X + (size_t)t * 1024 + col); *xp = *xp + g2 * y[j]; }
        LDS_WAIT();
    }
}

constexpr int PH_PER_LAYER = 10, N_PHASES = 1 + DEPTH * PH_PER_LAYER + 1;
struct Args { const void* in[N_INPUTS]; float* out; unsigned char* ws; int ph_lo, ph_hi; };
static_assert(sizeof(Args) == N_INPUTS * 8 + 24, "Args has no padding");

constexpr int PTAB_OFF = LDSCTL_OFF + 1024;
__device__ __forceinline__ unsigned char* getp(LAS unsigned char* lds, int i) {
    asm volatile("" ::: "memory");
    const u32x2 v = *(volatile LAS u32x2*)(lds + PTAB_OFF + 8 * i);
    const unsigned lo = __builtin_amdgcn_readfirstlane(v.x), hi = __builtin_amdgcn_readfirstlane(v.y);
    return (unsigned char*)(((unsigned long long)hi << 32) | lo);
}
#define INP(i) ((const float*)getp(lds, (i)))
#define WSB() getp(lds, 30)

#define IN(k) (lo <= (k) && (k) < hi)
#define SEAM(k) do { if (MK_ONE_LAUNCH && IN(k) && IN((k) + 1)) { XcdBarrier b_; b_.bar = (unsigned*)(WSB() + WS_CTL) + CW_BAR; b_.x = xb_xcc_id(); b_.st = MISC + 8; xcd_barrier(b_); } } while (0)
#define PH_BEGIN(lv) int tidq = threadIdx.x; asm volatile("" : "+v"(tidq)); const int lane = tidq & 63, wave = __builtin_amdgcn_readfirstlane(tidq >> 6); \
    int G = gridDim.x, bx = blockIdx.x, l = (lv); asm volatile("" : "+s"(G), "+s"(bx), "+s"(l)); const int gw = bx * NWAVES + wave, NGW = G * NWAVES; \
    unsigned char* ws = WSB(); LAS float* wscr = (LAS float*)(lds + RING_OFF + wave * 16384); (void)lane; (void)gw; (void)NGW; (void)ws; (void)wscr; (void)l

template <int lv> __device__ __forceinline__ void layer_phases(LAS unsigned char* lds, volatile LAS unsigned* MISC, const int lo, const int hi) {
        const int P = 1 + lv * PH_PER_LAYER;
#define WL() (ws + WS_W + (size_t)l * W_LAYER)
#define ADAL() ((const float*)(ws + ADA_OFF) + (size_t)l * 8 * NADA)
#define XIN() ((l == 0) ? INP(I_X) : (const float*)(ws + WS_X))
#define WSP(type, off) ((type*)(ws + (off)))
        if (IN(P + 0)) { PH_BEGIN(lv); rowpass_norm_mod(XIN(), INP(I_N1G) + l * D, ADAL() + 0, ADAL() + 1024, WSP(bf16, WS_H), gw, NGW, lane); }
        SEAM(P + 0);
        if (IN(P + 1)) { PH_BEGIN(lv);
            pg8::Gemm g{WSP(bf16, WS_H), (const bf16*)(WL() + WO_WIN), T, NPROJ, D}; pg8::StaticOrder S; S.init(T, NPROJ, G, bx);
            EpiProj E{WSP(bf16, WS_QLAT), WSP(bf16, WS_KVLAT), WSP(bf16, WS_UM), WSP(bf16, WS_OPRE), WSP(bf16, WS_GA), WSP(bf16, WS_GM), WSP(float, WS_SMALL)};
            pg8::gemm_phase<EpiProj, pg8::StaticOrder, true, true>(lds + RING_OFF, g, S, E);
        }
        SEAM(P + 1);
        if (IN(P + 2)) { PH_BEGIN(lv);
            rowpass_mid(WSP(bf16, WS_QLAT), WSP(bf16, WS_KVLAT), WSP(float, WS_SMALL), WSP(float, WS_COS), WSP(float, WS_SIN), WSP(bf16, WS_UM), INP(I_CONVW) + l * 4 * 512, INP(I_CONVB) + l * 512,
                        INP(I_BI) + l * 4, INP(I_BF) + l * 4, WSP(float, WS_RQ), WSP(float, WS_RKV), WSP(bf16, WS_K), WSP(float, WS_LOGI), WSP(float, WS_LOGF), WSP(bf16, WS_CONV), gw, NGW, lane); }
        SEAM(P + 2);
        if (IN(P + 3)) {
            { PH_BEGIN(lv); pg8::Gemm g{WSP(bf16, WS_QLAT), (const bf16*)(WL() + WO_WQ), T, 768, 768}; pg8::StaticOrder S; S.init(T, 768, G, bx);
              EpiQ E{WSP(bf16, WS_Q), WSP(float, WS_RQ), WSP(float, WS_COS), WSP(float, WS_SIN)}; pg8::gemm_phase<EpiQ, pg8::StaticOrder, true, true>(lds + RING_OFF, g, S, E); }
            { PH_BEGIN(lv); pg8::Gemm g{WSP(bf16, WS_KVLAT), (const bf16*)(WL() + WO_WKV), T, 1024, 256}; pg8::StaticOrder S; S.init(T, 1024, G, bx);
              EpiKV E{WSP(bf16, WS_K), WSP(bf16, WS_V), WSP(float, WS_RKV)}; pg8::gemm_phase<EpiKV, pg8::StaticOrder, true, true>(lds + RING_OFF, g, S, E); }
            { PH_BEGIN(lv); pg8::Gemm g{WSP(bf16, WS_CONV), (const bf16*)(WL() + WO_WQK), T, 1024, 512}; pg8::StaticOrder S; S.init(T, 1024, G, bx);
              pg8::EpiBf16<0> E{WSP(bf16, WS_QKM), 1024, nullptr, 0, 0, 1.f}; pg8::gemm_phase<pg8::EpiBf16<0>, pg8::StaticOrder, true, true>(lds + RING_OFF, g, S, E); }
            { PH_BEGIN(lv); pg8::Gemm g{WSP(bf16, WS_UM), (const bf16*)(WL() + WO_WV), T, 512, 512}; pg8::StaticOrder S; S.init(T, 512, G, bx);
              pg8::EpiBf16<0> E{WSP(bf16, WS_VM), 512, nullptr, 0, 0, 1.f}; pg8::gemm_phase<pg8::EpiBf16<0>, pg8::StaticOrder, true, true>(lds + RING_OFF, g, S, E); }
        }
        SEAM(P + 3);
        if (IN(P + 4)) {
            { PH_BEGIN(lv); attn_naive(WSP(bf16, WS_Q), WSP(bf16, WS_K), WSP(bf16, WS_V), WSP(bf16, WS_AO), gw, NGW, lane); }
            { PH_BEGIN(lv); mlstm_naive(WSP(bf16, WS_QKM), WSP(bf16, WS_VM), WSP(float, WS_LOGI), WSP(float, WS_LOGF), WSP(bf16, WS_CONV), WSP(bf16, WS_OPRE), INP(I_MHG) + l * 512, INP(I_MSKIP) + l * 512,
                          WSP(bf16, WS_OUTM), wscr, gw, NGW, lane); }
        }
        SEAM(P + 4);
        if (IN(P + 5)) {
            { PH_BEGIN(lv); pg8::Gemm g{WSP(bf16, WS_AO), (const bf16*)(WL() + WO_WA), T, 1024, 512}; pg8::StaticOrder S; S.init(T, 1024, G, bx);
              EpiMerge E{WSP(bf16, WS_MERGED), WSP(bf16, WS_GA), 1}; pg8::gemm_phase<EpiMerge, pg8::StaticOrder, true, true>(lds + RING_OFF, g, S, E); }
            { PH_BEGIN(lv); pg8::Gemm g{WSP(bf16, WS_OUTM), (const bf16*)(WL() + WO_WM), T, 1024, 512}; pg8::StaticOrder S; S.init(T, 1024, G, bx);
              EpiMerge E{WSP(bf16, WS_MERGED), WSP(bf16, WS_GM), 0}; pg8::gemm_phase<EpiMerge, pg8::StaticOrder, true, true>(lds + RING_OFF, g, S, E); }
        }
        SEAM(P + 5);
        if (IN(P + 6)) { PH_BEGIN(lv);
            pg8::Gemm g{WSP(bf16, WS_MERGED), (const bf16*)(WL() + WO_WO), T, 1024, 1024}; pg8::StaticOrder S; S.init(T, 1024, G, bx);
            EpiResid E{XIN(), WSP(float, WS_X), ADAL() + 2048}; pg8::gemm_phase<EpiResid, pg8::StaticOrder, true, true>(lds + RING_OFF, g, S, E);
        }
        SEAM(P + 6);
        if (IN(P + 7)) { PH_BEGIN(lv); rowpass_norm_mod(WSP(float, WS_X), INP(I_N2G) + l * D, ADAL() + 3072, ADAL() + 4096, WSP(bf16, WS_H), gw, NGW, lane); }
        SEAM(P + 7);
        if (IN(P + 8)) { PH_BEGIN(lv);
            pg8::Gemm g{WSP(bf16, WS_H), (const bf16*)(WL() + WO_PWQ), T, 1024, 1024}; pg8::StaticOrder S; S.init(T, 1024, G, bx);
            pg8::EpiBf16<0> E{WSP(bf16, WS_PQ), 1024, nullptr, 0, 0, 1.f}; pg8::gemm_phase<pg8::EpiBf16<0>, pg8::StaticOrder, true, true>(lds + RING_OFF, g, S, E);
        }
        SEAM(P + 8);
        if (IN(P + 9)) { PH_BEGIN(lv);
            peer_naive(WSP(bf16, WS_PQ), WSP(bf16, WS_H), INP(I_PKEYS) + (size_t)l * 8 * 2 * 128 * 64, INP(I_PU) + (size_t)l * 16384 * 1024, INP(I_PV) + (size_t)l * 16384 * 1024,
                       ADAL() + 5120, WSP(float, WS_X), wscr, gw, NGW, lane); }
        SEAM(P + 9);
    }

__global__ void __launch_bounds__(NTHREADS, 2) fwd(Args args) {
    extern __shared__ __attribute__((aligned(16))) unsigned char lds_raw[];
    LAS unsigned char* lds = (LAS unsigned char*)lds_raw;
    volatile LAS unsigned* MISC = (volatile LAS unsigned*)(lds + MISC_OFF);
    const int tid = threadIdx.x;
    for (int u = tid; u < (LDS_BYTES - LDSCTL_OFF) / 4; u += NTHREADS) ((LAS unsigned*)(lds + LDSCTL_OFF))[u] = 0u;
    __syncthreads();
    if (tid == 0) { LAS unsigned long long* pt = (LAS unsigned long long*)(lds + PTAB_OFF);
#pragma unroll
        for (int i = 0; i < N_INPUTS; ++i) pt[i] = (unsigned long long)args.in[i];
        pt[29] = (unsigned long long)args.out; pt[30] = (unsigned long long)args.ws; }
    __syncthreads();
    if (MK_ONE_LAUNCH) (void)xcd_barrier_post((unsigned*)(WSB() + WS_CTL) + CW_BAR, MISC + 8);
    const int lo = args.ph_lo, hi = args.ph_hi;

    if (IN(0)) {
        PH_BEGIN(0);
        float* ADA = (float*)(ws + ADA_OFF);
        { const float* c = INP(I_C); const float* wada = INP(I_WADA); const float* bada = INP(I_BADA);
          for (int it = gw; it < DEPTH * 96; it += NGW) {
            const int l = it / 96, cg = it % 96; const int n = cg * 64 + lane;
            float a[8];
#pragma unroll
            for (int bb = 0; bb < 8; ++bb) a[bb] = 0.f;
            for (int kc = 0; kc < 8; ++kc) {
#pragma unroll
                for (int i = 0; i < 16; ++i) { const int e = lane + 64 * i; const int bb = e >> 7, kk = e & 127; const float cv = c[bb * D + kc * 128 + kk]; wscr[e] = cv * sigm(cv); }
                LDS_WAIT();
                const float* w = wada + (size_t)l * D * NADA + (size_t)(kc * 128) * NADA + n;
#pragma unroll 8
                for (int kk = 0; kk < 128; ++kk) { const float wv = w[(size_t)kk * NADA];
#pragma unroll
                    for (int bb = 0; bb < 8; ++bb) a[bb] += wscr[bb * 128 + kk] * wv; }
                LDS_WAIT();
            }
            const float bias = bada[l * NADA + n];
#pragma unroll
            for (int bb = 0; bb < 8; ++bb) ADA[((size_t)l * 8 + bb) * NADA + n] = a[bb] + bias;
          } }
        { const int* pos = (const int*)INP(I_POS); float* COS = (float*)(ws + WS_COS); float* SIN = (float*)(ws + WS_SIN);
          for (int idx = gw * 64 + lane; idx < T * 16; idx += NGW * 64) { const int t = idx >> 4, j = idx & 15;
              const float ang = (float)pos[t] * INV_FREQ[j];
              const double rev = (double)ang * 0.15915494309189535; const float fr = (float)(rev - rint(rev));
              COS[idx] = __builtin_amdgcn_cosf(fr); SIN[idx] = __builtin_amdgcn_sinf(fr); } }
        { constexpr int I_WIN_ = 16 * 136, I_WQ_ = 12 * 24, I_WKV_ = 4 * 32, I_WA_ = 8 * 32, I_WM_ = 8 * 32, I_WO_ = 16 * 32, I_PW_ = 16 * 32, I_WQK_ = 8 * 32, I_WV_ = 8 * 16;
          constexpr int PER_L = I_WIN_ + I_WQ_ + I_WKV_ + I_WA_ + I_WM_ + I_WO_ + I_PW_ + I_WQK_ + I_WV_;
          for (int it = gw; it < DEPTH * PER_L; it += NGW) {
              const int l = it / PER_L; int r = it % PER_L; unsigned char* wl = ws + WS_W + (size_t)l * W_LAYER;
              if (r < I_WIN_) { const GetWin g{INP(I_WIN) + (size_t)l * D * 4136}; prep_tile(g, (bf16*)(wl + WO_WIN), 1024, 64 * (r / 136), 32 * (r % 136), wscr, lane); continue; } r -= I_WIN_;
              if (r < I_WQ_) { const GetWq g{INP(I_WQUP) + (size_t)l * 768 * 768, INP(I_QNG) + l * 768}; prep_tile(g, (bf16*)(wl + WO_WQ), 768, 64 * (r / 24), 32 * (r % 24), wscr, lane); continue; } r -= I_WQ_;
              if (r < I_WKV_) { const GetWkv g{INP(I_WKVUP) + (size_t)l * 256 * 1024, INP(I_KVNG) + l * 256}; prep_tile(g, (bf16*)(wl + WO_WKV), 256, 64 * (r / 32), 32 * (r % 32), wscr, lane); continue; } r -= I_WKV_;
              if (r < I_WA_) { const GetPlain g{INP(I_WBA) + (size_t)l * 512 * 1024, 1024}; prep_tile(g, (bf16*)(wl + WO_WA), 512, 64 * (r / 32), 32 * (r % 32), wscr, lane); continue; } r -= I_WA_;
              if (r < I_WM_) { const GetPlain g{INP(I_WBM) + (size_t)l * 512 * 1024, 1024}; prep_tile(g, (bf16*)(wl + WO_WM), 512, 64 * (r / 32), 32 * (r % 32), wscr, lane); continue; } r -= I_WM_;
              if (r < I_WO_) { const GetPlain g{INP(I_WOUT) + (size_t)l * 1024 * 1024, 1024}; prep_tile(g, (bf16*)(wl + WO_WO), 1024, 64 * (r / 32), 32 * (r % 32), wscr, lane); continue; } r -= I_WO_;
              if (r < I_PW_) { const GetPlain g{INP(I_PWQ) + (size_t)l * 1024 * 1024, 1024}; prep_tile(g, (bf16*)(wl + WO_PWQ), 1024, 64 * (r / 32), 32 * (r % 32), wscr, lane); continue; } r -= I_PW_;
              if (r < I_WQK_) { const GetWqk g{INP(I_WQM) + (size_t)l * 65536, INP(I_WKM) + (size_t)l * 65536}; prep_tile(g, (bf16*)(wl + WO_WQK), 512, 64 * (r / 32), 32 * (r % 32), wscr, lane); continue; } r -= I_WQK_;
              { const GetWv g{INP(I_WVM) + (size_t)l * 65536}; prep_tile(g, (bf16*)(wl + WO_WV), 512, 64 * (r / 16), 32 * (r % 16), wscr, lane); }
          } }
    }
    SEAM(0);

    layer_phases<0>(lds, MISC, lo, hi);
    layer_phases<1>(lds, MISC, lo, hi);
    if (IN(N_PHASES - 1)) { PH_BEGIN(0); rowpass_final(WSP(float, WS_X), INP(I_FG), (float*)getp(lds, 29), gw, NGW, lane); }
#undef IN
#undef SEAM
}

extern "C" void kernel_launch(void* const* d_in, const int* in_sizes, int n_in, void* d_out, int out_size, void* d_ws, size_t ws_size, hipStream_t stream) {
    static int grid = 0;
    if (grid == 0) {
        if (n_in != N_INPUTS || in_sizes[0] != T * D || out_size != T * D || ws_size < WS_END) {
            fprintf(stderr, "kernel_launch: unexpected shapes: n_in %d in0 %d out %d ws %zu (need %zu); nothing launched\n", n_in, n_in > 0 ? in_sizes[0] : -1, out_size, ws_size, (size_t)WS_END); grid = -1; return; }
        int dev = 0, cus = 0, per_cu = 0;
        if (hipGetDevice(&dev) != hipSuccess || hipDeviceGetAttribute(&cus, hipDeviceAttributeMultiprocessorCount, dev) != hipSuccess) { fprintf(stderr, "kernel_launch: device query failed\n"); grid = -1; return; }
        if (hipFuncSetAttribute((const void*)fwd, hipFuncAttributeMaxDynamicSharedMemorySize, LDS_BYTES) != hipSuccess) { fprintf(stderr, "kernel_launch: hipFuncSetAttribute failed\n"); grid = -1; return; }
        if (hipOccupancyMaxActiveBlocksPerMultiprocessor(&per_cu, (const void*)fwd, NTHREADS, LDS_BYTES) != hipSuccess || per_cu < 1)
            fprintf(stderr, "kernel_launch: note: occupancy query reports %d workgroups per CU\n", per_cu);
        (void)hipGetLastError();
        grid = cus;
    }
    if (grid < 0) return;
    if (hipMemsetAsync((char*)d_ws + WS_CTL, 0, CTL_ZERO_BYTES, stream) != hipSuccess) { fprintf(stderr, "kernel_launch: memset failed\n"); return; }
    Args a{};
    for (int i = 0; i < N_INPUTS; ++i) a.in[i] = d_in[i];
    a.out = (float*)d_out; a.ws = (unsigned char*)d_ws;
#if MK_ONE_LAUNCH
    a.ph_lo = 0; a.ph_hi = N_PHASES;
    hipLaunchKernelGGL(fwd, dim3(grid), dim3(NTHREADS), LDS_BYTES, stream, a);
#else
    for (int p = 0; p < N_PHASES; ++p) { a.ph_lo = p; a.ph_hi = p + 1; hipLaunchKernelGGL(fwd, dim3(grid), dim3(NTHREADS), LDS_BYTES, stream, a); }
#endif
    const hipError_t le = hipPeekAtLastError();
    if (le != hipSuccess) fprintf(stderr, "kernel_launch: launch failed: %s\n", hipGetErrorName(le));
}
```

```cpp
#include <hip/hip_runtime.h>
#include <cstdio>
#include <cstdint>
namespace pg8 {
#define PG8_LAS __attribute__((address_space(3)))
typedef unsigned short bf16_t;
typedef short bf16x8 __attribute__((ext_vector_type(8)));
typedef float f32x4 __attribute__((ext_vector_type(4)));
typedef unsigned u32x4 __attribute__((ext_vector_type(4)));
constexpr int BM = 256, BK = 64, HALF = 128, HTB = HALF * BK * 2  , STAGE_BYTES = 8 * HTB, NXCD = 8, WGM = 8;

__host__ __device__ __forceinline__ int lds_byte(int r, int c) { const int st = (r >> 4) * 2 + (c >> 5), rr = r & 15, cc = c & 31, ob = rr * 64 + cc * 2; return st * 1024 + (ob ^ (((ob >> 9) & 1) << 5)); }
__host__ __device__ __forceinline__ void stage_rc(int b, int& R, int& C) { const int st = b / 1024, sb = b % 1024, swz = sb ^ (((sb >> 9) & 1) << 5); R = (st >> 1) * 16 + swz / 64; C = (st & 1) * 32 + (swz % 64) / 2; }
__host__ __device__ __forceinline__ int perm32(int rho) { const int n = rho >> 4, i = rho & 15; return 8 * (i >> 2) + 4 * n + (i & 3); }

struct Unit { int pm, pn; };
struct Gemm { const bf16_t* A; const bf16_t* Bt; int M, N, K; int ld = 0; };

struct StaticOrder {
    int nM, nN, nwg, G, c;
    __host__ __device__ void init(int M, int N, int G_, int c_) { nM = M / BM; nN = N / BM; nwg = nM * nN; G = G_; c = c_; }
    __host__ __device__ bool next(int i, Unit& u) const {
        const long L = (long)i * G + c; if (L >= nwg) return false;
        int wgid = (int)L; { const int q = nwg / NXCD, r = nwg % NXCD, xcd = wgid % NXCD, off = wgid / NXCD; wgid = (xcd < r ? xcd * (q + 1) : r * (q + 1) + (xcd - r) * q) + off; }
        const int nig = WGM * nN, gid = wgid / nig, fm = gid * WGM, gsz = (nM - fm) < WGM ? (nM - fm) : WGM;
        u.pm = fm + ((wgid % nig) % gsz); u.pn = (wgid % nig) / gsz; return true;
    }
    __device__ __forceinline__ void a_ready(const Unit&) const {}
    __device__ __forceinline__ void done(const Unit&) const {}
};

__device__ __forceinline__ unsigned cvt_pk_bf16(float lo, float hi) { unsigned r; asm volatile("v_cvt_pk_bf16_f32 %0, %1, %2" : "=v"(r) : "v"(lo), "v"(hi)); return r; }
typedef float f32x2 __attribute__((ext_vector_type(2)));
__device__ __forceinline__ f32x2 gelu_pk(f32x2 v) {
    const f32x2 av = __builtin_elementwise_abs(v), d = av * 0.2316418882f + 1.0f;
    f32x2 t; t.x = __builtin_amdgcn_rcpf(d.x); t.y = __builtin_amdgcn_rcpf(d.y);
    f32x2 q = t * 0.5307027145f + (-0.7265760135f); q = q * t + 0.7107068705f; q = q * t + (-0.142248368f); q = q * t + 0.127414796f; q = q * t;
    const f32x2 s = (v * v) * (-0.72134752044f);
    f32x2 e; e.x = __builtin_amdgcn_exp2f(s.x); e.y = __builtin_amdgcn_exp2f(s.y);
    const f32x2 m = v * (q * e), r = v - m;
    f32x2 o; o.x = v.x < 0.f ? m.x : r.x; o.y = v.y < 0.f ? m.y : r.y; return o;
}

template <int ACT  > struct EpiBf16 {
    static constexpr bool PERM = true, AFTER_DRAIN = false; static_assert(ACT == 0 || ACT == 1, "EpiBf16: ACT is 0 (none) or 1 (gelu_pk)");
    bf16_t* O; int ldc; const float* bias; int split_cols; size_t split_stride; float scale0;
    __device__ __forceinline__ void operator()(const f32x4 (&acc)[2][2][4][2], const Unit& u, int wr, int wc, int fr, int fq) const {
        const int row0 = u.pm * BM + wr * 64 + fr; int colt = u.pn * BM; bf16_t* base = O;
        float sc = 1.f; if (split_cols) { const int t = colt / split_cols; base += (size_t)t * split_stride; colt -= t * split_cols; if (t == 0) sc = scale0; }
        const int col0 = colt + wc * 32 + 8 * fq, bcol0 = u.pn * BM + wc * 32 + 8 * fq;
        f32x4 bv[2][2];
#pragma unroll
        for (int bj = 0; bj < 2; ++bj)
#pragma unroll
            for (int n = 0; n < 2; ++n) bv[bj][n] = bias ? *(const f32x4*)(bias + bcol0 + bj * HALF + 4 * n) : (f32x4){0.f, 0.f, 0.f, 0.f};
#pragma unroll
        for (int ai = 0; ai < 2; ++ai)
#pragma unroll
            for (int m = 0; m < 4; ++m) { bf16_t* rowp = base + (size_t)(row0 + ai * HALF + m * 16) * ldc + col0;
#pragma unroll
                for (int bj = 0; bj < 2; ++bj) { f32x4 v0 = acc[ai][bj][m][0] + bv[bj][0], v1 = acc[ai][bj][m][1] + bv[bj][1];
                    if (ACT == 1) { f32x2 a = gelu_pk((f32x2){v0[0], v0[1]}), b = gelu_pk((f32x2){v0[2], v0[3]}), c = gelu_pk((f32x2){v1[0], v1[1]}), d = gelu_pk((f32x2){v1[2], v1[3]});
                        v0 = (f32x4){a.x, a.y, b.x, b.y}; v1 = (f32x4){c.x, c.y, d.x, d.y}; }
                    v0 = v0 * sc; v1 = v1 * sc; u32x4 w; w.x = cvt_pk_bf16(v0[0], v0[1]); w.y = cvt_pk_bf16(v0[2], v0[3]); w.z = cvt_pk_bf16(v1[0], v1[1]); w.w = cvt_pk_bf16(v1[2], v1[3]);
                    *(u32x4*)(rowp + bj * HALF) = w; } }
    }
};


template <class Epi, class Sched, bool ALIGN_EPI = false, bool SP2 = false>
__device__ __forceinline__ void gemm_phase(PG8_LAS unsigned char* lds, const Gemm g, const Sched& S, const Epi& E, const int tid_in) {
    int tid_l = tid_in; asm volatile("" : "+v"(tid_l));
    const int tid = tid_l, wid = __builtin_amdgcn_readfirstlane(tid >> 6), lane = tid & 63, wr = wid >> 2, wc = wid & 3, fr = lane & 15, fq = lane >> 4;
    const int K = g.K, nt = K / BK, LD = g.ld ? g.ld : g.K;
    unsigned voffA[2], voffB[2];
#pragma unroll
    for (int i = 0; i < 2; ++i) { int R, C; stage_rc(tid * 16 + i * 8192, R, C); const int Rb = Epi::PERM ? ((R & ~31) + perm32(R & 31)) : R;
        voffA[i] = (unsigned)(R * LD + C) * 2u; voffB[i] = (unsigned)(Rb * LD + C) * 2u; }
    const size_t kstep = (size_t)(BK * 2);
    const size_t hstep = (size_t)HALF * LD * 2;
    const size_t tstep = 2 * hstep;
    const unsigned ldsw = (unsigned)wid * 1024u;
    const int aoff = lds_byte(wr * 64 + fr, fq * 8), boff = lds_byte(wc * 32 + fr, fq * 8);
#define PG8_SA(b, h) (((b) * 2 + (h)) * HTB)
#define PG8_SB(b, h) ((4 + (b) * 2 + (h)) * HTB)
#define PG8_STAGE(bufoff, gbase, voff) do { _Pragma("unroll") for (int _i = 0; _i < 2; ++_i) \
        __builtin_amdgcn_global_load_lds((const unsigned*)((const char*)(gbase) + (voff)[_i]), (PG8_LAS unsigned*)(lds + (bufoff) + ldsw + _i * 8192), 16, 0, 0); } while (0)
#define PG8_LDA(dst, b, h) do { _Pragma("unroll") for (int m = 0; m < 4; ++m) _Pragma("unroll") for (int k = 0; k < 2; ++k) dst[m][k] = *(const PG8_LAS bf16x8*)(lds + PG8_SA(b, h) + aoff + m * 2048 + k * 1024); } while (0)
#define PG8_LDB(dst, b, h) do { _Pragma("unroll") for (int n = 0; n < 2; ++n) _Pragma("unroll") for (int k = 0; k < 2; ++k) dst[n][k] = *(const PG8_LAS bf16x8*)(lds + PG8_SB(b, h) + boff + n * 2048 + k * 1024); } while (0)
#define PG8_MMA(ai, bj, At, Bt) do { __builtin_amdgcn_s_setprio(1); _Pragma("unroll") for (int m = 0; m < 4; ++m) _Pragma("unroll") for (int n = 0; n < 2; ++n) _Pragma("unroll") for (int k = 0; k < 2; ++k) \
        acc[ai][bj][m][n] = __builtin_amdgcn_mfma_f32_16x16x32_bf16(Bt[n][k], At[m][k], acc[ai][bj][m][n], 0, 0, 0); __builtin_amdgcn_s_setprio(0); } while (0)
#define PG8_WAIT_V(n) asm volatile("s_waitcnt vmcnt(" #n ")" ::: "memory")
#define PG8_WAIT_L(n) asm volatile("s_waitcnt lgkmcnt(" #n ")" ::: "memory")
#define PG8_BAR __builtin_amdgcn_s_barrier()
#define PG8_SCHED __builtin_amdgcn_sched_barrier(0)
    Unit cur, nxt; int ui = 0;
    if (!S.next(0, cur)) return;
    f32x4 acc[2][2][4][2];
#pragma unroll
    for (int a = 0; a < 2; ++a)
#pragma unroll
        for (int b = 0; b < 2; ++b)
#pragma unroll
            for (int m = 0; m < 4; ++m)
#pragma unroll
                for (int n = 0; n < 2; ++n) acc[a][b][m][n] = (f32x4){0.f, 0.f, 0.f, 0.f};
    bf16x8 At[4][2], B0[2][2], B1[2][2];
    const char* cA = (const char*)g.A + (size_t)cur.pm * tstep; const char* cB = (const char*)g.Bt + (size_t)cur.pn * tstep;
    S.a_ready(cur);
    if constexpr (SP2) {
        PG8_STAGE(PG8_SB(0, 0), cB, voffB); PG8_STAGE(PG8_SB(0, 1), cB + hstep, voffB); PG8_STAGE(PG8_SA(0, 0), cA, voffA); PG8_STAGE(PG8_SA(0, 1), cA + hstep, voffA);
        if (wr == 1) PG8_BAR;
        PG8_WAIT_V(2); PG8_BAR;
        PG8_STAGE(PG8_SB(1, 0), cB + kstep, voffB); PG8_STAGE(PG8_SA(1, 0), cA + kstep, voffA); PG8_STAGE(PG8_SB(1, 1), cB + hstep + kstep, voffB);
        PG8_WAIT_V(6); PG8_BAR;
    } else {
        PG8_STAGE(PG8_SB(0, 0), cB, voffB); PG8_STAGE(PG8_SA(0, 0), cA, voffA); PG8_STAGE(PG8_SB(0, 1), cB + hstep, voffB); PG8_STAGE(PG8_SA(0, 1), cA + hstep, voffA);
        if (wr == 1) PG8_BAR;
        PG8_WAIT_V(4); PG8_BAR;
        PG8_STAGE(PG8_SB(1, 0), cB + kstep, voffB); PG8_STAGE(PG8_SA(1, 0), cA + kstep, voffA); PG8_STAGE(PG8_SB(1, 1), cB + hstep + kstep, voffB);
        PG8_WAIT_V(6); PG8_BAR;
    }
    for (;;) {
        const bool has_next = S.next(ui + 1, nxt);
        const char* nA = has_next ? (const char*)g.A + (size_t)nxt.pm * tstep : cA; const char* nB = has_next ? (const char*)g.Bt + (size_t)nxt.pn * tstep : cB;
        for (int t = 0; t < nt; t += 2) {
            const bool last = (t == nt - 2);
            const char* a1 = cA + (size_t)(t + 1) * kstep;
            const char* a2 = last ? nA : cA + (size_t)(t + 2) * kstep; const char* b2 = last ? nB : cB + (size_t)(t + 2) * kstep;
            const char* a3 = a2 + kstep; const char* b3 = b2 + kstep;
            if (last && has_next) S.a_ready(nxt);
            if constexpr (SP2) {
            PG8_LDB(B0, 0, 0); PG8_LDB(B1, 0, 1); PG8_SCHED; PG8_LDA(At, 0, 0); PG8_STAGE(PG8_SA(1, 1), a1 + hstep, voffA);
            PG8_WAIT_V(8); PG8_WAIT_L(0); PG8_BAR; PG8_MMA(0, 0, At, B0); PG8_MMA(0, 1, At, B1); PG8_BAR; PG8_SCHED;
            PG8_LDA(At, 0, 1); PG8_STAGE(PG8_SB(0, 0), b2, voffB); PG8_STAGE(PG8_SB(0, 1), b2 + hstep, voffB); PG8_STAGE(PG8_SA(0, 0), a2, voffA);
            PG8_WAIT_V(8); PG8_WAIT_L(0); PG8_BAR; PG8_MMA(1, 0, At, B0); PG8_MMA(1, 1, At, B1); PG8_BAR; PG8_SCHED;
            PG8_LDB(B0, 1, 0); PG8_LDB(B1, 1, 1); PG8_SCHED; PG8_LDA(At, 1, 0); PG8_STAGE(PG8_SA(0, 1), a2 + hstep, voffA);
            PG8_WAIT_V(8); PG8_WAIT_L(0); PG8_BAR; PG8_MMA(0, 0, At, B0); PG8_MMA(0, 1, At, B1); PG8_BAR; PG8_SCHED;
            PG8_LDA(At, 1, 1); PG8_STAGE(PG8_SB(1, 0), b3, voffB); PG8_STAGE(PG8_SB(1, 1), b3 + hstep, voffB); PG8_STAGE(PG8_SA(1, 0), a3, voffA);
            PG8_WAIT_V(8); PG8_WAIT_L(0); PG8_BAR; PG8_MMA(1, 0, At, B0); PG8_MMA(1, 1, At, B1); PG8_BAR; PG8_SCHED;
            } else {
            PG8_LDB(B0, 0, 0); PG8_SCHED; PG8_LDA(At, 0, 0); PG8_STAGE(PG8_SA(1, 1), a1 + hstep, voffA);
            PG8_WAIT_L(8); PG8_BAR; PG8_WAIT_L(0); PG8_MMA(0, 0, At, B0); PG8_BAR; PG8_SCHED;
            PG8_LDB(B1, 0, 1); PG8_STAGE(PG8_SB(0, 0), b2, voffB);
            PG8_BAR; PG8_WAIT_L(0); PG8_MMA(0, 1, At, B1); PG8_BAR;
            PG8_LDA(At, 0, 1); PG8_STAGE(PG8_SA(0, 0), a2, voffA);
            PG8_BAR; PG8_WAIT_L(0); PG8_MMA(1, 0, At, B0); PG8_BAR; PG8_SCHED;
            PG8_STAGE(PG8_SB(0, 1), b2 + hstep, voffB);
            PG8_WAIT_V(6); PG8_BAR; PG8_MMA(1, 1, At, B1); PG8_BAR;
            PG8_LDB(B0, 1, 0); PG8_SCHED; PG8_LDA(At, 1, 0); PG8_STAGE(PG8_SA(0, 1), a2 + hstep, voffA);
            PG8_WAIT_L(8); PG8_BAR; PG8_WAIT_L(0); PG8_MMA(0, 0, At, B0); PG8_BAR; PG8_SCHED;
            PG8_LDB(B1, 1, 1); PG8_STAGE(PG8_SB(1, 0), b3, voffB);
            PG8_BAR; PG8_WAIT_L(0); PG8_MMA(0, 1, At, B1); PG8_BAR;
            PG8_LDA(At, 1, 1); PG8_STAGE(PG8_SA(1, 0), a3, voffA);
            PG8_BAR; PG8_WAIT_L(0); PG8_MMA(1, 0, At, B0); PG8_BAR; PG8_SCHED;
            PG8_STAGE(PG8_SB(1, 1), b3 + hstep, voffB);
            PG8_WAIT_V(6); PG8_BAR; PG8_MMA(1, 1, At, B1); PG8_BAR;
            }
        }
        if constexpr (ALIGN_EPI) { if (wr == 0) PG8_BAR; }
        if constexpr (!Epi::AFTER_DRAIN) { E(acc, cur, wr, wc, fr, fq); S.done(cur); }
        if (!has_next) break;
#pragma unroll
        for (int a = 0; a < 2; ++a)
#pragma unroll
            for (int b = 0; b < 2; ++b)
#pragma unroll
                for (int m = 0; m < 4; ++m)
#pragma unroll
                    for (int n = 0; n < 2; ++n) acc[a][b][m][n] = (f32x4){0.f, 0.f, 0.f, 0.f};
        cur = nxt; cA = nA; cB = nB; ++ui;
        if constexpr (ALIGN_EPI) { if (wr == 1) PG8_BAR; }
    }
    PG8_WAIT_V(0);
    if constexpr (!ALIGN_EPI) { if (wr == 0) PG8_BAR; }
    PG8_BAR;
    if constexpr (Epi::AFTER_DRAIN) { E.fused(acc, cur, wr, wc, fr, fq, lds, wid, lane); S.done(cur); }
#undef PG8_SA
#undef PG8_SB
#undef PG8_STAGE
#undef PG8_LDA
#undef PG8_LDB
#undef PG8_MMA
#undef PG8_WAIT_V
#undef PG8_WAIT_L
#undef PG8_BAR
#undef PG8_SCHED
}
}
#define GAS __attribute__((address_space(1)))
#define LAS __attribute__((address_space(3)))
typedef unsigned short bf16;
typedef unsigned v4u __attribute__((ext_vector_type(4)));
typedef float f32x4 __attribute__((ext_vector_type(4)));
typedef short bf16x8 __attribute__((ext_vector_type(8)));
typedef GAS unsigned gu32;
typedef GAS unsigned long long gu64;
#define RLX_AGENT __ATOMIC_RELAXED, __HIP_MEMORY_SCOPE_AGENT
#define LDS_WAIT() asm volatile("s_waitcnt lgkmcnt(0)" ::: "memory")
#define VM_WAIT() asm volatile("s_waitcnt vmcnt(0)" ::: "memory")
__device__ __forceinline__ unsigned long long rt() { return __builtin_amdgcn_s_memrealtime(); }
__device__ __forceinline__ unsigned f2bf(float f) { unsigned u = __builtin_bit_cast(unsigned, f); return (u + 0x7fffu + ((u >> 16) & 1u)) >> 16; }
__device__ __forceinline__ unsigned pk2(float lo, float hi) { return f2bf(lo) | (f2bf(hi) << 16); }

#define XB_TMO      128
#define XB_XCNT(j)  (256  + 64 * (j))
#define XB_XSUB(j)  (1280 + 64 * (j))
#define XB_XGEN(j)  (2304 + 64 * (j))
#define XB_TOP      3328
#define XB_TOPGEN   3392
#define XCD_BAR_WORDS 3456
#define XB_SPIN_CAP (1u << 18)

__device__ __forceinline__ unsigned xb_ld(unsigned* p)              { return __hip_atomic_load(p, __ATOMIC_RELAXED, __HIP_MEMORY_SCOPE_AGENT); }
__device__ __forceinline__ unsigned xb_add(unsigned* p, unsigned v) { return __hip_atomic_fetch_add(p, v, __ATOMIC_RELAXED, __HIP_MEMORY_SCOPE_AGENT); }
__device__ __forceinline__ unsigned xb_xcc_id() { return (unsigned)__builtin_amdgcn_s_getreg((3 << 11) | 20) & 0xFu; }
#define XB_SPIN(cond, bar) do { unsigned _sp = 0; while (cond) { __builtin_amdgcn_s_sleep(1); \
    if ((++_sp & 255u) == 0u) { if (xb_ld(&(bar)[XB_TMO])) break; if (_sp > XB_SPIN_CAP) { atomicAdd(&(bar)[XB_TMO], 1u); break; } } } } while (0)

struct XcdBarrier {
    unsigned* bar; unsigned x;
    volatile LAS unsigned* st;
};

__device__ __forceinline__ XcdBarrier xcd_barrier_post(unsigned* bar, volatile LAS unsigned* st) {
    XcdBarrier b; b.bar = bar; b.x = xb_xcc_id(); b.st = st;
    if (threadIdx.x == 0) (void)xb_add(&bar[XB_XCNT(b.x)], 1u);
    return b;
}
__device__ __forceinline__ void xcd_barrier_complete(unsigned* bar, unsigned x, unsigned& nloc, unsigned& nx) {
    const unsigned G = gridDim.x * gridDim.y * gridDim.z;
    unsigned sum, cnt, mine, sp = 0u;
    for (;;) {
        sum = 0u; cnt = 0u; mine = 0u;
#pragma unroll
        for (unsigned j = 0; j < 16; ++j) { const unsigned c = xb_ld(&bar[XB_XCNT(j)]); sum += c; cnt += (c > 0u) ? 1u : 0u; mine = (j == x) ? c : mine; }
        if (sum == G) break;
        __builtin_amdgcn_s_sleep(1);
        if ((++sp & 255u) == 0u) { if (xb_ld(&bar[XB_TMO])) break; if (sp > XB_SPIN_CAP) { atomicAdd(&bar[XB_TMO], 1u); break; } }
    }
    nloc = mine > 0u ? mine : 1u; nx = cnt > 0u ? cnt : 1u;
}

__device__ __forceinline__ void xcd_barrier(const XcdBarrier& b, const int tid_in) {
    asm volatile("s_waitcnt vmcnt(0)" ::: "memory");
    __syncthreads();
    if (tid_in == 0) {
        unsigned* bar = b.bar;
        __builtin_amdgcn_s_waitcnt(0);
        unsigned nloc = b.st[0], nx = b.st[1];
        if (nloc == 0u) { xcd_barrier_complete(bar, b.x, nloc, nx); b.st[0] = nloc; b.st[1] = nx; }
        const unsigned old = xb_add(&bar[XB_XSUB(b.x)], 1u);
        const unsigned gen = old / nloc;
        if (old + 1u == (gen + 1u) * nloc) {
            __builtin_amdgcn_fence(__ATOMIC_RELEASE, "agent");
            asm volatile("s_waitcnt vmcnt(0)" ::: "memory");
            const unsigned og = xb_add(&bar[XB_TOP], 1u);
            const unsigned tg = og / nx;
            if (og + 1u == (tg + 1u) * nx) xb_add(&bar[XB_TOPGEN], 1u);
            else XB_SPIN(xb_ld(&bar[XB_TOPGEN]) == tg, bar);
            __builtin_amdgcn_fence(__ATOMIC_ACQUIRE, "agent");
            xb_add(&bar[XB_XGEN(b.x)], 1u);
            asm volatile("s_waitcnt vmcnt(0)" ::: "memory");
        } else {
            XB_SPIN(xb_ld(&bar[XB_XGEN(b.x)]) == gen, bar);
            __builtin_amdgcn_fence(__ATOMIC_ACQUIRE, "agent");
            asm volatile("s_waitcnt vmcnt(0)" ::: "memory");
        }
    }
    __syncthreads();
}

#ifndef MK_ONE_LAUNCH
#define MK_ONE_LAUNCH 1
#endif
#ifndef PROBE_REP_MASK
#define PROBE_REP_MASK 0
#endif
#define REPS(bit) _Pragma("unroll") for (int rep_ = 0; rep_ < ((PROBE_REP_MASK >> (bit)) & 1) + 1; ++rep_)
constexpr int NWAVES = 8, NTHREADS = NWAVES * 64;
constexpr int BATCH = 8, SEQ = 2048, T = BATCH * SEQ, D = 1024, DEPTH = 2;
constexpr int NPROJ = 4352;
constexpr int N_INPUTS = 29;
constexpr int NADA = 6144;
constexpr float RMS_EPS = 1e-6f;
constexpr float QSCALE = 0.10206207261596575f * 1.4426950408889634f;
enum { I_X = 0, I_C, I_POS, I_WADA, I_BADA, I_N1G, I_WIN, I_QNG, I_WQUP, I_KVNG, I_WKVUP, I_WBA, I_CONVW, I_CONVB, I_WQM, I_WKM, I_WVM, I_BI, I_BF, I_MHG, I_MSKIP,
       I_WBM, I_WOUT, I_N2G, I_PWQ, I_PKEYS, I_PU, I_PV, I_FG };

constexpr size_t MiB = 1u << 20;
constexpr size_t WS_CTL = 0, CTL_ZERO_BYTES = 1 * MiB;
constexpr int CW_BAR = 4096;
constexpr int CW_XC = 8192;
constexpr size_t ADA_OFF = 256 * 1024;
constexpr size_t WS_COS = 1 * MiB, WS_SIN = 2 * MiB;
constexpr size_t WS_W = 3 * MiB, W_LAYER = 18 * MiB;
constexpr size_t WO_WIN = 0, WO_WQ = 8912896, WO_WKV = WO_WQ + 1179648, WO_WA = WO_WKV + 524288, WO_WM = WO_WA + 1048576, WO_WO = WO_WM + 1048576,
                 WO_PWQ = WO_WO + 2097152, WO_WQK = WO_PWQ + 2097152, WO_WV = WO_WQK + 1048576, WO_KEYB = WO_WV + 524288;
static_assert(WO_KEYB + 262144 <= W_LAYER, "weights fit");
constexpr size_t WS_X = 40 * MiB, WS_H = 104 * MiB, WS_QLAT = 136 * MiB, WS_KVLAT = 160 * MiB, WS_UM = 168 * MiB, WS_OPRE = 184 * MiB, WS_GA = 200 * MiB, WS_GM = 232 * MiB,
                 WS_SMALL = 264 * MiB, WS_RQ = 268 * MiB, WS_RKV = WS_RQ + 65536, WS_LOGI = WS_RQ + 262144, WS_LOGF = WS_RQ + 524288, WS_Q = 269 * MiB, WS_K = 293 * MiB,
                 WS_V = 317 * MiB, WS_CONV = 333 * MiB, WS_QKM = 349 * MiB, WS_VM = 381 * MiB, WS_AO = 397 * MiB, WS_OUTM = 413 * MiB, WS_U8 = 429 * MiB, WS_V8 = 445 * MiB, WS_END = 493 * MiB;
constexpr size_t WS_H8 = 493 * MiB, WS_XS = WS_RQ + 131072, WS_USC = WS_RQ + 786432;
constexpr size_t WS_END2 = 509 * MiB;
constexpr size_t WS_IDX = WS_UM, WS_GATE = WS_UM + 8 * MiB, WS_ACT = WS_OPRE;
constexpr size_t WS_SMALLP = WS_OUTM;
constexpr size_t WS_PQ = WS_QLAT, WS_MERGED = WS_QLAT;

constexpr int RING_OFF = 0, RING_BYTES = 131072;
constexpr int LDSCTL_OFF = RING_BYTES, MISC_OFF = LDSCTL_OFF + 320;
constexpr int LDS_BYTES = 147456;

typedef float f32x2v __attribute__((ext_vector_type(2)));
typedef unsigned u32x2 __attribute__((ext_vector_type(2)));

__device__ __forceinline__ float wave_sum(float v) {
#pragma unroll
    for (int o = 1; o < 64; o <<= 1) v += __shfl_xor(v, o);
    return v;
}
__device__ __forceinline__ float bflo(unsigned u) { return __uint_as_float(u << 16); }
__device__ __forceinline__ float bfhi(unsigned u) { return __uint_as_float(u & 0xffff0000u); }
__device__ __forceinline__ float sigm(float x) { return 1.f / (1.f + __expf(-x)); }
__device__ __forceinline__ float dot4(f32x4 a, f32x4 b) { return (a.x * b.x + a.y * b.y) + (a.z * b.z + a.w * b.w); }
__device__ __forceinline__ float gelu_erf(float x) { return 0.5f * x * (1.f + erff(x * 0.70710678118654752f)); }

struct EpiProj {
    static constexpr bool PERM = true, AFTER_DRAIN = false;
    bf16 *qlat, *kvlat, *um, *opre, *ga, *gm; float* small;
    __device__ __forceinline__ void operator()(const f32x4 (&acc)[2][2][4][2], const pg8::Unit& u, int wr, int wc, int fr, int fq) const {
        const int pn = u.pn; bf16* dst; int ld, cb; int mode = 0;
        if (pn < 3) { dst = qlat; ld = 768; cb = pn * 256; }
        else if (pn == 3) { dst = kvlat; ld = 256; cb = 0; }
        else if (pn < 6) { dst = um; ld = 512; cb = (pn - 4) * 256; }
        else if (pn < 8) { dst = opre; ld = 512; cb = (pn - 6) * 256; }
        else if (pn < 12) { dst = ga; ld = 1024; cb = (pn - 8) * 256; mode = 1; }
        else if (pn < 16) { dst = gm; ld = 1024; cb = (pn - 12) * 256; mode = 1; }
        else { dst = nullptr; ld = 0; cb = 0; mode = 2; }
        const int row0 = u.pm * 256 + wr * 64 + fr;
        if (mode == 2) {
            if (wc < 2) {
#pragma unroll
                for (int ai = 0; ai < 2; ++ai)
#pragma unroll
                    for (int m = 0; m < 4; ++m) { float* p = small + (size_t)(row0 + ai * 128 + m * 16) * 64 + wc * 32 + 8 * fq;
                        *(f32x4*)p = acc[ai][0][m][0]; *(f32x4*)(p + 4) = acc[ai][0][m][1]; }
            }
        } else {
#pragma unroll
            for (int ai = 0; ai < 2; ++ai)
#pragma unroll
                for (int m = 0; m < 4; ++m) { bf16* rowp = dst + (size_t)(row0 + ai * 128 + m * 16) * ld + cb + wc * 32 + 8 * fq;
#pragma unroll
                    for (int bj = 0; bj < 2; ++bj) { f32x4 v0 = acc[ai][bj][m][0], v1 = acc[ai][bj][m][1];
                        if (mode == 1) { v0 = (f32x4){sigm(v0[0]), sigm(v0[1]), sigm(v0[2]), sigm(v0[3])}; v1 = (f32x4){sigm(v1[0]), sigm(v1[1]), sigm(v1[2]), sigm(v1[3])}; }
                        v4u w; w.x = pk2(v0[0], v0[1]); w.y = pk2(v0[2], v0[3]); w.z = pk2(v1[0], v1[1]); w.w = pk2(v1[2], v1[3]);
                        *(v4u*)(rowp + bj * 128) = w; } }
        }
    }
};
struct EpiSmallPart {
    static constexpr bool PERM = true, AFTER_DRAIN = false;
    float* part;
    __device__ __forceinline__ void operator()(const f32x4 (&acc)[2][2][4][2], const pg8::Unit& u, int wr, int wc, int fr, int fq) const {
        if (wc >= 2) return;
        const int row0 = u.pm * 256 + wr * 64 + fr;
#pragma unroll
        for (int ai = 0; ai < 2; ++ai)
#pragma unroll
            for (int m = 0; m < 4; ++m) { float* p = part + (size_t)(row0 + ai * 128 + m * 16) * 64 + wc * 32 + 8 * fq;
                *(f32x4*)p = acc[ai][0][m][0]; *(f32x4*)(p + 4) = acc[ai][0][m][1]; }
    }
};
struct EpiQ {
    static constexpr bool PERM = true, AFTER_DRAIN = false;
    bf16* Q; const float* rq; const float* cosT; const float* sinT;
    __device__ __forceinline__ void operator()(const f32x4 (&acc)[2][2][4][2], const pg8::Unit& u, int wr, int wc, int fr, int fq) const {
        const int row0 = u.pm * 256 + wr * 64 + fr;
        int c0b[2], d0b[2];
#pragma unroll
        for (int bj = 0; bj < 2; ++bj) { c0b[bj] = u.pn * 256 + bj * 128 + wc * 32 + 8 * fq; d0b[bj] = c0b[bj] % 96; }
#pragma unroll
        for (int ai = 0; ai < 2; ++ai) {
            float rr[4]; f32x4 csv[4][2], snv[4][2];
#pragma unroll
            for (int m = 0; m < 4; ++m) { const int row = row0 + ai * 128 + m * 16; rr[m] = rq[row];
#pragma unroll
                for (int bj = 0; bj < 2; ++bj) { csv[m][bj] = (f32x4){1.f, 1.f, 1.f, 1.f}; snv[m][bj] = (f32x4){0.f, 0.f, 0.f, 0.f};
                    if (d0b[bj] >= 64) { const int j0 = (d0b[bj] - 64) >> 1; csv[m][bj] = *(const f32x4*)(cosT + (size_t)row * 16 + j0); snv[m][bj] = *(const f32x4*)(sinT + (size_t)row * 16 + j0); } } }
            __builtin_amdgcn_sched_barrier(0);
#pragma unroll
            for (int m = 0; m < 4; ++m) { const int row = row0 + ai * 128 + m * 16; const float r = rr[m];
#pragma unroll
                for (int bj = 0; bj < 2; ++bj) {
                    f32x4 v0 = acc[ai][bj][m][0] * r, v1 = acc[ai][bj][m][1] * r;
                    if (d0b[bj] >= 64) { const f32x4 cs = csv[m][bj], sn = snv[m][bj]; const f32x4 a0 = v0, a1 = v1;
                        v0[0] = a0[0] * cs[0] - a0[1] * sn[0]; v0[1] = a0[1] * cs[0] + a0[0] * sn[0];
                        v0[2] = a0[2] * cs[1] - a0[3] * sn[1]; v0[3] = a0[3] * cs[1] + a0[2] * sn[1];
                        v1[0] = a1[0] * cs[2] - a1[1] * sn[2]; v1[1] = a1[1] * cs[2] + a1[0] * sn[2];
                        v1[2] = a1[2] * cs[3] - a1[3] * sn[3]; v1[3] = a1[3] * cs[3] + a1[2] * sn[3]; }
                    v4u w; w.x = pk2(v0[0], v0[1]); w.y = pk2(v0[2], v0[3]); w.z = pk2(v1[0], v1[1]); w.w = pk2(v1[2], v1[3]);
                    *(v4u*)(Q + (size_t)row * 768 + c0b[bj]) = w; } }
        }
    }
};
struct EpiKV {
    static constexpr bool PERM = true, AFTER_DRAIN = false;
    bf16* K; bf16* V; const float* rkv;
    __device__ __forceinline__ void operator()(const f32x4 (&acc)[2][2][4][2], const pg8::Unit& u, int wr, int wc, int fr, int fq) const {
        const int row0 = u.pm * 256 + wr * 64 + fr;
        float rr[2][4];
#pragma unroll
        for (int ai = 0; ai < 2; ++ai)
#pragma unroll
            for (int m = 0; m < 4; ++m) rr[ai][m] = rkv[row0 + ai * 128 + m * 16];
#pragma unroll
        for (int ai = 0; ai < 2; ++ai)
#pragma unroll
            for (int m = 0; m < 4; ++m) { const int row = row0 + ai * 128 + m * 16; const float r = rr[ai][m];
#pragma unroll
                for (int bj = 0; bj < 2; ++bj) { const int c0 = u.pn * 256 + bj * 128 + wc * 32 + 8 * fq;
                    const f32x4 v0 = acc[ai][bj][m][0] * r, v1 = acc[ai][bj][m][1] * r;
                    bf16* dst = (c0 < 512) ? (K + (size_t)row * 768 + 96 * (c0 >> 6) + (c0 & 63)) : (V + (size_t)row * 512 + (c0 - 512));
                    v4u w; w.x = pk2(v0[0], v0[1]); w.y = pk2(v0[2], v0[3]); w.z = pk2(v1[0], v1[1]); w.w = pk2(v1[2], v1[3]);
                    *(v4u*)dst = w; } }
    }
};
struct EpiMerge {
    static constexpr bool PERM = true, AFTER_DRAIN = false;
    bf16* Mg; const bf16* gate; int first;
    __device__ __forceinline__ void operator()(const f32x4 (&acc)[2][2][4][2], const pg8::Unit& u, int wr, int wc, int fr, int fq) const {
        const int row0 = u.pm * 256 + wr * 64 + fr, cbase = u.pn * 256 + wc * 32 + 8 * fq;
#pragma unroll
        for (int ai = 0; ai < 2; ++ai) {
            v4u gq[4][2], oq[4][2];
#pragma unroll
            for (int m = 0; m < 4; ++m)
#pragma unroll
                for (int bj = 0; bj < 2; ++bj) { const size_t off = (size_t)(row0 + ai * 128 + m * 16) * 1024 + cbase + bj * 128;
                    gq[m][bj] = *(const v4u*)(gate + off); oq[m][bj] = first ? (v4u){0u, 0u, 0u, 0u} : *(const v4u*)(Mg + off); }
            __builtin_amdgcn_sched_barrier(0);
#pragma unroll
            for (int m = 0; m < 4; ++m)
#pragma unroll
                for (int bj = 0; bj < 2; ++bj) { const size_t off = (size_t)(row0 + ai * 128 + m * 16) * 1024 + cbase + bj * 128;
                    const v4u g = gq[m][bj], o = oq[m][bj];
                    f32x4 v0 = acc[ai][bj][m][0], v1 = acc[ai][bj][m][1];
                    v0[0] = v0[0] * bflo(g.x) + bflo(o.x); v0[1] = v0[1] * bfhi(g.x) + bfhi(o.x); v0[2] = v0[2] * bflo(g.y) + bflo(o.y); v0[3] = v0[3] * bfhi(g.y) + bfhi(o.y);
                    v1[0] = v1[0] * bflo(g.z) + bflo(o.z); v1[1] = v1[1] * bfhi(g.z) + bfhi(o.z); v1[2] = v1[2] * bflo(g.w) + bflo(o.w); v1[3] = v1[3] * bfhi(g.w) + bfhi(o.w);
                    v4u w; w.x = pk2(v0[0], v0[1]); w.y = pk2(v0[2], v0[3]); w.z = pk2(v1[0], v1[1]); w.w = pk2(v1[2], v1[3]);
                    *(v4u*)(Mg + off) = w; }
        }
    }
};
struct EpiResid {
    static constexpr bool PERM = true, AFTER_DRAIN = false;
    const float* xin; float* xout; const float* gate;
    __device__ __forceinline__ void operator()(const f32x4 (&acc)[2][2][4][2], const pg8::Unit& u, int wr, int wc, int fr, int fq) const {
        const int row0 = u.pm * 256 + wr * 64 + fr, b = (u.pm * 256) >> 11, cbase = u.pn * 256 + wc * 32 + 8 * fq;
        f32x4 gv[2][2];
#pragma unroll
        for (int bj = 0; bj < 2; ++bj) { const float* gp = gate + (size_t)b * NADA + cbase + bj * 128; gv[bj][0] = *(const f32x4*)gp; gv[bj][1] = *(const f32x4*)(gp + 4); }
#pragma unroll
        for (int ai = 0; ai < 2; ++ai) {
            f32x4 xv[4][2][2];
#pragma unroll
            for (int m = 0; m < 4; ++m)
#pragma unroll
                for (int bj = 0; bj < 2; ++bj) { const size_t off = (size_t)(row0 + ai * 128 + m * 16) * 1024 + cbase + bj * 128; xv[m][bj][0] = *(const f32x4*)(xin + off); xv[m][bj][1] = *(const f32x4*)(xin + off + 4); }
            __builtin_amdgcn_sched_barrier(0);
#pragma unroll
            for (int m = 0; m < 4; ++m)
#pragma unroll
                for (int bj = 0; bj < 2; ++bj) { const size_t off = (size_t)(row0 + ai * 128 + m * 16) * 1024 + cbase + bj * 128;
                    *(f32x4*)(xout + off) = xv[m][bj][0] + gv[bj][0] * acc[ai][bj][m][0]; *(f32x4*)(xout + off + 4) = xv[m][bj][1] + gv[bj][1] * acc[ai][bj][m][1]; }
        }
    }
};

template <class Get> __device__ __forceinline__ void prep_tile(const Get& get, bf16* dst, int K, int k0, int n0, LAS float* scr, int lane) {
    float tv[32];
#pragma unroll
    for (int i = 0; i < 32; ++i) tv[i] = get(k0 + 2 * i + (lane >> 5), n0 + (lane & 31));
#pragma unroll
    for (int i = 0; i < 32; ++i) { const int kk = 2 * i + (lane >> 5); scr[kk * 33 + (lane & 31)] = tv[i]; }
    LDS_WAIT(); asm volatile("" ::: "memory");
    const int c = lane & 7;
#pragma unroll
    for (int j = 0; j < 4; ++j) { const int n = (lane >> 3) + 8 * j; const LAS float* s = scr + (8 * c) * 33 + n;
        v4u o; o.x = pk2(s[0 * 33], s[1 * 33]); o.y = pk2(s[2 * 33], s[3 * 33]); o.z = pk2(s[4 * 33], s[5 * 33]); o.w = pk2(s[6 * 33], s[7 * 33]);
        *(GAS v4u*)(dst + (size_t)(n0 + n) * K + k0 + 8 * c) = o; }
    LDS_WAIT(); asm volatile("" ::: "memory");
}
struct GetWin { const float* w; __device__ __forceinline__ float operator()(int k, int n) const {
    int sc; if (n < 1024) sc = n; else if (n < 2048) sc = n + 32; else if (n < 4096) sc = n + 40; else if (n < 4128) sc = n - 3072; else if (n < 4136) sc = n - 2048; else sc = -1;
    return sc < 0 ? 0.f : w[(size_t)k * 4136 + sc]; } };
struct GetWq { const float* w; const float* g; __device__ __forceinline__ float operator()(int k, int n) const {
    const int h = n / 96, dd = n % 96; const int e = dd - 64; const int sd = dd < 64 ? dd : 64 + (e >> 1) + 16 * (e & 1);
    return w[(size_t)k * 768 + h * 96 + sd] * g[k] * QSCALE; } };
struct GetWkv { const float* w; const float* g; __device__ __forceinline__ float operator()(int k, int n) const {
    const int nn = n & 511, h = nn >> 6, c = nn & 63; const int sc = h * 128 + c + ((n >= 512) ? 64 : 0);
    return w[(size_t)k * 1024 + sc] * g[k]; } };
struct GetPlain { const float* w; int N; __device__ __forceinline__ float operator()(int k, int n) const { return w[(size_t)k * N + n]; } };
struct GetWqk { const float* wq; const float* wk; __device__ __forceinline__ float operator()(int k, int n) const {
    const int part = n >> 9, nn = n & 511, h = nn >> 7, e = nn & 127, kh = k >> 7, d = k & 127;
    if (kh != h) return 0.f;
    const size_t off = ((size_t)h * 128 + d) * 128 + e;
    return part ? wk[off] * 0.08838834764831845f : wq[off]; } };
struct GetWv { const float* wv; __device__ __forceinline__ float operator()(int k, int n) const {
    const int h = n >> 7, e = n & 127, kh = k >> 7, d = k & 127;
    return (kh != h) ? 0.f : wv[((size_t)h * 128 + d) * 128 + e]; } };

__device__ const float INV_FREQ[16] = { 1.0f, 0.5623413251903491f, 0.31622776601683794f, 0.1778279410038923f, 0.1f, 0.05623413251903491f, 0.031622776601683794f, 0.01778279410038923f,
    0.01f, 0.005623413251903491f, 0.0031622776601683794f, 0.001778279410038923f, 0.001f, 0.0005623413251903491f, 0.00031622776601683794f, 0.0001778279410038923f };

__device__ __forceinline__ void rowpass_norm_mod(const float* xin, const float* g, const float* ada_shift, const float* ada_scale, bf16* hout, int gw, int NGW, int lane, unsigned char* h8 = nullptr, float* xs = nullptr) {
    f32x4 vn[4];
    if (gw < T) {
#pragma unroll
        for (int j = 0; j < 4; ++j) vn[j] = ((const f32x4*)(xin + (size_t)gw * D) + lane)[64 * j]; }
    for (int t = gw; t < T; t += NGW) {
        const int b = t >> 11;
        f32x4 v[4]; float s = 0.f;
#pragma unroll
        for (int j = 0; j < 4; ++j) { v[j] = vn[j]; s += dot4(v[j], v[j]); }
        if (t + NGW < T) {
#pragma unroll
            for (int j = 0; j < 4; ++j) vn[j] = ((const f32x4*)(xin + (size_t)(t + NGW) * D) + lane)[64 * j]; }
        const float r = rsqrtf(wave_sum(s) * (1.f / D) + RMS_EPS);
        unsigned long long* o8 = (unsigned long long*)(hout + (size_t)t * D) + lane;
        f32x4 ov[4]; float am = 0.f;
#pragma unroll
        for (int j = 0; j < 4; ++j) { const int col = 4 * lane + 256 * j;
            const f32x4 gg = *(const f32x4*)(g + col), sc = *(const f32x4*)(ada_scale + (size_t)b * NADA + col), sh = *(const f32x4*)(ada_shift + (size_t)b * NADA + col);
            const f32x4 o = v[j] * r * gg * (sc + 1.f) + sh; ov[j] = o;
            am = fmaxf(fmaxf(am, fmaxf(fabsf(o.x), fabsf(o.y))), fmaxf(fabsf(o.z), fabsf(o.w)));
            o8[64 * j] = (unsigned long long)pk2(o.x, o.y) | ((unsigned long long)pk2(o.z, o.w) << 32); }
        if (h8) {
#pragma unroll
            for (int o = 1; o < 64; o <<= 1) am = fmaxf(am, __shfl_xor(am, o));
            const float inv = am > 0.f ? 127.f / am : 0.f;
#pragma unroll
            for (int j = 0; j < 4; ++j) { const int q0 = (int)rintf(ov[j].x * inv), q1 = (int)rintf(ov[j].y * inv), q2 = (int)rintf(ov[j].z * inv), q3 = (int)rintf(ov[j].w * inv);
                ((unsigned*)(h8 + (size_t)t * D))[lane + 64 * j] = (unsigned)(q0 & 255) | ((unsigned)(q1 & 255) << 8) | ((unsigned)(q2 & 255) << 16) | ((unsigned)(q3 & 255) << 24); }
            if (lane == 0) xs[t] = am * (1.f / 127.f);
        }
    }
}
__device__ __forceinline__ void rowpass_final(const float* xin, const float* g, float* out, int gw, int NGW, int lane) {
    f32x4 vn[4];
    if (gw < T) {
#pragma unroll
        for (int j = 0; j < 4; ++j) vn[j] = ((const f32x4*)(xin + (size_t)gw * D) + lane)[64 * j]; }
    for (int t = gw; t < T; t += NGW) {
        f32x4 v[4]; float s = 0.f;
#pragma unroll
        for (int j = 0; j < 4; ++j) { v[j] = vn[j]; s += dot4(v[j], v[j]); }
        if (t + NGW < T) {
#pragma unroll
            for (int j = 0; j < 4; ++j) vn[j] = ((const f32x4*)(xin + (size_t)(t + NGW) * D) + lane)[64 * j]; }
        const float r = rsqrtf(wave_sum(s) * (1.f / D) + RMS_EPS);
        f32x4* o = (f32x4*)(out + (size_t)t * D) + lane;
#pragma unroll
        for (int j = 0; j < 4; ++j) { const f32x4 gg = *(const f32x4*)(g + 4 * lane + 256 * j); o[64 * j] = v[j] * r * gg; }
    }
}
__device__ __forceinline__ void rowpass_mid(const bf16* qlat, const bf16* kvlat, const float* small, const float* smallp, const float* cosT, const float* sinT, const bf16* um,
                                            const float* conv_w, const float* conv_b, const float* b_i, const float* b_f,
                                            float* RQ, float* RKV, bf16* K, float* LOGI, float* LOGF, bf16* CONV, int gw, int NGW, int lane) {
    const int c0 = 8 * lane;
    f32x4 cw[4][2], cb[2];
#pragma unroll
    for (int j = 0; j < 4; ++j) { cw[j][0] = *(const f32x4*)(conv_w + j * 512 + c0); cw[j][1] = *(const f32x4*)(conv_w + j * 512 + c0 + 4); }
    cb[0] = *(const f32x4*)(conv_b + c0); cb[1] = *(const f32x4*)(conv_b + c0 + 4);
    const float bsel = (lane >= 32 && lane < 36) ? b_i[lane - 32] : (lane >= 36 && lane < 40) ? b_f[lane - 36] : 0.f;
    for (int tb = gw * 4; tb < T; tb += NGW * 4) {
        const int pos0 = tb & (SEQ - 1);
        u32x2 qv[4][3], kvv[4]; v4u uw[7]; float sv[4], cs[4], sn[4];
#pragma unroll
        for (int i = 0; i < 4; ++i) { const int t = tb + i; const u32x2* p = (const u32x2*)(qlat + (size_t)t * 768);
#pragma unroll
            for (int j = 0; j < 3; ++j) qv[i][j] = p[lane + 64 * j];
            kvv[i] = ((const u32x2*)(kvlat + (size_t)t * 256))[lane];
            sv[i] = 0.f;
            if (lane < 40) sv[i] = smallp ? ((smallp[(size_t)t * 64 + lane] + smallp[(size_t)(T + t) * 64 + lane]) + (smallp[(size_t)(2 * T + t) * 64 + lane] + smallp[(size_t)(3 * T + t) * 64 + lane]))
                                         : small[(size_t)t * 64 + lane];
            cs[i] = 0.f; sn[i] = 0.f; if (lane < 16) { cs[i] = cosT[(size_t)t * 16 + lane]; sn[i] = sinT[(size_t)t * 16 + lane]; } }
#pragma unroll
        for (int j = 0; j < 7; ++j) { uw[j] = (v4u){0u, 0u, 0u, 0u}; if (pos0 - 3 + j >= 0) uw[j] = *(const v4u*)(um + (size_t)(tb - 3 + j) * 512 + c0); }
#pragma unroll
        for (int i = 0; i < 4; ++i) { const int t = tb + i;
            float s = 0.f;
#pragma unroll
            for (int j = 0; j < 3; ++j) { const u32x2 w = qv[i][j]; const float a = bflo(w.x), b2 = bfhi(w.x), c = bflo(w.y), d = bfhi(w.y); s += (a * a + b2 * b2) + (c * c + d * d); }
            const float rq = rsqrtf(wave_sum(s) * (1.f / 768.f) + RMS_EPS);
            const u32x2 w = kvv[i]; const float a = bflo(w.x), b2 = bfhi(w.x), c = bflo(w.y), d = bfhi(w.y);
            const float rkv = rsqrtf(wave_sum((a * a + b2 * b2) + (c * c + d * d)) * (1.f / 256.f) + RMS_EPS);
            if (lane == 0) { RQ[t] = rq; RKV[t] = rkv; }
            const float x2 = __shfl(sv[i], (lane + 16) & 63);
            if (lane < 16) { const float x1 = sv[i]; const unsigned pk = pk2(x1 * cs[i] - x2 * sn[i], x2 * cs[i] + x1 * sn[i]);
#pragma unroll
                for (int h = 0; h < 8; ++h) ((unsigned*)(K + (size_t)t * 768 + 96 * h + 64))[lane] = pk; }
            else if (lane >= 32 && lane < 36) LOGI[(size_t)t * 4 + (lane - 32)] = sv[i] + bsel;
            else if (lane >= 36 && lane < 40) { const float x = sv[i] + bsel; LOGF[(size_t)t * 4 + (lane - 36)] = fminf(x, 0.f) - log1pf(expf(-fabsf(x))); }
            float acc[8];
            acc[0] = cb[0][0]; acc[1] = cb[0][1]; acc[2] = cb[0][2]; acc[3] = cb[0][3]; acc[4] = cb[1][0]; acc[5] = cb[1][1]; acc[6] = cb[1][2]; acc[7] = cb[1][3];
#pragma unroll
            for (int j = 0; j < 4; ++j) { const v4u u4 = uw[i + j];
                acc[0] += cw[j][0][0] * bflo(u4.x); acc[1] += cw[j][0][1] * bfhi(u4.x); acc[2] += cw[j][0][2] * bflo(u4.y); acc[3] += cw[j][0][3] * bfhi(u4.y);
                acc[4] += cw[j][1][0] * bflo(u4.z); acc[5] += cw[j][1][1] * bfhi(u4.z); acc[6] += cw[j][1][2] * bflo(u4.w); acc[7] += cw[j][1][3] * bfhi(u4.w); }
#pragma unroll
            for (int q = 0; q < 8; ++q) acc[q] = acc[q] * sigm(acc[q]);
            v4u o; o.x = pk2(acc[0], acc[1]); o.y = pk2(acc[2], acc[3]); o.z = pk2(acc[4], acc[5]); o.w = pk2(acc[6], acc[7]);
            *(v4u*)(CONV + (size_t)t * 512 + c0) = o; }
    }
}

typedef float f32x16 __attribute__((ext_vector_type(16)));
typedef short s16x4 __attribute__((ext_vector_type(4)));
typedef short v4i16_t __attribute__((ext_vector_type(4)));
typedef float f32x2_t __attribute__((ext_vector_type(2))); typedef __bf16 bf16x2_t __attribute__((ext_vector_type(2)));
__device__ __forceinline__ unsigned cvtpk(float lo, float hi) { f32x2_t v = {lo, hi}; bf16x2_t b = __builtin_convertvector(v, bf16x2_t); return __builtin_bit_cast(unsigned, b); }
__device__ __forceinline__ s16x4 vtr(const LAS unsigned char* p) { return __builtin_bit_cast(s16x4, __builtin_amdgcn_ds_read_tr16_b64_v4i16((LAS v4i16_t*)p)); }
__device__ __forceinline__ bf16x8 pack8(float a0, float a1, float a2, float a3, float a4, float a5, float a6, float a7) {
    v4u p; p.x = cvtpk(a0, a1); p.y = cvtpk(a2, a3); p.z = cvtpk(a4, a5); p.w = cvtpk(a6, a7); return __builtin_bit_cast(bf16x8, p); }
#define MFMA32(a, b, c) __builtin_amdgcn_mfma_f32_32x32x16_bf16((a), (b), (c), 0, 0, 0)
constexpr int AT_KB = 12288, AT_VB = 8192;
__device__ __forceinline__ void attn_mfma(const bf16* Q, const bf16* K, const bf16* V, bf16* AO, LAS unsigned char* lds, int bx, int G, int tid) {
    const int lane = tid & 63, wave = __builtin_amdgcn_readfirstlane(tid >> 6), r = lane & 31, hh = lane >> 5;
    const int i16 = lane & 15, q4 = i16 >> 2, p4 = i16 & 3, blk = (lane >> 4) & 1;
    const int vboff = (4 * hh + q4) * 64 + 32 * blk + 8 * p4;
    const int kr0 = tid / 12, kc0 = tid % 12, kr1 = (tid + 512) / 12, kc1 = (tid + 512) % 12, vr = tid >> 3, vc = tid & 7;
    const int klds0 = (kc0 >> 1) * 2048 + (kc0 & 1) * 1024 + kr0 * 16, klds1 = (kc1 >> 1) * 2048 + (kc1 & 1) * 1024 + kr1 * 16;
    const int vlds = (vc >> 2) * 4096 + (vr >> 4) * 1024 + ((vr >> 3) & 1) * 512 + (vr & 7) * 64 + (vc & 3) * 16;
    for (int pu = bx; pu < 256; pu += G) {
        const int bh = pu >> 2, b = bh >> 3, h = bh & 7;
        const bf16* kg = K + ((size_t)b * SEQ) * 768 + h * 96; const bf16* vg = V + ((size_t)b * SEQ) * 512 + h * 64;
        for (int half = 0; half < 2; ++half) {
            const int qb = half == 0 ? 7 - (pu & 3) : (pu & 3);
            const int q0w = qb * 256 + wave * 32, nkt = 4 * (qb + 1), kmax = (q0w + 31) >> 6;
            bf16x8 qf[6];
            { const bf16* qrow = Q + ((size_t)b * SEQ + q0w + r) * 768 + h * 96 + 8 * hh;
#pragma unroll
              for (int s = 0; s < 6; ++s) qf[s] = *(const bf16x8*)(qrow + 16 * s); }
            f32x16 o0, o1;
#pragma unroll
            for (int i = 0; i < 16; ++i) { o0[i] = 0.f; o1[i] = 0.f; }
            float m = 0.f, l = 0.f; f32x16 negm;
#pragma unroll
            for (int i = 0; i < 16; ++i) negm[i] = 0.f;
            v4u ka = *(const v4u*)(kg + (size_t)kr0 * 768 + kc0 * 8), kb2 = (v4u){0u, 0u, 0u, 0u}, va = *(const v4u*)(vg + (size_t)vr * 512 + vc * 8);
            if (tid < 256) kb2 = *(const v4u*)(kg + (size_t)kr1 * 768 + kc1 * 8);
            __syncthreads();
            *(LAS v4u*)(lds + klds0) = ka; if (tid < 256) *(LAS v4u*)(lds + klds1) = kb2; *(LAS v4u*)(lds + 2 * AT_KB + vlds) = va;
            __syncthreads();
            for (int kt = 0; kt < nkt; ++kt) {
                const int buf = kt & 1;
                if (kt + 1 < nkt) { const size_t k1 = (size_t)(kt + 1) * 64;
                    ka = *(const v4u*)(kg + (k1 + kr0) * 768 + kc0 * 8); if (tid < 256) kb2 = *(const v4u*)(kg + (k1 + kr1) * 768 + kc1 * 8); va = *(const v4u*)(vg + (k1 + vr) * 512 + vc * 8); }
                if (kt <= kmax) {
                    const LAS unsigned char* kb_ = lds + buf * AT_KB + hh * 1024 + r * 16; const LAS unsigned char* vb_ = lds + 2 * AT_KB + buf * AT_VB + vboff;
                    f32x16 s0, s1;
                    { bf16x8 kf0[6], kf1[6];
#pragma unroll
                      for (int s = 0; s < 6; ++s) { kf0[s] = *(const LAS bf16x8*)(kb_ + s * 2048); kf1[s] = *(const LAS bf16x8*)(kb_ + s * 2048 + 512); }
                      __builtin_amdgcn_sched_barrier(0);
                      s0 = MFMA32(kf0[0], qf[0], negm); s1 = MFMA32(kf1[0], qf[0], negm);
#pragma unroll
                      for (int s = 1; s < 6; ++s) { s0 = MFMA32(kf0[s], qf[s], s0); s1 = MFMA32(kf1[s], qf[s], s1); } }
                    if (kt * 64 + 63 > q0w) { const int qq = q0w + r - kt * 64;
#pragma unroll
                        for (int i = 0; i < 16; ++i) { const int key = (i & 3) + 8 * (i >> 2) + 4 * hh; if (key > qq) s0[i] = -INFINITY; if (key + 32 > qq) s1[i] = -INFINITY; } }
                    float mx = fmaxf(fmaxf(s0[0], s1[0]), fmaxf(s0[1], s1[1]));
#pragma unroll
                    for (int i = 2; i < 16; i += 2) mx = fmaxf(fmaxf(mx, fmaxf(s0[i], s1[i])), fmaxf(s0[i + 1], s1[i + 1]));
                    mx = fmaxf(mx, __shfl_xor(mx, 32));
                    if (kt == 0 || __builtin_amdgcn_ballot_w64(mx > 8.f) != 0ull) {
                        const float d = (kt == 0) ? mx : fmaxf(mx, 0.f), corr = (kt == 0) ? 0.f : __builtin_amdgcn_exp2f(-d);
                        m = (kt == 0) ? mx : m + d; l *= corr;
#pragma unroll
                        for (int i = 0; i < 16; ++i) { o0[i] *= corr; o1[i] *= corr; s0[i] -= d; s1[i] -= d; negm[i] = -m; } }
                    float ps = 0.f;
#pragma unroll
                    for (int i = 0; i < 16; ++i) { s0[i] = __builtin_amdgcn_exp2f(s0[i]); s1[i] = __builtin_amdgcn_exp2f(s1[i]); ps += s0[i] + s1[i]; }
                    l += ps;
                    bf16x8 pf[4];
                    pf[0] = pack8(s0[0], s0[1], s0[2], s0[3], s0[4], s0[5], s0[6], s0[7]); pf[1] = pack8(s0[8], s0[9], s0[10], s0[11], s0[12], s0[13], s0[14], s0[15]);
                    pf[2] = pack8(s1[0], s1[1], s1[2], s1[3], s1[4], s1[5], s1[6], s1[7]); pf[3] = pack8(s1[8], s1[9], s1[10], s1[11], s1[12], s1[13], s1[14], s1[15]);
                    { s16x4 vlo[8], vhi[8];
#pragma unroll
                      for (int ks = 0; ks < 4; ++ks) { vlo[ks] = vtr(vb_ + ks * 1024); vhi[ks] = vtr(vb_ + ks * 1024 + 512); vlo[4 + ks] = vtr(vb_ + 4096 + ks * 1024); vhi[4 + ks] = vtr(vb_ + 4096 + ks * 1024 + 512); }
                      __builtin_amdgcn_sched_barrier(0);
#pragma unroll
                      for (int ks = 0; ks < 4; ++ks) {
                          const bf16x8 a0 = (bf16x8){vlo[ks][0], vlo[ks][1], vlo[ks][2], vlo[ks][3], vhi[ks][0], vhi[ks][1], vhi[ks][2], vhi[ks][3]};
                          const bf16x8 a1 = (bf16x8){vlo[4 + ks][0], vlo[4 + ks][1], vlo[4 + ks][2], vlo[4 + ks][3], vhi[4 + ks][0], vhi[4 + ks][1], vhi[4 + ks][2], vhi[4 + ks][3]};
                          o0 = MFMA32(a0, pf[ks], o0); o1 = MFMA32(a1, pf[ks], o1); } }
                }
                if (kt + 1 < nkt) { LAS unsigned char* nb = lds + (buf ^ 1) * AT_KB; *(LAS v4u*)(nb + klds0) = ka; if (tid < 256) *(LAS v4u*)(nb + klds1) = kb2; *(LAS v4u*)(lds + 2 * AT_KB + (buf ^ 1) * AT_VB + vlds) = va; }
                __syncthreads();
            }
            const float inv = 1.f / (l + __shfl_xor(l, 32));
            bf16* orow = AO + ((size_t)b * SEQ + q0w + r) * 512 + h * 64 + 4 * hh;
#pragma unroll
            for (int g = 0; g < 4; ++g) { u32x2 w0, w1; w0.x = cvtpk(o0[4 * g] * inv, o0[4 * g + 1] * inv); w0.y = cvtpk(o0[4 * g + 2] * inv, o0[4 * g + 3] * inv);
                w1.x = cvtpk(o1[4 * g] * inv, o1[4 * g + 1] * inv); w1.y = cvtpk(o1[4 * g + 2] * inv, o1[4 * g + 3] * inv);
                *(u32x2*)(orow + 8 * g) = w0; *(u32x2*)(orow + 32 + 8 * g) = w1; }
        }
    }
}


constexpr int ML_KB = 16384, ML_VB = 16384, ML_BUF = 32768, ML_TAB = 3 * 32768;
__device__ __forceinline__ void mlstm_mfma(const bf16* QKM, const bf16* VM, const float* LOGI, const float* LOGF, const bf16* CONV, const bf16* OPRE, const float* ng, const float* skip,
                                           bf16* OUTM, LAS unsigned char* lds, int bx, int G, int tid) {
    const int lane = tid & 63, wave = __builtin_amdgcn_readfirstlane(tid >> 6), r = lane & 31, hh = lane >> 5;
    const int i16 = lane & 15, q4 = i16 >> 2, p4 = i16 & 3, blk = (lane >> 4) & 1;
    const int vboff = (4 * hh + q4) * 64 + 32 * blk + 8 * p4;
    int goff[4], loff[4];
#pragma unroll
    for (int q = 0; q < 4; ++q) { const int j = 4 * wave + q;
        if (j < 16) { goff[q] = lane * 1024 + 16 * (j >> 1) + 8 * (j & 1); loff[q] = (j >> 1) * 2048 + (j & 1) * 1024; }
        else { const int jv = j - 16, dq = jv >> 2, ks = jv & 3; goff[q] = (16 * ks + 8 * (lane >> 5) + ((lane >> 2) & 7)) * 512 + 32 * dq + 8 * (lane & 3); loff[q] = ML_KB + dq * 4096 + ks * 1024; } }
    const bool kwave = wave < 4;
#define ML_DMA(tile, bufi) do { _Pragma("unroll") for (int q_ = 0; q_ < 4; ++q_) { \
        const bf16* src_ = kwave ? (kg + (size_t)(tile) * 64 * 1024 + goff[q_]) : (vg + (size_t)(tile) * 64 * 512 + goff[q_]); \
        __builtin_amdgcn_global_load_lds((const unsigned*)src_, (LAS unsigned*)(lds + (bufi) * ML_BUF + loff[q_]), 16, 0, 0); } } while (0)
    LAS float* Ftab = (LAS float*)(lds + ML_TAB); LAS float* Ctab = Ftab + 2048; LAS float* wtot = Ctab + 2048;
    constexpr float L2E = 1.4426950408889634f;
    for (int pu = bx; pu < 256; pu += G) {
        const int bh = pu >> 3, p = pu & 7, b = bh >> 2, h = bh & 3;
        __syncthreads();
        { float f4[4], i4[4];
#pragma unroll
          for (int e = 0; e < 4; ++e) { const size_t row = (size_t)b * SEQ + tid * 4 + e; f4[e] = LOGF[row * 4 + h]; i4[e] = LOGI[row * 4 + h]; }
          f4[1] += f4[0]; f4[2] += f4[1]; f4[3] += f4[2];
          float x = f4[3];
          x += __uint_as_float(__builtin_amdgcn_update_dpp(0, __float_as_uint(x), 0x111, 0xf, 0xf, true)); x += __uint_as_float(__builtin_amdgcn_update_dpp(0, __float_as_uint(x), 0x112, 0xf, 0xf, true));
          x += __uint_as_float(__builtin_amdgcn_update_dpp(0, __float_as_uint(x), 0x114, 0xf, 0xf, true)); x += __uint_as_float(__builtin_amdgcn_update_dpp(0, __float_as_uint(x), 0x118, 0xf, 0xf, true));
          { const float t0 = __uint_as_float(__builtin_amdgcn_readlane(__float_as_uint(x), 15)), t1 = __uint_as_float(__builtin_amdgcn_readlane(__float_as_uint(x), 31)), t2 = __uint_as_float(__builtin_amdgcn_readlane(__float_as_uint(x), 47));
            const int row = lane >> 4; x += (row >= 1 ? t0 : 0.f) + (row >= 2 ? t1 : 0.f) + (row >= 3 ? t2 : 0.f); }
          if (lane == 63) wtot[wave] = x;
          __syncthreads();
          float base = x - f4[3];
          for (int w = 0; w < wave; ++w) base += wtot[w];
#pragma unroll
          for (int e = 0; e < 4; ++e) { const float F = base + f4[e]; Ftab[tid * 4 + e] = F * L2E; Ctab[tid * 4 + e] = (i4[e] - F) * L2E; } }
        __syncthreads();
        const int grp = wave >> 2, w4 = wave & 3;
        const int q0w = (grp == 0 ? 128 * p : 128 * (15 - p)) + 32 * w4, kmax = (q0w + 31) >> 6, nkt = 2 * (16 - p);
        const size_t trow = (size_t)b * SEQ + q0w + r;
        bf16x8 qf[8];
        { const bf16* qrow = QKM + trow * 1024 + h * 128 + 8 * hh;
#pragma unroll
          for (int s = 0; s < 8; ++s) qf[s] = *(const bf16x8*)(qrow + 16 * s); }
        const float Ft = Ftab[q0w + r], Ft0 = Ftab[q0w];
        LAS float* wt = Ctab + 2048 + 64 + wave * 64;
        f32x16 o[4];
#pragma unroll
        for (int d = 0; d < 4; ++d)
#pragma unroll
            for (int i = 0; i < 16; ++i) o[d][i] = 0.f;
        float den = 0.f;
        const bf16* kg = QKM + ((size_t)b * SEQ) * 1024 + 512 + h * 128; const bf16* vg = VM + ((size_t)b * SEQ) * 512 + h * 128;
        ML_DMA(0, 0);
        if (nkt > 1) { ML_DMA(1, 1); asm volatile("s_waitcnt vmcnt(4)" ::: "memory"); } else asm volatile("s_waitcnt vmcnt(0)" ::: "memory");
        asm volatile("s_waitcnt lgkmcnt(0)" ::: "memory"); __builtin_amdgcn_s_barrier(); asm volatile("" ::: "memory");
        for (int kt = 0; kt < nkt; ++kt) {
            const int buf = kt % 3;
            if (kt + 2 < nkt) ML_DMA(kt + 2, (kt + 2) % 3);
            if (kt <= kmax) {
                const LAS unsigned char* kb_ = lds + buf * ML_BUF + hh * 1024 + r * 16; const LAS unsigned char* vb_ = lds + buf * ML_BUF + ML_KB + vboff;
                f32x16 s0, s1;
#pragma unroll
                for (int i = 0; i < 16; ++i) { s0[i] = 0.f; s1[i] = 0.f; }
#pragma unroll
                for (int sh = 0; sh < 2; ++sh) { bf16x8 kf0[4], kf1[4];
#pragma unroll
                  for (int s = 0; s < 4; ++s) { kf0[s] = *(const LAS bf16x8*)(kb_ + (4 * sh + s) * 2048); kf1[s] = *(const LAS bf16x8*)(kb_ + (4 * sh + s) * 2048 + 512); }
                  __builtin_amdgcn_sched_barrier(0);
#pragma unroll
                  for (int s = 0; s < 4; ++s) { s0 = MFMA32(kf0[s], qf[4 * sh + s], s0); s1 = MFMA32(kf1[s], qf[4 * sh + s], s1); } }
                const int qq = q0w + r - kt * 64;
                const bool diag = kt * 64 + 63 > q0w;
                wt[lane] = __builtin_amdgcn_exp2f(Ctab[kt * 64 + lane] + Ft0);
                LDS_WAIT();
                const LAS float* ct = wt + 4 * hh;
                float ps = 0.f;
#pragma unroll
                for (int g = 0; g < 4; ++g) { const f32x4 c0v = *(const LAS f32x4*)(ct + 8 * g), c1v = *(const LAS f32x4*)(ct + 32 + 8 * g);
#pragma unroll
                    for (int e = 0; e < 4; ++e) { const int i = 4 * g + e, key = e + 8 * g + 4 * hh;
                        float w0 = c0v[e], w1 = c1v[e];
                        if (diag) { w0 = (key <= qq) ? w0 : 0.f; w1 = (key + 32 <= qq) ? w1 : 0.f; }
                        s0[i] *= w0; s1[i] *= w1; ps += s0[i] + s1[i]; } }
                den += ps;
                bf16x8 pf[4];
                pf[0] = pack8(s0[0], s0[1], s0[2], s0[3], s0[4], s0[5], s0[6], s0[7]); pf[1] = pack8(s0[8], s0[9], s0[10], s0[11], s0[12], s0[13], s0[14], s0[15]);
                pf[2] = pack8(s1[0], s1[1], s1[2], s1[3], s1[4], s1[5], s1[6], s1[7]); pf[3] = pack8(s1[8], s1[9], s1[10], s1[11], s1[12], s1[13], s1[14], s1[15]);
#pragma unroll
                for (int ks = 0; ks < 4; ++ks) { s16x4 vlo[4], vhi[4];
#pragma unroll
                    for (int d = 0; d < 4; ++d) { vlo[d] = vtr(vb_ + d * 4096 + ks * 1024); vhi[d] = vtr(vb_ + d * 4096 + ks * 1024 + 512); }
                    __builtin_amdgcn_sched_barrier(0);
#pragma unroll
                    for (int d = 0; d < 4; ++d) { const s16x4 lo = vlo[d], hi = vhi[d];
                        const bf16x8 av = (bf16x8){lo[0], lo[1], lo[2], lo[3], hi[0], hi[1], hi[2], hi[3]};
                        o[d] = MFMA32(av, pf[ks], o[d]); } }
            }
            if (kt + 2 < nkt) asm volatile("s_waitcnt vmcnt(4)" ::: "memory"); else asm volatile("s_waitcnt vmcnt(0)" ::: "memory");
            asm volatile("s_waitcnt lgkmcnt(0)" ::: "memory"); __builtin_amdgcn_s_barrier(); asm volatile("" ::: "memory");
        }
        const float kap = __builtin_amdgcn_exp2f(Ft - Ft0);
        const float dt = (den + __shfl_xor(den, 32)) * kap;
        const float inv = kap / fmaxf(fabsf(dt), 1.f);
        float sm = 0.f;
#pragma unroll
        for (int d = 0; d < 4; ++d)
#pragma unroll
            for (int i = 0; i < 16; ++i) { o[d][i] *= inv; sm += o[d][i]; }
        sm += __shfl_xor(sm, 32);
        const float mu = sm * (1.f / 128.f);
        float vs = 0.f;
#pragma unroll
        for (int d = 0; d < 4; ++d)
#pragma unroll
            for (int i = 0; i < 16; ++i) { const float dlt = o[d][i] - mu; vs += dlt * dlt; }
        vs += __shfl_xor(vs, 32);
        const float rstd = rsqrtf(vs * (1.f / 128.f) + RMS_EPS);
#pragma unroll
        for (int d = 0; d < 4; ++d)
#pragma unroll
            for (int g = 0; g < 4; ++g) { const int ch = h * 128 + 32 * d + 8 * g + 4 * hh; const size_t off = trow * 512 + ch;
                const u32x2 cv = *(const u32x2*)(CONV + off), ov = *(const u32x2*)(OPRE + off); const f32x4 gg = *(const f32x4*)(ng + ch), sk = *(const f32x4*)(skip + ch);
                const float y0 = sigm(bflo(ov.x)) * ((o[d][4 * g] - mu) * rstd * gg[0] + sk[0] * bflo(cv.x)), y1 = sigm(bfhi(ov.x)) * ((o[d][4 * g + 1] - mu) * rstd * gg[1] + sk[1] * bfhi(cv.x));
                const float y2 = sigm(bflo(ov.y)) * ((o[d][4 * g + 2] - mu) * rstd * gg[2] + sk[2] * bflo(cv.y)), y3 = sigm(bfhi(ov.y)) * ((o[d][4 * g + 3] - mu) * rstd * gg[3] + sk[3] * bfhi(cv.y));
                u32x2 w; w.x = cvtpk(y0, y1); w.y = cvtpk(y2, y3); *(u32x2*)(OUTM + off) = w; }
    }
#undef ML_DMA
}

template <int N> __device__ __forceinline__ void bitonic_sort_desc(float (&v)[N]) {
#pragma unroll
    for (int k = 2; k <= N; k <<= 1)
#pragma unroll
        for (int j = k >> 1; j > 0; j >>= 1)
#pragma unroll
            for (int i = 0; i < N; ++i) { const int l = i ^ j; if (l > i) { const bool desc = ((i & k) == 0); const float a = v[i], b = v[l], hi = fmaxf(a, b), lo = fminf(a, b); v[i] = desc ? hi : lo; v[l] = desc ? lo : hi; } }
}
__device__ __forceinline__ void top16_merge(float (&a)[16], const float (&b)[16]) {
#pragma unroll
    for (int i = 0; i < 16; ++i) a[i] = fmaxf(a[i], b[15 - i]);
#pragma unroll
    for (int j = 8; j > 0; j >>= 1)
#pragma unroll
        for (int i = 0; i < 16; ++i) { const int l = i ^ j; if (l > i) { const float x = a[i], y = a[l]; a[i] = fmaxf(x, y); a[l] = fminf(x, y); } }
}
constexpr int PE_EIDX = 0, PE_EGATE = 16384, PE_KEYT = 32768;
__device__ __forceinline__ void peer_route(const bf16* PQ, const bf16* KEYB, int* IDX, float* GATE, LAS unsigned char* lds, int bx, int G, int tid) {
    const int lane = tid & 63, wave = __builtin_amdgcn_readfirstlane(tid >> 6), r = lane & 31, hh = lane >> 5;
    LAS unsigned char* keyt = lds + PE_KEYT + (wave * 32 + r) * 32;
    for (int grp = bx; grp < T / 32; grp += G) {
        const int t0 = grp * 32;
        { const int h = wave;
          int rq = r; asm volatile("" : "+v"(rq));
          float top[2][16];
#pragma unroll
          for (int p = 0; p < 2; ++p) {
              bf16x8 qf[4];
              { const bf16* qrow = PQ + (size_t)(t0 + rq) * 1024 + h * 128 + p * 64 + 8 * hh;
#pragma unroll
                for (int s = 0; s < 4; ++s) qf[s] = *(const bf16x8*)(qrow + 16 * s); }
              const bf16* kb = KEYB + ((size_t)(h * 2 + p) * 128 + rq) * 64 + 8 * hh;
              float sv[4][16];
#pragma unroll
              for (int kt = 0; kt < 4; ++kt) { f32x16 acc;
#pragma unroll
                  for (int i = 0; i < 16; ++i) acc[i] = 0.f;
#pragma unroll
                  for (int s = 0; s < 4; ++s) { const bf16x8 a = *(const bf16x8*)(kb + (size_t)(32 * kt) * 64 + 16 * s); acc = MFMA32(a, qf[s], acc); }
#pragma unroll
                  for (int i = 0; i < 16; ++i) { const unsigned key = (unsigned)(32 * kt + (i & 3) + 8 * (i >> 2)) + 4u * (unsigned)hh; sv[kt][i] = __uint_as_float((__float_as_uint(acc[i]) & ~127u) | key); } }
              bitonic_sort_desc<16>(sv[0]); bitonic_sort_desc<16>(sv[1]); bitonic_sort_desc<16>(sv[2]); bitonic_sort_desc<16>(sv[3]);
              top16_merge(sv[0], sv[1]); top16_merge(sv[2], sv[3]); top16_merge(sv[0], sv[2]);
              float pr[16];
#pragma unroll
              for (int i = 0; i < 16; ++i) pr[i] = __shfl_xor(sv[0][i], 32);
              top16_merge(sv[0], pr);
#pragma unroll
              for (int i = 0; i < 16; ++i) top[p][i] = sv[0][i];
          }
          if (hh == 0) {
#pragma unroll
              for (int i = 0; i < 16; ++i) { keyt[i] = (unsigned char)(__float_as_uint(top[0][i]) & 127u); keyt[16 + i] = (unsigned char)(__float_as_uint(top[1][i]) & 127u); } }
          float cs[4][16];
#define PSUM(a, b) __uint_as_float((__float_as_uint(top[0][a] + top[1][b]) & ~255u) | (unsigned)((a) * 16 + (b)))
#pragma unroll
          for (int b2 = 0; b2 < 16; ++b2) cs[0][b2] = PSUM(0, b2);
#pragma unroll
          for (int b2 = 0; b2 < 8; ++b2) cs[1][b2] = PSUM(1, b2);
#pragma unroll
          for (int a2 = 8; a2 < 16; ++a2) cs[1][a2] = PSUM(a2, 0);
#pragma unroll
          for (int b2 = 0; b2 < 5; ++b2) cs[2][b2] = PSUM(2, b2);
#pragma unroll
          for (int b2 = 0; b2 < 4; ++b2) cs[2][5 + b2] = PSUM(3, b2);
#pragma unroll
          for (int b2 = 0; b2 < 3; ++b2) cs[2][9 + b2] = PSUM(4, b2);
          cs[2][12] = PSUM(5, 0); cs[2][13] = PSUM(5, 1); cs[2][14] = PSUM(6, 0); cs[2][15] = PSUM(6, 1);
          cs[3][0] = PSUM(7, 0); cs[3][1] = PSUM(7, 1);
#undef PSUM
#pragma unroll
          for (int i = 2; i < 16; ++i) cs[3][i] = -3.0e38f;
          bitonic_sort_desc<16>(cs[0]); bitonic_sort_desc<16>(cs[1]); bitonic_sort_desc<16>(cs[2]); bitonic_sort_desc<16>(cs[3]);
          top16_merge(cs[0], cs[1]); top16_merge(cs[2], cs[3]); top16_merge(cs[0], cs[2]);
          LDS_WAIT();
          float ev[16], den = 0.f; const float mx = __uint_as_float(__float_as_uint(cs[0][0]) & ~255u);
#pragma unroll
          for (int k = 0; k < 16; ++k) { ev[k] = __expf(__uint_as_float(__float_as_uint(cs[0][k]) & ~255u) - mx); den += ev[k]; }
          const float rden = 1.f / den;
          if (hh == 0) {
#pragma unroll
              for (int k = 0; k < 16; ++k) { const unsigned code = __float_as_uint(cs[0][k]) & 255u; const int e = (int)keyt[code >> 4] * 128 + (int)keyt[16 + (code & 15u)];
                  IDX[(size_t)(t0 + r) * 128 + h * 16 + k] = e; GATE[(size_t)(t0 + r) * 128 + h * 16 + k] = ev[k] * rden; } }
        }
    }
}
__device__ __forceinline__ void peer_partition(const unsigned* xc_cnt, volatile LAS unsigned* MISC, int bx, int G, int& vx, int& rank, int& nb) {
    bool use_xcc = MK_ONE_LAUNCH != 0; unsigned mine = 0u; const unsigned myx = MISC[13];
    if (use_xcc) { unsigned sum = 0u;
#pragma unroll
        for (unsigned j = 0; j < 8; ++j) { const unsigned c = __hip_atomic_load(xc_cnt + 64 * j, __ATOMIC_RELAXED, __HIP_MEMORY_SCOPE_AGENT); use_xcc = use_xcc && (c > 0u); sum += c; mine = (j == myx) ? c : mine; }
        use_xcc = use_xcc && (sum == (unsigned)G); }
    if (use_xcc) { vx = (int)myx; rank = (int)MISC[12]; nb = (int)mine; } else { vx = bx & 7; rank = bx >> 3; nb = (G - vx + 7) >> 3; }
    vx = __builtin_amdgcn_readfirstlane(vx); rank = __builtin_amdgcn_readfirstlane(rank); nb = __builtin_amdgcn_readfirstlane(nb);
}
__device__ __forceinline__ void peer_u_i8(const unsigned char* H8, const float* XS, const int* IDX, const unsigned char* U8, const f32x2v* SC2, float* ACT, LAS float* wscr, int vx, int rank, int nb, int tid) {
    const int lane = tid & 63, wave = __builtin_amdgcn_readfirstlane(tid >> 6), g4 = lane >> 4, c16 = lane & 15;
    const int tstride = nb * 8;
    LAS int* clist = (LAS int*)wscr;
    const unsigned long long lt = (1ull << lane) - 1ull;
    const unsigned char* ubase = U8 + 16 * c16;
    int ni[8];
    { const int tb = rank * 8 + wave;
#pragma unroll
      for (int j = 0; j < 4; ++j) { const int tj = tb + j * tstride; const bool ok = tj < T; ni[2 * j] = ok ? IDX[(size_t)tj * 128 + lane] : 0x7fffffff; ni[2 * j + 1] = ok ? IDX[(size_t)tj * 128 + 64 + lane] : 0x7fffffff; } }
    for (int tb = rank * 8 + wave; tb < T; tb += 4 * tstride) {
        int nj[4];
#pragma unroll
        for (int j = 0; j < 4; ++j) { const int e0 = ni[2 * j], e1 = ni[2 * j + 1]; const bool f0 = (e0 >> 11) == vx, f1 = (e1 >> 11) == vx;
            const unsigned long long m0 = __ballot(f0), m1 = __ballot(f1); const int n0 = __popcll(m0); nj[j] = n0 + __popcll(m1);
            if (f0) clist[j * 128 + __popcll(m0 & lt)] = (e0 << 7) | lane;
            if (f1) clist[j * 128 + n0 + __popcll(m1 & lt)] = (e1 << 7) | (64 + lane); }
        { const int tn = tb + 4 * tstride;
#pragma unroll
          for (int j = 0; j < 4; ++j) { const int tj = tn + j * tstride; const bool ok = tj < T; ni[2 * j] = ok ? IDX[(size_t)tj * 128 + lane] : 0x7fffffff; ni[2 * j + 1] = ok ? IDX[(size_t)tj * 128 + 64 + lane] : 0x7fffffff; } }
        const int nmax = max(max(nj[0], nj[1]), max(nj[2], nj[3]));
        if (nmax == 0) continue;
        const int nown = g4 == 0 ? nj[0] : g4 == 1 ? nj[1] : g4 == 2 ? nj[2] : nj[3];
        const int town = tb + g4 * tstride; const int tld = town < T ? town : tb;
        v4u xq[4];
#pragma unroll
        for (int j = 0; j < 4; ++j) xq[j] = *(const v4u*)(H8 + (size_t)tld * 1024 + 256 * j + 16 * c16);
        const float sx = XS[tld];
        LDS_WAIT();
        const LAS int* cl = clist + g4 * 128;
        v4u ub[4][4]; f32x2v us[4]; int up[4];
#pragma unroll
        for (int k = 0; k < 3; ++k) { up[k] = 0; us[k] = (f32x2v){0.f, 0.f};
#pragma unroll
            for (int j = 0; j < 4; ++j) ub[k][j] = (v4u){0u, 0u, 0u, 0u};
            if (k < nown) { const int pk = cl[k]; up[k] = pk; const unsigned eo = (unsigned)(pk >> 7) * 1024u; us[k] = SC2[pk >> 7];
#pragma unroll
                for (int j = 0; j < 4; ++j) ub[k][j] = *(const v4u*)(ubase + eo + 256 * j); } }
        up[3] = 0; us[3] = (f32x2v){0.f, 0.f};
#pragma unroll
        for (int j = 0; j < 4; ++j) ub[3][j] = (v4u){0u, 0u, 0u, 0u};
        int dsel = 0, psel = 0; f32x2v ssel = (f32x2v){0.f, 0.f}; bool vsel = false;
        const int nit = (nmax + 3) >> 2;
#pragma unroll 1
        for (int o = 0; o < nit; ++o) {
#pragma unroll
            for (int k = 0; k < 4; ++k) {
                const int i = 4 * o + k;
                if (i + 3 < nown) { const int pk = cl[i + 3]; up[(k + 3) & 3] = pk; const unsigned eo = (unsigned)(pk >> 7) * 1024u; us[(k + 3) & 3] = SC2[pk >> 7];
#pragma unroll
                  for (int j = 0; j < 4; ++j) ub[(k + 3) & 3][j] = *(const v4u*)(ubase + eo + 256 * j); }
                int a0 = 0, a1 = 0, a2 = 0, a3 = 0;
                a0 = __builtin_amdgcn_sdot4((int)xq[0].x, (int)ub[k][0].x, a0, false); a1 = __builtin_amdgcn_sdot4((int)xq[0].y, (int)ub[k][0].y, a1, false);
                a2 = __builtin_amdgcn_sdot4((int)xq[0].z, (int)ub[k][0].z, a2, false); a3 = __builtin_amdgcn_sdot4((int)xq[0].w, (int)ub[k][0].w, a3, false);
                a0 = __builtin_amdgcn_sdot4((int)xq[1].x, (int)ub[k][1].x, a0, false); a1 = __builtin_amdgcn_sdot4((int)xq[1].y, (int)ub[k][1].y, a1, false);
                a2 = __builtin_amdgcn_sdot4((int)xq[1].z, (int)ub[k][1].z, a2, false); a3 = __builtin_amdgcn_sdot4((int)xq[1].w, (int)ub[k][1].w, a3, false);
                a0 = __builtin_amdgcn_sdot4((int)xq[2].x, (int)ub[k][2].x, a0, false); a1 = __builtin_amdgcn_sdot4((int)xq[2].y, (int)ub[k][2].y, a1, false);
                a2 = __builtin_amdgcn_sdot4((int)xq[2].z, (int)ub[k][2].z, a2, false); a3 = __builtin_amdgcn_sdot4((int)xq[2].w, (int)ub[k][2].w, a3, false);
                a0 = __builtin_amdgcn_sdot4((int)xq[3].x, (int)ub[k][3].x, a0, false); a1 = __builtin_amdgcn_sdot4((int)xq[3].y, (int)ub[k][3].y, a1, false);
                a2 = __builtin_amdgcn_sdot4((int)xq[3].z, (int)ub[k][3].z, a2, false); a3 = __builtin_amdgcn_sdot4((int)xq[3].w, (int)ub[k][3].w, a3, false);
                int d = (a0 + a1) + (a2 + a3);
                d += __builtin_amdgcn_update_dpp(0, d, 0x128, 0xf, 0xf, false); d += __builtin_amdgcn_update_dpp(0, d, 0x124, 0xf, 0xf, false);
                d += __builtin_amdgcn_update_dpp(0, d, 0x122, 0xf, 0xf, false); d += __builtin_amdgcn_update_dpp(0, d, 0x121, 0xf, 0xf, false);
                if ((i & 15) == c16) { dsel = d; ssel = us[k]; psel = up[k]; vsel = i < nown; }
                if (k == 3 && ((o & 3) == 3 || o == nit - 1)) {
                    if (vsel) ACT[(size_t)town * 128 + (psel & 127)] = gelu_erf((float)dsel * sx * ssel.x) * ssel.y;
                    vsel = false; }
            }
        }
        LDS_WAIT();
    }
}
__device__ __forceinline__ void peer_v(const int* IDX, const float* ACT, const float* GATE, const unsigned char* V8, const float* gate2, const float* Xin, float* Xout, LAS float* wscr,
                                       int vx, int rank, int nb, int tid) {
    const int lane = tid & 63, wave = __builtin_amdgcn_readfirstlane(tid >> 6), g8 = lane >> 3, c8 = lane & 7;
    const int tstride = nb * 8;
    LAS int* wl = (LAS int*)wscr; LAS unsigned char* wqb = (LAS unsigned char*)(wscr + 128);
    const unsigned char* vbase = V8 + (size_t)vx * (2 * MiB) + 16 * c8;
    const int col = 128 * vx + 16 * c8;
    const int wqo0 = (lane & 7) * 16 + (lane >> 3), wqo1 = wqo0 + 8;
    int t = rank * 8 + wave;
    if (t >= T) return;
    int i0 = IDX[(size_t)t * 128 + lane], i1 = IDX[(size_t)t * 128 + 64 + lane] ;
    float a0 = ACT[(size_t)t * 128 + lane] * GATE[(size_t)t * 128 + lane], a1 = ACT[(size_t)t * 128 + 64 + lane] * GATE[(size_t)t * 128 + 64 + lane];
    f32x4 xin[4], g2[4], xnn[4], gnn[4];
    if (g8 == 0) {
#pragma unroll
        for (int q = 0; q < 4; ++q) { xnn[q] = *(const f32x4*)(Xin + (size_t)t * 1024 + col + 4 * q); gnn[q] = *(const f32x4*)(gate2 + (size_t)(t >> 11) * NADA + col + 4 * q); } }
    for (; t < T; t += tstride) {
        const int tn = t + tstride;
        const float w0 = a0, w1 = a1;
        float am = fmaxf(fabsf(w0), fabsf(w1));
#pragma unroll
        for (int o = 1; o < 64; o <<= 1) am = fmaxf(am, __shfl_xor(am, o));
        const float inv = am > 0.f ? 127.f / am : 0.f, sw = am * (1.f / 127.f);
        wl[lane] = i0; wl[64 + lane] = i1; wqb[wqo0] = (unsigned char)((int)rintf(w0 * inv) & 255); wqb[wqo1] = (unsigned char)((int)rintf(w1 * inv) & 255);
        if (tn < T) { i0 = IDX[(size_t)tn * 128 + lane] ; i1 = IDX[(size_t)tn * 128 + 64 + lane] ;
            a0 = ACT[(size_t)tn * 128 + lane] * GATE[(size_t)tn * 128 + lane]; a1 = ACT[(size_t)tn * 128 + 64 + lane] * GATE[(size_t)tn * 128 + 64 + lane]; }
#pragma unroll
        for (int q = 0; q < 4; ++q) { xin[q] = xnn[q]; g2[q] = gnn[q]; }
        if (g8 == 0 && tn < T) {
#pragma unroll
            for (int q = 0; q < 4; ++q) { xnn[q] = *(const f32x4*)(Xin + (size_t)tn * 1024 + col + 4 * q); gnn[q] = *(const f32x4*)(gate2 + (size_t)(tn >> 11) * NADA + col + 4 * q); } }
        LDS_WAIT();
        v4u vv[16];
#pragma unroll
        for (int i = 0; i < 16; ++i) { const int e = wl[8 * i + g8]; vv[i] = *(const v4u*)(vbase + (size_t)(unsigned)(e * 128)); }
        const v4u wq4 = *(const LAS v4u*)(wqb + g8 * 16);
        int acc[16];
#pragma unroll
        for (int i = 0; i < 16; ++i) acc[i] = 0;
#pragma unroll
        for (int q = 0; q < 4; ++q) { const int wq = (int)(q == 0 ? wq4.x : q == 1 ? wq4.y : q == 2 ? wq4.z : wq4.w);
#pragma unroll
            for (int cb = 0; cb < 4; ++cb) {
                const unsigned a = cb == 0 ? vv[4 * q].x : cb == 1 ? vv[4 * q].y : cb == 2 ? vv[4 * q].z : vv[4 * q].w, bb = cb == 0 ? vv[4 * q + 1].x : cb == 1 ? vv[4 * q + 1].y : cb == 2 ? vv[4 * q + 1].z : vv[4 * q + 1].w;
                const unsigned c = cb == 0 ? vv[4 * q + 2].x : cb == 1 ? vv[4 * q + 2].y : cb == 2 ? vv[4 * q + 2].z : vv[4 * q + 2].w, d = cb == 0 ? vv[4 * q + 3].x : cb == 1 ? vv[4 * q + 3].y : cb == 2 ? vv[4 * q + 3].z : vv[4 * q + 3].w;
                const unsigned ab_lo = __builtin_amdgcn_perm(bb, a, 0x05010400u), ab_hi = __builtin_amdgcn_perm(bb, a, 0x07030602u), cd_lo = __builtin_amdgcn_perm(d, c, 0x05010400u), cd_hi = __builtin_amdgcn_perm(d, c, 0x07030602u);
                acc[4 * cb + 0] = __builtin_amdgcn_sdot4((int)__builtin_amdgcn_perm(cd_lo, ab_lo, 0x05040100u), wq, acc[4 * cb + 0], false);
                acc[4 * cb + 1] = __builtin_amdgcn_sdot4((int)__builtin_amdgcn_perm(cd_lo, ab_lo, 0x07060302u), wq, acc[4 * cb + 1], false);
                acc[4 * cb + 2] = __builtin_amdgcn_sdot4((int)__builtin_amdgcn_perm(cd_hi, ab_hi, 0x05040100u), wq, acc[4 * cb + 2], false);
                acc[4 * cb + 3] = __builtin_amdgcn_sdot4((int)__builtin_amdgcn_perm(cd_hi, ab_hi, 0x07060302u), wq, acc[4 * cb + 3], false); } }
#pragma unroll
        for (int i = 0; i < 16; ++i) { acc[i] += __builtin_amdgcn_update_dpp(0, acc[i], 0x128, 0xf, 0xf, false);
            acc[i] += __shfl_xor(acc[i], 16); acc[i] += __shfl_xor(acc[i], 32); }
        if (g8 == 0) {
#pragma unroll
            for (int q = 0; q < 4; ++q) *(f32x4*)(Xout + (size_t)t * 1024 + col + 4 * q) = xin[q] + g2[q] * ((f32x4){(float)acc[4 * q], (float)acc[4 * q + 1], (float)acc[4 * q + 2], (float)acc[4 * q + 3]} * sw); }
        LDS_WAIT();
    }
}
constexpr int PH_PER_LAYER = 12, N_PHASES = 1 + DEPTH * PH_PER_LAYER + 1;
struct Args { const void* in[N_INPUTS]; float* out; unsigned char* ws; int ph_lo, ph_hi; };
static_assert(sizeof(Args) == N_INPUTS * 8 + 24, "Args has no padding");

constexpr int PTAB_OFF = LDSCTL_OFF + 1024;
__device__ __forceinline__ unsigned char* getp(LAS unsigned char* lds, int i) {
    asm volatile("" ::: "memory");
    const u32x2 v = *(volatile LAS u32x2*)(lds + PTAB_OFF + 8 * i);
    const unsigned lo = __builtin_amdgcn_readfirstlane(v.x), hi = __builtin_amdgcn_readfirstlane(v.y);
    GAS unsigned char* g = (GAS unsigned char*)(((unsigned long long)hi << 32) | lo);
    return (unsigned char*)g;
}
#define INP(i) ((const float*)getp(lds, (i)))
#define WSB() getp(lds, 30)

#define IN(k) (lo <= (k) && (k) < hi)
#define SEAM(k) do { if (MK_ONE_LAUNCH && IN(k) && IN((k) + 1)) { XcdBarrier b_; b_.bar = (unsigned*)(WSB() + WS_CTL) + CW_BAR; b_.x = xb_xcc_id(); b_.st = MISC + 8; REPS(11) xcd_barrier(b_, (wave_s << 6) | (int)__lane_id()); } } while (0)
#define PH_BEGIN(lv) int tidq; asm volatile("v_mbcnt_lo_u32_b32 %0, -1, 0\n\tv_mbcnt_hi_u32_b32 %0, -1, %0" : "=v"(tidq)); tidq |= wave_s << 6;     \
    asm volatile("" : "+v"(tidq)); const int lane = tidq & 63, wave = __builtin_amdgcn_readfirstlane(tidq >> 6); \
    int G = gridDim.x, bx = blockIdx.x, l = (lv); asm volatile("" : "+s"(G), "+s"(bx), "+s"(l)); const int gw = bx * NWAVES + wave, NGW = G * NWAVES; \
    unsigned char* ws = WSB(); LAS float* wscr = (LAS float*)(lds + RING_OFF + wave * 16384); (void)lane; (void)gw; (void)NGW; (void)ws; (void)wscr; (void)l


constexpr int PI_W = 4512, PI_K = 512, PI_U = 2048, PI_V = 2048, PI_TOTAL = PI_W + PI_K + PI_U + PI_V;
template <int NR> __device__ __forceinline__ void prep_rows_i8(const float* src, size_t src_stride, unsigned char* dst, size_t dst_stride, float* scale_slot  , int lane) {
    f32x4 v[NR][4];
#pragma unroll
    for (int rr = 0; rr < NR; ++rr) { const f32x4* s = (const f32x4*)(src + rr * src_stride) + lane * 4;
#pragma unroll
        for (int j = 0; j < 4; ++j) v[rr][j] = s[j]; }
#pragma unroll
    for (int rr = 0; rr < NR; ++rr) {
        float am = 0.f;
#pragma unroll
        for (int j = 0; j < 4; ++j) am = fmaxf(fmaxf(am, fmaxf(fabsf(v[rr][j][0]), fabsf(v[rr][j][1]))), fmaxf(fabsf(v[rr][j][2]), fabsf(v[rr][j][3])));
#pragma unroll
        for (int o = 1; o < 64; o <<= 1) am = fmaxf(am, __shfl_xor(am, o));
        const float inv = am > 0.f ? 127.f / am : 0.f;
#define Q4(x) ((unsigned)((int)rintf((x)[0] * inv) & 255) | ((unsigned)((int)rintf((x)[1] * inv) & 255) << 8) | ((unsigned)((int)rintf((x)[2] * inv) & 255) << 16) | ((unsigned)((int)rintf((x)[3] * inv) & 255) << 24))
        v4u o; o.x = Q4(v[rr][0]); o.y = Q4(v[rr][1]); o.z = Q4(v[rr][2]); o.w = Q4(v[rr][3]);
#undef Q4
        *(v4u*)(dst + rr * dst_stride) = o;
        if (lane == 0) scale_slot[2 * rr] = am * (1.f / 127.f);
    }
}
__device__ __forceinline__ void prep_item(LAS unsigned char* lds, unsigned char* ws, LAS float* wscr, int l, int r, int lane) {
    constexpr int I_WIN_ = 16 * 136, I_WQ_ = 12 * 24, I_WKV_ = 4 * 32, I_WA_ = 8 * 32, I_WM_ = 8 * 32, I_WO_ = 16 * 32, I_PW_ = 16 * 32, I_WQK_ = 8 * 32, I_WV_ = 8 * 16;
    static_assert(I_WIN_ + I_WQ_ + I_WKV_ + I_WA_ + I_WM_ + I_WO_ + I_PW_ + I_WQK_ + I_WV_ == PI_W, "weight items");
    unsigned char* wl = ws + WS_W + (size_t)l * W_LAYER;
    if (r < PI_W) {
        if (r < I_WIN_) { const GetWin g{INP(I_WIN) + (size_t)l * D * 4136}; prep_tile(g, (bf16*)(wl + WO_WIN), 1024, 64 * (r / 136), 32 * (r % 136), wscr, lane); return; } r -= I_WIN_;
        if (r < I_WQ_) { const GetWq g{INP(I_WQUP) + (size_t)l * 768 * 768, INP(I_QNG) + l * 768}; prep_tile(g, (bf16*)(wl + WO_WQ), 768, 64 * (r / 24), 32 * (r % 24), wscr, lane); return; } r -= I_WQ_;
        if (r < I_WKV_) { const GetWkv g{INP(I_WKVUP) + (size_t)l * 256 * 1024, INP(I_KVNG) + l * 256}; prep_tile(g, (bf16*)(wl + WO_WKV), 256, 64 * (r / 32), 32 * (r % 32), wscr, lane); return; } r -= I_WKV_;
        if (r < I_WA_) { const GetPlain g{INP(I_WBA) + (size_t)l * 512 * 1024, 1024}; prep_tile(g, (bf16*)(wl + WO_WA), 512, 64 * (r / 32), 32 * (r % 32), wscr, lane); return; } r -= I_WA_;
        if (r < I_WM_) { const GetPlain g{INP(I_WBM) + (size_t)l * 512 * 1024, 1024}; prep_tile(g, (bf16*)(wl + WO_WM), 512, 64 * (r / 32), 32 * (r % 32), wscr, lane); return; } r -= I_WM_;
        if (r < I_WO_) { const GetPlain g{INP(I_WOUT) + (size_t)l * 1024 * 1024, 1024}; prep_tile(g, (bf16*)(wl + WO_WO), 1024, 64 * (r / 32), 32 * (r % 32), wscr, lane); return; } r -= I_WO_;
        if (r < I_PW_) { const GetPlain g{INP(I_PWQ) + (size_t)l * 1024 * 1024, 1024}; prep_tile(g, (bf16*)(wl + WO_PWQ), 1024, 64 * (r / 32), 32 * (r % 32), wscr, lane); return; } r -= I_PW_;
        if (r < I_WQK_) { const GetWqk g{INP(I_WQM) + (size_t)l * 65536, INP(I_WKM) + (size_t)l * 65536}; prep_tile(g, (bf16*)(wl + WO_WQK), 512, 64 * (r / 32), 32 * (r % 32), wscr, lane); return; } r -= I_WQK_;
        { const GetWv g{INP(I_WVM) + (size_t)l * 65536}; prep_tile(g, (bf16*)(wl + WO_WV), 512, 64 * (r / 16), 32 * (r % 16), wscr, lane); }
        return; }
    r -= PI_W;
    if (r < PI_K) { const int o = (r * 64 + lane) * 4;
        const f32x4 v = *(const f32x4*)(INP(I_PKEYS) + (size_t)l * 131072 + o); u32x2 w; w.x = pk2(v[0], v[1]); w.y = pk2(v[2], v[3]);
        *(u32x2*)(wl + WO_KEYB + (size_t)o * 2) = w; return; }
    r -= PI_K;
    float* sc2 = (float*)(ws + WS_USC);
    if (r < PI_U) { const float* pu = INP(I_PU) + (size_t)l * 16777216;
        for (int rr = 0; rr < 8; rr += 8) { const int er = r * 8 + rr; prep_rows_i8<8>(pu + (size_t)er * 1024, 1024, ws + WS_U8 + (size_t)l * 32 * MiB + (size_t)er * 1024 + 16 * lane, 1024, sc2 + 2 * (l * 16384 + er), lane); }
        return; }
    r -= PI_U;
    { const float* pv = INP(I_PV) + (size_t)l * 16777216;
      for (int rr = 0; rr < 8; rr += 8) { const int er = r * 8 + rr;
          prep_rows_i8<8>(pv + (size_t)er * 1024, 1024, ws + WS_V8 + (size_t)l * 32 * MiB + (size_t)(lane >> 3) * (2 * MiB) + (size_t)er * 128 + 16 * (lane & 7), 128, sc2 + 2 * (l * 16384 + er) + 1, lane); } }
}
template <int lv> __device__ __forceinline__ void layer_phases(LAS unsigned char* lds, volatile LAS unsigned* MISC, const int lo, const int hi, const int wave_s) {
        const int P = 1 + lv * PH_PER_LAYER;
#define WL() (ws + WS_W + (size_t)l * W_LAYER)
#define ADAL() ((const float*)(ws + ADA_OFF) + (size_t)l * 8 * NADA)
#define XIN() ((l == 0) ? INP(I_X) : (const float*)getp(lds, 29))
#define WSP(type, off) ((type*)(ws + (off)))
        if (IN(P + 0)) REPS(1) { PH_BEGIN(lv); rowpass_norm_mod(XIN(), INP(I_N1G) + l * D, ADAL() + 0, ADAL() + 1024, WSP(bf16, WS_H), gw, NGW, lane); }
        SEAM(P + 0);
        if (IN(P + 1)) REPS(2) { PH_BEGIN(lv);
            if (G == 256) {
                { pg8::Gemm g{WSP(bf16, WS_H), (const bf16*)(WL() + WO_WIN), T, 4096, D}; pg8::StaticOrder S; S.init(T, 4096, G, bx);
                  EpiProj E{WSP(bf16, WS_QLAT), WSP(bf16, WS_KVLAT), WSP(bf16, WS_UM), WSP(bf16, WS_OPRE), WSP(bf16, WS_GA), WSP(bf16, WS_GM), WSP(float, WS_SMALL)};
                  pg8::gemm_phase<EpiProj, pg8::StaticOrder, true, true>(lds + RING_OFF, g, S, E, tidq); }
                { const int kq = bx >> 6;
                  pg8::Gemm g{WSP(bf16, WS_H) + 256 * kq, (const bf16*)(WL() + WO_WIN) + (size_t)4096 * 1024 + 256 * kq, T, 256, 256, 1024}; pg8::StaticOrder S; S.init(T, 256, 64, bx & 63);
                  EpiSmallPart E{WSP(float, WS_SMALLP) + (size_t)kq * T * 64};
                  pg8::gemm_phase<EpiSmallPart, pg8::StaticOrder, true, true>(lds + RING_OFF, g, S, E, tidq); }
            } else {
                pg8::Gemm g{WSP(bf16, WS_H), (const bf16*)(WL() + WO_WIN), T, NPROJ, D}; pg8::StaticOrder S; S.init(T, NPROJ, G, bx);
                EpiProj E{WSP(bf16, WS_QLAT), WSP(bf16, WS_KVLAT), WSP(bf16, WS_UM), WSP(bf16, WS_OPRE), WSP(bf16, WS_GA), WSP(bf16, WS_GM), WSP(float, WS_SMALL)};
                pg8::gemm_phase<EpiProj, pg8::StaticOrder, true, true>(lds + RING_OFF, g, S, E, tidq);
            }
        }
        SEAM(P + 1);
        if (IN(P + 2)) REPS(3) { PH_BEGIN(lv);
            rowpass_mid(WSP(bf16, WS_QLAT), WSP(bf16, WS_KVLAT), WSP(float, WS_SMALL), (G == 256) ? WSP(float, WS_SMALLP) : (const float*)nullptr, WSP(float, WS_COS), WSP(float, WS_SIN), WSP(bf16, WS_UM), INP(I_CONVW) + l * 4 * 512, INP(I_CONVB) + l * 512,
                        INP(I_BI) + l * 4, INP(I_BF) + l * 4, WSP(float, WS_RQ), WSP(float, WS_RKV), WSP(bf16, WS_K), WSP(float, WS_LOGI), WSP(float, WS_LOGF), WSP(bf16, WS_CONV), gw, NGW, lane); }
        SEAM(P + 2);
        if (IN(P + 3)) REPS(4) {
            { PH_BEGIN(lv); pg8::Gemm g{WSP(bf16, WS_QLAT), (const bf16*)(WL() + WO_WQ), T, 768, 768}; pg8::StaticOrder S; S.init(T, 768, G, bx);
              EpiQ E{WSP(bf16, WS_Q), WSP(float, WS_RQ), WSP(float, WS_COS), WSP(float, WS_SIN)}; pg8::gemm_phase<EpiQ, pg8::StaticOrder, true, true>(lds + RING_OFF, g, S, E, tidq); }
            { PH_BEGIN(lv); pg8::Gemm g{WSP(bf16, WS_KVLAT), (const bf16*)(WL() + WO_WKV), T, 1024, 256}; pg8::StaticOrder S; S.init(T, 1024, G, bx);
              EpiKV E{WSP(bf16, WS_K), WSP(bf16, WS_V), WSP(float, WS_RKV)}; pg8::gemm_phase<EpiKV, pg8::StaticOrder, true, true>(lds + RING_OFF, g, S, E, tidq); }
            { PH_BEGIN(lv); pg8::Gemm g{WSP(bf16, WS_CONV), (const bf16*)(WL() + WO_WQK), T, 1024, 512}; pg8::StaticOrder S; S.init(T, 1024, G, bx);
              pg8::EpiBf16<0> E{WSP(bf16, WS_QKM), 1024, nullptr, 0, 0, 1.f}; pg8::gemm_phase<pg8::EpiBf16<0>, pg8::StaticOrder, true, true>(lds + RING_OFF, g, S, E, tidq); }
            { PH_BEGIN(lv); pg8::Gemm g{WSP(bf16, WS_UM), (const bf16*)(WL() + WO_WV), T, 512, 512}; pg8::StaticOrder S;
              if (G == 256) S.init(T, 512, 64, bx >= 192 ? bx - 192 : (1 << 20)); else S.init(T, 512, G, bx);
              pg8::EpiBf16<0> E{WSP(bf16, WS_VM), 512, nullptr, 0, 0, 1.f}; pg8::gemm_phase<pg8::EpiBf16<0>, pg8::StaticOrder, true, true>(lds + RING_OFF, g, S, E, tidq); }
        }
        SEAM(P + 3);
        if (IN(P + 4)) {
            REPS(5) { PH_BEGIN(lv); attn_mfma(WSP(bf16, WS_Q), WSP(bf16, WS_K), WSP(bf16, WS_V), WSP(bf16, WS_AO), lds + RING_OFF, bx, G, tidq); __syncthreads(); }
            REPS(6) { PH_BEGIN(lv); mlstm_mfma(WSP(bf16, WS_QKM), WSP(bf16, WS_VM), WSP(float, WS_LOGI), WSP(float, WS_LOGF), WSP(bf16, WS_CONV), WSP(bf16, WS_OPRE), INP(I_MHG) + l * 512, INP(I_MSKIP) + l * 512,
                          WSP(bf16, WS_OUTM), lds + RING_OFF, bx, G, tidq); }
        }
        SEAM(P + 4);
        if (IN(P + 5)) REPS(7) {
            { PH_BEGIN(lv); pg8::Gemm g{WSP(bf16, WS_AO), (const bf16*)(WL() + WO_WA), T, 1024, 512}; pg8::StaticOrder S; S.init(T, 1024, G, bx);
              EpiMerge E{WSP(bf16, WS_MERGED), WSP(bf16, WS_GA), 1}; pg8::gemm_phase<EpiMerge, pg8::StaticOrder, true, true>(lds + RING_OFF, g, S, E, tidq); }
            { PH_BEGIN(lv); pg8::Gemm g{WSP(bf16, WS_OUTM), (const bf16*)(WL() + WO_WM), T, 1024, 512}; pg8::StaticOrder S; S.init(T, 1024, G, bx);
              EpiMerge E{WSP(bf16, WS_MERGED), WSP(bf16, WS_GM), 0}; pg8::gemm_phase<EpiMerge, pg8::StaticOrder, true, true>(lds + RING_OFF, g, S, E, tidq); }
        }
        SEAM(P + 5);
        if (IN(P + 6)) REPS(8) { PH_BEGIN(lv);
            pg8::Gemm g{WSP(bf16, WS_MERGED), (const bf16*)(WL() + WO_WO), T, 1024, 1024}; pg8::StaticOrder S; S.init(T, 1024, G, bx);
            EpiResid E{XIN(), WSP(float, WS_X), ADAL() + 2048}; pg8::gemm_phase<EpiResid, pg8::StaticOrder, true, true>(lds + RING_OFF, g, S, E, tidq);
        }
        SEAM(P + 6);
        if (IN(P + 7)) REPS(1) { PH_BEGIN(lv); rowpass_norm_mod(WSP(float, WS_X), INP(I_N2G) + l * D, ADAL() + 3072, ADAL() + 4096, WSP(bf16, WS_H), gw, NGW, lane, ws + WS_H8, WSP(float, WS_XS)); }
        SEAM(P + 7);
        if (IN(P + 8)) REPS(9) { PH_BEGIN(lv);
            pg8::Gemm g{WSP(bf16, WS_H), (const bf16*)(WL() + WO_PWQ), T, 1024, 1024}; pg8::StaticOrder S; S.init(T, 1024, G, bx);
            pg8::EpiBf16<0> E{WSP(bf16, WS_PQ), 1024, nullptr, 0, 0, 1.f}; pg8::gemm_phase<pg8::EpiBf16<0>, pg8::StaticOrder, true, true>(lds + RING_OFF, g, S, E, tidq);
        }
        SEAM(P + 8);
        if (IN(P + 9)) REPS(10) { PH_BEGIN(lv);
            peer_route(WSP(bf16, WS_PQ), (const bf16*)(WL() + WO_KEYB), WSP(int, WS_IDX), WSP(float, WS_GATE), lds + RING_OFF, bx, G, tidq); }
        SEAM(P + 9);
        if (IN(P + 10)) REPS(12) { PH_BEGIN(lv);
            int vx, rank, nb; peer_partition((const unsigned*)(ws + WS_CTL) + CW_XC, MISC, bx, G, vx, rank, nb);
            peer_u_i8(ws + WS_H8, WSP(float, WS_XS), WSP(int, WS_IDX), ws + WS_U8 + (size_t)l * 32 * MiB, WSP(f32x2v, WS_USC) + l * 16384, WSP(float, WS_ACT), wscr, vx, rank, nb, tidq); }
        SEAM(P + 10);
        if (IN(P + 11)) REPS(13) { PH_BEGIN(lv);
            int vx, rank, nb; peer_partition((const unsigned*)(ws + WS_CTL) + CW_XC, MISC, bx, G, vx, rank, nb);
            peer_v(WSP(int, WS_IDX), WSP(float, WS_ACT), WSP(float, WS_GATE), ws + WS_V8 + (size_t)l * 32 * MiB, ADAL() + 5120, WSP(float, WS_X), (float*)getp(lds, 29), wscr, vx, rank, nb, tidq);
        }
        SEAM(P + 11);
    }

__global__ void __launch_bounds__(NTHREADS, 2) fwd(Args args) {
    extern __shared__ __attribute__((aligned(16))) unsigned char lds_raw[];
    LAS unsigned char* lds = (LAS unsigned char*)lds_raw;
    volatile LAS unsigned* MISC = (volatile LAS unsigned*)(lds + MISC_OFF);
    const int tid = threadIdx.x;
    const int wave_s = __builtin_amdgcn_readfirstlane(tid >> 6);
    for (int u = tid; u < (LDS_BYTES - LDSCTL_OFF) / 4; u += NTHREADS) ((LAS unsigned*)(lds + LDSCTL_OFF))[u] = 0u;
    __syncthreads();
    if (tid == 0) { LAS unsigned long long* pt = (LAS unsigned long long*)(lds + PTAB_OFF);
#pragma unroll
        for (int i = 0; i < N_INPUTS; ++i) pt[i] = (unsigned long long)args.in[i];
        pt[29] = (unsigned long long)args.out; pt[30] = (unsigned long long)args.ws; }
    __syncthreads();
    if (MK_ONE_LAUNCH) (void)xcd_barrier_post((unsigned*)(WSB() + WS_CTL) + CW_BAR, MISC + 8);
    if (MK_ONE_LAUNCH && tid == 0) { const unsigned xc = xb_xcc_id() & 7u; MISC[12] = xb_add((unsigned*)(WSB() + WS_CTL) + CW_XC + 64 * xc, 1u); MISC[13] = xc; }
    __syncthreads();
    const int lo = args.ph_lo, hi = args.ph_hi;

    if (IN(0)) REPS(0) {
        PH_BEGIN(0);
        float* ADA = (float*)(ws + ADA_OFF);
        { const float* c = INP(I_C); const float* wada = INP(I_WADA); const float* bada = INP(I_BADA);
          for (int it = bx; it < DEPTH * 96; it += G) {
            const int ll = it / 96, cg = it % 96; const int n = cg * 64 + lane;
#pragma unroll
            for (int i = 0; i < 16; ++i) { const int e = lane + 64 * i; const int bb = e >> 7, kk = e & 127; const float cv = c[bb * D + wave * 128 + kk]; wscr[e] = cv * sigm(cv); }
            LDS_WAIT();
            const float* w = wada + (size_t)ll * D * NADA + (size_t)(wave * 128) * NADA + n;
            float a[8];
#pragma unroll
            for (int bb = 0; bb < 8; ++bb) a[bb] = 0.f;
#pragma unroll 16
            for (int kk = 0; kk < 128; ++kk) { const float wv = w[(size_t)kk * NADA];
#pragma unroll
                for (int bb = 0; bb < 8; ++bb) a[bb] += wscr[bb * 128 + kk] * wv; }
#pragma unroll
            for (int bb = 0; bb < 8; ++bb) wscr[1024 + bb * 64 + lane] = a[bb];
            __syncthreads();
            { float s = 0.f;
#pragma unroll
              for (int w8 = 0; w8 < 8; ++w8) s += ((const LAS float*)(lds + RING_OFF + w8 * 16384))[1024 + wave * 64 + lane];
              ADA[((size_t)ll * 8 + wave) * NADA + n] = s + bada[ll * NADA + n]; }
            __syncthreads();
          } }
        { const int* pos = (const int*)INP(I_POS); float* COS = (float*)(ws + WS_COS); float* SIN = (float*)(ws + WS_SIN);
          for (int idx = gw * 64 + lane; idx < T * 16; idx += NGW * 64) { const int t = idx >> 4, j = idx & 15;
              const float ang = (float)pos[t] * INV_FREQ[j];
              const double rev = (double)ang * 0.15915494309189535; const float fr = (float)(rev - rint(rev));
              COS[idx] = __builtin_amdgcn_cosf(fr); SIN[idx] = __builtin_amdgcn_sinf(fr); } }
        for (int it = gw; it < DEPTH * PI_TOTAL; it += NGW) prep_item(lds, ws, wscr, it / PI_TOTAL, it % PI_TOTAL, lane);
    }
    SEAM(0);

    layer_phases<0>(lds, MISC, lo, hi, wave_s);
    layer_phases<1>(lds, MISC, lo, hi, wave_s);
    if (IN(N_PHASES - 1)) REPS(1) { PH_BEGIN(0); rowpass_final((const float*)getp(lds, 29), INP(I_FG), (float*)getp(lds, 29), gw, NGW, lane); }
#undef IN
#undef SEAM
}

extern "C" void kernel_launch(void* const* d_in, const int* in_sizes, int n_in, void* d_out, int out_size, void* d_ws, size_t ws_size, hipStream_t stream) {
    static int grid = 0;
    if (grid == 0) {
        if (n_in != N_INPUTS || in_sizes[0] != T * D || out_size != T * D || ws_size < WS_END2) {
            fprintf(stderr, "kernel_launch: unexpected shapes: n_in %d in0 %d out %d ws %zu (need %zu); nothing launched\n", n_in, n_in > 0 ? in_sizes[0] : -1, out_size, ws_size, (size_t)WS_END2); grid = -1; return; }
        int dev = 0, cus = 0, per_cu = 0;
        if (hipGetDevice(&dev) != hipSuccess || hipDeviceGetAttribute(&cus, hipDeviceAttributeMultiprocessorCount, dev) != hipSuccess) { fprintf(stderr, "kernel_launch: device query failed\n"); grid = -1; return; }
        if (hipFuncSetAttribute((const void*)fwd, hipFuncAttributeMaxDynamicSharedMemorySize, LDS_BYTES) != hipSuccess) { fprintf(stderr, "kernel_launch: hipFuncSetAttribute failed\n"); grid = -1; return; }
        if (hipOccupancyMaxActiveBlocksPerMultiprocessor(&per_cu, (const void*)fwd, NTHREADS, LDS_BYTES) != hipSuccess || per_cu < 1)
            fprintf(stderr, "kernel_launch: note: occupancy query reports %d workgroups per CU\n", per_cu);
        (void)hipGetLastError();
        grid = cus;
    }
    if (grid < 0) return;
    if (hipMemsetAsync((char*)d_ws + WS_CTL, 0, CTL_ZERO_BYTES, stream) != hipSuccess) { fprintf(stderr, "kernel_launch: memset failed\n"); return; }
    Args a{};
    for (int i = 0; i < N_INPUTS; ++i) a.in[i] = d_in[i];
    a.out = (float*)d_out; a.ws = (unsigned char*)d_ws;
#if MK_ONE_LAUNCH
    a.ph_lo = 0; a.ph_hi = N_PHASES;
    hipLaunchKernelGGL(fwd, dim3(grid), dim3(NTHREADS), LDS_BYTES, stream, a);
#else
    for (int p = 0; p < N_PHASES; ++p) { a.ph_lo = p; a.ph_hi = p + 1; hipLaunchKernelGGL(fwd, dim3(grid), dim3(NTHREADS), LDS_BYTES, stream, a); }
#endif
    const hipError_t le = hipPeekAtLastError();
    if (le != hipSuccess) fprintf(stderr, "kernel_launch: launch failed: %s\n", hipGetErrorName(le));
}
```

```cpp
#include <hip/hip_runtime.h>
#include <cstdio>
#include <cstdint>
namespace pg8 {
#define PG8_LAS __attribute__((address_space(3)))
typedef unsigned short bf16_t;
typedef short bf16x8 __attribute__((ext_vector_type(8)));
typedef float f32x4 __attribute__((ext_vector_type(4)));
typedef unsigned u32x4 __attribute__((ext_vector_type(4)));
constexpr int BM = 256, BK = 64, HALF = 128, HTB = HALF * BK * 2  , STAGE_BYTES = 8 * HTB, NXCD = 8, WGM = 8;

__host__ __device__ __forceinline__ int lds_byte(int r, int c) { const int st = (r >> 4) * 2 + (c >> 5), rr = r & 15, cc = c & 31, ob = rr * 64 + cc * 2; return st * 1024 + (ob ^ (((ob >> 9) & 1) << 5)); }
__host__ __device__ __forceinline__ void stage_rc(int b, int& R, int& C) { const int st = b / 1024, sb = b % 1024, swz = sb ^ (((sb >> 9) & 1) << 5); R = (st >> 1) * 16 + swz / 64; C = (st & 1) * 32 + (swz % 64) / 2; }
__host__ __device__ __forceinline__ int perm32(int rho) { const int n = rho >> 4, i = rho & 15; return 8 * (i >> 2) + 4 * n + (i & 3); }

struct Unit { int pm, pn; };
struct Gemm { const bf16_t* A; const bf16_t* Bt; int M, N, K; int ld = 0; };

struct StaticOrder {
    int nM, nN, nwg, G, c;
    __host__ __device__ void init(int M, int N, int G_, int c_) { nM = M / BM; nN = N / BM; nwg = nM * nN; G = G_; c = c_; }
    __host__ __device__ bool next(int i, Unit& u) const {
        const long L = (long)i * G + c; if (L >= nwg) return false;
        int wgid = (int)L; { const int q = nwg / NXCD, r = nwg % NXCD, xcd = wgid % NXCD, off = wgid / NXCD; wgid = (xcd < r ? xcd * (q + 1) : r * (q + 1) + (xcd - r) * q) + off; }
        const int nig = WGM * nN, gid = wgid / nig, fm = gid * WGM, gsz = (nM - fm) < WGM ? (nM - fm) : WGM;
        u.pm = fm + ((wgid % nig) % gsz); u.pn = (wgid % nig) / gsz; return true;
    }
    __device__ __forceinline__ void a_ready(const Unit&) const {}
    __device__ __forceinline__ void done(const Unit&) const {}
};

__device__ __forceinline__ unsigned cvt_pk_bf16(float lo, float hi) { unsigned r; asm volatile("v_cvt_pk_bf16_f32 %0, %1, %2" : "=v"(r) : "v"(lo), "v"(hi)); return r; }
typedef float f32x2 __attribute__((ext_vector_type(2)));
__device__ __forceinline__ f32x2 gelu_pk(f32x2 v) {
    const f32x2 av = __builtin_elementwise_abs(v), d = av * 0.2316418882f + 1.0f;
    f32x2 t; t.x = __builtin_amdgcn_rcpf(d.x); t.y = __builtin_amdgcn_rcpf(d.y);
    f32x2 q = t * 0.5307027145f + (-0.7265760135f); q = q * t + 0.7107068705f; q = q * t + (-0.142248368f); q = q * t + 0.127414796f; q = q * t;
    const f32x2 s = (v * v) * (-0.72134752044f);
    f32x2 e; e.x = __builtin_amdgcn_exp2f(s.x); e.y = __builtin_amdgcn_exp2f(s.y);
    const f32x2 m = v * (q * e), r = v - m;
    f32x2 o; o.x = v.x < 0.f ? m.x : r.x; o.y = v.y < 0.f ? m.y : r.y; return o;
}

template <int ACT  > struct EpiBf16 {
    static constexpr bool PERM = true, AFTER_DRAIN = false; static_assert(ACT == 0 || ACT == 1, "EpiBf16: ACT is 0 (none) or 1 (gelu_pk)");
    bf16_t* O; int ldc; const float* bias; int split_cols; size_t split_stride; float scale0;
    __device__ __forceinline__ void operator()(const f32x4 (&acc)[2][2][4][2], const Unit& u, int wr, int wc, int fr, int fq) const {
        const int row0 = u.pm * BM + wr * 64 + fr; int colt = u.pn * BM; bf16_t* base = O;
        float sc = 1.f; if (split_cols) { const int t = colt / split_cols; base += (size_t)t * split_stride; colt -= t * split_cols; if (t == 0) sc = scale0; }
        const int col0 = colt + wc * 32 + 8 * fq, bcol0 = u.pn * BM + wc * 32 + 8 * fq;
        f32x4 bv[2][2];
#pragma unroll
        for (int bj = 0; bj < 2; ++bj)
#pragma unroll
            for (int n = 0; n < 2; ++n) bv[bj][n] = bias ? *(const f32x4*)(bias + bcol0 + bj * HALF + 4 * n) : (f32x4){0.f, 0.f, 0.f, 0.f};
#pragma unroll
        for (int ai = 0; ai < 2; ++ai)
#pragma unroll
            for (int m = 0; m < 4; ++m) { bf16_t* rowp = base + (size_t)(row0 + ai * HALF + m * 16) * ldc + col0;
#pragma unroll
                for (int bj = 0; bj < 2; ++bj) { f32x4 v0 = acc[ai][bj][m][0] + bv[bj][0], v1 = acc[ai][bj][m][1] + bv[bj][1];
                    if (ACT == 1) { f32x2 a = gelu_pk((f32x2){v0[0], v0[1]}), b = gelu_pk((f32x2){v0[2], v0[3]}), c = gelu_pk((f32x2){v1[0], v1[1]}), d = gelu_pk((f32x2){v1[2], v1[3]});
                        v0 = (f32x4){a.x, a.y, b.x, b.y}; v1 = (f32x4){c.x, c.y, d.x, d.y}; }
                    v0 = v0 * sc; v1 = v1 * sc; u32x4 w; w.x = cvt_pk_bf16(v0[0], v0[1]); w.y = cvt_pk_bf16(v0[2], v0[3]); w.z = cvt_pk_bf16(v1[0], v1[1]); w.w = cvt_pk_bf16(v1[2], v1[3]);
                    *(u32x4*)(rowp + bj * HALF) = w; } }
    }
};


template <class Epi, class Sched, bool ALIGN_EPI = false, bool SP2 = false>
__device__ __forceinline__ void gemm_phase(PG8_LAS unsigned char* lds, const Gemm g, const Sched& S, const Epi& E, const int tid_in) {
    int tid_l = tid_in; asm volatile("" : "+v"(tid_l));
    const int tid = tid_l, wid = __builtin_amdgcn_readfirstlane(tid >> 6), lane = tid & 63, wr = wid >> 2, wc = wid & 3, fr = lane & 15, fq = lane >> 4;
    const int K = g.K, nt = K / BK, LD = g.ld ? g.ld : g.K;
    unsigned voffA[2], voffB[2];
#pragma unroll
    for (int i = 0; i < 2; ++i) { int R, C; stage_rc(tid * 16 + i * 8192, R, C); const int Rb = Epi::PERM ? ((R & ~31) + perm32(R & 31)) : R;
        voffA[i] = (unsigned)(R * LD + C) * 2u; voffB[i] = (unsigned)(Rb * LD + C) * 2u; }
    const size_t kstep = (size_t)(BK * 2);
    const size_t hstep = (size_t)HALF * LD * 2;
    const size_t tstep = 2 * hstep;
    const unsigned ldsw = (unsigned)wid * 1024u;
    const int aoff = lds_byte(wr * 64 + fr, fq * 8), boff = lds_byte(wc * 32 + fr, fq * 8);
#define PG8_SA(b, h) (((b) * 2 + (h)) * HTB)
#define PG8_SB(b, h) ((4 + (b) * 2 + (h)) * HTB)
#define PG8_STAGE(bufoff, gbase, voff) do { _Pragma("unroll") for (int _i = 0; _i < 2; ++_i) \
        __builtin_amdgcn_global_load_lds((const unsigned*)((const char*)(gbase) + (voff)[_i]), (PG8_LAS unsigned*)(lds + (bufoff) + ldsw + _i * 8192), 16, 0, 0); } while (0)
#define PG8_LDA(dst, b, h) do { _Pragma("unroll") for (int m = 0; m < 4; ++m) _Pragma("unroll") for (int k = 0; k < 2; ++k) dst[m][k] = *(const PG8_LAS bf16x8*)(lds + PG8_SA(b, h) + aoff + m * 2048 + k * 1024); } while (0)
#define PG8_LDB(dst, b, h) do { _Pragma("unroll") for (int n = 0; n < 2; ++n) _Pragma("unroll") for (int k = 0; k < 2; ++k) dst[n][k] = *(const PG8_LAS bf16x8*)(lds + PG8_SB(b, h) + boff + n * 2048 + k * 1024); } while (0)
#define PG8_MMA(ai, bj, At, Bt) do { __builtin_amdgcn_s_setprio(1); _Pragma("unroll") for (int m = 0; m < 4; ++m) _Pragma("unroll") for (int n = 0; n < 2; ++n) _Pragma("unroll") for (int k = 0; k < 2; ++k) \
        acc[ai][bj][m][n] = __builtin_amdgcn_mfma_f32_16x16x32_bf16(Bt[n][k], At[m][k], acc[ai][bj][m][n], 0, 0, 0); __builtin_amdgcn_s_setprio(0); } while (0)
#define PG8_WAIT_V(n) asm volatile("s_waitcnt vmcnt(" #n ")" ::: "memory")
#define PG8_WAIT_L(n) asm volatile("s_waitcnt lgkmcnt(" #n ")" ::: "memory")
#define PG8_BAR __builtin_amdgcn_s_barrier()
#define PG8_SCHED __builtin_amdgcn_sched_barrier(0)
    Unit cur, nxt; int ui = 0;
    if (!S.next(0, cur)) return;
    f32x4 acc[2][2][4][2];
#pragma unroll
    for (int a = 0; a < 2; ++a)
#pragma unroll
        for (int b = 0; b < 2; ++b)
#pragma unroll
            for (int m = 0; m < 4; ++m)
#pragma unroll
                for (int n = 0; n < 2; ++n) acc[a][b][m][n] = (f32x4){0.f, 0.f, 0.f, 0.f};
    bf16x8 At[4][2], B0[2][2], B1[2][2];
    const char* cA = (const char*)g.A + (size_t)cur.pm * tstep; const char* cB = (const char*)g.Bt + (size_t)cur.pn * tstep;
    S.a_ready(cur);
    if constexpr (SP2) {
        PG8_STAGE(PG8_SB(0, 0), cB, voffB); PG8_STAGE(PG8_SB(0, 1), cB + hstep, voffB); PG8_STAGE(PG8_SA(0, 0), cA, voffA); PG8_STAGE(PG8_SA(0, 1), cA + hstep, voffA);
        if (wr == 1) PG8_BAR;
        PG8_WAIT_V(2); PG8_BAR;
        PG8_STAGE(PG8_SB(1, 0), cB + kstep, voffB); PG8_STAGE(PG8_SA(1, 0), cA + kstep, voffA); PG8_STAGE(PG8_SB(1, 1), cB + hstep + kstep, voffB);
        PG8_WAIT_V(6); PG8_BAR;
    } else {
        PG8_STAGE(PG8_SB(0, 0), cB, voffB); PG8_STAGE(PG8_SA(0, 0), cA, voffA); PG8_STAGE(PG8_SB(0, 1), cB + hstep, voffB); PG8_STAGE(PG8_SA(0, 1), cA + hstep, voffA);
        if (wr == 1) PG8_BAR;
        PG8_WAIT_V(4); PG8_BAR;
        PG8_STAGE(PG8_SB(1, 0), cB + kstep, voffB); PG8_STAGE(PG8_SA(1, 0), cA + kstep, voffA); PG8_STAGE(PG8_SB(1, 1), cB + hstep + kstep, voffB);
        PG8_WAIT_V(6); PG8_BAR;
    }
    for (;;) {
        const bool has_next = S.next(ui + 1, nxt);
        const char* nA = has_next ? (const char*)g.A + (size_t)nxt.pm * tstep : cA; const char* nB = has_next ? (const char*)g.Bt + (size_t)nxt.pn * tstep : cB;
        for (int t = 0; t < nt; t += 2) {
            const bool last = (t == nt - 2);
            const char* a1 = cA + (size_t)(t + 1) * kstep;
            const char* a2 = last ? nA : cA + (size_t)(t + 2) * kstep; const char* b2 = last ? nB : cB + (size_t)(t + 2) * kstep;
            const char* a3 = a2 + kstep; const char* b3 = b2 + kstep;
            if (last && has_next) S.a_ready(nxt);
            if constexpr (SP2) {
            PG8_LDB(B0, 0, 0); PG8_LDB(B1, 0, 1); PG8_SCHED; PG8_LDA(At, 0, 0); PG8_STAGE(PG8_SA(1, 1), a1 + hstep, voffA);
            PG8_WAIT_V(8); PG8_WAIT_L(0); PG8_BAR; PG8_MMA(0, 0, At, B0); PG8_MMA(0, 1, At, B1); PG8_BAR; PG8_SCHED;
            PG8_LDA(At, 0, 1); PG8_STAGE(PG8_SB(0, 0), b2, voffB); PG8_STAGE(PG8_SB(0, 1), b2 + hstep, voffB); PG8_STAGE(PG8_SA(0, 0), a2, voffA);
            PG8_WAIT_V(8); PG8_WAIT_L(0); PG8_BAR; PG8_MMA(1, 0, At, B0); PG8_MMA(1, 1, At, B1); PG8_BAR; PG8_SCHED;
            PG8_LDB(B0, 1, 0); PG8_LDB(B1, 1, 1); PG8_SCHED; PG8_LDA(At, 1, 0); PG8_STAGE(PG8_SA(0, 1), a2 + hstep, voffA);
            PG8_WAIT_V(8); PG8_WAIT_L(0); PG8_BAR; PG8_MMA(0, 0, At, B0); PG8_MMA(0, 1, At, B1); PG8_BAR; PG8_SCHED;
            PG8_LDA(At, 1, 1); PG8_STAGE(PG8_SB(1, 0), b3, voffB); PG8_STAGE(PG8_SB(1, 1), b3 + hstep, voffB); PG8_STAGE(PG8_SA(1, 0), a3, voffA);
            PG8_WAIT_V(8); PG8_WAIT_L(0); PG8_BAR; PG8_MMA(1, 0, At, B0); PG8_MMA(1, 1, At, B1); PG8_BAR; PG8_SCHED;
            } else {
            PG8_LDB(B0, 0, 0); PG8_SCHED; PG8_LDA(At, 0, 0); PG8_STAGE(PG8_SA(1, 1), a1 + hstep, voffA);
            PG8_WAIT_L(8); PG8_BAR; PG8_WAIT_L(0); PG8_MMA(0, 0, At, B0); PG8_BAR; PG8_SCHED;
            PG8_LDB(B1, 0, 1); PG8_STAGE(PG8_SB(0, 0), b2, voffB);
            PG8_BAR; PG8_WAIT_L(0); PG8_MMA(0, 1, At, B1); PG8_BAR;
            PG8_LDA(At, 0, 1); PG8_STAGE(PG8_SA(0, 0), a2, voffA);
            PG8_BAR; PG8_WAIT_L(0); PG8_MMA(1, 0, At, B0); PG8_BAR; PG8_SCHED;
            PG8_STAGE(PG8_SB(0, 1), b2 + hstep, voffB);
            PG8_WAIT_V(6); PG8_BAR; PG8_MMA(1, 1, At, B1); PG8_BAR;
            PG8_LDB(B0, 1, 0); PG8_SCHED; PG8_LDA(At, 1, 0); PG8_STAGE(PG8_SA(0, 1), a2 + hstep, voffA);
            PG8_WAIT_L(8); PG8_BAR; PG8_WAIT_L(0); PG8_MMA(0, 0, At, B0); PG8_BAR; PG8_SCHED;
            PG8_LDB(B1, 1, 1); PG8_STAGE(PG8_SB(1, 0), b3, voffB);
            PG8_BAR; PG8_WAIT_L(0); PG8_MMA(0, 1, At, B1); PG8_BAR;
            PG8_LDA(At, 1, 1); PG8_STAGE(PG8_SA(1, 0), a3, voffA);
            PG8_BAR; PG8_WAIT_L(0); PG8_MMA(1, 0, At, B0); PG8_BAR; PG8_SCHED;
            PG8_STAGE(PG8_SB(1, 1), b3 + hstep, voffB);
            PG8_WAIT_V(6); PG8_BAR; PG8_MMA(1, 1, At, B1); PG8_BAR;
            }
        }
        if constexpr (ALIGN_EPI) { if (wr == 0) PG8_BAR; }
        if constexpr (!Epi::AFTER_DRAIN) { E(acc, cur, wr, wc, fr, fq); S.done(cur); }
        if (!has_next) break;
#pragma unroll
        for (int a = 0; a < 2; ++a)
#pragma unroll
            for (int b = 0; b < 2; ++b)
#pragma unroll
                for (int m = 0; m < 4; ++m)
#pragma unroll
                    for (int n = 0; n < 2; ++n) acc[a][b][m][n] = (f32x4){0.f, 0.f, 0.f, 0.f};
        cur = nxt; cA = nA; cB = nB; ++ui;
        if constexpr (ALIGN_EPI) { if (wr == 1) PG8_BAR; }
    }
    PG8_WAIT_V(0);
    if constexpr (!ALIGN_EPI) { if (wr == 0) PG8_BAR; }
    PG8_BAR;
    if constexpr (Epi::AFTER_DRAIN) { E.fused(acc, cur, wr, wc, fr, fq, lds, wid, lane); S.done(cur); }
#undef PG8_SA
#undef PG8_SB
#undef PG8_STAGE
#undef PG8_LDA
#undef PG8_LDB
#undef PG8_MMA
#undef PG8_WAIT_V
#undef PG8_WAIT_L
#undef PG8_BAR
#undef PG8_SCHED
}
}
#define GAS __attribute__((address_space(1)))
#define LAS __attribute__((address_space(3)))
typedef unsigned short bf16;
typedef unsigned v4u __attribute__((ext_vector_type(4)));
typedef float f32x4 __attribute__((ext_vector_type(4)));
typedef short bf16x8 __attribute__((ext_vector_type(8)));
typedef GAS unsigned gu32;
typedef GAS unsigned long long gu64;
#define RLX_AGENT __ATOMIC_RELAXED, __HIP_MEMORY_SCOPE_AGENT
#define LDS_WAIT() asm volatile("s_waitcnt lgkmcnt(0)" ::: "memory")
#define VM_WAIT() asm volatile("s_waitcnt vmcnt(0)" ::: "memory")
__device__ __forceinline__ unsigned long long rt() { return __builtin_amdgcn_s_memrealtime(); }
__device__ __forceinline__ unsigned f2bf(float f) { unsigned u = __builtin_bit_cast(unsigned, f); return (u + 0x7fffu + ((u >> 16) & 1u)) >> 16; }
__device__ __forceinline__ unsigned pk2(float lo, float hi) { return f2bf(lo) | (f2bf(hi) << 16); }

#define XB_TMO      128
#define XB_XCNT(j)  (256  + 64 * (j))
#define XB_XSUB(j)  (1280 + 64 * (j))
#define XB_XGEN(j)  (2304 + 64 * (j))
#define XB_TOP      3328
#define XB_TOPGEN   3392
#define XCD_BAR_WORDS 3456
#define XB_SPIN_CAP (1u << 18)

__device__ __forceinline__ unsigned xb_ld(unsigned* p)              { return __hip_atomic_load(p, __ATOMIC_RELAXED, __HIP_MEMORY_SCOPE_AGENT); }
__device__ __forceinline__ unsigned xb_add(unsigned* p, unsigned v) { return __hip_atomic_fetch_add(p, v, __ATOMIC_RELAXED, __HIP_MEMORY_SCOPE_AGENT); }
__device__ __forceinline__ unsigned xb_xcc_id() { return (unsigned)__builtin_amdgcn_s_getreg((3 << 11) | 20) & 0xFu; }
#define XB_SPIN(cond, bar) do { unsigned _sp = 0; while (cond) { __builtin_amdgcn_s_sleep(1); \
    if ((++_sp & 255u) == 0u) { if (xb_ld(&(bar)[XB_TMO])) break; if (_sp > XB_SPIN_CAP) { atomicAdd(&(bar)[XB_TMO], 1u); break; } } } } while (0)

struct XcdBarrier {
    unsigned* bar; unsigned x;
    volatile LAS unsigned* st;
};

__device__ __forceinline__ XcdBarrier xcd_barrier_post(unsigned* bar, volatile LAS unsigned* st) {
    XcdBarrier b; b.bar = bar; b.x = xb_xcc_id(); b.st = st;
    if (threadIdx.x == 0) (void)xb_add(&bar[XB_XCNT(b.x)], 1u);
    return b;
}
__device__ __forceinline__ void xcd_barrier_complete(unsigned* bar, unsigned x, unsigned& nloc, unsigned& nx) {
    const unsigned G = gridDim.x * gridDim.y * gridDim.z;
    unsigned sum, cnt, mine, sp = 0u;
    for (;;) {
        sum = 0u; cnt = 0u; mine = 0u;
#pragma unroll
        for (unsigned j = 0; j < 16; ++j) { const unsigned c = xb_ld(&bar[XB_XCNT(j)]); sum += c; cnt += (c > 0u) ? 1u : 0u; mine = (j == x) ? c : mine; }
        if (sum == G) break;
        __builtin_amdgcn_s_sleep(1);
        if ((++sp & 255u) == 0u) { if (xb_ld(&bar[XB_TMO])) break; if (sp > XB_SPIN_CAP) { atomicAdd(&bar[XB_TMO], 1u); break; } }
    }
    nloc = mine > 0u ? mine : 1u; nx = cnt > 0u ? cnt : 1u;
}

__device__ __forceinline__ void xcd_barrier(const XcdBarrier& b, const int tid_in) {
    asm volatile("s_waitcnt vmcnt(0)" ::: "memory");
    __syncthreads();
    if (tid_in == 0) {
        unsigned* bar = b.bar;
        __builtin_amdgcn_s_waitcnt(0);
        unsigned nloc = b.st[0], nx = b.st[1];
        if (nloc == 0u) { xcd_barrier_complete(bar, b.x, nloc, nx); b.st[0] = nloc; b.st[1] = nx; }
        const unsigned old = xb_add(&bar[XB_XSUB(b.x)], 1u);
        const unsigned gen = old / nloc;
        if (old + 1u == (gen + 1u) * nloc) {
            __builtin_amdgcn_fence(__ATOMIC_RELEASE, "agent");
            asm volatile("s_waitcnt vmcnt(0)" ::: "memory");
            const unsigned og = xb_add(&bar[XB_TOP], 1u);
            const unsigned tg = og / nx;
            if (og + 1u == (tg + 1u) * nx) xb_add(&bar[XB_TOPGEN], 1u);
            else XB_SPIN(xb_ld(&bar[XB_TOPGEN]) == tg, bar);
            __builtin_amdgcn_fence(__ATOMIC_ACQUIRE, "agent");
            xb_add(&bar[XB_XGEN(b.x)], 1u);
            asm volatile("s_waitcnt vmcnt(0)" ::: "memory");
        } else {
            XB_SPIN(xb_ld(&bar[XB_XGEN(b.x)]) == gen, bar);
            __builtin_amdgcn_fence(__ATOMIC_ACQUIRE, "agent");
            asm volatile("s_waitcnt vmcnt(0)" ::: "memory");
        }
    }
    __syncthreads();
}

#ifndef MK_ONE_LAUNCH
#define MK_ONE_LAUNCH 1
#endif
#ifndef PROBE_REP_MASK
#define PROBE_REP_MASK 0
#endif
#define REPS(bit) _Pragma("unroll") for (int rep_ = 0; rep_ < ((PROBE_REP_MASK >> (bit)) & 1) + 1; ++rep_)
constexpr int NWAVES = 8, NTHREADS = NWAVES * 64;
constexpr int BATCH = 8, SEQ = 2048, T = BATCH * SEQ, D = 1024, DEPTH = 2;
constexpr int NPROJ = 4352;
constexpr int N_INPUTS = 29;
constexpr int NADA = 6144;
constexpr float RMS_EPS = 1e-6f;
constexpr float QSCALE = 0.10206207261596575f * 1.4426950408889634f;
enum { I_X = 0, I_C, I_POS, I_WADA, I_BADA, I_N1G, I_WIN, I_QNG, I_WQUP, I_KVNG, I_WKVUP, I_WBA, I_CONVW, I_CONVB, I_WQM, I_WKM, I_WVM, I_BI, I_BF, I_MHG, I_MSKIP,
       I_WBM, I_WOUT, I_N2G, I_PWQ, I_PKEYS, I_PU, I_PV, I_FG };

constexpr size_t MiB = 1u << 20;
constexpr size_t WS_CTL = 0, CTL_ZERO_BYTES = 1 * MiB;
constexpr int CW_BAR = 4096;
constexpr int CW_XC = 8192;
constexpr size_t ADA_OFF = 256 * 1024;
constexpr size_t WS_COS = 1 * MiB, WS_SIN = 2 * MiB;
constexpr size_t WS_W = 3 * MiB, W_LAYER = 18 * MiB;
constexpr size_t WO_WIN = 0, WO_WQ = 8912896, WO_WKV = WO_WQ + 1179648, WO_WA = WO_WKV + 524288, WO_WM = WO_WA + 1048576, WO_WO = WO_WM + 1048576,
                 WO_PWQ = WO_WO + 2097152, WO_WQK = WO_PWQ + 2097152, WO_WV = WO_WQK + 1048576, WO_KEYB = WO_WV + 524288;
static_assert(WO_KEYB + 262144 <= W_LAYER, "weights fit");
constexpr size_t WS_X = 40 * MiB, WS_H = 104 * MiB, WS_QLAT = 136 * MiB, WS_KVLAT = 160 * MiB, WS_UM = 168 * MiB, WS_OPRE = 184 * MiB, WS_GA = 200 * MiB, WS_GM = 232 * MiB,
                 WS_SMALL = 264 * MiB, WS_RQ = 268 * MiB, WS_RKV = WS_RQ + 65536, WS_LOGI = WS_RQ + 262144, WS_LOGF = WS_RQ + 524288, WS_Q = 269 * MiB, WS_K = 293 * MiB,
                 WS_V = 317 * MiB, WS_CONV = 333 * MiB, WS_QKM = 349 * MiB, WS_VM = 381 * MiB, WS_AO = 397 * MiB, WS_OUTM = 413 * MiB, WS_U8 = 429 * MiB, WS_V8 = 445 * MiB, WS_END = 493 * MiB;
constexpr size_t WS_H8 = 493 * MiB, WS_XS = WS_RQ + 131072, WS_USC = WS_RQ + 786432;
constexpr size_t WS_END2 = 509 * MiB;
constexpr size_t WS_IDX = WS_UM, WS_GATE = WS_UM + 8 * MiB, WS_ACT = WS_OPRE;
constexpr size_t WS_SMALLP = WS_OUTM;
constexpr size_t WS_PQ = WS_QLAT, WS_MERGED = WS_QLAT;

constexpr int RING_OFF = 0, RING_BYTES = 131072;
constexpr int LDSCTL_OFF = RING_BYTES, MISC_OFF = LDSCTL_OFF + 320;
constexpr int LDS_BYTES = 147456;

typedef float f32x2v __attribute__((ext_vector_type(2)));
typedef unsigned u32x2 __attribute__((ext_vector_type(2)));

__device__ __forceinline__ float wave_sum(float v) {
#pragma unroll
    for (int o = 1; o < 64; o <<= 1) v += __shfl_xor(v, o);
    return v;
}
__device__ __forceinline__ float bflo(unsigned u) { return __uint_as_float(u << 16); }
__device__ __forceinline__ float bfhi(unsigned u) { return __uint_as_float(u & 0xffff0000u); }
__device__ __forceinline__ float sigm(float x) { return 1.f / (1.f + __expf(-x)); }
__device__ __forceinline__ float dot4(f32x4 a, f32x4 b) { return (a.x * b.x + a.y * b.y) + (a.z * b.z + a.w * b.w); }
__device__ __forceinline__ float gelu_erf(float x) { return 0.5f * x * (1.f + erff(x * 0.70710678118654752f)); }

struct EpiProj {
    static constexpr bool PERM = true, AFTER_DRAIN = false;
    bf16 *qlat, *kvlat, *um, *opre, *ga, *gm; float* small;
    __device__ __forceinline__ void operator()(const f32x4 (&acc)[2][2][4][2], const pg8::Unit& u, int wr, int wc, int fr, int fq) const {
        const int pn = u.pn; bf16* dst; int ld, cb; int mode = 0;
        if (pn < 3) { dst = qlat; ld = 768; cb = pn * 256; }
        else if (pn == 3) { dst = kvlat; ld = 256; cb = 0; }
        else if (pn < 6) { dst = um; ld = 512; cb = (pn - 4) * 256; }
        else if (pn < 8) { dst = opre; ld = 512; cb = (pn - 6) * 256; }
        else if (pn < 12) { dst = ga; ld = 1024; cb = (pn - 8) * 256; mode = 1; }
        else if (pn < 16) { dst = gm; ld = 1024; cb = (pn - 12) * 256; mode = 1; }
        else { dst = nullptr; ld = 0; cb = 0; mode = 2; }
        const int row0 = u.pm * 256 + wr * 64 + fr;
        if (mode == 2) {
            if (wc < 2) {
#pragma unroll
                for (int ai = 0; ai < 2; ++ai)
#pragma unroll
                    for (int m = 0; m < 4; ++m) { float* p = small + (size_t)(row0 + ai * 128 + m * 16) * 64 + wc * 32 + 8 * fq;
                        *(f32x4*)p = acc[ai][0][m][0]; *(f32x4*)(p + 4) = acc[ai][0][m][1]; }
            }
        } else {
#pragma unroll
            for (int ai = 0; ai < 2; ++ai)
#pragma unroll
                for (int m = 0; m < 4; ++m) { bf16* rowp = dst + (size_t)(row0 + ai * 128 + m * 16) * ld + cb + wc * 32 + 8 * fq;
#pragma unroll
                    for (int bj = 0; bj < 2; ++bj) { f32x4 v0 = acc[ai][bj][m][0], v1 = acc[ai][bj][m][1];
                        if (mode == 1) { v0 = (f32x4){sigm(v0[0]), sigm(v0[1]), sigm(v0[2]), sigm(v0[3])}; v1 = (f32x4){sigm(v1[0]), sigm(v1[1]), sigm(v1[2]), sigm(v1[3])}; }
                        v4u w; w.x = pk2(v0[0], v0[1]); w.y = pk2(v0[2], v0[3]); w.z = pk2(v1[0], v1[1]); w.w = pk2(v1[2], v1[3]);
                        *(v4u*)(rowp + bj * 128) = w; } }
        }
    }
};
struct EpiSmallPart {
    static constexpr bool PERM = true, AFTER_DRAIN = false;
    float* part;
    __device__ __forceinline__ void operator()(const f32x4 (&acc)[2][2][4][2], const pg8::Unit& u, int wr, int wc, int fr, int fq) const {
        if (wc >= 2) return;
        const int row0 = u.pm * 256 + wr * 64 + fr;
#pragma unroll
        for (int ai = 0; ai < 2; ++ai)
#pragma unroll
            for (int m = 0; m < 4; ++m) { float* p = part + (size_t)(row0 + ai * 128 + m * 16) * 64 + wc * 32 + 8 * fq;
                *(f32x4*)p = acc[ai][0][m][0]; *(f32x4*)(p + 4) = acc[ai][0][m][1]; }
    }
};
struct EpiQ {
    static constexpr bool PERM = true, AFTER_DRAIN = false;
    bf16* Q; const float* rq; const float* cosT; const float* sinT;
    __device__ __forceinline__ void operator()(const f32x4 (&acc)[2][2][4][2], const pg8::Unit& u, int wr, int wc, int fr, int fq) const {
        const int row0 = u.pm * 256 + wr * 64 + fr;
        int c0b[2], d0b[2];
#pragma unroll
        for (int bj = 0; bj < 2; ++bj) { c0b[bj] = u.pn * 256 + bj * 128 + wc * 32 + 8 * fq; d0b[bj] = c0b[bj] % 96; }
#pragma unroll
        for (int ai = 0; ai < 2; ++ai) {
            float rr[4]; f32x4 csv[4][2], snv[4][2];
#pragma unroll
            for (int m = 0; m < 4; ++m) { const int row = row0 + ai * 128 + m * 16; rr[m] = rq[row];
#pragma unroll
                for (int bj = 0; bj < 2; ++bj) { csv[m][bj] = (f32x4){1.f, 1.f, 1.f, 1.f}; snv[m][bj] = (f32x4){0.f, 0.f, 0.f, 0.f};
                    if (d0b[bj] >= 64) { const int j0 = (d0b[bj] - 64) >> 1; csv[m][bj] = *(const f32x4*)(cosT + (size_t)row * 16 + j0); snv[m][bj] = *(const f32x4*)(sinT + (size_t)row * 16 + j0); } } }
            __builtin_amdgcn_sched_barrier(0);
#pragma unroll
            for (int m = 0; m < 4; ++m) { const int row = row0 + ai * 128 + m * 16; const float r = rr[m];
#pragma unroll
                for (int bj = 0; bj < 2; ++bj) {
                    f32x4 v0 = acc[ai][bj][m][0] * r, v1 = acc[ai][bj][m][1] * r;
                    if (d0b[bj] >= 64) { const f32x4 cs = csv[m][bj], sn = snv[m][bj]; const f32x4 a0 = v0, a1 = v1;
                        v0[0] = a0[0] * cs[0] - a0[1] * sn[0]; v0[1] = a0[1] * cs[0] + a0[0] * sn[0];
                        v0[2] = a0[2] * cs[1] - a0[3] * sn[1]; v0[3] = a0[3] * cs[1] + a0[2] * sn[1];
                        v1[0] = a1[0] * cs[2] - a1[1] * sn[2]; v1[1] = a1[1] * cs[2] + a1[0] * sn[2];
                        v1[2] = a1[2] * cs[3] - a1[3] * sn[3]; v1[3] = a1[3] * cs[3] + a1[2] * sn[3]; }
                    v4u w; w.x = pk2(v0[0], v0[1]); w.y = pk2(v0[2], v0[3]); w.z = pk2(v1[0], v1[1]); w.w = pk2(v1[2], v1[3]);
                    *(v4u*)(Q + (size_t)row * 768 + c0b[bj]) = w; } }
        }
    }
};
struct EpiKV {
    static constexpr bool PERM = true, AFTER_DRAIN = false;
    bf16* K; bf16* V; const float* rkv;
    __device__ __forceinline__ void operator()(const f32x4 (&acc)[2][2][4][2], const pg8::Unit& u, int wr, int wc, int fr, int fq) const {
        const int row0 = u.pm * 256 + wr * 64 + fr;
        float rr[2][4];
#pragma unroll
        for (int ai = 0; ai < 2; ++ai)
#pragma unroll
            for (int m = 0; m < 4; ++m) rr[ai][m] = rkv[row0 + ai * 128 + m * 16];
#pragma unroll
        for (int ai = 0; ai < 2; ++ai)
#pragma unroll
            for (int m = 0; m < 4; ++m) { const int row = row0 + ai * 128 + m * 16; const float r = rr[ai][m];
#pragma unroll
                for (int bj = 0; bj < 2; ++bj) { const int c0 = u.pn * 256 + bj * 128 + wc * 32 + 8 * fq;
                    const f32x4 v0 = acc[ai][bj][m][0] * r, v1 = acc[ai][bj][m][1] * r;
                    bf16* dst = (c0 < 512) ? (K + (size_t)row * 768 + 96 * (c0 >> 6) + (c0 & 63)) : (V + (size_t)row * 512 + (c0 - 512));
                    v4u w; w.x = pk2(v0[0], v0[1]); w.y = pk2(v0[2], v0[3]); w.z = pk2(v1[0], v1[1]); w.w = pk2(v1[2], v1[3]);
                    *(v4u*)dst = w; } }
    }
};
struct EpiMerge {
    static constexpr bool PERM = true, AFTER_DRAIN = false;
    bf16* Mg; const bf16* gate; int first;
    __device__ __forceinline__ void operator()(const f32x4 (&acc)[2][2][4][2], const pg8::Unit& u, int wr, int wc, int fr, int fq) const {
        const int row0 = u.pm * 256 + wr * 64 + fr, cbase = u.pn * 256 + wc * 32 + 8 * fq;
#pragma unroll
        for (int ai = 0; ai < 2; ++ai) {
            v4u gq[4][2], oq[4][2];
#pragma unroll
            for (int m = 0; m < 4; ++m)
#pragma unroll
                for (int bj = 0; bj < 2; ++bj) { const size_t off = (size_t)(row0 + ai * 128 + m * 16) * 1024 + cbase + bj * 128;
                    gq[m][bj] = *(const v4u*)(gate + off); oq[m][bj] = first ? (v4u){0u, 0u, 0u, 0u} : *(const v4u*)(Mg + off); }
            __builtin_amdgcn_sched_barrier(0);
#pragma unroll
            for (int m = 0; m < 4; ++m)
#pragma unroll
                for (int bj = 0; bj < 2; ++bj) { const size_t off = (size_t)(row0 + ai * 128 + m * 16) * 1024 + cbase + bj * 128;
                    const v4u g = gq[m][bj], o = oq[m][bj];
                    f32x4 v0 = acc[ai][bj][m][0], v1 = acc[ai][bj][m][1];
                    v0[0] = v0[0] * bflo(g.x) + bflo(o.x); v0[1] = v0[1] * bfhi(g.x) + bfhi(o.x); v0[2] = v0[2] * bflo(g.y) + bflo(o.y); v0[3] = v0[3] * bfhi(g.y) + bfhi(o.y);
                    v1[0] = v1[0] * bflo(g.z) + bflo(o.z); v1[1] = v1[1] * bfhi(g.z) + bfhi(o.z); v1[2] = v1[2] * bflo(g.w) + bflo(o.w); v1[3] = v1[3] * bfhi(g.w) + bfhi(o.w);
                    v4u w; w.x = pk2(v0[0], v0[1]); w.y = pk2(v0[2], v0[3]); w.z = pk2(v1[0], v1[1]); w.w = pk2(v1[2], v1[3]);
                    *(v4u*)(Mg + off) = w; }
        }
    }
};
struct EpiResid {
    static constexpr bool PERM = true, AFTER_DRAIN = false;
    const float* xin; float* xout; const float* gate;
    __device__ __forceinline__ void operator()(const f32x4 (&acc)[2][2][4][2], const pg8::Unit& u, int wr, int wc, int fr, int fq) const {
        const int row0 = u.pm * 256 + wr * 64 + fr, b = (u.pm * 256) >> 11, cbase = u.pn * 256 + wc * 32 + 8 * fq;
        f32x4 gv[2][2];
#pragma unroll
        for (int bj = 0; bj < 2; ++bj) { const float* gp = gate + (size_t)b * NADA + cbase + bj * 128; gv[bj][0] = *(const f32x4*)gp; gv[bj][1] = *(const f32x4*)(gp + 4); }
#pragma unroll
        for (int ai = 0; ai < 2; ++ai) {
            f32x4 xv[4][2][2];
#pragma unroll
            for (int m = 0; m < 4; ++m)
#pragma unroll
                for (int bj = 0; bj < 2; ++bj) { const size_t off = (size_t)(row0 + ai * 128 + m * 16) * 1024 + cbase + bj * 128; xv[m][bj][0] = *(const f32x4*)(xin + off); xv[m][bj][1] = *(const f32x4*)(xin + off + 4); }
            __builtin_amdgcn_sched_barrier(0);
#pragma unroll
            for (int m = 0; m < 4; ++m)
#pragma unroll
                for (int bj = 0; bj < 2; ++bj) { const size_t off = (size_t)(row0 + ai * 128 + m * 16) * 1024 + cbase + bj * 128;
                    *(f32x4*)(xout + off) = xv[m][bj][0] + gv[bj][0] * acc[ai][bj][m][0]; *(f32x4*)(xout + off + 4) = xv[m][bj][1] + gv[bj][1] * acc[ai][bj][m][1]; }
        }
    }
};

template <class Get> __device__ __forceinline__ void prep_tile(const Get& get, bf16* dst, int K, int k0, int n0, LAS float* scr, int lane) {
    float tv[32];
#pragma unroll
    for (int i = 0; i < 32; ++i) tv[i] = get(k0 + 2 * i + (lane >> 5), n0 + (lane & 31));
#pragma unroll
    for (int i = 0; i < 32; ++i) { const int kk = 2 * i + (lane >> 5); scr[kk * 33 + (lane & 31)] = tv[i]; }
    LDS_WAIT(); asm volatile("" ::: "memory");
    const int c = lane & 7;
#pragma unroll
    for (int j = 0; j < 4; ++j) { const int n = (lane >> 3) + 8 * j; const LAS float* s = scr + (8 * c) * 33 + n;
        v4u o; o.x = pk2(s[0 * 33], s[1 * 33]); o.y = pk2(s[2 * 33], s[3 * 33]); o.z = pk2(s[4 * 33], s[5 * 33]); o.w = pk2(s[6 * 33], s[7 * 33]);
        *(GAS v4u*)(dst + (size_t)(n0 + n) * K + k0 + 8 * c) = o; }
    LDS_WAIT(); asm volatile("" ::: "memory");
}
struct GetWin { const float* w; __device__ __forceinline__ float operator()(int k, int n) const {
    int sc; if (n < 1024) sc = n; else if (n < 2048) sc = n + 32; else if (n < 4096) sc = n + 40; else if (n < 4128) sc = n - 3072; else if (n < 4136) sc = n - 2048; else sc = -1;
    return sc < 0 ? 0.f : w[(size_t)k * 4136 + sc]; } };
struct GetWq { const float* w; const float* g; __device__ __forceinline__ float operator()(int k, int n) const {
    const int h = n / 96, dd = n % 96; const int e = dd - 64; const int sd = dd < 64 ? dd : 64 + (e >> 1) + 16 * (e & 1);
    return w[(size_t)k * 768 + h * 96 + sd] * g[k] * QSCALE; } };
struct GetWkv { const float* w; const float* g; __device__ __forceinline__ float operator()(int k, int n) const {
    const int nn = n & 511, h = nn >> 6, c = nn & 63; const int sc = h * 128 + c + ((n >= 512) ? 64 : 0);
    return w[(size_t)k * 1024 + sc] * g[k]; } };
struct GetPlain { const float* w; int N; __device__ __forceinline__ float operator()(int k, int n) const { return w[(size_t)k * N + n]; } };
struct GetWqk { const float* wq; const float* wk; __device__ __forceinline__ float operator()(int k, int n) const {
    const int part = n >> 9, nn = n & 511, h = nn >> 7, e = nn & 127, kh = k >> 7, d = k & 127;
    if (kh != h) return 0.f;
    const size_t off = ((size_t)h * 128 + d) * 128 + e;
    return part ? wk[off] * 0.08838834764831845f : wq[off]; } };
struct GetWv { const float* wv; __device__ __forceinline__ float operator()(int k, int n) const {
    const int h = n >> 7, e = n & 127, kh = k >> 7, d = k & 127;
    return (kh != h) ? 0.f : wv[((size_t)h * 128 + d) * 128 + e]; } };

__device__ const float INV_FREQ[16] = { 1.0f, 0.5623413251903491f, 0.31622776601683794f, 0.1778279410038923f, 0.1f, 0.05623413251903491f, 0.031622776601683794f, 0.01778279410038923f,
    0.01f, 0.005623413251903491f, 0.0031622776601683794f, 0.001778279410038923f, 0.001f, 0.0005623413251903491f, 0.00031622776601683794f, 0.0001778279410038923f };

__device__ __forceinline__ void rowpass_norm_mod(const float* xin, const float* g, const float* ada_shift, const float* ada_scale, bf16* hout, int gw, int NGW, int lane, unsigned char* h8 = nullptr, float* xs = nullptr) {
    f32x4 vn[4];
    if (gw < T) {
#pragma unroll
        for (int j = 0; j < 4; ++j) vn[j] = ((const f32x4*)(xin + (size_t)gw * D) + lane)[64 * j]; }
    for (int t = gw; t < T; t += NGW) {
        const int b = t >> 11;
        f32x4 v[4]; float s = 0.f;
#pragma unroll
        for (int j = 0; j < 4; ++j) { v[j] = vn[j]; s += dot4(v[j], v[j]); }
        { const int tn = (t + NGW < T) ? t + NGW : t;
#pragma unroll
          for (int j = 0; j < 4; ++j) vn[j] = ((const f32x4*)(xin + (size_t)tn * D) + lane)[64 * j]; }
        const float r = rsqrtf(wave_sum(s) * (1.f / D) + RMS_EPS);
        unsigned long long* o8 = (unsigned long long*)(hout + (size_t)t * D) + lane;
        f32x4 ov[4]; float am = 0.f;
#pragma unroll
        for (int j = 0; j < 4; ++j) { const int col = 4 * lane + 256 * j;
            const f32x4 gg = *(const f32x4*)(g + col), sc = *(const f32x4*)(ada_scale + (size_t)b * NADA + col), sh = *(const f32x4*)(ada_shift + (size_t)b * NADA + col);
            const f32x4 o = v[j] * r * gg * (sc + 1.f) + sh; ov[j] = o;
            am = fmaxf(fmaxf(am, fmaxf(fabsf(o.x), fabsf(o.y))), fmaxf(fabsf(o.z), fabsf(o.w)));
            o8[64 * j] = (unsigned long long)pk2(o.x, o.y) | ((unsigned long long)pk2(o.z, o.w) << 32); }
        if (h8) {
#pragma unroll
            for (int o = 1; o < 64; o <<= 1) am = fmaxf(am, __shfl_xor(am, o));
            const float inv = am > 0.f ? 127.f / am : 0.f;
#pragma unroll
            for (int j = 0; j < 4; ++j) { const int q0 = (int)rintf(ov[j].x * inv), q1 = (int)rintf(ov[j].y * inv), q2 = (int)rintf(ov[j].z * inv), q3 = (int)rintf(ov[j].w * inv);
                ((unsigned*)(h8 + (size_t)t * D))[lane + 64 * j] = (unsigned)(q0 & 255) | ((unsigned)(q1 & 255) << 8) | ((unsigned)(q2 & 255) << 16) | ((unsigned)(q3 & 255) << 24); }
            if (lane == 0) xs[t] = am * (1.f / 127.f);
        }
    }
}
__device__ __forceinline__ void rowpass_final(const float* xin, const float* g, float* out, int gw, int NGW, int lane) {
    f32x4 vn[4];
    if (gw < T) {
#pragma unroll
        for (int j = 0; j < 4; ++j) vn[j] = ((const f32x4*)(xin + (size_t)gw * D) + lane)[64 * j]; }
    for (int t = gw; t < T; t += NGW) {
        f32x4 v[4]; float s = 0.f;
#pragma unroll
        for (int j = 0; j < 4; ++j) { v[j] = vn[j]; s += dot4(v[j], v[j]); }
        { const int tn = (t + NGW < T) ? t + NGW : t;
#pragma unroll
          for (int j = 0; j < 4; ++j) vn[j] = ((const f32x4*)(xin + (size_t)tn * D) + lane)[64 * j]; }
        const float r = rsqrtf(wave_sum(s) * (1.f / D) + RMS_EPS);
        f32x4* o = (f32x4*)(out + (size_t)t * D) + lane;
#pragma unroll
        for (int j = 0; j < 4; ++j) { const f32x4 gg = *(const f32x4*)(g + 4 * lane + 256 * j); o[64 * j] = v[j] * r * gg; }
    }
}
__device__ __forceinline__ void rowpass_mid(const bf16* qlat, const bf16* kvlat, const float* small, const float* smallp, const float* cosT, const float* sinT, const bf16* um,
                                            const float* conv_w, const float* conv_b, const float* b_i, const float* b_f,
                                            float* RQ, float* RKV, bf16* K, float* LOGI, float* LOGF, bf16* CONV, int gw, int NGW, int lane) {
    const int c0 = 8 * lane;
    f32x4 cw[4][2], cb[2];
#pragma unroll
    for (int j = 0; j < 4; ++j) { cw[j][0] = *(const f32x4*)(conv_w + j * 512 + c0); cw[j][1] = *(const f32x4*)(conv_w + j * 512 + c0 + 4); }
    cb[0] = *(const f32x4*)(conv_b + c0); cb[1] = *(const f32x4*)(conv_b + c0 + 4);
    const float bsel = (lane >= 32 && lane < 36) ? b_i[lane - 32] : (lane >= 36 && lane < 40) ? b_f[lane - 36] : 0.f;
    for (int tb = gw * 4; tb < T; tb += NGW * 4) {
        const int pos0 = tb & (SEQ - 1);
        u32x2 qv[4][3], kvv[4]; v4u uw[7]; float sv[4], cs[4], sn[4];
#pragma unroll
        for (int i = 0; i < 4; ++i) { const int t = tb + i; const u32x2* p = (const u32x2*)(qlat + (size_t)t * 768);
#pragma unroll
            for (int j = 0; j < 3; ++j) qv[i][j] = p[lane + 64 * j];
            kvv[i] = ((const u32x2*)(kvlat + (size_t)t * 256))[lane];
            sv[i] = 0.f;
            if (lane < 40) sv[i] = smallp ? ((smallp[(size_t)t * 64 + lane] + smallp[(size_t)(T + t) * 64 + lane]) + (smallp[(size_t)(2 * T + t) * 64 + lane] + smallp[(size_t)(3 * T + t) * 64 + lane]))
                                         : small[(size_t)t * 64 + lane];
            cs[i] = 0.f; sn[i] = 0.f; if (lane < 16) { cs[i] = cosT[(size_t)t * 16 + lane]; sn[i] = sinT[(size_t)t * 16 + lane]; } }
#pragma unroll
        for (int j = 0; j < 7; ++j) { uw[j] = (v4u){0u, 0u, 0u, 0u}; if (pos0 - 3 + j >= 0) uw[j] = *(const v4u*)(um + (size_t)(tb - 3 + j) * 512 + c0); }
#pragma unroll
        for (int i = 0; i < 4; ++i) { const int t = tb + i;
            float s = 0.f;
#pragma unroll
            for (int j = 0; j < 3; ++j) { const u32x2 w = qv[i][j]; const float a = bflo(w.x), b2 = bfhi(w.x), c = bflo(w.y), d = bfhi(w.y); s += (a * a + b2 * b2) + (c * c + d * d); }
            const float rq = rsqrtf(wave_sum(s) * (1.f / 768.f) + RMS_EPS);
            const u32x2 w = kvv[i]; const float a = bflo(w.x), b2 = bfhi(w.x), c = bflo(w.y), d = bfhi(w.y);
            const float rkv = rsqrtf(wave_sum((a * a + b2 * b2) + (c * c + d * d)) * (1.f / 256.f) + RMS_EPS);
            if (lane == 0) { RQ[t] = rq; RKV[t] = rkv; }
            const float x2 = __shfl(sv[i], (lane + 16) & 63);
            if (lane < 16) { const float x1 = sv[i]; const unsigned pk = pk2(x1 * cs[i] - x2 * sn[i], x2 * cs[i] + x1 * sn[i]);
#pragma unroll
                for (int h = 0; h < 8; ++h) ((unsigned*)(K + (size_t)t * 768 + 96 * h + 64))[lane] = pk; }
            else if (lane >= 32 && lane < 36) LOGI[(size_t)t * 4 + (lane - 32)] = sv[i] + bsel;
            else if (lane >= 36 && lane < 40) { const float x = sv[i] + bsel; LOGF[(size_t)t * 4 + (lane - 36)] = fminf(x, 0.f) - log1pf(expf(-fabsf(x))); }
            float acc[8];
            acc[0] = cb[0][0]; acc[1] = cb[0][1]; acc[2] = cb[0][2]; acc[3] = cb[0][3]; acc[4] = cb[1][0]; acc[5] = cb[1][1]; acc[6] = cb[1][2]; acc[7] = cb[1][3];
#pragma unroll
            for (int j = 0; j < 4; ++j) { const v4u u4 = uw[i + j];
                acc[0] += cw[j][0][0] * bflo(u4.x); acc[1] += cw[j][0][1] * bfhi(u4.x); acc[2] += cw[j][0][2] * bflo(u4.y); acc[3] += cw[j][0][3] * bfhi(u4.y);
                acc[4] += cw[j][1][0] * bflo(u4.z); acc[5] += cw[j][1][1] * bfhi(u4.z); acc[6] += cw[j][1][2] * bflo(u4.w); acc[7] += cw[j][1][3] * bfhi(u4.w); }
#pragma unroll
            for (int q = 0; q < 8; ++q) acc[q] = acc[q] * sigm(acc[q]);
            v4u o; o.x = pk2(acc[0], acc[1]); o.y = pk2(acc[2], acc[3]); o.z = pk2(acc[4], acc[5]); o.w = pk2(acc[6], acc[7]);
            *(v4u*)(CONV + (size_t)t * 512 + c0) = o; }
    }
}

typedef float f32x16 __attribute__((ext_vector_type(16)));
typedef short s16x4 __attribute__((ext_vector_type(4)));
typedef short v4i16_t __attribute__((ext_vector_type(4)));
typedef float f32x2_t __attribute__((ext_vector_type(2))); typedef __bf16 bf16x2_t __attribute__((ext_vector_type(2)));
__device__ __forceinline__ unsigned cvtpk(float lo, float hi) { f32x2_t v = {lo, hi}; bf16x2_t b = __builtin_convertvector(v, bf16x2_t); return __builtin_bit_cast(unsigned, b); }
__device__ __forceinline__ s16x4 vtr(const LAS unsigned char* p) { return __builtin_bit_cast(s16x4, __builtin_amdgcn_ds_read_tr16_b64_v4i16((LAS v4i16_t*)p)); }
__device__ __forceinline__ bf16x8 pack8(float a0, float a1, float a2, float a3, float a4, float a5, float a6, float a7) {
    v4u p; p.x = cvtpk(a0, a1); p.y = cvtpk(a2, a3); p.z = cvtpk(a4, a5); p.w = cvtpk(a6, a7); return __builtin_bit_cast(bf16x8, p); }
#define MFMA32(a, b, c) __builtin_amdgcn_mfma_f32_32x32x16_bf16((a), (b), (c), 0, 0, 0)
constexpr int AT_KB = 12288, AT_VB = 8192;
__device__ __forceinline__ void attn_mfma(const bf16* Q, const bf16* K, const bf16* V, bf16* AO, LAS unsigned char* lds, int bx, int G, int tid) {
    const int lane = tid & 63, wave = __builtin_amdgcn_readfirstlane(tid >> 6), r = lane & 31, hh = lane >> 5;
    const int i16 = lane & 15, q4 = i16 >> 2, p4 = i16 & 3, blk = (lane >> 4) & 1;
    const int vboff = (4 * hh + q4) * 64 + 32 * blk + 8 * p4;
    const int kr0 = tid / 12, kc0 = tid % 12, kr1 = (tid + 512) / 12, kc1 = (tid + 512) % 12, vr = tid >> 3, vc = tid & 7;
    const int klds0 = (kc0 >> 1) * 2048 + (kc0 & 1) * 1024 + kr0 * 16, klds1 = (kc1 >> 1) * 2048 + (kc1 & 1) * 1024 + kr1 * 16;
    const int vlds = (vc >> 2) * 4096 + (vr >> 4) * 1024 + ((vr >> 3) & 1) * 512 + (vr & 7) * 64 + (vc & 3) * 16;
    for (int pu = bx; pu < 256; pu += G) {
        const int bh = pu >> 2, b = bh >> 3, h = bh & 7;
        const bf16* kg = K + ((size_t)b * SEQ) * 768 + h * 96; const bf16* vg = V + ((size_t)b * SEQ) * 512 + h * 64;
        for (int half = 0; half < 2; ++half) {
            const int qb = half == 0 ? 7 - (pu & 3) : (pu & 3);
            const int q0w = qb * 256 + wave * 32, nkt = 4 * (qb + 1), kmax = (q0w + 31) >> 6;
            bf16x8 qf[6];
            { const bf16* qrow = Q + ((size_t)b * SEQ + q0w + r) * 768 + h * 96 + 8 * hh;
#pragma unroll
              for (int s = 0; s < 6; ++s) qf[s] = *(const bf16x8*)(qrow + 16 * s); }
            f32x16 o0, o1;
#pragma unroll
            for (int i = 0; i < 16; ++i) { o0[i] = 0.f; o1[i] = 0.f; }
            float m = 0.f, l = 0.f; f32x16 negm;
#pragma unroll
            for (int i = 0; i < 16; ++i) negm[i] = 0.f;
            v4u ka = *(const v4u*)(kg + (size_t)kr0 * 768 + kc0 * 8), kb2 = (v4u){0u, 0u, 0u, 0u}, va = *(const v4u*)(vg + (size_t)vr * 512 + vc * 8);
            if (tid < 256) kb2 = *(const v4u*)(kg + (size_t)kr1 * 768 + kc1 * 8);
            __syncthreads();
            *(LAS v4u*)(lds + klds0) = ka; if (tid < 256) *(LAS v4u*)(lds + klds1) = kb2; *(LAS v4u*)(lds + 2 * AT_KB + vlds) = va;
            __syncthreads();
            for (int kt = 0; kt < nkt; ++kt) {
                const int buf = kt & 1;
                if (kt + 1 < nkt) { const size_t k1 = (size_t)(kt + 1) * 64;
                    ka = *(const v4u*)(kg + (k1 + kr0) * 768 + kc0 * 8); if (tid < 256) kb2 = *(const v4u*)(kg + (k1 + kr1) * 768 + kc1 * 8); va = *(const v4u*)(vg + (k1 + vr) * 512 + vc * 8); }
                if (kt <= kmax) {
                    const LAS unsigned char* kb_ = lds + buf * AT_KB + hh * 1024 + r * 16; const LAS unsigned char* vb_ = lds + 2 * AT_KB + buf * AT_VB + vboff;
                    f32x16 s0, s1;
                    { bf16x8 kf0[6], kf1[6];
#pragma unroll
                      for (int s = 0; s < 6; ++s) { kf0[s] = *(const LAS bf16x8*)(kb_ + s * 2048); kf1[s] = *(const LAS bf16x8*)(kb_ + s * 2048 + 512); }
                      __builtin_amdgcn_sched_barrier(0);
                      s0 = MFMA32(kf0[0], qf[0], negm); s1 = MFMA32(kf1[0], qf[0], negm);
#pragma unroll
                      for (int s = 1; s < 6; ++s) { s0 = MFMA32(kf0[s], qf[s], s0); s1 = MFMA32(kf1[s], qf[s], s1); } }
                    if (kt * 64 + 63 > q0w) { const int qq = q0w + r - kt * 64;
#pragma unroll
                        for (int i = 0; i < 16; ++i) { const int key = (i & 3) + 8 * (i >> 2) + 4 * hh; if (key > qq) s0[i] = -INFINITY; if (key + 32 > qq) s1[i] = -INFINITY; } }
                    float mx = fmaxf(fmaxf(s0[0], s1[0]), fmaxf(s0[1], s1[1]));
#pragma unroll
                    for (int i = 2; i < 16; i += 2) mx = fmaxf(fmaxf(mx, fmaxf(s0[i], s1[i])), fmaxf(s0[i + 1], s1[i + 1]));
                    mx = fmaxf(mx, __shfl_xor(mx, 32));
                    if (kt == 0 || __builtin_amdgcn_ballot_w64(mx > 8.f) != 0ull) {
                        const float d = (kt == 0) ? mx : fmaxf(mx, 0.f), corr = (kt == 0) ? 0.f : __builtin_amdgcn_exp2f(-d);
                        m = (kt == 0) ? mx : m + d; l *= corr;
#pragma unroll
                        for (int i = 0; i < 16; ++i) { o0[i] *= corr; o1[i] *= corr; s0[i] -= d; s1[i] -= d; negm[i] = -m; } }
                    float ps = 0.f;
#pragma unroll
                    for (int i = 0; i < 16; ++i) { s0[i] = __builtin_amdgcn_exp2f(s0[i]); s1[i] = __builtin_amdgcn_exp2f(s1[i]); ps += s0[i] + s1[i]; }
                    l += ps;
                    bf16x8 pf[4];
                    pf[0] = pack8(s0[0], s0[1], s0[2], s0[3], s0[4], s0[5], s0[6], s0[7]); pf[1] = pack8(s0[8], s0[9], s0[10], s0[11], s0[12], s0[13], s0[14], s0[15]);
                    pf[2] = pack8(s1[0], s1[1], s1[2], s1[3], s1[4], s1[5], s1[6], s1[7]); pf[3] = pack8(s1[8], s1[9], s1[10], s1[11], s1[12], s1[13], s1[14], s1[15]);
                    { s16x4 vlo[8], vhi[8];
#pragma unroll
                      for (int ks = 0; ks < 4; ++ks) { vlo[ks] = vtr(vb_ + ks * 1024); vhi[ks] = vtr(vb_ + ks * 1024 + 512); vlo[4 + ks] = vtr(vb_ + 4096 + ks * 1024); vhi[4 + ks] = vtr(vb_ + 4096 + ks * 1024 + 512); }
                      __builtin_amdgcn_sched_barrier(0);
#pragma unroll
                      for (int ks = 0; ks < 4; ++ks) {
                          const bf16x8 a0 = (bf16x8){vlo[ks][0], vlo[ks][1], vlo[ks][2], vlo[ks][3], vhi[ks][0], vhi[ks][1], vhi[ks][2], vhi[ks][3]};
                          const bf16x8 a1 = (bf16x8){vlo[4 + ks][0], vlo[4 + ks][1], vlo[4 + ks][2], vlo[4 + ks][3], vhi[4 + ks][0], vhi[4 + ks][1], vhi[4 + ks][2], vhi[4 + ks][3]};
                          o0 = MFMA32(a0, pf[ks], o0); o1 = MFMA32(a1, pf[ks], o1); } }
                }
                if (kt + 1 < nkt) { LAS unsigned char* nb = lds + (buf ^ 1) * AT_KB; *(LAS v4u*)(nb + klds0) = ka; if (tid < 256) *(LAS v4u*)(nb + klds1) = kb2; *(LAS v4u*)(lds + 2 * AT_KB + (buf ^ 1) * AT_VB + vlds) = va; }
                __syncthreads();
            }
            const float inv = 1.f / (l + __shfl_xor(l, 32));
            bf16* orow = AO + ((size_t)b * SEQ + q0w + r) * 512 + h * 64 + 4 * hh;
#pragma unroll
            for (int g = 0; g < 4; ++g) { u32x2 w0, w1; w0.x = cvtpk(o0[4 * g] * inv, o0[4 * g + 1] * inv); w0.y = cvtpk(o0[4 * g + 2] * inv, o0[4 * g + 3] * inv);
                w1.x = cvtpk(o1[4 * g] * inv, o1[4 * g + 1] * inv); w1.y = cvtpk(o1[4 * g + 2] * inv, o1[4 * g + 3] * inv);
                *(u32x2*)(orow + 8 * g) = w0; *(u32x2*)(orow + 32 + 8 * g) = w1; }
        }
    }
}


constexpr int ML_KB = 16384, ML_VB = 16384, ML_BUF = 32768, ML_TAB = 3 * 32768;
__device__ __forceinline__ void mlstm_mfma(const bf16* QKM, const bf16* VM, const float* LOGI, const float* LOGF, const bf16* CONV, const bf16* OPRE, const float* ng, const float* skip,
                                           bf16* OUTM, LAS unsigned char* lds, int bx, int G, int tid) {
    const int lane = tid & 63, wave = __builtin_amdgcn_readfirstlane(tid >> 6), r = lane & 31, hh = lane >> 5;
    const int i16 = lane & 15, q4 = i16 >> 2, p4 = i16 & 3, blk = (lane >> 4) & 1;
    const int vboff = (4 * hh + q4) * 64 + 32 * blk + 8 * p4;
    int goff[4], loff[4];
#pragma unroll
    for (int q = 0; q < 4; ++q) { const int j = 4 * wave + q;
        if (j < 16) { goff[q] = lane * 1024 + 16 * (j >> 1) + 8 * (j & 1); loff[q] = (j >> 1) * 2048 + (j & 1) * 1024; }
        else { const int jv = j - 16, dq = jv >> 2, ks = jv & 3; goff[q] = (16 * ks + 8 * (lane >> 5) + ((lane >> 2) & 7)) * 512 + 32 * dq + 8 * (lane & 3); loff[q] = ML_KB + dq * 4096 + ks * 1024; } }
    const bool kwave = wave < 4;
#define ML_DMA(tile, bufi) do { _Pragma("unroll") for (int q_ = 0; q_ < 4; ++q_) { \
        const bf16* src_ = kwave ? (kg + (size_t)(tile) * 64 * 1024 + goff[q_]) : (vg + (size_t)(tile) * 64 * 512 + goff[q_]); \
        __builtin_amdgcn_global_load_lds((const unsigned*)src_, (LAS unsigned*)(lds + (bufi) * ML_BUF + loff[q_]), 16, 0, 0); } } while (0)
    LAS float* Ftab = (LAS float*)(lds + ML_TAB); LAS float* Ctab = Ftab + 2048; LAS float* wtot = Ctab + 2048;
    constexpr float L2E = 1.4426950408889634f;
    for (int pu = bx; pu < 256; pu += G) {
        const int bh = pu >> 3, p = pu & 7, b = bh >> 2, h = bh & 3;
        __syncthreads();
        { float f4[4], i4[4];
#pragma unroll
          for (int e = 0; e < 4; ++e) { const size_t row = (size_t)b * SEQ + tid * 4 + e; f4[e] = LOGF[row * 4 + h]; i4[e] = LOGI[row * 4 + h]; }
          f4[1] += f4[0]; f4[2] += f4[1]; f4[3] += f4[2];
          float x = f4[3];
          x += __uint_as_float(__builtin_amdgcn_update_dpp(0, __float_as_uint(x), 0x111, 0xf, 0xf, true)); x += __uint_as_float(__builtin_amdgcn_update_dpp(0, __float_as_uint(x), 0x112, 0xf, 0xf, true));
          x += __uint_as_float(__builtin_amdgcn_update_dpp(0, __float_as_uint(x), 0x114, 0xf, 0xf, true)); x += __uint_as_float(__builtin_amdgcn_update_dpp(0, __float_as_uint(x), 0x118, 0xf, 0xf, true));
          { const float t0 = __uint_as_float(__builtin_amdgcn_readlane(__float_as_uint(x), 15)), t1 = __uint_as_float(__builtin_amdgcn_readlane(__float_as_uint(x), 31)), t2 = __uint_as_float(__builtin_amdgcn_readlane(__float_as_uint(x), 47));
            const int row = lane >> 4; x += (row >= 1 ? t0 : 0.f) + (row >= 2 ? t1 : 0.f) + (row >= 3 ? t2 : 0.f); }
          if (lane == 63) wtot[wave] = x;
          __syncthreads();
          float base = x - f4[3];
          for (int w = 0; w < wave; ++w) base += wtot[w];
#pragma unroll
          for (int e = 0; e < 4; ++e) { const float F = base + f4[e]; Ftab[tid * 4 + e] = F * L2E; Ctab[tid * 4 + e] = (i4[e] - F) * L2E; } }
        __syncthreads();
        const int grp = wave >> 2, w4 = wave & 3;
        const int q0w = (grp == 0 ? 128 * p : 128 * (15 - p)) + 32 * w4, kmax = (q0w + 31) >> 6, nkt = 2 * (16 - p);
        const size_t trow = (size_t)b * SEQ + q0w + r;
        bf16x8 qf[8];
        { const bf16* qrow = QKM + trow * 1024 + h * 128 + 8 * hh;
#pragma unroll
          for (int s = 0; s < 8; ++s) qf[s] = *(const bf16x8*)(qrow + 16 * s); }
        const float Ft = Ftab[q0w + r], Ft0 = Ftab[q0w];
        LAS float* wt = Ctab + 2048 + 64 + wave * 64;
        f32x16 o[4];
#pragma unroll
        for (int d = 0; d < 4; ++d)
#pragma unroll
            for (int i = 0; i < 16; ++i) o[d][i] = 0.f;
        float den = 0.f;
        const bf16* kg = QKM + ((size_t)b * SEQ) * 1024 + 512 + h * 128; const bf16* vg = VM + ((size_t)b * SEQ) * 512 + h * 128;
        ML_DMA(0, 0);
        if (nkt > 1) { ML_DMA(1, 1); asm volatile("s_waitcnt vmcnt(4)" ::: "memory"); } else asm volatile("s_waitcnt vmcnt(0)" ::: "memory");
        asm volatile("s_waitcnt lgkmcnt(0)" ::: "memory"); __builtin_amdgcn_s_barrier(); asm volatile("" ::: "memory");
        for (int kt = 0; kt < nkt; ++kt) {
            const int buf = kt % 3;
            if (kt + 2 < nkt) ML_DMA(kt + 2, (kt + 2) % 3);
            if (kt <= kmax) {
                const LAS unsigned char* kb_ = lds + buf * ML_BUF + hh * 1024 + r * 16; const LAS unsigned char* vb_ = lds + buf * ML_BUF + ML_KB + vboff;
                f32x16 s0, s1;
#pragma unroll
                for (int i = 0; i < 16; ++i) { s0[i] = 0.f; s1[i] = 0.f; }
#pragma unroll
                for (int sh = 0; sh < 2; ++sh) { bf16x8 kf0[4], kf1[4];
#pragma unroll
                  for (int s = 0; s < 4; ++s) { kf0[s] = *(const LAS bf16x8*)(kb_ + (4 * sh + s) * 2048); kf1[s] = *(const LAS bf16x8*)(kb_ + (4 * sh + s) * 2048 + 512); }
                  __builtin_amdgcn_sched_barrier(0);
#pragma unroll
                  for (int s = 0; s < 4; ++s) { s0 = MFMA32(kf0[s], qf[4 * sh + s], s0); s1 = MFMA32(kf1[s], qf[4 * sh + s], s1); } }
                const int qq = q0w + r - kt * 64;
                const bool diag = kt * 64 + 63 > q0w;
                wt[lane] = __builtin_amdgcn_exp2f(Ctab[kt * 64 + lane] + Ft0);
                LDS_WAIT();
                const LAS float* ct = wt + 4 * hh;
                float ps = 0.f;
#pragma unroll
                for (int g = 0; g < 4; ++g) { const f32x4 c0v = *(const LAS f32x4*)(ct + 8 * g), c1v = *(const LAS f32x4*)(ct + 32 + 8 * g);
#pragma unroll
                    for (int e = 0; e < 4; ++e) { const int i = 4 * g + e, key = e + 8 * g + 4 * hh;
                        float w0 = c0v[e], w1 = c1v[e];
                        if (diag) { w0 = (key <= qq) ? w0 : 0.f; w1 = (key + 32 <= qq) ? w1 : 0.f; }
                        s0[i] *= w0; s1[i] *= w1; ps += s0[i] + s1[i]; } }
                den += ps;
                bf16x8 pf[4];
                pf[0] = pack8(s0[0], s0[1], s0[2], s0[3], s0[4], s0[5], s0[6], s0[7]); pf[1] = pack8(s0[8], s0[9], s0[10], s0[11], s0[12], s0[13], s0[14], s0[15]);
                pf[2] = pack8(s1[0], s1[1], s1[2], s1[3], s1[4], s1[5], s1[6], s1[7]); pf[3] = pack8(s1[8], s1[9], s1[10], s1[11], s1[12], s1[13], s1[14], s1[15]);
#pragma unroll
                for (int ks = 0; ks < 4; ++ks) { s16x4 vlo[4], vhi[4];
#pragma unroll
                    for (int d = 0; d < 4; ++d) { vlo[d] = vtr(vb_ + d * 4096 + ks * 1024); vhi[d] = vtr(vb_ + d * 4096 + ks * 1024 + 512); }
                    __builtin_amdgcn_sched_barrier(0);
#pragma unroll
                    for (int d = 0; d < 4; ++d) { const s16x4 lo = vlo[d], hi = vhi[d];
                        const bf16x8 av = (bf16x8){lo[0], lo[1], lo[2], lo[3], hi[0], hi[1], hi[2], hi[3]};
                        o[d] = MFMA32(av, pf[ks], o[d]); } }
            }
            if (kt + 2 < nkt) asm volatile("s_waitcnt vmcnt(4)" ::: "memory"); else asm volatile("s_waitcnt vmcnt(0)" ::: "memory");
            asm volatile("s_waitcnt lgkmcnt(0)" ::: "memory"); __builtin_amdgcn_s_barrier(); asm volatile("" ::: "memory");
        }
        const float kap = __builtin_amdgcn_exp2f(Ft - Ft0);
        const float dt = (den + __shfl_xor(den, 32)) * kap;
        const float inv = kap / fmaxf(fabsf(dt), 1.f);
        float sm = 0.f;
#pragma unroll
        for (int d = 0; d < 4; ++d)
#pragma unroll
            for (int i = 0; i < 16; ++i) { o[d][i] *= inv; sm += o[d][i]; }
        sm += __shfl_xor(sm, 32);
        const float mu = sm * (1.f / 128.f);
        float vs = 0.f;
#pragma unroll
        for (int d = 0; d < 4; ++d)
#pragma unroll
            for (int i = 0; i < 16; ++i) { const float dlt = o[d][i] - mu; vs += dlt * dlt; }
        vs += __shfl_xor(vs, 32);
        const float rstd = rsqrtf(vs * (1.f / 128.f) + RMS_EPS);
#pragma unroll
        for (int d = 0; d < 4; ++d)
#pragma unroll
            for (int g = 0; g < 4; ++g) { const int ch = h * 128 + 32 * d + 8 * g + 4 * hh; const size_t off = trow * 512 + ch;
                const u32x2 cv = *(const u32x2*)(CONV + off), ov = *(const u32x2*)(OPRE + off); const f32x4 gg = *(const f32x4*)(ng + ch), sk = *(const f32x4*)(skip + ch);
                const float y0 = sigm(bflo(ov.x)) * ((o[d][4 * g] - mu) * rstd * gg[0] + sk[0] * bflo(cv.x)), y1 = sigm(bfhi(ov.x)) * ((o[d][4 * g + 1] - mu) * rstd * gg[1] + sk[1] * bfhi(cv.x));
                const float y2 = sigm(bflo(ov.y)) * ((o[d][4 * g + 2] - mu) * rstd * gg[2] + sk[2] * bflo(cv.y)), y3 = sigm(bfhi(ov.y)) * ((o[d][4 * g + 3] - mu) * rstd * gg[3] + sk[3] * bfhi(cv.y));
                u32x2 w; w.x = cvtpk(y0, y1); w.y = cvtpk(y2, y3); *(u32x2*)(OUTM + off) = w; }
    }
#undef ML_DMA
}

template <int N> __device__ __forceinline__ void bitonic_sort_desc(float (&v)[N]) {
#pragma unroll
    for (int k = 2; k <= N; k <<= 1)
#pragma unroll
        for (int j = k >> 1; j > 0; j >>= 1)
#pragma unroll
            for (int i = 0; i < N; ++i) { const int l = i ^ j; if (l > i) { const bool desc = ((i & k) == 0); const float a = v[i], b = v[l], hi = fmaxf(a, b), lo = fminf(a, b); v[i] = desc ? hi : lo; v[l] = desc ? lo : hi; } }
}
__device__ __forceinline__ void top16_merge(float (&a)[16], const float (&b)[16]) {
#pragma unroll
    for (int i = 0; i < 16; ++i) a[i] = fmaxf(a[i], b[15 - i]);
#pragma unroll
    for (int j = 8; j > 0; j >>= 1)
#pragma unroll
        for (int i = 0; i < 16; ++i) { const int l = i ^ j; if (l > i) { const float x = a[i], y = a[l]; a[i] = fmaxf(x, y); a[l] = fminf(x, y); } }
}
constexpr int PE_EIDX = 0, PE_EGATE = 16384, PE_KEYT = 32768;
__device__ __forceinline__ void peer_route(const bf16* PQ, const bf16* KEYB, int* IDX, float* GATE, LAS unsigned char* lds, int bx, int G, int tid) {
    const int lane = tid & 63, wave = __builtin_amdgcn_readfirstlane(tid >> 6), r = lane & 31, hh = lane >> 5;
    LAS unsigned char* keyt = lds + PE_KEYT + (wave * 32 + r) * 32;
    for (int grp = bx; grp < T / 32; grp += G) {
        const int t0 = grp * 32;
        { const int h = wave;
          int rq = r; asm volatile("" : "+v"(rq));
          float top[2][16];
#pragma unroll
          for (int p = 0; p < 2; ++p) {
              bf16x8 qf[4];
              { const bf16* qrow = PQ + (size_t)(t0 + rq) * 1024 + h * 128 + p * 64 + 8 * hh;
#pragma unroll
                for (int s = 0; s < 4; ++s) qf[s] = *(const bf16x8*)(qrow + 16 * s); }
              const bf16* kb = KEYB + ((size_t)(h * 2 + p) * 128 + rq) * 64 + 8 * hh;
              float sv[4][16];
#pragma unroll
              for (int kt = 0; kt < 4; ++kt) { f32x16 acc;
#pragma unroll
                  for (int i = 0; i < 16; ++i) acc[i] = 0.f;
#pragma unroll
                  for (int s = 0; s < 4; ++s) { const bf16x8 a = *(const bf16x8*)(kb + (size_t)(32 * kt) * 64 + 16 * s); acc = MFMA32(a, qf[s], acc); }
#pragma unroll
                  for (int i = 0; i < 16; ++i) { const unsigned key = (unsigned)(32 * kt + (i & 3) + 8 * (i >> 2)) + 4u * (unsigned)hh; sv[kt][i] = __uint_as_float((__float_as_uint(acc[i]) & ~127u) | key); } }
              bitonic_sort_desc<16>(sv[0]); bitonic_sort_desc<16>(sv[1]); bitonic_sort_desc<16>(sv[2]); bitonic_sort_desc<16>(sv[3]);
              top16_merge(sv[0], sv[1]); top16_merge(sv[2], sv[3]); top16_merge(sv[0], sv[2]);
              float pr[16];
#pragma unroll
              for (int i = 0; i < 16; ++i) pr[i] = __shfl_xor(sv[0][i], 32);
              top16_merge(sv[0], pr);
#pragma unroll
              for (int i = 0; i < 16; ++i) top[p][i] = sv[0][i];
          }
          if (hh == 0) {
#pragma unroll
              for (int i = 0; i < 16; ++i) { keyt[i] = (unsigned char)(__float_as_uint(top[0][i]) & 127u); keyt[16 + i] = (unsigned char)(__float_as_uint(top[1][i]) & 127u); } }
          float cs[4][16];
#define PSUM(a, b) __uint_as_float((__float_as_uint(top[0][a] + top[1][b]) & ~255u) | (unsigned)((a) * 16 + (b)))
#pragma unroll
          for (int b2 = 0; b2 < 16; ++b2) cs[0][b2] = PSUM(0, b2);
#pragma unroll
          for (int b2 = 0; b2 < 8; ++b2) cs[1][b2] = PSUM(1, b2);
#pragma unroll
          for (int a2 = 8; a2 < 16; ++a2) cs[1][a2] = PSUM(a2, 0);
#pragma unroll
          for (int b2 = 0; b2 < 5; ++b2) cs[2][b2] = PSUM(2, b2);
#pragma unroll
          for (int b2 = 0; b2 < 4; ++b2) cs[2][5 + b2] = PSUM(3, b2);
#pragma unroll
          for (int b2 = 0; b2 < 3; ++b2) cs[2][9 + b2] = PSUM(4, b2);
          cs[2][12] = PSUM(5, 0); cs[2][13] = PSUM(5, 1); cs[2][14] = PSUM(6, 0); cs[2][15] = PSUM(6, 1);
          cs[3][0] = PSUM(7, 0); cs[3][1] = PSUM(7, 1);
#undef PSUM
#pragma unroll
          for (int i = 2; i < 16; ++i) cs[3][i] = -3.0e38f;
          bitonic_sort_desc<16>(cs[0]); bitonic_sort_desc<16>(cs[1]); bitonic_sort_desc<16>(cs[2]); bitonic_sort_desc<16>(cs[3]);
          top16_merge(cs[0], cs[1]); top16_merge(cs[2], cs[3]); top16_merge(cs[0], cs[2]);
          LDS_WAIT();
          float ev[16], den = 0.f; const float mx = __uint_as_float(__float_as_uint(cs[0][0]) & ~255u);
#pragma unroll
          for (int k = 0; k < 16; ++k) { ev[k] = __expf(__uint_as_float(__float_as_uint(cs[0][k]) & ~255u) - mx); den += ev[k]; }
          const float rden = 1.f / den;
          if (hh == 0) {
#pragma unroll
              for (int k = 0; k < 16; ++k) { const unsigned code = __float_as_uint(cs[0][k]) & 255u; const int e = (int)keyt[code >> 4] * 128 + (int)keyt[16 + (code & 15u)];
                  IDX[(size_t)(t0 + r) * 128 + h * 16 + k] = e; GATE[(size_t)(t0 + r) * 128 + h * 16 + k] = ev[k] * rden; } }
        }
    }
}
__device__ __forceinline__ void peer_partition(const unsigned* xc_cnt, volatile LAS unsigned* MISC, int bx, int G, int& vx, int& rank, int& nb) {
    bool use_xcc = MK_ONE_LAUNCH != 0; unsigned mine = 0u; const unsigned myx = MISC[13];
    if (use_xcc) { unsigned sum = 0u;
#pragma unroll
        for (unsigned j = 0; j < 8; ++j) { const unsigned c = __hip_atomic_load(xc_cnt + 64 * j, __ATOMIC_RELAXED, __HIP_MEMORY_SCOPE_AGENT); use_xcc = use_xcc && (c > 0u); sum += c; mine = (j == myx) ? c : mine; }
        use_xcc = use_xcc && (sum == (unsigned)G); }
    if (use_xcc) { vx = (int)myx; rank = (int)MISC[12]; nb = (int)mine; } else { vx = bx & 7; rank = bx >> 3; nb = (G - vx + 7) >> 3; }
    vx = __builtin_amdgcn_readfirstlane(vx); rank = __builtin_amdgcn_readfirstlane(rank); nb = __builtin_amdgcn_readfirstlane(nb);
}
__device__ __forceinline__ void peer_u_i8(const unsigned char* H8, const float* XS, const int* IDX, const unsigned char* U8, const f32x2v* SC2, float* ACT, LAS float* wscr, int vx, int rank, int nb, int tid) {
    const int lane = tid & 63, wave = __builtin_amdgcn_readfirstlane(tid >> 6), g4 = lane >> 4, c16 = lane & 15;
    const int tstride = nb * 8;
    LAS int* clist = (LAS int*)wscr;
    LAS unsigned char* xs = (LAS unsigned char*)(wscr + 512);
    const unsigned long long lt = (1ull << lane) - 1ull;
    const unsigned char* ubase = U8 + 16 * c16;
    int ni[8];
    { const int tb = rank * 8 + wave;
#pragma unroll
      for (int j = 0; j < 4; ++j) { const int tj = tb + j * tstride; const bool ok = tj < T; ni[2 * j] = ok ? IDX[(size_t)tj * 128 + lane] : 0x7fffffff; ni[2 * j + 1] = ok ? IDX[(size_t)tj * 128 + 64 + lane] : 0x7fffffff; } }
    for (int tb = rank * 8 + wave; tb < T; tb += 4 * tstride) {
        int ntot = 0;
#pragma unroll
        for (int j = 0; j < 4; ++j) { const int e0 = ni[2 * j], e1 = ni[2 * j + 1]; const bool f0 = (e0 >> 11) == vx, f1 = (e1 >> 11) == vx;
            const unsigned long long m0 = __ballot(f0), m1 = __ballot(f1); const int n0 = __popcll(m0);
            if (f0) clist[ntot + __popcll(m0 & lt)] = (j << 21) | (e0 << 7) | lane;
            if (f1) clist[ntot + n0 + __popcll(m1 & lt)] = (j << 21) | (e1 << 7) | (64 + lane);
            ntot += n0 + __popcll(m1); }
        v4u xr[4]; float sx[4];
#pragma unroll
        for (int j = 0; j < 4; ++j) { const int tj = tb + j * tstride, tl = tj < T ? tj : tb; xr[j] = *(const v4u*)(H8 + (size_t)tl * 1024 + 16 * lane); sx[j] = XS[tl]; }
        { const int tn = tb + 4 * tstride;
#pragma unroll
          for (int j = 0; j < 4; ++j) { const int tj = tn + j * tstride; const bool ok = tj < T; ni[2 * j] = ok ? IDX[(size_t)tj * 128 + lane] : 0x7fffffff; ni[2 * j + 1] = ok ? IDX[(size_t)tj * 128 + 64 + lane] : 0x7fffffff; } }
        if (ntot == 0) continue;
#pragma unroll
        for (int j = 0; j < 4; ++j) *(LAS v4u*)(xs + j * 1024 + 16 * lane) = xr[j];
        LDS_WAIT();
        const int last = ntot - 1, nit = (ntot + 3) >> 2, nit4 = (nit + 3) >> 2;
        v4u ub[4][4]; f32x2v us[4]; int up[4];
#pragma unroll
        for (int k = 0; k < 3; ++k) { const int p = min(4 * k + g4, last); const int pk = clist[p]; up[k] = pk; const unsigned eo = (unsigned)((pk >> 7) & 16383) * 1024u; us[k] = SC2[(pk >> 7) & 16383];
#pragma unroll
            for (int jj = 0; jj < 4; ++jj) ub[k][jj] = *(const v4u*)(ubase + eo + 256 * jj); }
        int dsel = 0, psel = 0; f32x2v ssel = (f32x2v){0.f, 0.f}; bool vsel = false;
#pragma unroll 1
        for (int o = 0; o < nit4; ++o) {
#pragma unroll
            for (int k = 0; k < 4; ++k) {
                const int i = 4 * o + k;
                { const int p = min(4 * (i + 3) + g4, last); const int pk = clist[p]; up[(k + 3) & 3] = pk; const unsigned eo = (unsigned)((pk >> 7) & 16383) * 1024u; us[(k + 3) & 3] = SC2[(pk >> 7) & 16383];
#pragma unroll
                  for (int jj = 0; jj < 4; ++jj) ub[(k + 3) & 3][jj] = *(const v4u*)(ubase + eo + 256 * jj); }
                const LAS unsigned char* xp = xs + (up[k] >> 21) * 1024 + 16 * c16;
                v4u xq[4];
#pragma unroll
                for (int jj = 0; jj < 4; ++jj) xq[jj] = *(const LAS v4u*)(xp + 256 * jj);
                int a0 = 0, a1 = 0, a2 = 0, a3 = 0;
#pragma unroll
                for (int jj = 0; jj < 4; ++jj) {
                    a0 = __builtin_amdgcn_sdot4((int)xq[jj].x, (int)ub[k][jj].x, a0, false); a1 = __builtin_amdgcn_sdot4((int)xq[jj].y, (int)ub[k][jj].y, a1, false);
                    a2 = __builtin_amdgcn_sdot4((int)xq[jj].z, (int)ub[k][jj].z, a2, false); a3 = __builtin_amdgcn_sdot4((int)xq[jj].w, (int)ub[k][jj].w, a3, false); }
                int d = (a0 + a1) + (a2 + a3);
                d += __builtin_amdgcn_update_dpp(0, d, 0x128, 0xf, 0xf, false); d += __builtin_amdgcn_update_dpp(0, d, 0x124, 0xf, 0xf, false);
                d += __builtin_amdgcn_update_dpp(0, d, 0x122, 0xf, 0xf, false); d += __builtin_amdgcn_update_dpp(0, d, 0x121, 0xf, 0xf, false);
                if ((i & 15) == c16) { dsel = d; ssel = us[k]; psel = up[k]; vsel = 4 * i + g4 <= last; }
                if (k == 3 && ((o & 3) == 3 || o == nit4 - 1)) {
                    if (vsel) { const int j = psel >> 21; const float sxj = j == 0 ? sx[0] : j == 1 ? sx[1] : j == 2 ? sx[2] : sx[3];
                        ACT[(size_t)(tb + j * tstride) * 128 + (psel & 127)] = gelu_erf((float)dsel * sxj * ssel.x) * ssel.y; }
                    vsel = false; }
            }
        }
        LDS_WAIT();
    }
}
__device__ __forceinline__ void peer_v(const int* IDX, const float* ACT, const float* GATE, const unsigned char* V8, const float* gate2, const float* Xin, float* Xout, LAS float* wscr,
                                       int vx, int rank, int nb, int tid) {
    const int lane = tid & 63, wave = __builtin_amdgcn_readfirstlane(tid >> 6), g8 = lane >> 3, c8 = lane & 7;
    const int tstride = nb * 8;
    LAS int* wl = (LAS int*)wscr; LAS unsigned char* wqb = (LAS unsigned char*)(wscr + 128);
    const unsigned char* vbase = V8 + (size_t)vx * (2 * MiB) + 16 * c8;
    const int col = 128 * vx + 16 * c8;
    const int wqo0 = (lane & 7) * 16 + (lane >> 3), wqo1 = wqo0 + 8;
    const int t0 = rank * 8 + wave;
    if (t0 >= T) return;
    const int tlast = t0 + ((T - 1 - t0) / tstride) * tstride;
#define PV_STAGE(tt, I0, I1, A0, A1, VV, WQ4, SW) { \
        float am_ = fmaxf(fabsf(A0), fabsf(A1)); \
        _Pragma("unroll") for (int o_ = 1; o_ < 64; o_ <<= 1) am_ = fmaxf(am_, __shfl_xor(am_, o_)); \
        const float inv_ = am_ > 0.f ? 127.f / am_ : 0.f; SW = am_ * (1.f / 127.f); \
        wl[lane] = I0; wl[64 + lane] = I1; wqb[wqo0] = (unsigned char)((int)rintf(A0 * inv_) & 255); wqb[wqo1] = (unsigned char)((int)rintf(A1 * inv_) & 255); \
        LDS_WAIT(); \
        _Pragma("unroll") for (int i_ = 0; i_ < 16; ++i_) { const int e_ = wl[8 * i_ + g8]; VV[i_] = *(const v4u*)(vbase + (size_t)(unsigned)(e_ * 128)); } \
        WQ4 = *(const LAS v4u*)(wqb + g8 * 16); LDS_WAIT(); }
#define PV_META(tt, I0, I1, A0, A1) { const size_t o_ = (size_t)(tt) * 128; I0 = IDX[o_ + lane]; I1 = IDX[o_ + 64 + lane]; A0 = ACT[o_ + lane] * GATE[o_ + lane]; A1 = ACT[o_ + 64 + lane] * GATE[o_ + 64 + lane]; }
    int i0, i1; float a0, a1;
    v4u vv[16], vvn[16], wq4, wq4n; float sw, swn;
    PV_META(t0, i0, i1, a0, a1);
    PV_STAGE(t0, i0, i1, a0, a1, vvn, wq4n, swn);
    { const int t1 = min(t0 + tstride, tlast); PV_META(t1, i0, i1, a0, a1); }
    for (int t = t0; t < T; t += tstride) {
        const int b = t >> 11, tn = min(t + tstride, tlast), tn2 = min(t + 2 * tstride, tlast);
#pragma unroll
        for (int i = 0; i < 16; ++i) vv[i] = vvn[i];
        wq4 = wq4n; sw = swn;
        f32x4 xin[4], g2[4];
#pragma unroll
        for (int q = 0; q < 4; ++q) { xin[q] = *(const f32x4*)(Xin + (size_t)t * 1024 + col + 4 * q); g2[q] = *(const f32x4*)(gate2 + (size_t)b * NADA + col + 4 * q); }
        PV_STAGE(tn, i0, i1, a0, a1, vvn, wq4n, swn);
        PV_META(tn2, i0, i1, a0, a1);
        int acc[16];
#pragma unroll
        for (int i = 0; i < 16; ++i) acc[i] = 0;
#pragma unroll
        for (int q = 0; q < 4; ++q) { const int wq = (int)(q == 0 ? wq4.x : q == 1 ? wq4.y : q == 2 ? wq4.z : wq4.w);
#pragma unroll
            for (int cb = 0; cb < 4; ++cb) {
                const unsigned a = cb == 0 ? vv[4 * q].x : cb == 1 ? vv[4 * q].y : cb == 2 ? vv[4 * q].z : vv[4 * q].w, bb = cb == 0 ? vv[4 * q + 1].x : cb == 1 ? vv[4 * q + 1].y : cb == 2 ? vv[4 * q + 1].z : vv[4 * q + 1].w;
                const unsigned c = cb == 0 ? vv[4 * q + 2].x : cb == 1 ? vv[4 * q + 2].y : cb == 2 ? vv[4 * q + 2].z : vv[4 * q + 2].w, d = cb == 0 ? vv[4 * q + 3].x : cb == 1 ? vv[4 * q + 3].y : cb == 2 ? vv[4 * q + 3].z : vv[4 * q + 3].w;
                const unsigned ab_lo = __builtin_amdgcn_perm(bb, a, 0x05010400u), ab_hi = __builtin_amdgcn_perm(bb, a, 0x07030602u), cd_lo = __builtin_amdgcn_perm(d, c, 0x05010400u), cd_hi = __builtin_amdgcn_perm(d, c, 0x07030602u);
                acc[4 * cb + 0] = __builtin_amdgcn_sdot4((int)__builtin_amdgcn_perm(cd_lo, ab_lo, 0x05040100u), wq, acc[4 * cb + 0], false);
                acc[4 * cb + 1] = __builtin_amdgcn_sdot4((int)__builtin_amdgcn_perm(cd_lo, ab_lo, 0x07060302u), wq, acc[4 * cb + 1], false);
                acc[4 * cb + 2] = __builtin_amdgcn_sdot4((int)__builtin_amdgcn_perm(cd_hi, ab_hi, 0x05040100u), wq, acc[4 * cb + 2], false);
                acc[4 * cb + 3] = __builtin_amdgcn_sdot4((int)__builtin_amdgcn_perm(cd_hi, ab_hi, 0x07060302u), wq, acc[4 * cb + 3], false); } }
#pragma unroll
        for (int i = 0; i < 16; ++i) { acc[i] += __builtin_amdgcn_update_dpp(0, acc[i], 0x128, 0xf, 0xf, false);
            acc[i] += __shfl_xor(acc[i], 16); acc[i] += __shfl_xor(acc[i], 32); }
        if (g8 == 0) {
#pragma unroll
            for (int q = 0; q < 4; ++q) *(f32x4*)(Xout + (size_t)t * 1024 + col + 4 * q) = xin[q] + g2[q] * ((f32x4){(float)acc[4 * q], (float)acc[4 * q + 1], (float)acc[4 * q + 2], (float)acc[4 * q + 3]} * sw); }
    }
#undef PV_STAGE
#undef PV_META
}

constexpr int PH_PER_LAYER = 12, N_PHASES = 1 + DEPTH * PH_PER_LAYER + 1;
struct Args { const void* in[N_INPUTS]; float* out; unsigned char* ws; int ph_lo, ph_hi; };
static_assert(sizeof(Args) == N_INPUTS * 8 + 24, "Args has no padding");

constexpr int PTAB_OFF = LDSCTL_OFF + 1024;
__device__ __forceinline__ unsigned char* getp(LAS unsigned char* lds, int i) {
    asm volatile("" ::: "memory");
    const u32x2 v = *(volatile LAS u32x2*)(lds + PTAB_OFF + 8 * i);
    const unsigned lo = __builtin_amdgcn_readfirstlane(v.x), hi = __builtin_amdgcn_readfirstlane(v.y);
    GAS unsigned char* g = (GAS unsigned char*)(((unsigned long long)hi << 32) | lo);
    return (unsigned char*)g;
}
#define INP(i) ((const float*)getp(lds, (i)))
#define WSB() getp(lds, 30)

#define IN(k) (lo <= (k) && (k) < hi)
#define SEAM(k) do { if (MK_ONE_LAUNCH && IN(k) && IN((k) + 1)) { XcdBarrier b_; b_.bar = (unsigned*)(WSB() + WS_CTL) + CW_BAR; b_.x = xb_xcc_id(); b_.st = MISC + 8; REPS(11) xcd_barrier(b_, (wave_s << 6) | (int)__lane_id()); } } while (0)
#define PH_BEGIN(lv) int tidq; asm volatile("v_mbcnt_lo_u32_b32 %0, -1, 0\n\tv_mbcnt_hi_u32_b32 %0, -1, %0" : "=v"(tidq)); tidq |= wave_s << 6;     \
    asm volatile("" : "+v"(tidq)); const int lane = tidq & 63, wave = __builtin_amdgcn_readfirstlane(tidq >> 6); \
    int G = gridDim.x, bx = blockIdx.x, l = (lv); asm volatile("" : "+s"(G), "+s"(bx), "+s"(l)); const int gw = bx * NWAVES + wave, NGW = G * NWAVES; \
    unsigned char* ws = WSB(); LAS float* wscr = (LAS float*)(lds + RING_OFF + wave * 16384); (void)lane; (void)gw; (void)NGW; (void)ws; (void)wscr; (void)l


constexpr int PI_W = 4512, PI_K = 512, PI_U = 2048, PI_V = 2048, PI_TOTAL = PI_W + PI_K + PI_U + PI_V;
template <int NR> __device__ __forceinline__ void prep_rows_i8(const float* src, size_t src_stride, unsigned char* dst, size_t dst_stride, float* scale_slot  , int lane) {
    f32x4 v[NR][4];
#pragma unroll
    for (int rr = 0; rr < NR; ++rr) { const f32x4* s = (const f32x4*)(src + rr * src_stride) + lane * 4;
#pragma unroll
        for (int j = 0; j < 4; ++j) v[rr][j] = s[j]; }
#pragma unroll
    for (int rr = 0; rr < NR; ++rr) {
        float am = 0.f;
#pragma unroll
        for (int j = 0; j < 4; ++j) am = fmaxf(fmaxf(am, fmaxf(fabsf(v[rr][j][0]), fabsf(v[rr][j][1]))), fmaxf(fabsf(v[rr][j][2]), fabsf(v[rr][j][3])));
#pragma unroll
        for (int o = 1; o < 64; o <<= 1) am = fmaxf(am, __shfl_xor(am, o));
        const float inv = am > 0.f ? 127.f / am : 0.f;
#define Q4(x) ((unsigned)((int)rintf((x)[0] * inv) & 255) | ((unsigned)((int)rintf((x)[1] * inv) & 255) << 8) | ((unsigned)((int)rintf((x)[2] * inv) & 255) << 16) | ((unsigned)((int)rintf((x)[3] * inv) & 255) << 24))
        v4u o; o.x = Q4(v[rr][0]); o.y = Q4(v[rr][1]); o.z = Q4(v[rr][2]); o.w = Q4(v[rr][3]);
#undef Q4
        *(v4u*)(dst + rr * dst_stride) = o;
        if (lane == 0) scale_slot[2 * rr] = am * (1.f / 127.f);
    }
}
__device__ __forceinline__ void prep_item(LAS unsigned char* lds, unsigned char* ws, LAS float* wscr, int l, int r, int lane) {
    constexpr int I_WIN_ = 16 * 136, I_WQ_ = 12 * 24, I_WKV_ = 4 * 32, I_WA_ = 8 * 32, I_WM_ = 8 * 32, I_WO_ = 16 * 32, I_PW_ = 16 * 32, I_WQK_ = 8 * 32, I_WV_ = 8 * 16;
    static_assert(I_WIN_ + I_WQ_ + I_WKV_ + I_WA_ + I_WM_ + I_WO_ + I_PW_ + I_WQK_ + I_WV_ == PI_W, "weight items");
    unsigned char* wl = ws + WS_W + (size_t)l * W_LAYER;
    if (r < PI_W) {
        if (r < I_WIN_) { const GetWin g{INP(I_WIN) + (size_t)l * D * 4136}; prep_tile(g, (bf16*)(wl + WO_WIN), 1024, 64 * (r / 136), 32 * (r % 136), wscr, lane); return; } r -= I_WIN_;
        if (r < I_WQ_) { const GetWq g{INP(I_WQUP) + (size_t)l * 768 * 768, INP(I_QNG) + l * 768}; prep_tile(g, (bf16*)(wl + WO_WQ), 768, 64 * (r / 24), 32 * (r % 24), wscr, lane); return; } r -= I_WQ_;
        if (r < I_WKV_) { const GetWkv g{INP(I_WKVUP) + (size_t)l * 256 * 1024, INP(I_KVNG) + l * 256}; prep_tile(g, (bf16*)(wl + WO_WKV), 256, 64 * (r / 32), 32 * (r % 32), wscr, lane); return; } r -= I_WKV_;
        if (r < I_WA_) { const GetPlain g{INP(I_WBA) + (size_t)l * 512 * 1024, 1024}; prep_tile(g, (bf16*)(wl + WO_WA), 512, 64 * (r / 32), 32 * (r % 32), wscr, lane); return; } r -= I_WA_;
        if (r < I_WM_) { const GetPlain g{INP(I_WBM) + (size_t)l * 512 * 1024, 1024}; prep_tile(g, (bf16*)(wl + WO_WM), 512, 64 * (r / 32), 32 * (r % 32), wscr, lane); return; } r -= I_WM_;
        if (r < I_WO_) { const GetPlain g{INP(I_WOUT) + (size_t)l * 1024 * 1024, 1024}; prep_tile(g, (bf16*)(wl + WO_WO), 1024, 64 * (r / 32), 32 * (r % 32), wscr, lane); return; } r -= I_WO_;
        if (r < I_PW_) { const GetPlain g{INP(I_PWQ) + (size_t)l * 1024 * 1024, 1024}; prep_tile(g, (bf16*)(wl + WO_PWQ), 1024, 64 * (r / 32), 32 * (r % 32), wscr, lane); return; } r -= I_PW_;
        if (r < I_WQK_) { const GetWqk g{INP(I_WQM) + (size_t)l * 65536, INP(I_WKM) + (size_t)l * 65536}; prep_tile(g, (bf16*)(wl + WO_WQK), 512, 64 * (r / 32), 32 * (r % 32), wscr, lane); return; } r -= I_WQK_;
        { const GetWv g{INP(I_WVM) + (size_t)l * 65536}; prep_tile(g, (bf16*)(wl + WO_WV), 512, 64 * (r / 16), 32 * (r % 16), wscr, lane); }
        return; }
    r -= PI_W;
    if (r < PI_K) { const int o = (r * 64 + lane) * 4;
        const f32x4 v = *(const f32x4*)(INP(I_PKEYS) + (size_t)l * 131072 + o); u32x2 w; w.x = pk2(v[0], v[1]); w.y = pk2(v[2], v[3]);
        *(u32x2*)(wl + WO_KEYB + (size_t)o * 2) = w; return; }
    r -= PI_K;
    float* sc2 = (float*)(ws + WS_USC);
    if (r < PI_U) { const float* pu = INP(I_PU) + (size_t)l * 16777216;
        for (int rr = 0; rr < 8; rr += 8) { const int er = r * 8 + rr; prep_rows_i8<8>(pu + (size_t)er * 1024, 1024, ws + WS_U8 + (size_t)l * 32 * MiB + (size_t)er * 1024 + 16 * lane, 1024, sc2 + 2 * (l * 16384 + er), lane); }
        return; }
    r -= PI_U;
    { const float* pv = INP(I_PV) + (size_t)l * 16777216;
      for (int rr = 0; rr < 8; rr += 8) { const int er = r * 8 + rr;
          prep_rows_i8<8>(pv + (size_t)er * 1024, 1024, ws + WS_V8 + (size_t)l * 32 * MiB + (size_t)(lane >> 3) * (2 * MiB) + (size_t)er * 128 + 16 * (lane & 7), 128, sc2 + 2 * (l * 16384 + er) + 1, lane); } }
}
template <int lv> __device__ __forceinline__ void layer_phases(LAS unsigned char* lds, volatile LAS unsigned* MISC, const int lo, const int hi, const int wave_s) {
        const int P = 1 + lv * PH_PER_LAYER;
#define WL() (ws + WS_W + (size_t)l * W_LAYER)
#define ADAL() ((const float*)(ws + ADA_OFF) + (size_t)l * 8 * NADA)
#define XIN() ((l == 0) ? INP(I_X) : (const float*)getp(lds, 29))
#define WSP(type, off) ((type*)(ws + (off)))
        if (IN(P + 0)) REPS(1) { PH_BEGIN(lv); rowpass_norm_mod(XIN(), INP(I_N1G) + l * D, ADAL() + 0, ADAL() + 1024, WSP(bf16, WS_H), gw, NGW, lane); }
        SEAM(P + 0);
        if (IN(P + 1)) REPS(2) { PH_BEGIN(lv);
            if (G == 256) {
                { pg8::Gemm g{WSP(bf16, WS_H), (const bf16*)(WL() + WO_WIN), T, 4096, D}; pg8::StaticOrder S; S.init(T, 4096, G, bx);
                  EpiProj E{WSP(bf16, WS_QLAT), WSP(bf16, WS_KVLAT), WSP(bf16, WS_UM), WSP(bf16, WS_OPRE), WSP(bf16, WS_GA), WSP(bf16, WS_GM), WSP(float, WS_SMALL)};
                  pg8::gemm_phase<EpiProj, pg8::StaticOrder, true, true>(lds + RING_OFF, g, S, E, tidq); }
                { const int kq = bx >> 6;
                  pg8::Gemm g{WSP(bf16, WS_H) + 256 * kq, (const bf16*)(WL() + WO_WIN) + (size_t)4096 * 1024 + 256 * kq, T, 256, 256, 1024}; pg8::StaticOrder S; S.init(T, 256, 64, bx & 63);
                  EpiSmallPart E{WSP(float, WS_SMALLP) + (size_t)kq * T * 64};
                  pg8::gemm_phase<EpiSmallPart, pg8::StaticOrder, true, true>(lds + RING_OFF, g, S, E, tidq); }
            } else {
                pg8::Gemm g{WSP(bf16, WS_H), (const bf16*)(WL() + WO_WIN), T, NPROJ, D}; pg8::StaticOrder S; S.init(T, NPROJ, G, bx);
                EpiProj E{WSP(bf16, WS_QLAT), WSP(bf16, WS_KVLAT), WSP(bf16, WS_UM), WSP(bf16, WS_OPRE), WSP(bf16, WS_GA), WSP(bf16, WS_GM), WSP(float, WS_SMALL)};
                pg8::gemm_phase<EpiProj, pg8::StaticOrder, true, true>(lds + RING_OFF, g, S, E, tidq);
            }
        }
        SEAM(P + 1);
        if (IN(P + 2)) REPS(3) { PH_BEGIN(lv);
            rowpass_mid(WSP(bf16, WS_QLAT), WSP(bf16, WS_KVLAT), WSP(float, WS_SMALL), (G == 256) ? WSP(float, WS_SMALLP) : (const float*)nullptr, WSP(float, WS_COS), WSP(float, WS_SIN), WSP(bf16, WS_UM), INP(I_CONVW) + l * 4 * 512, INP(I_CONVB) + l * 512,
                        INP(I_BI) + l * 4, INP(I_BF) + l * 4, WSP(float, WS_RQ), WSP(float, WS_RKV), WSP(bf16, WS_K), WSP(float, WS_LOGI), WSP(float, WS_LOGF), WSP(bf16, WS_CONV), gw, NGW, lane); }
        SEAM(P + 2);
        if (IN(P + 3)) REPS(4) {
            { PH_BEGIN(lv); pg8::Gemm g{WSP(bf16, WS_QLAT), (const bf16*)(WL() + WO_WQ), T, 768, 768}; pg8::StaticOrder S; S.init(T, 768, G, bx);
              EpiQ E{WSP(bf16, WS_Q), WSP(float, WS_RQ), WSP(float, WS_COS), WSP(float, WS_SIN)}; pg8::gemm_phase<EpiQ, pg8::StaticOrder, true, true>(lds + RING_OFF, g, S, E, tidq); }
            { PH_BEGIN(lv); pg8::Gemm g{WSP(bf16, WS_KVLAT), (const bf16*)(WL() + WO_WKV), T, 1024, 256}; pg8::StaticOrder S; S.init(T, 1024, G, bx);
              EpiKV E{WSP(bf16, WS_K), WSP(bf16, WS_V), WSP(float, WS_RKV)}; pg8::gemm_phase<EpiKV, pg8::StaticOrder, true, true>(lds + RING_OFF, g, S, E, tidq); }
            { PH_BEGIN(lv); pg8::Gemm g{WSP(bf16, WS_CONV), (const bf16*)(WL() + WO_WQK), T, 1024, 512}; pg8::StaticOrder S; S.init(T, 1024, G, bx);
              pg8::EpiBf16<0> E{WSP(bf16, WS_QKM), 1024, nullptr, 0, 0, 1.f}; pg8::gemm_phase<pg8::EpiBf16<0>, pg8::StaticOrder, true, true>(lds + RING_OFF, g, S, E, tidq); }
            { PH_BEGIN(lv); pg8::Gemm g{WSP(bf16, WS_UM), (const bf16*)(WL() + WO_WV), T, 512, 512}; pg8::StaticOrder S;
              if (G == 256) S.init(T, 512, 64, bx >= 192 ? bx - 192 : (1 << 20)); else S.init(T, 512, G, bx);
              pg8::EpiBf16<0> E{WSP(bf16, WS_VM), 512, nullptr, 0, 0, 1.f}; pg8::gemm_phase<pg8::EpiBf16<0>, pg8::StaticOrder, true, true>(lds + RING_OFF, g, S, E, tidq); }
        }
        SEAM(P + 3);
        if (IN(P + 4)) {
            REPS(5) { PH_BEGIN(lv); attn_mfma(WSP(bf16, WS_Q), WSP(bf16, WS_K), WSP(bf16, WS_V), WSP(bf16, WS_AO), lds + RING_OFF, bx, G, tidq); __syncthreads(); }
            REPS(6) { PH_BEGIN(lv); mlstm_mfma(WSP(bf16, WS_QKM), WSP(bf16, WS_VM), WSP(float, WS_LOGI), WSP(float, WS_LOGF), WSP(bf16, WS_CONV), WSP(bf16, WS_OPRE), INP(I_MHG) + l * 512, INP(I_MSKIP) + l * 512,
                          WSP(bf16, WS_OUTM), lds + RING_OFF, bx, G, tidq); }
        }
        SEAM(P + 4);
        if (IN(P + 5)) REPS(7) {
            { PH_BEGIN(lv); pg8::Gemm g{WSP(bf16, WS_AO), (const bf16*)(WL() + WO_WA), T, 1024, 512}; pg8::StaticOrder S; S.init(T, 1024, G, bx);
              EpiMerge E{WSP(bf16, WS_MERGED), WSP(bf16, WS_GA), 1}; pg8::gemm_phase<EpiMerge, pg8::StaticOrder, true, true>(lds + RING_OFF, g, S, E, tidq); }
            { PH_BEGIN(lv); pg8::Gemm g{WSP(bf16, WS_OUTM), (const bf16*)(WL() + WO_WM), T, 1024, 512}; pg8::StaticOrder S; S.init(T, 1024, G, bx);
              EpiMerge E{WSP(bf16, WS_MERGED), WSP(bf16, WS_GM), 0}; pg8::gemm_phase<EpiMerge, pg8::StaticOrder, true, true>(lds + RING_OFF, g, S, E, tidq); }
        }
        SEAM(P + 5);
        if (IN(P + 6)) REPS(8) { PH_BEGIN(lv);
            pg8::Gemm g{WSP(bf16, WS_MERGED), (const bf16*)(WL() + WO_WO), T, 1024, 1024}; pg8::StaticOrder S; S.init(T, 1024, G, bx);
            EpiResid E{XIN(), WSP(float, WS_X), ADAL() + 2048}; pg8::gemm_phase<EpiResid, pg8::StaticOrder, true, true>(lds + RING_OFF, g, S, E, tidq);
        }
        SEAM(P + 6);
        if (IN(P + 7)) REPS(1) { PH_BEGIN(lv); rowpass_norm_mod(WSP(float, WS_X), INP(I_N2G) + l * D, ADAL() + 3072, ADAL() + 4096, WSP(bf16, WS_H), gw, NGW, lane, ws + WS_H8, WSP(float, WS_XS)); }
        SEAM(P + 7);
        if (IN(P + 8)) REPS(9) { PH_BEGIN(lv);
            pg8::Gemm g{WSP(bf16, WS_H), (const bf16*)(WL() + WO_PWQ), T, 1024, 1024}; pg8::StaticOrder S; S.init(T, 1024, G, bx);
            pg8::EpiBf16<0> E{WSP(bf16, WS_PQ), 1024, nullptr, 0, 0, 1.f}; pg8::gemm_phase<pg8::EpiBf16<0>, pg8::StaticOrder, true, true>(lds + RING_OFF, g, S, E, tidq);
        }
        SEAM(P + 8);
        if (IN(P + 9)) REPS(10) { PH_BEGIN(lv);
            peer_route(WSP(bf16, WS_PQ), (const bf16*)(WL() + WO_KEYB), WSP(int, WS_IDX), WSP(float, WS_GATE), lds + RING_OFF, bx, G, tidq); }
        SEAM(P + 9);
        if (IN(P + 10)) REPS(12) { PH_BEGIN(lv);
            int vx, rank, nb; peer_partition((const unsigned*)(ws + WS_CTL) + CW_XC, MISC, bx, G, vx, rank, nb);
            peer_u_i8(ws + WS_H8, WSP(float, WS_XS), WSP(int, WS_IDX), ws + WS_U8 + (size_t)l * 32 * MiB, WSP(f32x2v, WS_USC) + l * 16384, WSP(float, WS_ACT), wscr, vx, rank, nb, tidq); }
        SEAM(P + 10);
        if (IN(P + 11)) REPS(13) { PH_BEGIN(lv);
            int vx, rank, nb; peer_partition((const unsigned*)(ws + WS_CTL) + CW_XC, MISC, bx, G, vx, rank, nb);
            peer_v(WSP(int, WS_IDX), WSP(float, WS_ACT), WSP(float, WS_GATE), ws + WS_V8 + (size_t)l * 32 * MiB, ADAL() + 5120, WSP(float, WS_X), (float*)getp(lds, 29), wscr, vx, rank, nb, tidq);
        }
        SEAM(P + 11);
    }

__global__ void __launch_bounds__(NTHREADS, 2) fwd(Args args) {
    extern __shared__ __attribute__((aligned(16))) unsigned char lds_raw[];
    LAS unsigned char* lds = (LAS unsigned char*)lds_raw;
    volatile LAS unsigned* MISC = (volatile LAS unsigned*)(lds + MISC_OFF);
    const int tid = threadIdx.x;
    const int wave_s = __builtin_amdgcn_readfirstlane(tid >> 6);
    for (int u = tid; u < (LDS_BYTES - LDSCTL_OFF) / 4; u += NTHREADS) ((LAS unsigned*)(lds + LDSCTL_OFF))[u] = 0u;
    __syncthreads();
    if (tid == 0) { LAS unsigned long long* pt = (LAS unsigned long long*)(lds + PTAB_OFF);
#pragma unroll
        for (int i = 0; i < N_INPUTS; ++i) pt[i] = (unsigned long long)args.in[i];
        pt[29] = (unsigned long long)args.out; pt[30] = (unsigned long long)args.ws; }
    __syncthreads();
    if (MK_ONE_LAUNCH) (void)xcd_barrier_post((unsigned*)(WSB() + WS_CTL) + CW_BAR, MISC + 8);
    if (MK_ONE_LAUNCH && tid == 0) { const unsigned xc = xb_xcc_id() & 7u; MISC[12] = xb_add((unsigned*)(WSB() + WS_CTL) + CW_XC + 64 * xc, 1u); MISC[13] = xc; }
    __syncthreads();
    const int lo = args.ph_lo, hi = args.ph_hi;

    if (IN(0)) REPS(0) {
        PH_BEGIN(0);
        float* ADA = (float*)(ws + ADA_OFF);
        { const float* c = INP(I_C); const float* wada = INP(I_WADA); const float* bada = INP(I_BADA);
          for (int it = bx; it < DEPTH * 96; it += G) {
            const int ll = it / 96, cg = it % 96; const int n = cg * 64 + lane;
#pragma unroll
            for (int i = 0; i < 16; ++i) { const int e = lane + 64 * i; const int bb = e >> 7, kk = e & 127; const float cv = c[bb * D + wave * 128 + kk]; wscr[e] = cv * sigm(cv); }
            LDS_WAIT();
            const float* w = wada + (size_t)ll * D * NADA + (size_t)(wave * 128) * NADA + n;
            float a[8];
#pragma unroll
            for (int bb = 0; bb < 8; ++bb) a[bb] = 0.f;
#pragma unroll 16
            for (int kk = 0; kk < 128; ++kk) { const float wv = w[(size_t)kk * NADA];
#pragma unroll
                for (int bb = 0; bb < 8; ++bb) a[bb] += wscr[bb * 128 + kk] * wv; }
#pragma unroll
            for (int bb = 0; bb < 8; ++bb) wscr[1024 + bb * 64 + lane] = a[bb];
            __syncthreads();
            { float s = 0.f;
#pragma unroll
              for (int w8 = 0; w8 < 8; ++w8) s += ((const LAS float*)(lds + RING_OFF + w8 * 16384))[1024 + wave * 64 + lane];
              ADA[((size_t)ll * 8 + wave) * NADA + n] = s + bada[ll * NADA + n]; }
            __syncthreads();
          } }
        { const int* pos = (const int*)INP(I_POS); float* COS = (float*)(ws + WS_COS); float* SIN = (float*)(ws + WS_SIN);
          for (int idx = gw * 64 + lane; idx < T * 16; idx += NGW * 64) { const int t = idx >> 4, j = idx & 15;
              const float ang = (float)pos[t] * INV_FREQ[j];
              const double rev = (double)ang * 0.15915494309189535; const float fr = (float)(rev - rint(rev));
              COS[idx] = __builtin_amdgcn_cosf(fr); SIN[idx] = __builtin_amdgcn_sinf(fr); } }
        for (int it = gw; it < DEPTH * PI_TOTAL; it += NGW) prep_item(lds, ws, wscr, it / PI_TOTAL, it % PI_TOTAL, lane);
    }
    SEAM(0);

    layer_phases<0>(lds, MISC, lo, hi, wave_s);
    layer_phases<1>(lds, MISC, lo, hi, wave_s);
    if (IN(N_PHASES - 1)) REPS(1) { PH_BEGIN(0); rowpass_final((const float*)getp(lds, 29), INP(I_FG), (float*)getp(lds, 29), gw, NGW, lane); }
#undef IN
#undef SEAM
}

extern "C" void kernel_launch(void* const* d_in, const int* in_sizes, int n_in, void* d_out, int out_size, void* d_ws, size_t ws_size, hipStream_t stream) {
    static int grid = 0;
    if (grid == 0) {
        if (n_in != N_INPUTS || in_sizes[0] != T * D || out_size != T * D || ws_size < WS_END2) {
            fprintf(stderr, "kernel_launch: unexpected shapes: n_in %d in0 %d out %d ws %zu (need %zu); nothing launched\n", n_in, n_in > 0 ? in_sizes[0] : -1, out_size, ws_size, (size_t)WS_END2); grid = -1; return; }
        int dev = 0, cus = 0, per_cu = 0;
        if (hipGetDevice(&dev) != hipSuccess || hipDeviceGetAttribute(&cus, hipDeviceAttributeMultiprocessorCount, dev) != hipSuccess) { fprintf(stderr, "kernel_launch: device query failed\n"); grid = -1; return; }
        if (hipFuncSetAttribute((const void*)fwd, hipFuncAttributeMaxDynamicSharedMemorySize, LDS_BYTES) != hipSuccess) { fprintf(stderr, "kernel_launch: hipFuncSetAttribute failed\n"); grid = -1; return; }
        if (hipOccupancyMaxActiveBlocksPerMultiprocessor(&per_cu, (const void*)fwd, NTHREADS, LDS_BYTES) != hipSuccess || per_cu < 1)
            fprintf(stderr, "kernel_launch: note: occupancy query reports %d workgroups per CU\n", per_cu);
        (void)hipGetLastError();
        grid = cus;
    }
    if (grid < 0) return;
    if (hipMemsetAsync((char*)d_ws + WS_CTL, 0, CTL_ZERO_BYTES, stream) != hipSuccess) { fprintf(stderr, "kernel_launch: memset failed\n"); return; }
    Args a{};
    for (int i = 0; i < N_INPUTS; ++i) a.in[i] = d_in[i];
    a.out = (float*)d_out; a.ws = (unsigned char*)d_ws;
#if MK_ONE_LAUNCH
    a.ph_lo = 0; a.ph_hi = N_PHASES;
    hipLaunchKernelGGL(fwd, dim3(grid), dim3(NTHREADS), LDS_BYTES, stream, a);
#else
    for (int p = 0; p < N_PHASES; ++p) { a.ph_lo = p; a.ph_hi = p + 1; hipLaunchKernelGGL(fwd, dim3(grid), dim3(NTHREADS), LDS_BYTES, stream, a); }
#endif
    const hipError_t le = hipPeekAtLastError();
    if (le != hipSuccess) fprintf(stderr, "kernel_launch: launch failed: %s\n", hipGetErrorName(le));
}
```

```cpp
#include <hip/hip_runtime.h>
#include <cstdio>
#include <cstdint>
namespace pg8 {
#define PG8_LAS __attribute__((address_space(3)))
typedef unsigned short bf16_t;
typedef short bf16x8 __attribute__((ext_vector_type(8)));
typedef float f32x4 __attribute__((ext_vector_type(4)));
typedef unsigned u32x4 __attribute__((ext_vector_type(4)));
constexpr int BM = 256, BK = 64, HALF = 128, HTB = HALF * BK * 2  , STAGE_BYTES = 8 * HTB, NXCD = 8, WGM = 8;

__host__ __device__ __forceinline__ int lds_byte(int r, int c) { const int st = (r >> 4) * 2 + (c >> 5), rr = r & 15, cc = c & 31, ob = rr * 64 + cc * 2; return st * 1024 + (ob ^ (((ob >> 9) & 1) << 5)); }
__host__ __device__ __forceinline__ void stage_rc(int b, int& R, int& C) { const int st = b / 1024, sb = b % 1024, swz = sb ^ (((sb >> 9) & 1) << 5); R = (st >> 1) * 16 + swz / 64; C = (st & 1) * 32 + (swz % 64) / 2; }
__host__ __device__ __forceinline__ int perm32(int rho) { const int n = rho >> 4, i = rho & 15; return 8 * (i >> 2) + 4 * n + (i & 3); }

struct Unit { int pm, pn; };
struct Gemm { const bf16_t* A; const bf16_t* Bt; int M, N, K; int ld = 0; };

struct StaticOrder {
    int nM, nN, nwg, G, c;
    __host__ __device__ void init(int M, int N, int G_, int c_) { nM = M / BM; nN = N / BM; nwg = nM * nN; G = G_; c = c_; }
    __host__ __device__ bool next(int i, Unit& u) const {
        const long L = (long)i * G + c; if (L >= nwg) return false;
        int wgid = (int)L; { const int q = nwg / NXCD, r = nwg % NXCD, xcd = wgid % NXCD, off = wgid / NXCD; wgid = (xcd < r ? xcd * (q + 1) : r * (q + 1) + (xcd - r) * q) + off; }
        const int nig = WGM * nN, gid = wgid / nig, fm = gid * WGM, gsz = (nM - fm) < WGM ? (nM - fm) : WGM;
        u.pm = fm + ((wgid % nig) % gsz); u.pn = (wgid % nig) / gsz; return true;
    }
    __device__ __forceinline__ void a_ready(const Unit&) const {}
    __device__ __forceinline__ void done(const Unit&) const {}
};

__device__ __forceinline__ unsigned cvt_pk_bf16(float lo, float hi) { unsigned r; asm volatile("v_cvt_pk_bf16_f32 %0, %1, %2" : "=v"(r) : "v"(lo), "v"(hi)); return r; }
typedef float f32x2 __attribute__((ext_vector_type(2)));
__device__ __forceinline__ f32x2 gelu_pk(f32x2 v) {
    const f32x2 av = __builtin_elementwise_abs(v), d = av * 0.2316418882f + 1.0f;
    f32x2 t; t.x = __builtin_amdgcn_rcpf(d.x); t.y = __builtin_amdgcn_rcpf(d.y);
    f32x2 q = t * 0.5307027145f + (-0.7265760135f); q = q * t + 0.7107068705f; q = q * t + (-0.142248368f); q = q * t + 0.127414796f; q = q * t;
    const f32x2 s = (v * v) * (-0.72134752044f);
    f32x2 e; e.x = __builtin_amdgcn_exp2f(s.x); e.y = __builtin_amdgcn_exp2f(s.y);
    const f32x2 m = v * (q * e), r = v - m;
    f32x2 o; o.x = v.x < 0.f ? m.x : r.x; o.y = v.y < 0.f ? m.y : r.y; return o;
}

template <int ACT  > struct EpiBf16 {
    static constexpr bool PERM = true, AFTER_DRAIN = false; static_assert(ACT == 0 || ACT == 1, "EpiBf16: ACT is 0 (none) or 1 (gelu_pk)");
    bf16_t* O; int ldc; const float* bias; int split_cols; size_t split_stride; float scale0;
    __device__ __forceinline__ void operator()(const f32x4 (&acc)[2][2][4][2], const Unit& u, int wr, int wc, int fr, int fq) const {
        const int row0 = u.pm * BM + wr * 64 + fr; int colt = u.pn * BM; bf16_t* base = O;
        float sc = 1.f; if (split_cols) { const int t = colt / split_cols; base += (size_t)t * split_stride; colt -= t * split_cols; if (t == 0) sc = scale0; }
        const int col0 = colt + wc * 32 + 8 * fq, bcol0 = u.pn * BM + wc * 32 + 8 * fq;
        f32x4 bv[2][2];
#pragma unroll
        for (int bj = 0; bj < 2; ++bj)
#pragma unroll
            for (int n = 0; n < 2; ++n) bv[bj][n] = bias ? *(const f32x4*)(bias + bcol0 + bj * HALF + 4 * n) : (f32x4){0.f, 0.f, 0.f, 0.f};
#pragma unroll
        for (int ai = 0; ai < 2; ++ai)
#pragma unroll
            for (int m = 0; m < 4; ++m) { bf16_t* rowp = base + (size_t)(row0 + ai * HALF + m * 16) * ldc + col0;
#pragma unroll
                for (int bj = 0; bj < 2; ++bj) { f32x4 v0 = acc[ai][bj][m][0] + bv[bj][0], v1 = acc[ai][bj][m][1] + bv[bj][1];
                    if (ACT == 1) { f32x2 a = gelu_pk((f32x2){v0[0], v0[1]}), b = gelu_pk((f32x2){v0[2], v0[3]}), c = gelu_pk((f32x2){v1[0], v1[1]}), d = gelu_pk((f32x2){v1[2], v1[3]});
                        v0 = (f32x4){a.x, a.y, b.x, b.y}; v1 = (f32x4){c.x, c.y, d.x, d.y}; }
                    v0 = v0 * sc; v1 = v1 * sc; u32x4 w; w.x = cvt_pk_bf16(v0[0], v0[1]); w.y = cvt_pk_bf16(v0[2], v0[3]); w.z = cvt_pk_bf16(v1[0], v1[1]); w.w = cvt_pk_bf16(v1[2], v1[3]);
                    *(u32x4*)(rowp + bj * HALF) = w; } }
    }
};


template <class Epi, class Sched, bool ALIGN_EPI = false, bool SP2 = false>
__device__ __forceinline__ void gemm_phase(PG8_LAS unsigned char* lds, const Gemm g, const Sched& S, const Epi& E, const int tid_in) {
    int tid_l = tid_in; asm volatile("" : "+v"(tid_l));
    const int tid = tid_l, wid = __builtin_amdgcn_readfirstlane(tid >> 6), lane = tid & 63, wr = wid >> 2, wc = wid & 3, fr = lane & 15, fq = lane >> 4;
    const int K = g.K, nt = K / BK, LD = g.ld ? g.ld : g.K;
    unsigned voffA[2], voffB[2];
#pragma unroll
    for (int i = 0; i < 2; ++i) { int R, C; stage_rc(tid * 16 + i * 8192, R, C); const int Rb = Epi::PERM ? ((R & ~31) + perm32(R & 31)) : R;
        voffA[i] = (unsigned)(R * LD + C) * 2u; voffB[i] = (unsigned)(Rb * LD + C) * 2u; }
    const size_t kstep = (size_t)(BK * 2);
    const size_t hstep = (size_t)HALF * LD * 2;
    const size_t tstep = 2 * hstep;
    const unsigned ldsw = (unsigned)wid * 1024u;
    const int aoff = lds_byte(wr * 64 + fr, fq * 8), boff = lds_byte(wc * 32 + fr, fq * 8);
#define PG8_SA(b, h) (((b) * 2 + (h)) * HTB)
#define PG8_SB(b, h) ((4 + (b) * 2 + (h)) * HTB)
#define PG8_STAGE(bufoff, gbase, voff) do { _Pragma("unroll") for (int _i = 0; _i < 2; ++_i) \
        __builtin_amdgcn_global_load_lds((const unsigned*)((const char*)(gbase) + (voff)[_i]), (PG8_LAS unsigned*)(lds + (bufoff) + ldsw + _i * 8192), 16, 0, 0); } while (0)
#define PG8_LDA(dst, b, h) do { _Pragma("unroll") for (int m = 0; m < 4; ++m) _Pragma("unroll") for (int k = 0; k < 2; ++k) dst[m][k] = *(const PG8_LAS bf16x8*)(lds + PG8_SA(b, h) + aoff + m * 2048 + k * 1024); } while (0)
#define PG8_LDB(dst, b, h) do { _Pragma("unroll") for (int n = 0; n < 2; ++n) _Pragma("unroll") for (int k = 0; k < 2; ++k) dst[n][k] = *(const PG8_LAS bf16x8*)(lds + PG8_SB(b, h) + boff + n * 2048 + k * 1024); } while (0)
#define PG8_MMA(ai, bj, At, Bt) do { __builtin_amdgcn_s_setprio(1); _Pragma("unroll") for (int m = 0; m < 4; ++m) _Pragma("unroll") for (int n = 0; n < 2; ++n) _Pragma("unroll") for (int k = 0; k < 2; ++k) \
        acc[ai][bj][m][n] = __builtin_amdgcn_mfma_f32_16x16x32_bf16(Bt[n][k], At[m][k], acc[ai][bj][m][n], 0, 0, 0); __builtin_amdgcn_s_setprio(0); } while (0)
#define PG8_WAIT_V(n) asm volatile("s_waitcnt vmcnt(" #n ")" ::: "memory")
#define PG8_WAIT_L(n) asm volatile("s_waitcnt lgkmcnt(" #n ")" ::: "memory")
#define PG8_BAR __builtin_amdgcn_s_barrier()
#define PG8_SCHED __builtin_amdgcn_sched_barrier(0)
    Unit cur, nxt; int ui = 0;
    if (!S.next(0, cur)) return;
    f32x4 acc[2][2][4][2];
#pragma unroll
    for (int a = 0; a < 2; ++a)
#pragma unroll
        for (int b = 0; b < 2; ++b)
#pragma unroll
            for (int m = 0; m < 4; ++m)
#pragma unroll
                for (int n = 0; n < 2; ++n) acc[a][b][m][n] = (f32x4){0.f, 0.f, 0.f, 0.f};
    bf16x8 At[4][2], B0[2][2], B1[2][2];
    const char* cA = (const char*)g.A + (size_t)cur.pm * tstep; const char* cB = (const char*)g.Bt + (size_t)cur.pn * tstep;
    S.a_ready(cur);
    if constexpr (SP2) {
        PG8_STAGE(PG8_SB(0, 0), cB, voffB); PG8_STAGE(PG8_SB(0, 1), cB + hstep, voffB); PG8_STAGE(PG8_SA(0, 0), cA, voffA); PG8_STAGE(PG8_SA(0, 1), cA + hstep, voffA);
        if (wr == 1) PG8_BAR;
        PG8_WAIT_V(2); PG8_BAR;
        PG8_STAGE(PG8_SB(1, 0), cB + kstep, voffB); PG8_STAGE(PG8_SA(1, 0), cA + kstep, voffA); PG8_STAGE(PG8_SB(1, 1), cB + hstep + kstep, voffB);
        PG8_WAIT_V(6); PG8_BAR;
    } else {
        PG8_STAGE(PG8_SB(0, 0), cB, voffB); PG8_STAGE(PG8_SA(0, 0), cA, voffA); PG8_STAGE(PG8_SB(0, 1), cB + hstep, voffB); PG8_STAGE(PG8_SA(0, 1), cA + hstep, voffA);
        if (wr == 1) PG8_BAR;
        PG8_WAIT_V(4); PG8_BAR;
        PG8_STAGE(PG8_SB(1, 0), cB + kstep, voffB); PG8_STAGE(PG8_SA(1, 0), cA + kstep, voffA); PG8_STAGE(PG8_SB(1, 1), cB + hstep + kstep, voffB);
        PG8_WAIT_V(6); PG8_BAR;
    }
    for (;;) {
        const bool has_next = S.next(ui + 1, nxt);
        const char* nA = has_next ? (const char*)g.A + (size_t)nxt.pm * tstep : cA; const char* nB = has_next ? (const char*)g.Bt + (size_t)nxt.pn * tstep : cB;
        for (int t = 0; t < nt; t += 2) {
            const bool last = (t == nt - 2);
            const char* a1 = cA + (size_t)(t + 1) * kstep;
            const char* a2 = last ? nA : cA + (size_t)(t + 2) * kstep; const char* b2 = last ? nB : cB + (size_t)(t + 2) * kstep;
            const char* a3 = a2 + kstep; const char* b3 = b2 + kstep;
            if (last && has_next) S.a_ready(nxt);
            if constexpr (SP2) {
            PG8_LDB(B0, 0, 0); PG8_LDB(B1, 0, 1); PG8_SCHED; PG8_LDA(At, 0, 0); PG8_STAGE(PG8_SA(1, 1), a1 + hstep, voffA);
            PG8_WAIT_V(8); PG8_WAIT_L(0); PG8_BAR; PG8_MMA(0, 0, At, B0); PG8_MMA(0, 1, At, B1); PG8_BAR; PG8_SCHED;
            PG8_LDA(At, 0, 1); PG8_STAGE(PG8_SB(0, 0), b2, voffB); PG8_STAGE(PG8_SB(0, 1), b2 + hstep, voffB); PG8_STAGE(PG8_SA(0, 0), a2, voffA);
            PG8_WAIT_V(8); PG8_WAIT_L(0); PG8_BAR; PG8_MMA(1, 0, At, B0); PG8_MMA(1, 1, At, B1); PG8_BAR; PG8_SCHED;
            PG8_LDB(B0, 1, 0); PG8_LDB(B1, 1, 1); PG8_SCHED; PG8_LDA(At, 1, 0); PG8_STAGE(PG8_SA(0, 1), a2 + hstep, voffA);
            PG8_WAIT_V(8); PG8_WAIT_L(0); PG8_BAR; PG8_MMA(0, 0, At, B0); PG8_MMA(0, 1, At, B1); PG8_BAR; PG8_SCHED;
            PG8_LDA(At, 1, 1); PG8_STAGE(PG8_SB(1, 0), b3, voffB); PG8_STAGE(PG8_SB(1, 1), b3 + hstep, voffB); PG8_STAGE(PG8_SA(1, 0), a3, voffA);
            PG8_WAIT_V(8); PG8_WAIT_L(0); PG8_BAR; PG8_MMA(1, 0, At, B0); PG8_MMA(1, 1, At, B1); PG8_BAR; PG8_SCHED;
            } else {
            PG8_LDB(B0, 0, 0); PG8_SCHED; PG8_LDA(At, 0, 0); PG8_STAGE(PG8_SA(1, 1), a1 + hstep, voffA);
            PG8_WAIT_L(8); PG8_BAR; PG8_WAIT_L(0); PG8_MMA(0, 0, At, B0); PG8_BAR; PG8_SCHED;
            PG8_LDB(B1, 0, 1); PG8_STAGE(PG8_SB(0, 0), b2, voffB);
            PG8_BAR; PG8_WAIT_L(0); PG8_MMA(0, 1, At, B1); PG8_BAR;
            PG8_LDA(At, 0, 1); PG8_STAGE(PG8_SA(0, 0), a2, voffA);
            PG8_BAR; PG8_WAIT_L(0); PG8_MMA(1, 0, At, B0); PG8_BAR; PG8_SCHED;
            PG8_STAGE(PG8_SB(0, 1), b2 + hstep, voffB);
            PG8_WAIT_V(6); PG8_BAR; PG8_MMA(1, 1, At, B1); PG8_BAR;
            PG8_LDB(B0, 1, 0); PG8_SCHED; PG8_LDA(At, 1, 0); PG8_STAGE(PG8_SA(0, 1), a2 + hstep, voffA);
            PG8_WAIT_L(8); PG8_BAR; PG8_WAIT_L(0); PG8_MMA(0, 0, At, B0); PG8_BAR; PG8_SCHED;
            PG8_LDB(B1, 1, 1); PG8_STAGE(PG8_SB(1, 0), b3, voffB);
            PG8_BAR; PG8_WAIT_L(0); PG8_MMA(0, 1, At, B1); PG8_BAR;
            PG8_LDA(At, 1, 1); PG8_STAGE(PG8_SA(1, 0), a3, voffA);
            PG8_BAR; PG8_WAIT_L(0); PG8_MMA(1, 0, At, B0); PG8_BAR; PG8_SCHED;
            PG8_STAGE(PG8_SB(1, 1), b3 + hstep, voffB);
            PG8_WAIT_V(6); PG8_BAR; PG8_MMA(1, 1, At, B1); PG8_BAR;
            }
        }
        if constexpr (ALIGN_EPI) { if (wr == 0) PG8_BAR; }
        if constexpr (!Epi::AFTER_DRAIN) { E(acc, cur, wr, wc, fr, fq); S.done(cur); }
        if (!has_next) break;
#pragma unroll
        for (int a = 0; a < 2; ++a)
#pragma unroll
            for (int b = 0; b < 2; ++b)
#pragma unroll
                for (int m = 0; m < 4; ++m)
#pragma unroll
                    for (int n = 0; n < 2; ++n) acc[a][b][m][n] = (f32x4){0.f, 0.f, 0.f, 0.f};
        cur = nxt; cA = nA; cB = nB; ++ui;
        if constexpr (ALIGN_EPI) { if (wr == 1) PG8_BAR; }
    }
    PG8_WAIT_V(0);
    if constexpr (!ALIGN_EPI) { if (wr == 0) PG8_BAR; }
    PG8_BAR;
    if constexpr (Epi::AFTER_DRAIN) { E.fused(acc, cur, wr, wc, fr, fq, lds, wid, lane); S.done(cur); }
#undef PG8_SA
#undef PG8_SB
#undef PG8_STAGE
#undef PG8_LDA
#undef PG8_LDB
#undef PG8_MMA
#undef PG8_WAIT_V
#undef PG8_WAIT_L
#undef PG8_BAR
#undef PG8_SCHED
}
}
#define GAS __attribute__((address_space(1)))
#define LAS __attribute__((address_space(3)))
typedef unsigned short bf16;
typedef unsigned v4u __attribute__((ext_vector_type(4)));
typedef float f32x4 __attribute__((ext_vector_type(4)));
typedef short bf16x8 __attribute__((ext_vector_type(8)));
typedef GAS unsigned gu32;
typedef GAS unsigned long long gu64;
#define RLX_AGENT __ATOMIC_RELAXED, __HIP_MEMORY_SCOPE_AGENT
#define LDS_WAIT() asm volatile("s_waitcnt lgkmcnt(0)" ::: "memory")
#define VM_WAIT() asm volatile("s_waitcnt vmcnt(0)" ::: "memory")
__device__ __forceinline__ unsigned long long rt() { return __builtin_amdgcn_s_memrealtime(); }
__device__ __forceinline__ unsigned f2bf(float f) { unsigned u = __builtin_bit_cast(unsigned, f); return (u + 0x7fffu + ((u >> 16) & 1u)) >> 16; }
__device__ __forceinline__ unsigned pk2(float lo, float hi) { return f2bf(lo) | (f2bf(hi) << 16); }

#define XB_TMO      128
#define XB_XCNT(j)  (256  + 64 * (j))
#define XB_XSUB(j)  (1280 + 64 * (j))
#define XB_XGEN(j)  (2304 + 64 * (j))
#define XB_TOP      3328
#define XB_TOPGEN   3392
#define XCD_BAR_WORDS 3456
#define XB_SPIN_CAP (1u << 18)

__device__ __forceinline__ unsigned xb_ld(unsigned* p)              { return __hip_atomic_load(p, __ATOMIC_RELAXED, __HIP_MEMORY_SCOPE_AGENT); }
__device__ __forceinline__ unsigned xb_add(unsigned* p, unsigned v) { return __hip_atomic_fetch_add(p, v, __ATOMIC_RELAXED, __HIP_MEMORY_SCOPE_AGENT); }
__device__ __forceinline__ unsigned xb_xcc_id() { return (unsigned)__builtin_amdgcn_s_getreg((3 << 11) | 20) & 0xFu; }
#define XB_SPIN(cond, bar) do { unsigned _sp = 0; while (cond) { __builtin_amdgcn_s_sleep(1); \
    if ((++_sp & 255u) == 0u) { if (xb_ld(&(bar)[XB_TMO])) break; if (_sp > XB_SPIN_CAP) { atomicAdd(&(bar)[XB_TMO], 1u); break; } } } } while (0)

struct XcdBarrier {
    unsigned* bar; unsigned x;
    volatile LAS unsigned* st;
};

__device__ __forceinline__ XcdBarrier xcd_barrier_post(unsigned* bar, volatile LAS unsigned* st) {
    XcdBarrier b; b.bar = bar; b.x = xb_xcc_id(); b.st = st;
    if (threadIdx.x == 0) (void)xb_add(&bar[XB_XCNT(b.x)], 1u);
    return b;
}
__device__ __forceinline__ void xcd_barrier_complete(unsigned* bar, unsigned x, unsigned& nloc, unsigned& nx) {
    const unsigned G = gridDim.x * gridDim.y * gridDim.z;
    unsigned sum, cnt, mine, sp = 0u;
    for (;;) {
        sum = 0u; cnt = 0u; mine = 0u;
#pragma unroll
        for (unsigned j = 0; j < 16; ++j) { const unsigned c = xb_ld(&bar[XB_XCNT(j)]); sum += c; cnt += (c > 0u) ? 1u : 0u; mine = (j == x) ? c : mine; }
        if (sum == G) break;
        __builtin_amdgcn_s_sleep(1);
        if ((++sp & 255u) == 0u) { if (xb_ld(&bar[XB_TMO])) break; if (sp > XB_SPIN_CAP) { atomicAdd(&bar[XB_TMO], 1u); break; } }
    }
    nloc = mine > 0u ? mine : 1u; nx = cnt > 0u ? cnt : 1u;
}

__device__ __forceinline__ void xcd_barrier(const XcdBarrier& b, const int tid_in) {
    asm volatile("s_waitcnt vmcnt(0)" ::: "memory");
    __syncthreads();
    if (tid_in == 0) {
        unsigned* bar = b.bar;
        __builtin_amdgcn_s_waitcnt(0);
        unsigned nloc = b.st[0], nx = b.st[1];
        if (nloc == 0u) { xcd_barrier_complete(bar, b.x, nloc, nx); b.st[0] = nloc; b.st[1] = nx; }
        const unsigned old = xb_add(&bar[XB_XSUB(b.x)], 1u);
        const unsigned gen = old / nloc;
        if (old + 1u == (gen + 1u) * nloc) {
            __builtin_amdgcn_fence(__ATOMIC_RELEASE, "agent");
            asm volatile("s_waitcnt vmcnt(0)" ::: "memory");
            const unsigned og = xb_add(&bar[XB_TOP], 1u);
            const unsigned tg = og / nx;
            if (og + 1u == (tg + 1u) * nx) xb_add(&bar[XB_TOPGEN], 1u);
            else XB_SPIN(xb_ld(&bar[XB_TOPGEN]) == tg, bar);
            __builtin_amdgcn_fence(__ATOMIC_ACQUIRE, "agent");
            xb_add(&bar[XB_XGEN(b.x)], 1u);
            asm volatile("s_waitcnt vmcnt(0)" ::: "memory");
        } else {
            XB_SPIN(xb_ld(&bar[XB_XGEN(b.x)]) == gen, bar);
            __builtin_amdgcn_fence(__ATOMIC_ACQUIRE, "agent");
            asm volatile("s_waitcnt vmcnt(0)" ::: "memory");
        }
    }
    __syncthreads();
}

#ifndef MK_ONE_LAUNCH
#define MK_ONE_LAUNCH 1
#endif
#ifndef PROBE_REP_MASK
#define PROBE_REP_MASK 0
#endif
#define REPS(bit) _Pragma("unroll") for (int rep_ = 0; rep_ < ((PROBE_REP_MASK >> (bit)) & 1) + 1; ++rep_)
constexpr int NWAVES = 8, NTHREADS = NWAVES * 64;
constexpr int BATCH = 8, SEQ = 2048, T = BATCH * SEQ, D = 1024, DEPTH = 2;
constexpr int NPROJ = 4352;
constexpr int N_INPUTS = 29;
constexpr int NADA = 6144;
constexpr float RMS_EPS = 1e-6f;
constexpr float QSCALE = 0.10206207261596575f * 1.4426950408889634f;
enum { I_X = 0, I_C, I_POS, I_WADA, I_BADA, I_N1G, I_WIN, I_QNG, I_WQUP, I_KVNG, I_WKVUP, I_WBA, I_CONVW, I_CONVB, I_WQM, I_WKM, I_WVM, I_BI, I_BF, I_MHG, I_MSKIP,
       I_WBM, I_WOUT, I_N2G, I_PWQ, I_PKEYS, I_PU, I_PV, I_FG };

constexpr size_t MiB = 1u << 20;
constexpr size_t WS_CTL = 0, CTL_ZERO_BYTES = 1 * MiB;
constexpr int CW_BAR = 4096;
constexpr int CW_XC = 8192;
constexpr size_t ADA_OFF = 256 * 1024;
constexpr size_t WS_COS = 1 * MiB, WS_SIN = 2 * MiB;
constexpr size_t WS_W = 3 * MiB, W_LAYER = 18 * MiB;
constexpr size_t WO_WIN = 0, WO_WQ = 8912896, WO_WKV = WO_WQ + 1179648, WO_WA = WO_WKV + 524288, WO_WM = WO_WA + 1048576, WO_WO = WO_WM + 1048576,
                 WO_PWQ = WO_WO + 2097152, WO_WQK = WO_PWQ + 2097152, WO_WV = WO_WQK + 1048576, WO_KEYB = WO_WV + 524288;
static_assert(WO_KEYB + 262144 <= W_LAYER, "weights fit");
constexpr size_t WS_X = 40 * MiB, WS_H = 104 * MiB, WS_QLAT = 136 * MiB, WS_KVLAT = 160 * MiB, WS_UM = 168 * MiB, WS_OPRE = 184 * MiB, WS_GA = 200 * MiB, WS_GM = 232 * MiB,
                 WS_SMALL = 264 * MiB, WS_RQ = 268 * MiB, WS_RKV = WS_RQ + 65536, WS_LOGI = WS_RQ + 262144, WS_LOGF = WS_RQ + 524288, WS_Q = 269 * MiB, WS_K = 293 * MiB,
                 WS_V = 317 * MiB, WS_CONV = 333 * MiB, WS_QKM = 349 * MiB, WS_VM = 381 * MiB, WS_AO = 397 * MiB, WS_OUTM = 413 * MiB, WS_U8 = 429 * MiB, WS_V8 = 445 * MiB, WS_END = 493 * MiB;
constexpr size_t WS_H8 = 493 * MiB, WS_XS = WS_RQ + 131072, WS_USC = WS_RQ + 786432;
constexpr size_t WS_END2 = 509 * MiB;
constexpr size_t WS_IDX = WS_UM, WS_GATE = WS_UM + 8 * MiB, WS_ACT = WS_OPRE;
constexpr size_t WS_SMALLP = WS_OUTM;
constexpr size_t WS_PQ = WS_QLAT, WS_MERGED = WS_QLAT;

constexpr int RING_OFF = 0, RING_BYTES = 131072;
constexpr int LDSCTL_OFF = RING_BYTES, MISC_OFF = LDSCTL_OFF + 320;
constexpr int LDS_BYTES = 147456;

typedef float f32x2v __attribute__((ext_vector_type(2)));
typedef unsigned u32x2 __attribute__((ext_vector_type(2)));

__device__ __forceinline__ float wave_sum(float v) {
#pragma unroll
    for (int o = 1; o < 64; o <<= 1) v += __shfl_xor(v, o);
    return v;
}
__device__ __forceinline__ float bflo(unsigned u) { return __uint_as_float(u << 16); }
__device__ __forceinline__ float bfhi(unsigned u) { return __uint_as_float(u & 0xffff0000u); }
__device__ __forceinline__ float sigm(float x) { return 1.f / (1.f + __expf(-x)); }
__device__ __forceinline__ float dot4(f32x4 a, f32x4 b) { return (a.x * b.x + a.y * b.y) + (a.z * b.z + a.w * b.w); }
__device__ __forceinline__ float gelu_erf(float x) { return 0.5f * x * (1.f + erff(x * 0.70710678118654752f)); }

struct EpiProj {
    static constexpr bool PERM = true, AFTER_DRAIN = false;
    bf16 *qlat, *kvlat, *um, *opre, *ga, *gm; float* small;
    __device__ __forceinline__ void operator()(const f32x4 (&acc)[2][2][4][2], const pg8::Unit& u, int wr, int wc, int fr, int fq) const {
        const int pn = u.pn; bf16* dst; int ld, cb; int mode = 0;
        if (pn < 3) { dst = qlat; ld = 768; cb = pn * 256; }
        else if (pn == 3) { dst = kvlat; ld = 256; cb = 0; }
        else if (pn < 6) { dst = um; ld = 512; cb = (pn - 4) * 256; }
        else if (pn < 8) { dst = opre; ld = 512; cb = (pn - 6) * 256; }
        else if (pn < 12) { dst = ga; ld = 1024; cb = (pn - 8) * 256; mode = 1; }
        else if (pn < 16) { dst = gm; ld = 1024; cb = (pn - 12) * 256; mode = 1; }
        else { dst = nullptr; ld = 0; cb = 0; mode = 2; }
        const int row0 = u.pm * 256 + wr * 64 + fr;
        if (mode == 2) {
            if (wc < 2) {
#pragma unroll
                for (int ai = 0; ai < 2; ++ai)
#pragma unroll
                    for (int m = 0; m < 4; ++m) { float* p = small + (size_t)(row0 + ai * 128 + m * 16) * 64 + wc * 32 + 8 * fq;
                        *(f32x4*)p = acc[ai][0][m][0]; *(f32x4*)(p + 4) = acc[ai][0][m][1]; }
            }
        } else {
#pragma unroll
            for (int ai = 0; ai < 2; ++ai)
#pragma unroll
                for (int m = 0; m < 4; ++m) { bf16* rowp = dst + (size_t)(row0 + ai * 128 + m * 16) * ld + cb + wc * 32 + 8 * fq;
#pragma unroll
                    for (int bj = 0; bj < 2; ++bj) { f32x4 v0 = acc[ai][bj][m][0], v1 = acc[ai][bj][m][1];
                        if (mode == 1) { v0 = (f32x4){sigm(v0[0]), sigm(v0[1]), sigm(v0[2]), sigm(v0[3])}; v1 = (f32x4){sigm(v1[0]), sigm(v1[1]), sigm(v1[2]), sigm(v1[3])}; }
                        v4u w; w.x = pk2(v0[0], v0[1]); w.y = pk2(v0[2], v0[3]); w.z = pk2(v1[0], v1[1]); w.w = pk2(v1[2], v1[3]);
                        *(v4u*)(rowp + bj * 128) = w; } }
        }
    }
};
struct EpiSmallPart {
    static constexpr bool PERM = true, AFTER_DRAIN = false;
    float* part;
    __device__ __forceinline__ void operator()(const f32x4 (&acc)[2][2][4][2], const pg8::Unit& u, int wr, int wc, int fr, int fq) const {
        if (wc >= 2) return;
        const int row0 = u.pm * 256 + wr * 64 + fr;
#pragma unroll
        for (int ai = 0; ai < 2; ++ai)
#pragma unroll
            for (int m = 0; m < 4; ++m) { float* p = part + (size_t)(row0 + ai * 128 + m * 16) * 64 + wc * 32 + 8 * fq;
                *(f32x4*)p = acc[ai][0][m][0]; *(f32x4*)(p + 4) = acc[ai][0][m][1]; }
    }
};
struct EpiQ {
    static constexpr bool PERM = true, AFTER_DRAIN = false;
    bf16* Q; const float* rq; const float* cosT; const float* sinT;
    __device__ __forceinline__ void operator()(const f32x4 (&acc)[2][2][4][2], const pg8::Unit& u, int wr, int wc, int fr, int fq) const {
        const int row0 = u.pm * 256 + wr * 64 + fr;
        int c0b[2], d0b[2];
#pragma unroll
        for (int bj = 0; bj < 2; ++bj) { c0b[bj] = u.pn * 256 + bj * 128 + wc * 32 + 8 * fq; d0b[bj] = c0b[bj] % 96; }
#pragma unroll
        for (int ai = 0; ai < 2; ++ai) {
            float rr[4]; f32x4 csv[4][2], snv[4][2];
#pragma unroll
            for (int m = 0; m < 4; ++m) { const int row = row0 + ai * 128 + m * 16; rr[m] = rq[row];
#pragma unroll
                for (int bj = 0; bj < 2; ++bj) { csv[m][bj] = (f32x4){1.f, 1.f, 1.f, 1.f}; snv[m][bj] = (f32x4){0.f, 0.f, 0.f, 0.f};
                    if (d0b[bj] >= 64) { const int j0 = (d0b[bj] - 64) >> 1; csv[m][bj] = *(const f32x4*)(cosT + (size_t)row * 16 + j0); snv[m][bj] = *(const f32x4*)(sinT + (size_t)row * 16 + j0); } } }
            __builtin_amdgcn_sched_barrier(0);
#pragma unroll
            for (int m = 0; m < 4; ++m) { const int row = row0 + ai * 128 + m * 16; const float r = rr[m];
#pragma unroll
                for (int bj = 0; bj < 2; ++bj) {
                    f32x4 v0 = acc[ai][bj][m][0] * r, v1 = acc[ai][bj][m][1] * r;
                    if (d0b[bj] >= 64) { const f32x4 cs = csv[m][bj], sn = snv[m][bj]; const f32x4 a0 = v0, a1 = v1;
                        v0[0] = a0[0] * cs[0] - a0[1] * sn[0]; v0[1] = a0[1] * cs[0] + a0[0] * sn[0];
                        v0[2] = a0[2] * cs[1] - a0[3] * sn[1]; v0[3] = a0[3] * cs[1] + a0[2] * sn[1];
                        v1[0] = a1[0] * cs[2] - a1[1] * sn[2]; v1[1] = a1[1] * cs[2] + a1[0] * sn[2];
                        v1[2] = a1[2] * cs[3] - a1[3] * sn[3]; v1[3] = a1[3] * cs[3] + a1[2] * sn[3]; }
                    v4u w; w.x = pk2(v0[0], v0[1]); w.y = pk2(v0[2], v0[3]); w.z = pk2(v1[0], v1[1]); w.w = pk2(v1[2], v1[3]);
                    *(v4u*)(Q + (size_t)row * 768 + c0b[bj]) = w; } }
        }
    }
};
struct EpiKV {
    static constexpr bool PERM = true, AFTER_DRAIN = false;
    bf16* K; bf16* V; const float* rkv;
    __device__ __forceinline__ void operator()(const f32x4 (&acc)[2][2][4][2], const pg8::Unit& u, int wr, int wc, int fr, int fq) const {
        const int row0 = u.pm * 256 + wr * 64 + fr;
        float rr[2][4];
#pragma unroll
        for (int ai = 0; ai < 2; ++ai)
#pragma unroll
            for (int m = 0; m < 4; ++m) rr[ai][m] = rkv[row0 + ai * 128 + m * 16];
#pragma unroll
        for (int ai = 0; ai < 2; ++ai)
#pragma unroll
            for (int m = 0; m < 4; ++m) { const int row = row0 + ai * 128 + m * 16; const float r = rr[ai][m];
#pragma unroll
                for (int bj = 0; bj < 2; ++bj) { const int c0 = u.pn * 256 + bj * 128 + wc * 32 + 8 * fq;
                    const f32x4 v0 = acc[ai][bj][m][0] * r, v1 = acc[ai][bj][m][1] * r;
                    bf16* dst = (c0 < 512) ? (K + (size_t)row * 768 + 96 * (c0 >> 6) + (c0 & 63)) : (V + (size_t)row * 512 + (c0 - 512));
                    v4u w; w.x = pk2(v0[0], v0[1]); w.y = pk2(v0[2], v0[3]); w.z = pk2(v1[0], v1[1]); w.w = pk2(v1[2], v1[3]);
                    *(v4u*)dst = w; } }
    }
};
struct EpiMerge {
    static constexpr bool PERM = true, AFTER_DRAIN = false;
    bf16* Mg; const bf16* gate; int first;
    __device__ __forceinline__ void operator()(const f32x4 (&acc)[2][2][4][2], const pg8::Unit& u, int wr, int wc, int fr, int fq) const {
        const int row0 = u.pm * 256 + wr * 64 + fr, cbase = u.pn * 256 + wc * 32 + 8 * fq;
#pragma unroll
        for (int ai = 0; ai < 2; ++ai) {
            v4u gq[4][2], oq[4][2];
#pragma unroll
            for (int m = 0; m < 4; ++m)
#pragma unroll
                for (int bj = 0; bj < 2; ++bj) { const size_t off = (size_t)(row0 + ai * 128 + m * 16) * 1024 + cbase + bj * 128;
                    gq[m][bj] = *(const v4u*)(gate + off); oq[m][bj] = first ? (v4u){0u, 0u, 0u, 0u} : *(const v4u*)(Mg + off); }
            __builtin_amdgcn_sched_barrier(0);
#pragma unroll
            for (int m = 0; m < 4; ++m)
#pragma unroll
                for (int bj = 0; bj < 2; ++bj) { const size_t off = (size_t)(row0 + ai * 128 + m * 16) * 1024 + cbase + bj * 128;
                    const v4u g = gq[m][bj], o = oq[m][bj];
                    f32x4 v0 = acc[ai][bj][m][0], v1 = acc[ai][bj][m][1];
                    v0[0] = v0[0] * bflo(g.x) + bflo(o.x); v0[1] = v0[1] * bfhi(g.x) + bfhi(o.x); v0[2] = v0[2] * bflo(g.y) + bflo(o.y); v0[3] = v0[3] * bfhi(g.y) + bfhi(o.y);
                    v1[0] = v1[0] * bflo(g.z) + bflo(o.z); v1[1] = v1[1] * bfhi(g.z) + bfhi(o.z); v1[2] = v1[2] * bflo(g.w) + bflo(o.w); v1[3] = v1[3] * bfhi(g.w) + bfhi(o.w);
                    v4u w; w.x = pk2(v0[0], v0[1]); w.y = pk2(v0[2], v0[3]); w.z = pk2(v1[0], v1[1]); w.w = pk2(v1[2], v1[3]);
                    *(v4u*)(Mg + off) = w; }
        }
    }
};
struct EpiResid {
    static constexpr bool PERM = true, AFTER_DRAIN = false;
    const float* xin; float* xout; const float* gate;
    __device__ __forceinline__ void operator()(const f32x4 (&acc)[2][2][4][2], const pg8::Unit& u, int wr, int wc, int fr, int fq) const {
        const int row0 = u.pm * 256 + wr * 64 + fr, b = (u.pm * 256) >> 11, cbase = u.pn * 256 + wc * 32 + 8 * fq;
        f32x4 gv[2][2];
#pragma unroll
        for (int bj = 0; bj < 2; ++bj) { const float* gp = gate + (size_t)b * NADA + cbase + bj * 128; gv[bj][0] = *(const f32x4*)gp; gv[bj][1] = *(const f32x4*)(gp + 4); }
#pragma unroll
        for (int ai = 0; ai < 2; ++ai) {
            f32x4 xv[4][2][2];
#pragma unroll
            for (int m = 0; m < 4; ++m)
#pragma unroll
                for (int bj = 0; bj < 2; ++bj) { const size_t off = (size_t)(row0 + ai * 128 + m * 16) * 1024 + cbase + bj * 128; xv[m][bj][0] = *(const f32x4*)(xin + off); xv[m][bj][1] = *(const f32x4*)(xin + off + 4); }
            __builtin_amdgcn_sched_barrier(0);
#pragma unroll
            for (int m = 0; m < 4; ++m)
#pragma unroll
                for (int bj = 0; bj < 2; ++bj) { const size_t off = (size_t)(row0 + ai * 128 + m * 16) * 1024 + cbase + bj * 128;
                    *(f32x4*)(xout + off) = xv[m][bj][0] + gv[bj][0] * acc[ai][bj][m][0]; *(f32x4*)(xout + off + 4) = xv[m][bj][1] + gv[bj][1] * acc[ai][bj][m][1]; }
        }
    }
};

template <class Get> __device__ __forceinline__ void prep_tile(const Get& get, bf16* dst, int K, int k0, int n0, LAS float* scr, int lane) {
    float tv[32];
#pragma unroll
    for (int i = 0; i < 32; ++i) tv[i] = get(k0 + 2 * i + (lane >> 5), n0 + (lane & 31));
#pragma unroll
    for (int i = 0; i < 32; ++i) { const int kk = 2 * i + (lane >> 5); scr[kk * 33 + (lane & 31)] = tv[i]; }
    LDS_WAIT(); asm volatile("" ::: "memory");
    const int c = lane & 7;
#pragma unroll
    for (int j = 0; j < 4; ++j) { const int n = (lane >> 3) + 8 * j; const LAS float* s = scr + (8 * c) * 33 + n;
        v4u o; o.x = pk2(s[0 * 33], s[1 * 33]); o.y = pk2(s[2 * 33], s[3 * 33]); o.z = pk2(s[4 * 33], s[5 * 33]); o.w = pk2(s[6 * 33], s[7 * 33]);
        *(GAS v4u*)(dst + (size_t)(n0 + n) * K + k0 + 8 * c) = o; }
    LDS_WAIT(); asm volatile("" ::: "memory");
}
struct GetWin { const float* w; __device__ __forceinline__ float operator()(int k, int n) const {
    int sc; if (n < 1024) sc = n; else if (n < 2048) sc = n + 32; else if (n < 4096) sc = n + 40; else if (n < 4128) sc = n - 3072; else if (n < 4136) sc = n - 2048; else sc = -1;
    return sc < 0 ? 0.f : w[(size_t)k * 4136 + sc]; } };
struct GetWq { const float* w; const float* g; __device__ __forceinline__ float operator()(int k, int n) const {
    const int h = n / 96, dd = n % 96; const int e = dd - 64; const int sd = dd < 64 ? dd : 64 + (e >> 1) + 16 * (e & 1);
    return w[(size_t)k * 768 + h * 96 + sd] * g[k] * QSCALE; } };
struct GetWkv { const float* w; const float* g; __device__ __forceinline__ float operator()(int k, int n) const {
    const int nn = n & 511, h = nn >> 6, c = nn & 63; const int sc = h * 128 + c + ((n >= 512) ? 64 : 0);
    return w[(size_t)k * 1024 + sc] * g[k]; } };
struct GetPlain { const float* w; int N; __device__ __forceinline__ float operator()(int k, int n) const { return w[(size_t)k * N + n]; } };
struct GetWqk { const float* wq; const float* wk; __device__ __forceinline__ float operator()(int k, int n) const {
    const int part = n >> 9, nn = n & 511, h = nn >> 7, e = nn & 127, kh = k >> 7, d = k & 127;
    if (kh != h) return 0.f;
    const size_t off = ((size_t)h * 128 + d) * 128 + e;
    return part ? wk[off] * 0.08838834764831845f : wq[off]; } };
struct GetWv { const float* wv; __device__ __forceinline__ float operator()(int k, int n) const {
    const int h = n >> 7, e = n & 127, kh = k >> 7, d = k & 127;
    return (kh != h) ? 0.f : wv[((size_t)h * 128 + d) * 128 + e]; } };

__device__ const float INV_FREQ[16] = { 1.0f, 0.5623413251903491f, 0.31622776601683794f, 0.1778279410038923f, 0.1f, 0.05623413251903491f, 0.031622776601683794f, 0.01778279410038923f,
    0.01f, 0.005623413251903491f, 0.0031622776601683794f, 0.001778279410038923f, 0.001f, 0.0005623413251903491f, 0.00031622776601683794f, 0.0001778279410038923f };

__device__ __forceinline__ void rowpass_norm_mod(const float* xin, const float* g, const float* ada_shift, const float* ada_scale, bf16* hout, int gw, int NGW, int lane, unsigned char* h8 = nullptr, float* xs = nullptr) {
    f32x4 vn[4];
    if (gw < T) {
#pragma unroll
        for (int j = 0; j < 4; ++j) vn[j] = ((const f32x4*)(xin + (size_t)gw * D) + lane)[64 * j]; }
    for (int t = gw; t < T; t += NGW) {
        const int b = t >> 11;
        f32x4 v[4]; float s = 0.f;
#pragma unroll
        for (int j = 0; j < 4; ++j) { v[j] = vn[j]; s += dot4(v[j], v[j]); }
        { const int tn = (t + NGW < T) ? t + NGW : t;
#pragma unroll
          for (int j = 0; j < 4; ++j) vn[j] = ((const f32x4*)(xin + (size_t)tn * D) + lane)[64 * j]; }
        const float r = rsqrtf(wave_sum(s) * (1.f / D) + RMS_EPS);
        unsigned long long* o8 = (unsigned long long*)(hout + (size_t)t * D) + lane;
        f32x4 ov[4]; float am = 0.f;
#pragma unroll
        for (int j = 0; j < 4; ++j) { const int col = 4 * lane + 256 * j;
            const f32x4 gg = *(const f32x4*)(g + col), sc = *(const f32x4*)(ada_scale + (size_t)b * NADA + col), sh = *(const f32x4*)(ada_shift + (size_t)b * NADA + col);
            const f32x4 o = v[j] * r * gg * (sc + 1.f) + sh; ov[j] = o;
            am = fmaxf(fmaxf(am, fmaxf(fabsf(o.x), fabsf(o.y))), fmaxf(fabsf(o.z), fabsf(o.w)));
            o8[64 * j] = (unsigned long long)pk2(o.x, o.y) | ((unsigned long long)pk2(o.z, o.w) << 32); }
        if (h8) {
#pragma unroll
            for (int o = 1; o < 64; o <<= 1) am = fmaxf(am, __shfl_xor(am, o));
            const float inv = am > 0.f ? 127.f / am : 0.f;
#pragma unroll
            for (int j = 0; j < 4; ++j) { const int q0 = (int)rintf(ov[j].x * inv), q1 = (int)rintf(ov[j].y * inv), q2 = (int)rintf(ov[j].z * inv), q3 = (int)rintf(ov[j].w * inv);
                ((unsigned*)(h8 + (size_t)t * D))[lane + 64 * j] = (unsigned)(q0 & 255) | ((unsigned)(q1 & 255) << 8) | ((unsigned)(q2 & 255) << 16) | ((unsigned)(q3 & 255) << 24); }
            if (lane == 0) xs[t] = am * (1.f / 127.f);
        }
    }
}
__device__ __forceinline__ void rowpass_final(const float* xin, const float* g, float* out, int gw, int NGW, int lane) {
    f32x4 vn[4];
    if (gw < T) {
#pragma unroll
        for (int j = 0; j < 4; ++j) vn[j] = ((const f32x4*)(xin + (size_t)gw * D) + lane)[64 * j]; }
    for (int t = gw; t < T; t += NGW) {
        f32x4 v[4]; float s = 0.f;
#pragma unroll
        for (int j = 0; j < 4; ++j) { v[j] = vn[j]; s += dot4(v[j], v[j]); }
        { const int tn = (t + NGW < T) ? t + NGW : t;
#pragma unroll
          for (int j = 0; j < 4; ++j) vn[j] = ((const f32x4*)(xin + (size_t)tn * D) + lane)[64 * j]; }
        const float r = rsqrtf(wave_sum(s) * (1.f / D) + RMS_EPS);
        f32x4* o = (f32x4*)(out + (size_t)t * D) + lane;
#pragma unroll
        for (int j = 0; j < 4; ++j) { const f32x4 gg = *(const f32x4*)(g + 4 * lane + 256 * j); o[64 * j] = v[j] * r * gg; }
    }
}
__device__ __forceinline__ void rowpass_mid(const bf16* qlat, const bf16* kvlat, const float* small, const float* smallp, const float* cosT, const float* sinT, const bf16* um,
                                            const float* conv_w, const float* conv_b, const float* b_i, const float* b_f,
                                            float* RQ, float* RKV, bf16* K, float* LOGI, float* LOGF, bf16* CONV, int gw, int NGW, int lane) {
    const int c0 = 8 * lane;
    f32x4 cw[4][2], cb[2];
#pragma unroll
    for (int j = 0; j < 4; ++j) { cw[j][0] = *(const f32x4*)(conv_w + j * 512 + c0); cw[j][1] = *(const f32x4*)(conv_w + j * 512 + c0 + 4); }
    cb[0] = *(const f32x4*)(conv_b + c0); cb[1] = *(const f32x4*)(conv_b + c0 + 4);
    const float bsel = (lane >= 32 && lane < 36) ? b_i[lane - 32] : (lane >= 36 && lane < 40) ? b_f[lane - 36] : 0.f;
    for (int tb = gw * 4; tb < T; tb += NGW * 4) {
        const int pos0 = tb & (SEQ - 1);
        u32x2 qv[4][3], kvv[4]; v4u uw[7]; float sv[4], cs[4], sn[4];
#pragma unroll
        for (int i = 0; i < 4; ++i) { const int t = tb + i; const u32x2* p = (const u32x2*)(qlat + (size_t)t * 768);
#pragma unroll
            for (int j = 0; j < 3; ++j) qv[i][j] = p[lane + 64 * j];
            kvv[i] = ((const u32x2*)(kvlat + (size_t)t * 256))[lane];
            sv[i] = 0.f;
            if (lane < 40) sv[i] = smallp ? ((smallp[(size_t)t * 64 + lane] + smallp[(size_t)(T + t) * 64 + lane]) + (smallp[(size_t)(2 * T + t) * 64 + lane] + smallp[(size_t)(3 * T + t) * 64 + lane]))
                                         : small[(size_t)t * 64 + lane];
            cs[i] = 0.f; sn[i] = 0.f; if (lane < 16) { cs[i] = cosT[(size_t)t * 16 + lane]; sn[i] = sinT[(size_t)t * 16 + lane]; } }
#pragma unroll
        for (int j = 0; j < 7; ++j) { uw[j] = (v4u){0u, 0u, 0u, 0u}; if (pos0 - 3 + j >= 0) uw[j] = *(const v4u*)(um + (size_t)(tb - 3 + j) * 512 + c0); }
#pragma unroll
        for (int i = 0; i < 4; ++i) { const int t = tb + i;
            float s = 0.f;
#pragma unroll
            for (int j = 0; j < 3; ++j) { const u32x2 w = qv[i][j]; const float a = bflo(w.x), b2 = bfhi(w.x), c = bflo(w.y), d = bfhi(w.y); s += (a * a + b2 * b2) + (c * c + d * d); }
            const float rq = rsqrtf(wave_sum(s) * (1.f / 768.f) + RMS_EPS);
            const u32x2 w = kvv[i]; const float a = bflo(w.x), b2 = bfhi(w.x), c = bflo(w.y), d = bfhi(w.y);
            const float rkv = rsqrtf(wave_sum((a * a + b2 * b2) + (c * c + d * d)) * (1.f / 256.f) + RMS_EPS);
            if (lane == 0) { RQ[t] = rq; RKV[t] = rkv; }
            const float x2 = __shfl(sv[i], (lane + 16) & 63);
            if (lane < 16) { const float x1 = sv[i]; const unsigned pk = pk2(x1 * cs[i] - x2 * sn[i], x2 * cs[i] + x1 * sn[i]);
#pragma unroll
                for (int h = 0; h < 8; ++h) ((unsigned*)(K + (size_t)t * 768 + 96 * h + 64))[lane] = pk; }
            else if (lane >= 32 && lane < 36) LOGI[(size_t)t * 4 + (lane - 32)] = sv[i] + bsel;
            else if (lane >= 36 && lane < 40) { const float x = sv[i] + bsel; LOGF[(size_t)t * 4 + (lane - 36)] = fminf(x, 0.f) - log1pf(expf(-fabsf(x))); }
            float acc[8];
            acc[0] = cb[0][0]; acc[1] = cb[0][1]; acc[2] = cb[0][2]; acc[3] = cb[0][3]; acc[4] = cb[1][0]; acc[5] = cb[1][1]; acc[6] = cb[1][2]; acc[7] = cb[1][3];
#pragma unroll
            for (int j = 0; j < 4; ++j) { const v4u u4 = uw[i + j];
                acc[0] += cw[j][0][0] * bflo(u4.x); acc[1] += cw[j][0][1] * bfhi(u4.x); acc[2] += cw[j][0][2] * bflo(u4.y); acc[3] += cw[j][0][3] * bfhi(u4.y);
                acc[4] += cw[j][1][0] * bflo(u4.z); acc[5] += cw[j][1][1] * bfhi(u4.z); acc[6] += cw[j][1][2] * bflo(u4.w); acc[7] += cw[j][1][3] * bfhi(u4.w); }
#pragma unroll
            for (int q = 0; q < 8; ++q) acc[q] = acc[q] * sigm(acc[q]);
            v4u o; o.x = pk2(acc[0], acc[1]); o.y = pk2(acc[2], acc[3]); o.z = pk2(acc[4], acc[5]); o.w = pk2(acc[6], acc[7]);
            *(v4u*)(CONV + (size_t)t * 512 + c0) = o; }
    }
}

typedef float f32x16 __attribute__((ext_vector_type(16)));
typedef short s16x4 __attribute__((ext_vector_type(4)));
typedef short v4i16_t __attribute__((ext_vector_type(4)));
typedef float f32x2_t __attribute__((ext_vector_type(2))); typedef __bf16 bf16x2_t __attribute__((ext_vector_type(2)));
__device__ __forceinline__ unsigned cvtpk(float lo, float hi) { f32x2_t v = {lo, hi}; bf16x2_t b = __builtin_convertvector(v, bf16x2_t); return __builtin_bit_cast(unsigned, b); }
__device__ __forceinline__ s16x4 vtr(const LAS unsigned char* p) { return __builtin_bit_cast(s16x4, __builtin_amdgcn_ds_read_tr16_b64_v4i16((LAS v4i16_t*)p)); }
__device__ __forceinline__ bf16x8 pack8(float a0, float a1, float a2, float a3, float a4, float a5, float a6, float a7) {
    v4u p; p.x = cvtpk(a0, a1); p.y = cvtpk(a2, a3); p.z = cvtpk(a4, a5); p.w = cvtpk(a6, a7); return __builtin_bit_cast(bf16x8, p); }
#define MFMA32(a, b, c) __builtin_amdgcn_mfma_f32_32x32x16_bf16((a), (b), (c), 0, 0, 0)
constexpr int AT_KB = 12288, AT_VB = 8192;
__device__ __forceinline__ void attn_mfma(const bf16* Q, const bf16* K, const bf16* V, bf16* AO, LAS unsigned char* lds, int bx, int G, int tid) {
    const int lane = tid & 63, wave = __builtin_amdgcn_readfirstlane(tid >> 6), r = lane & 31, hh = lane >> 5;
    const int i16 = lane & 15, q4 = i16 >> 2, p4 = i16 & 3, blk = (lane >> 4) & 1;
    const int vboff = (4 * hh + q4) * 64 + 32 * blk + 8 * p4;
    const int kr0 = tid / 12, kc0 = tid % 12, kr1 = (tid + 512) / 12, kc1 = (tid + 512) % 12, vr = tid >> 3, vc = tid & 7;
    const int klds0 = (kc0 >> 1) * 2048 + (kc0 & 1) * 1024 + kr0 * 16, klds1 = (kc1 >> 1) * 2048 + (kc1 & 1) * 1024 + kr1 * 16;
    const int vlds = (vc >> 2) * 4096 + (vr >> 4) * 1024 + ((vr >> 3) & 1) * 512 + (vr & 7) * 64 + (vc & 3) * 16;
    for (int pu = bx; pu < 256; pu += G) {
        const int bh = pu >> 2, b = bh >> 3, h = bh & 7;
        const bf16* kg = K + ((size_t)b * SEQ) * 768 + h * 96; const bf16* vg = V + ((size_t)b * SEQ) * 512 + h * 64;
        for (int half = 0; half < 2; ++half) {
            const int qb = half == 0 ? 7 - (pu & 3) : (pu & 3);
            const int q0w = qb * 256 + wave * 32, nkt = 4 * (qb + 1), kmax = (q0w + 31) >> 6;
            bf16x8 qf[6];
            { const bf16* qrow = Q + ((size_t)b * SEQ + q0w + r) * 768 + h * 96 + 8 * hh;
#pragma unroll
              for (int s = 0; s < 6; ++s) qf[s] = *(const bf16x8*)(qrow + 16 * s); }
            f32x16 o0, o1;
#pragma unroll
            for (int i = 0; i < 16; ++i) { o0[i] = 0.f; o1[i] = 0.f; }
            float m = 0.f, l = 0.f; f32x16 negm;
#pragma unroll
            for (int i = 0; i < 16; ++i) negm[i] = 0.f;
            v4u ka = *(const v4u*)(kg + (size_t)kr0 * 768 + kc0 * 8), kb2 = (v4u){0u, 0u, 0u, 0u}, va = *(const v4u*)(vg + (size_t)vr * 512 + vc * 8);
            if (tid < 256) kb2 = *(const v4u*)(kg + (size_t)kr1 * 768 + kc1 * 8);
            __syncthreads();
            *(LAS v4u*)(lds + klds0) = ka; if (tid < 256) *(LAS v4u*)(lds + klds1) = kb2; *(LAS v4u*)(lds + 2 * AT_KB + vlds) = va;
            __syncthreads();
            for (int kt = 0; kt < nkt; ++kt) {
                const int buf = kt & 1;
                if (kt + 1 < nkt) { const size_t k1 = (size_t)(kt + 1) * 64;
                    ka = *(const v4u*)(kg + (k1 + kr0) * 768 + kc0 * 8); if (tid < 256) kb2 = *(const v4u*)(kg + (k1 + kr1) * 768 + kc1 * 8); va = *(const v4u*)(vg + (k1 + vr) * 512 + vc * 8); }
                if (kt <= kmax) {
                    const LAS unsigned char* kb_ = lds + buf * AT_KB + hh * 1024 + r * 16; const LAS unsigned char* vb_ = lds + 2 * AT_KB + buf * AT_VB + vboff;
                    f32x16 s0, s1;
                    { bf16x8 kf0[6], kf1[6];
#pragma unroll
                      for (int s = 0; s < 6; ++s) { kf0[s] = *(const LAS bf16x8*)(kb_ + s * 2048); kf1[s] = *(const LAS bf16x8*)(kb_ + s * 2048 + 512); }
                      __builtin_amdgcn_sched_barrier(0);
                      s0 = MFMA32(kf0[0], qf[0], negm); s1 = MFMA32(kf1[0], qf[0], negm);
#pragma unroll
                      for (int s = 1; s < 6; ++s) { s0 = MFMA32(kf0[s], qf[s], s0); s1 = MFMA32(kf1[s], qf[s], s1); } }
                    if (kt * 64 + 63 > q0w) { const int qq = q0w + r - kt * 64;
#pragma unroll
                        for (int i = 0; i < 16; ++i) { const int key = (i & 3) + 8 * (i >> 2) + 4 * hh; if (key > qq) s0[i] = -INFINITY; if (key + 32 > qq) s1[i] = -INFINITY; } }
                    float mx = fmaxf(fmaxf(s0[0], s1[0]), fmaxf(s0[1], s1[1]));
#pragma unroll
                    for (int i = 2; i < 16; i += 2) mx = fmaxf(fmaxf(mx, fmaxf(s0[i], s1[i])), fmaxf(s0[i + 1], s1[i + 1]));
                    mx = fmaxf(mx, __shfl_xor(mx, 32));
                    if (kt == 0 || __builtin_amdgcn_ballot_w64(mx > 8.f) != 0ull) {
                        const float d = (kt == 0) ? mx : fmaxf(mx, 0.f), corr = (kt == 0) ? 0.f : __builtin_amdgcn_exp2f(-d);
                        m = (kt == 0) ? mx : m + d; l *= corr;
#pragma unroll
                        for (int i = 0; i < 16; ++i) { o0[i] *= corr; o1[i] *= corr; s0[i] -= d; s1[i] -= d; negm[i] = -m; } }
                    float ps = 0.f;
#pragma unroll
                    for (int i = 0; i < 16; ++i) { s0[i] = __builtin_amdgcn_exp2f(s0[i]); s1[i] = __builtin_amdgcn_exp2f(s1[i]); ps += s0[i] + s1[i]; }
                    l += ps;
                    bf16x8 pf[4];
                    pf[0] = pack8(s0[0], s0[1], s0[2], s0[3], s0[4], s0[5], s0[6], s0[7]); pf[1] = pack8(s0[8], s0[9], s0[10], s0[11], s0[12], s0[13], s0[14], s0[15]);
                    pf[2] = pack8(s1[0], s1[1], s1[2], s1[3], s1[4], s1[5], s1[6], s1[7]); pf[3] = pack8(s1[8], s1[9], s1[10], s1[11], s1[12], s1[13], s1[14], s1[15]);
                    { s16x4 vlo[8], vhi[8];
#pragma unroll
                      for (int ks = 0; ks < 4; ++ks) { vlo[ks] = vtr(vb_ + ks * 1024); vhi[ks] = vtr(vb_ + ks * 1024 + 512); vlo[4 + ks] = vtr(vb_ + 4096 + ks * 1024); vhi[4 + ks] = vtr(vb_ + 4096 + ks * 1024 + 512); }
                      __builtin_amdgcn_sched_barrier(0);
#pragma unroll
                      for (int ks = 0; ks < 4; ++ks) {
                          const bf16x8 a0 = (bf16x8){vlo[ks][0], vlo[ks][1], vlo[ks][2], vlo[ks][3], vhi[ks][0], vhi[ks][1], vhi[ks][2], vhi[ks][3]};
                          const bf16x8 a1 = (bf16x8){vlo[4 + ks][0], vlo[4 + ks][1], vlo[4 + ks][2], vlo[4 + ks][3], vhi[4 + ks][0], vhi[4 + ks][1], vhi[4 + ks][2], vhi[4 + ks][3]};
                          o0 = MFMA32(a0, pf[ks], o0); o1 = MFMA32(a1, pf[ks], o1); } }
                }
                if (kt + 1 < nkt) { LAS unsigned char* nb = lds + (buf ^ 1) * AT_KB; *(LAS v4u*)(nb + klds0) = ka; if (tid < 256) *(LAS v4u*)(nb + klds1) = kb2; *(LAS v4u*)(lds + 2 * AT_KB + (buf ^ 1) * AT_VB + vlds) = va; }
                __syncthreads();
            }
            const float inv = 1.f / (l + __shfl_xor(l, 32));
            bf16* orow = AO + ((size_t)b * SEQ + q0w + r) * 512 + h * 64 + 4 * hh;
#pragma unroll
            for (int g = 0; g < 4; ++g) { u32x2 w0, w1; w0.x = cvtpk(o0[4 * g] * inv, o0[4 * g + 1] * inv); w0.y = cvtpk(o0[4 * g + 2] * inv, o0[4 * g + 3] * inv);
                w1.x = cvtpk(o1[4 * g] * inv, o1[4 * g + 1] * inv); w1.y = cvtpk(o1[4 * g + 2] * inv, o1[4 * g + 3] * inv);
                *(u32x2*)(orow + 8 * g) = w0; *(u32x2*)(orow + 32 + 8 * g) = w1; }
        }
    }
}


constexpr int ML_KB = 16384, ML_VB = 16384, ML_BUF = 32768, ML_TAB = 3 * 32768;
__device__ __forceinline__ void mlstm_mfma(const bf16* QKM, const bf16* VM, const float* LOGI, const float* LOGF, const bf16* CONV, const bf16* OPRE, const float* ng, const float* skip,
                                           bf16* OUTM, LAS unsigned char* lds, int bx, int G, int tid) {
    const int lane = tid & 63, wave = __builtin_amdgcn_readfirstlane(tid >> 6), r = lane & 31, hh = lane >> 5;
    const int i16 = lane & 15, q4 = i16 >> 2, p4 = i16 & 3, blk = (lane >> 4) & 1;
    const int vboff = (4 * hh + q4) * 64 + 32 * blk + 8 * p4;
    int goff[4], loff[4];
#pragma unroll
    for (int q = 0; q < 4; ++q) { const int j = 4 * wave + q;
        if (j < 16) { goff[q] = lane * 1024 + 16 * (j >> 1) + 8 * (j & 1); loff[q] = (j >> 1) * 2048 + (j & 1) * 1024; }
        else { const int jv = j - 16, dq = jv >> 2, ks = jv & 3; goff[q] = (16 * ks + 8 * (lane >> 5) + ((lane >> 2) & 7)) * 512 + 32 * dq + 8 * (lane & 3); loff[q] = ML_KB + dq * 4096 + ks * 1024; } }
    const bool kwave = wave < 4;
#define ML_DMA(tile, bufi) do { _Pragma("unroll") for (int q_ = 0; q_ < 4; ++q_) { \
        const bf16* src_ = kwave ? (kg + (size_t)(tile) * 64 * 1024 + goff[q_]) : (vg + (size_t)(tile) * 64 * 512 + goff[q_]); \
        __builtin_amdgcn_global_load_lds((const unsigned*)src_, (LAS unsigned*)(lds + (bufi) * ML_BUF + loff[q_]), 16, 0, 0); } } while (0)
    LAS float* Ftab = (LAS float*)(lds + ML_TAB); LAS float* Ctab = Ftab + 2048; LAS float* wtot = Ctab + 2048;
    constexpr float L2E = 1.4426950408889634f;
    for (int pu = bx; pu < 256; pu += G) {
        const int bh = pu >> 3, p = pu & 7, b = bh >> 2, h = bh & 3;
        __syncthreads();
        { float f4[4], i4[4];
#pragma unroll
          for (int e = 0; e < 4; ++e) { const size_t row = (size_t)b * SEQ + tid * 4 + e; f4[e] = LOGF[row * 4 + h]; i4[e] = LOGI[row * 4 + h]; }
          f4[1] += f4[0]; f4[2] += f4[1]; f4[3] += f4[2];
          float x = f4[3];
          x += __uint_as_float(__builtin_amdgcn_update_dpp(0, __float_as_uint(x), 0x111, 0xf, 0xf, true)); x += __uint_as_float(__builtin_amdgcn_update_dpp(0, __float_as_uint(x), 0x112, 0xf, 0xf, true));
          x += __uint_as_float(__builtin_amdgcn_update_dpp(0, __float_as_uint(x), 0x114, 0xf, 0xf, true)); x += __uint_as_float(__builtin_amdgcn_update_dpp(0, __float_as_uint(x), 0x118, 0xf, 0xf, true));
          { const float t0 = __uint_as_float(__builtin_amdgcn_readlane(__float_as_uint(x), 15)), t1 = __uint_as_float(__builtin_amdgcn_readlane(__float_as_uint(x), 31)), t2 = __uint_as_float(__builtin_amdgcn_readlane(__float_as_uint(x), 47));
            const int row = lane >> 4; x += (row >= 1 ? t0 : 0.f) + (row >= 2 ? t1 : 0.f) + (row >= 3 ? t2 : 0.f); }
          if (lane == 63) wtot[wave] = x;
          __syncthreads();
          float base = x - f4[3];
          for (int w = 0; w < wave; ++w) base += wtot[w];
#pragma unroll
          for (int e = 0; e < 4; ++e) { const float F = base + f4[e]; Ftab[tid * 4 + e] = F * L2E; Ctab[tid * 4 + e] = (i4[e] - F) * L2E; } }
        __syncthreads();
        const int grp = wave >> 2, w4 = wave & 3;
        const int q0w = (grp == 0 ? 128 * p : 128 * (15 - p)) + 32 * w4, kmax = (q0w + 31) >> 6, nkt = 2 * (16 - p);
        const size_t trow = (size_t)b * SEQ + q0w + r;
        bf16x8 qf[8];
        { const bf16* qrow = QKM + trow * 1024 + h * 128 + 8 * hh;
#pragma unroll
          for (int s = 0; s < 8; ++s) qf[s] = *(const bf16x8*)(qrow + 16 * s); }
        const float Ft = Ftab[q0w + r], Ft0 = Ftab[q0w];
        LAS float* wt = Ctab + 2048 + 64 + wave * 64;
        f32x16 o[4];
#pragma unroll
        for (int d = 0; d < 4; ++d)
#pragma unroll
            for (int i = 0; i < 16; ++i) o[d][i] = 0.f;
        float den = 0.f;
        const bf16* kg = QKM + ((size_t)b * SEQ) * 1024 + 512 + h * 128; const bf16* vg = VM + ((size_t)b * SEQ) * 512 + h * 128;
        ML_DMA(0, 0);
        if (nkt > 1) { ML_DMA(1, 1); asm volatile("s_waitcnt vmcnt(4)" ::: "memory"); } else asm volatile("s_waitcnt vmcnt(0)" ::: "memory");
        asm volatile("s_waitcnt lgkmcnt(0)" ::: "memory"); __builtin_amdgcn_s_barrier(); asm volatile("" ::: "memory");
        for (int kt = 0; kt < nkt; ++kt) {
            const int buf = kt % 3;
            if (kt + 2 < nkt) ML_DMA(kt + 2, (kt + 2) % 3);
            if (kt <= kmax) {
                const LAS unsigned char* kb_ = lds + buf * ML_BUF + hh * 1024 + r * 16; const LAS unsigned char* vb_ = lds + buf * ML_BUF + ML_KB + vboff;
                f32x16 s0, s1;
#pragma unroll
                for (int i = 0; i < 16; ++i) { s0[i] = 0.f; s1[i] = 0.f; }
#pragma unroll
                for (int sh = 0; sh < 2; ++sh) { bf16x8 kf0[4], kf1[4];
#pragma unroll
                  for (int s = 0; s < 4; ++s) { kf0[s] = *(const LAS bf16x8*)(kb_ + (4 * sh + s) * 2048); kf1[s] = *(const LAS bf16x8*)(kb_ + (4 * sh + s) * 2048 + 512); }
                  __builtin_amdgcn_sched_barrier(0);
#pragma unroll
                  for (int s = 0; s < 4; ++s) { s0 = MFMA32(kf0[s], qf[4 * sh + s], s0); s1 = MFMA32(kf1[s], qf[4 * sh + s], s1); } }
                const int qq = q0w + r - kt * 64;
                const bool diag = kt * 64 + 63 > q0w;
                wt[lane] = __builtin_amdgcn_exp2f(Ctab[kt * 64 + lane] + Ft0);
                LDS_WAIT();
                const LAS float* ct = wt + 4 * hh;
                float ps = 0.f;
#pragma unroll
                for (int g = 0; g < 4; ++g) { const f32x4 c0v = *(const LAS f32x4*)(ct + 8 * g), c1v = *(const LAS f32x4*)(ct + 32 + 8 * g);
#pragma unroll
                    for (int e = 0; e < 4; ++e) { const int i = 4 * g + e, key = e + 8 * g + 4 * hh;
                        float w0 = c0v[e], w1 = c1v[e];
                        if (diag) { w0 = (key <= qq) ? w0 : 0.f; w1 = (key + 32 <= qq) ? w1 : 0.f; }
                        s0[i] *= w0; s1[i] *= w1; ps += s0[i] + s1[i]; } }
                den += ps;
                bf16x8 pf[4];
                pf[0] = pack8(s0[0], s0[1], s0[2], s0[3], s0[4], s0[5], s0[6], s0[7]); pf[1] = pack8(s0[8], s0[9], s0[10], s0[11], s0[12], s0[13], s0[14], s0[15]);
                pf[2] = pack8(s1[0], s1[1], s1[2], s1[3], s1[4], s1[5], s1[6], s1[7]); pf[3] = pack8(s1[8], s1[9], s1[10], s1[11], s1[12], s1[13], s1[14], s1[15]);
#pragma unroll
                for (int ks = 0; ks < 4; ++ks) { s16x4 vlo[4], vhi[4];
#pragma unroll
                    for (int d = 0; d < 4; ++d) { vlo[d] = vtr(vb_ + d * 4096 + ks * 1024); vhi[d] = vtr(vb_ + d * 4096 + ks * 1024 + 512); }
                    __builtin_amdgcn_sched_barrier(0);
#pragma unroll
                    for (int d = 0; d < 4; ++d) { const s16x4 lo = vlo[d], hi = vhi[d];
                        const bf16x8 av = (bf16x8){lo[0], lo[1], lo[2], lo[3], hi[0], hi[1], hi[2], hi[3]};
                        o[d] = MFMA32(av, pf[ks], o[d]); } }
            }
            if (kt + 2 < nkt) asm volatile("s_waitcnt vmcnt(4)" ::: "memory"); else asm volatile("s_waitcnt vmcnt(0)" ::: "memory");
            asm volatile("s_waitcnt lgkmcnt(0)" ::: "memory"); __builtin_amdgcn_s_barrier(); asm volatile("" ::: "memory");
        }
        const float kap = __builtin_amdgcn_exp2f(Ft - Ft0);
        const float dt = (den + __shfl_xor(den, 32)) * kap;
        const float inv = kap / fmaxf(fabsf(dt), 1.f);
        float sm = 0.f;
#pragma unroll
        for (int d = 0; d < 4; ++d)
#pragma unroll
            for (int i = 0; i < 16; ++i) { o[d][i] *= inv; sm += o[d][i]; }
        sm += __shfl_xor(sm, 32);
        const float mu = sm * (1.f / 128.f);
        float vs = 0.f;
#pragma unroll
        for (int d = 0; d < 4; ++d)
#pragma unroll
            for (int i = 0; i < 16; ++i) { const float dlt = o[d][i] - mu; vs += dlt * dlt; }
        vs += __shfl_xor(vs, 32);
        const float rstd = rsqrtf(vs * (1.f / 128.f) + RMS_EPS);
#pragma unroll
        for (int d = 0; d < 4; ++d)
#pragma unroll
            for (int g = 0; g < 4; ++g) { const int ch = h * 128 + 32 * d + 8 * g + 4 * hh; const size_t off = trow * 512 + ch;
                const u32x2 cv = *(const u32x2*)(CONV + off), ov = *(const u32x2*)(OPRE + off); const f32x4 gg = *(const f32x4*)(ng + ch), sk = *(const f32x4*)(skip + ch);
                const float y0 = sigm(bflo(ov.x)) * ((o[d][4 * g] - mu) * rstd * gg[0] + sk[0] * bflo(cv.x)), y1 = sigm(bfhi(ov.x)) * ((o[d][4 * g + 1] - mu) * rstd * gg[1] + sk[1] * bfhi(cv.x));
                const float y2 = sigm(bflo(ov.y)) * ((o[d][4 * g + 2] - mu) * rstd * gg[2] + sk[2] * bflo(cv.y)), y3 = sigm(bfhi(ov.y)) * ((o[d][4 * g + 3] - mu) * rstd * gg[3] + sk[3] * bfhi(cv.y));
                u32x2 w; w.x = cvtpk(y0, y1); w.y = cvtpk(y2, y3); *(u32x2*)(OUTM + off) = w; }
    }
#undef ML_DMA
}

template <int N> __device__ __forceinline__ void bitonic_sort_desc(float (&v)[N]) {
#pragma unroll
    for (int k = 2; k <= N; k <<= 1)
#pragma unroll
        for (int j = k >> 1; j > 0; j >>= 1)
#pragma unroll
            for (int i = 0; i < N; ++i) { const int l = i ^ j; if (l > i) { const bool desc = ((i & k) == 0); const float a = v[i], b = v[l], hi = fmaxf(a, b), lo = fminf(a, b); v[i] = desc ? hi : lo; v[l] = desc ? lo : hi; } }
}
__device__ __forceinline__ void top16_merge(float (&a)[16], const float (&b)[16]) {
#pragma unroll
    for (int i = 0; i < 16; ++i) a[i] = fmaxf(a[i], b[15 - i]);
#pragma unroll
    for (int j = 8; j > 0; j >>= 1)
#pragma unroll
        for (int i = 0; i < 16; ++i) { const int l = i ^ j; if (l > i) { const float x = a[i], y = a[l]; a[i] = fmaxf(x, y); a[l] = fminf(x, y); } }
}
constexpr int PE_EIDX = 0, PE_EGATE = 16384, PE_KEYT = 32768;
__device__ __forceinline__ void peer_route(const bf16* PQ, const bf16* KEYB, int* IDX, float* GATE, LAS unsigned char* lds, int bx, int G, int tid) {
    const int lane = tid & 63, wave = __builtin_amdgcn_readfirstlane(tid >> 6), r = lane & 31, hh = lane >> 5;
    LAS unsigned char* keyt = lds + PE_KEYT + (wave * 32 + r) * 32;
    for (int grp = bx; grp < T / 32; grp += G) {
        const int t0 = grp * 32;
        { const int h = wave;
          int rq = r; asm volatile("" : "+v"(rq));
          float top[2][16];
#pragma unroll
          for (int p = 0; p < 2; ++p) {
              bf16x8 qf[4];
              { const bf16* qrow = PQ + (size_t)(t0 + rq) * 1024 + h * 128 + p * 64 + 8 * hh;
#pragma unroll
                for (int s = 0; s < 4; ++s) qf[s] = *(const bf16x8*)(qrow + 16 * s); }
              const bf16* kb = KEYB + ((size_t)(h * 2 + p) * 128 + rq) * 64 + 8 * hh;
              float sv[4][16];
#pragma unroll
              for (int kt = 0; kt < 4; ++kt) { f32x16 acc;
#pragma unroll
                  for (int i = 0; i < 16; ++i) acc[i] = 0.f;
#pragma unroll
                  for (int s = 0; s < 4; ++s) { const bf16x8 a = *(const bf16x8*)(kb + (size_t)(32 * kt) * 64 + 16 * s); acc = MFMA32(a, qf[s], acc); }
#pragma unroll
                  for (int i = 0; i < 16; ++i) { const unsigned key = (unsigned)(32 * kt + (i & 3) + 8 * (i >> 2)) + 4u * (unsigned)hh; sv[kt][i] = __uint_as_float((__float_as_uint(acc[i]) & ~127u) | key); } }
              bitonic_sort_desc<16>(sv[0]); bitonic_sort_desc<16>(sv[1]); bitonic_sort_desc<16>(sv[2]); bitonic_sort_desc<16>(sv[3]);
              top16_merge(sv[0], sv[1]); top16_merge(sv[2], sv[3]); top16_merge(sv[0], sv[2]);
              float pr[16];
#pragma unroll
              for (int i = 0; i < 16; ++i) pr[i] = __shfl_xor(sv[0][i], 32);
              top16_merge(sv[0], pr);
#pragma unroll
              for (int i = 0; i < 16; ++i) top[p][i] = sv[0][i];
          }
          if (hh == 0) {
#pragma unroll
              for (int i = 0; i < 16; ++i) { keyt[i] = (unsigned char)(__float_as_uint(top[0][i]) & 127u); keyt[16 + i] = (unsigned char)(__float_as_uint(top[1][i]) & 127u); } }
          float cs[4][16];
#define PSUM(a, b) __uint_as_float((__float_as_uint(top[0][a] + top[1][b]) & ~255u) | (unsigned)((a) * 16 + (b)))
#pragma unroll
          for (int b2 = 0; b2 < 16; ++b2) cs[0][b2] = PSUM(0, b2);
#pragma unroll
          for (int b2 = 0; b2 < 8; ++b2) cs[1][b2] = PSUM(1, b2);
#pragma unroll
          for (int a2 = 8; a2 < 16; ++a2) cs[1][a2] = PSUM(a2, 0);
#pragma unroll
          for (int b2 = 0; b2 < 5; ++b2) cs[2][b2] = PSUM(2, b2);
#pragma unroll
          for (int b2 = 0; b2 < 4; ++b2) cs[2][5 + b2] = PSUM(3, b2);
#pragma unroll
          for (int b2 = 0; b2 < 3; ++b2) cs[2][9 + b2] = PSUM(4, b2);
          cs[2][12] = PSUM(5, 0); cs[2][13] = PSUM(5, 1); cs[2][14] = PSUM(6, 0); cs[2][15] = PSUM(6, 1);
          cs[3][0] = PSUM(7, 0); cs[3][1] = PSUM(7, 1);
#undef PSUM
#pragma unroll
          for (int i = 2; i < 16; ++i) cs[3][i] = -3.0e38f;
          bitonic_sort_desc<16>(cs[0]); bitonic_sort_desc<16>(cs[1]); bitonic_sort_desc<16>(cs[2]); bitonic_sort_desc<16>(cs[3]);
          top16_merge(cs[0], cs[1]); top16_merge(cs[2], cs[3]); top16_merge(cs[0], cs[2]);
          LDS_WAIT();
          float ev[16], den = 0.f; const float mx = __uint_as_float(__float_as_uint(cs[0][0]) & ~255u);
#pragma unroll
          for (int k = 0; k < 16; ++k) { ev[k] = __expf(__uint_as_float(__float_as_uint(cs[0][k]) & ~255u) - mx); den += ev[k]; }
          const float rden = 1.f / den;
          if (hh == 0) {
#pragma unroll
              for (int k = 0; k < 16; ++k) { const unsigned code = __float_as_uint(cs[0][k]) & 255u; const int e = (int)keyt[code >> 4] * 128 + (int)keyt[16 + (code & 15u)];
                  IDX[(size_t)(t0 + r) * 128 + h * 16 + k] = e; GATE[(size_t)(t0 + r) * 128 + h * 16 + k] = ev[k] * rden; } }
        }
    }
}
__device__ __forceinline__ void peer_partition(const unsigned* xc_cnt, volatile LAS unsigned* MISC, int bx, int G, int& vx, int& rank, int& nb) {
    bool use_xcc = MK_ONE_LAUNCH != 0; unsigned mine = 0u; const unsigned myx = MISC[13];
    if (use_xcc) { unsigned sum = 0u;
#pragma unroll
        for (unsigned j = 0; j < 8; ++j) { const unsigned c = __hip_atomic_load(xc_cnt + 64 * j, __ATOMIC_RELAXED, __HIP_MEMORY_SCOPE_AGENT); use_xcc = use_xcc && (c > 0u); sum += c; mine = (j == myx) ? c : mine; }
        use_xcc = use_xcc && (sum == (unsigned)G); }
    if (use_xcc) { vx = (int)myx; rank = (int)MISC[12]; nb = (int)mine; } else { vx = bx & 7; rank = bx >> 3; nb = (G - vx + 7) >> 3; }
    vx = __builtin_amdgcn_readfirstlane(vx); rank = __builtin_amdgcn_readfirstlane(rank); nb = __builtin_amdgcn_readfirstlane(nb);
}
__device__ __forceinline__ void peer_u_i8(const unsigned char* H8, const float* XS, const int* IDX, const unsigned char* U8, const f32x2v* SC2, float* ACT, LAS float* wscr, int vx, int rank, int nb, int tid) {
    const int lane = tid & 63, wave = __builtin_amdgcn_readfirstlane(tid >> 6), g4 = lane >> 4, c16 = lane & 15;
    const int tstride = nb * 8;
    LAS int* clist = (LAS int*)wscr;
    LAS unsigned char* xs = (LAS unsigned char*)(wscr + 512);
    const unsigned long long lt = (1ull << lane) - 1ull;
    const unsigned char* ubase = U8 + 16 * c16;
    int ni[8];
    { const int tb = rank * 8 + wave;
#pragma unroll
      for (int j = 0; j < 4; ++j) { const int tj = tb + j * tstride; const bool ok = tj < T; ni[2 * j] = ok ? IDX[(size_t)tj * 128 + lane] : 0x7fffffff; ni[2 * j + 1] = ok ? IDX[(size_t)tj * 128 + 64 + lane] : 0x7fffffff; } }
    for (int tb = rank * 8 + wave; tb < T; tb += 4 * tstride) {
        int ntot = 0;
#pragma unroll
        for (int j = 0; j < 4; ++j) { const int e0 = ni[2 * j], e1 = ni[2 * j + 1]; const bool f0 = (e0 >> 11) == vx, f1 = (e1 >> 11) == vx;
            const unsigned long long m0 = __ballot(f0), m1 = __ballot(f1); const int n0 = __popcll(m0);
            if (f0) clist[ntot + __popcll(m0 & lt)] = (j << 21) | (e0 << 7) | lane;
            if (f1) clist[ntot + n0 + __popcll(m1 & lt)] = (j << 21) | (e1 << 7) | (64 + lane);
            ntot += n0 + __popcll(m1); }
        v4u xr[4]; float sx[4];
#pragma unroll
        for (int j = 0; j < 4; ++j) { const int tj = tb + j * tstride, tl = tj < T ? tj : tb; xr[j] = *(const v4u*)(H8 + (size_t)tl * 1024 + 16 * lane); sx[j] = XS[tl]; }
        { const int tn = tb + 4 * tstride;
#pragma unroll
          for (int j = 0; j < 4; ++j) { const int tj = tn + j * tstride; const bool ok = tj < T; ni[2 * j] = ok ? IDX[(size_t)tj * 128 + lane] : 0x7fffffff; ni[2 * j + 1] = ok ? IDX[(size_t)tj * 128 + 64 + lane] : 0x7fffffff; } }
        if (ntot == 0) continue;
#pragma unroll
        for (int j = 0; j < 4; ++j) *(LAS v4u*)(xs + j * 1024 + 16 * lane) = xr[j];
        LDS_WAIT();
        const int last = ntot - 1, nit = (ntot + 3) >> 2, nit4 = (nit + 3) >> 2;
        v4u ub[4][4]; f32x2v us[4]; int up[4];
#pragma unroll
        for (int k = 0; k < 3; ++k) { const int p = min(4 * k + g4, last); const int pk = clist[p]; up[k] = pk; const unsigned eo = (unsigned)((pk >> 7) & 16383) * 1024u; us[k] = SC2[(pk >> 7) & 16383];
#pragma unroll
            for (int jj = 0; jj < 4; ++jj) ub[k][jj] = *(const v4u*)(ubase + eo + 256 * jj); }
        int dsel = 0, psel = 0; f32x2v ssel = (f32x2v){0.f, 0.f}; bool vsel = false;
#pragma unroll 1
        for (int o = 0; o < nit4; ++o) {
#pragma unroll
            for (int k = 0; k < 4; ++k) {
                const int i = 4 * o + k;
                { const int p = min(4 * (i + 3) + g4, last); const int pk = clist[p]; up[(k + 3) & 3] = pk; const unsigned eo = (unsigned)((pk >> 7) & 16383) * 1024u; us[(k + 3) & 3] = SC2[(pk >> 7) & 16383];
#pragma unroll
                  for (int jj = 0; jj < 4; ++jj) ub[(k + 3) & 3][jj] = *(const v4u*)(ubase + eo + 256 * jj); }
                const LAS unsigned char* xp = xs + (up[k] >> 21) * 1024 + 16 * c16;
                v4u xq[4];
#pragma unroll
                for (int jj = 0; jj < 4; ++jj) xq[jj] = *(const LAS v4u*)(xp + 256 * jj);
                int a0 = 0, a1 = 0, a2 = 0, a3 = 0;
#pragma unroll
                for (int jj = 0; jj < 4; ++jj) {
                    a0 = __builtin_amdgcn_sdot4((int)xq[jj].x, (int)ub[k][jj].x, a0, false); a1 = __builtin_amdgcn_sdot4((int)xq[jj].y, (int)ub[k][jj].y, a1, false);
                    a2 = __builtin_amdgcn_sdot4((int)xq[jj].z, (int)ub[k][jj].z, a2, false); a3 = __builtin_amdgcn_sdot4((int)xq[jj].w, (int)ub[k][jj].w, a3, false); }
                int d = (a0 + a1) + (a2 + a3);
                d += __builtin_amdgcn_update_dpp(0, d, 0x128, 0xf, 0xf, false); d += __builtin_amdgcn_update_dpp(0, d, 0x124, 0xf, 0xf, false);
                d += __builtin_amdgcn_update_dpp(0, d, 0x122, 0xf, 0xf, false); d += __builtin_amdgcn_update_dpp(0, d, 0x121, 0xf, 0xf, false);
                if ((i & 15) == c16) { dsel = d; ssel = us[k]; psel = up[k]; vsel = 4 * i + g4 <= last; }
                if (k == 3 && ((o & 3) == 3 || o == nit4 - 1)) {
                    if (vsel) { const int j = psel >> 21; const float sxj = j == 0 ? sx[0] : j == 1 ? sx[1] : j == 2 ? sx[2] : sx[3];
                        ACT[(size_t)(tb + j * tstride) * 128 + (psel & 127)] = gelu_erf((float)dsel * sxj * ssel.x) * ssel.y; }
                    vsel = false; }
            }
        }
        LDS_WAIT();
    }
}
__device__ __forceinline__ void peer_v(const int* IDX, const float* ACT, const float* GATE, const unsigned char* V8, const float* gate2, const float* Xin, float* Xout, LAS float* wscr,
                                       int vx, int rank, int nb, int tid) {
    const int lane = tid & 63, wave = __builtin_amdgcn_readfirstlane(tid >> 6), g8 = lane >> 3, c8 = lane & 7;
    const int tstride = nb * 8;
    LAS int* wl = (LAS int*)wscr; LAS unsigned char* wqb = (LAS unsigned char*)(wscr + 128);
    const unsigned char* vbase = V8 + (size_t)vx * (2 * MiB) + 16 * c8;
    const int col = 128 * vx + 16 * c8;
    const int wqo0 = (lane & 7) * 16 + (lane >> 3), wqo1 = wqo0 + 8;
    const int t0 = rank * 8 + wave;
    if (t0 >= T) return;
    const int tlast = t0 + ((T - 1 - t0) / tstride) * tstride;
#define PV_STAGE(tt, I0, I1, A0, A1, VV, WQ4, SW) { \
        float am_ = fmaxf(fabsf(A0), fabsf(A1));   \
        am_ = fmaxf(am_, __uint_as_float(__builtin_amdgcn_update_dpp(0, __float_as_uint(am_), 0x128, 0xf, 0xf, false))); am_ = fmaxf(am_, __uint_as_float(__builtin_amdgcn_update_dpp(0, __float_as_uint(am_), 0x124, 0xf, 0xf, false))); \
        am_ = fmaxf(am_, __uint_as_float(__builtin_amdgcn_update_dpp(0, __float_as_uint(am_), 0x122, 0xf, 0xf, false))); am_ = fmaxf(am_, __uint_as_float(__builtin_amdgcn_update_dpp(0, __float_as_uint(am_), 0x121, 0xf, 0xf, false))); \
        am_ = fmaxf(fmaxf(__uint_as_float(__builtin_amdgcn_readlane(__float_as_uint(am_), 0)), __uint_as_float(__builtin_amdgcn_readlane(__float_as_uint(am_), 16))), \
                    fmaxf(__uint_as_float(__builtin_amdgcn_readlane(__float_as_uint(am_), 32)), __uint_as_float(__builtin_amdgcn_readlane(__float_as_uint(am_), 48)))); \
        const float inv_ = am_ > 0.f ? 127.f / am_ : 0.f; SW = am_ * (1.f / 127.f); \
        wl[lane] = I0; wl[64 + lane] = I1; wqb[wqo0] = (unsigned char)((int)rintf(A0 * inv_) & 255); wqb[wqo1] = (unsigned char)((int)rintf(A1 * inv_) & 255); \
        LDS_WAIT(); \
        _Pragma("unroll") for (int i_ = 0; i_ < 16; ++i_) { const int e_ = wl[8 * i_ + g8]; VV[i_] = *(const v4u*)(vbase + (size_t)(unsigned)(e_ * 128)); } \
        WQ4 = *(const LAS v4u*)(wqb + g8 * 16); LDS_WAIT(); }
#define PV_META(tt, I0, I1, A0, A1) { const size_t o_ = (size_t)(tt) * 128; I0 = IDX[o_ + lane]; I1 = IDX[o_ + 64 + lane]; A0 = ACT[o_ + lane] * GATE[o_ + lane]; A1 = ACT[o_ + 64 + lane] * GATE[o_ + 64 + lane]; }
    int i0, i1, j0, j1; float a0, a1, b0, b1;
    v4u vv[16], vvn[16], wq4, wq4n; float sw, swn;
    PV_META(t0, i0, i1, a0, a1);
    PV_STAGE(t0, i0, i1, a0, a1, vvn, wq4n, swn);
    { const int t1 = min(t0 + tstride, tlast); PV_META(t1, i0, i1, a0, a1); }
    for (int t = t0; t < T; t += tstride) {
        const int b = t >> 11, tn = min(t + tstride, tlast), tn2 = min(t + 2 * tstride, tlast);
#pragma unroll
        for (int i = 0; i < 16; ++i) vv[i] = vvn[i];
        wq4 = wq4n; sw = swn;
        PV_META(tn2, j0, j1, b0, b1);
        f32x4 xin[4], g2[4];
#pragma unroll
        for (int q = 0; q < 4; ++q) { xin[q] = *(const f32x4*)(Xin + (size_t)t * 1024 + col + 4 * q); g2[q] = *(const f32x4*)(gate2 + (size_t)b * NADA + col + 4 * q); }
        PV_STAGE(tn, i0, i1, a0, a1, vvn, wq4n, swn);
        i0 = j0; i1 = j1; a0 = b0; a1 = b1;
        int acc[16];
#pragma unroll
        for (int i = 0; i < 16; ++i) acc[i] = 0;
#pragma unroll
        for (int q = 0; q < 4; ++q) { const int wq = (int)(q == 0 ? wq4.x : q == 1 ? wq4.y : q == 2 ? wq4.z : wq4.w);
#pragma unroll
            for (int cb = 0; cb < 4; ++cb) {
                const unsigned a = cb == 0 ? vv[4 * q].x : cb == 1 ? vv[4 * q].y : cb == 2 ? vv[4 * q].z : vv[4 * q].w, bb = cb == 0 ? vv[4 * q + 1].x : cb == 1 ? vv[4 * q + 1].y : cb == 2 ? vv[4 * q + 1].z : vv[4 * q + 1].w;
                const unsigned c = cb == 0 ? vv[4 * q + 2].x : cb == 1 ? vv[4 * q + 2].y : cb == 2 ? vv[4 * q + 2].z : vv[4 * q + 2].w, d = cb == 0 ? vv[4 * q + 3].x : cb == 1 ? vv[4 * q + 3].y : cb == 2 ? vv[4 * q + 3].z : vv[4 * q + 3].w;
                const unsigned ab_lo = __builtin_amdgcn_perm(bb, a, 0x05010400u), ab_hi = __builtin_amdgcn_perm(bb, a, 0x07030602u), cd_lo = __builtin_amdgcn_perm(d, c, 0x05010400u), cd_hi = __builtin_amdgcn_perm(d, c, 0x07030602u);
                acc[4 * cb + 0] = __builtin_amdgcn_sdot4((int)__builtin_amdgcn_perm(cd_lo, ab_lo, 0x05040100u), wq, acc[4 * cb + 0], false);
                acc[4 * cb + 1] = __builtin_amdgcn_sdot4((int)__builtin_amdgcn_perm(cd_lo, ab_lo, 0x07060302u), wq, acc[4 * cb + 1], false);
                acc[4 * cb + 2] = __builtin_amdgcn_sdot4((int)__builtin_amdgcn_perm(cd_hi, ab_hi, 0x05040100u), wq, acc[4 * cb + 2], false);
                acc[4 * cb + 3] = __builtin_amdgcn_sdot4((int)__builtin_amdgcn_perm(cd_hi, ab_hi, 0x07060302u), wq, acc[4 * cb + 3], false); } }
#pragma unroll
        for (int i = 0; i < 16; ++i) { acc[i] += __builtin_amdgcn_update_dpp(0, acc[i], 0x128, 0xf, 0xf, false);
            { auto r16 = __builtin_amdgcn_permlane16_swap((unsigned)acc[i], (unsigned)acc[i], false, false); acc[i] = (int)(r16[0] + r16[1]); }
            { auto r32 = __builtin_amdgcn_permlane32_swap((unsigned)acc[i], (unsigned)acc[i], false, false); acc[i] = (int)(r32[0] + r32[1]); } }
        if (g8 == 0) {
#pragma unroll
            for (int q = 0; q < 4; ++q) *(f32x4*)(Xout + (size_t)t * 1024 + col + 4 * q) = xin[q] + g2[q] * ((f32x4){(float)acc[4 * q], (float)acc[4 * q + 1], (float)acc[4 * q + 2], (float)acc[4 * q + 3]} * sw); }
    }
#undef PV_STAGE
#undef PV_META
}

constexpr int PH_PER_LAYER = 12, N_PHASES = 1 + DEPTH * PH_PER_LAYER + 1;
struct Args { const void* in[N_INPUTS]; float* out; unsigned char* ws; int ph_lo, ph_hi; };
static_assert(sizeof(Args) == N_INPUTS * 8 + 24, "Args has no padding");

constexpr int PTAB_OFF = LDSCTL_OFF + 1024;
__device__ __forceinline__ unsigned char* getp(LAS unsigned char* lds, int i) {
    asm volatile("" ::: "memory");
    const u32x2 v = *(volatile LAS u32x2*)(lds + PTAB_OFF + 8 * i);
    const unsigned lo = __builtin_amdgcn_readfirstlane(v.x), hi = __builtin_amdgcn_readfirstlane(v.y);
    GAS unsigned char* g = (GAS unsigned char*)(((unsigned long long)hi << 32) | lo);
    return (unsigned char*)g;
}
#define INP(i) ((const float*)getp(lds, (i)))
#define WSB() getp(lds, 30)

#define IN(k) (lo <= (k) && (k) < hi)
#define SEAM(k) do { if (MK_ONE_LAUNCH && IN(k) && IN((k) + 1)) { XcdBarrier b_; b_.bar = (unsigned*)(WSB() + WS_CTL) + CW_BAR; b_.x = xb_xcc_id(); b_.st = MISC + 8; REPS(11) xcd_barrier(b_, (wave_s << 6) | (int)__lane_id()); } } while (0)
#define PH_BEGIN(lv) int tidq; asm volatile("v_mbcnt_lo_u32_b32 %0, -1, 0\n\tv_mbcnt_hi_u32_b32 %0, -1, %0" : "=v"(tidq)); tidq |= wave_s << 6;     \
    asm volatile("" : "+v"(tidq)); const int lane = tidq & 63, wave = __builtin_amdgcn_readfirstlane(tidq >> 6); \
    int G = gridDim.x, bx = blockIdx.x, l = (lv); asm volatile("" : "+s"(G), "+s"(bx), "+s"(l)); const int gw = bx * NWAVES + wave, NGW = G * NWAVES; \
    unsigned char* ws = WSB(); LAS float* wscr = (LAS float*)(lds + RING_OFF + wave * 16384); (void)lane; (void)gw; (void)NGW; (void)ws; (void)wscr; (void)l


constexpr int PI_W = 4512, PI_K = 512, PI_U = 2048, PI_V = 2048, PI_TOTAL = PI_W + PI_K + PI_U + PI_V;
template <int NR> __device__ __forceinline__ void prep_rows_i8(const float* src, size_t src_stride, unsigned char* dst, size_t dst_stride, float* scale_slot  , int lane) {
    f32x4 v[NR][4];
#pragma unroll
    for (int rr = 0; rr < NR; ++rr) { const f32x4* s = (const f32x4*)(src + rr * src_stride) + lane * 4;
#pragma unroll
        for (int j = 0; j < 4; ++j) v[rr][j] = s[j]; }
#pragma unroll
    for (int rr = 0; rr < NR; ++rr) {
        float am = 0.f;
#pragma unroll
        for (int j = 0; j < 4; ++j) am = fmaxf(fmaxf(am, fmaxf(fabsf(v[rr][j][0]), fabsf(v[rr][j][1]))), fmaxf(fabsf(v[rr][j][2]), fabsf(v[rr][j][3])));
#pragma unroll
        for (int o = 1; o < 64; o <<= 1) am = fmaxf(am, __shfl_xor(am, o));
        const float inv = am > 0.f ? 127.f / am : 0.f;
#define Q4(x) ((unsigned)((int)rintf((x)[0] * inv) & 255) | ((unsigned)((int)rintf((x)[1] * inv) & 255) << 8) | ((unsigned)((int)rintf((x)[2] * inv) & 255) << 16) | ((unsigned)((int)rintf((x)[3] * inv) & 255) << 24))
        v4u o; o.x = Q4(v[rr][0]); o.y = Q4(v[rr][1]); o.z = Q4(v[rr][2]); o.w = Q4(v[rr][3]);
#undef Q4
        *(v4u*)(dst + rr * dst_stride) = o;
        if (lane == 0) scale_slot[2 * rr] = am * (1.f / 127.f);
    }
}
__device__ __forceinline__ void prep_item(LAS unsigned char* lds, unsigned char* ws, LAS float* wscr, int l, int r, int lane) {
    constexpr int I_WIN_ = 16 * 136, I_WQ_ = 12 * 24, I_WKV_ = 4 * 32, I_WA_ = 8 * 32, I_WM_ = 8 * 32, I_WO_ = 16 * 32, I_PW_ = 16 * 32, I_WQK_ = 8 * 32, I_WV_ = 8 * 16;
    static_assert(I_WIN_ + I_WQ_ + I_WKV_ + I_WA_ + I_WM_ + I_WO_ + I_PW_ + I_WQK_ + I_WV_ == PI_W, "weight items");
    unsigned char* wl = ws + WS_W + (size_t)l * W_LAYER;
    if (r < PI_W) {
        if (r < I_WIN_) { const GetWin g{INP(I_WIN) + (size_t)l * D * 4136}; prep_tile(g, (bf16*)(wl + WO_WIN), 1024, 64 * (r / 136), 32 * (r % 136), wscr, lane); return; } r -= I_WIN_;
        if (r < I_WQ_) { const GetWq g{INP(I_WQUP) + (size_t)l * 768 * 768, INP(I_QNG) + l * 768}; prep_tile(g, (bf16*)(wl + WO_WQ), 768, 64 * (r / 24), 32 * (r % 24), wscr, lane); return; } r -= I_WQ_;
        if (r < I_WKV_) { const GetWkv g{INP(I_WKVUP) + (size_t)l * 256 * 1024, INP(I_KVNG) + l * 256}; prep_tile(g, (bf16*)(wl + WO_WKV), 256, 64 * (r / 32), 32 * (r % 32), wscr, lane); return; } r -= I_WKV_;
        if (r < I_WA_) { const GetPlain g{INP(I_WBA) + (size_t)l * 512 * 1024, 1024}; prep_tile(g, (bf16*)(wl + WO_WA), 512, 64 * (r / 32), 32 * (r % 32), wscr, lane); return; } r -= I_WA_;
        if (r < I_WM_) { const GetPlain g{INP(I_WBM) + (size_t)l * 512 * 1024, 1024}; prep_tile(g, (bf16*)(wl + WO_WM), 512, 64 * (r / 32), 32 * (r % 32), wscr, lane); return; } r -= I_WM_;
        if (r < I_WO_) { const GetPlain g{INP(I_WOUT) + (size_t)l * 1024 * 1024, 1024}; prep_tile(g, (bf16*)(wl + WO_WO), 1024, 64 * (r / 32), 32 * (r % 32), wscr, lane); return; } r -= I_WO_;
        if (r < I_PW_) { const GetPlain g{INP(I_PWQ) + (size_t)l * 1024 * 1024, 1024}; prep_tile(g, (bf16*)(wl + WO_PWQ), 1024, 64 * (r / 32), 32 * (r % 32), wscr, lane); return; } r -= I_PW_;
        if (r < I_WQK_) { const GetWqk g{INP(I_WQM) + (size_t)l * 65536, INP(I_WKM) + (size_t)l * 65536}; prep_tile(g, (bf16*)(wl + WO_WQK), 512, 64 * (r / 32), 32 * (r % 32), wscr, lane); return; } r -= I_WQK_;
        { const GetWv g{INP(I_WVM) + (size_t)l * 65536}; prep_tile(g, (bf16*)(wl + WO_WV), 512, 64 * (r / 16), 32 * (r % 16), wscr, lane); }
        return; }
    r -= PI_W;
    if (r < PI_K) { const int o = (r * 64 + lane) * 4;
        const f32x4 v = *(const f32x4*)(INP(I_PKEYS) + (size_t)l * 131072 + o); u32x2 w; w.x = pk2(v[0], v[1]); w.y = pk2(v[2], v[3]);
        *(u32x2*)(wl + WO_KEYB + (size_t)o * 2) = w; return; }
    r -= PI_K;
    float* sc2 = (float*)(ws + WS_USC);
    if (r < PI_U) { const float* pu = INP(I_PU) + (size_t)l * 16777216;
        for (int rr = 0; rr < 8; rr += 8) { const int er = r * 8 + rr; prep_rows_i8<8>(pu + (size_t)er * 1024, 1024, ws + WS_U8 + (size_t)l * 32 * MiB + (size_t)er * 1024 + 16 * lane, 1024, sc2 + 2 * (l * 16384 + er), lane); }
        return; }
    r -= PI_U;
    { const float* pv = INP(I_PV) + (size_t)l * 16777216;
      for (int rr = 0; rr < 8; rr += 8) { const int er = r * 8 + rr;
          prep_rows_i8<8>(pv + (size_t)er * 1024, 1024, ws + WS_V8 + (size_t)l * 32 * MiB + (size_t)(lane >> 3) * (2 * MiB) + (size_t)er * 128 + 16 * (lane & 7), 128, sc2 + 2 * (l * 16384 + er) + 1, lane); } }
}
template <int lv> __device__ __forceinline__ void layer_phases(LAS unsigned char* lds, volatile LAS unsigned* MISC, const int lo, const int hi, const int wave_s) {
        const int P = 1 + lv * PH_PER_LAYER;
#define WL() (ws + WS_W + (size_t)l * W_LAYER)
#define ADAL() ((const float*)(ws + ADA_OFF) + (size_t)l * 8 * NADA)
#define XIN() ((l == 0) ? INP(I_X) : (const float*)getp(lds, 29))
#define WSP(type, off) ((type*)(ws + (off)))
        if (IN(P + 0)) REPS(1) { PH_BEGIN(lv); rowpass_norm_mod(XIN(), INP(I_N1G) + l * D, ADAL() + 0, ADAL() + 1024, WSP(bf16, WS_H), gw, NGW, lane); }
        SEAM(P + 0);
        if (IN(P + 1)) REPS(2) { PH_BEGIN(lv);
            if (G == 256) {
                { pg8::Gemm g{WSP(bf16, WS_H), (const bf16*)(WL() + WO_WIN), T, 4096, D}; pg8::StaticOrder S; S.init(T, 4096, G, bx);
                  EpiProj E{WSP(bf16, WS_QLAT), WSP(bf16, WS_KVLAT), WSP(bf16, WS_UM), WSP(bf16, WS_OPRE), WSP(bf16, WS_GA), WSP(bf16, WS_GM), WSP(float, WS_SMALL)};
                  pg8::gemm_phase<EpiProj, pg8::StaticOrder, true, true>(lds + RING_OFF, g, S, E, tidq); }
                { const int kq = bx >> 6;
                  pg8::Gemm g{WSP(bf16, WS_H) + 256 * kq, (const bf16*)(WL() + WO_WIN) + (size_t)4096 * 1024 + 256 * kq, T, 256, 256, 1024}; pg8::StaticOrder S; S.init(T, 256, 64, bx & 63);
                  EpiSmallPart E{WSP(float, WS_SMALLP) + (size_t)kq * T * 64};
                  pg8::gemm_phase<EpiSmallPart, pg8::StaticOrder, true, true>(lds + RING_OFF, g, S, E, tidq); }
            } else {
                pg8::Gemm g{WSP(bf16, WS_H), (const bf16*)(WL() + WO_WIN), T, NPROJ, D}; pg8::StaticOrder S; S.init(T, NPROJ, G, bx);
                EpiProj E{WSP(bf16, WS_QLAT), WSP(bf16, WS_KVLAT), WSP(bf16, WS_UM), WSP(bf16, WS_OPRE), WSP(bf16, WS_GA), WSP(bf16, WS_GM), WSP(float, WS_SMALL)};
                pg8::gemm_phase<EpiProj, pg8::StaticOrder, true, true>(lds + RING_OFF, g, S, E, tidq);
            }
        }
        SEAM(P + 1);
        if (IN(P + 2)) REPS(3) { PH_BEGIN(lv);
            rowpass_mid(WSP(bf16, WS_QLAT), WSP(bf16, WS_KVLAT), WSP(float, WS_SMALL), (G == 256) ? WSP(float, WS_SMALLP) : (const float*)nullptr, WSP(float, WS_COS), WSP(float, WS_SIN), WSP(bf16, WS_UM), INP(I_CONVW) + l * 4 * 512, INP(I_CONVB) + l * 512,
                        INP(I_BI) + l * 4, INP(I_BF) + l * 4, WSP(float, WS_RQ), WSP(float, WS_RKV), WSP(bf16, WS_K), WSP(float, WS_LOGI), WSP(float, WS_LOGF), WSP(bf16, WS_CONV), gw, NGW, lane); }
        SEAM(P + 2);
        if (IN(P + 3)) REPS(4) {
            { PH_BEGIN(lv); pg8::Gemm g{WSP(bf16, WS_QLAT), (const bf16*)(WL() + WO_WQ), T, 768, 768}; pg8::StaticOrder S; S.init(T, 768, G, bx);
              EpiQ E{WSP(bf16, WS_Q), WSP(float, WS_RQ), WSP(float, WS_COS), WSP(float, WS_SIN)}; pg8::gemm_phase<EpiQ, pg8::StaticOrder, true, true>(lds + RING_OFF, g, S, E, tidq); }
            { PH_BEGIN(lv); pg8::Gemm g{WSP(bf16, WS_KVLAT), (const bf16*)(WL() + WO_WKV), T, 1024, 256}; pg8::StaticOrder S; S.init(T, 1024, G, bx);
              EpiKV E{WSP(bf16, WS_K), WSP(bf16, WS_V), WSP(float, WS_RKV)}; pg8::gemm_phase<EpiKV, pg8::StaticOrder, true, true>(lds + RING_OFF, g, S, E, tidq); }
            { PH_BEGIN(lv); pg8::Gemm g{WSP(bf16, WS_CONV), (const bf16*)(WL() + WO_WQK), T, 1024, 512}; pg8::StaticOrder S; S.init(T, 1024, G, bx);
              pg8::EpiBf16<0> E{WSP(bf16, WS_QKM), 1024, nullptr, 0, 0, 1.f}; pg8::gemm_phase<pg8::EpiBf16<0>, pg8::StaticOrder, true, true>(lds + RING_OFF, g, S, E, tidq); }
            { PH_BEGIN(lv); pg8::Gemm g{WSP(bf16, WS_UM), (const bf16*)(WL() + WO_WV), T, 512, 512}; pg8::StaticOrder S;
              if (G == 256) S.init(T, 512, 64, bx >= 192 ? bx - 192 : (1 << 20)); else S.init(T, 512, G, bx);
              pg8::EpiBf16<0> E{WSP(bf16, WS_VM), 512, nullptr, 0, 0, 1.f}; pg8::gemm_phase<pg8::EpiBf16<0>, pg8::StaticOrder, true, true>(lds + RING_OFF, g, S, E, tidq); }
        }
        SEAM(P + 3);
        if (IN(P + 4)) {
            REPS(5) { PH_BEGIN(lv); attn_mfma(WSP(bf16, WS_Q), WSP(bf16, WS_K), WSP(bf16, WS_V), WSP(bf16, WS_AO), lds + RING_OFF, bx, G, tidq); __syncthreads(); }
            REPS(6) { PH_BEGIN(lv); mlstm_mfma(WSP(bf16, WS_QKM), WSP(bf16, WS_VM), WSP(float, WS_LOGI), WSP(float, WS_LOGF), WSP(bf16, WS_CONV), WSP(bf16, WS_OPRE), INP(I_MHG) + l * 512, INP(I_MSKIP) + l * 512,
                          WSP(bf16, WS_OUTM), lds + RING_OFF, bx, G, tidq); }
        }
        SEAM(P + 4);
        if (IN(P + 5)) REPS(7) {
            { PH_BEGIN(lv); pg8::Gemm g{WSP(bf16, WS_AO), (const bf16*)(WL() + WO_WA), T, 1024, 512}; pg8::StaticOrder S; S.init(T, 1024, G, bx);
              EpiMerge E{WSP(bf16, WS_MERGED), WSP(bf16, WS_GA), 1}; pg8::gemm_phase<EpiMerge, pg8::StaticOrder, true, true>(lds + RING_OFF, g, S, E, tidq); }
            { PH_BEGIN(lv); pg8::Gemm g{WSP(bf16, WS_OUTM), (const bf16*)(WL() + WO_WM), T, 1024, 512}; pg8::StaticOrder S; S.init(T, 1024, G, bx);
              EpiMerge E{WSP(bf16, WS_MERGED), WSP(bf16, WS_GM), 0}; pg8::gemm_phase<EpiMerge, pg8::StaticOrder, true, true>(lds + RING_OFF, g, S, E, tidq); }
        }
        SEAM(P + 5);
        if (IN(P + 6)) REPS(8) { PH_BEGIN(lv);
            pg8::Gemm g{WSP(bf16, WS_MERGED), (const bf16*)(WL() + WO_WO), T, 1024, 1024}; pg8::StaticOrder S; S.init(T, 1024, G, bx);
            EpiResid E{XIN(), WSP(float, WS_X), ADAL() + 2048}; pg8::gemm_phase<EpiResid, pg8::StaticOrder, true, true>(lds + RING_OFF, g, S, E, tidq);
        }
        SEAM(P + 6);
        if (IN(P + 7)) REPS(1) { PH_BEGIN(lv); rowpass_norm_mod(WSP(float, WS_X), INP(I_N2G) + l * D, ADAL() + 3072, ADAL() + 4096, WSP(bf16, WS_H), gw, NGW, lane, ws + WS_H8, WSP(float, WS_XS)); }
        SEAM(P + 7);
        if (IN(P + 8)) REPS(9) { PH_BEGIN(lv);
            pg8::Gemm g{WSP(bf16, WS_H), (const bf16*)(WL() + WO_PWQ), T, 1024, 1024}; pg8::StaticOrder S; S.init(T, 1024, G, bx);
            pg8::EpiBf16<0> E{WSP(bf16, WS_PQ), 1024, nullptr, 0, 0, 1.f}; pg8::gemm_phase<pg8::EpiBf16<0>, pg8::StaticOrder, true, true>(lds + RING_OFF, g, S, E, tidq);
        }
        SEAM(P + 8);
        if (IN(P + 9)) REPS(10) { PH_BEGIN(lv);
            peer_route(WSP(bf16, WS_PQ), (const bf16*)(WL() + WO_KEYB), WSP(int, WS_IDX), WSP(float, WS_GATE), lds + RING_OFF, bx, G, tidq); }
        SEAM(P + 9);
        if (IN(P + 10)) REPS(12) { PH_BEGIN(lv);
            int vx, rank, nb; peer_partition((const unsigned*)(ws + WS_CTL) + CW_XC, MISC, bx, G, vx, rank, nb);
            peer_u_i8(ws + WS_H8, WSP(float, WS_XS), WSP(int, WS_IDX), ws + WS_U8 + (size_t)l * 32 * MiB, WSP(f32x2v, WS_USC) + l * 16384, WSP(float, WS_ACT), wscr, vx, rank, nb, tidq); }
        SEAM(P + 10);
        if (IN(P + 11)) REPS(13) { PH_BEGIN(lv);
            int vx, rank, nb; peer_partition((const unsigned*)(ws + WS_CTL) + CW_XC, MISC, bx, G, vx, rank, nb);
            peer_v(WSP(int, WS_IDX), WSP(float, WS_ACT), WSP(float, WS_GATE), ws + WS_V8 + (size_t)l * 32 * MiB, ADAL() + 5120, WSP(float, WS_X), (float*)getp(lds, 29), wscr, vx, rank, nb, tidq);
        }
        SEAM(P + 11);
    }

__global__ void __launch_bounds__(NTHREADS, 2) fwd(Args args) {
    extern __shared__ __attribute__((aligned(16))) unsigned char lds_raw[];
    LAS unsigned char* lds = (LAS unsigned char*)lds_raw;
    volatile LAS unsigned* MISC = (volatile LAS unsigned*)(lds + MISC_OFF);
    const int tid = threadIdx.x;
    const int wave_s = __builtin_amdgcn_readfirstlane(tid >> 6);
    for (int u = tid; u < (LDS_BYTES - LDSCTL_OFF) / 4; u += NTHREADS) ((LAS unsigned*)(lds + LDSCTL_OFF))[u] = 0u;
    __syncthreads();
    if (tid == 0) { LAS unsigned long long* pt = (LAS unsigned long long*)(lds + PTAB_OFF);
#pragma unroll
        for (int i = 0; i < N_INPUTS; ++i) pt[i] = (unsigned long long)args.in[i];
        pt[29] = (unsigned long long)args.out; pt[30] = (unsigned long long)args.ws; }
    __syncthreads();
    if (MK_ONE_LAUNCH) (void)xcd_barrier_post((unsigned*)(WSB() + WS_CTL) + CW_BAR, MISC + 8);
    if (MK_ONE_LAUNCH && tid == 0) { const unsigned xc = xb_xcc_id() & 7u; MISC[12] = xb_add((unsigned*)(WSB() + WS_CTL) + CW_XC + 64 * xc, 1u); MISC[13] = xc; }
    __syncthreads();
    const int lo = args.ph_lo, hi = args.ph_hi;

    if (IN(0)) REPS(0) {
        PH_BEGIN(0);
        float* ADA = (float*)(ws + ADA_OFF);
        { const float* c = INP(I_C); const float* wada = INP(I_WADA); const float* bada = INP(I_BADA);
          for (int it = bx; it < DEPTH * 96; it += G) {
            const int ll = it / 96, cg = it % 96; const int n = cg * 64 + lane;
#pragma unroll
            for (int i = 0; i < 16; ++i) { const int e = lane + 64 * i; const int bb = e >> 7, kk = e & 127; const float cv = c[bb * D + wave * 128 + kk]; wscr[e] = cv * sigm(cv); }
            LDS_WAIT();
            const float* w = wada + (size_t)ll * D * NADA + (size_t)(wave * 128) * NADA + n;
            float a[8];
#pragma unroll
            for (int bb = 0; bb < 8; ++bb) a[bb] = 0.f;
#pragma unroll 16
            for (int kk = 0; kk < 128; ++kk) { const float wv = w[(size_t)kk * NADA];
#pragma unroll
                for (int bb = 0; bb < 8; ++bb) a[bb] += wscr[bb * 128 + kk] * wv; }
#pragma unroll
            for (int bb = 0; bb < 8; ++bb) wscr[1024 + bb * 64 + lane] = a[bb];
            __syncthreads();
            { float s = 0.f;
#pragma unroll
              for (int w8 = 0; w8 < 8; ++w8) s += ((const LAS float*)(lds + RING_OFF + w8 * 16384))[1024 + wave * 64 + lane];
              ADA[((size_t)ll * 8 + wave) * NADA + n] = s + bada[ll * NADA + n]; }
            __syncthreads();
          } }
        { const int* pos = (const int*)INP(I_POS); float* COS = (float*)(ws + WS_COS); float* SIN = (float*)(ws + WS_SIN);
          for (int idx = gw * 64 + lane; idx < T * 16; idx += NGW * 64) { const int t = idx >> 4, j = idx & 15;
              const float ang = (float)pos[t] * INV_FREQ[j];
              const double rev = (double)ang * 0.15915494309189535; const float fr = (float)(rev - rint(rev));
              COS[idx] = __builtin_amdgcn_cosf(fr); SIN[idx] = __builtin_amdgcn_sinf(fr); } }
        for (int it = gw; it < DEPTH * PI_TOTAL; it += NGW) prep_item(lds, ws, wscr, it / PI_TOTAL, it % PI_TOTAL, lane);
    }
    SEAM(0);

    layer_phases<0>(lds, MISC, lo, hi, wave_s);
    layer_phases<1>(lds, MISC, lo, hi, wave_s);
    if (IN(N_PHASES - 1)) REPS(1) { PH_BEGIN(0); rowpass_final((const float*)getp(lds, 29), INP(I_FG), (float*)getp(lds, 29), gw, NGW, lane); }
#undef IN
#undef SEAM
}

extern "C" void kernel_launch(void* const* d_in, const int* in_sizes, int n_in, void* d_out, int out_size, void* d_ws, size_t ws_size, hipStream_t stream) {
    static int grid = 0;
    if (grid == 0) {
        if (n_in != N_INPUTS || in_sizes[0] != T * D || out_size != T * D || ws_size < WS_END2) {
            fprintf(stderr, "kernel_launch: unexpected shapes: n_in %d in0 %d out %d ws %zu (need %zu); nothing launched\n", n_in, n_in > 0 ? in_sizes[0] : -1, out_size, ws_size, (size_t)WS_END2); grid = -1; return; }
        int dev = 0, cus = 0, per_cu = 0;
        if (hipGetDevice(&dev) != hipSuccess || hipDeviceGetAttribute(&cus, hipDeviceAttributeMultiprocessorCount, dev) != hipSuccess) { fprintf(stderr, "kernel_launch: device query failed\n"); grid = -1; return; }
        if (hipFuncSetAttribute((const void*)fwd, hipFuncAttributeMaxDynamicSharedMemorySize, LDS_BYTES) != hipSuccess) { fprintf(stderr, "kernel_launch: hipFuncSetAttribute failed\n"); grid = -1; return; }
        if (hipOccupancyMaxActiveBlocksPerMultiprocessor(&per_cu, (const void*)fwd, NTHREADS, LDS_BYTES) != hipSuccess || per_cu < 1)
            fprintf(stderr, "kernel_launch: note: occupancy query reports %d workgroups per CU\n", per_cu);
        (void)hipGetLastError();
        grid = cus;
    }
    if (grid < 0) return;
    if (hipMemsetAsync((char*)d_ws + WS_CTL, 0, CTL_ZERO_BYTES, stream) != hipSuccess) { fprintf(stderr, "kernel_launch: memset failed\n"); return; }
    Args a{};
    for (int i = 0; i < N_INPUTS; ++i) a.in[i] = d_in[i];
    a.out = (float*)d_out; a.ws = (unsigned char*)d_ws;
#if MK_ONE_LAUNCH
    a.ph_lo = 0; a.ph_hi = N_PHASES;
    hipLaunchKernelGGL(fwd, dim3(grid), dim3(NTHREADS), LDS_BYTES, stream, a);
#else
    for (int p = 0; p < N_PHASES; ++p) { a.ph_lo = p; a.ph_hi = p + 1; hipLaunchKernelGGL(fwd, dim3(grid), dim3(NTHREADS), LDS_BYTES, stream, a); }
#endif
    const hipError_t le = hipPeekAtLastError();
    if (le != hipSuccess) fprintf(stderr, "kernel_launch: launch failed: %s\n", hipGetErrorName(le));
}
```

```cpp
#include <hip/hip_runtime.h>
#include <cstdio>
#include <cstdint>
namespace pg8 {
#define PG8_LAS __attribute__((address_space(3)))
typedef unsigned short bf16_t;
typedef short bf16x8 __attribute__((ext_vector_type(8)));
typedef float f32x4 __attribute__((ext_vector_type(4)));
typedef unsigned u32x4 __attribute__((ext_vector_type(4)));
constexpr int BM = 256, BK = 64, HALF = 128, HTB = HALF * BK * 2  , STAGE_BYTES = 8 * HTB, NXCD = 8, WGM = 8;

__host__ __device__ __forceinline__ int lds_byte(int r, int c) { const int st = (r >> 4) * 2 + (c >> 5), rr = r & 15, cc = c & 31, ob = rr * 64 + cc * 2; return st * 1024 + (ob ^ (((ob >> 9) & 1) << 5)); }
__host__ __device__ __forceinline__ void stage_rc(int b, int& R, int& C) { const int st = b / 1024, sb = b % 1024, swz = sb ^ (((sb >> 9) & 1) << 5); R = (st >> 1) * 16 + swz / 64; C = (st & 1) * 32 + (swz % 64) / 2; }
__host__ __device__ __forceinline__ int perm32(int rho) { const int n = rho >> 4, i = rho & 15; return 8 * (i >> 2) + 4 * n + (i & 3); }

struct Unit { int pm, pn; };
struct Gemm { const bf16_t* A; const bf16_t* Bt; int M, N, K; int ld = 0; };

struct StaticOrder {
    int nM, nN, nwg, G, c;
    __host__ __device__ void init(int M, int N, int G_, int c_) { nM = M / BM; nN = N / BM; nwg = nM * nN; G = G_; c = c_; }
    __host__ __device__ bool next(int i, Unit& u) const {
        const long L = (long)i * G + c; if (L >= nwg) return false;
        int wgid = (int)L; { const int q = nwg / NXCD, r = nwg % NXCD, xcd = wgid % NXCD, off = wgid / NXCD; wgid = (xcd < r ? xcd * (q + 1) : r * (q + 1) + (xcd - r) * q) + off; }
        const int nig = WGM * nN, gid = wgid / nig, fm = gid * WGM, gsz = (nM - fm) < WGM ? (nM - fm) : WGM;
        u.pm = fm + ((wgid % nig) % gsz); u.pn = (wgid % nig) / gsz; return true;
    }
    __device__ __forceinline__ void a_ready(const Unit&) const {}
    __device__ __forceinline__ void done(const Unit&) const {}
};

__device__ __forceinline__ unsigned cvt_pk_bf16(float lo, float hi) { unsigned r; asm volatile("v_cvt_pk_bf16_f32 %0, %1, %2" : "=v"(r) : "v"(lo), "v"(hi)); return r; }
typedef float f32x2 __attribute__((ext_vector_type(2)));
__device__ __forceinline__ f32x2 gelu_pk(f32x2 v) {
    const f32x2 av = __builtin_elementwise_abs(v), d = av * 0.2316418882f + 1.0f;
    f32x2 t; t.x = __builtin_amdgcn_rcpf(d.x); t.y = __builtin_amdgcn_rcpf(d.y);
    f32x2 q = t * 0.5307027145f + (-0.7265760135f); q = q * t + 0.7107068705f; q = q * t + (-0.142248368f); q = q * t + 0.127414796f; q = q * t;
    const f32x2 s = (v * v) * (-0.72134752044f);
    f32x2 e; e.x = __builtin_amdgcn_exp2f(s.x); e.y = __builtin_amdgcn_exp2f(s.y);
    const f32x2 m = v * (q * e), r = v - m;
    f32x2 o; o.x = v.x < 0.f ? m.x : r.x; o.y = v.y < 0.f ? m.y : r.y; return o;
}

template <int ACT  > struct EpiBf16 {
    static constexpr bool PERM = true, AFTER_DRAIN = false; static_assert(ACT == 0 || ACT == 1, "EpiBf16: ACT is 0 (none) or 1 (gelu_pk)");
    bf16_t* O; int ldc; const float* bias; int split_cols; size_t split_stride; float scale0;
    __device__ __forceinline__ void operator()(const f32x4 (&acc)[2][2][4][2], const Unit& u, int wr, int wc, int fr, int fq) const {
        const int row0 = u.pm * BM + wr * 64 + fr; int colt = u.pn * BM; bf16_t* base = O;
        float sc = 1.f; if (split_cols) { const int t = colt / split_cols; base += (size_t)t * split_stride; colt -= t * split_cols; if (t == 0) sc = scale0; }
        const int col0 = colt + wc * 32 + 8 * fq, bcol0 = u.pn * BM + wc * 32 + 8 * fq;
        f32x4 bv[2][2];
#pragma unroll
        for (int bj = 0; bj < 2; ++bj)
#pragma unroll
            for (int n = 0; n < 2; ++n) bv[bj][n] = bias ? *(const f32x4*)(bias + bcol0 + bj * HALF + 4 * n) : (f32x4){0.f, 0.f, 0.f, 0.f};
#pragma unroll
        for (int ai = 0; ai < 2; ++ai)
#pragma unroll
            for (int m = 0; m < 4; ++m) { bf16_t* rowp = base + (size_t)(row0 + ai * HALF + m * 16) * ldc + col0;
#pragma unroll
                for (int bj = 0; bj < 2; ++bj) { f32x4 v0 = acc[ai][bj][m][0] + bv[bj][0], v1 = acc[ai][bj][m][1] + bv[bj][1];
                    if (ACT == 1) { f32x2 a = gelu_pk((f32x2){v0[0], v0[1]}), b = gelu_pk((f32x2){v0[2], v0[3]}), c = gelu_pk((f32x2){v1[0], v1[1]}), d = gelu_pk((f32x2){v1[2], v1[3]});
                        v0 = (f32x4){a.x, a.y, b.x, b.y}; v1 = (f32x4){c.x, c.y, d.x, d.y}; }
                    v0 = v0 * sc; v1 = v1 * sc; u32x4 w; w.x = cvt_pk_bf16(v0[0], v0[1]); w.y = cvt_pk_bf16(v0[2], v0[3]); w.z = cvt_pk_bf16(v1[0], v1[1]); w.w = cvt_pk_bf16(v1[2], v1[3]);
                    *(u32x4*)(rowp + bj * HALF) = w; } }
    }
};


template <class Epi, class Sched, bool ALIGN_EPI = false, bool SP2 = false>
__device__ __forceinline__ void gemm_phase(PG8_LAS unsigned char* lds, const Gemm g, const Sched& S, const Epi& E, const int tid_in) {
    int tid_l = tid_in; asm volatile("" : "+v"(tid_l));
    const int tid = tid_l, wid = __builtin_amdgcn_readfirstlane(tid >> 6), lane = tid & 63, wr = wid >> 2, wc = wid & 3, fr = lane & 15, fq = lane >> 4;
    const int K = g.K, nt = K / BK, LD = g.ld ? g.ld : g.K;
    unsigned voffA[2], voffB[2];
#pragma unroll
    for (int i = 0; i < 2; ++i) { int R, C; stage_rc(tid * 16 + i * 8192, R, C); const int Rb = Epi::PERM ? ((R & ~31) + perm32(R & 31)) : R;
        voffA[i] = (unsigned)(R * LD + C) * 2u; voffB[i] = (unsigned)(Rb * LD + C) * 2u; }
    const size_t kstep = (size_t)(BK * 2);
    const size_t hstep = (size_t)HALF * LD * 2;
    const size_t tstep = 2 * hstep;
    const unsigned ldsw = (unsigned)wid * 1024u;
    const int aoff = lds_byte(wr * 64 + fr, fq * 8), boff = lds_byte(wc * 32 + fr, fq * 8);
#define PG8_SA(b, h) (((b) * 2 + (h)) * HTB)
#define PG8_SB(b, h) ((4 + (b) * 2 + (h)) * HTB)
#define PG8_STAGE(bufoff, gbase, voff) do { _Pragma("unroll") for (int _i = 0; _i < 2; ++_i) \
        __builtin_amdgcn_global_load_lds((const unsigned*)((const char*)(gbase) + (voff)[_i]), (PG8_LAS unsigned*)(lds + (bufoff) + ldsw + _i * 8192), 16, 0, 0); } while (0)
#define PG8_LDA(dst, b, h) do { _Pragma("unroll") for (int m = 0; m < 4; ++m) _Pragma("unroll") for (int k = 0; k < 2; ++k) dst[m][k] = *(const PG8_LAS bf16x8*)(lds + PG8_SA(b, h) + aoff + m * 2048 + k * 1024); } while (0)
#define PG8_LDB(dst, b, h) do { _Pragma("unroll") for (int n = 0; n < 2; ++n) _Pragma("unroll") for (int k = 0; k < 2; ++k) dst[n][k] = *(const PG8_LAS bf16x8*)(lds + PG8_SB(b, h) + boff + n * 2048 + k * 1024); } while (0)
#define PG8_MMA(ai, bj, At, Bt) do { __builtin_amdgcn_s_setprio(1); _Pragma("unroll") for (int m = 0; m < 4; ++m) _Pragma("unroll") for (int n = 0; n < 2; ++n) _Pragma("unroll") for (int k = 0; k < 2; ++k) \
        acc[ai][bj][m][n] = __builtin_amdgcn_mfma_f32_16x16x32_bf16(Bt[n][k], At[m][k], acc[ai][bj][m][n], 0, 0, 0); __builtin_amdgcn_s_setprio(0); } while (0)
#define PG8_WAIT_V(n) asm volatile("s_waitcnt vmcnt(" #n ")" ::: "memory")
#define PG8_WAIT_L(n) asm volatile("s_waitcnt lgkmcnt(" #n ")" ::: "memory")
#define PG8_BAR __builtin_amdgcn_s_barrier()
#define PG8_SCHED __builtin_amdgcn_sched_barrier(0)
    Unit cur, nxt; int ui = 0;
    if (!S.next(0, cur)) return;
    f32x4 acc[2][2][4][2];
#pragma unroll
    for (int a = 0; a < 2; ++a)
#pragma unroll
        for (int b = 0; b < 2; ++b)
#pragma unroll
            for (int m = 0; m < 4; ++m)
#pragma unroll
                for (int n = 0; n < 2; ++n) acc[a][b][m][n] = (f32x4){0.f, 0.f, 0.f, 0.f};
    bf16x8 At[4][2], B0[2][2], B1[2][2];
    const char* cA = (const char*)g.A + (size_t)cur.pm * tstep; const char* cB = (const char*)g.Bt + (size_t)cur.pn * tstep;
    S.a_ready(cur);
    if constexpr (SP2) {
        PG8_STAGE(PG8_SB(0, 0), cB, voffB); PG8_STAGE(PG8_SB(0, 1), cB + hstep, voffB); PG8_STAGE(PG8_SA(0, 0), cA, voffA); PG8_STAGE(PG8_SA(0, 1), cA + hstep, voffA);
        if (wr == 1) PG8_BAR;
        PG8_WAIT_V(2); PG8_BAR;
        PG8_STAGE(PG8_SB(1, 0), cB + kstep, voffB); PG8_STAGE(PG8_SA(1, 0), cA + kstep, voffA); PG8_STAGE(PG8_SB(1, 1), cB + hstep + kstep, voffB);
        PG8_WAIT_V(6); PG8_BAR;
    } else {
        PG8_STAGE(PG8_SB(0, 0), cB, voffB); PG8_STAGE(PG8_SA(0, 0), cA, voffA); PG8_STAGE(PG8_SB(0, 1), cB + hstep, voffB); PG8_STAGE(PG8_SA(0, 1), cA + hstep, voffA);
        if (wr == 1) PG8_BAR;
        PG8_WAIT_V(4); PG8_BAR;
        PG8_STAGE(PG8_SB(1, 0), cB + kstep, voffB); PG8_STAGE(PG8_SA(1, 0), cA + kstep, voffA); PG8_STAGE(PG8_SB(1, 1), cB + hstep + kstep, voffB);
        PG8_WAIT_V(6); PG8_BAR;
    }
    for (;;) {
        const bool has_next = S.next(ui + 1, nxt);
        const char* nA = has_next ? (const char*)g.A + (size_t)nxt.pm * tstep : cA; const char* nB = has_next ? (const char*)g.Bt + (size_t)nxt.pn * tstep : cB;
        for (int t = 0; t < nt; t += 2) {
            const bool last = (t == nt - 2);
            const char* a1 = cA + (size_t)(t + 1) * kstep;
            const char* a2 = last ? nA : cA + (size_t)(t + 2) * kstep; const char* b2 = last ? nB : cB + (size_t)(t + 2) * kstep;
            const char* a3 = a2 + kstep; const char* b3 = b2 + kstep;
            if (last && has_next) S.a_ready(nxt);
            if constexpr (SP2) {
            PG8_LDB(B0, 0, 0); PG8_LDB(B1, 0, 1); PG8_SCHED; PG8_LDA(At, 0, 0); PG8_STAGE(PG8_SA(1, 1), a1 + hstep, voffA);
            PG8_WAIT_V(8); PG8_WAIT_L(0); PG8_BAR; PG8_MMA(0, 0, At, B0); PG8_MMA(0, 1, At, B1); PG8_BAR; PG8_SCHED;
            PG8_LDA(At, 0, 1); PG8_STAGE(PG8_SB(0, 0), b2, voffB); PG8_STAGE(PG8_SB(0, 1), b2 + hstep, voffB); PG8_STAGE(PG8_SA(0, 0), a2, voffA);
            PG8_WAIT_V(8); PG8_WAIT_L(0); PG8_BAR; PG8_MMA(1, 0, At, B0); PG8_MMA(1, 1, At, B1); PG8_BAR; PG8_SCHED;
            PG8_LDB(B0, 1, 0); PG8_LDB(B1, 1, 1); PG8_SCHED; PG8_LDA(At, 1, 0); PG8_STAGE(PG8_SA(0, 1), a2 + hstep, voffA);
            PG8_WAIT_V(8); PG8_WAIT_L(0); PG8_BAR; PG8_MMA(0, 0, At, B0); PG8_MMA(0, 1, At, B1); PG8_BAR; PG8_SCHED;
            PG8_LDA(At, 1, 1); PG8_STAGE(PG8_SB(1, 0), b3, voffB); PG8_STAGE(PG8_SB(1, 1), b3 + hstep, voffB); PG8_STAGE(PG8_SA(1, 0), a3, voffA);
            PG8_WAIT_V(8); PG8_WAIT_L(0); PG8_BAR; PG8_MMA(1, 0, At, B0); PG8_MMA(1, 1, At, B1); PG8_BAR; PG8_SCHED;
            } else {
            PG8_LDB(B0, 0, 0); PG8_SCHED; PG8_LDA(At, 0, 0); PG8_STAGE(PG8_SA(1, 1), a1 + hstep, voffA);
            PG8_WAIT_L(8); PG8_BAR; PG8_WAIT_L(0); PG8_MMA(0, 0, At, B0); PG8_BAR; PG8_SCHED;
            PG8_LDB(B1, 0, 1); PG8_STAGE(PG8_SB(0, 0), b2, voffB);
            PG8_BAR; PG8_WAIT_L(0); PG8_MMA(0, 1, At, B1); PG8_BAR;
            PG8_LDA(At, 0, 1); PG8_STAGE(PG8_SA(0, 0), a2, voffA);
            PG8_BAR; PG8_WAIT_L(0); PG8_MMA(1, 0, At, B0); PG8_BAR; PG8_SCHED;
            PG8_STAGE(PG8_SB(0, 1), b2 + hstep, voffB);
            PG8_WAIT_V(6); PG8_BAR; PG8_MMA(1, 1, At, B1); PG8_BAR;
            PG8_LDB(B0, 1, 0); PG8_SCHED; PG8_LDA(At, 1, 0); PG8_STAGE(PG8_SA(0, 1), a2 + hstep, voffA);
            PG8_WAIT_L(8); PG8_BAR; PG8_WAIT_L(0); PG8_MMA(0, 0, At, B0); PG8_BAR; PG8_SCHED;
            PG8_LDB(B1, 1, 1); PG8_STAGE(PG8_SB(1, 0), b3, voffB);
            PG8_BAR; PG8_WAIT_L(0); PG8_MMA(0, 1, At, B1); PG8_BAR;
            PG8_LDA(At, 1, 1); PG8_STAGE(PG8_SA(1, 0), a3, voffA);
            PG8_BAR; PG8_WAIT_L(0); PG8_MMA(1, 0, At, B0); PG8_BAR; PG8_SCHED;
            PG8_STAGE(PG8_SB(1, 1), b3 + hstep, voffB);
            PG8_WAIT_V(6); PG8_BAR; PG8_MMA(1, 1, At, B1); PG8_BAR;
            }
        }
        if constexpr (ALIGN_EPI) { if (wr == 0) PG8_BAR; }
        if constexpr (!Epi::AFTER_DRAIN) { E(acc, cur, wr, wc, fr, fq); S.done(cur); }
        if (!has_next) break;
#pragma unroll
        for (int a = 0; a < 2; ++a)
#pragma unroll
            for (int b = 0; b < 2; ++b)
#pragma unroll
                for (int m = 0; m < 4; ++m)
#pragma unroll
                    for (int n = 0; n < 2; ++n) acc[a][b][m][n] = (f32x4){0.f, 0.f, 0.f, 0.f};
        cur = nxt; cA = nA; cB = nB; ++ui;
        if constexpr (ALIGN_EPI) { if (wr == 1) PG8_BAR; }
    }
    PG8_WAIT_V(0);
    if constexpr (!ALIGN_EPI) { if (wr == 0) PG8_BAR; }
    PG8_BAR;
    if constexpr (Epi::AFTER_DRAIN) { E.fused(acc, cur, wr, wc, fr, fq, lds, wid, lane); S.done(cur); }
#undef PG8_SA
#undef PG8_SB
#undef PG8_STAGE
#undef PG8_LDA
#undef PG8_LDB
#undef PG8_MMA
#undef PG8_WAIT_V
#undef PG8_WAIT_L
#undef PG8_BAR
#undef PG8_SCHED
}
}
#define GAS __attribute__((address_space(1)))
#define LAS __attribute__((address_space(3)))
typedef unsigned short bf16;
typedef unsigned v4u __attribute__((ext_vector_type(4)));
typedef float f32x4 __attribute__((ext_vector_type(4)));
typedef short bf16x8 __attribute__((ext_vector_type(8)));
typedef GAS unsigned gu32;
typedef GAS unsigned long long gu64;
#define RLX_AGENT __ATOMIC_RELAXED, __HIP_MEMORY_SCOPE_AGENT
#define LDS_WAIT() asm volatile("s_waitcnt lgkmcnt(0)" ::: "memory")
#define VM_WAIT() asm volatile("s_waitcnt vmcnt(0)" ::: "memory")
__device__ __forceinline__ unsigned long long rt() { return __builtin_amdgcn_s_memrealtime(); }
__device__ __forceinline__ unsigned f2bf(float f) { unsigned u = __builtin_bit_cast(unsigned, f); return (u + 0x7fffu + ((u >> 16) & 1u)) >> 16; }
__device__ __forceinline__ unsigned pk2(float lo, float hi) { return f2bf(lo) | (f2bf(hi) << 16); }

#define XB_TMO      128
#define XB_XCNT(j)  (256  + 64 * (j))
#define XB_XSUB(j)  (1280 + 64 * (j))
#define XB_XGEN(j)  (2304 + 64 * (j))
#define XB_TOP      3328
#define XB_TOPGEN   3392
#define XCD_BAR_WORDS 3456
#define XB_SPIN_CAP (1u << 18)

__device__ __forceinline__ unsigned xb_ld(unsigned* p)              { return __hip_atomic_load(p, __ATOMIC_RELAXED, __HIP_MEMORY_SCOPE_AGENT); }
__device__ __forceinline__ unsigned xb_add(unsigned* p, unsigned v) { return __hip_atomic_fetch_add(p, v, __ATOMIC_RELAXED, __HIP_MEMORY_SCOPE_AGENT); }
__device__ __forceinline__ unsigned xb_xcc_id() { return (unsigned)__builtin_amdgcn_s_getreg((3 << 11) | 20) & 0xFu; }
#define XB_SPIN(cond, bar) do { unsigned _sp = 0; while (cond) { __builtin_amdgcn_s_sleep(1); \
    if ((++_sp & 255u) == 0u) { if (xb_ld(&(bar)[XB_TMO])) break; if (_sp > XB_SPIN_CAP) { atomicAdd(&(bar)[XB_TMO], 1u); break; } } } } while (0)

struct XcdBarrier {
    unsigned* bar; unsigned x;
    volatile LAS unsigned* st;
};

__device__ __forceinline__ XcdBarrier xcd_barrier_post(unsigned* bar, volatile LAS unsigned* st) {
    XcdBarrier b; b.bar = bar; b.x = xb_xcc_id(); b.st = st;
    if (threadIdx.x == 0) (void)xb_add(&bar[XB_XCNT(b.x)], 1u);
    return b;
}
__device__ __forceinline__ void xcd_barrier_complete(unsigned* bar, unsigned x, unsigned& nloc, unsigned& nx) {
    const unsigned G = gridDim.x * gridDim.y * gridDim.z;
    unsigned sum, cnt, mine, sp = 0u;
    for (;;) {
        sum = 0u; cnt = 0u; mine = 0u;
#pragma unroll
        for (unsigned j = 0; j < 16; ++j) { const unsigned c = xb_ld(&bar[XB_XCNT(j)]); sum += c; cnt += (c > 0u) ? 1u : 0u; mine = (j == x) ? c : mine; }
        if (sum == G) break;
        __builtin_amdgcn_s_sleep(1);
        if ((++sp & 255u) == 0u) { if (xb_ld(&bar[XB_TMO])) break; if (sp > XB_SPIN_CAP) { atomicAdd(&bar[XB_TMO], 1u); break; } }
    }
    nloc = mine > 0u ? mine : 1u; nx = cnt > 0u ? cnt : 1u;
}

__device__ __forceinline__ void xcd_barrier(const XcdBarrier& b, const int tid_in) {
    asm volatile("s_waitcnt vmcnt(0)" ::: "memory");
    __syncthreads();
    if (tid_in == 0) {
        unsigned* bar = b.bar;
        __builtin_amdgcn_s_waitcnt(0);
        unsigned nloc = b.st[0], nx = b.st[1];
        if (nloc == 0u) { xcd_barrier_complete(bar, b.x, nloc, nx); b.st[0] = nloc; b.st[1] = nx; }
        const unsigned old = xb_add(&bar[XB_XSUB(b.x)], 1u);
        const unsigned gen = old / nloc;
        if (old + 1u == (gen + 1u) * nloc) {
            __builtin_amdgcn_fence(__ATOMIC_RELEASE, "agent");
            asm volatile("s_waitcnt vmcnt(0)" ::: "memory");
            const unsigned og = xb_add(&bar[XB_TOP], 1u);
            const unsigned tg = og / nx;
            if (og + 1u == (tg + 1u) * nx) xb_add(&bar[XB_TOPGEN], 1u);
            else XB_SPIN(xb_ld(&bar[XB_TOPGEN]) == tg, bar);
            __builtin_amdgcn_fence(__ATOMIC_ACQUIRE, "agent");
            xb_add(&bar[XB_XGEN(b.x)], 1u);
            asm volatile("s_waitcnt vmcnt(0)" ::: "memory");
        } else {
            XB_SPIN(xb_ld(&bar[XB_XGEN(b.x)]) == gen, bar);
            __builtin_amdgcn_fence(__ATOMIC_ACQUIRE, "agent");
            asm volatile("s_waitcnt vmcnt(0)" ::: "memory");
        }
    }
    __syncthreads();
}

#ifndef MK_ONE_LAUNCH
#define MK_ONE_LAUNCH 1
#endif
#ifndef PROBE_REP_MASK
#define PROBE_REP_MASK 0
#endif
#define REPS(bit) _Pragma("unroll") for (int rep_ = 0; rep_ < ((PROBE_REP_MASK >> (bit)) & 1) + 1; ++rep_)
constexpr int NWAVES = 8, NTHREADS = NWAVES * 64;
constexpr int BATCH = 8, SEQ = 2048, T = BATCH * SEQ, D = 1024, DEPTH = 2;
constexpr int NPROJ = 4352;
constexpr int N_INPUTS = 29;
constexpr int NADA = 6144;
constexpr float RMS_EPS = 1e-6f;
constexpr float QSCALE = 0.10206207261596575f * 1.4426950408889634f;
enum { I_X = 0, I_C, I_POS, I_WADA, I_BADA, I_N1G, I_WIN, I_QNG, I_WQUP, I_KVNG, I_WKVUP, I_WBA, I_CONVW, I_CONVB, I_WQM, I_WKM, I_WVM, I_BI, I_BF, I_MHG, I_MSKIP,
       I_WBM, I_WOUT, I_N2G, I_PWQ, I_PKEYS, I_PU, I_PV, I_FG };

constexpr size_t MiB = 1u << 20;
constexpr size_t WS_CTL = 0, CTL_ZERO_BYTES = 1 * MiB;
constexpr int CW_BAR = 4096;
constexpr int CW_XC = 8192;
constexpr size_t ADA_OFF = 256 * 1024;
constexpr size_t WS_COS = 1 * MiB, WS_SIN = 2 * MiB;
constexpr size_t WS_W = 3 * MiB, W_LAYER = 18 * MiB;
constexpr size_t WO_WIN = 0, WO_WQ = 8912896, WO_WKV = WO_WQ + 1179648, WO_WA = WO_WKV + 524288, WO_WM = WO_WA + 1048576, WO_WO = WO_WM + 1048576,
                 WO_PWQ = WO_WO + 2097152, WO_WQK = WO_PWQ + 2097152, WO_WV = WO_WQK + 1048576, WO_KEYB = WO_WV + 524288;
static_assert(WO_KEYB + 262144 <= W_LAYER, "weights fit");
constexpr size_t WS_X = 40 * MiB, WS_H = 104 * MiB, WS_QLAT = 136 * MiB, WS_KVLAT = 160 * MiB, WS_UM = 168 * MiB, WS_OPRE = 184 * MiB, WS_GA = 200 * MiB, WS_GM = 232 * MiB,
                 WS_SMALL = 264 * MiB, WS_RQ = 268 * MiB, WS_RKV = WS_RQ + 65536, WS_LOGI = WS_RQ + 262144, WS_LOGF = WS_RQ + 524288, WS_Q = 269 * MiB, WS_K = 293 * MiB,
                 WS_V = 317 * MiB, WS_CONV = 333 * MiB, WS_QKM = 349 * MiB, WS_VM = 381 * MiB, WS_AO = 397 * MiB, WS_OUTM = 413 * MiB, WS_U8 = 429 * MiB, WS_V8 = 445 * MiB, WS_END = 493 * MiB;
constexpr size_t WS_H8 = 493 * MiB, WS_XS = WS_RQ + 131072, WS_USC = WS_RQ + 786432;
constexpr size_t WS_END2 = 509 * MiB;
constexpr size_t WS_IDX = WS_UM, WS_GATE = WS_UM + 8 * MiB, WS_ACT = WS_OPRE;
constexpr size_t WS_SMALLP = WS_OUTM;
constexpr size_t WS_PQ = WS_QLAT, WS_MERGED = WS_QLAT;

constexpr int RING_OFF = 0, RING_BYTES = 131072;
constexpr int LDSCTL_OFF = RING_BYTES, MISC_OFF = LDSCTL_OFF + 320;
constexpr int LDS_BYTES = 147456;

typedef float f32x2v __attribute__((ext_vector_type(2)));
typedef unsigned u32x2 __attribute__((ext_vector_type(2)));

__device__ __forceinline__ float wave_sum(float v) {
#pragma unroll
    for (int o = 1; o < 64; o <<= 1) v += __shfl_xor(v, o);
    return v;
}
__device__ __forceinline__ float bflo(unsigned u) { return __uint_as_float(u << 16); }
__device__ __forceinline__ float bfhi(unsigned u) { return __uint_as_float(u & 0xffff0000u); }
__device__ __forceinline__ float sigm(float x) { return 1.f / (1.f + __expf(-x)); }
__device__ __forceinline__ float dot4(f32x4 a, f32x4 b) { return (a.x * b.x + a.y * b.y) + (a.z * b.z + a.w * b.w); }
__device__ __forceinline__ float gelu_erf(float x) { return 0.5f * x * (1.f + erff(x * 0.70710678118654752f)); }

struct EpiProj {
    static constexpr bool PERM = true, AFTER_DRAIN = false;
    bf16 *qlat, *kvlat, *um, *opre, *ga, *gm; float* small;
    __device__ __forceinline__ void operator()(const f32x4 (&acc)[2][2][4][2], const pg8::Unit& u, int wr, int wc, int fr, int fq) const {
        const int pn = u.pn; bf16* dst; int ld, cb; int mode = 0;
        if (pn < 3) { dst = qlat; ld = 768; cb = pn * 256; }
        else if (pn == 3) { dst = kvlat; ld = 256; cb = 0; }
        else if (pn < 6) { dst = um; ld = 512; cb = (pn - 4) * 256; }
        else if (pn < 8) { dst = opre; ld = 512; cb = (pn - 6) * 256; }
        else if (pn < 12) { dst = ga; ld = 1024; cb = (pn - 8) * 256; mode = 1; }
        else if (pn < 16) { dst = gm; ld = 1024; cb = (pn - 12) * 256; mode = 1; }
        else { dst = nullptr; ld = 0; cb = 0; mode = 2; }
        const int row0 = u.pm * 256 + wr * 64 + fr;
        if (mode == 2) {
            if (wc < 2) {
#pragma unroll
                for (int ai = 0; ai < 2; ++ai)
#pragma unroll
                    for (int m = 0; m < 4; ++m) { float* p = small + (size_t)(row0 + ai * 128 + m * 16) * 64 + wc * 32 + 8 * fq;
                        *(f32x4*)p = acc[ai][0][m][0]; *(f32x4*)(p + 4) = acc[ai][0][m][1]; }
            }
        } else {
#pragma unroll
            for (int ai = 0; ai < 2; ++ai)
#pragma unroll
                for (int m = 0; m < 4; ++m) { bf16* rowp = dst + (size_t)(row0 + ai * 128 + m * 16) * ld + cb + wc * 32 + 8 * fq;
#pragma unroll
                    for (int bj = 0; bj < 2; ++bj) { f32x4 v0 = acc[ai][bj][m][0], v1 = acc[ai][bj][m][1];
                        if (mode == 1) { v0 = (f32x4){sigm(v0[0]), sigm(v0[1]), sigm(v0[2]), sigm(v0[3])}; v1 = (f32x4){sigm(v1[0]), sigm(v1[1]), sigm(v1[2]), sigm(v1[3])}; }
                        v4u w; w.x = pk2(v0[0], v0[1]); w.y = pk2(v0[2], v0[3]); w.z = pk2(v1[0], v1[1]); w.w = pk2(v1[2], v1[3]);
                        *(v4u*)(rowp + bj * 128) = w; } }
        }
    }
};
struct EpiSmallPart {
    static constexpr bool PERM = true, AFTER_DRAIN = false;
    float* part;
    __device__ __forceinline__ void operator()(const f32x4 (&acc)[2][2][4][2], const pg8::Unit& u, int wr, int wc, int fr, int fq) const {
        if (wc >= 2) return;
        const int row0 = u.pm * 256 + wr * 64 + fr;
#pragma unroll
        for (int ai = 0; ai < 2; ++ai)
#pragma unroll
            for (int m = 0; m < 4; ++m) { float* p = part + (size_t)(row0 + ai * 128 + m * 16) * 64 + wc * 32 + 8 * fq;
                *(f32x4*)p = acc[ai][0][m][0]; *(f32x4*)(p + 4) = acc[ai][0][m][1]; }
    }
};
struct EpiQ {
    static constexpr bool PERM = true, AFTER_DRAIN = false;
    bf16* Q; const float* rq; const float* cosT; const float* sinT;
    __device__ __forceinline__ void operator()(const f32x4 (&acc)[2][2][4][2], const pg8::Unit& u, int wr, int wc, int fr, int fq) const {
        const int row0 = u.pm * 256 + wr * 64 + fr;
        int c0b[2], d0b[2];
#pragma unroll
        for (int bj = 0; bj < 2; ++bj) { c0b[bj] = u.pn * 256 + bj * 128 + wc * 32 + 8 * fq; d0b[bj] = c0b[bj] % 96; }
#pragma unroll
        for (int ai = 0; ai < 2; ++ai) {
            float rr[4]; f32x4 csv[4][2], snv[4][2];
#pragma unroll
            for (int m = 0; m < 4; ++m) { const int row = row0 + ai * 128 + m * 16; rr[m] = rq[row];
#pragma unroll
                for (int bj = 0; bj < 2; ++bj) { csv[m][bj] = (f32x4){1.f, 1.f, 1.f, 1.f}; snv[m][bj] = (f32x4){0.f, 0.f, 0.f, 0.f};
                    if (d0b[bj] >= 64) { const int j0 = (d0b[bj] - 64) >> 1; csv[m][bj] = *(const f32x4*)(cosT + (size_t)row * 16 + j0); snv[m][bj] = *(const f32x4*)(sinT + (size_t)row * 16 + j0); } } }
            __builtin_amdgcn_sched_barrier(0);
#pragma unroll
            for (int m = 0; m < 4; ++m) { const int row = row0 + ai * 128 + m * 16; const float r = rr[m];
#pragma unroll
                for (int bj = 0; bj < 2; ++bj) {
                    f32x4 v0 = acc[ai][bj][m][0] * r, v1 = acc[ai][bj][m][1] * r;
                    if (d0b[bj] >= 64) { const f32x4 cs = csv[m][bj], sn = snv[m][bj]; const f32x4 a0 = v0, a1 = v1;
                        v0[0] = a0[0] * cs[0] - a0[1] * sn[0]; v0[1] = a0[1] * cs[0] + a0[0] * sn[0];
                        v0[2] = a0[2] * cs[1] - a0[3] * sn[1]; v0[3] = a0[3] * cs[1] + a0[2] * sn[1];
                        v1[0] = a1[0] * cs[2] - a1[1] * sn[2]; v1[1] = a1[1] * cs[2] + a1[0] * sn[2];
                        v1[2] = a1[2] * cs[3] - a1[3] * sn[3]; v1[3] = a1[3] * cs[3] + a1[2] * sn[3]; }
                    v4u w; w.x = pk2(v0[0], v0[1]); w.y = pk2(v0[2], v0[3]); w.z = pk2(v1[0], v1[1]); w.w = pk2(v1[2], v1[3]);
                    *(v4u*)(Q + (size_t)row * 768 + c0b[bj]) = w; } }
        }
    }
};
struct EpiKV {
    static constexpr bool PERM = true, AFTER_DRAIN = false;
    bf16* K; bf16* V; const float* rkv;
    __device__ __forceinline__ void operator()(const f32x4 (&acc)[2][2][4][2], const pg8::Unit& u, int wr, int wc, int fr, int fq) const {
        const int row0 = u.pm * 256 + wr * 64 + fr;
        float rr[2][4];
#pragma unroll
        for (int ai = 0; ai < 2; ++ai)
#pragma unroll
            for (int m = 0; m < 4; ++m) rr[ai][m] = rkv[row0 + ai * 128 + m * 16];
#pragma unroll
        for (int ai = 0; ai < 2; ++ai)
#pragma unroll
            for (int m = 0; m < 4; ++m) { const int row = row0 + ai * 128 + m * 16; const float r = rr[ai][m];
#pragma unroll
                for (int bj = 0; bj < 2; ++bj) { const int c0 = u.pn * 256 + bj * 128 + wc * 32 + 8 * fq;
                    const f32x4 v0 = acc[ai][bj][m][0] * r, v1 = acc[ai][bj][m][1] * r;
                    bf16* dst = (c0 < 512) ? (K + (size_t)row * 768 + 96 * (c0 >> 6) + (c0 & 63)) : (V + (size_t)row * 512 + (c0 - 512));
                    v4u w; w.x = pk2(v0[0], v0[1]); w.y = pk2(v0[2], v0[3]); w.z = pk2(v1[0], v1[1]); w.w = pk2(v1[2], v1[3]);
                    *(v4u*)dst = w; } }
    }
};
struct EpiMerge {
    static constexpr bool PERM = true, AFTER_DRAIN = false;
    bf16* Mg; const bf16* gate; int first;
    __device__ __forceinline__ void operator()(const f32x4 (&acc)[2][2][4][2], const pg8::Unit& u, int wr, int wc, int fr, int fq) const {
        const int row0 = u.pm * 256 + wr * 64 + fr, cbase = u.pn * 256 + wc * 32 + 8 * fq;
#pragma unroll
        for (int ai = 0; ai < 2; ++ai) {
            v4u gq[4][2], oq[4][2];
#pragma unroll
            for (int m = 0; m < 4; ++m)
#pragma unroll
                for (int bj = 0; bj < 2; ++bj) { const size_t off = (size_t)(row0 + ai * 128 + m * 16) * 1024 + cbase + bj * 128;
                    gq[m][bj] = *(const v4u*)(gate + off); oq[m][bj] = first ? (v4u){0u, 0u, 0u, 0u} : *(const v4u*)(Mg + off); }
            __builtin_amdgcn_sched_barrier(0);
#pragma unroll
            for (int m = 0; m < 4; ++m)
#pragma unroll
                for (int bj = 0; bj < 2; ++bj) { const size_t off = (size_t)(row0 + ai * 128 + m * 16) * 1024 + cbase + bj * 128;
                    const v4u g = gq[m][bj], o = oq[m][bj];
                    f32x4 v0 = acc[ai][bj][m][0], v1 = acc[ai][bj][m][1];
                    v0[0] = v0[0] * bflo(g.x) + bflo(o.x); v0[1] = v0[1] * bfhi(g.x) + bfhi(o.x); v0[2] = v0[2] * bflo(g.y) + bflo(o.y); v0[3] = v0[3] * bfhi(g.y) + bfhi(o.y);
                    v1[0] = v1[0] * bflo(g.z) + bflo(o.z); v1[1] = v1[1] * bfhi(g.z) + bfhi(o.z); v1[2] = v1[2] * bflo(g.w) + bflo(o.w); v1[3] = v1[3] * bfhi(g.w) + bfhi(o.w);
                    v4u w; w.x = pk2(v0[0], v0[1]); w.y = pk2(v0[2], v0[3]); w.z = pk2(v1[0], v1[1]); w.w = pk2(v1[2], v1[3]);
                    *(v4u*)(Mg + off) = w; }
        }
    }
};
struct EpiResid {
    static constexpr bool PERM = true, AFTER_DRAIN = false;
    const float* xin; float* xout; const float* gate;
    __device__ __forceinline__ void operator()(const f32x4 (&acc)[2][2][4][2], const pg8::Unit& u, int wr, int wc, int fr, int fq) const {
        const int row0 = u.pm * 256 + wr * 64 + fr, b = (u.pm * 256) >> 11, cbase = u.pn * 256 + wc * 32 + 8 * fq;
        f32x4 gv[2][2];
#pragma unroll
        for (int bj = 0; bj < 2; ++bj) { const float* gp = gate + (size_t)b * NADA + cbase + bj * 128; gv[bj][0] = *(const f32x4*)gp; gv[bj][1] = *(const f32x4*)(gp + 4); }
#pragma unroll
        for (int ai = 0; ai < 2; ++ai) {
            f32x4 xv[4][2][2];
#pragma unroll
            for (int m = 0; m < 4; ++m)
#pragma unroll
                for (int bj = 0; bj < 2; ++bj) { const size_t off = (size_t)(row0 + ai * 128 + m * 16) * 1024 + cbase + bj * 128; xv[m][bj][0] = *(const f32x4*)(xin + off); xv[m][bj][1] = *(const f32x4*)(xin + off + 4); }
            __builtin_amdgcn_sched_barrier(0);
#pragma unroll
            for (int m = 0; m < 4; ++m)
#pragma unroll
                for (int bj = 0; bj < 2; ++bj) { const size_t off = (size_t)(row0 + ai * 128 + m * 16) * 1024 + cbase + bj * 128;
                    *(f32x4*)(xout + off) = xv[m][bj][0] + gv[bj][0] * acc[ai][bj][m][0]; *(f32x4*)(xout + off + 4) = xv[m][bj][1] + gv[bj][1] * acc[ai][bj][m][1]; }
        }
    }
};

template <class Get> __device__ __forceinline__ void prep_tile(const Get& get, bf16* dst, int K, int k0, int n0, LAS float* scr, int lane) {
    float tv[32];
#pragma unroll
    for (int i = 0; i < 32; ++i) tv[i] = get(k0 + 2 * i + (lane >> 5), n0 + (lane & 31));
#pragma unroll
    for (int i = 0; i < 32; ++i) { const int kk = 2 * i + (lane >> 5); scr[kk * 33 + (lane & 31)] = tv[i]; }
    LDS_WAIT(); asm volatile("" ::: "memory");
    const int c = lane & 7;
#pragma unroll
    for (int j = 0; j < 4; ++j) { const int n = (lane >> 3) + 8 * j; const LAS float* s = scr + (8 * c) * 33 + n;
        v4u o; o.x = pk2(s[0 * 33], s[1 * 33]); o.y = pk2(s[2 * 33], s[3 * 33]); o.z = pk2(s[4 * 33], s[5 * 33]); o.w = pk2(s[6 * 33], s[7 * 33]);
        *(GAS v4u*)(dst + (size_t)(n0 + n) * K + k0 + 8 * c) = o; }
    LDS_WAIT(); asm volatile("" ::: "memory");
}
struct GetWin { const float* w; __device__ __forceinline__ float operator()(int k, int n) const {
    int sc; if (n < 1024) sc = n; else if (n < 2048) sc = n + 32; else if (n < 4096) sc = n + 40; else if (n < 4128) sc = n - 3072; else if (n < 4136) sc = n - 2048; else sc = -1;
    return sc < 0 ? 0.f : w[(size_t)k * 4136 + sc]; } };
struct GetWq { const float* w; const float* g; __device__ __forceinline__ float operator()(int k, int n) const {
    const int h = n / 96, dd = n % 96; const int e = dd - 64; const int sd = dd < 64 ? dd : 64 + (e >> 1) + 16 * (e & 1);
    return w[(size_t)k * 768 + h * 96 + sd] * g[k] * QSCALE; } };
struct GetWkv { const float* w; const float* g; __device__ __forceinline__ float operator()(int k, int n) const {
    const int nn = n & 511, h = nn >> 6, c = nn & 63; const int sc = h * 128 + c + ((n >= 512) ? 64 : 0);
    return w[(size_t)k * 1024 + sc] * g[k]; } };
struct GetPlain { const float* w; int N; __device__ __forceinline__ float operator()(int k, int n) const { return w[(size_t)k * N + n]; } };
struct GetWqk { const float* wq; const float* wk; __device__ __forceinline__ float operator()(int k, int n) const {
    const int part = n >> 9, nn = n & 511, h = nn >> 7, e = nn & 127, kh = k >> 7, d = k & 127;
    if (kh != h) return 0.f;
    const size_t off = ((size_t)h * 128 + d) * 128 + e;
    return part ? wk[off] * 0.08838834764831845f : wq[off]; } };
struct GetWv { const float* wv; __device__ __forceinline__ float operator()(int k, int n) const {
    const int h = n >> 7, e = n & 127, kh = k >> 7, d = k & 127;
    return (kh != h) ? 0.f : wv[((size_t)h * 128 + d) * 128 + e]; } };

__device__ const float INV_FREQ[16] = { 1.0f, 0.5623413251903491f, 0.31622776601683794f, 0.1778279410038923f, 0.1f, 0.05623413251903491f, 0.031622776601683794f, 0.01778279410038923f,
    0.01f, 0.005623413251903491f, 0.0031622776601683794f, 0.001778279410038923f, 0.001f, 0.0005623413251903491f, 0.00031622776601683794f, 0.0001778279410038923f };

__device__ __forceinline__ void rowpass_norm_mod(const float* xin, const float* g, const float* ada_shift, const float* ada_scale, bf16* hout, int gw, int NGW, int lane, unsigned char* h8 = nullptr, float* xs = nullptr) {
    f32x4 vn[4];
    if (gw < T) {
#pragma unroll
        for (int j = 0; j < 4; ++j) vn[j] = ((const f32x4*)(xin + (size_t)gw * D) + lane)[64 * j]; }
    for (int t = gw; t < T; t += NGW) {
        const int b = t >> 11;
        f32x4 v[4]; float s = 0.f;
#pragma unroll
        for (int j = 0; j < 4; ++j) { v[j] = vn[j]; s += dot4(v[j], v[j]); }
        { const int tn = (t + NGW < T) ? t + NGW : t;
#pragma unroll
          for (int j = 0; j < 4; ++j) vn[j] = ((const f32x4*)(xin + (size_t)tn * D) + lane)[64 * j]; }
        const float r = rsqrtf(wave_sum(s) * (1.f / D) + RMS_EPS);
        unsigned long long* o8 = (unsigned long long*)(hout + (size_t)t * D) + lane;
        f32x4 ov[4]; float am = 0.f;
#pragma unroll
        for (int j = 0; j < 4; ++j) { const int col = 4 * lane + 256 * j;
            const f32x4 gg = *(const f32x4*)(g + col), sc = *(const f32x4*)(ada_scale + (size_t)b * NADA + col), sh = *(const f32x4*)(ada_shift + (size_t)b * NADA + col);
            const f32x4 o = v[j] * r * gg * (sc + 1.f) + sh; ov[j] = o;
            am = fmaxf(fmaxf(am, fmaxf(fabsf(o.x), fabsf(o.y))), fmaxf(fabsf(o.z), fabsf(o.w)));
            o8[64 * j] = (unsigned long long)pk2(o.x, o.y) | ((unsigned long long)pk2(o.z, o.w) << 32); }
        if (h8) {
#pragma unroll
            for (int o = 1; o < 64; o <<= 1) am = fmaxf(am, __shfl_xor(am, o));
            const float inv = am > 0.f ? 127.f / am : 0.f;
#pragma unroll
            for (int j = 0; j < 4; ++j) { const int q0 = (int)rintf(ov[j].x * inv), q1 = (int)rintf(ov[j].y * inv), q2 = (int)rintf(ov[j].z * inv), q3 = (int)rintf(ov[j].w * inv);
                ((unsigned*)(h8 + (size_t)t * D))[lane + 64 * j] = (unsigned)(q0 & 255) | ((unsigned)(q1 & 255) << 8) | ((unsigned)(q2 & 255) << 16) | ((unsigned)(q3 & 255) << 24); }
            if (lane == 0) xs[t] = am * (1.f / 127.f);
        }
    }
}
__device__ __forceinline__ void rowpass_final(const float* xin, const float* g, float* out, int gw, int NGW, int lane) {
    f32x4 vn[4];
    if (gw < T) {
#pragma unroll
        for (int j = 0; j < 4; ++j) vn[j] = ((const f32x4*)(xin + (size_t)gw * D) + lane)[64 * j]; }
    for (int t = gw; t < T; t += NGW) {
        f32x4 v[4]; float s = 0.f;
#pragma unroll
        for (int j = 0; j < 4; ++j) { v[j] = vn[j]; s += dot4(v[j], v[j]); }
        { const int tn = (t + NGW < T) ? t + NGW : t;
#pragma unroll
          for (int j = 0; j < 4; ++j) vn[j] = ((const f32x4*)(xin + (size_t)tn * D) + lane)[64 * j]; }
        const float r = rsqrtf(wave_sum(s) * (1.f / D) + RMS_EPS);
        f32x4* o = (f32x4*)(out + (size_t)t * D) + lane;
#pragma unroll
        for (int j = 0; j < 4; ++j) { const f32x4 gg = *(const f32x4*)(g + 4 * lane + 256 * j); o[64 * j] = v[j] * r * gg; }
    }
}
__device__ __forceinline__ void rowpass_mid(const bf16* qlat, const bf16* kvlat, const float* small, const float* smallp, const float* cosT, const float* sinT, const bf16* um,
                                            const float* conv_w, const float* conv_b, const float* b_i, const float* b_f,
                                            float* RQ, float* RKV, bf16* K, float* LOGI, float* LOGF, bf16* CONV, int gw, int NGW, int lane) {
    const int c0 = 8 * lane;
    f32x4 cw[4][2], cb[2];
#pragma unroll
    for (int j = 0; j < 4; ++j) { cw[j][0] = *(const f32x4*)(conv_w + j * 512 + c0); cw[j][1] = *(const f32x4*)(conv_w + j * 512 + c0 + 4); }
    cb[0] = *(const f32x4*)(conv_b + c0); cb[1] = *(const f32x4*)(conv_b + c0 + 4);
    const float bsel = (lane >= 32 && lane < 36) ? b_i[lane - 32] : (lane >= 36 && lane < 40) ? b_f[lane - 36] : 0.f;
    for (int tb = gw * 4; tb < T; tb += NGW * 4) {
        const int pos0 = tb & (SEQ - 1);
        u32x2 qv[4][3], kvv[4]; v4u uw[7]; float sv[4], cs[4], sn[4];
#pragma unroll
        for (int i = 0; i < 4; ++i) { const int t = tb + i; const u32x2* p = (const u32x2*)(qlat + (size_t)t * 768);
#pragma unroll
            for (int j = 0; j < 3; ++j) qv[i][j] = p[lane + 64 * j];
            kvv[i] = ((const u32x2*)(kvlat + (size_t)t * 256))[lane];
            sv[i] = 0.f;
            if (lane < 40) sv[i] = smallp ? ((smallp[(size_t)t * 64 + lane] + smallp[(size_t)(T + t) * 64 + lane]) + (smallp[(size_t)(2 * T + t) * 64 + lane] + smallp[(size_t)(3 * T + t) * 64 + lane]))
                                         : small[(size_t)t * 64 + lane];
            cs[i] = 0.f; sn[i] = 0.f; if (lane < 16) { cs[i] = cosT[(size_t)t * 16 + lane]; sn[i] = sinT[(size_t)t * 16 + lane]; } }
#pragma unroll
        for (int j = 0; j < 7; ++j) { uw[j] = (v4u){0u, 0u, 0u, 0u}; if (pos0 - 3 + j >= 0) uw[j] = *(const v4u*)(um + (size_t)(tb - 3 + j) * 512 + c0); }
#pragma unroll
        for (int i = 0; i < 4; ++i) { const int t = tb + i;
            float s = 0.f;
#pragma unroll
            for (int j = 0; j < 3; ++j) { const u32x2 w = qv[i][j]; const float a = bflo(w.x), b2 = bfhi(w.x), c = bflo(w.y), d = bfhi(w.y); s += (a * a + b2 * b2) + (c * c + d * d); }
            const float rq = rsqrtf(wave_sum(s) * (1.f / 768.f) + RMS_EPS);
            const u32x2 w = kvv[i]; const float a = bflo(w.x), b2 = bfhi(w.x), c = bflo(w.y), d = bfhi(w.y);
            const float rkv = rsqrtf(wave_sum((a * a + b2 * b2) + (c * c + d * d)) * (1.f / 256.f) + RMS_EPS);
            if (lane == 0) { RQ[t] = rq; RKV[t] = rkv; }
            const float x2 = __shfl(sv[i], (lane + 16) & 63);
            if (lane < 16) { const float x1 = sv[i]; const unsigned pk = pk2(x1 * cs[i] - x2 * sn[i], x2 * cs[i] + x1 * sn[i]);
#pragma unroll
                for (int h = 0; h < 8; ++h) ((unsigned*)(K + (size_t)t * 768 + 96 * h + 64))[lane] = pk; }
            else if (lane >= 32 && lane < 36) LOGI[(size_t)t * 4 + (lane - 32)] = sv[i] + bsel;
            else if (lane >= 36 && lane < 40) { const float x = sv[i] + bsel; LOGF[(size_t)t * 4 + (lane - 36)] = fminf(x, 0.f) - log1pf(expf(-fabsf(x))); }
            float acc[8];
            acc[0] = cb[0][0]; acc[1] = cb[0][1]; acc[2] = cb[0][2]; acc[3] = cb[0][3]; acc[4] = cb[1][0]; acc[5] = cb[1][1]; acc[6] = cb[1][2]; acc[7] = cb[1][3];
#pragma unroll
            for (int j = 0; j < 4; ++j) { const v4u u4 = uw[i + j];
                acc[0] += cw[j][0][0] * bflo(u4.x); acc[1] += cw[j][0][1] * bfhi(u4.x); acc[2] += cw[j][0][2] * bflo(u4.y); acc[3] += cw[j][0][3] * bfhi(u4.y);
                acc[4] += cw[j][1][0] * bflo(u4.z); acc[5] += cw[j][1][1] * bfhi(u4.z); acc[6] += cw[j][1][2] * bflo(u4.w); acc[7] += cw[j][1][3] * bfhi(u4.w); }
#pragma unroll
            for (int q = 0; q < 8; ++q) acc[q] = acc[q] * sigm(acc[q]);
            v4u o; o.x = pk2(acc[0], acc[1]); o.y = pk2(acc[2], acc[3]); o.z = pk2(acc[4], acc[5]); o.w = pk2(acc[6], acc[7]);
            *(v4u*)(CONV + (size_t)t * 512 + c0) = o; }
    }
}

typedef float f32x16 __attribute__((ext_vector_type(16)));
typedef short s16x4 __attribute__((ext_vector_type(4)));
typedef short v4i16_t __attribute__((ext_vector_type(4)));
typedef float f32x2_t __attribute__((ext_vector_type(2))); typedef __bf16 bf16x2_t __attribute__((ext_vector_type(2)));
__device__ __forceinline__ unsigned cvtpk(float lo, float hi) { f32x2_t v = {lo, hi}; bf16x2_t b = __builtin_convertvector(v, bf16x2_t); return __builtin_bit_cast(unsigned, b); }
__device__ __forceinline__ s16x4 vtr(const LAS unsigned char* p) { return __builtin_bit_cast(s16x4, __builtin_amdgcn_ds_read_tr16_b64_v4i16((LAS v4i16_t*)p)); }
__device__ __forceinline__ bf16x8 pack8(float a0, float a1, float a2, float a3, float a4, float a5, float a6, float a7) {
    v4u p; p.x = cvtpk(a0, a1); p.y = cvtpk(a2, a3); p.z = cvtpk(a4, a5); p.w = cvtpk(a6, a7); return __builtin_bit_cast(bf16x8, p); }
#define MFMA32(a, b, c) __builtin_amdgcn_mfma_f32_32x32x16_bf16((a), (b), (c), 0, 0, 0)
constexpr int AT_KB = 12288, AT_VB = 8192;
__device__ __forceinline__ void attn_mfma(const bf16* Q, const bf16* K, const bf16* V, bf16* AO, LAS unsigned char* lds, int bx, int G, int tid) {
    const int lane = tid & 63, wave = __builtin_amdgcn_readfirstlane(tid >> 6), r = lane & 31, hh = lane >> 5;
    const int i16 = lane & 15, q4 = i16 >> 2, p4 = i16 & 3, blk = (lane >> 4) & 1;
    const int vboff = (4 * hh + q4) * 64 + 32 * blk + 8 * p4;
    const int kr0 = tid / 12, kc0 = tid % 12, kr1 = (tid + 512) / 12, kc1 = (tid + 512) % 12, vr = tid >> 3, vc = tid & 7;
    const int klds0 = (kc0 >> 1) * 2048 + (kc0 & 1) * 1024 + kr0 * 16, klds1 = (kc1 >> 1) * 2048 + (kc1 & 1) * 1024 + kr1 * 16;
    const int vlds = (vc >> 2) * 4096 + (vr >> 4) * 1024 + ((vr >> 3) & 1) * 512 + (vr & 7) * 64 + (vc & 3) * 16;
    for (int pu = bx; pu < 256; pu += G) {
        const int bh = pu >> 2, b = bh >> 3, h = bh & 7;
        const bf16* kg = K + ((size_t)b * SEQ) * 768 + h * 96; const bf16* vg = V + ((size_t)b * SEQ) * 512 + h * 64;
        for (int half = 0; half < 2; ++half) {
            const int qb = half == 0 ? 7 - (pu & 3) : (pu & 3);
            const int q0w = qb * 256 + wave * 32, nkt = 4 * (qb + 1), kmax = (q0w + 31) >> 6;
            bf16x8 qf[6];
            { const bf16* qrow = Q + ((size_t)b * SEQ + q0w + r) * 768 + h * 96 + 8 * hh;
#pragma unroll
              for (int s = 0; s < 6; ++s) qf[s] = *(const bf16x8*)(qrow + 16 * s); }
            f32x16 o0, o1;
#pragma unroll
            for (int i = 0; i < 16; ++i) { o0[i] = 0.f; o1[i] = 0.f; }
            float m = 0.f, l = 0.f; f32x16 negm;
#pragma unroll
            for (int i = 0; i < 16; ++i) negm[i] = 0.f;
            v4u ka = *(const v4u*)(kg + (size_t)kr0 * 768 + kc0 * 8), kb2 = (v4u){0u, 0u, 0u, 0u}, va = *(const v4u*)(vg + (size_t)vr * 512 + vc * 8);
            if (tid < 256) kb2 = *(const v4u*)(kg + (size_t)kr1 * 768 + kc1 * 8);
            __syncthreads();
            *(LAS v4u*)(lds + klds0) = ka; if (tid < 256) *(LAS v4u*)(lds + klds1) = kb2; *(LAS v4u*)(lds + 2 * AT_KB + vlds) = va;
            __syncthreads();
            for (int kt = 0; kt < nkt; ++kt) {
                const int buf = kt & 1;
                if (kt + 1 < nkt) { const size_t k1 = (size_t)(kt + 1) * 64;
                    ka = *(const v4u*)(kg + (k1 + kr0) * 768 + kc0 * 8); if (tid < 256) kb2 = *(const v4u*)(kg + (k1 + kr1) * 768 + kc1 * 8); va = *(const v4u*)(vg + (k1 + vr) * 512 + vc * 8); }
                if (kt <= kmax) {
                    const LAS unsigned char* kb_ = lds + buf * AT_KB + hh * 1024 + r * 16; const LAS unsigned char* vb_ = lds + 2 * AT_KB + buf * AT_VB + vboff;
                    f32x16 s0, s1;
                    { bf16x8 kf0[6], kf1[6];
#pragma unroll
                      for (int s = 0; s < 6; ++s) { kf0[s] = *(const LAS bf16x8*)(kb_ + s * 2048); kf1[s] = *(const LAS bf16x8*)(kb_ + s * 2048 + 512); }
                      __builtin_amdgcn_sched_barrier(0);
                      s0 = MFMA32(kf0[0], qf[0], negm); s1 = MFMA32(kf1[0], qf[0], negm);
#pragma unroll
                      for (int s = 1; s < 6; ++s) { s0 = MFMA32(kf0[s], qf[s], s0); s1 = MFMA32(kf1[s], qf[s], s1); } }
                    if (kt * 64 + 63 > q0w) { const int qq = q0w + r - kt * 64;
#pragma unroll
                        for (int i = 0; i < 16; ++i) { const int key = (i & 3) + 8 * (i >> 2) + 4 * hh; if (key > qq) s0[i] = -INFINITY; if (key + 32 > qq) s1[i] = -INFINITY; } }
                    float mx = fmaxf(fmaxf(s0[0], s1[0]), fmaxf(s0[1], s1[1]));
#pragma unroll
                    for (int i = 2; i < 16; i += 2) mx = fmaxf(fmaxf(mx, fmaxf(s0[i], s1[i])), fmaxf(s0[i + 1], s1[i + 1]));
                    { auto r32 = __builtin_amdgcn_permlane32_swap(__float_as_uint(mx), __float_as_uint(mx), false, false); mx = fmaxf(__uint_as_float(r32[0]), __uint_as_float(r32[1])); }
                    if (kt == 0 || __builtin_amdgcn_ballot_w64(mx > 8.f) != 0ull) {
                        const float d = (kt == 0) ? mx : fmaxf(mx, 0.f), corr = (kt == 0) ? 0.f : __builtin_amdgcn_exp2f(-d);
                        m = (kt == 0) ? mx : m + d; l *= corr;
#pragma unroll
                        for (int i = 0; i < 16; ++i) { o0[i] *= corr; o1[i] *= corr; s0[i] -= d; s1[i] -= d; negm[i] = -m; } }
                    float ps = 0.f;
#pragma unroll
                    for (int i = 0; i < 16; ++i) { s0[i] = __builtin_amdgcn_exp2f(s0[i]); s1[i] = __builtin_amdgcn_exp2f(s1[i]); ps += s0[i] + s1[i]; }
                    l += ps;
                    bf16x8 pf[4];
                    pf[0] = pack8(s0[0], s0[1], s0[2], s0[3], s0[4], s0[5], s0[6], s0[7]); pf[1] = pack8(s0[8], s0[9], s0[10], s0[11], s0[12], s0[13], s0[14], s0[15]);
                    pf[2] = pack8(s1[0], s1[1], s1[2], s1[3], s1[4], s1[5], s1[6], s1[7]); pf[3] = pack8(s1[8], s1[9], s1[10], s1[11], s1[12], s1[13], s1[14], s1[15]);
                    { s16x4 vlo[8], vhi[8];
#pragma unroll
                      for (int ks = 0; ks < 4; ++ks) { vlo[ks] = vtr(vb_ + ks * 1024); vhi[ks] = vtr(vb_ + ks * 1024 + 512); vlo[4 + ks] = vtr(vb_ + 4096 + ks * 1024); vhi[4 + ks] = vtr(vb_ + 4096 + ks * 1024 + 512); }
                      __builtin_amdgcn_sched_barrier(0);
#pragma unroll
                      for (int ks = 0; ks < 4; ++ks) {
                          const bf16x8 a0 = (bf16x8){vlo[ks][0], vlo[ks][1], vlo[ks][2], vlo[ks][3], vhi[ks][0], vhi[ks][1], vhi[ks][2], vhi[ks][3]};
                          const bf16x8 a1 = (bf16x8){vlo[4 + ks][0], vlo[4 + ks][1], vlo[4 + ks][2], vlo[4 + ks][3], vhi[4 + ks][0], vhi[4 + ks][1], vhi[4 + ks][2], vhi[4 + ks][3]};
                          o0 = MFMA32(a0, pf[ks], o0); o1 = MFMA32(a1, pf[ks], o1); } }
                }
                if (kt + 1 < nkt) { LAS unsigned char* nb = lds + (buf ^ 1) * AT_KB; *(LAS v4u*)(nb + klds0) = ka; if (tid < 256) *(LAS v4u*)(nb + klds1) = kb2; *(LAS v4u*)(lds + 2 * AT_KB + (buf ^ 1) * AT_VB + vlds) = va; }
                __syncthreads();
            }
            const float inv = 1.f / (l + __shfl_xor(l, 32));
            bf16* orow = AO + ((size_t)b * SEQ + q0w + r) * 512 + h * 64 + 4 * hh;
#pragma unroll
            for (int g = 0; g < 4; ++g) { u32x2 w0, w1; w0.x = cvtpk(o0[4 * g] * inv, o0[4 * g + 1] * inv); w0.y = cvtpk(o0[4 * g + 2] * inv, o0[4 * g + 3] * inv);
                w1.x = cvtpk(o1[4 * g] * inv, o1[4 * g + 1] * inv); w1.y = cvtpk(o1[4 * g + 2] * inv, o1[4 * g + 3] * inv);
                *(u32x2*)(orow + 8 * g) = w0; *(u32x2*)(orow + 32 + 8 * g) = w1; }
        }
    }
}


constexpr int ML_KB = 16384, ML_VB = 16384, ML_BUF = 32768, ML_TAB = 3 * 32768;
__device__ __forceinline__ void mlstm_mfma(const bf16* QKM, const bf16* VM, const float* LOGI, const float* LOGF, const bf16* CONV, const bf16* OPRE, const float* ng, const float* skip,
                                           bf16* OUTM, LAS unsigned char* lds, int bx, int G, int tid) {
    const int lane = tid & 63, wave = __builtin_amdgcn_readfirstlane(tid >> 6), r = lane & 31, hh = lane >> 5;
    const int i16 = lane & 15, q4 = i16 >> 2, p4 = i16 & 3, blk = (lane >> 4) & 1;
    const int vboff = (4 * hh + q4) * 64 + 32 * blk + 8 * p4;
    int goff[4], loff[4];
#pragma unroll
    for (int q = 0; q < 4; ++q) { const int j = 4 * wave + q;
        if (j < 16) { goff[q] = lane * 1024 + 16 * (j >> 1) + 8 * (j & 1); loff[q] = (j >> 1) * 2048 + (j & 1) * 1024; }
        else { const int jv = j - 16, dq = jv >> 2, ks = jv & 3; goff[q] = (16 * ks + 8 * (lane >> 5) + ((lane >> 2) & 7)) * 512 + 32 * dq + 8 * (lane & 3); loff[q] = ML_KB + dq * 4096 + ks * 1024; } }
    const bool kwave = wave < 4;
#define ML_DMA(tile, bufi) do { _Pragma("unroll") for (int q_ = 0; q_ < 4; ++q_) { \
        const bf16* src_ = kwave ? (kg + (size_t)(tile) * 64 * 1024 + goff[q_]) : (vg + (size_t)(tile) * 64 * 512 + goff[q_]); \
        __builtin_amdgcn_global_load_lds((const unsigned*)src_, (LAS unsigned*)(lds + (bufi) * ML_BUF + loff[q_]), 16, 0, 0); } } while (0)
    LAS float* Ftab = (LAS float*)(lds + ML_TAB); LAS float* Ctab = Ftab + 2048; LAS float* wtot = Ctab + 2048;
    constexpr float L2E = 1.4426950408889634f;
    for (int pu = bx; pu < 256; pu += G) {
        const int bh = pu >> 3, p = pu & 7, b = bh >> 2, h = bh & 3;
        __syncthreads();
        { float f4[4], i4[4];
#pragma unroll
          for (int e = 0; e < 4; ++e) { const size_t row = (size_t)b * SEQ + tid * 4 + e; f4[e] = LOGF[row * 4 + h]; i4[e] = LOGI[row * 4 + h]; }
          f4[1] += f4[0]; f4[2] += f4[1]; f4[3] += f4[2];
          float x = f4[3];
          x += __uint_as_float(__builtin_amdgcn_update_dpp(0, __float_as_uint(x), 0x111, 0xf, 0xf, true)); x += __uint_as_float(__builtin_amdgcn_update_dpp(0, __float_as_uint(x), 0x112, 0xf, 0xf, true));
          x += __uint_as_float(__builtin_amdgcn_update_dpp(0, __float_as_uint(x), 0x114, 0xf, 0xf, true)); x += __uint_as_float(__builtin_amdgcn_update_dpp(0, __float_as_uint(x), 0x118, 0xf, 0xf, true));
          { const float t0 = __uint_as_float(__builtin_amdgcn_readlane(__float_as_uint(x), 15)), t1 = __uint_as_float(__builtin_amdgcn_readlane(__float_as_uint(x), 31)), t2 = __uint_as_float(__builtin_amdgcn_readlane(__float_as_uint(x), 47));
            const int row = lane >> 4; x += (row >= 1 ? t0 : 0.f) + (row >= 2 ? t1 : 0.f) + (row >= 3 ? t2 : 0.f); }
          if (lane == 63) wtot[wave] = x;
          __syncthreads();
          float base = x - f4[3];
          for (int w = 0; w < wave; ++w) base += wtot[w];
#pragma unroll
          for (int e = 0; e < 4; ++e) { const float F = base + f4[e]; Ftab[tid * 4 + e] = F * L2E; Ctab[tid * 4 + e] = (i4[e] - F) * L2E; } }
        __syncthreads();
        const int grp = wave >> 2, w4 = wave & 3;
        const int q0w = (grp == 0 ? 128 * p : 128 * (15 - p)) + 32 * w4, kmax = (q0w + 31) >> 6, nkt = 2 * (16 - p);
        const size_t trow = (size_t)b * SEQ + q0w + r;
        bf16x8 qf[8];
        { const bf16* qrow = QKM + trow * 1024 + h * 128 + 8 * hh;
#pragma unroll
          for (int s = 0; s < 8; ++s) qf[s] = *(const bf16x8*)(qrow + 16 * s); }
        const float Ft = Ftab[q0w + r], Ft0 = Ftab[q0w];
        LAS float* wt = Ctab + 2048 + 64 + wave * 64;
        f32x16 o[4];
#pragma unroll
        for (int d = 0; d < 4; ++d)
#pragma unroll
            for (int i = 0; i < 16; ++i) o[d][i] = 0.f;
        float den = 0.f;
        const bf16* kg = QKM + ((size_t)b * SEQ) * 1024 + 512 + h * 128; const bf16* vg = VM + ((size_t)b * SEQ) * 512 + h * 128;
        ML_DMA(0, 0);
        if (nkt > 1) { ML_DMA(1, 1); asm volatile("s_waitcnt vmcnt(4)" ::: "memory"); } else asm volatile("s_waitcnt vmcnt(0)" ::: "memory");
        asm volatile("s_waitcnt lgkmcnt(0)" ::: "memory"); __builtin_amdgcn_s_barrier(); asm volatile("" ::: "memory");
        for (int kt = 0; kt < nkt; ++kt) {
            const int buf = kt % 3;
            if (kt + 2 < nkt) ML_DMA(kt + 2, (kt + 2) % 3);
            if (kt <= kmax) {
                const LAS unsigned char* kb_ = lds + buf * ML_BUF + hh * 1024 + r * 16; const LAS unsigned char* vb_ = lds + buf * ML_BUF + ML_KB + vboff;
                f32x16 s0, s1;
#pragma unroll
                for (int i = 0; i < 16; ++i) { s0[i] = 0.f; s1[i] = 0.f; }
#pragma unroll
                for (int sh = 0; sh < 2; ++sh) { bf16x8 kf0[4], kf1[4];
#pragma unroll
                  for (int s = 0; s < 4; ++s) { kf0[s] = *(const LAS bf16x8*)(kb_ + (4 * sh + s) * 2048); kf1[s] = *(const LAS bf16x8*)(kb_ + (4 * sh + s) * 2048 + 512); }
                  __builtin_amdgcn_sched_barrier(0);
#pragma unroll
                  for (int s = 0; s < 4; ++s) { s0 = MFMA32(kf0[s], qf[4 * sh + s], s0); s1 = MFMA32(kf1[s], qf[4 * sh + s], s1); } }
                const int qq = q0w + r - kt * 64;
                const bool diag = kt * 64 + 63 > q0w;
                wt[lane] = __builtin_amdgcn_exp2f(Ctab[kt * 64 + lane] + Ft0);
                LDS_WAIT();
                const LAS float* ct = wt + 4 * hh;
                float ps = 0.f;
#pragma unroll
                for (int g = 0; g < 4; ++g) { const f32x4 c0v = *(const LAS f32x4*)(ct + 8 * g), c1v = *(const LAS f32x4*)(ct + 32 + 8 * g);
#pragma unroll
                    for (int e = 0; e < 4; ++e) { const int i = 4 * g + e, key = e + 8 * g + 4 * hh;
                        float w0 = c0v[e], w1 = c1v[e];
                        if (diag) { w0 = (key <= qq) ? w0 : 0.f; w1 = (key + 32 <= qq) ? w1 : 0.f; }
                        s0[i] *= w0; s1[i] *= w1; ps += s0[i] + s1[i]; } }
                den += ps;
                bf16x8 pf[4];
                pf[0] = pack8(s0[0], s0[1], s0[2], s0[3], s0[4], s0[5], s0[6], s0[7]); pf[1] = pack8(s0[8], s0[9], s0[10], s0[11], s0[12], s0[13], s0[14], s0[15]);
                pf[2] = pack8(s1[0], s1[1], s1[2], s1[3], s1[4], s1[5], s1[6], s1[7]); pf[3] = pack8(s1[8], s1[9], s1[10], s1[11], s1[12], s1[13], s1[14], s1[15]);
#pragma unroll
                for (int ks = 0; ks < 4; ++ks) { s16x4 vlo[4], vhi[4];
#pragma unroll
                    for (int d = 0; d < 4; ++d) { vlo[d] = vtr(vb_ + d * 4096 + ks * 1024); vhi[d] = vtr(vb_ + d * 4096 + ks * 1024 + 512); }
                    __builtin_amdgcn_sched_barrier(0);
#pragma unroll
                    for (int d = 0; d < 4; ++d) { const s16x4 lo = vlo[d], hi = vhi[d];
                        const bf16x8 av = (bf16x8){lo[0], lo[1], lo[2], lo[3], hi[0], hi[1], hi[2], hi[3]};
                        o[d] = MFMA32(av, pf[ks], o[d]); } }
            }
            if (kt + 2 < nkt) asm volatile("s_waitcnt vmcnt(4)" ::: "memory"); else asm volatile("s_waitcnt vmcnt(0)" ::: "memory");
            asm volatile("s_waitcnt lgkmcnt(0)" ::: "memory"); __builtin_amdgcn_s_barrier(); asm volatile("" ::: "memory");
        }
        const float kap = __builtin_amdgcn_exp2f(Ft - Ft0);
        const float dt = (den + __shfl_xor(den, 32)) * kap;
        const float inv = kap / fmaxf(fabsf(dt), 1.f);
        float sm = 0.f;
#pragma unroll
        for (int d = 0; d < 4; ++d)
#pragma unroll
            for (int i = 0; i < 16; ++i) { o[d][i] *= inv; sm += o[d][i]; }
        sm += __shfl_xor(sm, 32);
        const float mu = sm * (1.f / 128.f);
        float vs = 0.f;
#pragma unroll
        for (int d = 0; d < 4; ++d)
#pragma unroll
            for (int i = 0; i < 16; ++i) { const float dlt = o[d][i] - mu; vs += dlt * dlt; }
        vs += __shfl_xor(vs, 32);
        const float rstd = rsqrtf(vs * (1.f / 128.f) + RMS_EPS);
#pragma unroll
        for (int d = 0; d < 4; ++d)
#pragma unroll
            for (int g = 0; g < 4; ++g) { const int ch = h * 128 + 32 * d + 8 * g + 4 * hh; const size_t off = trow * 512 + ch;
                const u32x2 cv = *(const u32x2*)(CONV + off), ov = *(const u32x2*)(OPRE + off); const f32x4 gg = *(const f32x4*)(ng + ch), sk = *(const f32x4*)(skip + ch);
                const float y0 = sigm(bflo(ov.x)) * ((o[d][4 * g] - mu) * rstd * gg[0] + sk[0] * bflo(cv.x)), y1 = sigm(bfhi(ov.x)) * ((o[d][4 * g + 1] - mu) * rstd * gg[1] + sk[1] * bfhi(cv.x));
                const float y2 = sigm(bflo(ov.y)) * ((o[d][4 * g + 2] - mu) * rstd * gg[2] + sk[2] * bflo(cv.y)), y3 = sigm(bfhi(ov.y)) * ((o[d][4 * g + 3] - mu) * rstd * gg[3] + sk[3] * bfhi(cv.y));
                u32x2 w; w.x = cvtpk(y0, y1); w.y = cvtpk(y2, y3); *(u32x2*)(OUTM + off) = w; }
    }
#undef ML_DMA
}

template <int N> __device__ __forceinline__ void bitonic_sort_desc(float (&v)[N]) {
#pragma unroll
    for (int k = 2; k <= N; k <<= 1)
#pragma unroll
        for (int j = k >> 1; j > 0; j >>= 1)
#pragma unroll
            for (int i = 0; i < N; ++i) { const int l = i ^ j; if (l > i) { const bool desc = ((i & k) == 0); const float a = v[i], b = v[l], hi = fmaxf(a, b), lo = fminf(a, b); v[i] = desc ? hi : lo; v[l] = desc ? lo : hi; } }
}
__device__ __forceinline__ void top16_merge(float (&a)[16], const float (&b)[16]) {
#pragma unroll
    for (int i = 0; i < 16; ++i) a[i] = fmaxf(a[i], b[15 - i]);
#pragma unroll
    for (int j = 8; j > 0; j >>= 1)
#pragma unroll
        for (int i = 0; i < 16; ++i) { const int l = i ^ j; if (l > i) { const float x = a[i], y = a[l]; a[i] = fmaxf(x, y); a[l] = fminf(x, y); } }
}
constexpr int PE_EIDX = 0, PE_EGATE = 16384, PE_KEYT = 32768;
__device__ __forceinline__ void peer_route(const bf16* PQ, const bf16* KEYB, int* IDX, float* GATE, LAS unsigned char* lds, int bx, int G, int tid) {
    const int lane = tid & 63, wave = __builtin_amdgcn_readfirstlane(tid >> 6), r = lane & 31, hh = lane >> 5;
    LAS unsigned char* keyt = lds + PE_KEYT + (wave * 32 + r) * 32;
    for (int grp = bx; grp < T / 32; grp += G) {
        const int t0 = grp * 32;
        { const int h = wave;
          int rq = r; asm volatile("" : "+v"(rq));
          float top[2][16];
#pragma unroll
          for (int p = 0; p < 2; ++p) {
              bf16x8 qf[4];
              { const bf16* qrow = PQ + (size_t)(t0 + rq) * 1024 + h * 128 + p * 64 + 8 * hh;
#pragma unroll
                for (int s = 0; s < 4; ++s) qf[s] = *(const bf16x8*)(qrow + 16 * s); }
              const bf16* kb = KEYB + ((size_t)(h * 2 + p) * 128 + rq) * 64 + 8 * hh;
              float sv[4][16];
#pragma unroll
              for (int kt = 0; kt < 4; ++kt) { f32x16 acc;
#pragma unroll
                  for (int i = 0; i < 16; ++i) acc[i] = 0.f;
#pragma unroll
                  for (int s = 0; s < 4; ++s) { const bf16x8 a = *(const bf16x8*)(kb + (size_t)(32 * kt) * 64 + 16 * s); acc = MFMA32(a, qf[s], acc); }
#pragma unroll
                  for (int i = 0; i < 16; ++i) { const unsigned key = (unsigned)(32 * kt + (i & 3) + 8 * (i >> 2)) + 4u * (unsigned)hh; sv[kt][i] = __uint_as_float((__float_as_uint(acc[i]) & ~127u) | key); } }
              bitonic_sort_desc<16>(sv[0]); bitonic_sort_desc<16>(sv[1]); bitonic_sort_desc<16>(sv[2]); bitonic_sort_desc<16>(sv[3]);
              top16_merge(sv[0], sv[1]); top16_merge(sv[2], sv[3]); top16_merge(sv[0], sv[2]);
              float pr[16];
#pragma unroll
              for (int i = 0; i < 16; ++i) { auto r32 = __builtin_amdgcn_permlane32_swap(__float_as_uint(sv[0][i]), __float_as_uint(sv[0][i]), false, false); pr[i] = __uint_as_float(hh ? r32[0] : r32[1]); }
              top16_merge(sv[0], pr);
#pragma unroll
              for (int i = 0; i < 16; ++i) top[p][i] = sv[0][i];
          }
          if (hh == 0) {
#pragma unroll
              for (int i = 0; i < 16; ++i) { keyt[i] = (unsigned char)(__float_as_uint(top[0][i]) & 127u); keyt[16 + i] = (unsigned char)(__float_as_uint(top[1][i]) & 127u); } }
          float cs[4][16];
#define PSUM(a, b) __uint_as_float((__float_as_uint(top[0][a] + top[1][b]) & ~255u) | (unsigned)((a) * 16 + (b)))
#pragma unroll
          for (int b2 = 0; b2 < 16; ++b2) cs[0][b2] = PSUM(0, b2);
#pragma unroll
          for (int b2 = 0; b2 < 8; ++b2) cs[1][b2] = PSUM(1, b2);
#pragma unroll
          for (int a2 = 8; a2 < 16; ++a2) cs[1][a2] = PSUM(a2, 0);
#pragma unroll
          for (int b2 = 0; b2 < 5; ++b2) cs[2][b2] = PSUM(2, b2);
#pragma unroll
          for (int b2 = 0; b2 < 4; ++b2) cs[2][5 + b2] = PSUM(3, b2);
#pragma unroll
          for (int b2 = 0; b2 < 3; ++b2) cs[2][9 + b2] = PSUM(4, b2);
          cs[2][12] = PSUM(5, 0); cs[2][13] = PSUM(5, 1); cs[2][14] = PSUM(6, 0); cs[2][15] = PSUM(6, 1);
          cs[3][0] = PSUM(7, 0); cs[3][1] = PSUM(7, 1);
#undef PSUM
#pragma unroll
          for (int i = 2; i < 16; ++i) cs[3][i] = -3.0e38f;
          bitonic_sort_desc<16>(cs[0]); bitonic_sort_desc<16>(cs[1]); bitonic_sort_desc<16>(cs[2]); bitonic_sort_desc<16>(cs[3]);
          top16_merge(cs[0], cs[1]); top16_merge(cs[2], cs[3]); top16_merge(cs[0], cs[2]);
          LDS_WAIT();
          float ev[16], den = 0.f; const float mx = __uint_as_float(__float_as_uint(cs[0][0]) & ~255u);
#pragma unroll
          for (int k = 0; k < 16; ++k) { ev[k] = __expf(__uint_as_float(__float_as_uint(cs[0][k]) & ~255u) - mx); den += ev[k]; }
          const float rden = 1.f / den;
          if (hh == 0) {
#pragma unroll
              for (int k = 0; k < 16; ++k) { const unsigned code = __float_as_uint(cs[0][k]) & 255u; const int e = (int)keyt[code >> 4] * 128 + (int)keyt[16 + (code & 15u)];
                  IDX[(size_t)(t0 + r) * 128 + h * 16 + k] = e; GATE[(size_t)(t0 + r) * 128 + h * 16 + k] = ev[k] * rden; } }
        }
    }
}
__device__ __forceinline__ void peer_partition(const unsigned* xc_cnt, volatile LAS unsigned* MISC, int bx, int G, int& vx, int& rank, int& nb) {
    bool use_xcc = MK_ONE_LAUNCH != 0; unsigned mine = 0u; const unsigned myx = MISC[13];
    if (use_xcc) { unsigned sum = 0u;
#pragma unroll
        for (unsigned j = 0; j < 8; ++j) { const unsigned c = __hip_atomic_load(xc_cnt + 64 * j, __ATOMIC_RELAXED, __HIP_MEMORY_SCOPE_AGENT); use_xcc = use_xcc && (c > 0u); sum += c; mine = (j == myx) ? c : mine; }
        use_xcc = use_xcc && (sum == (unsigned)G); }
    if (use_xcc) { vx = (int)myx; rank = (int)MISC[12]; nb = (int)mine; } else { vx = bx & 7; rank = bx >> 3; nb = (G - vx + 7) >> 3; }
    vx = __builtin_amdgcn_readfirstlane(vx); rank = __builtin_amdgcn_readfirstlane(rank); nb = __builtin_amdgcn_readfirstlane(nb);
}
__device__ __forceinline__ void peer_u_i8(const unsigned char* H8, const float* XS, const int* IDX, const unsigned char* U8, const f32x2v* SC2, float* ACT, LAS float* wscr, int vx, int rank, int nb, int tid) {
    const int lane = tid & 63, wave = __builtin_amdgcn_readfirstlane(tid >> 6), g4 = lane >> 4, c16 = lane & 15;
    const int tstride = nb * 8;
    LAS int* clist = (LAS int*)wscr;
    LAS unsigned char* xs = (LAS unsigned char*)(wscr + 512);
    const unsigned long long lt = (1ull << lane) - 1ull;
    const unsigned char* ubase = U8 + 16 * c16;
    int ni[8];
    { const int tb = rank * 8 + wave;
#pragma unroll
      for (int j = 0; j < 4; ++j) { const int tj = tb + j * tstride; const bool ok = tj < T; ni[2 * j] = ok ? IDX[(size_t)tj * 128 + lane] : 0x7fffffff; ni[2 * j + 1] = ok ? IDX[(size_t)tj * 128 + 64 + lane] : 0x7fffffff; } }
    for (int tb = rank * 8 + wave; tb < T; tb += 4 * tstride) {
        int ntot = 0;
#pragma unroll
        for (int j = 0; j < 4; ++j) { const int e0 = ni[2 * j], e1 = ni[2 * j + 1]; const bool f0 = (e0 >> 11) == vx, f1 = (e1 >> 11) == vx;
            const unsigned long long m0 = __ballot(f0), m1 = __ballot(f1); const int n0 = __popcll(m0);
            if (f0) clist[ntot + __popcll(m0 & lt)] = (j << 21) | (e0 << 7) | lane;
            if (f1) clist[ntot + n0 + __popcll(m1 & lt)] = (j << 21) | (e1 << 7) | (64 + lane);
            ntot += n0 + __popcll(m1); }
        v4u xr[4]; float sx[4];
#pragma unroll
        for (int j = 0; j < 4; ++j) { const int tj = tb + j * tstride, tl = tj < T ? tj : tb; xr[j] = *(const v4u*)(H8 + (size_t)tl * 1024 + 16 * lane); sx[j] = XS[tl]; }
        { const int tn = tb + 4 * tstride;
#pragma unroll
          for (int j = 0; j < 4; ++j) { const int tj = tn + j * tstride; const bool ok = tj < T; ni[2 * j] = ok ? IDX[(size_t)tj * 128 + lane] : 0x7fffffff; ni[2 * j + 1] = ok ? IDX[(size_t)tj * 128 + 64 + lane] : 0x7fffffff; } }
        if (ntot == 0) continue;
#pragma unroll
        for (int j = 0; j < 4; ++j) *(LAS v4u*)(xs + j * 1024 + 16 * lane) = xr[j];
        LDS_WAIT();
        const int last = ntot - 1, nit = (ntot + 3) >> 2, nit4 = (nit + 3) >> 2;
        v4u ub[4][4]; f32x2v us[4]; int up[4];
#pragma unroll
        for (int k = 0; k < 3; ++k) { const int p = min(4 * k + g4, last); const int pk = clist[p]; up[k] = pk; const unsigned eo = (unsigned)((pk >> 7) & 16383) * 1024u; us[k] = SC2[(pk >> 7) & 16383];
#pragma unroll
            for (int jj = 0; jj < 4; ++jj) ub[k][jj] = *(const v4u*)(ubase + eo + 256 * jj); }
        int dsel = 0, psel = 0; f32x2v ssel = (f32x2v){0.f, 0.f}; bool vsel = false;
#pragma unroll 1
        for (int o = 0; o < nit4; ++o) {
#pragma unroll
            for (int k = 0; k < 4; ++k) {
                const int i = 4 * o + k;
                { const int p = min(4 * (i + 3) + g4, last); const int pk = clist[p]; up[(k + 3) & 3] = pk; const unsigned eo = (unsigned)((pk >> 7) & 16383) * 1024u; us[(k + 3) & 3] = SC2[(pk >> 7) & 16383];
#pragma unroll
                  for (int jj = 0; jj < 4; ++jj) ub[(k + 3) & 3][jj] = *(const v4u*)(ubase + eo + 256 * jj); }
                const LAS unsigned char* xp = xs + (up[k] >> 21) * 1024 + 16 * c16;
                v4u xq[4];
#pragma unroll
                for (int jj = 0; jj < 4; ++jj) xq[jj] = *(const LAS v4u*)(xp + 256 * jj);
                int a0 = 0, a1 = 0, a2 = 0, a3 = 0;
#pragma unroll
                for (int jj = 0; jj < 4; ++jj) {
                    a0 = __builtin_amdgcn_sdot4((int)xq[jj].x, (int)ub[k][jj].x, a0, false); a1 = __builtin_amdgcn_sdot4((int)xq[jj].y, (int)ub[k][jj].y, a1, false);
                    a2 = __builtin_amdgcn_sdot4((int)xq[jj].z, (int)ub[k][jj].z, a2, false); a3 = __builtin_amdgcn_sdot4((int)xq[jj].w, (int)ub[k][jj].w, a3, false); }
                int d = (a0 + a1) + (a2 + a3);
                d += __builtin_amdgcn_update_dpp(0, d, 0x128, 0xf, 0xf, false); d += __builtin_amdgcn_update_dpp(0, d, 0x124, 0xf, 0xf, false);
                d += __builtin_amdgcn_update_dpp(0, d, 0x122, 0xf, 0xf, false); d += __builtin_amdgcn_update_dpp(0, d, 0x121, 0xf, 0xf, false);
                if ((i & 15) == c16) { dsel = d; ssel = us[k]; psel = up[k]; vsel = 4 * i + g4 <= last; }
                if (k == 3 && ((o & 3) == 3 || o == nit4 - 1)) {
                    if (vsel) { const int j = psel >> 21; const float sxj = j == 0 ? sx[0] : j == 1 ? sx[1] : j == 2 ? sx[2] : sx[3];
                        ACT[(size_t)(tb + j * tstride) * 128 + (psel & 127)] = gelu_erf((float)dsel * sxj * ssel.x) * ssel.y; }
                    vsel = false; }
            }
        }
        LDS_WAIT();
    }
}
__device__ __forceinline__ void peer_v(const int* IDX, const float* ACT, const float* GATE, const unsigned char* V8, const float* gate2, const float* Xin, float* Xout, LAS float* wscr,
                                       int vx, int rank, int nb, int tid) {
    const int lane = tid & 63, wave = __builtin_amdgcn_readfirstlane(tid >> 6), g8 = lane >> 3, c8 = lane & 7;
    const int tstride = nb * 16;
    LAS int* wl = (LAS int*)wscr; LAS unsigned char* wqb = (LAS unsigned char*)(wscr + 128);
    const unsigned char* vbase = V8 + (size_t)(vx >> 1) * (2 * MiB) + 16 * c8;
    const int col = 256 * (vx >> 1) + 32 * c8;
    const int wqo0 = (lane & 7) * 16 + (lane >> 3), wqo1 = wqo0 + 8;
    const int t0 = (rank * 8 + wave) * 2 + (vx & 1);
    if (t0 >= T) return;
    const int tlast = t0 + ((T - 1 - t0) / tstride) * tstride;
#define PV_STAGE(tt, I0, I1, A0, A1, VV, WQ4, SW) { \
        float am_ = fmaxf(fabsf(A0), fabsf(A1));   \
        am_ = fmaxf(am_, __uint_as_float(__builtin_amdgcn_update_dpp(0, __float_as_uint(am_), 0x128, 0xf, 0xf, false))); am_ = fmaxf(am_, __uint_as_float(__builtin_amdgcn_update_dpp(0, __float_as_uint(am_), 0x124, 0xf, 0xf, false))); \
        am_ = fmaxf(am_, __uint_as_float(__builtin_amdgcn_update_dpp(0, __float_as_uint(am_), 0x122, 0xf, 0xf, false))); am_ = fmaxf(am_, __uint_as_float(__builtin_amdgcn_update_dpp(0, __float_as_uint(am_), 0x121, 0xf, 0xf, false))); \
        am_ = fmaxf(fmaxf(__uint_as_float(__builtin_amdgcn_readlane(__float_as_uint(am_), 0)), __uint_as_float(__builtin_amdgcn_readlane(__float_as_uint(am_), 16))), \
                    fmaxf(__uint_as_float(__builtin_amdgcn_readlane(__float_as_uint(am_), 32)), __uint_as_float(__builtin_amdgcn_readlane(__float_as_uint(am_), 48)))); \
        const float inv_ = am_ > 0.f ? 127.f / am_ : 0.f; SW = am_ * (1.f / 127.f); \
        wl[lane] = I0; wl[64 + lane] = I1; wqb[wqo0] = (unsigned char)((int)rintf(A0 * inv_) & 255); wqb[wqo1] = (unsigned char)((int)rintf(A1 * inv_) & 255); \
        LDS_WAIT(); \
        _Pragma("unroll") for (int i_ = 0; i_ < 16; ++i_) { const int e_ = wl[8 * i_ + g8]; VV[i_] = *(const v4u*)(vbase + (size_t)(unsigned)(e_ * 128)); } \
        WQ4 = *(const LAS v4u*)(wqb + g8 * 16); LDS_WAIT(); }
#define PV_META(tt, I0, I1, A0, A1) { const size_t o_ = (size_t)(tt) * 128; I0 = IDX[o_ + lane]; I1 = IDX[o_ + 64 + lane]; A0 = ACT[o_ + lane] * GATE[o_ + lane]; A1 = ACT[o_ + 64 + lane] * GATE[o_ + 64 + lane]; }
    int i0, i1, j0, j1; float a0, a1, b0, b1;
    v4u vv[16], vvn[16], wq4, wq4n; float sw, swn;
    PV_META(t0, i0, i1, a0, a1);
    PV_STAGE(t0, i0, i1, a0, a1, vvn, wq4n, swn);
    { const int t1 = min(t0 + tstride, tlast); PV_META(t1, i0, i1, a0, a1); }
    for (int t = t0; t < T; t += tstride) {
        const int b = t >> 11, tn = min(t + tstride, tlast), tn2 = min(t + 2 * tstride, tlast);
#pragma unroll
        for (int i = 0; i < 16; ++i) vv[i] = vvn[i];
        wq4 = wq4n; sw = swn;
        PV_META(tn2, j0, j1, b0, b1);
        const f32x4 xin1 = *(const f32x4*)(Xin + (size_t)t * 1024 + col + 4 * g8), g21 = *(const f32x4*)(gate2 + (size_t)b * NADA + col + 4 * g8);
        PV_STAGE(tn, i0, i1, a0, a1, vvn, wq4n, swn);
        i0 = j0; i1 = j1; a0 = b0; a1 = b1;
        int acc[32], accw = 0;
#pragma unroll
        for (int i = 0; i < 32; ++i) acc[i] = 0;
#pragma unroll
        for (int q = 0; q < 4; ++q) { const int wq = (int)(q == 0 ? wq4.x : q == 1 ? wq4.y : q == 2 ? wq4.z : wq4.w);
            accw = __builtin_amdgcn_sdot4(wq, 0x01010101, accw, false);
#pragma unroll
            for (int d = 0; d < 4; ++d) {
                const unsigned ra = d == 0 ? vv[4 * q].x : d == 1 ? vv[4 * q].y : d == 2 ? vv[4 * q].z : vv[4 * q].w, rb = d == 0 ? vv[4 * q + 1].x : d == 1 ? vv[4 * q + 1].y : d == 2 ? vv[4 * q + 1].z : vv[4 * q + 1].w;
                const unsigned rc = d == 0 ? vv[4 * q + 2].x : d == 1 ? vv[4 * q + 2].y : d == 2 ? vv[4 * q + 2].z : vv[4 * q + 2].w, rd = d == 0 ? vv[4 * q + 3].x : d == 1 ? vv[4 * q + 3].y : d == 2 ? vv[4 * q + 3].z : vv[4 * q + 3].w;
#pragma unroll
                for (int h = 0; h < 2; ++h) {
                    const unsigned a = (h ? (ra >> 4) : ra) & 0x0f0f0f0fu, bb = (h ? (rb >> 4) : rb) & 0x0f0f0f0fu, c = (h ? (rc >> 4) : rc) & 0x0f0f0f0fu, dd = (h ? (rd >> 4) : rd) & 0x0f0f0f0fu;
                    const unsigned ab_lo = __builtin_amdgcn_perm(bb, a, 0x05010400u), ab_hi = __builtin_amdgcn_perm(bb, a, 0x07030602u), cd_lo = __builtin_amdgcn_perm(dd, c, 0x05010400u), cd_hi = __builtin_amdgcn_perm(dd, c, 0x07030602u);
                    acc[8 * d + 0 + h] = __builtin_amdgcn_sdot4((int)__builtin_amdgcn_perm(cd_lo, ab_lo, 0x05040100u), wq, acc[8 * d + 0 + h], false);
                    acc[8 * d + 2 + h] = __builtin_amdgcn_sdot4((int)__builtin_amdgcn_perm(cd_lo, ab_lo, 0x07060302u), wq, acc[8 * d + 2 + h], false);
                    acc[8 * d + 4 + h] = __builtin_amdgcn_sdot4((int)__builtin_amdgcn_perm(cd_hi, ab_hi, 0x05040100u), wq, acc[8 * d + 4 + h], false);
                    acc[8 * d + 6 + h] = __builtin_amdgcn_sdot4((int)__builtin_amdgcn_perm(cd_hi, ab_hi, 0x07060302u), wq, acc[8 * d + 6 + h], false); } } }
#define PV_RED(x) { x += __builtin_amdgcn_update_dpp(0, x, 0x128, 0xf, 0xf, false); \
        { auto r16 = __builtin_amdgcn_permlane16_swap((unsigned)x, (unsigned)x, false, false); x = (int)(r16[0] + r16[1]); } \
        { auto r32 = __builtin_amdgcn_permlane32_swap((unsigned)x, (unsigned)x, false, false); x = (int)(r32[0] + r32[1]); } }
#pragma unroll
        for (int i = 0; i < 32; ++i) PV_RED(acc[i]);
        PV_RED(accw);
#undef PV_RED
        { const int off8 = 8 * accw;
          int s0 = acc[0], s1 = acc[1], s2 = acc[2], s3 = acc[3];
#pragma unroll
          for (int k = 1; k < 8; ++k) { s0 = g8 == k ? acc[4 * k] : s0; s1 = g8 == k ? acc[4 * k + 1] : s1; s2 = g8 == k ? acc[4 * k + 2] : s2; s3 = g8 == k ? acc[4 * k + 3] : s3; }
          *(f32x4*)(Xout + (size_t)t * 1024 + col + 4 * g8) = xin1 + g21 * ((f32x4){(float)(s0 - off8), (float)(s1 - off8), (float)(s2 - off8), (float)(s3 - off8)} * sw); }
    }
#undef PV_STAGE
#undef PV_META
}

constexpr int PH_PER_LAYER = 12, N_PHASES = 1 + DEPTH * PH_PER_LAYER + 1;
struct Args { const void* in[N_INPUTS]; float* out; unsigned char* ws; int ph_lo, ph_hi; };
static_assert(sizeof(Args) == N_INPUTS * 8 + 24, "Args has no padding");

constexpr int PTAB_OFF = LDSCTL_OFF + 1024;
__device__ __forceinline__ unsigned char* getp(LAS unsigned char* lds, int i) {
    asm volatile("" ::: "memory");
    const u32x2 v = *(volatile LAS u32x2*)(lds + PTAB_OFF + 8 * i);
    const unsigned lo = __builtin_amdgcn_readfirstlane(v.x), hi = __builtin_amdgcn_readfirstlane(v.y);
    GAS unsigned char* g = (GAS unsigned char*)(((unsigned long long)hi << 32) | lo);
    return (unsigned char*)g;
}
#define INP(i) ((const float*)getp(lds, (i)))
#define WSB() getp(lds, 30)

#define IN(k) (lo <= (k) && (k) < hi)
#define SEAM(k) do { if (MK_ONE_LAUNCH && IN(k) && IN((k) + 1)) { XcdBarrier b_; b_.bar = (unsigned*)(WSB() + WS_CTL) + CW_BAR; b_.x = xb_xcc_id(); b_.st = MISC + 8; REPS(11) xcd_barrier(b_, (wave_s << 6) | (int)__lane_id()); } } while (0)
#define PH_BEGIN(lv) int tidq; asm volatile("v_mbcnt_lo_u32_b32 %0, -1, 0\n\tv_mbcnt_hi_u32_b32 %0, -1, %0" : "=v"(tidq)); tidq |= wave_s << 6;     \
    asm volatile("" : "+v"(tidq)); const int lane = tidq & 63, wave = __builtin_amdgcn_readfirstlane(tidq >> 6); \
    int G = gridDim.x, bx = blockIdx.x, l = (lv); asm volatile("" : "+s"(G), "+s"(bx), "+s"(l)); const int gw = bx * NWAVES + wave, NGW = G * NWAVES; \
    unsigned char* ws = WSB(); LAS float* wscr = (LAS float*)(lds + RING_OFF + wave * 16384); (void)lane; (void)gw; (void)NGW; (void)ws; (void)wscr; (void)l


constexpr int PI_W = 4512, PI_K = 512, PI_U = 2048, PI_V = 2048, PI_TOTAL = PI_W + PI_K + PI_U + PI_V;
template <int NR> __device__ __forceinline__ void prep_rows_i8(const float* src, size_t src_stride, unsigned char* dst, size_t dst_stride, float* scale_slot  , int lane) {
    f32x4 v[NR][4];
#pragma unroll
    for (int rr = 0; rr < NR; ++rr) { const f32x4* s = (const f32x4*)(src + rr * src_stride) + lane * 4;
#pragma unroll
        for (int j = 0; j < 4; ++j) v[rr][j] = s[j]; }
#pragma unroll
    for (int rr = 0; rr < NR; ++rr) {
        float am = 0.f;
#pragma unroll
        for (int j = 0; j < 4; ++j) am = fmaxf(fmaxf(am, fmaxf(fabsf(v[rr][j][0]), fabsf(v[rr][j][1]))), fmaxf(fabsf(v[rr][j][2]), fabsf(v[rr][j][3])));
#pragma unroll
        for (int o = 1; o < 64; o <<= 1) am = fmaxf(am, __shfl_xor(am, o));
        const float inv = am > 0.f ? 127.f / am : 0.f;
#define Q4(x) ((unsigned)((int)rintf((x)[0] * inv) & 255) | ((unsigned)((int)rintf((x)[1] * inv) & 255) << 8) | ((unsigned)((int)rintf((x)[2] * inv) & 255) << 16) | ((unsigned)((int)rintf((x)[3] * inv) & 255) << 24))
        v4u o; o.x = Q4(v[rr][0]); o.y = Q4(v[rr][1]); o.z = Q4(v[rr][2]); o.w = Q4(v[rr][3]);
#undef Q4
        *(v4u*)(dst + rr * dst_stride) = o;
        if (lane == 0) scale_slot[2 * rr] = am * (1.f / 127.f);
    }
}
template <int NR> __device__ __forceinline__ void prep_rows_i4(const float* src, size_t src_stride, unsigned char* dst, size_t dst_stride, float* scale_slot  , int lane) {
    f32x4 v[NR][4];
#pragma unroll
    for (int rr = 0; rr < NR; ++rr) { const f32x4* s = (const f32x4*)(src + rr * src_stride) + lane * 4;
#pragma unroll
        for (int j = 0; j < 4; ++j) v[rr][j] = s[j]; }
#pragma unroll
    for (int rr = 0; rr < NR; ++rr) {
        float am = 0.f, ss = 0.f;
#pragma unroll
        for (int j = 0; j < 4; ++j) { am = fmaxf(fmaxf(am, fmaxf(fabsf(v[rr][j][0]), fabsf(v[rr][j][1]))), fmaxf(fabsf(v[rr][j][2]), fabsf(v[rr][j][3]))); ss += dot4(v[rr][j], v[rr][j]); }
#pragma unroll
        for (int o = 1; o < 64; o <<= 1) { am = fmaxf(am, __shfl_xor(am, o)); ss += __shfl_xor(ss, o); }
        am = fminf(am, 2.7f * sqrtf(ss * (1.f / 1024.f)));
        const float inv = am > 0.f ? 7.f / am : 0.f;
#define N4(x) ((unsigned)((int)fminf(fmaxf(rintf((x) * inv), -7.f), 7.f) + 8))
#define B4(x, y) (N4(x) | (N4(y) << 4))
        u32x2 o;
        o.x = B4(v[rr][0][0], v[rr][0][1]) | (B4(v[rr][0][2], v[rr][0][3]) << 8) | (B4(v[rr][1][0], v[rr][1][1]) << 16) | (B4(v[rr][1][2], v[rr][1][3]) << 24);
        o.y = B4(v[rr][2][0], v[rr][2][1]) | (B4(v[rr][2][2], v[rr][2][3]) << 8) | (B4(v[rr][3][0], v[rr][3][1]) << 16) | (B4(v[rr][3][2], v[rr][3][3]) << 24);
#undef B4
#undef N4
        *(u32x2*)(dst + rr * dst_stride) = o;
        if (lane == 0) scale_slot[2 * rr] = am * (1.f / 7.f);
    }
}
__device__ __forceinline__ void prep_item(LAS unsigned char* lds, unsigned char* ws, LAS float* wscr, int l, int r, int lane) {
    constexpr int I_WIN_ = 16 * 136, I_WQ_ = 12 * 24, I_WKV_ = 4 * 32, I_WA_ = 8 * 32, I_WM_ = 8 * 32, I_WO_ = 16 * 32, I_PW_ = 16 * 32, I_WQK_ = 8 * 32, I_WV_ = 8 * 16;
    static_assert(I_WIN_ + I_WQ_ + I_WKV_ + I_WA_ + I_WM_ + I_WO_ + I_PW_ + I_WQK_ + I_WV_ == PI_W, "weight items");
    unsigned char* wl = ws + WS_W + (size_t)l * W_LAYER;
    if (r < PI_W) {
        if (r < I_WIN_) { const GetWin g{INP(I_WIN) + (size_t)l * D * 4136}; prep_tile(g, (bf16*)(wl + WO_WIN), 1024, 64 * (r / 136), 32 * (r % 136), wscr, lane); return; } r -= I_WIN_;
        if (r < I_WQ_) { const GetWq g{INP(I_WQUP) + (size_t)l * 768 * 768, INP(I_QNG) + l * 768}; prep_tile(g, (bf16*)(wl + WO_WQ), 768, 64 * (r / 24), 32 * (r % 24), wscr, lane); return; } r -= I_WQ_;
        if (r < I_WKV_) { const GetWkv g{INP(I_WKVUP) + (size_t)l * 256 * 1024, INP(I_KVNG) + l * 256}; prep_tile(g, (bf16*)(wl + WO_WKV), 256, 64 * (r / 32), 32 * (r % 32), wscr, lane); return; } r -= I_WKV_;
        if (r < I_WA_) { const GetPlain g{INP(I_WBA) + (size_t)l * 512 * 1024, 1024}; prep_tile(g, (bf16*)(wl + WO_WA), 512, 64 * (r / 32), 32 * (r % 32), wscr, lane); return; } r -= I_WA_;
        if (r < I_WM_) { const GetPlain g{INP(I_WBM) + (size_t)l * 512 * 1024, 1024}; prep_tile(g, (bf16*)(wl + WO_WM), 512, 64 * (r / 32), 32 * (r % 32), wscr, lane); return; } r -= I_WM_;
        if (r < I_WO_) { const GetPlain g{INP(I_WOUT) + (size_t)l * 1024 * 1024, 1024}; prep_tile(g, (bf16*)(wl + WO_WO), 1024, 64 * (r / 32), 32 * (r % 32), wscr, lane); return; } r -= I_WO_;
        if (r < I_PW_) { const GetPlain g{INP(I_PWQ) + (size_t)l * 1024 * 1024, 1024}; prep_tile(g, (bf16*)(wl + WO_PWQ), 1024, 64 * (r / 32), 32 * (r % 32), wscr, lane); return; } r -= I_PW_;
        if (r < I_WQK_) { const GetWqk g{INP(I_WQM) + (size_t)l * 65536, INP(I_WKM) + (size_t)l * 65536}; prep_tile(g, (bf16*)(wl + WO_WQK), 512, 64 * (r / 32), 32 * (r % 32), wscr, lane); return; } r -= I_WQK_;
        { const GetWv g{INP(I_WVM) + (size_t)l * 65536}; prep_tile(g, (bf16*)(wl + WO_WV), 512, 64 * (r / 16), 32 * (r % 16), wscr, lane); }
        return; }
    r -= PI_W;
    if (r < PI_K) { const int o = (r * 64 + lane) * 4;
        const f32x4 v = *(const f32x4*)(INP(I_PKEYS) + (size_t)l * 131072 + o); u32x2 w; w.x = pk2(v[0], v[1]); w.y = pk2(v[2], v[3]);
        *(u32x2*)(wl + WO_KEYB + (size_t)o * 2) = w; return; }
    r -= PI_K;
    float* sc2 = (float*)(ws + WS_USC);
    if (r < PI_U) { const float* pu = INP(I_PU) + (size_t)l * 16777216;
        for (int rr = 0; rr < 8; rr += 8) { const int er = r * 8 + rr; prep_rows_i8<8>(pu + (size_t)er * 1024, 1024, ws + WS_U8 + (size_t)l * 32 * MiB + (size_t)er * 1024 + 16 * lane, 1024, sc2 + 2 * (l * 16384 + er), lane); }
        return; }
    r -= PI_U;
    { const float* pv = INP(I_PV) + (size_t)l * 16777216;
      for (int rr = 0; rr < 8; rr += 8) { const int er = r * 8 + rr;
          prep_rows_i4<8>(pv + (size_t)er * 1024, 1024, ws + WS_V8 + (size_t)l * 32 * MiB + (size_t)(lane >> 4) * (2 * MiB) + (size_t)er * 128 + 8 * (lane & 15), 128, sc2 + 2 * (l * 16384 + er) + 1, lane); } }
}
template <int lv> __device__ __forceinline__ void layer_phases(LAS unsigned char* lds, volatile LAS unsigned* MISC, const int lo, const int hi, const int wave_s) {
        const int P = 1 + lv * PH_PER_LAYER;
#define WL() (ws + WS_W + (size_t)l * W_LAYER)
#define ADAL() ((const float*)(ws + ADA_OFF) + (size_t)l * 8 * NADA)
#define XIN() ((l == 0) ? INP(I_X) : (const float*)getp(lds, 29))
#define WSP(type, off) ((type*)(ws + (off)))
        if (IN(P + 0)) REPS(1) { PH_BEGIN(lv); rowpass_norm_mod(XIN(), INP(I_N1G) + l * D, ADAL() + 0, ADAL() + 1024, WSP(bf16, WS_H), gw, NGW, lane); }
        SEAM(P + 0);
        if (IN(P + 1)) REPS(2) { PH_BEGIN(lv);
            if (G == 256) {
                { pg8::Gemm g{WSP(bf16, WS_H), (const bf16*)(WL() + WO_WIN), T, 4096, D}; pg8::StaticOrder S; S.init(T, 4096, G, bx);
                  EpiProj E{WSP(bf16, WS_QLAT), WSP(bf16, WS_KVLAT), WSP(bf16, WS_UM), WSP(bf16, WS_OPRE), WSP(bf16, WS_GA), WSP(bf16, WS_GM), WSP(float, WS_SMALL)};
                  pg8::gemm_phase<EpiProj, pg8::StaticOrder, true, true>(lds + RING_OFF, g, S, E, tidq); }
                { const int kq = bx >> 6;
                  pg8::Gemm g{WSP(bf16, WS_H) + 256 * kq, (const bf16*)(WL() + WO_WIN) + (size_t)4096 * 1024 + 256 * kq, T, 256, 256, 1024}; pg8::StaticOrder S; S.init(T, 256, 64, bx & 63);
                  EpiSmallPart E{WSP(float, WS_SMALLP) + (size_t)kq * T * 64};
                  pg8::gemm_phase<EpiSmallPart, pg8::StaticOrder, true, true>(lds + RING_OFF, g, S, E, tidq); }
            } else {
                pg8::Gemm g{WSP(bf16, WS_H), (const bf16*)(WL() + WO_WIN), T, NPROJ, D}; pg8::StaticOrder S; S.init(T, NPROJ, G, bx);
                EpiProj E{WSP(bf16, WS_QLAT), WSP(bf16, WS_KVLAT), WSP(bf16, WS_UM), WSP(bf16, WS_OPRE), WSP(bf16, WS_GA), WSP(bf16, WS_GM), WSP(float, WS_SMALL)};
                pg8::gemm_phase<EpiProj, pg8::StaticOrder, true, true>(lds + RING_OFF, g, S, E, tidq);
            }
        }
        SEAM(P + 1);
        if (IN(P + 2)) REPS(3) { PH_BEGIN(lv);
            rowpass_mid(WSP(bf16, WS_QLAT), WSP(bf16, WS_KVLAT), WSP(float, WS_SMALL), (G == 256) ? WSP(float, WS_SMALLP) : (const float*)nullptr, WSP(float, WS_COS), WSP(float, WS_SIN), WSP(bf16, WS_UM), INP(I_CONVW) + l * 4 * 512, INP(I_CONVB) + l * 512,
                        INP(I_BI) + l * 4, INP(I_BF) + l * 4, WSP(float, WS_RQ), WSP(float, WS_RKV), WSP(bf16, WS_K), WSP(float, WS_LOGI), WSP(float, WS_LOGF), WSP(bf16, WS_CONV), gw, NGW, lane); }
        SEAM(P + 2);
        if (IN(P + 3)) REPS(4) {
            { PH_BEGIN(lv); pg8::Gemm g{WSP(bf16, WS_QLAT), (const bf16*)(WL() + WO_WQ), T, 768, 768}; pg8::StaticOrder S; S.init(T, 768, G, bx);
              EpiQ E{WSP(bf16, WS_Q), WSP(float, WS_RQ), WSP(float, WS_COS), WSP(float, WS_SIN)}; pg8::gemm_phase<EpiQ, pg8::StaticOrder, true, true>(lds + RING_OFF, g, S, E, tidq); }
            { PH_BEGIN(lv); pg8::Gemm g{WSP(bf16, WS_KVLAT), (const bf16*)(WL() + WO_WKV), T, 1024, 256}; pg8::StaticOrder S; S.init(T, 1024, G, bx);
              EpiKV E{WSP(bf16, WS_K), WSP(bf16, WS_V), WSP(float, WS_RKV)}; pg8::gemm_phase<EpiKV, pg8::StaticOrder, true, true>(lds + RING_OFF, g, S, E, tidq); }
            { PH_BEGIN(lv); pg8::Gemm g{WSP(bf16, WS_CONV), (const bf16*)(WL() + WO_WQK), T, 1024, 512}; pg8::StaticOrder S; S.init(T, 1024, G, bx);
              pg8::EpiBf16<0> E{WSP(bf16, WS_QKM), 1024, nullptr, 0, 0, 1.f}; pg8::gemm_phase<pg8::EpiBf16<0>, pg8::StaticOrder, true, true>(lds + RING_OFF, g, S, E, tidq); }
            { PH_BEGIN(lv); pg8::Gemm g{WSP(bf16, WS_UM), (const bf16*)(WL() + WO_WV), T, 512, 512}; pg8::StaticOrder S;
              if (G == 256) S.init(T, 512, 64, bx >= 192 ? bx - 192 : (1 << 20)); else S.init(T, 512, G, bx);
              pg8::EpiBf16<0> E{WSP(bf16, WS_VM), 512, nullptr, 0, 0, 1.f}; pg8::gemm_phase<pg8::EpiBf16<0>, pg8::StaticOrder, true, true>(lds + RING_OFF, g, S, E, tidq); }
        }
        SEAM(P + 3);
        if (IN(P + 4)) {
            REPS(5) { PH_BEGIN(lv); attn_mfma(WSP(bf16, WS_Q), WSP(bf16, WS_K), WSP(bf16, WS_V), WSP(bf16, WS_AO), lds + RING_OFF, bx, G, tidq); __syncthreads(); }
            REPS(6) { PH_BEGIN(lv); mlstm_mfma(WSP(bf16, WS_QKM), WSP(bf16, WS_VM), WSP(float, WS_LOGI), WSP(float, WS_LOGF), WSP(bf16, WS_CONV), WSP(bf16, WS_OPRE), INP(I_MHG) + l * 512, INP(I_MSKIP) + l * 512,
                          WSP(bf16, WS_OUTM), lds + RING_OFF, bx, G, tidq); }
        }
        SEAM(P + 4);
        if (IN(P + 5)) REPS(7) {
            { PH_BEGIN(lv); pg8::Gemm g{WSP(bf16, WS_AO), (const bf16*)(WL() + WO_WA), T, 1024, 512}; pg8::StaticOrder S; S.init(T, 1024, G, bx);
              EpiMerge E{WSP(bf16, WS_MERGED), WSP(bf16, WS_GA), 1}; pg8::gemm_phase<EpiMerge, pg8::StaticOrder, true, true>(lds + RING_OFF, g, S, E, tidq); }
            { PH_BEGIN(lv); pg8::Gemm g{WSP(bf16, WS_OUTM), (const bf16*)(WL() + WO_WM), T, 1024, 512}; pg8::StaticOrder S; S.init(T, 1024, G, bx);
              EpiMerge E{WSP(bf16, WS_MERGED), WSP(bf16, WS_GM), 0}; pg8::gemm_phase<EpiMerge, pg8::StaticOrder, true, true>(lds + RING_OFF, g, S, E, tidq); }
        }
        SEAM(P + 5);
        if (IN(P + 6)) REPS(8) { PH_BEGIN(lv);
            pg8::Gemm g{WSP(bf16, WS_MERGED), (const bf16*)(WL() + WO_WO), T, 1024, 1024}; pg8::StaticOrder S; S.init(T, 1024, G, bx);
            EpiResid E{XIN(), WSP(float, WS_X), ADAL() + 2048}; pg8::gemm_phase<EpiResid, pg8::StaticOrder, true, true>(lds + RING_OFF, g, S, E, tidq);
        }
        SEAM(P + 6);
        if (IN(P + 7)) REPS(1) { PH_BEGIN(lv); rowpass_norm_mod(WSP(float, WS_X), INP(I_N2G) + l * D, ADAL() + 3072, ADAL() + 4096, WSP(bf16, WS_H), gw, NGW, lane, ws + WS_H8, WSP(float, WS_XS)); }
        SEAM(P + 7);
        if (IN(P + 8)) REPS(9) { PH_BEGIN(lv);
            pg8::Gemm g{WSP(bf16, WS_H), (const bf16*)(WL() + WO_PWQ), T, 1024, 1024}; pg8::StaticOrder S; S.init(T, 1024, G, bx);
            pg8::EpiBf16<0> E{WSP(bf16, WS_PQ), 1024, nullptr, 0, 0, 1.f}; pg8::gemm_phase<pg8::EpiBf16<0>, pg8::StaticOrder, true, true>(lds + RING_OFF, g, S, E, tidq);
        }
        SEAM(P + 8);
        if (IN(P + 9)) REPS(10) { PH_BEGIN(lv);
            peer_route(WSP(bf16, WS_PQ), (const bf16*)(WL() + WO_KEYB), WSP(int, WS_IDX), WSP(float, WS_GATE), lds + RING_OFF, bx, G, tidq); }
        SEAM(P + 9);
        if (IN(P + 10)) REPS(12) { PH_BEGIN(lv);
            int vx, rank, nb; peer_partition((const unsigned*)(ws + WS_CTL) + CW_XC, MISC, bx, G, vx, rank, nb);
            peer_u_i8(ws + WS_H8, WSP(float, WS_XS), WSP(int, WS_IDX), ws + WS_U8 + (size_t)l * 32 * MiB, WSP(f32x2v, WS_USC) + l * 16384, WSP(float, WS_ACT), wscr, vx, rank, nb, tidq); }
        SEAM(P + 10);
        if (IN(P + 11)) REPS(13) { PH_BEGIN(lv);
            int vx, rank, nb; peer_partition((const unsigned*)(ws + WS_CTL) + CW_XC, MISC, bx, G, vx, rank, nb);
            peer_v(WSP(int, WS_IDX), WSP(float, WS_ACT), WSP(float, WS_GATE), ws + WS_V8 + (size_t)l * 32 * MiB, ADAL() + 5120, WSP(float, WS_X), (float*)getp(lds, 29), wscr, vx, rank, nb, tidq);
        }
        SEAM(P + 11);
    }

__global__ void __launch_bounds__(NTHREADS, 2) fwd(Args args) {
    extern __shared__ __attribute__((aligned(16))) unsigned char lds_raw[];
    LAS unsigned char* lds = (LAS unsigned char*)lds_raw;
    volatile LAS unsigned* MISC = (volatile LAS unsigned*)(lds + MISC_OFF);
    const int tid = threadIdx.x;
    const int wave_s = __builtin_amdgcn_readfirstlane(tid >> 6);
    for (int u = tid; u < (LDS_BYTES - LDSCTL_OFF) / 4; u += NTHREADS) ((LAS unsigned*)(lds + LDSCTL_OFF))[u] = 0u;
    __syncthreads();
    if (tid == 0) { LAS unsigned long long* pt = (LAS unsigned long long*)(lds + PTAB_OFF);
#pragma unroll
        for (int i = 0; i < N_INPUTS; ++i) pt[i] = (unsigned long long)args.in[i];
        pt[29] = (unsigned long long)args.out; pt[30] = (unsigned long long)args.ws; }
    __syncthreads();
    if (MK_ONE_LAUNCH) (void)xcd_barrier_post((unsigned*)(WSB() + WS_CTL) + CW_BAR, MISC + 8);
    if (MK_ONE_LAUNCH && tid == 0) { const unsigned xc = xb_xcc_id() & 7u; MISC[12] = xb_add((unsigned*)(WSB() + WS_CTL) + CW_XC + 64 * xc, 1u); MISC[13] = xc; }
    __syncthreads();
    const int lo = args.ph_lo, hi = args.ph_hi;

    if (IN(0)) REPS(0) {
        PH_BEGIN(0);
        float* ADA = (float*)(ws + ADA_OFF);
        { const float* c = INP(I_C); const float* wada = INP(I_WADA); const float* bada = INP(I_BADA);
          for (int it = bx; it < DEPTH * 96; it += G) {
            const int ll = it / 96, cg = it % 96; const int n = cg * 64 + lane;
#pragma unroll
            for (int i = 0; i < 16; ++i) { const int e = lane + 64 * i; const int bb = e >> 7, kk = e & 127; const float cv = c[bb * D + wave * 128 + kk]; wscr[e] = cv * sigm(cv); }
            LDS_WAIT();
            const float* w = wada + (size_t)ll * D * NADA + (size_t)(wave * 128) * NADA + n;
            float a[8];
#pragma unroll
            for (int bb = 0; bb < 8; ++bb) a[bb] = 0.f;
#pragma unroll 16
            for (int kk = 0; kk < 128; ++kk) { const float wv = w[(size_t)kk * NADA];
#pragma unroll
                for (int bb = 0; bb < 8; ++bb) a[bb] += wscr[bb * 128 + kk] * wv; }
#pragma unroll
            for (int bb = 0; bb < 8; ++bb) wscr[1024 + bb * 64 + lane] = a[bb];
            __syncthreads();
            { float s = 0.f;
#pragma unroll
              for (int w8 = 0; w8 < 8; ++w8) s += ((const LAS float*)(lds + RING_OFF + w8 * 16384))[1024 + wave * 64 + lane];
              ADA[((size_t)ll * 8 + wave) * NADA + n] = s + bada[ll * NADA + n]; }
            __syncthreads();
          } }
        { const int* pos = (const int*)INP(I_POS); float* COS = (float*)(ws + WS_COS); float* SIN = (float*)(ws + WS_SIN);
          for (int idx = gw * 64 + lane; idx < T * 16; idx += NGW * 64) { const int t = idx >> 4, j = idx & 15;
              const float ang = (float)pos[t] * INV_FREQ[j];
              const double rev = (double)ang * 0.15915494309189535; const float fr = (float)(rev - rint(rev));
              COS[idx] = __builtin_amdgcn_cosf(fr); SIN[idx] = __builtin_amdgcn_sinf(fr); } }
        for (int it = gw; it < DEPTH * PI_TOTAL; it += NGW) prep_item(lds, ws, wscr, it / PI_TOTAL, it % PI_TOTAL, lane);
    }
    SEAM(0);

    layer_phases<0>(lds, MISC, lo, hi, wave_s);
    layer_phases<1>(lds, MISC, lo, hi, wave_s);
    if (IN(N_PHASES - 1)) REPS(1) { PH_BEGIN(0); rowpass_final((const float*)getp(lds, 29), INP(I_FG), (float*)getp(lds, 29), gw, NGW, lane); }
#undef IN
#undef SEAM
}

extern "C" void kernel_launch(void* const* d_in, const int* in_sizes, int n_in, void* d_out, int out_size, void* d_ws, size_t ws_size, hipStream_t stream) {
    static int grid = 0;
    if (grid == 0) {
        if (n_in != N_INPUTS || in_sizes[0] != T * D || out_size != T * D || ws_size < WS_END2) {
            fprintf(stderr, "kernel_launch: unexpected shapes: n_in %d in0 %d out %d ws %zu (need %zu); nothing launched\n", n_in, n_in > 0 ? in_sizes[0] : -1, out_size, ws_size, (size_t)WS_END2); grid = -1; return; }
        int dev = 0, cus = 0, per_cu = 0;
        if (hipGetDevice(&dev) != hipSuccess || hipDeviceGetAttribute(&cus, hipDeviceAttributeMultiprocessorCount, dev) != hipSuccess) { fprintf(stderr, "kernel_launch: device query failed\n"); grid = -1; return; }
        if (hipFuncSetAttribute((const void*)fwd, hipFuncAttributeMaxDynamicSharedMemorySize, LDS_BYTES) != hipSuccess) { fprintf(stderr, "kernel_launch: hipFuncSetAttribute failed\n"); grid = -1; return; }
        if (hipOccupancyMaxActiveBlocksPerMultiprocessor(&per_cu, (const void*)fwd, NTHREADS, LDS_BYTES) != hipSuccess || per_cu < 1)
            fprintf(stderr, "kernel_launch: note: occupancy query reports %d workgroups per CU\n", per_cu);
        (void)hipGetLastError();
        grid = cus;
    }
    if (grid < 0) return;
    if (hipMemsetAsync((char*)d_ws + WS_CTL, 0, CTL_ZERO_BYTES, stream) != hipSuccess) { fprintf(stderr, "kernel_launch: memset failed\n"); return; }
    Args a{};
    for (int i = 0; i < N_INPUTS; ++i) a.in[i] = d_in[i];
    a.out = (float*)d_out; a.ws = (unsigned char*)d_ws;
#if MK_ONE_LAUNCH
    a.ph_lo = 0; a.ph_hi = N_PHASES;
    hipLaunchKernelGGL(fwd, dim3(grid), dim3(NTHREADS), LDS_BYTES, stream, a);
#else
    for (int p = 0; p < N_PHASES; ++p) { a.ph_lo = p; a.ph_hi = p + 1; hipLaunchKernelGGL(fwd, dim3(grid), dim3(NTHREADS), LDS_BYTES, stream, a); }
#endif
    const hipError_t le = hipPeekAtLastError();
    if (le != hipSuccess) fprintf(stderr, "kernel_launch: launch failed: %s\n", hipGetErrorName(le));
}
```

```cpp
#include <hip/hip_runtime.h>
#include <cstdio>
#include <cstdint>
namespace pg8 {
#define PG8_LAS __attribute__((address_space(3)))
typedef unsigned short bf16_t;
typedef short bf16x8 __attribute__((ext_vector_type(8)));
typedef float f32x4 __attribute__((ext_vector_type(4)));
typedef unsigned u32x4 __attribute__((ext_vector_type(4)));
constexpr int BM = 256, BK = 64, HALF = 128, HTB = HALF * BK * 2  , STAGE_BYTES = 8 * HTB, NXCD = 8, WGM = 8;

__host__ __device__ __forceinline__ int lds_byte(int r, int c) { const int st = (r >> 4) * 2 + (c >> 5), rr = r & 15, cc = c & 31, ob = rr * 64 + cc * 2; return st * 1024 + (ob ^ (((ob >> 9) & 1) << 5)); }
__host__ __device__ __forceinline__ void stage_rc(int b, int& R, int& C) { const int st = b / 1024, sb = b % 1024, swz = sb ^ (((sb >> 9) & 1) << 5); R = (st >> 1) * 16 + swz / 64; C = (st & 1) * 32 + (swz % 64) / 2; }
__host__ __device__ __forceinline__ int perm32(int rho) { const int n = rho >> 4, i = rho & 15; return 8 * (i >> 2) + 4 * n + (i & 3); }

struct Unit { int pm, pn; };
struct Gemm { const bf16_t* A; const bf16_t* Bt; int M, N, K; int ld = 0; };

struct StaticOrder {
    int nM, nN, nwg, G, c;
    __host__ __device__ void init(int M, int N, int G_, int c_) { nM = M / BM; nN = N / BM; nwg = nM * nN; G = G_; c = c_; }
    __host__ __device__ bool next(int i, Unit& u) const {
        const long L = (long)i * G + c; if (L >= nwg) return false;
        int wgid = (int)L; { const int q = nwg / NXCD, r = nwg % NXCD, xcd = wgid % NXCD, off = wgid / NXCD; wgid = (xcd < r ? xcd * (q + 1) : r * (q + 1) + (xcd - r) * q) + off; }
        const int nig = WGM * nN, gid = wgid / nig, fm = gid * WGM, gsz = (nM - fm) < WGM ? (nM - fm) : WGM;
        u.pm = fm + ((wgid % nig) % gsz); u.pn = (wgid % nig) / gsz; return true;
    }
    __device__ __forceinline__ void a_ready(const Unit&) const {}
    __device__ __forceinline__ void done(const Unit&) const {}
};

__device__ __forceinline__ unsigned cvt_pk_bf16(float lo, float hi) { unsigned r; asm volatile("v_cvt_pk_bf16_f32 %0, %1, %2" : "=v"(r) : "v"(lo), "v"(hi)); return r; }
typedef float f32x2 __attribute__((ext_vector_type(2)));
__device__ __forceinline__ f32x2 gelu_pk(f32x2 v) {
    const f32x2 av = __builtin_elementwise_abs(v), d = av * 0.2316418882f + 1.0f;
    f32x2 t; t.x = __builtin_amdgcn_rcpf(d.x); t.y = __builtin_amdgcn_rcpf(d.y);
    f32x2 q = t * 0.5307027145f + (-0.7265760135f); q = q * t + 0.7107068705f; q = q * t + (-0.142248368f); q = q * t + 0.127414796f; q = q * t;
    const f32x2 s = (v * v) * (-0.72134752044f);
    f32x2 e; e.x = __builtin_amdgcn_exp2f(s.x); e.y = __builtin_amdgcn_exp2f(s.y);
    const f32x2 m = v * (q * e), r = v - m;
    f32x2 o; o.x = v.x < 0.f ? m.x : r.x; o.y = v.y < 0.f ? m.y : r.y; return o;
}

template <int ACT  > struct EpiBf16 {
    static constexpr bool PERM = true, AFTER_DRAIN = false; static_assert(ACT == 0 || ACT == 1, "EpiBf16: ACT is 0 (none) or 1 (gelu_pk)");
    bf16_t* O; int ldc; const float* bias; int split_cols; size_t split_stride; float scale0;
    __device__ __forceinline__ void operator()(const f32x4 (&acc)[2][2][4][2], const Unit& u, int wr, int wc, int fr, int fq) const {
        const int row0 = u.pm * BM + wr * 64 + fr; int colt = u.pn * BM; bf16_t* base = O;
        float sc = 1.f; if (split_cols) { const int t = colt / split_cols; base += (size_t)t * split_stride; colt -= t * split_cols; if (t == 0) sc = scale0; }
        const int col0 = colt + wc * 32 + 8 * fq, bcol0 = u.pn * BM + wc * 32 + 8 * fq;
        f32x4 bv[2][2];
#pragma unroll
        for (int bj = 0; bj < 2; ++bj)
#pragma unroll
            for (int n = 0; n < 2; ++n) bv[bj][n] = bias ? *(const f32x4*)(bias + bcol0 + bj * HALF + 4 * n) : (f32x4){0.f, 0.f, 0.f, 0.f};
#pragma unroll
        for (int ai = 0; ai < 2; ++ai)
#pragma unroll
            for (int m = 0; m < 4; ++m) { bf16_t* rowp = base + (size_t)(row0 + ai * HALF + m * 16) * ldc + col0;
#pragma unroll
                for (int bj = 0; bj < 2; ++bj) { f32x4 v0 = acc[ai][bj][m][0] + bv[bj][0], v1 = acc[ai][bj][m][1] + bv[bj][1];
                    if (ACT == 1) { f32x2 a = gelu_pk((f32x2){v0[0], v0[1]}), b = gelu_pk((f32x2){v0[2], v0[3]}), c = gelu_pk((f32x2){v1[0], v1[1]}), d = gelu_pk((f32x2){v1[2], v1[3]});
                        v0 = (f32x4){a.x, a.y, b.x, b.y}; v1 = (f32x4){c.x, c.y, d.x, d.y}; }
                    v0 = v0 * sc; v1 = v1 * sc; u32x4 w; w.x = cvt_pk_bf16(v0[0], v0[1]); w.y = cvt_pk_bf16(v0[2], v0[3]); w.z = cvt_pk_bf16(v1[0], v1[1]); w.w = cvt_pk_bf16(v1[2], v1[3]);
                    *(u32x4*)(rowp + bj * HALF) = w; } }
    }
};


template <class Epi, class Sched, bool ALIGN_EPI = false, bool SP2 = false>
__device__ __forceinline__ void gemm_phase(PG8_LAS unsigned char* lds, const Gemm g, const Sched& S, const Epi& E, const int tid_in) {
    int tid_l = tid_in; asm volatile("" : "+v"(tid_l));
    const int tid = tid_l, wid = __builtin_amdgcn_readfirstlane(tid >> 6), lane = tid & 63, wr = wid >> 2, wc = wid & 3, fr = lane & 15, fq = lane >> 4;
    const int K = g.K, nt = K / BK, LD = g.ld ? g.ld : g.K;
    unsigned voffA[2], voffB[2];
#pragma unroll
    for (int i = 0; i < 2; ++i) { int R, C; stage_rc(tid * 16 + i * 8192, R, C); const int Rb = Epi::PERM ? ((R & ~31) + perm32(R & 31)) : R;
        voffA[i] = (unsigned)(R * LD + C) * 2u; voffB[i] = (unsigned)(Rb * LD + C) * 2u; }
    const size_t kstep = (size_t)(BK * 2);
    const size_t hstep = (size_t)HALF * LD * 2;
    const size_t tstep = 2 * hstep;
    const unsigned ldsw = (unsigned)wid * 1024u;
    const int aoff = lds_byte(wr * 64 + fr, fq * 8), boff = lds_byte(wc * 32 + fr, fq * 8);
#define PG8_SA(b, h) (((b) * 2 + (h)) * HTB)
#define PG8_SB(b, h) ((4 + (b) * 2 + (h)) * HTB)
#define PG8_STAGE(bufoff, gbase, voff) do { _Pragma("unroll") for (int _i = 0; _i < 2; ++_i) \
        __builtin_amdgcn_global_load_lds((const unsigned*)((const char*)(gbase) + (voff)[_i]), (PG8_LAS unsigned*)(lds + (bufoff) + ldsw + _i * 8192), 16, 0, 0); } while (0)
#define PG8_LDA(dst, b, h) do { _Pragma("unroll") for (int m = 0; m < 4; ++m) _Pragma("unroll") for (int k = 0; k < 2; ++k) dst[m][k] = *(const PG8_LAS bf16x8*)(lds + PG8_SA(b, h) + aoff + m * 2048 + k * 1024); } while (0)
#define PG8_LDB(dst, b, h) do { _Pragma("unroll") for (int n = 0; n < 2; ++n) _Pragma("unroll") for (int k = 0; k < 2; ++k) dst[n][k] = *(const PG8_LAS bf16x8*)(lds + PG8_SB(b, h) + boff + n * 2048 + k * 1024); } while (0)
#define PG8_MMA(ai, bj, At, Bt) do { __builtin_amdgcn_s_setprio(1); _Pragma("unroll") for (int m = 0; m < 4; ++m) _Pragma("unroll") for (int n = 0; n < 2; ++n) _Pragma("unroll") for (int k = 0; k < 2; ++k) \
        acc[ai][bj][m][n] = __builtin_amdgcn_mfma_f32_16x16x32_bf16(Bt[n][k], At[m][k], acc[ai][bj][m][n], 0, 0, 0); __builtin_amdgcn_s_setprio(0); } while (0)
#define PG8_WAIT_V(n) asm volatile("s_waitcnt vmcnt(" #n ")" ::: "memory")
#define PG8_WAIT_L(n) asm volatile("s_waitcnt lgkmcnt(" #n ")" ::: "memory")
#define PG8_BAR __builtin_amdgcn_s_barrier()
#define PG8_SCHED __builtin_amdgcn_sched_barrier(0)
    Unit cur, nxt; int ui = 0;
    if (!S.next(0, cur)) return;
    f32x4 acc[2][2][4][2];
#pragma unroll
    for (int a = 0; a < 2; ++a)
#pragma unroll
        for (int b = 0; b < 2; ++b)
#pragma unroll
            for (int m = 0; m < 4; ++m)
#pragma unroll
                for (int n = 0; n < 2; ++n) acc[a][b][m][n] = (f32x4){0.f, 0.f, 0.f, 0.f};
    bf16x8 At[4][2], B0[2][2], B1[2][2];
    const char* cA = (const char*)g.A + (size_t)cur.pm * tstep; const char* cB = (const char*)g.Bt + (size_t)cur.pn * tstep;
    S.a_ready(cur);
    if constexpr (SP2) {
        PG8_STAGE(PG8_SB(0, 0), cB, voffB); PG8_STAGE(PG8_SB(0, 1), cB + hstep, voffB); PG8_STAGE(PG8_SA(0, 0), cA, voffA); PG8_STAGE(PG8_SA(0, 1), cA + hstep, voffA);
        if (wr == 1) PG8_BAR;
        PG8_WAIT_V(2); PG8_BAR;
        PG8_STAGE(PG8_SB(1, 0), cB + kstep, voffB); PG8_STAGE(PG8_SA(1, 0), cA + kstep, voffA); PG8_STAGE(PG8_SB(1, 1), cB + hstep + kstep, voffB);
        PG8_WAIT_V(6); PG8_BAR;
    } else {
        PG8_STAGE(PG8_SB(0, 0), cB, voffB); PG8_STAGE(PG8_SA(0, 0), cA, voffA); PG8_STAGE(PG8_SB(0, 1), cB + hstep, voffB); PG8_STAGE(PG8_SA(0, 1), cA + hstep, voffA);
        if (wr == 1) PG8_BAR;
        PG8_WAIT_V(4); PG8_BAR;
        PG8_STAGE(PG8_SB(1, 0), cB + kstep, voffB); PG8_STAGE(PG8_SA(1, 0), cA + kstep, voffA); PG8_STAGE(PG8_SB(1, 1), cB + hstep + kstep, voffB);
        PG8_WAIT_V(6); PG8_BAR;
    }
    for (;;) {
        const bool has_next = S.next(ui + 1, nxt);
        const char* nA = has_next ? (const char*)g.A + (size_t)nxt.pm * tstep : cA; const char* nB = has_next ? (const char*)g.Bt + (size_t)nxt.pn * tstep : cB;
        for (int t = 0; t < nt; t += 2) {
            const bool last = (t == nt - 2);
            const char* a1 = cA + (size_t)(t + 1) * kstep;
            const char* a2 = last ? nA : cA + (size_t)(t + 2) * kstep; const char* b2 = last ? nB : cB + (size_t)(t + 2) * kstep;
            const char* a3 = a2 + kstep; const char* b3 = b2 + kstep;
            if (last && has_next) S.a_ready(nxt);
            if constexpr (SP2) {
            PG8_LDB(B0, 0, 0); PG8_LDB(B1, 0, 1); PG8_SCHED; PG8_LDA(At, 0, 0); PG8_STAGE(PG8_SA(1, 1), a1 + hstep, voffA);
            PG8_WAIT_V(8); PG8_WAIT_L(0); PG8_BAR; PG8_MMA(0, 0, At, B0); PG8_MMA(0, 1, At, B1); PG8_BAR; PG8_SCHED;
            PG8_LDA(At, 0, 1); PG8_STAGE(PG8_SB(0, 0), b2, voffB); PG8_STAGE(PG8_SB(0, 1), b2 + hstep, voffB); PG8_STAGE(PG8_SA(0, 0), a2, voffA);
            PG8_WAIT_V(8); PG8_WAIT_L(0); PG8_BAR; PG8_MMA(1, 0, At, B0); PG8_MMA(1, 1, At, B1); PG8_BAR; PG8_SCHED;
            PG8_LDB(B0, 1, 0); PG8_LDB(B1, 1, 1); PG8_SCHED; PG8_LDA(At, 1, 0); PG8_STAGE(PG8_SA(0, 1), a2 + hstep, voffA);
            PG8_WAIT_V(8); PG8_WAIT_L(0); PG8_BAR; PG8_MMA(0, 0, At, B0); PG8_MMA(0, 1, At, B1); PG8_BAR; PG8_SCHED;
            PG8_LDA(At, 1, 1); PG8_STAGE(PG8_SB(1, 0), b3, voffB); PG8_STAGE(PG8_SB(1, 1), b3 + hstep, voffB); PG8_STAGE(PG8_SA(1, 0), a3, voffA);
            PG8_WAIT_V(8); PG8_WAIT_L(0); PG8_BAR; PG8_MMA(1, 0, At, B0); PG8_MMA(1, 1, At, B1); PG8_BAR; PG8_SCHED;
            } else {
            PG8_LDB(B0, 0, 0); PG8_SCHED; PG8_LDA(At, 0, 0); PG8_STAGE(PG8_SA(1, 1), a1 + hstep, voffA);
            PG8_WAIT_L(8); PG8_BAR; PG8_WAIT_L(0); PG8_MMA(0, 0, At, B0); PG8_BAR; PG8_SCHED;
            PG8_LDB(B1, 0, 1); PG8_STAGE(PG8_SB(0, 0), b2, voffB);
            PG8_BAR; PG8_WAIT_L(0); PG8_MMA(0, 1, At, B1); PG8_BAR;
            PG8_LDA(At, 0, 1); PG8_STAGE(PG8_SA(0, 0), a2, voffA);
            PG8_BAR; PG8_WAIT_L(0); PG8_MMA(1, 0, At, B0); PG8_BAR; PG8_SCHED;
            PG8_STAGE(PG8_SB(0, 1), b2 + hstep, voffB);
            PG8_WAIT_V(6); PG8_BAR; PG8_MMA(1, 1, At, B1); PG8_BAR;
            PG8_LDB(B0, 1, 0); PG8_SCHED; PG8_LDA(At, 1, 0); PG8_STAGE(PG8_SA(0, 1), a2 + hstep, voffA);
            PG8_WAIT_L(8); PG8_BAR; PG8_WAIT_L(0); PG8_MMA(0, 0, At, B0); PG8_BAR; PG8_SCHED;
            PG8_LDB(B1, 1, 1); PG8_STAGE(PG8_SB(1, 0), b3, voffB);
            PG8_BAR; PG8_WAIT_L(0); PG8_MMA(0, 1, At, B1); PG8_BAR;
            PG8_LDA(At, 1, 1); PG8_STAGE(PG8_SA(1, 0), a3, voffA);
            PG8_BAR; PG8_WAIT_L(0); PG8_MMA(1, 0, At, B0); PG8_BAR; PG8_SCHED;
            PG8_STAGE(PG8_SB(1, 1), b3 + hstep, voffB);
            PG8_WAIT_V(6); PG8_BAR; PG8_MMA(1, 1, At, B1); PG8_BAR;
            }
        }
        if constexpr (ALIGN_EPI) { if (wr == 0) PG8_BAR; }
        if constexpr (!Epi::AFTER_DRAIN) { E(acc, cur, wr, wc, fr, fq); S.done(cur); }
        if (!has_next) break;
#pragma unroll
        for (int a = 0; a < 2; ++a)
#pragma unroll
            for (int b = 0; b < 2; ++b)
#pragma unroll
                for (int m = 0; m < 4; ++m)
#pragma unroll
                    for (int n = 0; n < 2; ++n) acc[a][b][m][n] = (f32x4){0.f, 0.f, 0.f, 0.f};
        cur = nxt; cA = nA; cB = nB; ++ui;
        if constexpr (ALIGN_EPI) { if (wr == 1) PG8_BAR; }
    }
    PG8_WAIT_V(0);
    if constexpr (!ALIGN_EPI) { if (wr == 0) PG8_BAR; }
    PG8_BAR;
    if constexpr (Epi::AFTER_DRAIN) { E.fused(acc, cur, wr, wc, fr, fq, lds, wid, lane); S.done(cur); }
#undef PG8_SA
#undef PG8_SB
#undef PG8_STAGE
#undef PG8_LDA
#undef PG8_LDB
#undef PG8_MMA
#undef PG8_WAIT_V
#undef PG8_WAIT_L
#undef PG8_BAR
#undef PG8_SCHED
}
}
#define GAS __attribute__((address_space(1)))
#define LAS __attribute__((address_space(3)))
typedef unsigned short bf16;
typedef unsigned v4u __attribute__((ext_vector_type(4)));
typedef float f32x4 __attribute__((ext_vector_type(4)));
typedef short bf16x8 __attribute__((ext_vector_type(8)));
typedef GAS unsigned gu32;
typedef GAS unsigned long long gu64;
#define RLX_AGENT __ATOMIC_RELAXED, __HIP_MEMORY_SCOPE_AGENT
#define LDS_WAIT() asm volatile("s_waitcnt lgkmcnt(0)" ::: "memory")
#define VM_WAIT() asm volatile("s_waitcnt vmcnt(0)" ::: "memory")
__device__ __forceinline__ unsigned long long rt() { return __builtin_amdgcn_s_memrealtime(); }
__device__ __forceinline__ unsigned f2bf(float f) { unsigned u = __builtin_bit_cast(unsigned, f); return (u + 0x7fffu + ((u >> 16) & 1u)) >> 16; }
__device__ __forceinline__ unsigned pk2(float lo, float hi) { return f2bf(lo) | (f2bf(hi) << 16); }

#define XB_TMO      128
#define XB_XCNT(j)  (256  + 64 * (j))
#define XB_XSUB(j)  (1280 + 64 * (j))
#define XB_XGEN(j)  (2304 + 64 * (j))
#define XB_TOP      3328
#define XB_TOPGEN   3392
#define XCD_BAR_WORDS 3456
#define XB_SPIN_CAP (1u << 18)

__device__ __forceinline__ unsigned xb_ld(unsigned* p)              { return __hip_atomic_load(p, __ATOMIC_RELAXED, __HIP_MEMORY_SCOPE_AGENT); }
__device__ __forceinline__ unsigned xb_add(unsigned* p, unsigned v) { return __hip_atomic_fetch_add(p, v, __ATOMIC_RELAXED, __HIP_MEMORY_SCOPE_AGENT); }
__device__ __forceinline__ unsigned xb_xcc_id() { return (unsigned)__builtin_amdgcn_s_getreg((3 << 11) | 20) & 0xFu; }
#define XB_SPIN(cond, bar) do { unsigned _sp = 0; while (cond) { __builtin_amdgcn_s_sleep(1); \
    if ((++_sp & 255u) == 0u) { if (xb_ld(&(bar)[XB_TMO])) break; if (_sp > XB_SPIN_CAP) { atomicAdd(&(bar)[XB_TMO], 1u); break; } } } } while (0)

struct XcdBarrier {
    unsigned* bar; unsigned x;
    volatile LAS unsigned* st;
};

__device__ __forceinline__ XcdBarrier xcd_barrier_post(unsigned* bar, volatile LAS unsigned* st) {
    XcdBarrier b; b.bar = bar; b.x = xb_xcc_id(); b.st = st;
    if (threadIdx.x == 0) (void)xb_add(&bar[XB_XCNT(b.x)], 1u);
    return b;
}
__device__ __forceinline__ void xcd_barrier_complete(unsigned* bar, unsigned x, unsigned& nloc, unsigned& nx) {
    const unsigned G = gridDim.x * gridDim.y * gridDim.z;
    unsigned sum, cnt, mine, sp = 0u;
    for (;;) {
        sum = 0u; cnt = 0u; mine = 0u;
#pragma unroll
        for (unsigned j = 0; j < 16; ++j) { const unsigned c = xb_ld(&bar[XB_XCNT(j)]); sum += c; cnt += (c > 0u) ? 1u : 0u; mine = (j == x) ? c : mine; }
        if (sum == G) break;
        __builtin_amdgcn_s_sleep(1);
        if ((++sp & 255u) == 0u) { if (xb_ld(&bar[XB_TMO])) break; if (sp > XB_SPIN_CAP) { atomicAdd(&bar[XB_TMO], 1u); break; } }
    }
    nloc = mine > 0u ? mine : 1u; nx = cnt > 0u ? cnt : 1u;
}

__device__ __forceinline__ void xcd_barrier(const XcdBarrier& b, const int tid_in) {
    asm volatile("s_waitcnt vmcnt(0)" ::: "memory");
    __syncthreads();
    if (tid_in == 0) {
        unsigned* bar = b.bar;
        __builtin_amdgcn_s_waitcnt(0);
        unsigned nloc = b.st[0], nx = b.st[1];
        if (nloc == 0u) { xcd_barrier_complete(bar, b.x, nloc, nx); b.st[0] = nloc; b.st[1] = nx; }
        const unsigned old = xb_add(&bar[XB_XSUB(b.x)], 1u);
        const unsigned gen = old / nloc;
        if (old + 1u == (gen + 1u) * nloc) {
            __builtin_amdgcn_fence(__ATOMIC_RELEASE, "agent");
            asm volatile("s_waitcnt vmcnt(0)" ::: "memory");
            const unsigned og = xb_add(&bar[XB_TOP], 1u);
            const unsigned tg = og / nx;
            if (og + 1u == (tg + 1u) * nx) xb_add(&bar[XB_TOPGEN], 1u);
            else XB_SPIN(xb_ld(&bar[XB_TOPGEN]) == tg, bar);
            __builtin_amdgcn_fence(__ATOMIC_ACQUIRE, "agent");
            xb_add(&bar[XB_XGEN(b.x)], 1u);
            asm volatile("s_waitcnt vmcnt(0)" ::: "memory");
        } else {
            XB_SPIN(xb_ld(&bar[XB_XGEN(b.x)]) == gen, bar);
            __builtin_amdgcn_fence(__ATOMIC_ACQUIRE, "agent");
            asm volatile("s_waitcnt vmcnt(0)" ::: "memory");
        }
    }
    __syncthreads();
}

#ifndef MK_ONE_LAUNCH
#define MK_ONE_LAUNCH 1
#endif
#ifndef PROBE_REP_MASK
#define PROBE_REP_MASK 0
#endif
#define REPS(bit) _Pragma("unroll") for (int rep_ = 0; rep_ < ((PROBE_REP_MASK >> (bit)) & 1) + 1; ++rep_)
constexpr int NWAVES = 8, NTHREADS = NWAVES * 64;
constexpr int BATCH = 8, SEQ = 2048, T = BATCH * SEQ, D = 1024, DEPTH = 2;
constexpr int NPROJ = 4352;
constexpr int N_INPUTS = 29;
constexpr int NADA = 6144;
constexpr float RMS_EPS = 1e-6f;
constexpr float QSCALE = 0.10206207261596575f * 1.4426950408889634f;
enum { I_X = 0, I_C, I_POS, I_WADA, I_BADA, I_N1G, I_WIN, I_QNG, I_WQUP, I_KVNG, I_WKVUP, I_WBA, I_CONVW, I_CONVB, I_WQM, I_WKM, I_WVM, I_BI, I_BF, I_MHG, I_MSKIP,
       I_WBM, I_WOUT, I_N2G, I_PWQ, I_PKEYS, I_PU, I_PV, I_FG };

constexpr size_t MiB = 1u << 20;
constexpr size_t WS_CTL = 0, CTL_ZERO_BYTES = 1 * MiB;
constexpr int CW_BAR = 4096;
constexpr int CW_XC = 8192;
constexpr size_t ADA_OFF = 256 * 1024;
constexpr size_t WS_COS = 1 * MiB, WS_SIN = 2 * MiB;
constexpr size_t WS_W = 3 * MiB, W_LAYER = 18 * MiB;
constexpr size_t WO_WIN = 0, WO_WQ = 8912896, WO_WKV = WO_WQ + 1179648, WO_WA = WO_WKV + 524288, WO_WM = WO_WA + 1048576, WO_WO = WO_WM + 1048576,
                 WO_PWQ = WO_WO + 2097152, WO_WQK = WO_PWQ + 2097152, WO_WV = WO_WQK + 1048576, WO_KEYB = WO_WV + 524288;
static_assert(WO_KEYB + 262144 <= W_LAYER, "weights fit");
constexpr size_t WS_X = 40 * MiB, WS_H = 104 * MiB, WS_QLAT = 136 * MiB, WS_KVLAT = 160 * MiB, WS_UM = 168 * MiB, WS_OPRE = 184 * MiB, WS_GA = 200 * MiB, WS_GM = 232 * MiB,
                 WS_SMALL = 264 * MiB, WS_RQ = 268 * MiB, WS_RKV = WS_RQ + 65536, WS_LOGI = WS_RQ + 262144, WS_LOGF = WS_RQ + 524288, WS_Q = 269 * MiB, WS_K = 293 * MiB,
                 WS_V = 317 * MiB, WS_CONV = 333 * MiB, WS_QKM = 349 * MiB, WS_VM = 381 * MiB, WS_AO = 397 * MiB, WS_OUTM = 413 * MiB, WS_U8 = 429 * MiB, WS_V8 = 445 * MiB, WS_END = 493 * MiB;
constexpr size_t WS_H8 = 493 * MiB, WS_XS = WS_RQ + 131072, WS_USC = WS_RQ + 786432;
constexpr size_t WS_END2 = 509 * MiB;
constexpr size_t WS_IDX = WS_UM, WS_GATE = WS_UM + 8 * MiB, WS_ACT = WS_OPRE;
constexpr size_t WS_SMALLP = WS_OUTM;
constexpr size_t WS_PQ = WS_QLAT, WS_MERGED = WS_QLAT;

constexpr int RING_OFF = 0, RING_BYTES = 131072;
constexpr int LDSCTL_OFF = RING_BYTES, MISC_OFF = LDSCTL_OFF + 320;
constexpr int LDS_BYTES = 147456;

typedef float f32x2v __attribute__((ext_vector_type(2)));
typedef unsigned u32x2 __attribute__((ext_vector_type(2)));

__device__ __forceinline__ float wave_sum(float v) {
#pragma unroll
    for (int o = 1; o < 64; o <<= 1) v += __shfl_xor(v, o);
    return v;
}
__device__ __forceinline__ float bflo(unsigned u) { return __uint_as_float(u << 16); }
__device__ __forceinline__ float bfhi(unsigned u) { return __uint_as_float(u & 0xffff0000u); }
__device__ __forceinline__ float sigm(float x) { return 1.f / (1.f + __expf(-x)); }
__device__ __forceinline__ float dot4(f32x4 a, f32x4 b) { return (a.x * b.x + a.y * b.y) + (a.z * b.z + a.w * b.w); }
__device__ __forceinline__ float gelu_erf(float x) { return 0.5f * x * (1.f + erff(x * 0.70710678118654752f)); }

struct EpiProj {
    static constexpr bool PERM = true, AFTER_DRAIN = false;
    bf16 *qlat, *kvlat, *um, *opre, *ga, *gm; float* small;
    __device__ __forceinline__ void operator()(const f32x4 (&acc)[2][2][4][2], const pg8::Unit& u, int wr, int wc, int fr, int fq) const {
        const int pn = u.pn; bf16* dst; int ld, cb; int mode = 0;
        if (pn < 3) { dst = qlat; ld = 768; cb = pn * 256; }
        else if (pn == 3) { dst = kvlat; ld = 256; cb = 0; }
        else if (pn < 6) { dst = um; ld = 512; cb = (pn - 4) * 256; }
        else if (pn < 8) { dst = opre; ld = 512; cb = (pn - 6) * 256; }
        else if (pn < 12) { dst = ga; ld = 1024; cb = (pn - 8) * 256; mode = 1; }
        else if (pn < 16) { dst = gm; ld = 1024; cb = (pn - 12) * 256; mode = 1; }
        else { dst = nullptr; ld = 0; cb = 0; mode = 2; }
        const int row0 = u.pm * 256 + wr * 64 + fr;
        if (mode == 2) {
            if (wc < 2) {
#pragma unroll
                for (int ai = 0; ai < 2; ++ai)
#pragma unroll
                    for (int m = 0; m < 4; ++m) { float* p = small + (size_t)(row0 + ai * 128 + m * 16) * 64 + wc * 32 + 8 * fq;
                        *(f32x4*)p = acc[ai][0][m][0]; *(f32x4*)(p + 4) = acc[ai][0][m][1]; }
            }
        } else {
#pragma unroll
            for (int ai = 0; ai < 2; ++ai)
#pragma unroll
                for (int m = 0; m < 4; ++m) { bf16* rowp = dst + (size_t)(row0 + ai * 128 + m * 16) * ld + cb + wc * 32 + 8 * fq;
#pragma unroll
                    for (int bj = 0; bj < 2; ++bj) { f32x4 v0 = acc[ai][bj][m][0], v1 = acc[ai][bj][m][1];
                        if (mode == 1) { v0 = (f32x4){sigm(v0[0]), sigm(v0[1]), sigm(v0[2]), sigm(v0[3])}; v1 = (f32x4){sigm(v1[0]), sigm(v1[1]), sigm(v1[2]), sigm(v1[3])}; }
                        v4u w; w.x = pk2(v0[0], v0[1]); w.y = pk2(v0[2], v0[3]); w.z = pk2(v1[0], v1[1]); w.w = pk2(v1[2], v1[3]);
                        *(v4u*)(rowp + bj * 128) = w; } }
        }
    }
};
struct EpiSmallPart {
    static constexpr bool PERM = true, AFTER_DRAIN = false;
    float* part;
    __device__ __forceinline__ void operator()(const f32x4 (&acc)[2][2][4][2], const pg8::Unit& u, int wr, int wc, int fr, int fq) const {
        if (wc >= 2) return;
        const int row0 = u.pm * 256 + wr * 64 + fr;
#pragma unroll
        for (int ai = 0; ai < 2; ++ai)
#pragma unroll
            for (int m = 0; m < 4; ++m) { float* p = part + (size_t)(row0 + ai * 128 + m * 16) * 64 + wc * 32 + 8 * fq;
                *(f32x4*)p = acc[ai][0][m][0]; *(f32x4*)(p + 4) = acc[ai][0][m][1]; }
    }
};
struct EpiQ {
    static constexpr bool PERM = true, AFTER_DRAIN = false;
    bf16* Q; const float* rq; const float* cosT; const float* sinT;
    __device__ __forceinline__ void operator()(const f32x4 (&acc)[2][2][4][2], const pg8::Unit& u, int wr, int wc, int fr, int fq) const {
        const int row0 = u.pm * 256 + wr * 64 + fr;
        int c0b[2], d0b[2];
#pragma unroll
        for (int bj = 0; bj < 2; ++bj) { c0b[bj] = u.pn * 256 + bj * 128 + wc * 32 + 8 * fq; d0b[bj] = c0b[bj] % 96; }
#pragma unroll
        for (int ai = 0; ai < 2; ++ai) {
            float rr[4]; f32x4 csv[4][2], snv[4][2];
#pragma unroll
            for (int m = 0; m < 4; ++m) { const int row = row0 + ai * 128 + m * 16; rr[m] = rq[row];
#pragma unroll
                for (int bj = 0; bj < 2; ++bj) { csv[m][bj] = (f32x4){1.f, 1.f, 1.f, 1.f}; snv[m][bj] = (f32x4){0.f, 0.f, 0.f, 0.f};
                    if (d0b[bj] >= 64) { const int j0 = (d0b[bj] - 64) >> 1; csv[m][bj] = *(const f32x4*)(cosT + (size_t)row * 16 + j0); snv[m][bj] = *(const f32x4*)(sinT + (size_t)row * 16 + j0); } } }
            __builtin_amdgcn_sched_barrier(0);
#pragma unroll
            for (int m = 0; m < 4; ++m) { const int row = row0 + ai * 128 + m * 16; const float r = rr[m];
#pragma unroll
                for (int bj = 0; bj < 2; ++bj) {
                    f32x4 v0 = acc[ai][bj][m][0] * r, v1 = acc[ai][bj][m][1] * r;
                    if (d0b[bj] >= 64) { const f32x4 cs = csv[m][bj], sn = snv[m][bj]; const f32x4 a0 = v0, a1 = v1;
                        v0[0] = a0[0] * cs[0] - a0[1] * sn[0]; v0[1] = a0[1] * cs[0] + a0[0] * sn[0];
                        v0[2] = a0[2] * cs[1] - a0[3] * sn[1]; v0[3] = a0[3] * cs[1] + a0[2] * sn[1];
                        v1[0] = a1[0] * cs[2] - a1[1] * sn[2]; v1[1] = a1[1] * cs[2] + a1[0] * sn[2];
                        v1[2] = a1[2] * cs[3] - a1[3] * sn[3]; v1[3] = a1[3] * cs[3] + a1[2] * sn[3]; }
                    v4u w; w.x = pk2(v0[0], v0[1]); w.y = pk2(v0[2], v0[3]); w.z = pk2(v1[0], v1[1]); w.w = pk2(v1[2], v1[3]);
                    *(v4u*)(Q + (size_t)row * 768 + c0b[bj]) = w; } }
        }
    }
};
struct EpiKV {
    static constexpr bool PERM = true, AFTER_DRAIN = false;
    bf16* K; bf16* V; const float* rkv;
    __device__ __forceinline__ void operator()(const f32x4 (&acc)[2][2][4][2], const pg8::Unit& u, int wr, int wc, int fr, int fq) const {
        const int row0 = u.pm * 256 + wr * 64 + fr;
        float rr[2][4];
#pragma unroll
        for (int ai = 0; ai < 2; ++ai)
#pragma unroll
            for (int m = 0; m < 4; ++m) rr[ai][m] = rkv[row0 + ai * 128 + m * 16];
#pragma unroll
        for (int ai = 0; ai < 2; ++ai)
#pragma unroll
            for (int m = 0; m < 4; ++m) { const int row = row0 + ai * 128 + m * 16; const float r = rr[ai][m];
#pragma unroll
                for (int bj = 0; bj < 2; ++bj) { const int c0 = u.pn * 256 + bj * 128 + wc * 32 + 8 * fq;
                    const f32x4 v0 = acc[ai][bj][m][0] * r, v1 = acc[ai][bj][m][1] * r;
                    bf16* dst = (c0 < 512) ? (K + (size_t)row * 768 + 96 * (c0 >> 6) + (c0 & 63)) : (V + (size_t)row * 512 + (c0 - 512));
                    v4u w; w.x = pk2(v0[0], v0[1]); w.y = pk2(v0[2], v0[3]); w.z = pk2(v1[0], v1[1]); w.w = pk2(v1[2], v1[3]);
                    *(v4u*)dst = w; } }
    }
};
struct EpiMerge {
    static constexpr bool PERM = true, AFTER_DRAIN = false;
    bf16* Mg; const bf16* gate; int first;
    __device__ __forceinline__ void operator()(const f32x4 (&acc)[2][2][4][2], const pg8::Unit& u, int wr, int wc, int fr, int fq) const {
        const int row0 = u.pm * 256 + wr * 64 + fr, cbase = u.pn * 256 + wc * 32 + 8 * fq;
#pragma unroll
        for (int ai = 0; ai < 2; ++ai) {
            v4u gq[4][2], oq[4][2];
#pragma unroll
            for (int m = 0; m < 4; ++m)
#pragma unroll
                for (int bj = 0; bj < 2; ++bj) { const size_t off = (size_t)(row0 + ai * 128 + m * 16) * 1024 + cbase + bj * 128;
                    gq[m][bj] = *(const v4u*)(gate + off); oq[m][bj] = first ? (v4u){0u, 0u, 0u, 0u} : *(const v4u*)(Mg + off); }
            __builtin_amdgcn_sched_barrier(0);
#pragma unroll
            for (int m = 0; m < 4; ++m)
#pragma unroll
                for (int bj = 0; bj < 2; ++bj) { const size_t off = (size_t)(row0 + ai * 128 + m * 16) * 1024 + cbase + bj * 128;
                    const v4u g = gq[m][bj], o = oq[m][bj];
                    f32x4 v0 = acc[ai][bj][m][0], v1 = acc[ai][bj][m][1];
                    v0[0] = v0[0] * bflo(g.x) + bflo(o.x); v0[1] = v0[1] * bfhi(g.x) + bfhi(o.x); v0[2] = v0[2] * bflo(g.y) + bflo(o.y); v0[3] = v0[3] * bfhi(g.y) + bfhi(o.y);
                    v1[0] = v1[0] * bflo(g.z) + bflo(o.z); v1[1] = v1[1] * bfhi(g.z) + bfhi(o.z); v1[2] = v1[2] * bflo(g.w) + bflo(o.w); v1[3] = v1[3] * bfhi(g.w) + bfhi(o.w);
                    v4u w; w.x = pk2(v0[0], v0[1]); w.y = pk2(v0[2], v0[3]); w.z = pk2(v1[0], v1[1]); w.w = pk2(v1[2], v1[3]);
                    *(v4u*)(Mg + off) = w; }
        }
    }
};
template <bool XBF> struct EpiResid {
    static constexpr bool PERM = true, AFTER_DRAIN = false;
    const void* xin; bf16* xout; const float* gate;
    __device__ __forceinline__ void operator()(const f32x4 (&acc)[2][2][4][2], const pg8::Unit& u, int wr, int wc, int fr, int fq) const {
        const int row0 = u.pm * 256 + wr * 64 + fr, b = (u.pm * 256) >> 11, cbase = u.pn * 256 + wc * 32 + 8 * fq;
        f32x4 gv[2][2];
#pragma unroll
        for (int bj = 0; bj < 2; ++bj) { const float* gp = gate + (size_t)b * NADA + cbase + bj * 128; gv[bj][0] = *(const f32x4*)gp; gv[bj][1] = *(const f32x4*)(gp + 4); }
#pragma unroll
        for (int ai = 0; ai < 2; ++ai) {
            f32x4 xv[4][2][2];
#pragma unroll
            for (int m = 0; m < 4; ++m)
#pragma unroll
                for (int bj = 0; bj < 2; ++bj) { const size_t off = (size_t)(row0 + ai * 128 + m * 16) * 1024 + cbase + bj * 128;
                    if (XBF) { const v4u w = *(const v4u*)((const bf16*)xin + off); xv[m][bj][0] = (f32x4){bflo(w.x), bfhi(w.x), bflo(w.y), bfhi(w.y)}; xv[m][bj][1] = (f32x4){bflo(w.z), bfhi(w.z), bflo(w.w), bfhi(w.w)}; }
                    else { xv[m][bj][0] = *(const f32x4*)((const float*)xin + off); xv[m][bj][1] = *(const f32x4*)((const float*)xin + off + 4); } }
            __builtin_amdgcn_sched_barrier(0);
#pragma unroll
            for (int m = 0; m < 4; ++m)
#pragma unroll
                for (int bj = 0; bj < 2; ++bj) { const size_t off = (size_t)(row0 + ai * 128 + m * 16) * 1024 + cbase + bj * 128;
                    const f32x4 o0 = xv[m][bj][0] + gv[bj][0] * acc[ai][bj][m][0], o1 = xv[m][bj][1] + gv[bj][1] * acc[ai][bj][m][1];
                    v4u w; w.x = pk2(o0[0], o0[1]); w.y = pk2(o0[2], o0[3]); w.z = pk2(o1[0], o1[1]); w.w = pk2(o1[2], o1[3]);
                    *(v4u*)(xout + off) = w; }
        }
    }
};

template <class Get> __device__ __forceinline__ void prep_tile(const Get& get, bf16* dst, int K, int k0, int n0, LAS float* scr, int lane) {
    float tv[32];
#pragma unroll
    for (int i = 0; i < 32; ++i) tv[i] = get(k0 + 2 * i + (lane >> 5), n0 + (lane & 31));
#pragma unroll
    for (int i = 0; i < 32; ++i) { const int kk = 2 * i + (lane >> 5); scr[kk * 33 + (lane & 31)] = tv[i]; }
    LDS_WAIT(); asm volatile("" ::: "memory");
    const int c = lane & 7;
#pragma unroll
    for (int j = 0; j < 4; ++j) { const int n = (lane >> 3) + 8 * j; const LAS float* s = scr + (8 * c) * 33 + n;
        v4u o; o.x = pk2(s[0 * 33], s[1 * 33]); o.y = pk2(s[2 * 33], s[3 * 33]); o.z = pk2(s[4 * 33], s[5 * 33]); o.w = pk2(s[6 * 33], s[7 * 33]);
        *(GAS v4u*)(dst + (size_t)(n0 + n) * K + k0 + 8 * c) = o; }
    LDS_WAIT(); asm volatile("" ::: "memory");
}
struct GetWin { const float* w; __device__ __forceinline__ float operator()(int k, int n) const {
    int sc; if (n < 1024) sc = n; else if (n < 2048) sc = n + 32; else if (n < 4096) sc = n + 40; else if (n < 4128) sc = n - 3072; else if (n < 4136) sc = n - 2048; else sc = -1;
    return sc < 0 ? 0.f : w[(size_t)k * 4136 + sc]; } };
struct GetWq { const float* w; const float* g; __device__ __forceinline__ float operator()(int k, int n) const {
    const int h = n / 96, dd = n % 96; const int e = dd - 64; const int sd = dd < 64 ? dd : 64 + (e >> 1) + 16 * (e & 1);
    return w[(size_t)k * 768 + h * 96 + sd] * g[k] * QSCALE; } };
struct GetWkv { const float* w; const float* g; __device__ __forceinline__ float operator()(int k, int n) const {
    const int nn = n & 511, h = nn >> 6, c = nn & 63; const int sc = h * 128 + c + ((n >= 512) ? 64 : 0);
    return w[(size_t)k * 1024 + sc] * g[k]; } };
struct GetPlain { const float* w; int N; __device__ __forceinline__ float operator()(int k, int n) const { return w[(size_t)k * N + n]; } };
struct GetWqk { const float* wq; const float* wk; __device__ __forceinline__ float operator()(int k, int n) const {
    const int part = n >> 9, nn = n & 511, h = nn >> 7, e = nn & 127, kh = k >> 7, d = k & 127;
    if (kh != h) return 0.f;
    const size_t off = ((size_t)h * 128 + d) * 128 + e;
    return part ? wk[off] * 0.08838834764831845f : wq[off]; } };
struct GetWv { const float* wv; __device__ __forceinline__ float operator()(int k, int n) const {
    const int h = n >> 7, e = n & 127, kh = k >> 7, d = k & 127;
    return (kh != h) ? 0.f : wv[((size_t)h * 128 + d) * 128 + e]; } };

__device__ const float INV_FREQ[16] = { 1.0f, 0.5623413251903491f, 0.31622776601683794f, 0.1778279410038923f, 0.1f, 0.05623413251903491f, 0.031622776601683794f, 0.01778279410038923f,
    0.01f, 0.005623413251903491f, 0.0031622776601683794f, 0.001778279410038923f, 0.001f, 0.0005623413251903491f, 0.00031622776601683794f, 0.0001778279410038923f };

template <bool XBF> __device__ __forceinline__ void rowpass_norm_mod(const void* xin_, const float* g, const float* ada_shift, const float* ada_scale, bf16* hout, int gw, int NGW, int lane, unsigned char* h8 = nullptr, float* xs = nullptr) {
#define RP_LOAD(dst, row) { if (XBF) { const u32x2* p_ = (const u32x2*)((const bf16*)xin_ + (size_t)(row) * D) + lane; _Pragma("unroll") for (int j = 0; j < 4; ++j) { const u32x2 w_ = p_[64 * j]; dst[j] = (f32x4){bflo(w_.x), bfhi(w_.x), bflo(w_.y), bfhi(w_.y)}; } } \
                          else { const f32x4* p_ = (const f32x4*)((const float*)xin_ + (size_t)(row) * D) + lane; _Pragma("unroll") for (int j = 0; j < 4; ++j) dst[j] = p_[64 * j]; } }
    f32x4 vn[4];
    if (gw < T) RP_LOAD(vn, gw);
    for (int t = gw; t < T; t += NGW) {
        const int b = t >> 11;
        f32x4 v[4]; float s = 0.f;
#pragma unroll
        for (int j = 0; j < 4; ++j) { v[j] = vn[j]; s += dot4(v[j], v[j]); }
        { const int tn = (t + NGW < T) ? t + NGW : t;
          RP_LOAD(vn, tn); }
        const float r = rsqrtf(wave_sum(s) * (1.f / D) + RMS_EPS);
        unsigned long long* o8 = (unsigned long long*)(hout + (size_t)t * D) + lane;
        f32x4 ov[4]; float am = 0.f;
#pragma unroll
        for (int j = 0; j < 4; ++j) { const int col = 4 * lane + 256 * j;
            const f32x4 gg = *(const f32x4*)(g + col), sc = *(const f32x4*)(ada_scale + (size_t)b * NADA + col), sh = *(const f32x4*)(ada_shift + (size_t)b * NADA + col);
            const f32x4 o = v[j] * r * gg * (sc + 1.f) + sh; ov[j] = o;
            am = fmaxf(fmaxf(am, fmaxf(fabsf(o.x), fabsf(o.y))), fmaxf(fabsf(o.z), fabsf(o.w)));
            o8[64 * j] = (unsigned long long)pk2(o.x, o.y) | ((unsigned long long)pk2(o.z, o.w) << 32); }
        if (h8) {
#pragma unroll
            for (int o = 1; o < 64; o <<= 1) am = fmaxf(am, __shfl_xor(am, o));
            const float inv = am > 0.f ? 127.f / am : 0.f;
#pragma unroll
            for (int j = 0; j < 4; ++j) { const int q0 = (int)rintf(ov[j].x * inv), q1 = (int)rintf(ov[j].y * inv), q2 = (int)rintf(ov[j].z * inv), q3 = (int)rintf(ov[j].w * inv);
                ((unsigned*)(h8 + (size_t)t * D))[lane + 64 * j] = (unsigned)(q0 & 255) | ((unsigned)(q1 & 255) << 8) | ((unsigned)(q2 & 255) << 16) | ((unsigned)(q3 & 255) << 24); }
            if (lane == 0) xs[t] = am * (1.f / 127.f);
        }
    }
}
__device__ __forceinline__ void rowpass_final(const bf16* xin_, const float* g, float* out, int gw, int NGW, int lane) {
    constexpr bool XBF = true;
    f32x4 vn[4];
    if (gw < T) RP_LOAD(vn, gw);
    for (int t = gw; t < T; t += NGW) {
        f32x4 v[4]; float s = 0.f;
#pragma unroll
        for (int j = 0; j < 4; ++j) { v[j] = vn[j]; s += dot4(v[j], v[j]); }
        { const int tn = (t + NGW < T) ? t + NGW : t;
          RP_LOAD(vn, tn); }
        const float r = rsqrtf(wave_sum(s) * (1.f / D) + RMS_EPS);
        f32x4* o = (f32x4*)(out + (size_t)t * D) + lane;
#pragma unroll
        for (int j = 0; j < 4; ++j) { const f32x4 gg = *(const f32x4*)(g + 4 * lane + 256 * j); o[64 * j] = v[j] * r * gg; }
    }
}
#undef RP_LOAD
__device__ __forceinline__ void rowpass_mid(const bf16* qlat, const bf16* kvlat, const float* small, const float* smallp, const float* cosT, const float* sinT, const bf16* um,
                                            const float* conv_w, const float* conv_b, const float* b_i, const float* b_f,
                                            float* RQ, float* RKV, bf16* K, float* LOGI, float* LOGF, bf16* CONV, int gw, int NGW, int lane) {
    const int c0 = 8 * lane;
    f32x4 cw[4][2], cb[2];
#pragma unroll
    for (int j = 0; j < 4; ++j) { cw[j][0] = *(const f32x4*)(conv_w + j * 512 + c0); cw[j][1] = *(const f32x4*)(conv_w + j * 512 + c0 + 4); }
    cb[0] = *(const f32x4*)(conv_b + c0); cb[1] = *(const f32x4*)(conv_b + c0 + 4);
    const float bsel = (lane >= 32 && lane < 36) ? b_i[lane - 32] : (lane >= 36 && lane < 40) ? b_f[lane - 36] : 0.f;
    for (int tb = gw * 4; tb < T; tb += NGW * 4) {
        const int pos0 = tb & (SEQ - 1);
        u32x2 qv[4][3], kvv[4]; v4u uw[7]; float sv[4], cs[4], sn[4];
#pragma unroll
        for (int i = 0; i < 4; ++i) { const int t = tb + i; const u32x2* p = (const u32x2*)(qlat + (size_t)t * 768);
#pragma unroll
            for (int j = 0; j < 3; ++j) qv[i][j] = p[lane + 64 * j];
            kvv[i] = ((const u32x2*)(kvlat + (size_t)t * 256))[lane];
            sv[i] = 0.f;
            if (lane < 40) sv[i] = smallp ? ((smallp[(size_t)t * 64 + lane] + smallp[(size_t)(T + t) * 64 + lane]) + (smallp[(size_t)(2 * T + t) * 64 + lane] + smallp[(size_t)(3 * T + t) * 64 + lane]))
                                         : small[(size_t)t * 64 + lane];
            cs[i] = 0.f; sn[i] = 0.f; if (lane < 16) { cs[i] = cosT[(size_t)t * 16 + lane]; sn[i] = sinT[(size_t)t * 16 + lane]; } }
#pragma unroll
        for (int j = 0; j < 7; ++j) { uw[j] = (v4u){0u, 0u, 0u, 0u}; if (pos0 - 3 + j >= 0) uw[j] = *(const v4u*)(um + (size_t)(tb - 3 + j) * 512 + c0); }
#pragma unroll
        for (int i = 0; i < 4; ++i) { const int t = tb + i;
            float s = 0.f;
#pragma unroll
            for (int j = 0; j < 3; ++j) { const u32x2 w = qv[i][j]; const float a = bflo(w.x), b2 = bfhi(w.x), c = bflo(w.y), d = bfhi(w.y); s += (a * a + b2 * b2) + (c * c + d * d); }
            const float rq = rsqrtf(wave_sum(s) * (1.f / 768.f) + RMS_EPS);
            const u32x2 w = kvv[i]; const float a = bflo(w.x), b2 = bfhi(w.x), c = bflo(w.y), d = bfhi(w.y);
            const float rkv = rsqrtf(wave_sum((a * a + b2 * b2) + (c * c + d * d)) * (1.f / 256.f) + RMS_EPS);
            if (lane == 0) { RQ[t] = rq; RKV[t] = rkv; }
            const float x2 = __shfl(sv[i], (lane + 16) & 63);
            if (lane < 16) { const float x1 = sv[i]; const unsigned pk = pk2(x1 * cs[i] - x2 * sn[i], x2 * cs[i] + x1 * sn[i]);
#pragma unroll
                for (int h = 0; h < 8; ++h) ((unsigned*)(K + (size_t)t * 768 + 96 * h + 64))[lane] = pk; }
            else if (lane >= 32 && lane < 36) LOGI[(size_t)t * 4 + (lane - 32)] = sv[i] + bsel;
            else if (lane >= 36 && lane < 40) { const float x = sv[i] + bsel; LOGF[(size_t)t * 4 + (lane - 36)] = fminf(x, 0.f) - log1pf(expf(-fabsf(x))); }
            float acc[8];
            acc[0] = cb[0][0]; acc[1] = cb[0][1]; acc[2] = cb[0][2]; acc[3] = cb[0][3]; acc[4] = cb[1][0]; acc[5] = cb[1][1]; acc[6] = cb[1][2]; acc[7] = cb[1][3];
#pragma unroll
            for (int j = 0; j < 4; ++j) { const v4u u4 = uw[i + j];
                acc[0] += cw[j][0][0] * bflo(u4.x); acc[1] += cw[j][0][1] * bfhi(u4.x); acc[2] += cw[j][0][2] * bflo(u4.y); acc[3] += cw[j][0][3] * bfhi(u4.y);
                acc[4] += cw[j][1][0] * bflo(u4.z); acc[5] += cw[j][1][1] * bfhi(u4.z); acc[6] += cw[j][1][2] * bflo(u4.w); acc[7] += cw[j][1][3] * bfhi(u4.w); }
#pragma unroll
            for (int q = 0; q < 8; ++q) acc[q] = acc[q] * sigm(acc[q]);
            v4u o; o.x = pk2(acc[0], acc[1]); o.y = pk2(acc[2], acc[3]); o.z = pk2(acc[4], acc[5]); o.w = pk2(acc[6], acc[7]);
            *(v4u*)(CONV + (size_t)t * 512 + c0) = o; }
    }
}

typedef float f32x16 __attribute__((ext_vector_type(16)));
typedef short s16x4 __attribute__((ext_vector_type(4)));
typedef short v4i16_t __attribute__((ext_vector_type(4)));
typedef float f32x2_t __attribute__((ext_vector_type(2))); typedef __bf16 bf16x2_t __attribute__((ext_vector_type(2)));
__device__ __forceinline__ unsigned cvtpk(float lo, float hi) { f32x2_t v = {lo, hi}; bf16x2_t b = __builtin_convertvector(v, bf16x2_t); return __builtin_bit_cast(unsigned, b); }
__device__ __forceinline__ s16x4 vtr(const LAS unsigned char* p) { return __builtin_bit_cast(s16x4, __builtin_amdgcn_ds_read_tr16_b64_v4i16((LAS v4i16_t*)p)); }
__device__ __forceinline__ bf16x8 pack8(float a0, float a1, float a2, float a3, float a4, float a5, float a6, float a7) {
    v4u p; p.x = cvtpk(a0, a1); p.y = cvtpk(a2, a3); p.z = cvtpk(a4, a5); p.w = cvtpk(a6, a7); return __builtin_bit_cast(bf16x8, p); }
#define MFMA32(a, b, c) __builtin_amdgcn_mfma_f32_32x32x16_bf16((a), (b), (c), 0, 0, 0)
constexpr int AT_KB = 12288, AT_VB = 8192;
__device__ __forceinline__ void attn_mfma(const bf16* Q, const bf16* K, const bf16* V, bf16* AO, LAS unsigned char* lds, int bx, int G, int tid) {
    const int lane = tid & 63, wave = __builtin_amdgcn_readfirstlane(tid >> 6), r = lane & 31, hh = lane >> 5;
    const int i16 = lane & 15, q4 = i16 >> 2, p4 = i16 & 3, blk = (lane >> 4) & 1;
    const int vboff = (4 * hh + q4) * 64 + 32 * blk + 8 * p4;
    const int kr0 = tid / 12, kc0 = tid % 12, kr1 = (tid + 512) / 12, kc1 = (tid + 512) % 12, vr = tid >> 3, vc = tid & 7;
    const int klds0 = (kc0 >> 1) * 2048 + (kc0 & 1) * 1024 + kr0 * 16, klds1 = (kc1 >> 1) * 2048 + (kc1 & 1) * 1024 + kr1 * 16;
    const int vlds = (vc >> 2) * 4096 + (vr >> 4) * 1024 + ((vr >> 3) & 1) * 512 + (vr & 7) * 64 + (vc & 3) * 16;
    for (int pu = bx; pu < 256; pu += G) {
        const int bh = pu >> 2, b = bh >> 3, h = bh & 7;
        const bf16* kg = K + ((size_t)b * SEQ) * 768 + h * 96; const bf16* vg = V + ((size_t)b * SEQ) * 512 + h * 64;
        for (int half = 0; half < 2; ++half) {
            const int qb = half == 0 ? 7 - (pu & 3) : (pu & 3);
            const int q0w = qb * 256 + wave * 32, nkt = 4 * (qb + 1), kmax = (q0w + 31) >> 6;
            bf16x8 qf[6];
            { const bf16* qrow = Q + ((size_t)b * SEQ + q0w + r) * 768 + h * 96 + 8 * hh;
#pragma unroll
              for (int s = 0; s < 6; ++s) qf[s] = *(const bf16x8*)(qrow + 16 * s); }
            f32x16 o0, o1;
#pragma unroll
            for (int i = 0; i < 16; ++i) { o0[i] = 0.f; o1[i] = 0.f; }
            float m = 0.f, l = 0.f; f32x16 negm;
#pragma unroll
            for (int i = 0; i < 16; ++i) negm[i] = 0.f;
            v4u ka = *(const v4u*)(kg + (size_t)kr0 * 768 + kc0 * 8), kb2 = (v4u){0u, 0u, 0u, 0u}, va = *(const v4u*)(vg + (size_t)vr * 512 + vc * 8);
            if (tid < 256) kb2 = *(const v4u*)(kg + (size_t)kr1 * 768 + kc1 * 8);
            __syncthreads();
            *(LAS v4u*)(lds + klds0) = ka; if (tid < 256) *(LAS v4u*)(lds + klds1) = kb2; *(LAS v4u*)(lds + 2 * AT_KB + vlds) = va;
            __syncthreads();
            for (int kt = 0; kt < nkt; ++kt) {
                const int buf = kt & 1;
                if (kt + 1 < nkt) { const size_t k1 = (size_t)(kt + 1) * 64;
                    ka = *(const v4u*)(kg + (k1 + kr0) * 768 + kc0 * 8); if (tid < 256) kb2 = *(const v4u*)(kg + (k1 + kr1) * 768 + kc1 * 8); va = *(const v4u*)(vg + (k1 + vr) * 512 + vc * 8); }
                if (kt <= kmax) {
                    const LAS unsigned char* kb_ = lds + buf * AT_KB + hh * 1024 + r * 16; const LAS unsigned char* vb_ = lds + 2 * AT_KB + buf * AT_VB + vboff;
                    f32x16 s0, s1;
                    { bf16x8 kf0[6], kf1[6];
#pragma unroll
                      for (int s = 0; s < 6; ++s) { kf0[s] = *(const LAS bf16x8*)(kb_ + s * 2048); kf1[s] = *(const LAS bf16x8*)(kb_ + s * 2048 + 512); }
                      __builtin_amdgcn_sched_barrier(0);
                      s0 = MFMA32(kf0[0], qf[0], negm); s1 = MFMA32(kf1[0], qf[0], negm);
#pragma unroll
                      for (int s = 1; s < 6; ++s) { s0 = MFMA32(kf0[s], qf[s], s0); s1 = MFMA32(kf1[s], qf[s], s1); } }
                    if (kt * 64 + 63 > q0w) { const int qq = q0w + r - kt * 64;
#pragma unroll
                        for (int i = 0; i < 16; ++i) { const int key = (i & 3) + 8 * (i >> 2) + 4 * hh; if (key > qq) s0[i] = -INFINITY; if (key + 32 > qq) s1[i] = -INFINITY; } }
                    float mx = fmaxf(fmaxf(s0[0], s1[0]), fmaxf(s0[1], s1[1]));
#pragma unroll
                    for (int i = 2; i < 16; i += 2) mx = fmaxf(fmaxf(mx, fmaxf(s0[i], s1[i])), fmaxf(s0[i + 1], s1[i + 1]));
                    { auto r32 = __builtin_amdgcn_permlane32_swap(__float_as_uint(mx), __float_as_uint(mx), false, false); mx = fmaxf(__uint_as_float(r32[0]), __uint_as_float(r32[1])); }
                    if (kt == 0 || __builtin_amdgcn_ballot_w64(mx > 8.f) != 0ull) {
                        const float d = (kt == 0) ? mx : fmaxf(mx, 0.f), corr = (kt == 0) ? 0.f : __builtin_amdgcn_exp2f(-d);
                        m = (kt == 0) ? mx : m + d; l *= corr;
#pragma unroll
                        for (int i = 0; i < 16; ++i) { o0[i] *= corr; o1[i] *= corr; s0[i] -= d; s1[i] -= d; negm[i] = -m; } }
                    float ps = 0.f;
#pragma unroll
                    for (int i = 0; i < 16; ++i) { s0[i] = __builtin_amdgcn_exp2f(s0[i]); s1[i] = __builtin_amdgcn_exp2f(s1[i]); ps += s0[i] + s1[i]; }
                    l += ps;
                    bf16x8 pf[4];
                    pf[0] = pack8(s0[0], s0[1], s0[2], s0[3], s0[4], s0[5], s0[6], s0[7]); pf[1] = pack8(s0[8], s0[9], s0[10], s0[11], s0[12], s0[13], s0[14], s0[15]);
                    pf[2] = pack8(s1[0], s1[1], s1[2], s1[3], s1[4], s1[5], s1[6], s1[7]); pf[3] = pack8(s1[8], s1[9], s1[10], s1[11], s1[12], s1[13], s1[14], s1[15]);
                    { s16x4 vlo[8], vhi[8];
#pragma unroll
                      for (int ks = 0; ks < 4; ++ks) { vlo[ks] = vtr(vb_ + ks * 1024); vhi[ks] = vtr(vb_ + ks * 1024 + 512); vlo[4 + ks] = vtr(vb_ + 4096 + ks * 1024); vhi[4 + ks] = vtr(vb_ + 4096 + ks * 1024 + 512); }
                      __builtin_amdgcn_sched_barrier(0);
#pragma unroll
                      for (int ks = 0; ks < 4; ++ks) {
                          const bf16x8 a0 = (bf16x8){vlo[ks][0], vlo[ks][1], vlo[ks][2], vlo[ks][3], vhi[ks][0], vhi[ks][1], vhi[ks][2], vhi[ks][3]};
                          const bf16x8 a1 = (bf16x8){vlo[4 + ks][0], vlo[4 + ks][1], vlo[4 + ks][2], vlo[4 + ks][3], vhi[4 + ks][0], vhi[4 + ks][1], vhi[4 + ks][2], vhi[4 + ks][3]};
                          o0 = MFMA32(a0, pf[ks], o0); o1 = MFMA32(a1, pf[ks], o1); } }
                }
                if (kt + 1 < nkt) { LAS unsigned char* nb = lds + (buf ^ 1) * AT_KB; *(LAS v4u*)(nb + klds0) = ka; if (tid < 256) *(LAS v4u*)(nb + klds1) = kb2; *(LAS v4u*)(lds + 2 * AT_KB + (buf ^ 1) * AT_VB + vlds) = va; }
                __syncthreads();
            }
            const float inv = 1.f / (l + __shfl_xor(l, 32));
            bf16* orow = AO + ((size_t)b * SEQ + q0w + r) * 512 + h * 64 + 4 * hh;
#pragma unroll
            for (int g = 0; g < 4; ++g) { u32x2 w0, w1; w0.x = cvtpk(o0[4 * g] * inv, o0[4 * g + 1] * inv); w0.y = cvtpk(o0[4 * g + 2] * inv, o0[4 * g + 3] * inv);
                w1.x = cvtpk(o1[4 * g] * inv, o1[4 * g + 1] * inv); w1.y = cvtpk(o1[4 * g + 2] * inv, o1[4 * g + 3] * inv);
                *(u32x2*)(orow + 8 * g) = w0; *(u32x2*)(orow + 32 + 8 * g) = w1; }
        }
    }
}


constexpr int ML_KB = 16384, ML_VB = 16384, ML_BUF = 32768, ML_TAB = 3 * 32768;
__device__ __forceinline__ void mlstm_mfma(const bf16* QKM, const bf16* VM, const float* LOGI, const float* LOGF, const bf16* CONV, const bf16* OPRE, const float* ng, const float* skip,
                                           bf16* OUTM, LAS unsigned char* lds, int bx, int G, int tid) {
    const int lane = tid & 63, wave = __builtin_amdgcn_readfirstlane(tid >> 6), r = lane & 31, hh = lane >> 5;
    const int i16 = lane & 15, q4 = i16 >> 2, p4 = i16 & 3, blk = (lane >> 4) & 1;
    const int vboff = (4 * hh + q4) * 64 + 32 * blk + 8 * p4;
    int goff[4], loff[4];
#pragma unroll
    for (int q = 0; q < 4; ++q) { const int j = 4 * wave + q;
        if (j < 16) { goff[q] = lane * 1024 + 16 * (j >> 1) + 8 * (j & 1); loff[q] = (j >> 1) * 2048 + (j & 1) * 1024; }
        else { const int jv = j - 16, dq = jv >> 2, ks = jv & 3; goff[q] = (16 * ks + 8 * (lane >> 5) + ((lane >> 2) & 7)) * 512 + 32 * dq + 8 * (lane & 3); loff[q] = ML_KB + dq * 4096 + ks * 1024; } }
    const bool kwave = wave < 4;
#define ML_DMA(tile, bufi) do { _Pragma("unroll") for (int q_ = 0; q_ < 4; ++q_) { \
        const bf16* src_ = kwave ? (kg + (size_t)(tile) * 64 * 1024 + goff[q_]) : (vg + (size_t)(tile) * 64 * 512 + goff[q_]); \
        __builtin_amdgcn_global_load_lds((const unsigned*)src_, (LAS unsigned*)(lds + (bufi) * ML_BUF + loff[q_]), 16, 0, 0); } } while (0)
    LAS float* Ftab = (LAS float*)(lds + ML_TAB); LAS float* Ctab = Ftab + 2048; LAS float* wtot = Ctab + 2048;
    constexpr float L2E = 1.4426950408889634f;
    for (int pu = bx; pu < 256; pu += G) {
        const int bh = pu >> 3, p = pu & 7, b = bh >> 2, h = bh & 3;
        __syncthreads();
        { float f4[4], i4[4];
#pragma unroll
          for (int e = 0; e < 4; ++e) { const size_t row = (size_t)b * SEQ + tid * 4 + e; f4[e] = LOGF[row * 4 + h]; i4[e] = LOGI[row * 4 + h]; }
          f4[1] += f4[0]; f4[2] += f4[1]; f4[3] += f4[2];
          float x = f4[3];
          x += __uint_as_float(__builtin_amdgcn_update_dpp(0, __float_as_uint(x), 0x111, 0xf, 0xf, true)); x += __uint_as_float(__builtin_amdgcn_update_dpp(0, __float_as_uint(x), 0x112, 0xf, 0xf, true));
          x += __uint_as_float(__builtin_amdgcn_update_dpp(0, __float_as_uint(x), 0x114, 0xf, 0xf, true)); x += __uint_as_float(__builtin_amdgcn_update_dpp(0, __float_as_uint(x), 0x118, 0xf, 0xf, true));
          { const float t0 = __uint_as_float(__builtin_amdgcn_readlane(__float_as_uint(x), 15)), t1 = __uint_as_float(__builtin_amdgcn_readlane(__float_as_uint(x), 31)), t2 = __uint_as_float(__builtin_amdgcn_readlane(__float_as_uint(x), 47));
            const int row = lane >> 4; x += (row >= 1 ? t0 : 0.f) + (row >= 2 ? t1 : 0.f) + (row >= 3 ? t2 : 0.f); }
          if (lane == 63) wtot[wave] = x;
          __syncthreads();
          float base = x - f4[3];
          for (int w = 0; w < wave; ++w) base += wtot[w];
#pragma unroll
          for (int e = 0; e < 4; ++e) { const float F = base + f4[e]; Ftab[tid * 4 + e] = F * L2E; Ctab[tid * 4 + e] = (i4[e] - F) * L2E; } }
        __syncthreads();
        const int grp = wave >> 2, w4 = wave & 3;
        const int q0w = (grp == 0 ? 128 * p : 128 * (15 - p)) + 32 * w4, kmax = (q0w + 31) >> 6, nkt = 2 * (16 - p);
        const size_t trow = (size_t)b * SEQ + q0w + r;
        bf16x8 qf[8];
        { const bf16* qrow = QKM + trow * 1024 + h * 128 + 8 * hh;
#pragma unroll
          for (int s = 0; s < 8; ++s) qf[s] = *(const bf16x8*)(qrow + 16 * s); }
        const float Ft = Ftab[q0w + r], Ft0 = Ftab[q0w];
        LAS float* wt = Ctab + 2048 + 64 + wave * 64;
        f32x16 o[4];
#pragma unroll
        for (int d = 0; d < 4; ++d)
#pragma unroll
            for (int i = 0; i < 16; ++i) o[d][i] = 0.f;
        float den = 0.f;
        const bf16* kg = QKM + ((size_t)b * SEQ) * 1024 + 512 + h * 128; const bf16* vg = VM + ((size_t)b * SEQ) * 512 + h * 128;
        ML_DMA(0, 0);
        if (nkt > 1) { ML_DMA(1, 1); asm volatile("s_waitcnt vmcnt(4)" ::: "memory"); } else asm volatile("s_waitcnt vmcnt(0)" ::: "memory");
        asm volatile("s_waitcnt lgkmcnt(0)" ::: "memory"); __builtin_amdgcn_s_barrier(); asm volatile("" ::: "memory");
        for (int kt = 0; kt < nkt; ++kt) {
            const int buf = kt % 3;
            if (kt + 2 < nkt) ML_DMA(kt + 2, (kt + 2) % 3);
            if (kt <= kmax) {
                const LAS unsigned char* kb_ = lds + buf * ML_BUF + hh * 1024 + r * 16; const LAS unsigned char* vb_ = lds + buf * ML_BUF + ML_KB + vboff;
                f32x16 s0, s1;
#pragma unroll
                for (int i = 0; i < 16; ++i) { s0[i] = 0.f; s1[i] = 0.f; }
#pragma unroll
                for (int sh = 0; sh < 2; ++sh) { bf16x8 kf0[4], kf1[4];
#pragma unroll
                  for (int s = 0; s < 4; ++s) { kf0[s] = *(const LAS bf16x8*)(kb_ + (4 * sh + s) * 2048); kf1[s] = *(const LAS bf16x8*)(kb_ + (4 * sh + s) * 2048 + 512); }
                  __builtin_amdgcn_sched_barrier(0);
#pragma unroll
                  for (int s = 0; s < 4; ++s) { s0 = MFMA32(kf0[s], qf[4 * sh + s], s0); s1 = MFMA32(kf1[s], qf[4 * sh + s], s1); } }
                const int qq = q0w + r - kt * 64;
                const bool diag = kt * 64 + 63 > q0w;
                wt[lane] = __builtin_amdgcn_exp2f(Ctab[kt * 64 + lane] + Ft0);
                LDS_WAIT();
                const LAS float* ct = wt + 4 * hh;
                float ps = 0.f;
#pragma unroll
                for (int g = 0; g < 4; ++g) { const f32x4 c0v = *(const LAS f32x4*)(ct + 8 * g), c1v = *(const LAS f32x4*)(ct + 32 + 8 * g);
#pragma unroll
                    for (int e = 0; e < 4; ++e) { const int i = 4 * g + e, key = e + 8 * g + 4 * hh;
                        float w0 = c0v[e], w1 = c1v[e];
                        if (diag) { w0 = (key <= qq) ? w0 : 0.f; w1 = (key + 32 <= qq) ? w1 : 0.f; }
                        s0[i] *= w0; s1[i] *= w1; ps += s0[i] + s1[i]; } }
                den += ps;
                bf16x8 pf[4];
                pf[0] = pack8(s0[0], s0[1], s0[2], s0[3], s0[4], s0[5], s0[6], s0[7]); pf[1] = pack8(s0[8], s0[9], s0[10], s0[11], s0[12], s0[13], s0[14], s0[15]);
                pf[2] = pack8(s1[0], s1[1], s1[2], s1[3], s1[4], s1[5], s1[6], s1[7]); pf[3] = pack8(s1[8], s1[9], s1[10], s1[11], s1[12], s1[13], s1[14], s1[15]);
#pragma unroll
                for (int ks = 0; ks < 4; ++ks) { s16x4 vlo[4], vhi[4];
#pragma unroll
                    for (int d = 0; d < 4; ++d) { vlo[d] = vtr(vb_ + d * 4096 + ks * 1024); vhi[d] = vtr(vb_ + d * 4096 + ks * 1024 + 512); }
                    __builtin_amdgcn_sched_barrier(0);
#pragma unroll
                    for (int d = 0; d < 4; ++d) { const s16x4 lo = vlo[d], hi = vhi[d];
                        const bf16x8 av = (bf16x8){lo[0], lo[1], lo[2], lo[3], hi[0], hi[1], hi[2], hi[3]};
                        o[d] = MFMA32(av, pf[ks], o[d]); } }
            }
            if (kt + 2 < nkt) asm volatile("s_waitcnt vmcnt(4)" ::: "memory"); else asm volatile("s_waitcnt vmcnt(0)" ::: "memory");
            asm volatile("s_waitcnt lgkmcnt(0)" ::: "memory"); __builtin_amdgcn_s_barrier(); asm volatile("" ::: "memory");
        }
        const float kap = __builtin_amdgcn_exp2f(Ft - Ft0);
        const float dt = (den + __shfl_xor(den, 32)) * kap;
        const float inv = kap / fmaxf(fabsf(dt), 1.f);
        float sm = 0.f;
#pragma unroll
        for (int d = 0; d < 4; ++d)
#pragma unroll
            for (int i = 0; i < 16; ++i) { o[d][i] *= inv; sm += o[d][i]; }
        sm += __shfl_xor(sm, 32);
        const float mu = sm * (1.f / 128.f);
        float vs = 0.f;
#pragma unroll
        for (int d = 0; d < 4; ++d)
#pragma unroll
            for (int i = 0; i < 16; ++i) { const float dlt = o[d][i] - mu; vs += dlt * dlt; }
        vs += __shfl_xor(vs, 32);
        const float rstd = rsqrtf(vs * (1.f / 128.f) + RMS_EPS);
#pragma unroll
        for (int d = 0; d < 4; ++d)
#pragma unroll
            for (int g = 0; g < 4; ++g) { const int ch = h * 128 + 32 * d + 8 * g + 4 * hh; const size_t off = trow * 512 + ch;
                const u32x2 cv = *(const u32x2*)(CONV + off), ov = *(const u32x2*)(OPRE + off); const f32x4 gg = *(const f32x4*)(ng + ch), sk = *(const f32x4*)(skip + ch);
                const float y0 = sigm(bflo(ov.x)) * ((o[d][4 * g] - mu) * rstd * gg[0] + sk[0] * bflo(cv.x)), y1 = sigm(bfhi(ov.x)) * ((o[d][4 * g + 1] - mu) * rstd * gg[1] + sk[1] * bfhi(cv.x));
                const float y2 = sigm(bflo(ov.y)) * ((o[d][4 * g + 2] - mu) * rstd * gg[2] + sk[2] * bflo(cv.y)), y3 = sigm(bfhi(ov.y)) * ((o[d][4 * g + 3] - mu) * rstd * gg[3] + sk[3] * bfhi(cv.y));
                u32x2 w; w.x = cvtpk(y0, y1); w.y = cvtpk(y2, y3); *(u32x2*)(OUTM + off) = w; }
    }
#undef ML_DMA
}

template <int N> __device__ __forceinline__ void bitonic_sort_desc(float (&v)[N]) {
#pragma unroll
    for (int k = 2; k <= N; k <<= 1)
#pragma unroll
        for (int j = k >> 1; j > 0; j >>= 1)
#pragma unroll
            for (int i = 0; i < N; ++i) { const int l = i ^ j; if (l > i) { const bool desc = ((i & k) == 0); const float a = v[i], b = v[l], hi = fmaxf(a, b), lo = fminf(a, b); v[i] = desc ? hi : lo; v[l] = desc ? lo : hi; } }
}
__device__ __forceinline__ void top16_merge(float (&a)[16], const float (&b)[16]) {
#pragma unroll
    for (int i = 0; i < 16; ++i) a[i] = fmaxf(a[i], b[15 - i]);
#pragma unroll
    for (int j = 8; j > 0; j >>= 1)
#pragma unroll
        for (int i = 0; i < 16; ++i) { const int l = i ^ j; if (l > i) { const float x = a[i], y = a[l]; a[i] = fmaxf(x, y); a[l] = fminf(x, y); } }
}
constexpr int PE_EIDX = 0, PE_EGATE = 16384, PE_KEYT = 32768;
__device__ __forceinline__ void peer_route(const bf16* PQ, const bf16* KEYB, int* IDX, float* GATE, LAS unsigned char* lds, int bx, int G, int tid) {
    const int lane = tid & 63, wave = __builtin_amdgcn_readfirstlane(tid >> 6), r = lane & 31, hh = lane >> 5;
    LAS unsigned char* keyt = lds + PE_KEYT + (wave * 32 + r) * 32;
    for (int grp = bx; grp < T / 32; grp += G) {
        const int t0 = grp * 32;
        { const int h = wave;
          int rq = r; asm volatile("" : "+v"(rq));
          float top[2][16];
#pragma unroll
          for (int p = 0; p < 2; ++p) {
              bf16x8 qf[4];
              { const bf16* qrow = PQ + (size_t)(t0 + rq) * 1024 + h * 128 + p * 64 + 8 * hh;
#pragma unroll
                for (int s = 0; s < 4; ++s) qf[s] = *(const bf16x8*)(qrow + 16 * s); }
              const bf16* kb = KEYB + ((size_t)(h * 2 + p) * 128 + rq) * 64 + 8 * hh;
              float sv[4][16];
#pragma unroll
              for (int kt = 0; kt < 4; ++kt) { f32x16 acc;
#pragma unroll
                  for (int i = 0; i < 16; ++i) acc[i] = 0.f;
#pragma unroll
                  for (int s = 0; s < 4; ++s) { const bf16x8 a = *(const bf16x8*)(kb + (size_t)(32 * kt) * 64 + 16 * s); acc = MFMA32(a, qf[s], acc); }
#pragma unroll
                  for (int i = 0; i < 16; ++i) { const unsigned key = (unsigned)(32 * kt + (i & 3) + 8 * (i >> 2)) + 4u * (unsigned)hh; sv[kt][i] = __uint_as_float((__float_as_uint(acc[i]) & ~127u) | key); } }
              bitonic_sort_desc<16>(sv[0]); bitonic_sort_desc<16>(sv[1]); bitonic_sort_desc<16>(sv[2]); bitonic_sort_desc<16>(sv[3]);
              top16_merge(sv[0], sv[1]); top16_merge(sv[2], sv[3]); top16_merge(sv[0], sv[2]);
              float pr[16];
#pragma unroll
              for (int i = 0; i < 16; ++i) { auto r32 = __builtin_amdgcn_permlane32_swap(__float_as_uint(sv[0][i]), __float_as_uint(sv[0][i]), false, false); pr[i] = __uint_as_float(hh ? r32[0] : r32[1]); }
              top16_merge(sv[0], pr);
#pragma unroll
              for (int i = 0; i < 16; ++i) top[p][i] = sv[0][i];
          }
          if (hh == 0) {
#pragma unroll
              for (int i = 0; i < 16; ++i) { keyt[i] = (unsigned char)(__float_as_uint(top[0][i]) & 127u); keyt[16 + i] = (unsigned char)(__float_as_uint(top[1][i]) & 127u); } }
          float cs[4][16];
#define PSUM(a, b) __uint_as_float((__float_as_uint(top[0][a] + top[1][b]) & ~255u) | (unsigned)((a) * 16 + (b)))
#pragma unroll
          for (int b2 = 0; b2 < 16; ++b2) cs[0][b2] = PSUM(0, b2);
#pragma unroll
          for (int b2 = 0; b2 < 8; ++b2) cs[1][b2] = PSUM(1, b2);
#pragma unroll
          for (int a2 = 8; a2 < 16; ++a2) cs[1][a2] = PSUM(a2, 0);
#pragma unroll
          for (int b2 = 0; b2 < 5; ++b2) cs[2][b2] = PSUM(2, b2);
#pragma unroll
          for (int b2 = 0; b2 < 4; ++b2) cs[2][5 + b2] = PSUM(3, b2);
#pragma unroll
          for (int b2 = 0; b2 < 3; ++b2) cs[2][9 + b2] = PSUM(4, b2);
          cs[2][12] = PSUM(5, 0); cs[2][13] = PSUM(5, 1); cs[2][14] = PSUM(6, 0); cs[2][15] = PSUM(6, 1);
          cs[3][0] = PSUM(7, 0); cs[3][1] = PSUM(7, 1);
#undef PSUM
#pragma unroll
          for (int i = 2; i < 16; ++i) cs[3][i] = -3.0e38f;
          bitonic_sort_desc<16>(cs[0]); bitonic_sort_desc<16>(cs[1]); bitonic_sort_desc<16>(cs[2]); bitonic_sort_desc<16>(cs[3]);
          top16_merge(cs[0], cs[1]); top16_merge(cs[2], cs[3]); top16_merge(cs[0], cs[2]);
          LDS_WAIT();
          float ev[16], den = 0.f; const float mx = __uint_as_float(__float_as_uint(cs[0][0]) & ~255u);
#pragma unroll
          for (int k = 0; k < 16; ++k) { ev[k] = __expf(__uint_as_float(__float_as_uint(cs[0][k]) & ~255u) - mx); den += ev[k]; }
          const float rden = 1.f / den;
          if (hh == 0) {
#pragma unroll
              for (int k = 0; k < 16; ++k) { const unsigned code = __float_as_uint(cs[0][k]) & 255u; const int e = (int)keyt[code >> 4] * 128 + (int)keyt[16 + (code & 15u)];
                  IDX[(size_t)(t0 + r) * 128 + h * 16 + k] = e; GATE[(size_t)(t0 + r) * 128 + h * 16 + k] = ev[k] * rden; } }
        }
    }
}
__device__ __forceinline__ void peer_partition(const unsigned* xc_cnt, volatile LAS unsigned* MISC, int bx, int G, int& vx, int& rank, int& nb) {
    bool use_xcc = MK_ONE_LAUNCH != 0; unsigned mine = 0u; const unsigned myx = MISC[13];
    if (use_xcc) { unsigned sum = 0u;
#pragma unroll
        for (unsigned j = 0; j < 8; ++j) { const unsigned c = __hip_atomic_load(xc_cnt + 64 * j, __ATOMIC_RELAXED, __HIP_MEMORY_SCOPE_AGENT); use_xcc = use_xcc && (c > 0u); sum += c; mine = (j == myx) ? c : mine; }
        use_xcc = use_xcc && (sum == (unsigned)G); }
    if (use_xcc) { vx = (int)myx; rank = (int)MISC[12]; nb = (int)mine; } else { vx = bx & 7; rank = bx >> 3; nb = (G - vx + 7) >> 3; }
    vx = __builtin_amdgcn_readfirstlane(vx); rank = __builtin_amdgcn_readfirstlane(rank); nb = __builtin_amdgcn_readfirstlane(nb);
}
__device__ __forceinline__ void peer_u_i8(const unsigned char* H8, const float* XS, const int* IDX, const unsigned char* U8, const f32x2v* SC2, float* ACT, LAS float* wscr, int vx, int rank, int nb, int tid) {
    const int lane = tid & 63, wave = __builtin_amdgcn_readfirstlane(tid >> 6), g4 = lane >> 4, c16 = lane & 15;
    const int tstride = nb * 8;
    LAS int* clist = (LAS int*)wscr;
    LAS unsigned char* xs = (LAS unsigned char*)(wscr + 512);
    const unsigned long long lt = (1ull << lane) - 1ull;
    const unsigned char* ubase = U8 + 16 * c16;
    int ni[8];
    { const int tb = rank * 8 + wave;
#pragma unroll
      for (int j = 0; j < 4; ++j) { const int tj = tb + j * tstride; const bool ok = tj < T; ni[2 * j] = ok ? IDX[(size_t)tj * 128 + lane] : 0x7fffffff; ni[2 * j + 1] = ok ? IDX[(size_t)tj * 128 + 64 + lane] : 0x7fffffff; } }
    for (int tb = rank * 8 + wave; tb < T; tb += 4 * tstride) {
        int ntot = 0;
#pragma unroll
        for (int j = 0; j < 4; ++j) { const int e0 = ni[2 * j], e1 = ni[2 * j + 1]; const bool f0 = (e0 >> 11) == vx, f1 = (e1 >> 11) == vx;
            const unsigned long long m0 = __ballot(f0), m1 = __ballot(f1); const int n0 = __popcll(m0);
            if (f0) clist[ntot + __popcll(m0 & lt)] = (j << 21) | (e0 << 7) | lane;
            if (f1) clist[ntot + n0 + __popcll(m1 & lt)] = (j << 21) | (e1 << 7) | (64 + lane);
            ntot += n0 + __popcll(m1); }
        v4u xr[4]; float sx[4];
#pragma unroll
        for (int j = 0; j < 4; ++j) { const int tj = tb + j * tstride, tl = tj < T ? tj : tb; xr[j] = *(const v4u*)(H8 + (size_t)tl * 1024 + 16 * lane); sx[j] = XS[tl]; }
        { const int tn = tb + 4 * tstride;
#pragma unroll
          for (int j = 0; j < 4; ++j) { const int tj = tn + j * tstride; const bool ok = tj < T; ni[2 * j] = ok ? IDX[(size_t)tj * 128 + lane] : 0x7fffffff; ni[2 * j + 1] = ok ? IDX[(size_t)tj * 128 + 64 + lane] : 0x7fffffff; } }
        if (ntot == 0) continue;
#pragma unroll
        for (int j = 0; j < 4; ++j) *(LAS v4u*)(xs + j * 1024 + 16 * lane) = xr[j];
        LDS_WAIT();
        const int last = ntot - 1, nit = (ntot + 3) >> 2, nit4 = (nit + 3) >> 2;
        v4u ub[4][4]; f32x2v us[4]; int up[4];
#pragma unroll
        for (int k = 0; k < 3; ++k) { const int p = min(4 * k + g4, last); const int pk = clist[p]; up[k] = pk; const unsigned eo = (unsigned)((pk >> 7) & 16383) * 1024u; us[k] = SC2[(pk >> 7) & 16383];
#pragma unroll
            for (int jj = 0; jj < 4; ++jj) ub[k][jj] = *(const v4u*)(ubase + eo + 256 * jj); }
        int dsel = 0, psel = 0; f32x2v ssel = (f32x2v){0.f, 0.f}; bool vsel = false;
#pragma unroll 1
        for (int o = 0; o < nit4; ++o) {
#pragma unroll
            for (int k = 0; k < 4; ++k) {
                const int i = 4 * o + k;
                { const int p = min(4 * (i + 3) + g4, last); const int pk = clist[p]; up[(k + 3) & 3] = pk; const unsigned eo = (unsigned)((pk >> 7) & 16383) * 1024u; us[(k + 3) & 3] = SC2[(pk >> 7) & 16383];
#pragma unroll
                  for (int jj = 0; jj < 4; ++jj) ub[(k + 3) & 3][jj] = *(const v4u*)(ubase + eo + 256 * jj); }
                const LAS unsigned char* xp = xs + (up[k] >> 21) * 1024 + 16 * c16;
                v4u xq[4];
#pragma unroll
                for (int jj = 0; jj < 4; ++jj) xq[jj] = *(const LAS v4u*)(xp + 256 * jj);
                int a0 = 0, a1 = 0, a2 = 0, a3 = 0;
#pragma unroll
                for (int jj = 0; jj < 4; ++jj) {
                    a0 = __builtin_amdgcn_sdot4((int)xq[jj].x, (int)ub[k][jj].x, a0, false); a1 = __builtin_amdgcn_sdot4((int)xq[jj].y, (int)ub[k][jj].y, a1, false);
                    a2 = __builtin_amdgcn_sdot4((int)xq[jj].z, (int)ub[k][jj].z, a2, false); a3 = __builtin_amdgcn_sdot4((int)xq[jj].w, (int)ub[k][jj].w, a3, false); }
                int d = (a0 + a1) + (a2 + a3);
                d += __builtin_amdgcn_update_dpp(0, d, 0x128, 0xf, 0xf, false); d += __builtin_amdgcn_update_dpp(0, d, 0x124, 0xf, 0xf, false);
                d += __builtin_amdgcn_update_dpp(0, d, 0x122, 0xf, 0xf, false); d += __builtin_amdgcn_update_dpp(0, d, 0x121, 0xf, 0xf, false);
                if ((i & 15) == c16) { dsel = d; ssel = us[k]; psel = up[k]; vsel = 4 * i + g4 <= last; }
                if (k == 3 && ((o & 3) == 3 || o == nit4 - 1)) {
                    if (vsel) { const int j = psel >> 21; const float sxj = j == 0 ? sx[0] : j == 1 ? sx[1] : j == 2 ? sx[2] : sx[3];
                        ACT[(size_t)(tb + j * tstride) * 128 + (psel & 127)] = gelu_erf((float)dsel * sxj * ssel.x) * ssel.y; }
                    vsel = false; }
            }
        }
        LDS_WAIT();
    }
}
__device__ __forceinline__ void peer_v(const int* IDX, const float* ACT, const float* GATE, const unsigned char* V8, const float* gate2, const bf16* Xin, bf16* Xout, LAS float* wscr,
                                       int vx, int rank, int nb, int tid) {
    const int lane = tid & 63, wave = __builtin_amdgcn_readfirstlane(tid >> 6), g8 = lane >> 3, c8 = lane & 7;
    const int tstride = nb * 16;
    LAS int* wl = (LAS int*)wscr; LAS unsigned char* wqb = (LAS unsigned char*)(wscr + 128);
    const unsigned char* vbase = V8 + (size_t)(vx >> 1) * (2 * MiB) + 16 * c8;
    const int col = 256 * (vx >> 1) + 32 * c8;
    const int wqo0 = (lane & 7) * 16 + (lane >> 3), wqo1 = wqo0 + 8;
    const int t0 = (rank * 8 + wave) * 2 + (vx & 1);
    if (t0 >= T) return;
    const int tlast = t0 + ((T - 1 - t0) / tstride) * tstride;
#define PV_STAGE(tt, I0, I1, A0, A1, VV, WQ4, SW) { \
        float am_ = fmaxf(fabsf(A0), fabsf(A1));   \
        am_ = fmaxf(am_, __uint_as_float(__builtin_amdgcn_update_dpp(0, __float_as_uint(am_), 0x128, 0xf, 0xf, false))); am_ = fmaxf(am_, __uint_as_float(__builtin_amdgcn_update_dpp(0, __float_as_uint(am_), 0x124, 0xf, 0xf, false))); \
        am_ = fmaxf(am_, __uint_as_float(__builtin_amdgcn_update_dpp(0, __float_as_uint(am_), 0x122, 0xf, 0xf, false))); am_ = fmaxf(am_, __uint_as_float(__builtin_amdgcn_update_dpp(0, __float_as_uint(am_), 0x121, 0xf, 0xf, false))); \
        am_ = fmaxf(fmaxf(__uint_as_float(__builtin_amdgcn_readlane(__float_as_uint(am_), 0)), __uint_as_float(__builtin_amdgcn_readlane(__float_as_uint(am_), 16))), \
                    fmaxf(__uint_as_float(__builtin_amdgcn_readlane(__float_as_uint(am_), 32)), __uint_as_float(__builtin_amdgcn_readlane(__float_as_uint(am_), 48)))); \
        const float inv_ = am_ > 0.f ? 127.f / am_ : 0.f; SW = am_ * (1.f / 127.f); \
        wl[lane] = I0; wl[64 + lane] = I1; wqb[wqo0] = (unsigned char)((int)rintf(A0 * inv_) & 255); wqb[wqo1] = (unsigned char)((int)rintf(A1 * inv_) & 255); \
        LDS_WAIT(); \
        _Pragma("unroll") for (int i_ = 0; i_ < 16; ++i_) { const int e_ = wl[8 * i_ + g8]; VV[i_] = *(const v4u*)(vbase + (size_t)(unsigned)(e_ * 128)); } \
        WQ4 = *(const LAS v4u*)(wqb + g8 * 16); LDS_WAIT(); }
#define PV_META(tt, I0, I1, A0, A1) { const size_t o_ = (size_t)(tt) * 128; I0 = IDX[o_ + lane]; I1 = IDX[o_ + 64 + lane]; A0 = ACT[o_ + lane] * GATE[o_ + lane]; A1 = ACT[o_ + 64 + lane] * GATE[o_ + 64 + lane]; }
    int i0, i1, j0, j1; float a0, a1, b0, b1;
    v4u vv[16], vvn[16], wq4, wq4n; float sw, swn;
    PV_META(t0, i0, i1, a0, a1);
    PV_STAGE(t0, i0, i1, a0, a1, vvn, wq4n, swn);
    { const int t1 = min(t0 + tstride, tlast); PV_META(t1, i0, i1, a0, a1); }
    for (int t = t0; t < T; t += tstride) {
        const int b = t >> 11, tn = min(t + tstride, tlast), tn2 = min(t + 2 * tstride, tlast);
#pragma unroll
        for (int i = 0; i < 16; ++i) vv[i] = vvn[i];
        wq4 = wq4n; sw = swn;
        PV_META(tn2, j0, j1, b0, b1);
        const u32x2 xw1 = *(const u32x2*)(Xin + (size_t)t * 1024 + col + 4 * g8); const f32x4 g21 = *(const f32x4*)(gate2 + (size_t)b * NADA + col + 4 * g8);
        PV_STAGE(tn, i0, i1, a0, a1, vvn, wq4n, swn);
        i0 = j0; i1 = j1; a0 = b0; a1 = b1;
        int acc[32], accw = 0;
#pragma unroll
        for (int i = 0; i < 32; ++i) acc[i] = 0;
#pragma unroll
        for (int q = 0; q < 4; ++q) { const int wq = (int)(q == 0 ? wq4.x : q == 1 ? wq4.y : q == 2 ? wq4.z : wq4.w);
            accw = __builtin_amdgcn_sdot4(wq, 0x01010101, accw, false);
#pragma unroll
            for (int d = 0; d < 4; ++d) {
                const unsigned ra = d == 0 ? vv[4 * q].x : d == 1 ? vv[4 * q].y : d == 2 ? vv[4 * q].z : vv[4 * q].w, rb = d == 0 ? vv[4 * q + 1].x : d == 1 ? vv[4 * q + 1].y : d == 2 ? vv[4 * q + 1].z : vv[4 * q + 1].w;
                const unsigned rc = d == 0 ? vv[4 * q + 2].x : d == 1 ? vv[4 * q + 2].y : d == 2 ? vv[4 * q + 2].z : vv[4 * q + 2].w, rd = d == 0 ? vv[4 * q + 3].x : d == 1 ? vv[4 * q + 3].y : d == 2 ? vv[4 * q + 3].z : vv[4 * q + 3].w;
#pragma unroll
                for (int h = 0; h < 2; ++h) {
                    const unsigned a = (h ? (ra >> 4) : ra) & 0x0f0f0f0fu, bb = (h ? (rb >> 4) : rb) & 0x0f0f0f0fu, c = (h ? (rc >> 4) : rc) & 0x0f0f0f0fu, dd = (h ? (rd >> 4) : rd) & 0x0f0f0f0fu;
                    const unsigned ab_lo = __builtin_amdgcn_perm(bb, a, 0x05010400u), ab_hi = __builtin_amdgcn_perm(bb, a, 0x07030602u), cd_lo = __builtin_amdgcn_perm(dd, c, 0x05010400u), cd_hi = __builtin_amdgcn_perm(dd, c, 0x07030602u);
                    acc[8 * d + 0 + h] = __builtin_amdgcn_sdot4((int)__builtin_amdgcn_perm(cd_lo, ab_lo, 0x05040100u), wq, acc[8 * d + 0 + h], false);
                    acc[8 * d + 2 + h] = __builtin_amdgcn_sdot4((int)__builtin_amdgcn_perm(cd_lo, ab_lo, 0x07060302u), wq, acc[8 * d + 2 + h], false);
                    acc[8 * d + 4 + h] = __builtin_amdgcn_sdot4((int)__builtin_amdgcn_perm(cd_hi, ab_hi, 0x05040100u), wq, acc[8 * d + 4 + h], false);
                    acc[8 * d + 6 + h] = __builtin_amdgcn_sdot4((int)__builtin_amdgcn_perm(cd_hi, ab_hi, 0x07060302u), wq, acc[8 * d + 6 + h], false); } } }
#define PV_RED(x) { x += __builtin_amdgcn_update_dpp(0, x, 0x128, 0xf, 0xf, false); \
        { auto r16 = __builtin_amdgcn_permlane16_swap((unsigned)x, (unsigned)x, false, false); x = (int)(r16[0] + r16[1]); } \
        { auto r32 = __builtin_amdgcn_permlane32_swap((unsigned)x, (unsigned)x, false, false); x = (int)(r32[0] + r32[1]); } }
#pragma unroll
        for (int i = 0; i < 32; ++i) PV_RED(acc[i]);
        PV_RED(accw);
#undef PV_RED
        { const int off8 = 8 * accw;
          int s0 = acc[0], s1 = acc[1], s2 = acc[2], s3 = acc[3];
#pragma unroll
          for (int k = 1; k < 8; ++k) { s0 = g8 == k ? acc[4 * k] : s0; s1 = g8 == k ? acc[4 * k + 1] : s1; s2 = g8 == k ? acc[4 * k + 2] : s2; s3 = g8 == k ? acc[4 * k + 3] : s3; }
          const f32x4 xo = (f32x4){bflo(xw1.x), bfhi(xw1.x), bflo(xw1.y), bfhi(xw1.y)} + g21 * ((f32x4){(float)(s0 - off8), (float)(s1 - off8), (float)(s2 - off8), (float)(s3 - off8)} * sw);
          u32x2 w; w.x = pk2(xo[0], xo[1]); w.y = pk2(xo[2], xo[3]); *(u32x2*)(Xout + (size_t)t * 1024 + col + 4 * g8) = w; }
    }
#undef PV_STAGE
#undef PV_META
}

constexpr int PH_PER_LAYER = 12, N_PHASES = 1 + DEPTH * PH_PER_LAYER + 1;
struct Args { const void* in[N_INPUTS]; float* out; unsigned char* ws; int ph_lo, ph_hi; };
static_assert(sizeof(Args) == N_INPUTS * 8 + 24, "Args has no padding");

constexpr int PTAB_OFF = LDSCTL_OFF + 1024;
__device__ __forceinline__ unsigned char* getp(LAS unsigned char* lds, int i) {
    asm volatile("" ::: "memory");
    const u32x2 v = *(volatile LAS u32x2*)(lds + PTAB_OFF + 8 * i);
    const unsigned lo = __builtin_amdgcn_readfirstlane(v.x), hi = __builtin_amdgcn_readfirstlane(v.y);
    GAS unsigned char* g = (GAS unsigned char*)(((unsigned long long)hi << 32) | lo);
    return (unsigned char*)g;
}
#define INP(i) ((const float*)getp(lds, (i)))
#define WSB() getp(lds, 30)

#define IN(k) (lo <= (k) && (k) < hi)
#define SEAM(k) do { if (MK_ONE_LAUNCH && IN(k) && IN((k) + 1)) { XcdBarrier b_; b_.bar = (unsigned*)(WSB() + WS_CTL) + CW_BAR; b_.x = xb_xcc_id(); b_.st = MISC + 8; REPS(11) xcd_barrier(b_, (wave_s << 6) | (int)__lane_id()); } } while (0)
#define PH_BEGIN(lv) int tidq; asm volatile("v_mbcnt_lo_u32_b32 %0, -1, 0\n\tv_mbcnt_hi_u32_b32 %0, -1, %0" : "=v"(tidq)); tidq |= wave_s << 6;     \
    asm volatile("" : "+v"(tidq)); const int lane = tidq & 63, wave = __builtin_amdgcn_readfirstlane(tidq >> 6); \
    int G = gridDim.x, bx = blockIdx.x, l = (lv); asm volatile("" : "+s"(G), "+s"(bx), "+s"(l)); const int gw = bx * NWAVES + wave, NGW = G * NWAVES; \
    unsigned char* ws = WSB(); LAS float* wscr = (LAS float*)(lds + RING_OFF + wave * 16384); (void)lane; (void)gw; (void)NGW; (void)ws; (void)wscr; (void)l


constexpr int PI_W = 4512, PI_K = 512, PI_U = 2048, PI_V = 2048, PI_TOTAL = PI_W + PI_K + PI_U + PI_V;
template <int NR> __device__ __forceinline__ void prep_rows_i8(const float* src, size_t src_stride, unsigned char* dst, size_t dst_stride, float* scale_slot  , int lane) {
    f32x4 v[NR][4];
#pragma unroll
    for (int rr = 0; rr < NR; ++rr) { const f32x4* s = (const f32x4*)(src + rr * src_stride) + lane * 4;
#pragma unroll
        for (int j = 0; j < 4; ++j) v[rr][j] = s[j]; }
#pragma unroll
    for (int rr = 0; rr < NR; ++rr) {
        float am = 0.f;
#pragma unroll
        for (int j = 0; j < 4; ++j) am = fmaxf(fmaxf(am, fmaxf(fabsf(v[rr][j][0]), fabsf(v[rr][j][1]))), fmaxf(fabsf(v[rr][j][2]), fabsf(v[rr][j][3])));
#pragma unroll
        for (int o = 1; o < 64; o <<= 1) am = fmaxf(am, __shfl_xor(am, o));
        const float inv = am > 0.f ? 127.f / am : 0.f;
#define Q4(x) ((unsigned)((int)rintf((x)[0] * inv) & 255) | ((unsigned)((int)rintf((x)[1] * inv) & 255) << 8) | ((unsigned)((int)rintf((x)[2] * inv) & 255) << 16) | ((unsigned)((int)rintf((x)[3] * inv) & 255) << 24))
        v4u o; o.x = Q4(v[rr][0]); o.y = Q4(v[rr][1]); o.z = Q4(v[rr][2]); o.w = Q4(v[rr][3]);
#undef Q4
        *(v4u*)(dst + rr * dst_stride) = o;
        if (lane == 0) scale_slot[2 * rr] = am * (1.f / 127.f);
    }
}
template <int NR> __device__ __forceinline__ void prep_rows_i4(const float* src, size_t src_stride, unsigned char* dst, size_t dst_stride, float* scale_slot  , int lane) {
    f32x4 v[NR][4];
#pragma unroll
    for (int rr = 0; rr < NR; ++rr) { const f32x4* s = (const f32x4*)(src + rr * src_stride) + lane * 4;
#pragma unroll
        for (int j = 0; j < 4; ++j) v[rr][j] = s[j]; }
#pragma unroll
    for (int rr = 0; rr < NR; ++rr) {
        float am = 0.f, ss = 0.f;
#pragma unroll
        for (int j = 0; j < 4; ++j) { am = fmaxf(fmaxf(am, fmaxf(fabsf(v[rr][j][0]), fabsf(v[rr][j][1]))), fmaxf(fabsf(v[rr][j][2]), fabsf(v[rr][j][3]))); ss += dot4(v[rr][j], v[rr][j]); }
#pragma unroll
        for (int o = 1; o < 64; o <<= 1) { am = fmaxf(am, __shfl_xor(am, o)); ss += __shfl_xor(ss, o); }
        am = fminf(am, 2.7f * sqrtf(ss * (1.f / 1024.f)));
        const float inv = am > 0.f ? 7.f / am : 0.f;
#define N4(x) ((unsigned)((int)fminf(fmaxf(rintf((x) * inv), -7.f), 7.f) + 8))
#define B4(x, y) (N4(x) | (N4(y) << 4))
        u32x2 o;
        o.x = B4(v[rr][0][0], v[rr][0][1]) | (B4(v[rr][0][2], v[rr][0][3]) << 8) | (B4(v[rr][1][0], v[rr][1][1]) << 16) | (B4(v[rr][1][2], v[rr][1][3]) << 24);
        o.y = B4(v[rr][2][0], v[rr][2][1]) | (B4(v[rr][2][2], v[rr][2][3]) << 8) | (B4(v[rr][3][0], v[rr][3][1]) << 16) | (B4(v[rr][3][2], v[rr][3][3]) << 24);
#undef B4
#undef N4
        *(u32x2*)(dst + rr * dst_stride) = o;
        if (lane == 0) scale_slot[2 * rr] = am * (1.f / 7.f);
    }
}
__device__ __forceinline__ void prep_item(LAS unsigned char* lds, unsigned char* ws, LAS float* wscr, int l, int r, int lane) {
    constexpr int I_WIN_ = 16 * 136, I_WQ_ = 12 * 24, I_WKV_ = 4 * 32, I_WA_ = 8 * 32, I_WM_ = 8 * 32, I_WO_ = 16 * 32, I_PW_ = 16 * 32, I_WQK_ = 8 * 32, I_WV_ = 8 * 16;
    static_assert(I_WIN_ + I_WQ_ + I_WKV_ + I_WA_ + I_WM_ + I_WO_ + I_PW_ + I_WQK_ + I_WV_ == PI_W, "weight items");
    unsigned char* wl = ws + WS_W + (size_t)l * W_LAYER;
    if (r < PI_W) {
        if (r < I_WIN_) { const GetWin g{INP(I_WIN) + (size_t)l * D * 4136}; prep_tile(g, (bf16*)(wl + WO_WIN), 1024, 64 * (r / 136), 32 * (r % 136), wscr, lane); return; } r -= I_WIN_;
        if (r < I_WQ_) { const GetWq g{INP(I_WQUP) + (size_t)l * 768 * 768, INP(I_QNG) + l * 768}; prep_tile(g, (bf16*)(wl + WO_WQ), 768, 64 * (r / 24), 32 * (r % 24), wscr, lane); return; } r -= I_WQ_;
        if (r < I_WKV_) { const GetWkv g{INP(I_WKVUP) + (size_t)l * 256 * 1024, INP(I_KVNG) + l * 256}; prep_tile(g, (bf16*)(wl + WO_WKV), 256, 64 * (r / 32), 32 * (r % 32), wscr, lane); return; } r -= I_WKV_;
        if (r < I_WA_) { const GetPlain g{INP(I_WBA) + (size_t)l * 512 * 1024, 1024}; prep_tile(g, (bf16*)(wl + WO_WA), 512, 64 * (r / 32), 32 * (r % 32), wscr, lane); return; } r -= I_WA_;
        if (r < I_WM_) { const GetPlain g{INP(I_WBM) + (size_t)l * 512 * 1024, 1024}; prep_tile(g, (bf16*)(wl + WO_WM), 512, 64 * (r / 32), 32 * (r % 32), wscr, lane); return; } r -= I_WM_;
        if (r < I_WO_) { const GetPlain g{INP(I_WOUT) + (size_t)l * 1024 * 1024, 1024}; prep_tile(g, (bf16*)(wl + WO_WO), 1024, 64 * (r / 32), 32 * (r % 32), wscr, lane); return; } r -= I_WO_;
        if (r < I_PW_) { const GetPlain g{INP(I_PWQ) + (size_t)l * 1024 * 1024, 1024}; prep_tile(g, (bf16*)(wl + WO_PWQ), 1024, 64 * (r / 32), 32 * (r % 32), wscr, lane); return; } r -= I_PW_;
        if (r < I_WQK_) { const GetWqk g{INP(I_WQM) + (size_t)l * 65536, INP(I_WKM) + (size_t)l * 65536}; prep_tile(g, (bf16*)(wl + WO_WQK), 512, 64 * (r / 32), 32 * (r % 32), wscr, lane); return; } r -= I_WQK_;
        { const GetWv g{INP(I_WVM) + (size_t)l * 65536}; prep_tile(g, (bf16*)(wl + WO_WV), 512, 64 * (r / 16), 32 * (r % 16), wscr, lane); }
        return; }
    r -= PI_W;
    if (r < PI_K) { const int o = (r * 64 + lane) * 4;
        const f32x4 v = *(const f32x4*)(INP(I_PKEYS) + (size_t)l * 131072 + o); u32x2 w; w.x = pk2(v[0], v[1]); w.y = pk2(v[2], v[3]);
        *(u32x2*)(wl + WO_KEYB + (size_t)o * 2) = w; return; }
    r -= PI_K;
    float* sc2 = (float*)(ws + WS_USC);
    if (r < PI_U) { const float* pu = INP(I_PU) + (size_t)l * 16777216;
        for (int rr = 0; rr < 8; rr += 8) { const int er = r * 8 + rr; prep_rows_i8<8>(pu + (size_t)er * 1024, 1024, ws + WS_U8 + (size_t)l * 32 * MiB + (size_t)er * 1024 + 16 * lane, 1024, sc2 + 2 * (l * 16384 + er), lane); }
        return; }
    r -= PI_U;
    { const float* pv = INP(I_PV) + (size_t)l * 16777216;
      for (int rr = 0; rr < 8; rr += 8) { const int er = r * 8 + rr;
          prep_rows_i4<8>(pv + (size_t)er * 1024, 1024, ws + WS_V8 + (size_t)l * 32 * MiB + (size_t)(lane >> 4) * (2 * MiB) + (size_t)er * 128 + 8 * (lane & 15), 128, sc2 + 2 * (l * 16384 + er) + 1, lane); } }
}
template <int lv> __device__ __forceinline__ void layer_phases(LAS unsigned char* lds, volatile LAS unsigned* MISC, const int lo, const int hi, const int wave_s) {
        const int P = 1 + lv * PH_PER_LAYER;
#define WL() (ws + WS_W + (size_t)l * W_LAYER)
#define ADAL() ((const float*)(ws + ADA_OFF) + (size_t)l * 8 * NADA)
#define XA() WSP(bf16, WS_X)
#define XB() (WSP(bf16, WS_X) + (size_t)T * D)
#define WSP(type, off) ((type*)(ws + (off)))
        if (IN(P + 0)) REPS(1) { PH_BEGIN(lv);
            if (lv == 0) rowpass_norm_mod<false>(INP(I_X), INP(I_N1G) + l * D, ADAL() + 0, ADAL() + 1024, WSP(bf16, WS_H), gw, NGW, lane);
            else rowpass_norm_mod<true>(XB(), INP(I_N1G) + l * D, ADAL() + 0, ADAL() + 1024, WSP(bf16, WS_H), gw, NGW, lane); }
        SEAM(P + 0);
        if (IN(P + 1)) REPS(2) { PH_BEGIN(lv);
            if (G == 256) {
                { pg8::Gemm g{WSP(bf16, WS_H), (const bf16*)(WL() + WO_WIN), T, 4096, D}; pg8::StaticOrder S; S.init(T, 4096, G, bx);
                  EpiProj E{WSP(bf16, WS_QLAT), WSP(bf16, WS_KVLAT), WSP(bf16, WS_UM), WSP(bf16, WS_OPRE), WSP(bf16, WS_GA), WSP(bf16, WS_GM), WSP(float, WS_SMALL)};
                  pg8::gemm_phase<EpiProj, pg8::StaticOrder, true, true>(lds + RING_OFF, g, S, E, tidq); }
                { const int kq = bx >> 6;
                  pg8::Gemm g{WSP(bf16, WS_H) + 256 * kq, (const bf16*)(WL() + WO_WIN) + (size_t)4096 * 1024 + 256 * kq, T, 256, 256, 1024}; pg8::StaticOrder S; S.init(T, 256, 64, bx & 63);
                  EpiSmallPart E{WSP(float, WS_SMALLP) + (size_t)kq * T * 64};
                  pg8::gemm_phase<EpiSmallPart, pg8::StaticOrder, true, true>(lds + RING_OFF, g, S, E, tidq); }
            } else {
                pg8::Gemm g{WSP(bf16, WS_H), (const bf16*)(WL() + WO_WIN), T, NPROJ, D}; pg8::StaticOrder S; S.init(T, NPROJ, G, bx);
                EpiProj E{WSP(bf16, WS_QLAT), WSP(bf16, WS_KVLAT), WSP(bf16, WS_UM), WSP(bf16, WS_OPRE), WSP(bf16, WS_GA), WSP(bf16, WS_GM), WSP(float, WS_SMALL)};
                pg8::gemm_phase<EpiProj, pg8::StaticOrder, true, true>(lds + RING_OFF, g, S, E, tidq);
            }
        }
        SEAM(P + 1);
        if (IN(P + 2)) REPS(3) { PH_BEGIN(lv);
            rowpass_mid(WSP(bf16, WS_QLAT), WSP(bf16, WS_KVLAT), WSP(float, WS_SMALL), (G == 256) ? WSP(float, WS_SMALLP) : (const float*)nullptr, WSP(float, WS_COS), WSP(float, WS_SIN), WSP(bf16, WS_UM), INP(I_CONVW) + l * 4 * 512, INP(I_CONVB) + l * 512,
                        INP(I_BI) + l * 4, INP(I_BF) + l * 4, WSP(float, WS_RQ), WSP(float, WS_RKV), WSP(bf16, WS_K), WSP(float, WS_LOGI), WSP(float, WS_LOGF), WSP(bf16, WS_CONV), gw, NGW, lane); }
        SEAM(P + 2);
        if (IN(P + 3)) REPS(4) {
            { PH_BEGIN(lv); pg8::Gemm g{WSP(bf16, WS_QLAT), (const bf16*)(WL() + WO_WQ), T, 768, 768}; pg8::StaticOrder S; S.init(T, 768, G, bx);
              EpiQ E{WSP(bf16, WS_Q), WSP(float, WS_RQ), WSP(float, WS_COS), WSP(float, WS_SIN)}; pg8::gemm_phase<EpiQ, pg8::StaticOrder, true, true>(lds + RING_OFF, g, S, E, tidq); }
            { PH_BEGIN(lv); pg8::Gemm g{WSP(bf16, WS_KVLAT), (const bf16*)(WL() + WO_WKV), T, 1024, 256}; pg8::StaticOrder S; S.init(T, 1024, G, bx);
              EpiKV E{WSP(bf16, WS_K), WSP(bf16, WS_V), WSP(float, WS_RKV)}; pg8::gemm_phase<EpiKV, pg8::StaticOrder, true, true>(lds + RING_OFF, g, S, E, tidq); }
            { PH_BEGIN(lv); pg8::Gemm g{WSP(bf16, WS_CONV), (const bf16*)(WL() + WO_WQK), T, 1024, 512}; pg8::StaticOrder S; S.init(T, 1024, G, bx);
              pg8::EpiBf16<0> E{WSP(bf16, WS_QKM), 1024, nullptr, 0, 0, 1.f}; pg8::gemm_phase<pg8::EpiBf16<0>, pg8::StaticOrder, true, true>(lds + RING_OFF, g, S, E, tidq); }
            { PH_BEGIN(lv); pg8::Gemm g{WSP(bf16, WS_UM), (const bf16*)(WL() + WO_WV), T, 512, 512}; pg8::StaticOrder S;
              if (G == 256) S.init(T, 512, 64, bx >= 192 ? bx - 192 : (1 << 20)); else S.init(T, 512, G, bx);
              pg8::EpiBf16<0> E{WSP(bf16, WS_VM), 512, nullptr, 0, 0, 1.f}; pg8::gemm_phase<pg8::EpiBf16<0>, pg8::StaticOrder, true, true>(lds + RING_OFF, g, S, E, tidq); }
        }
        SEAM(P + 3);
        if (IN(P + 4)) {
            REPS(5) { PH_BEGIN(lv); attn_mfma(WSP(bf16, WS_Q), WSP(bf16, WS_K), WSP(bf16, WS_V), WSP(bf16, WS_AO), lds + RING_OFF, bx, G, tidq); __syncthreads(); }
            REPS(6) { PH_BEGIN(lv); mlstm_mfma(WSP(bf16, WS_QKM), WSP(bf16, WS_VM), WSP(float, WS_LOGI), WSP(float, WS_LOGF), WSP(bf16, WS_CONV), WSP(bf16, WS_OPRE), INP(I_MHG) + l * 512, INP(I_MSKIP) + l * 512,
                          WSP(bf16, WS_OUTM), lds + RING_OFF, bx, G, tidq); }
        }
        SEAM(P + 4);
        if (IN(P + 5)) REPS(7) {
            { PH_BEGIN(lv); pg8::Gemm g{WSP(bf16, WS_AO), (const bf16*)(WL() + WO_WA), T, 1024, 512}; pg8::StaticOrder S; S.init(T, 1024, G, bx);
              EpiMerge E{WSP(bf16, WS_MERGED), WSP(bf16, WS_GA), 1}; pg8::gemm_phase<EpiMerge, pg8::StaticOrder, true, true>(lds + RING_OFF, g, S, E, tidq); }
            { PH_BEGIN(lv); pg8::Gemm g{WSP(bf16, WS_OUTM), (const bf16*)(WL() + WO_WM), T, 1024, 512}; pg8::StaticOrder S; S.init(T, 1024, G, bx);
              EpiMerge E{WSP(bf16, WS_MERGED), WSP(bf16, WS_GM), 0}; pg8::gemm_phase<EpiMerge, pg8::StaticOrder, true, true>(lds + RING_OFF, g, S, E, tidq); }
        }
        SEAM(P + 5);
        if (IN(P + 6)) REPS(8) { PH_BEGIN(lv);
            pg8::Gemm g{WSP(bf16, WS_MERGED), (const bf16*)(WL() + WO_WO), T, 1024, 1024}; pg8::StaticOrder S; S.init(T, 1024, G, bx);
            if (lv == 0) { EpiResid<false> E{INP(I_X), XA(), ADAL() + 2048}; pg8::gemm_phase<EpiResid<false>, pg8::StaticOrder, true, true>(lds + RING_OFF, g, S, E, tidq); }
            else { EpiResid<true> E{XB(), XA(), ADAL() + 2048}; pg8::gemm_phase<EpiResid<true>, pg8::StaticOrder, true, true>(lds + RING_OFF, g, S, E, tidq); }
        }
        SEAM(P + 6);
        if (IN(P + 7)) REPS(1) { PH_BEGIN(lv); rowpass_norm_mod<true>(XA(), INP(I_N2G) + l * D, ADAL() + 3072, ADAL() + 4096, WSP(bf16, WS_H), gw, NGW, lane, ws + WS_H8, WSP(float, WS_XS)); }
        SEAM(P + 7);
        if (IN(P + 8)) REPS(9) { PH_BEGIN(lv);
            pg8::Gemm g{WSP(bf16, WS_H), (const bf16*)(WL() + WO_PWQ), T, 1024, 1024}; pg8::StaticOrder S; S.init(T, 1024, G, bx);
            pg8::EpiBf16<0> E{WSP(bf16, WS_PQ), 1024, nullptr, 0, 0, 1.f}; pg8::gemm_phase<pg8::EpiBf16<0>, pg8::StaticOrder, true, true>(lds + RING_OFF, g, S, E, tidq);
        }
        SEAM(P + 8);
        if (IN(P + 9)) REPS(10) { PH_BEGIN(lv);
            peer_route(WSP(bf16, WS_PQ), (const bf16*)(WL() + WO_KEYB), WSP(int, WS_IDX), WSP(float, WS_GATE), lds + RING_OFF, bx, G, tidq); }
        SEAM(P + 9);
        if (IN(P + 10)) REPS(12) { PH_BEGIN(lv);
            int vx, rank, nb; peer_partition((const unsigned*)(ws + WS_CTL) + CW_XC, MISC, bx, G, vx, rank, nb);
            peer_u_i8(ws + WS_H8, WSP(float, WS_XS), WSP(int, WS_IDX), ws + WS_U8 + (size_t)l * 32 * MiB, WSP(f32x2v, WS_USC) + l * 16384, WSP(float, WS_ACT), wscr, vx, rank, nb, tidq); }
        SEAM(P + 10);
        if (IN(P + 11)) REPS(13) { PH_BEGIN(lv);
            int vx, rank, nb; peer_partition((const unsigned*)(ws + WS_CTL) + CW_XC, MISC, bx, G, vx, rank, nb);
            peer_v(WSP(int, WS_IDX), WSP(float, WS_ACT), WSP(float, WS_GATE), ws + WS_V8 + (size_t)l * 32 * MiB, ADAL() + 5120, XA(), XB(), wscr, vx, rank, nb, tidq);
        }
        SEAM(P + 11);
    }

__global__ void __launch_bounds__(NTHREADS, 2) fwd(Args args) {
    extern __shared__ __attribute__((aligned(16))) unsigned char lds_raw[];
    LAS unsigned char* lds = (LAS unsigned char*)lds_raw;
    volatile LAS unsigned* MISC = (volatile LAS unsigned*)(lds + MISC_OFF);
    const int tid = threadIdx.x;
    const int wave_s = __builtin_amdgcn_readfirstlane(tid >> 6);
    for (int u = tid; u < (LDS_BYTES - LDSCTL_OFF) / 4; u += NTHREADS) ((LAS unsigned*)(lds + LDSCTL_OFF))[u] = 0u;
    __syncthreads();
    if (tid == 0) { LAS unsigned long long* pt = (LAS unsigned long long*)(lds + PTAB_OFF);
#pragma unroll
        for (int i = 0; i < N_INPUTS; ++i) pt[i] = (unsigned long long)args.in[i];
        pt[29] = (unsigned long long)args.out; pt[30] = (unsigned long long)args.ws; }
    __syncthreads();
    if (MK_ONE_LAUNCH) (void)xcd_barrier_post((unsigned*)(WSB() + WS_CTL) + CW_BAR, MISC + 8);
    if (MK_ONE_LAUNCH && tid == 0) { const unsigned xc = xb_xcc_id() & 7u; MISC[12] = xb_add((unsigned*)(WSB() + WS_CTL) + CW_XC + 64 * xc, 1u); MISC[13] = xc; }
    __syncthreads();
    const int lo = args.ph_lo, hi = args.ph_hi;

    if (IN(0)) REPS(0) {
        PH_BEGIN(0);
        float* ADA = (float*)(ws + ADA_OFF);
        { const float* c = INP(I_C); const float* wada = INP(I_WADA); const float* bada = INP(I_BADA);
          for (int it = bx; it < DEPTH * 96; it += G) {
            const int ll = it / 96, cg = it % 96; const int n = cg * 64 + lane;
#pragma unroll
            for (int i = 0; i < 16; ++i) { const int e = lane + 64 * i; const int bb = e >> 7, kk = e & 127; const float cv = c[bb * D + wave * 128 + kk]; wscr[e] = cv * sigm(cv); }
            LDS_WAIT();
            const float* w = wada + (size_t)ll * D * NADA + (size_t)(wave * 128) * NADA + n;
            float a[8];
#pragma unroll
            for (int bb = 0; bb < 8; ++bb) a[bb] = 0.f;
#pragma unroll 16
            for (int kk = 0; kk < 128; ++kk) { const float wv = w[(size_t)kk * NADA];
#pragma unroll
                for (int bb = 0; bb < 8; ++bb) a[bb] += wscr[bb * 128 + kk] * wv; }
#pragma unroll
            for (int bb = 0; bb < 8; ++bb) wscr[1024 + bb * 64 + lane] = a[bb];
            __syncthreads();
            { float s = 0.f;
#pragma unroll
              for (int w8 = 0; w8 < 8; ++w8) s += ((const LAS float*)(lds + RING_OFF + w8 * 16384))[1024 + wave * 64 + lane];
              ADA[((size_t)ll * 8 + wave) * NADA + n] = s + bada[ll * NADA + n]; }
            __syncthreads();
          } }
        { const int* pos = (const int*)INP(I_POS); float* COS = (float*)(ws + WS_COS); float* SIN = (float*)(ws + WS_SIN);
          for (int idx = gw * 64 + lane; idx < T * 16; idx += NGW * 64) { const int t = idx >> 4, j = idx & 15;
              const float ang = (float)pos[t] * INV_FREQ[j];
              const double rev = (double)ang * 0.15915494309189535; const float fr = (float)(rev - rint(rev));
              COS[idx] = __builtin_amdgcn_cosf(fr); SIN[idx] = __builtin_amdgcn_sinf(fr); } }
        for (int it = gw; it < DEPTH * PI_TOTAL; it += NGW) prep_item(lds, ws, wscr, it / PI_TOTAL, it % PI_TOTAL, lane);
    }
    SEAM(0);

    layer_phases<0>(lds, MISC, lo, hi, wave_s);
    layer_phases<1>(lds, MISC, lo, hi, wave_s);
    if (IN(N_PHASES - 1)) REPS(1) { PH_BEGIN(0); rowpass_final(XB(), INP(I_FG), (float*)getp(lds, 29), gw, NGW, lane); }
#undef IN
#undef SEAM
}

extern "C" void kernel_launch(void* const* d_in, const int* in_sizes, int n_in, void* d_out, int out_size, void* d_ws, size_t ws_size, hipStream_t stream) {
    static int grid = 0;
    if (grid == 0) {
        if (n_in != N_INPUTS || in_sizes[0] != T * D || out_size != T * D || ws_size < WS_END2) {
            fprintf(stderr, "kernel_launch: unexpected shapes: n_in %d in0 %d out %d ws %zu (need %zu); nothing launched\n", n_in, n_in > 0 ? in_sizes[0] : -1, out_size, ws_size, (size_t)WS_END2); grid = -1; return; }
        int dev = 0, cus = 0, per_cu = 0;
        if (hipGetDevice(&dev) != hipSuccess || hipDeviceGetAttribute(&cus, hipDeviceAttributeMultiprocessorCount, dev) != hipSuccess) { fprintf(stderr, "kernel_launch: device query failed\n"); grid = -1; return; }
        if (hipFuncSetAttribute((const void*)fwd, hipFuncAttributeMaxDynamicSharedMemorySize, LDS_BYTES) != hipSuccess) { fprintf(stderr, "kernel_launch: hipFuncSetAttribute failed\n"); grid = -1; return; }
        if (hipOccupancyMaxActiveBlocksPerMultiprocessor(&per_cu, (const void*)fwd, NTHREADS, LDS_BYTES) != hipSuccess || per_cu < 1)
            fprintf(stderr, "kernel_launch: note: occupancy query reports %d workgroups per CU\n", per_cu);
        (void)hipGetLastError();
        grid = cus;
    }
    if (grid < 0) return;
    if (hipMemsetAsync((char*)d_ws + WS_CTL, 0, CTL_ZERO_BYTES, stream) != hipSuccess) { fprintf(stderr, "kernel_launch: memset failed\n"); return; }
    Args a{};
    for (int i = 0; i < N_INPUTS; ++i) a.in[i] = d_in[i];
    a.out = (float*)d_out; a.ws = (unsigned char*)d_ws;
#if MK_ONE_LAUNCH
    a.ph_lo = 0; a.ph_hi = N_PHASES;
    hipLaunchKernelGGL(fwd, dim3(grid), dim3(NTHREADS), LDS_BYTES, stream, a);
#else
    for (int p = 0; p < N_PHASES; ++p) { a.ph_lo = p; a.ph_hi = p + 1; hipLaunchKernelGGL(fwd, dim3(grid), dim3(NTHREADS), LDS_BYTES, stream, a); }
#endif
    const hipError_t le = hipPeekAtLastError();
    if (le != hipSuccess) fprintf(stderr, "kernel_launch: launch failed: %s\n", hipGetErrorName(le));
}
```

```cpp
#include <hip/hip_runtime.h>
#include <cstdio>
#include <cstdint>
namespace pg8 {
#define PG8_LAS __attribute__((address_space(3)))
typedef unsigned short bf16_t;
typedef short bf16x8 __attribute__((ext_vector_type(8)));
typedef float f32x4 __attribute__((ext_vector_type(4)));
typedef unsigned u32x4 __attribute__((ext_vector_type(4)));
constexpr int BM = 256, BK = 64, HALF = 128, HTB = HALF * BK * 2  , STAGE_BYTES = 8 * HTB, NXCD = 8, WGM = 8;

__host__ __device__ __forceinline__ int lds_byte(int r, int c) { const int st = (r >> 4) * 2 + (c >> 5), rr = r & 15, cc = c & 31, ob = rr * 64 + cc * 2; return st * 1024 + (ob ^ (((ob >> 9) & 1) << 5)); }
__host__ __device__ __forceinline__ void stage_rc(int b, int& R, int& C) { const int st = b / 1024, sb = b % 1024, swz = sb ^ (((sb >> 9) & 1) << 5); R = (st >> 1) * 16 + swz / 64; C = (st & 1) * 32 + (swz % 64) / 2; }
__host__ __device__ __forceinline__ int perm32(int rho) { const int n = rho >> 4, i = rho & 15; return 8 * (i >> 2) + 4 * n + (i & 3); }

struct Unit { int pm, pn; };
struct Gemm { const bf16_t* A; const bf16_t* Bt; int M, N, K; int ld = 0; };

struct StaticOrder {
    int nM, nN, nwg, G, c;
    __host__ __device__ void init(int M, int N, int G_, int c_) { nM = M / BM; nN = N / BM; nwg = nM * nN; G = G_; c = c_; }
    __host__ __device__ bool next(int i, Unit& u) const {
        const long L = (long)i * G + c; if (L >= nwg) return false;
        int wgid = (int)L; { const int q = nwg / NXCD, r = nwg % NXCD, xcd = wgid % NXCD, off = wgid / NXCD; wgid = (xcd < r ? xcd * (q + 1) : r * (q + 1) + (xcd - r) * q) + off; }
        const int nig = WGM * nN, gid = wgid / nig, fm = gid * WGM, gsz = (nM - fm) < WGM ? (nM - fm) : WGM;
        u.pm = fm + ((wgid % nig) % gsz); u.pn = (wgid % nig) / gsz; return true;
    }
    __device__ __forceinline__ void a_ready(const Unit&) const {}
    __device__ __forceinline__ void done(const Unit&) const {}
};

__device__ __forceinline__ unsigned cvt_pk_bf16(float lo, float hi) { unsigned r; asm volatile("v_cvt_pk_bf16_f32 %0, %1, %2" : "=v"(r) : "v"(lo), "v"(hi)); return r; }
typedef float f32x2 __attribute__((ext_vector_type(2)));
__device__ __forceinline__ f32x2 gelu_pk(f32x2 v) {
    const f32x2 av = __builtin_elementwise_abs(v), d = av * 0.2316418882f + 1.0f;
    f32x2 t; t.x = __builtin_amdgcn_rcpf(d.x); t.y = __builtin_amdgcn_rcpf(d.y);
    f32x2 q = t * 0.5307027145f + (-0.7265760135f); q = q * t + 0.7107068705f; q = q * t + (-0.142248368f); q = q * t + 0.127414796f; q = q * t;
    const f32x2 s = (v * v) * (-0.72134752044f);
    f32x2 e; e.x = __builtin_amdgcn_exp2f(s.x); e.y = __builtin_amdgcn_exp2f(s.y);
    const f32x2 m = v * (q * e), r = v - m;
    f32x2 o; o.x = v.x < 0.f ? m.x : r.x; o.y = v.y < 0.f ? m.y : r.y; return o;
}

template <int ACT  > struct EpiBf16 {
    static constexpr bool PERM = true, AFTER_DRAIN = false; static_assert(ACT == 0 || ACT == 1, "EpiBf16: ACT is 0 (none) or 1 (gelu_pk)");
    bf16_t* O; int ldc; const float* bias; int split_cols; size_t split_stride; float scale0;
    __device__ __forceinline__ void operator()(const f32x4 (&acc)[2][2][4][2], const Unit& u, int wr, int wc, int fr, int fq) const {
        const int row0 = u.pm * BM + wr * 64 + fr; int colt = u.pn * BM; bf16_t* base = O;
        float sc = 1.f; if (split_cols) { const int t = colt / split_cols; base += (size_t)t * split_stride; colt -= t * split_cols; if (t == 0) sc = scale0; }
        const int col0 = colt + wc * 32 + 8 * fq, bcol0 = u.pn * BM + wc * 32 + 8 * fq;
        f32x4 bv[2][2];
#pragma unroll
        for (int bj = 0; bj < 2; ++bj)
#pragma unroll
            for (int n = 0; n < 2; ++n) bv[bj][n] = bias ? *(const f32x4*)(bias + bcol0 + bj * HALF + 4 * n) : (f32x4){0.f, 0.f, 0.f, 0.f};
#pragma unroll
        for (int ai = 0; ai < 2; ++ai)
#pragma unroll
            for (int m = 0; m < 4; ++m) { bf16_t* rowp = base + (size_t)(row0 + ai * HALF + m * 16) * ldc + col0;
#pragma unroll
                for (int bj = 0; bj < 2; ++bj) { f32x4 v0 = acc[ai][bj][m][0] + bv[bj][0], v1 = acc[ai][bj][m][1] + bv[bj][1];
                    if (ACT == 1) { f32x2 a = gelu_pk((f32x2){v0[0], v0[1]}), b = gelu_pk((f32x2){v0[2], v0[3]}), c = gelu_pk((f32x2){v1[0], v1[1]}), d = gelu_pk((f32x2){v1[2], v1[3]});
                        v0 = (f32x4){a.x, a.y, b.x, b.y}; v1 = (f32x4){c.x, c.y, d.x, d.y}; }
                    v0 = v0 * sc; v1 = v1 * sc; u32x4 w; w.x = cvt_pk_bf16(v0[0], v0[1]); w.y = cvt_pk_bf16(v0[2], v0[3]); w.z = cvt_pk_bf16(v1[0], v1[1]); w.w = cvt_pk_bf16(v1[2], v1[3]);
                    *(u32x4*)(rowp + bj * HALF) = w; } }
    }
};


template <class Epi, class Sched, bool ALIGN_EPI = false, bool SP2 = false>
__device__ __forceinline__ void gemm_phase(PG8_LAS unsigned char* lds, const Gemm g, const Sched& S, const Epi& E, const int tid_in) {
    int tid_l = tid_in; asm volatile("" : "+v"(tid_l));
    const int tid = tid_l, wid = __builtin_amdgcn_readfirstlane(tid >> 6), lane = tid & 63, wr = wid >> 2, wc = wid & 3, fr = lane & 15, fq = lane >> 4;
    const int K = g.K, nt = K / BK, LD = g.ld ? g.ld : g.K;
    unsigned voffA[2], voffB[2];
#pragma unroll
    for (int i = 0; i < 2; ++i) { int R, C; stage_rc(tid * 16 + i * 8192, R, C); const int Rb = Epi::PERM ? ((R & ~31) + perm32(R & 31)) : R;
        voffA[i] = (unsigned)(R * LD + C) * 2u; voffB[i] = (unsigned)(Rb * LD + C) * 2u; }
    const size_t kstep = (size_t)(BK * 2);
    const size_t hstep = (size_t)HALF * LD * 2;
    const size_t tstep = 2 * hstep;
    const unsigned ldsw = (unsigned)wid * 1024u;
    const int aoff = lds_byte(wr * 64 + fr, fq * 8), boff = lds_byte(wc * 32 + fr, fq * 8);
#define PG8_SA(b, h) (((b) * 2 + (h)) * HTB)
#define PG8_SB(b, h) ((4 + (b) * 2 + (h)) * HTB)
#define PG8_STAGE(bufoff, gbase, voff) do { _Pragma("unroll") for (int _i = 0; _i < 2; ++_i) \
        __builtin_amdgcn_global_load_lds((const unsigned*)((const char*)(gbase) + (voff)[_i]), (PG8_LAS unsigned*)(lds + (bufoff) + ldsw + _i * 8192), 16, 0, 0); } while (0)
#define PG8_LDA(dst, b, h) do { _Pragma("unroll") for (int m = 0; m < 4; ++m) _Pragma("unroll") for (int k = 0; k < 2; ++k) dst[m][k] = *(const PG8_LAS bf16x8*)(lds + PG8_SA(b, h) + aoff + m * 2048 + k * 1024); } while (0)
#define PG8_LDB(dst, b, h) do { _Pragma("unroll") for (int n = 0; n < 2; ++n) _Pragma("unroll") for (int k = 0; k < 2; ++k) dst[n][k] = *(const PG8_LAS bf16x8*)(lds + PG8_SB(b, h) + boff + n * 2048 + k * 1024); } while (0)
#define PG8_MMA(ai, bj, At, Bt) do { __builtin_amdgcn_s_setprio(1); _Pragma("unroll") for (int m = 0; m < 4; ++m) _Pragma("unroll") for (int n = 0; n < 2; ++n) _Pragma("unroll") for (int k = 0; k < 2; ++k) \
        acc[ai][bj][m][n] = __builtin_amdgcn_mfma_f32_16x16x32_bf16(Bt[n][k], At[m][k], acc[ai][bj][m][n], 0, 0, 0); __builtin_amdgcn_s_setprio(0); } while (0)
#define PG8_WAIT_V(n) asm volatile("s_waitcnt vmcnt(" #n ")" ::: "memory")
#define PG8_WAIT_L(n) asm volatile("s_waitcnt lgkmcnt(" #n ")" ::: "memory")
#define PG8_BAR __builtin_amdgcn_s_barrier()
#define PG8_SCHED __builtin_amdgcn_sched_barrier(0)
    Unit cur, nxt; int ui = 0;
    if (!S.next(0, cur)) return;
    f32x4 acc[2][2][4][2];
#pragma unroll
    for (int a = 0; a < 2; ++a)
#pragma unroll
        for (int b = 0; b < 2; ++b)
#pragma unroll
            for (int m = 0; m < 4; ++m)
#pragma unroll
                for (int n = 0; n < 2; ++n) acc[a][b][m][n] = (f32x4){0.f, 0.f, 0.f, 0.f};
    bf16x8 At[4][2], B0[2][2], B1[2][2];
    const char* cA = (const char*)g.A + (size_t)cur.pm * tstep; const char* cB = (const char*)g.Bt + (size_t)cur.pn * tstep;
    S.a_ready(cur);
    if constexpr (SP2) {
        PG8_STAGE(PG8_SB(0, 0), cB, voffB); PG8_STAGE(PG8_SB(0, 1), cB + hstep, voffB); PG8_STAGE(PG8_SA(0, 0), cA, voffA); PG8_STAGE(PG8_SA(0, 1), cA + hstep, voffA);
        if (wr == 1) PG8_BAR;
        PG8_WAIT_V(2); PG8_BAR;
        PG8_STAGE(PG8_SB(1, 0), cB + kstep, voffB); PG8_STAGE(PG8_SA(1, 0), cA + kstep, voffA); PG8_STAGE(PG8_SB(1, 1), cB + hstep + kstep, voffB);
        PG8_WAIT_V(6); PG8_BAR;
    } else {
        PG8_STAGE(PG8_SB(0, 0), cB, voffB); PG8_STAGE(PG8_SA(0, 0), cA, voffA); PG8_STAGE(PG8_SB(0, 1), cB + hstep, voffB); PG8_STAGE(PG8_SA(0, 1), cA + hstep, voffA);
        if (wr == 1) PG8_BAR;
        PG8_WAIT_V(4); PG8_BAR;
        PG8_STAGE(PG8_SB(1, 0), cB + kstep, voffB); PG8_STAGE(PG8_SA(1, 0), cA + kstep, voffA); PG8_STAGE(PG8_SB(1, 1), cB + hstep + kstep, voffB);
        PG8_WAIT_V(6); PG8_BAR;
    }
    for (;;) {
        const bool has_next = S.next(ui + 1, nxt);
        const char* nA = has_next ? (const char*)g.A + (size_t)nxt.pm * tstep : cA; const char* nB = has_next ? (const char*)g.Bt + (size_t)nxt.pn * tstep : cB;
        for (int t = 0; t < nt; t += 2) {
            const bool last = (t == nt - 2);
            const char* a1 = cA + (size_t)(t + 1) * kstep;
            const char* a2 = last ? nA : cA + (size_t)(t + 2) * kstep; const char* b2 = last ? nB : cB + (size_t)(t + 2) * kstep;
            const char* a3 = a2 + kstep; const char* b3 = b2 + kstep;
            if (last && has_next) S.a_ready(nxt);
            if constexpr (SP2) {
            PG8_LDB(B0, 0, 0); PG8_LDB(B1, 0, 1); PG8_SCHED; PG8_LDA(At, 0, 0); PG8_STAGE(PG8_SA(1, 1), a1 + hstep, voffA);
            PG8_WAIT_V(8); PG8_WAIT_L(0); PG8_BAR; PG8_MMA(0, 0, At, B0); PG8_MMA(0, 1, At, B1); PG8_BAR; PG8_SCHED;
            PG8_LDA(At, 0, 1); PG8_STAGE(PG8_SB(0, 0), b2, voffB); PG8_STAGE(PG8_SB(0, 1), b2 + hstep, voffB); PG8_STAGE(PG8_SA(0, 0), a2, voffA);
            PG8_WAIT_V(8); PG8_WAIT_L(0); PG8_BAR; PG8_MMA(1, 0, At, B0); PG8_MMA(1, 1, At, B1); PG8_BAR; PG8_SCHED;
            PG8_LDB(B0, 1, 0); PG8_LDB(B1, 1, 1); PG8_SCHED; PG8_LDA(At, 1, 0); PG8_STAGE(PG8_SA(0, 1), a2 + hstep, voffA);
            PG8_WAIT_V(8); PG8_WAIT_L(0); PG8_BAR; PG8_MMA(0, 0, At, B0); PG8_MMA(0, 1, At, B1); PG8_BAR; PG8_SCHED;
            PG8_LDA(At, 1, 1); PG8_STAGE(PG8_SB(1, 0), b3, voffB); PG8_STAGE(PG8_SB(1, 1), b3 + hstep, voffB); PG8_STAGE(PG8_SA(1, 0), a3, voffA);
            PG8_WAIT_V(8); PG8_WAIT_L(0); PG8_BAR; PG8_MMA(1, 0, At, B0); PG8_MMA(1, 1, At, B1); PG8_BAR; PG8_SCHED;
            } else {
            PG8_LDB(B0, 0, 0); PG8_SCHED; PG8_LDA(At, 0, 0); PG8_STAGE(PG8_SA(1, 1), a1 + hstep, voffA);
            PG8_WAIT_L(8); PG8_BAR; PG8_WAIT_L(0); PG8_MMA(0, 0, At, B0); PG8_BAR; PG8_SCHED;
            PG8_LDB(B1, 0, 1); PG8_STAGE(PG8_SB(0, 0), b2, voffB);
            PG8_BAR; PG8_WAIT_L(0); PG8_MMA(0, 1, At, B1); PG8_BAR;
            PG8_LDA(At, 0, 1); PG8_STAGE(PG8_SA(0, 0), a2, voffA);
            PG8_BAR; PG8_WAIT_L(0); PG8_MMA(1, 0, At, B0); PG8_BAR; PG8_SCHED;
            PG8_STAGE(PG8_SB(0, 1), b2 + hstep, voffB);
            PG8_WAIT_V(6); PG8_BAR; PG8_MMA(1, 1, At, B1); PG8_BAR;
            PG8_LDB(B0, 1, 0); PG8_SCHED; PG8_LDA(At, 1, 0); PG8_STAGE(PG8_SA(0, 1), a2 + hstep, voffA);
            PG8_WAIT_L(8); PG8_BAR; PG8_WAIT_L(0); PG8_MMA(0, 0, At, B0); PG8_BAR; PG8_SCHED;
            PG8_LDB(B1, 1, 1); PG8_STAGE(PG8_SB(1, 0), b3, voffB);
            PG8_BAR; PG8_WAIT_L(0); PG8_MMA(0, 1, At, B1); PG8_BAR;
            PG8_LDA(At, 1, 1); PG8_STAGE(PG8_SA(1, 0), a3, voffA);
            PG8_BAR; PG8_WAIT_L(0); PG8_MMA(1, 0, At, B0); PG8_BAR; PG8_SCHED;
            PG8_STAGE(PG8_SB(1, 1), b3 + hstep, voffB);
            PG8_WAIT_V(6); PG8_BAR; PG8_MMA(1, 1, At, B1); PG8_BAR;
            }
        }
        if constexpr (ALIGN_EPI) { if (wr == 0) PG8_BAR; }
        if constexpr (!Epi::AFTER_DRAIN) { E(acc, cur, wr, wc, fr, fq); S.done(cur); }
        if (!has_next) break;
#pragma unroll
        for (int a = 0; a < 2; ++a)
#pragma unroll
            for (int b = 0; b < 2; ++b)
#pragma unroll
                for (int m = 0; m < 4; ++m)
#pragma unroll
                    for (int n = 0; n < 2; ++n) acc[a][b][m][n] = (f32x4){0.f, 0.f, 0.f, 0.f};
        cur = nxt; cA = nA; cB = nB; ++ui;
        if constexpr (ALIGN_EPI) { if (wr == 1) PG8_BAR; }
    }
    PG8_WAIT_V(0);
    if constexpr (!ALIGN_EPI) { if (wr == 0) PG8_BAR; }
    PG8_BAR;
    if constexpr (Epi::AFTER_DRAIN) { E.fused(acc, cur, wr, wc, fr, fq, lds, wid, lane); S.done(cur); }
#undef PG8_SA
#undef PG8_SB
#undef PG8_STAGE
#undef PG8_LDA
#undef PG8_LDB
#undef PG8_MMA
#undef PG8_WAIT_V
#undef PG8_WAIT_L
#undef PG8_BAR
#undef PG8_SCHED
}
}
#define GAS __attribute__((address_space(1)))
#define LAS __attribute__((address_space(3)))
typedef unsigned short bf16;
typedef unsigned v4u __attribute__((ext_vector_type(4)));
typedef float f32x4 __attribute__((ext_vector_type(4)));
typedef short bf16x8 __attribute__((ext_vector_type(8)));
typedef GAS unsigned gu32;
typedef GAS unsigned long long gu64;
#define RLX_AGENT __ATOMIC_RELAXED, __HIP_MEMORY_SCOPE_AGENT
#define LDS_WAIT() asm volatile("s_waitcnt lgkmcnt(0)" ::: "memory")
#define VM_WAIT() asm volatile("s_waitcnt vmcnt(0)" ::: "memory")
__device__ __forceinline__ unsigned long long rt() { return __builtin_amdgcn_s_memrealtime(); }
__device__ __forceinline__ unsigned f2bf(float f) { unsigned u = __builtin_bit_cast(unsigned, f); return (u + 0x7fffu + ((u >> 16) & 1u)) >> 16; }
__device__ __forceinline__ unsigned pk2(float lo, float hi) { return f2bf(lo) | (f2bf(hi) << 16); }

#define XB_TMO      128
#define XB_XCNT(j)  (256  + 64 * (j))
#define XB_XSUB(j)  (1280 + 64 * (j))
#define XB_XGEN(j)  (2304 + 64 * (j))
#define XB_TOP      3328
#define XB_TOPGEN   3392
#define XCD_BAR_WORDS 3456
#define XB_SPIN_CAP (1u << 18)

__device__ __forceinline__ unsigned xb_ld(unsigned* p)              { return __hip_atomic_load(p, __ATOMIC_RELAXED, __HIP_MEMORY_SCOPE_AGENT); }
__device__ __forceinline__ unsigned xb_add(unsigned* p, unsigned v) { return __hip_atomic_fetch_add(p, v, __ATOMIC_RELAXED, __HIP_MEMORY_SCOPE_AGENT); }
__device__ __forceinline__ unsigned xb_xcc_id() { return (unsigned)__builtin_amdgcn_s_getreg((3 << 11) | 20) & 0xFu; }
#define XB_SPIN(cond, bar) do { unsigned _sp = 0; while (cond) { __builtin_amdgcn_s_sleep(1); \
    if ((++_sp & 255u) == 0u) { if (xb_ld(&(bar)[XB_TMO])) break; if (_sp > XB_SPIN_CAP) { atomicAdd(&(bar)[XB_TMO], 1u); break; } } } } while (0)

struct XcdBarrier {
    unsigned* bar; unsigned x;
    volatile LAS unsigned* st;
};

__device__ __forceinline__ XcdBarrier xcd_barrier_post(unsigned* bar, volatile LAS unsigned* st) {
    XcdBarrier b; b.bar = bar; b.x = xb_xcc_id(); b.st = st;
    if (threadIdx.x == 0) (void)xb_add(&bar[XB_XCNT(b.x)], 1u);
    return b;
}
__device__ __forceinline__ void xcd_barrier_complete(unsigned* bar, unsigned x, unsigned& nloc, unsigned& nx) {
    const unsigned G = gridDim.x * gridDim.y * gridDim.z;
    unsigned sum, cnt, mine, sp = 0u;
    for (;;) {
        sum = 0u; cnt = 0u; mine = 0u;
#pragma unroll
        for (unsigned j = 0; j < 16; ++j) { const unsigned c = xb_ld(&bar[XB_XCNT(j)]); sum += c; cnt += (c > 0u) ? 1u : 0u; mine = (j == x) ? c : mine; }
        if (sum == G) break;
        __builtin_amdgcn_s_sleep(1);
        if ((++sp & 255u) == 0u) { if (xb_ld(&bar[XB_TMO])) break; if (sp > XB_SPIN_CAP) { atomicAdd(&bar[XB_TMO], 1u); break; } }
    }
    nloc = mine > 0u ? mine : 1u; nx = cnt > 0u ? cnt : 1u;
}

__device__ __forceinline__ void xcd_barrier(const XcdBarrier& b, const int tid_in) {
    asm volatile("s_waitcnt vmcnt(0)" ::: "memory");
    __syncthreads();
    if (tid_in == 0) {
        unsigned* bar = b.bar;
        __builtin_amdgcn_s_waitcnt(0);
        unsigned nloc = b.st[0], nx = b.st[1];
        if (nloc == 0u) { xcd_barrier_complete(bar, b.x, nloc, nx); b.st[0] = nloc; b.st[1] = nx; }
        const unsigned old = xb_add(&bar[XB_XSUB(b.x)], 1u);
        const unsigned gen = old / nloc;
        if (old + 1u == (gen + 1u) * nloc) {
            __builtin_amdgcn_fence(__ATOMIC_RELEASE, "agent");
            asm volatile("s_waitcnt vmcnt(0)" ::: "memory");
            const unsigned og = xb_add(&bar[XB_TOP], 1u);
            const unsigned tg = og / nx;
            if (og + 1u == (tg + 1u) * nx) xb_add(&bar[XB_TOPGEN], 1u);
            else XB_SPIN(xb_ld(&bar[XB_TOPGEN]) == tg, bar);
            __builtin_amdgcn_fence(__ATOMIC_ACQUIRE, "agent");
            xb_add(&bar[XB_XGEN(b.x)], 1u);
            asm volatile("s_waitcnt vmcnt(0)" ::: "memory");
        } else {
            XB_SPIN(xb_ld(&bar[XB_XGEN(b.x)]) == gen, bar);
            __builtin_amdgcn_fence(__ATOMIC_ACQUIRE, "agent");
            asm volatile("s_waitcnt vmcnt(0)" ::: "memory");
        }
    }
    __syncthreads();
}

#ifndef MK_ONE_LAUNCH
#define MK_ONE_LAUNCH 1
#endif
#ifndef PROBE_REP_MASK
#define PROBE_REP_MASK 0
#endif
#define REPS(bit) _Pragma("unroll") for (int rep_ = 0; rep_ < ((PROBE_REP_MASK >> (bit)) & 1) + 1; ++rep_)
constexpr int NWAVES = 8, NTHREADS = NWAVES * 64;
constexpr int BATCH = 8, SEQ = 2048, T = BATCH * SEQ, D = 1024, DEPTH = 2;
constexpr int NPROJ = 4352;
constexpr int N_INPUTS = 29;
constexpr int NADA = 6144;
constexpr float RMS_EPS = 1e-6f;
constexpr float QSCALE = 0.10206207261596575f * 1.4426950408889634f;
enum { I_X = 0, I_C, I_POS, I_WADA, I_BADA, I_N1G, I_WIN, I_QNG, I_WQUP, I_KVNG, I_WKVUP, I_WBA, I_CONVW, I_CONVB, I_WQM, I_WKM, I_WVM, I_BI, I_BF, I_MHG, I_MSKIP,
       I_WBM, I_WOUT, I_N2G, I_PWQ, I_PKEYS, I_PU, I_PV, I_FG };

constexpr size_t MiB = 1u << 20;
constexpr size_t WS_CTL = 0, CTL_ZERO_BYTES = 1 * MiB;
constexpr int CW_BAR = 4096;
constexpr int CW_XC = 8192;
constexpr size_t ADA_OFF = 256 * 1024;
constexpr size_t WS_COS = 1 * MiB, WS_SIN = 2 * MiB;
constexpr size_t WS_W = 3 * MiB, W_LAYER = 18 * MiB;
constexpr size_t WO_WIN = 0, WO_WQ = 8912896, WO_WKV = WO_WQ + 1179648, WO_WA = WO_WKV + 524288, WO_WM = WO_WA + 1048576, WO_WO = WO_WM + 1048576,
                 WO_PWQ = WO_WO + 2097152, WO_WQK = WO_PWQ + 2097152, WO_WV = WO_WQK + 1048576, WO_KEYB = WO_WV + 524288;
static_assert(WO_KEYB + 262144 <= W_LAYER, "weights fit");
constexpr size_t WS_X = 40 * MiB, WS_H = 104 * MiB, WS_QLAT = 136 * MiB, WS_KVLAT = 160 * MiB, WS_UM = 168 * MiB, WS_OPRE = 184 * MiB, WS_GA = 200 * MiB, WS_GM = 232 * MiB,
                 WS_SMALL = 264 * MiB, WS_RQ = 268 * MiB, WS_RKV = WS_RQ + 65536, WS_LOGI = WS_RQ + 262144, WS_LOGF = WS_RQ + 524288, WS_Q = 269 * MiB, WS_K = 293 * MiB,
                 WS_V = 317 * MiB, WS_CONV = 333 * MiB, WS_QKM = 349 * MiB, WS_VM = 381 * MiB, WS_AO = 397 * MiB, WS_OUTM = 413 * MiB, WS_U8 = 429 * MiB, WS_V8 = 445 * MiB, WS_END = 493 * MiB;
constexpr size_t WS_H8 = 493 * MiB, WS_XS = WS_RQ + 131072, WS_USC = WS_RQ + 786432;
constexpr size_t WS_END2 = 509 * MiB;
constexpr size_t WS_IDX = WS_UM, WS_GATE = WS_UM + 8 * MiB, WS_ACT = WS_OPRE;
constexpr size_t WS_SMALLP = WS_OUTM;
constexpr size_t WS_PQ = WS_QLAT, WS_MERGED = WS_QLAT;

constexpr int RING_OFF = 0, RING_BYTES = 131072;
constexpr int LDSCTL_OFF = RING_BYTES, MISC_OFF = LDSCTL_OFF + 320;
constexpr int LDS_BYTES = 147456;

typedef float f32x2v __attribute__((ext_vector_type(2)));
typedef unsigned u32x2 __attribute__((ext_vector_type(2)));

__device__ __forceinline__ float wave_sum(float v) {
#pragma unroll
    for (int o = 1; o < 64; o <<= 1) v += __shfl_xor(v, o);
    return v;
}
__device__ __forceinline__ float bflo(unsigned u) { return __uint_as_float(u << 16); }
__device__ __forceinline__ float bfhi(unsigned u) { return __uint_as_float(u & 0xffff0000u); }
__device__ __forceinline__ float sigm(float x) { return 1.f / (1.f + __expf(-x)); }
__device__ __forceinline__ float dot4(f32x4 a, f32x4 b) { return (a.x * b.x + a.y * b.y) + (a.z * b.z + a.w * b.w); }
__device__ __forceinline__ float gelu_erf(float x) { return 0.5f * x * (1.f + erff(x * 0.70710678118654752f)); }

struct EpiProj {
    static constexpr bool PERM = true, AFTER_DRAIN = false;
    bf16 *qlat, *kvlat, *um, *opre, *ga, *gm; float* small;
    __device__ __forceinline__ void operator()(const f32x4 (&acc)[2][2][4][2], const pg8::Unit& u, int wr, int wc, int fr, int fq) const {
        const int pn = u.pn; bf16* dst; int ld, cb; int mode = 0;
        if (pn < 3) { dst = qlat; ld = 768; cb = pn * 256; }
        else if (pn == 3) { dst = kvlat; ld = 256; cb = 0; }
        else if (pn < 6) { dst = um; ld = 512; cb = (pn - 4) * 256; }
        else if (pn < 8) { dst = opre; ld = 512; cb = (pn - 6) * 256; }
        else if (pn < 12) { dst = ga; ld = 1024; cb = (pn - 8) * 256; mode = 1; }
        else if (pn < 16) { dst = gm; ld = 1024; cb = (pn - 12) * 256; mode = 1; }
        else { dst = nullptr; ld = 0; cb = 0; mode = 2; }
        const int row0 = u.pm * 256 + wr * 64 + fr;
        if (mode == 2) {
            if (wc < 2) {
#pragma unroll
                for (int ai = 0; ai < 2; ++ai)
#pragma unroll
                    for (int m = 0; m < 4; ++m) { float* p = small + (size_t)(row0 + ai * 128 + m * 16) * 64 + wc * 32 + 8 * fq;
                        *(f32x4*)p = acc[ai][0][m][0]; *(f32x4*)(p + 4) = acc[ai][0][m][1]; }
            }
        } else {
#pragma unroll
            for (int ai = 0; ai < 2; ++ai)
#pragma unroll
                for (int m = 0; m < 4; ++m) { bf16* rowp = dst + (size_t)(row0 + ai * 128 + m * 16) * ld + cb + wc * 32 + 8 * fq;
#pragma unroll
                    for (int bj = 0; bj < 2; ++bj) { f32x4 v0 = acc[ai][bj][m][0], v1 = acc[ai][bj][m][1];
                        if (mode == 1) { v0 = (f32x4){sigm(v0[0]), sigm(v0[1]), sigm(v0[2]), sigm(v0[3])}; v1 = (f32x4){sigm(v1[0]), sigm(v1[1]), sigm(v1[2]), sigm(v1[3])}; }
                        v4u w; w.x = pk2(v0[0], v0[1]); w.y = pk2(v0[2], v0[3]); w.z = pk2(v1[0], v1[1]); w.w = pk2(v1[2], v1[3]);
                        *(v4u*)(rowp + bj * 128) = w; } }
        }
    }
};
struct EpiSmallPart {
    static constexpr bool PERM = true, AFTER_DRAIN = false;
    float* part;
    __device__ __forceinline__ void operator()(const f32x4 (&acc)[2][2][4][2], const pg8::Unit& u, int wr, int wc, int fr, int fq) const {
        if (wc >= 2) return;
        const int row0 = u.pm * 256 + wr * 64 + fr;
#pragma unroll
        for (int ai = 0; ai < 2; ++ai)
#pragma unroll
            for (int m = 0; m < 4; ++m) { float* p = part + (size_t)(row0 + ai * 128 + m * 16) * 64 + wc * 32 + 8 * fq;
                *(f32x4*)p = acc[ai][0][m][0]; *(f32x4*)(p + 4) = acc[ai][0][m][1]; }
    }
};
struct EpiQ {
    static constexpr bool PERM = true, AFTER_DRAIN = false;
    bf16* Q; const float* rq; const float* cosT; const float* sinT;
    __device__ __forceinline__ void operator()(const f32x4 (&acc)[2][2][4][2], const pg8::Unit& u, int wr, int wc, int fr, int fq) const {
        const int row0 = u.pm * 256 + wr * 64 + fr;
        int c0b[2], d0b[2];
#pragma unroll
        for (int bj = 0; bj < 2; ++bj) { c0b[bj] = u.pn * 256 + bj * 128 + wc * 32 + 8 * fq; d0b[bj] = c0b[bj] % 96; }
#pragma unroll
        for (int ai = 0; ai < 2; ++ai) {
            float rr[4]; f32x4 csv[4][2], snv[4][2];
#pragma unroll
            for (int m = 0; m < 4; ++m) { const int row = row0 + ai * 128 + m * 16; rr[m] = rq[row];
#pragma unroll
                for (int bj = 0; bj < 2; ++bj) { csv[m][bj] = (f32x4){1.f, 1.f, 1.f, 1.f}; snv[m][bj] = (f32x4){0.f, 0.f, 0.f, 0.f};
                    if (d0b[bj] >= 64) { const int j0 = (d0b[bj] - 64) >> 1; csv[m][bj] = *(const f32x4*)(cosT + (size_t)row * 16 + j0); snv[m][bj] = *(const f32x4*)(sinT + (size_t)row * 16 + j0); } } }
            __builtin_amdgcn_sched_barrier(0);
#pragma unroll
            for (int m = 0; m < 4; ++m) { const int row = row0 + ai * 128 + m * 16; const float r = rr[m];
#pragma unroll
                for (int bj = 0; bj < 2; ++bj) {
                    f32x4 v0 = acc[ai][bj][m][0] * r, v1 = acc[ai][bj][m][1] * r;
                    if (d0b[bj] >= 64) { const f32x4 cs = csv[m][bj], sn = snv[m][bj]; const f32x4 a0 = v0, a1 = v1;
                        v0[0] = a0[0] * cs[0] - a0[1] * sn[0]; v0[1] = a0[1] * cs[0] + a0[0] * sn[0];
                        v0[2] = a0[2] * cs[1] - a0[3] * sn[1]; v0[3] = a0[3] * cs[1] + a0[2] * sn[1];
                        v1[0] = a1[0] * cs[2] - a1[1] * sn[2]; v1[1] = a1[1] * cs[2] + a1[0] * sn[2];
                        v1[2] = a1[2] * cs[3] - a1[3] * sn[3]; v1[3] = a1[3] * cs[3] + a1[2] * sn[3]; }
                    v4u w; w.x = pk2(v0[0], v0[1]); w.y = pk2(v0[2], v0[3]); w.z = pk2(v1[0], v1[1]); w.w = pk2(v1[2], v1[3]);
                    *(v4u*)(Q + (size_t)row * 768 + c0b[bj]) = w; } }
        }
    }
};
struct EpiKV {
    static constexpr bool PERM = true, AFTER_DRAIN = false;
    bf16* K; bf16* V; const float* rkv;
    __device__ __forceinline__ void operator()(const f32x4 (&acc)[2][2][4][2], const pg8::Unit& u, int wr, int wc, int fr, int fq) const {
        const int row0 = u.pm * 256 + wr * 64 + fr;
        float rr[2][4];
#pragma unroll
        for (int ai = 0; ai < 2; ++ai)
#pragma unroll
            for (int m = 0; m < 4; ++m) rr[ai][m] = rkv[row0 + ai * 128 + m * 16];
#pragma unroll
        for (int ai = 0; ai < 2; ++ai)
#pragma unroll
            for (int m = 0; m < 4; ++m) { const int row = row0 + ai * 128 + m * 16; const float r = rr[ai][m];
#pragma unroll
                for (int bj = 0; bj < 2; ++bj) { const int c0 = u.pn * 256 + bj * 128 + wc * 32 + 8 * fq;
                    const f32x4 v0 = acc[ai][bj][m][0] * r, v1 = acc[ai][bj][m][1] * r;
                    bf16* dst = (c0 < 512) ? (K + (size_t)row * 768 + 96 * (c0 >> 6) + (c0 & 63)) : (V + (size_t)row * 512 + (c0 - 512));
                    v4u w; w.x = pk2(v0[0], v0[1]); w.y = pk2(v0[2], v0[3]); w.z = pk2(v1[0], v1[1]); w.w = pk2(v1[2], v1[3]);
                    *(v4u*)dst = w; } }
    }
};
struct EpiMerge {
    static constexpr bool PERM = true, AFTER_DRAIN = false;
    bf16* Mg; const bf16* gate; int first;
    __device__ __forceinline__ void operator()(const f32x4 (&acc)[2][2][4][2], const pg8::Unit& u, int wr, int wc, int fr, int fq) const {
        const int row0 = u.pm * 256 + wr * 64 + fr, cbase = u.pn * 256 + wc * 32 + 8 * fq;
#pragma unroll
        for (int ai = 0; ai < 2; ++ai) {
            v4u gq[4][2], oq[4][2];
#pragma unroll
            for (int m = 0; m < 4; ++m)
#pragma unroll
                for (int bj = 0; bj < 2; ++bj) { const size_t off = (size_t)(row0 + ai * 128 + m * 16) * 1024 + cbase + bj * 128;
                    gq[m][bj] = *(const v4u*)(gate + off); oq[m][bj] = first ? (v4u){0u, 0u, 0u, 0u} : *(const v4u*)(Mg + off); }
            __builtin_amdgcn_sched_barrier(0);
#pragma unroll
            for (int m = 0; m < 4; ++m)
#pragma unroll
                for (int bj = 0; bj < 2; ++bj) { const size_t off = (size_t)(row0 + ai * 128 + m * 16) * 1024 + cbase + bj * 128;
                    const v4u g = gq[m][bj], o = oq[m][bj];
                    f32x4 v0 = acc[ai][bj][m][0], v1 = acc[ai][bj][m][1];
                    v0[0] = v0[0] * bflo(g.x) + bflo(o.x); v0[1] = v0[1] * bfhi(g.x) + bfhi(o.x); v0[2] = v0[2] * bflo(g.y) + bflo(o.y); v0[3] = v0[3] * bfhi(g.y) + bfhi(o.y);
                    v1[0] = v1[0] * bflo(g.z) + bflo(o.z); v1[1] = v1[1] * bfhi(g.z) + bfhi(o.z); v1[2] = v1[2] * bflo(g.w) + bflo(o.w); v1[3] = v1[3] * bfhi(g.w) + bfhi(o.w);
                    v4u w; w.x = pk2(v0[0], v0[1]); w.y = pk2(v0[2], v0[3]); w.z = pk2(v1[0], v1[1]); w.w = pk2(v1[2], v1[3]);
                    *(v4u*)(Mg + off) = w; }
        }
    }
};
template <bool XBF> struct EpiResid {
    static constexpr bool PERM = true, AFTER_DRAIN = false;
    const void* xin; bf16* xout; const float* gate;
    __device__ __forceinline__ void operator()(const f32x4 (&acc)[2][2][4][2], const pg8::Unit& u, int wr, int wc, int fr, int fq) const {
        const int row0 = u.pm * 256 + wr * 64 + fr, b = (u.pm * 256) >> 11, cbase = u.pn * 256 + wc * 32 + 8 * fq;
        f32x4 gv[2][2];
#pragma unroll
        for (int bj = 0; bj < 2; ++bj) { const float* gp = gate + (size_t)b * NADA + cbase + bj * 128; gv[bj][0] = *(const f32x4*)gp; gv[bj][1] = *(const f32x4*)(gp + 4); }
#pragma unroll
        for (int ai = 0; ai < 2; ++ai) {
            f32x4 xv[4][2][2];
#pragma unroll
            for (int m = 0; m < 4; ++m)
#pragma unroll
                for (int bj = 0; bj < 2; ++bj) { const size_t off = (size_t)(row0 + ai * 128 + m * 16) * 1024 + cbase + bj * 128;
                    if (XBF) { const v4u w = *(const v4u*)((const bf16*)xin + off); xv[m][bj][0] = (f32x4){bflo(w.x), bfhi(w.x), bflo(w.y), bfhi(w.y)}; xv[m][bj][1] = (f32x4){bflo(w.z), bfhi(w.z), bflo(w.w), bfhi(w.w)}; }
                    else { xv[m][bj][0] = *(const f32x4*)((const float*)xin + off); xv[m][bj][1] = *(const f32x4*)((const float*)xin + off + 4); } }
            __builtin_amdgcn_sched_barrier(0);
#pragma unroll
            for (int m = 0; m < 4; ++m)
#pragma unroll
                for (int bj = 0; bj < 2; ++bj) { const size_t off = (size_t)(row0 + ai * 128 + m * 16) * 1024 + cbase + bj * 128;
                    const f32x4 o0 = xv[m][bj][0] + gv[bj][0] * acc[ai][bj][m][0], o1 = xv[m][bj][1] + gv[bj][1] * acc[ai][bj][m][1];
                    v4u w; w.x = pk2(o0[0], o0[1]); w.y = pk2(o0[2], o0[3]); w.z = pk2(o1[0], o1[1]); w.w = pk2(o1[2], o1[3]);
                    *(v4u*)(xout + off) = w; }
        }
    }
};

template <class Get> __device__ __forceinline__ void prep_tile(const Get& get, bf16* dst, int K, int k0, int n0, LAS float* scr, int lane) {
    float tv[32];
#pragma unroll
    for (int i = 0; i < 32; ++i) tv[i] = get(k0 + 2 * i + (lane >> 5), n0 + (lane & 31));
#pragma unroll
    for (int i = 0; i < 32; ++i) { const int kk = 2 * i + (lane >> 5); scr[kk * 33 + (lane & 31)] = tv[i]; }
    LDS_WAIT(); asm volatile("" ::: "memory");
    const int c = lane & 7;
#pragma unroll
    for (int j = 0; j < 4; ++j) { const int n = (lane >> 3) + 8 * j; const LAS float* s = scr + (8 * c) * 33 + n;
        v4u o; o.x = pk2(s[0 * 33], s[1 * 33]); o.y = pk2(s[2 * 33], s[3 * 33]); o.z = pk2(s[4 * 33], s[5 * 33]); o.w = pk2(s[6 * 33], s[7 * 33]);
        *(GAS v4u*)(dst + (size_t)(n0 + n) * K + k0 + 8 * c) = o; }
    LDS_WAIT(); asm volatile("" ::: "memory");
}
struct GetWin { const float* w; __device__ __forceinline__ float operator()(int k, int n) const {
    int sc; if (n < 1024) sc = n; else if (n < 2048) sc = n + 32; else if (n < 4096) sc = n + 40; else if (n < 4128) sc = n - 3072; else if (n < 4136) sc = n - 2048; else sc = -1;
    return sc < 0 ? 0.f : w[(size_t)k * 4136 + sc]; } };
struct GetWq { const float* w; const float* g; __device__ __forceinline__ float operator()(int k, int n) const {
    const int h = n / 96, dd = n % 96; const int e = dd - 64; const int sd = dd < 64 ? dd : 64 + (e >> 1) + 16 * (e & 1);
    return w[(size_t)k * 768 + h * 96 + sd] * g[k] * QSCALE; } };
struct GetWkv { const float* w; const float* g; __device__ __forceinline__ float operator()(int k, int n) const {
    const int nn = n & 511, h = nn >> 6, c = nn & 63; const int sc = h * 128 + c + ((n >= 512) ? 64 : 0);
    return w[(size_t)k * 1024 + sc] * g[k]; } };
struct GetPlain { const float* w; int N; __device__ __forceinline__ float operator()(int k, int n) const { return w[(size_t)k * N + n]; } };
struct GetWqk { const float* wq; const float* wk; __device__ __forceinline__ float operator()(int k, int n) const {
    const int c = n >> 9, part = (n >> 8) & 1, h = 2 * c + ((n >> 7) & 1), e = n & 127, kh = k >> 7, d = k & 127;
    if (kh != h) return 0.f;
    const size_t off = ((size_t)h * 128 + d) * 128 + e;
    return part ? wk[off] * 0.08838834764831845f : wq[off]; } };
struct GetWv { const float* wv; __device__ __forceinline__ float operator()(int k, int n) const {
    const int h = n >> 7, e = n & 127, kh = k >> 7, d = k & 127;
    return (kh != h) ? 0.f : wv[((size_t)h * 128 + d) * 128 + e]; } };

__device__ const float INV_FREQ[16] = { 1.0f, 0.5623413251903491f, 0.31622776601683794f, 0.1778279410038923f, 0.1f, 0.05623413251903491f, 0.031622776601683794f, 0.01778279410038923f,
    0.01f, 0.005623413251903491f, 0.0031622776601683794f, 0.001778279410038923f, 0.001f, 0.0005623413251903491f, 0.00031622776601683794f, 0.0001778279410038923f };

template <bool XBF> __device__ __forceinline__ void rowpass_norm_mod(const void* xin_, const float* g, const float* ada_shift, const float* ada_scale, bf16* hout, int gw, int NGW, int lane, unsigned char* h8 = nullptr, float* xs = nullptr) {
#define RP_LOAD(dst, row) { if (XBF) { const u32x2* p_ = (const u32x2*)((const bf16*)xin_ + (size_t)(row) * D) + lane; _Pragma("unroll") for (int j = 0; j < 4; ++j) { const u32x2 w_ = p_[64 * j]; dst[j] = (f32x4){bflo(w_.x), bfhi(w_.x), bflo(w_.y), bfhi(w_.y)}; } } \
                          else { const f32x4* p_ = (const f32x4*)((const float*)xin_ + (size_t)(row) * D) + lane; _Pragma("unroll") for (int j = 0; j < 4; ++j) dst[j] = p_[64 * j]; } }
    f32x4 vn[4];
    if (gw < T) RP_LOAD(vn, gw);
    for (int t = gw; t < T; t += NGW) {
        const int b = t >> 11;
        f32x4 v[4]; float s = 0.f;
#pragma unroll
        for (int j = 0; j < 4; ++j) { v[j] = vn[j]; s += dot4(v[j], v[j]); }
        { const int tn = (t + NGW < T) ? t + NGW : t;
          RP_LOAD(vn, tn); }
        const float r = rsqrtf(wave_sum(s) * (1.f / D) + RMS_EPS);
        unsigned long long* o8 = (unsigned long long*)(hout + (size_t)t * D) + lane;
        f32x4 ov[4]; float am = 0.f;
#pragma unroll
        for (int j = 0; j < 4; ++j) { const int col = 4 * lane + 256 * j;
            const f32x4 gg = *(const f32x4*)(g + col), sc = *(const f32x4*)(ada_scale + (size_t)b * NADA + col), sh = *(const f32x4*)(ada_shift + (size_t)b * NADA + col);
            const f32x4 o = v[j] * r * gg * (sc + 1.f) + sh; ov[j] = o;
            am = fmaxf(fmaxf(am, fmaxf(fabsf(o.x), fabsf(o.y))), fmaxf(fabsf(o.z), fabsf(o.w)));
            o8[64 * j] = (unsigned long long)pk2(o.x, o.y) | ((unsigned long long)pk2(o.z, o.w) << 32); }
        if (h8) {
#pragma unroll
            for (int o = 1; o < 64; o <<= 1) am = fmaxf(am, __shfl_xor(am, o));
            const float inv = am > 0.f ? 127.f / am : 0.f;
#pragma unroll
            for (int j = 0; j < 4; ++j) { const int q0 = (int)rintf(ov[j].x * inv), q1 = (int)rintf(ov[j].y * inv), q2 = (int)rintf(ov[j].z * inv), q3 = (int)rintf(ov[j].w * inv);
                ((unsigned*)(h8 + (size_t)t * D))[lane + 64 * j] = (unsigned)(q0 & 255) | ((unsigned)(q1 & 255) << 8) | ((unsigned)(q2 & 255) << 16) | ((unsigned)(q3 & 255) << 24); }
            if (lane == 0) xs[t] = am * (1.f / 127.f);
        }
    }
}
__device__ __forceinline__ void rowpass_final(const bf16* xin_, const float* g, float* out, int gw, int NGW, int lane) {
    constexpr bool XBF = true;
    f32x4 vn[4];
    if (gw < T) RP_LOAD(vn, gw);
    for (int t = gw; t < T; t += NGW) {
        f32x4 v[4]; float s = 0.f;
#pragma unroll
        for (int j = 0; j < 4; ++j) { v[j] = vn[j]; s += dot4(v[j], v[j]); }
        { const int tn = (t + NGW < T) ? t + NGW : t;
          RP_LOAD(vn, tn); }
        const float r = rsqrtf(wave_sum(s) * (1.f / D) + RMS_EPS);
        f32x4* o = (f32x4*)(out + (size_t)t * D) + lane;
#pragma unroll
        for (int j = 0; j < 4; ++j) { const f32x4 gg = *(const f32x4*)(g + 4 * lane + 256 * j); o[64 * j] = v[j] * r * gg; }
    }
}
#undef RP_LOAD
__device__ __forceinline__ void rowpass_mid(const bf16* qlat, const bf16* kvlat, const float* small, const float* smallp, const float* cosT, const float* sinT, const bf16* um,
                                            const float* conv_w, const float* conv_b, const float* b_i, const float* b_f,
                                            float* RQ, float* RKV, bf16* K, float* LOGI, float* LOGF, bf16* CONV, int gw, int NGW, int lane) {
    const int c0 = 8 * lane;
    f32x4 cw[4][2], cb[2];
#pragma unroll
    for (int j = 0; j < 4; ++j) { cw[j][0] = *(const f32x4*)(conv_w + j * 512 + c0); cw[j][1] = *(const f32x4*)(conv_w + j * 512 + c0 + 4); }
    cb[0] = *(const f32x4*)(conv_b + c0); cb[1] = *(const f32x4*)(conv_b + c0 + 4);
    const float bsel = (lane >= 32 && lane < 36) ? b_i[lane - 32] : (lane >= 36 && lane < 40) ? b_f[lane - 36] : 0.f;
    for (int tb = gw * 4; tb < T; tb += NGW * 4) {
        const int pos0 = tb & (SEQ - 1);
        u32x2 qv[4][3], kvv[4]; v4u uw[7]; float sv[4], cs[4], sn[4];
#pragma unroll
        for (int i = 0; i < 4; ++i) { const int t = tb + i; const u32x2* p = (const u32x2*)(qlat + (size_t)t * 768);
#pragma unroll
            for (int j = 0; j < 3; ++j) qv[i][j] = p[lane + 64 * j];
            kvv[i] = ((const u32x2*)(kvlat + (size_t)t * 256))[lane];
            sv[i] = 0.f;
            if (lane < 40) sv[i] = smallp ? ((smallp[(size_t)t * 64 + lane] + smallp[(size_t)(T + t) * 64 + lane]) + (smallp[(size_t)(2 * T + t) * 64 + lane] + smallp[(size_t)(3 * T + t) * 64 + lane]))
                                         : small[(size_t)t * 64 + lane];
            cs[i] = 0.f; sn[i] = 0.f; if (lane < 16) { cs[i] = cosT[(size_t)t * 16 + lane]; sn[i] = sinT[(size_t)t * 16 + lane]; } }
#pragma unroll
        for (int j = 0; j < 7; ++j) { uw[j] = (v4u){0u, 0u, 0u, 0u}; if (pos0 - 3 + j >= 0) uw[j] = *(const v4u*)(um + (size_t)(tb - 3 + j) * 512 + c0); }
#pragma unroll
        for (int i = 0; i < 4; ++i) { const int t = tb + i;
            float s = 0.f;
#pragma unroll
            for (int j = 0; j < 3; ++j) { const u32x2 w = qv[i][j]; const float a = bflo(w.x), b2 = bfhi(w.x), c = bflo(w.y), d = bfhi(w.y); s += (a * a + b2 * b2) + (c * c + d * d); }
            const float rq = rsqrtf(wave_sum(s) * (1.f / 768.f) + RMS_EPS);
            const u32x2 w = kvv[i]; const float a = bflo(w.x), b2 = bfhi(w.x), c = bflo(w.y), d = bfhi(w.y);
            const float rkv = rsqrtf(wave_sum((a * a + b2 * b2) + (c * c + d * d)) * (1.f / 256.f) + RMS_EPS);
            if (lane == 0) { RQ[t] = rq; RKV[t] = rkv; }
            const float x2 = __shfl(sv[i], (lane + 16) & 63);
            if (lane < 16) { const float x1 = sv[i]; const unsigned pk = pk2(x1 * cs[i] - x2 * sn[i], x2 * cs[i] + x1 * sn[i]);
#pragma unroll
                for (int h = 0; h < 8; ++h) ((unsigned*)(K + (size_t)t * 768 + 96 * h + 64))[lane] = pk; }
            else if (lane >= 32 && lane < 36) LOGI[(size_t)t * 4 + (lane - 32)] = sv[i] + bsel;
            else if (lane >= 36 && lane < 40) { const float x = sv[i] + bsel; LOGF[(size_t)t * 4 + (lane - 36)] = fminf(x, 0.f) - log1pf(expf(-fabsf(x))); }
            float acc[8];
            acc[0] = cb[0][0]; acc[1] = cb[0][1]; acc[2] = cb[0][2]; acc[3] = cb[0][3]; acc[4] = cb[1][0]; acc[5] = cb[1][1]; acc[6] = cb[1][2]; acc[7] = cb[1][3];
#pragma unroll
            for (int j = 0; j < 4; ++j) { const v4u u4 = uw[i + j];
                acc[0] += cw[j][0][0] * bflo(u4.x); acc[1] += cw[j][0][1] * bfhi(u4.x); acc[2] += cw[j][0][2] * bflo(u4.y); acc[3] += cw[j][0][3] * bfhi(u4.y);
                acc[4] += cw[j][1][0] * bflo(u4.z); acc[5] += cw[j][1][1] * bfhi(u4.z); acc[6] += cw[j][1][2] * bflo(u4.w); acc[7] += cw[j][1][3] * bfhi(u4.w); }
#pragma unroll
            for (int q = 0; q < 8; ++q) acc[q] = acc[q] * sigm(acc[q]);
            v4u o; o.x = pk2(acc[0], acc[1]); o.y = pk2(acc[2], acc[3]); o.z = pk2(acc[4], acc[5]); o.w = pk2(acc[6], acc[7]);
            *(v4u*)(CONV + (size_t)t * 512 + c0) = o; }
    }
}

typedef float f32x16 __attribute__((ext_vector_type(16)));
typedef short s16x4 __attribute__((ext_vector_type(4)));
typedef short v4i16_t __attribute__((ext_vector_type(4)));
typedef float f32x2_t __attribute__((ext_vector_type(2))); typedef __bf16 bf16x2_t __attribute__((ext_vector_type(2)));
__device__ __forceinline__ unsigned cvtpk(float lo, float hi) { f32x2_t v = {lo, hi}; bf16x2_t b = __builtin_convertvector(v, bf16x2_t); return __builtin_bit_cast(unsigned, b); }
__device__ __forceinline__ s16x4 vtr(const LAS unsigned char* p) { return __builtin_bit_cast(s16x4, __builtin_amdgcn_ds_read_tr16_b64_v4i16((LAS v4i16_t*)p)); }
__device__ __forceinline__ bf16x8 pack8(float a0, float a1, float a2, float a3, float a4, float a5, float a6, float a7) {
    v4u p; p.x = cvtpk(a0, a1); p.y = cvtpk(a2, a3); p.z = cvtpk(a4, a5); p.w = cvtpk(a6, a7); return __builtin_bit_cast(bf16x8, p); }
#define MFMA32(a, b, c) __builtin_amdgcn_mfma_f32_32x32x16_bf16((a), (b), (c), 0, 0, 0)
constexpr int AT_KB = 12288, AT_VB = 8192;
__device__ __forceinline__ void attn_mfma(const bf16* Q, const bf16* K, const bf16* V, bf16* AO, LAS unsigned char* lds, int bx, int G, int tid) {
    const int lane = tid & 63, wave = __builtin_amdgcn_readfirstlane(tid >> 6), r = lane & 31, hh = lane >> 5;
    const int i16 = lane & 15, q4 = i16 >> 2, p4 = i16 & 3, blk = (lane >> 4) & 1;
    const int vboff = (4 * hh + q4) * 64 + 32 * blk + 8 * p4;
    const int kr0 = tid / 12, kc0 = tid % 12, kr1 = (tid + 512) / 12, kc1 = (tid + 512) % 12, vr = tid >> 3, vc = tid & 7;
    const int klds0 = (kc0 >> 1) * 2048 + (kc0 & 1) * 1024 + kr0 * 16, klds1 = (kc1 >> 1) * 2048 + (kc1 & 1) * 1024 + kr1 * 16;
    const int vlds = (vc >> 2) * 4096 + (vr >> 4) * 1024 + ((vr >> 3) & 1) * 512 + (vr & 7) * 64 + (vc & 3) * 16;
    for (int pu = bx; pu < 256; pu += G) {
        const int bh = pu >> 2, b = bh >> 3, h = bh & 7;
        const bf16* kg = K + ((size_t)b * SEQ) * 768 + h * 96; const bf16* vg = V + ((size_t)b * SEQ) * 512 + h * 64;
        for (int half = 0; half < 2; ++half) {
            const int qb = half == 0 ? 7 - (pu & 3) : (pu & 3);
            const int q0w = qb * 256 + wave * 32, nkt = 4 * (qb + 1), kmax = (q0w + 31) >> 6;
            bf16x8 qf[6];
            { const bf16* qrow = Q + ((size_t)b * SEQ + q0w + r) * 768 + h * 96 + 8 * hh;
#pragma unroll
              for (int s = 0; s < 6; ++s) qf[s] = *(const bf16x8*)(qrow + 16 * s); }
            f32x16 o0, o1;
#pragma unroll
            for (int i = 0; i < 16; ++i) { o0[i] = 0.f; o1[i] = 0.f; }
            float m = 0.f, l = 0.f; f32x16 negm;
#pragma unroll
            for (int i = 0; i < 16; ++i) negm[i] = 0.f;
            v4u ka = *(const v4u*)(kg + (size_t)kr0 * 768 + kc0 * 8), kb2 = (v4u){0u, 0u, 0u, 0u}, va = *(const v4u*)(vg + (size_t)vr * 512 + vc * 8);
            if (tid < 256) kb2 = *(const v4u*)(kg + (size_t)kr1 * 768 + kc1 * 8);
            __syncthreads();
            *(LAS v4u*)(lds + klds0) = ka; if (tid < 256) *(LAS v4u*)(lds + klds1) = kb2; *(LAS v4u*)(lds + 2 * AT_KB + vlds) = va;
            __syncthreads();
            for (int kt = 0; kt < nkt; ++kt) {
                const int buf = kt & 1;
                if (kt + 1 < nkt) { const size_t k1 = (size_t)(kt + 1) * 64;
                    ka = *(const v4u*)(kg + (k1 + kr0) * 768 + kc0 * 8); if (tid < 256) kb2 = *(const v4u*)(kg + (k1 + kr1) * 768 + kc1 * 8); va = *(const v4u*)(vg + (k1 + vr) * 512 + vc * 8); }
                if (kt <= kmax) {
                    const LAS unsigned char* kb_ = lds + buf * AT_KB + hh * 1024 + r * 16; const LAS unsigned char* vb_ = lds + 2 * AT_KB + buf * AT_VB + vboff;
                    f32x16 s0, s1;
                    { bf16x8 kf0[6], kf1[6];
#pragma unroll
                      for (int s = 0; s < 6; ++s) { kf0[s] = *(const LAS bf16x8*)(kb_ + s * 2048); kf1[s] = *(const LAS bf16x8*)(kb_ + s * 2048 + 512); }
                      __builtin_amdgcn_sched_barrier(0);
                      s0 = MFMA32(kf0[0], qf[0], negm); s1 = MFMA32(kf1[0], qf[0], negm);
#pragma unroll
                      for (int s = 1; s < 6; ++s) { s0 = MFMA32(kf0[s], qf[s], s0); s1 = MFMA32(kf1[s], qf[s], s1); } }
                    if (kt * 64 + 63 > q0w) { const int qq = q0w + r - kt * 64;
#pragma unroll
                        for (int i = 0; i < 16; ++i) { const int key = (i & 3) + 8 * (i >> 2) + 4 * hh; if (key > qq) s0[i] = -INFINITY; if (key + 32 > qq) s1[i] = -INFINITY; } }
                    float mx = fmaxf(fmaxf(s0[0], s1[0]), fmaxf(s0[1], s1[1]));
#pragma unroll
                    for (int i = 2; i < 16; i += 2) mx = fmaxf(fmaxf(mx, fmaxf(s0[i], s1[i])), fmaxf(s0[i + 1], s1[i + 1]));
                    { auto r32 = __builtin_amdgcn_permlane32_swap(__float_as_uint(mx), __float_as_uint(mx), false, false); mx = fmaxf(__uint_as_float(r32[0]), __uint_as_float(r32[1])); }
                    if (kt == 0 || __builtin_amdgcn_ballot_w64(mx > 8.f) != 0ull) {
                        const float d = (kt == 0) ? mx : fmaxf(mx, 0.f), corr = (kt == 0) ? 0.f : __builtin_amdgcn_exp2f(-d);
                        m = (kt == 0) ? mx : m + d; l *= corr;
#pragma unroll
                        for (int i = 0; i < 16; ++i) { o0[i] *= corr; o1[i] *= corr; s0[i] -= d; s1[i] -= d; negm[i] = -m; } }
                    float ps = 0.f;
#pragma unroll
                    for (int i = 0; i < 16; ++i) { s0[i] = __builtin_amdgcn_exp2f(s0[i]); s1[i] = __builtin_amdgcn_exp2f(s1[i]); ps += s0[i] + s1[i]; }
                    l += ps;
                    bf16x8 pf[4];
                    pf[0] = pack8(s0[0], s0[1], s0[2], s0[3], s0[4], s0[5], s0[6], s0[7]); pf[1] = pack8(s0[8], s0[9], s0[10], s0[11], s0[12], s0[13], s0[14], s0[15]);
                    pf[2] = pack8(s1[0], s1[1], s1[2], s1[3], s1[4], s1[5], s1[6], s1[7]); pf[3] = pack8(s1[8], s1[9], s1[10], s1[11], s1[12], s1[13], s1[14], s1[15]);
                    { s16x4 vlo[8], vhi[8];
#pragma unroll
                      for (int ks = 0; ks < 4; ++ks) { vlo[ks] = vtr(vb_ + ks * 1024); vhi[ks] = vtr(vb_ + ks * 1024 + 512); vlo[4 + ks] = vtr(vb_ + 4096 + ks * 1024); vhi[4 + ks] = vtr(vb_ + 4096 + ks * 1024 + 512); }
                      __builtin_amdgcn_sched_barrier(0);
#pragma unroll
                      for (int ks = 0; ks < 4; ++ks) {
                          const bf16x8 a0 = (bf16x8){vlo[ks][0], vlo[ks][1], vlo[ks][2], vlo[ks][3], vhi[ks][0], vhi[ks][1], vhi[ks][2], vhi[ks][3]};
                          const bf16x8 a1 = (bf16x8){vlo[4 + ks][0], vlo[4 + ks][1], vlo[4 + ks][2], vlo[4 + ks][3], vhi[4 + ks][0], vhi[4 + ks][1], vhi[4 + ks][2], vhi[4 + ks][3]};
                          o0 = MFMA32(a0, pf[ks], o0); o1 = MFMA32(a1, pf[ks], o1); } }
                }
                if (kt + 1 < nkt) { LAS unsigned char* nb = lds + (buf ^ 1) * AT_KB; *(LAS v4u*)(nb + klds0) = ka; if (tid < 256) *(LAS v4u*)(nb + klds1) = kb2; *(LAS v4u*)(lds + 2 * AT_KB + (buf ^ 1) * AT_VB + vlds) = va; }
                __syncthreads();
            }
            const float inv = 1.f / (l + __shfl_xor(l, 32));
            bf16* orow = AO + ((size_t)b * SEQ + q0w + r) * 512 + h * 64 + 4 * hh;
#pragma unroll
            for (int g = 0; g < 4; ++g) { u32x2 w0, w1; w0.x = cvtpk(o0[4 * g] * inv, o0[4 * g + 1] * inv); w0.y = cvtpk(o0[4 * g + 2] * inv, o0[4 * g + 3] * inv);
                w1.x = cvtpk(o1[4 * g] * inv, o1[4 * g + 1] * inv); w1.y = cvtpk(o1[4 * g + 2] * inv, o1[4 * g + 3] * inv);
                *(u32x2*)(orow + 8 * g) = w0; *(u32x2*)(orow + 32 + 8 * g) = w1; }
        }
    }
}


constexpr int ML_KB = 16384, ML_VB = 16384, ML_BUF = 32768, ML_TAB = 3 * 32768;
__device__ __forceinline__ void mlstm_mfma(const bf16* QKM, const bf16* VM, const float* LOGI, const float* LOGF, const bf16* CONV, const bf16* OPRE, const float* ng, const float* skip,
                                           bf16* OUTM, LAS unsigned char* lds, int bx, int G, int tid) {
    const int lane = tid & 63, wave = __builtin_amdgcn_readfirstlane(tid >> 6), r = lane & 31, hh = lane >> 5;
    const int i16 = lane & 15, q4 = i16 >> 2, p4 = i16 & 3, blk = (lane >> 4) & 1;
    const int vboff = (4 * hh + q4) * 64 + 32 * blk + 8 * p4;
    int goff[4], loff[4];
#pragma unroll
    for (int q = 0; q < 4; ++q) { const int j = 4 * wave + q;
        if (j < 16) { goff[q] = lane * 1024 + 16 * (j >> 1) + 8 * (j & 1); loff[q] = (j >> 1) * 2048 + (j & 1) * 1024; }
        else { const int jv = j - 16, dq = jv >> 2, ks = jv & 3; goff[q] = (16 * ks + 8 * (lane >> 5) + ((lane >> 2) & 7)) * 512 + 32 * dq + 8 * (lane & 3); loff[q] = ML_KB + dq * 4096 + ks * 1024; } }
    const bool kwave = wave < 4;
#define ML_DMA(tile, bufi) do { _Pragma("unroll") for (int q_ = 0; q_ < 4; ++q_) { \
        const bf16* src_ = kwave ? (kg + (size_t)(tile) * 64 * 1024 + goff[q_]) : (vg + (size_t)(tile) * 64 * 512 + goff[q_]); \
        __builtin_amdgcn_global_load_lds((const unsigned*)src_, (LAS unsigned*)(lds + (bufi) * ML_BUF + loff[q_]), 16, 0, 0); } } while (0)
    LAS float* Ftab = (LAS float*)(lds + ML_TAB); LAS float* Ctab = Ftab + 2048; LAS float* wtot = Ctab + 2048;
    constexpr float L2E = 1.4426950408889634f;
    for (int pu = bx; pu < 256; pu += G) {
        const int bh = pu >> 3, p = pu & 7, b = bh >> 2, h = bh & 3;
        __syncthreads();
        { float f4[4], i4[4];
#pragma unroll
          for (int e = 0; e < 4; ++e) { const size_t row = (size_t)b * SEQ + tid * 4 + e; f4[e] = LOGF[row * 4 + h]; i4[e] = LOGI[row * 4 + h]; }
          f4[1] += f4[0]; f4[2] += f4[1]; f4[3] += f4[2];
          float x = f4[3];
          x += __uint_as_float(__builtin_amdgcn_update_dpp(0, __float_as_uint(x), 0x111, 0xf, 0xf, true)); x += __uint_as_float(__builtin_amdgcn_update_dpp(0, __float_as_uint(x), 0x112, 0xf, 0xf, true));
          x += __uint_as_float(__builtin_amdgcn_update_dpp(0, __float_as_uint(x), 0x114, 0xf, 0xf, true)); x += __uint_as_float(__builtin_amdgcn_update_dpp(0, __float_as_uint(x), 0x118, 0xf, 0xf, true));
          { const float t0 = __uint_as_float(__builtin_amdgcn_readlane(__float_as_uint(x), 15)), t1 = __uint_as_float(__builtin_amdgcn_readlane(__float_as_uint(x), 31)), t2 = __uint_as_float(__builtin_amdgcn_readlane(__float_as_uint(x), 47));
            const int row = lane >> 4; x += (row >= 1 ? t0 : 0.f) + (row >= 2 ? t1 : 0.f) + (row >= 3 ? t2 : 0.f); }
          if (lane == 63) wtot[wave] = x;
          __syncthreads();
          float base = x - f4[3];
          for (int w = 0; w < wave; ++w) base += wtot[w];
#pragma unroll
          for (int e = 0; e < 4; ++e) { const float F = base + f4[e]; Ftab[tid * 4 + e] = F * L2E; Ctab[tid * 4 + e] = (i4[e] - F) * L2E; } }
        __syncthreads();
        const int grp = wave >> 2, w4 = wave & 3;
        const int q0w = (grp == 0 ? 128 * p : 128 * (15 - p)) + 32 * w4, kmax = (q0w + 31) >> 6, nkt = 2 * (16 - p);
        const size_t trow = (size_t)b * SEQ + q0w + r;
        bf16x8 qf[8];
        { const bf16* qrow = QKM + trow * 1024 + h * 128 + 8 * hh;
#pragma unroll
          for (int s = 0; s < 8; ++s) qf[s] = *(const bf16x8*)(qrow + 16 * s); }
        const float Ft = Ftab[q0w + r], Ft0 = Ftab[q0w];
        LAS float* wt = Ctab + 2048 + 64 + wave * 64;
        f32x16 o[4];
#pragma unroll
        for (int d = 0; d < 4; ++d)
#pragma unroll
            for (int i = 0; i < 16; ++i) o[d][i] = 0.f;
        float den = 0.f;
        const bf16* kg = QKM + ((size_t)b * SEQ) * 1024 + 512 + h * 128; const bf16* vg = VM + ((size_t)b * SEQ) * 512 + h * 128;
        ML_DMA(0, 0);
        if (nkt > 1) { ML_DMA(1, 1); asm volatile("s_waitcnt vmcnt(4)" ::: "memory"); } else asm volatile("s_waitcnt vmcnt(0)" ::: "memory");
        asm volatile("s_waitcnt lgkmcnt(0)" ::: "memory"); __builtin_amdgcn_s_barrier(); asm volatile("" ::: "memory");
        for (int kt = 0; kt < nkt; ++kt) {
            const int buf = kt % 3;
            if (kt + 2 < nkt) ML_DMA(kt + 2, (kt + 2) % 3);
            if (kt <= kmax) {
                const LAS unsigned char* kb_ = lds + buf * ML_BUF + hh * 1024 + r * 16; const LAS unsigned char* vb_ = lds + buf * ML_BUF + ML_KB + vboff;
                f32x16 s0, s1;
#pragma unroll
                for (int i = 0; i < 16; ++i) { s0[i] = 0.f; s1[i] = 0.f; }
#pragma unroll
                for (int sh = 0; sh < 2; ++sh) { bf16x8 kf0[4], kf1[4];
#pragma unroll
                  for (int s = 0; s < 4; ++s) { kf0[s] = *(const LAS bf16x8*)(kb_ + (4 * sh + s) * 2048); kf1[s] = *(const LAS bf16x8*)(kb_ + (4 * sh + s) * 2048 + 512); }
                  __builtin_amdgcn_sched_barrier(0);
#pragma unroll
                  for (int s = 0; s < 4; ++s) { s0 = MFMA32(kf0[s], qf[4 * sh + s], s0); s1 = MFMA32(kf1[s], qf[4 * sh + s], s1); } }
                const int qq = q0w + r - kt * 64;
                const bool diag = kt * 64 + 63 > q0w;
                wt[lane] = __builtin_amdgcn_exp2f(Ctab[kt * 64 + lane] + Ft0);
                LDS_WAIT();
                const LAS float* ct = wt + 4 * hh;
                float ps = 0.f;
#pragma unroll
                for (int g = 0; g < 4; ++g) { const f32x4 c0v = *(const LAS f32x4*)(ct + 8 * g), c1v = *(const LAS f32x4*)(ct + 32 + 8 * g);
#pragma unroll
                    for (int e = 0; e < 4; ++e) { const int i = 4 * g + e, key = e + 8 * g + 4 * hh;
                        float w0 = c0v[e], w1 = c1v[e];
                        if (diag) { w0 = (key <= qq) ? w0 : 0.f; w1 = (key + 32 <= qq) ? w1 : 0.f; }
                        s0[i] *= w0; s1[i] *= w1; ps += s0[i] + s1[i]; } }
                den += ps;
                bf16x8 pf[4];
                pf[0] = pack8(s0[0], s0[1], s0[2], s0[3], s0[4], s0[5], s0[6], s0[7]); pf[1] = pack8(s0[8], s0[9], s0[10], s0[11], s0[12], s0[13], s0[14], s0[15]);
                pf[2] = pack8(s1[0], s1[1], s1[2], s1[3], s1[4], s1[5], s1[6], s1[7]); pf[3] = pack8(s1[8], s1[9], s1[10], s1[11], s1[12], s1[13], s1[14], s1[15]);
#pragma unroll
                for (int ks = 0; ks < 4; ++ks) { s16x4 vlo[4], vhi[4];
#pragma unroll
                    for (int d = 0; d < 4; ++d) { vlo[d] = vtr(vb_ + d * 4096 + ks * 1024); vhi[d] = vtr(vb_ + d * 4096 + ks * 1024 + 512); }
                    __builtin_amdgcn_sched_barrier(0);
#pragma unroll
                    for (int d = 0; d < 4; ++d) { const s16x4 lo = vlo[d], hi = vhi[d];
                        const bf16x8 av = (bf16x8){lo[0], lo[1], lo[2], lo[3], hi[0], hi[1], hi[2], hi[3]};
                        o[d] = MFMA32(av, pf[ks], o[d]); } }
            }
            if (kt + 2 < nkt) asm volatile("s_waitcnt vmcnt(4)" ::: "memory"); else asm volatile("s_waitcnt vmcnt(0)" ::: "memory");
            asm volatile("s_waitcnt lgkmcnt(0)" ::: "memory"); __builtin_amdgcn_s_barrier(); asm volatile("" ::: "memory");
        }
        const float kap = __builtin_amdgcn_exp2f(Ft - Ft0);
        const float dt = (den + __shfl_xor(den, 32)) * kap;
        const float inv = kap / fmaxf(fabsf(dt), 1.f);
        float sm = 0.f;
#pragma unroll
        for (int d = 0; d < 4; ++d)
#pragma unroll
            for (int i = 0; i < 16; ++i) { o[d][i] *= inv; sm += o[d][i]; }
        sm += __shfl_xor(sm, 32);
        const float mu = sm * (1.f / 128.f);
        float vs = 0.f;
#pragma unroll
        for (int d = 0; d < 4; ++d)
#pragma unroll
            for (int i = 0; i < 16; ++i) { const float dlt = o[d][i] - mu; vs += dlt * dlt; }
        vs += __shfl_xor(vs, 32);
        const float rstd = rsqrtf(vs * (1.f / 128.f) + RMS_EPS);
#pragma unroll
        for (int d = 0; d < 4; ++d)
#pragma unroll
            for (int g = 0; g < 4; ++g) { const int ch = h * 128 + 32 * d + 8 * g + 4 * hh; const size_t off = trow * 512 + ch;
                const u32x2 cv = *(const u32x2*)(CONV + off), ov = *(const u32x2*)(OPRE + off); const f32x4 gg = *(const f32x4*)(ng + ch), sk = *(const f32x4*)(skip + ch);
                const float y0 = sigm(bflo(ov.x)) * ((o[d][4 * g] - mu) * rstd * gg[0] + sk[0] * bflo(cv.x)), y1 = sigm(bfhi(ov.x)) * ((o[d][4 * g + 1] - mu) * rstd * gg[1] + sk[1] * bfhi(cv.x));
                const float y2 = sigm(bflo(ov.y)) * ((o[d][4 * g + 2] - mu) * rstd * gg[2] + sk[2] * bflo(cv.y)), y3 = sigm(bfhi(ov.y)) * ((o[d][4 * g + 3] - mu) * rstd * gg[3] + sk[3] * bfhi(cv.y));
                u32x2 w; w.x = cvtpk(y0, y1); w.y = cvtpk(y2, y3); *(u32x2*)(OUTM + off) = w; }
    }
#undef ML_DMA
}

template <int N> __device__ __forceinline__ void bitonic_sort_desc(float (&v)[N]) {
#pragma unroll
    for (int k = 2; k <= N; k <<= 1)
#pragma unroll
        for (int j = k >> 1; j > 0; j >>= 1)
#pragma unroll
            for (int i = 0; i < N; ++i) { const int l = i ^ j; if (l > i) { const bool desc = ((i & k) == 0); const float a = v[i], b = v[l], hi = fmaxf(a, b), lo = fminf(a, b); v[i] = desc ? hi : lo; v[l] = desc ? lo : hi; } }
}
__device__ __forceinline__ void top16_merge(float (&a)[16], const float (&b)[16]) {
#pragma unroll
    for (int i = 0; i < 16; ++i) a[i] = fmaxf(a[i], b[15 - i]);
#pragma unroll
    for (int j = 8; j > 0; j >>= 1)
#pragma unroll
        for (int i = 0; i < 16; ++i) { const int l = i ^ j; if (l > i) { const float x = a[i], y = a[l]; a[i] = fmaxf(x, y); a[l] = fminf(x, y); } }
}
constexpr int PE_EIDX = 0, PE_EGATE = 16384, PE_KEYT = 32768;
__device__ __forceinline__ void peer_route(const bf16* PQ, const bf16* KEYB, int* IDX, float* GATE, LAS unsigned char* lds, int bx, int G, int tid) {
    const int lane = tid & 63, wave = __builtin_amdgcn_readfirstlane(tid >> 6), r = lane & 31, hh = lane >> 5;
    LAS unsigned char* keyt = lds + PE_KEYT + (wave * 32 + r) * 32;
    for (int grp = bx; grp < T / 32; grp += G) {
        const int t0 = grp * 32;
        { const int h = wave;
          int rq = r; asm volatile("" : "+v"(rq));
          float top[2][16];
#pragma unroll
          for (int p = 0; p < 2; ++p) {
              bf16x8 qf[4];
              { const bf16* qrow = PQ + (size_t)(t0 + rq) * 1024 + h * 128 + p * 64 + 8 * hh;
#pragma unroll
                for (int s = 0; s < 4; ++s) qf[s] = *(const bf16x8*)(qrow + 16 * s); }
              const bf16* kb = KEYB + ((size_t)(h * 2 + p) * 128 + rq) * 64 + 8 * hh;
              float sv[4][16];
#pragma unroll
              for (int kt = 0; kt < 4; ++kt) { f32x16 acc;
#pragma unroll
                  for (int i = 0; i < 16; ++i) acc[i] = 0.f;
#pragma unroll
                  for (int s = 0; s < 4; ++s) { const bf16x8 a = *(const bf16x8*)(kb + (size_t)(32 * kt) * 64 + 16 * s); acc = MFMA32(a, qf[s], acc); }
#pragma unroll
                  for (int i = 0; i < 16; ++i) { const unsigned key = (unsigned)(32 * kt + (i & 3) + 8 * (i >> 2)) + 4u * (unsigned)hh; sv[kt][i] = __uint_as_float((__float_as_uint(acc[i]) & ~127u) | key); } }
              bitonic_sort_desc<16>(sv[0]); bitonic_sort_desc<16>(sv[1]); bitonic_sort_desc<16>(sv[2]); bitonic_sort_desc<16>(sv[3]);
              top16_merge(sv[0], sv[1]); top16_merge(sv[2], sv[3]); top16_merge(sv[0], sv[2]);
              float pr[16];
#pragma unroll
              for (int i = 0; i < 16; ++i) { auto r32 = __builtin_amdgcn_permlane32_swap(__float_as_uint(sv[0][i]), __float_as_uint(sv[0][i]), false, false); pr[i] = __uint_as_float(hh ? r32[0] : r32[1]); }
              top16_merge(sv[0], pr);
#pragma unroll
              for (int i = 0; i < 16; ++i) top[p][i] = sv[0][i];
          }
          if (hh == 0) {
#pragma unroll
              for (int i = 0; i < 16; ++i) { keyt[i] = (unsigned char)(__float_as_uint(top[0][i]) & 127u); keyt[16 + i] = (unsigned char)(__float_as_uint(top[1][i]) & 127u); } }
          float cs[4][16];
#define PSUM(a, b) __uint_as_float((__float_as_uint(top[0][a] + top[1][b]) & ~255u) | (unsigned)((a) * 16 + (b)))
#pragma unroll
          for (int b2 = 0; b2 < 16; ++b2) cs[0][b2] = PSUM(0, b2);
#pragma unroll
          for (int b2 = 0; b2 < 8; ++b2) cs[1][b2] = PSUM(1, b2);
#pragma unroll
          for (int a2 = 8; a2 < 16; ++a2) cs[1][a2] = PSUM(a2, 0);
#pragma unroll
          for (int b2 = 0; b2 < 5; ++b2) cs[2][b2] = PSUM(2, b2);
#pragma unroll
          for (int b2 = 0; b2 < 4; ++b2) cs[2][5 + b2] = PSUM(3, b2);
#pragma unroll
          for (int b2 = 0; b2 < 3; ++b2) cs[2][9 + b2] = PSUM(4, b2);
          cs[2][12] = PSUM(5, 0); cs[2][13] = PSUM(5, 1); cs[2][14] = PSUM(6, 0); cs[2][15] = PSUM(6, 1);
          cs[3][0] = PSUM(7, 0); cs[3][1] = PSUM(7, 1);
#undef PSUM
#pragma unroll
          for (int i = 2; i < 16; ++i) cs[3][i] = -3.0e38f;
          bitonic_sort_desc<16>(cs[0]); bitonic_sort_desc<16>(cs[1]); bitonic_sort_desc<16>(cs[2]); bitonic_sort_desc<16>(cs[3]);
          top16_merge(cs[0], cs[1]); top16_merge(cs[2], cs[3]); top16_merge(cs[0], cs[2]);
          LDS_WAIT();
          float ev[16], den = 0.f; const float mx = __uint_as_float(__float_as_uint(cs[0][0]) & ~255u);
#pragma unroll
          for (int k = 0; k < 16; ++k) { ev[k] = __expf(__uint_as_float(__float_as_uint(cs[0][k]) & ~255u) - mx); den += ev[k]; }
          const float rden = 1.f / den;
          if (hh == 0) {
#pragma unroll
              for (int k = 0; k < 16; ++k) { const unsigned code = __float_as_uint(cs[0][k]) & 255u; const int e = (int)keyt[code >> 4] * 128 + (int)keyt[16 + (code & 15u)];
                  IDX[(size_t)(t0 + r) * 128 + h * 16 + k] = e; GATE[(size_t)(t0 + r) * 128 + h * 16 + k] = ev[k] * rden; } }
        }
    }
}
__device__ __forceinline__ void peer_partition(const unsigned* xc_cnt, volatile LAS unsigned* MISC, int bx, int G, int& vx, int& rank, int& nb) {
    bool use_xcc = MK_ONE_LAUNCH != 0; unsigned mine = 0u; const unsigned myx = MISC[13];
    if (use_xcc) { unsigned sum = 0u;
#pragma unroll
        for (unsigned j = 0; j < 8; ++j) { const unsigned c = __hip_atomic_load(xc_cnt + 64 * j, __ATOMIC_RELAXED, __HIP_MEMORY_SCOPE_AGENT); use_xcc = use_xcc && (c > 0u); sum += c; mine = (j == myx) ? c : mine; }
        use_xcc = use_xcc && (sum == (unsigned)G); }
    if (use_xcc) { vx = (int)myx; rank = (int)MISC[12]; nb = (int)mine; } else { vx = bx & 7; rank = bx >> 3; nb = (G - vx + 7) >> 3; }
    vx = __builtin_amdgcn_readfirstlane(vx); rank = __builtin_amdgcn_readfirstlane(rank); nb = __builtin_amdgcn_readfirstlane(nb);
}
__device__ __forceinline__ void peer_u_i8(const unsigned char* H8, const float* XS, const int* IDX, const unsigned char* U8, const f32x2v* SC2, float* ACT, LAS float* wscr, int vx, int rank, int nb, int tid) {
    const int lane = tid & 63, wave = __builtin_amdgcn_readfirstlane(tid >> 6), g4 = lane >> 4, c16 = lane & 15;
    const int tstride = nb * 8;
    LAS int* clist = (LAS int*)wscr;
    LAS unsigned char* xs = (LAS unsigned char*)(wscr + 512);
    const unsigned long long lt = (1ull << lane) - 1ull;
    const unsigned char* ubase = U8 + 16 * c16;
    int ni[8];
    { const int tb = rank * 8 + wave;
#pragma unroll
      for (int j = 0; j < 4; ++j) { const int tj = tb + j * tstride; const bool ok = tj < T; ni[2 * j] = ok ? IDX[(size_t)tj * 128 + lane] : 0x7fffffff; ni[2 * j + 1] = ok ? IDX[(size_t)tj * 128 + 64 + lane] : 0x7fffffff; } }
    for (int tb = rank * 8 + wave; tb < T; tb += 4 * tstride) {
        int ntot = 0;
#pragma unroll
        for (int j = 0; j < 4; ++j) { const int e0 = ni[2 * j], e1 = ni[2 * j + 1]; const bool f0 = (e0 >> 11) == vx, f1 = (e1 >> 11) == vx;
            const unsigned long long m0 = __ballot(f0), m1 = __ballot(f1); const int n0 = __popcll(m0);
            if (f0) clist[ntot + __popcll(m0 & lt)] = (j << 21) | (e0 << 7) | lane;
            if (f1) clist[ntot + n0 + __popcll(m1 & lt)] = (j << 21) | (e1 << 7) | (64 + lane);
            ntot += n0 + __popcll(m1); }
        v4u xr[4]; float sx[4];
#pragma unroll
        for (int j = 0; j < 4; ++j) { const int tj = tb + j * tstride, tl = tj < T ? tj : tb; xr[j] = *(const v4u*)(H8 + (size_t)tl * 1024 + 16 * lane); sx[j] = XS[tl]; }
        { const int tn = tb + 4 * tstride;
#pragma unroll
          for (int j = 0; j < 4; ++j) { const int tj = tn + j * tstride; const bool ok = tj < T; ni[2 * j] = ok ? IDX[(size_t)tj * 128 + lane] : 0x7fffffff; ni[2 * j + 1] = ok ? IDX[(size_t)tj * 128 + 64 + lane] : 0x7fffffff; } }
        if (ntot == 0) continue;
#pragma unroll
        for (int j = 0; j < 4; ++j) *(LAS v4u*)(xs + j * 1024 + 16 * lane) = xr[j];
        LDS_WAIT();
        const int last = ntot - 1, nit = (ntot + 3) >> 2, nit4 = (nit + 3) >> 2;
        v4u ub[4][4]; f32x2v us[4]; int up[4];
#pragma unroll
        for (int k = 0; k < 3; ++k) { const int p = min(4 * k + g4, last); const int pk = clist[p]; up[k] = pk; const unsigned eo = (unsigned)((pk >> 7) & 16383) * 1024u; us[k] = SC2[(pk >> 7) & 16383];
#pragma unroll
            for (int jj = 0; jj < 4; ++jj) ub[k][jj] = *(const v4u*)(ubase + eo + 256 * jj); }
        int dsel = 0, psel = 0; f32x2v ssel = (f32x2v){0.f, 0.f}; bool vsel = false;
#pragma unroll 1
        for (int o = 0; o < nit4; ++o) {
#pragma unroll
            for (int k = 0; k < 4; ++k) {
                const int i = 4 * o + k;
                { const int p = min(4 * (i + 3) + g4, last); const int pk = clist[p]; up[(k + 3) & 3] = pk; const unsigned eo = (unsigned)((pk >> 7) & 16383) * 1024u; us[(k + 3) & 3] = SC2[(pk >> 7) & 16383];
#pragma unroll
                  for (int jj = 0; jj < 4; ++jj) ub[(k + 3) & 3][jj] = *(const v4u*)(ubase + eo + 256 * jj); }
                const LAS unsigned char* xp = xs + (up[k] >> 21) * 1024 + 16 * c16;
                v4u xq[4];
#pragma unroll
                for (int jj = 0; jj < 4; ++jj) xq[jj] = *(const LAS v4u*)(xp + 256 * jj);
                int a0 = 0, a1 = 0, a2 = 0, a3 = 0;
#pragma unroll
                for (int jj = 0; jj < 4; ++jj) {
                    a0 = __builtin_amdgcn_sdot4((int)xq[jj].x, (int)ub[k][jj].x, a0, false); a1 = __builtin_amdgcn_sdot4((int)xq[jj].y, (int)ub[k][jj].y, a1, false);
                    a2 = __builtin_amdgcn_sdot4((int)xq[jj].z, (int)ub[k][jj].z, a2, false); a3 = __builtin_amdgcn_sdot4((int)xq[jj].w, (int)ub[k][jj].w, a3, false); }
                int d = (a0 + a1) + (a2 + a3);
                d += __builtin_amdgcn_update_dpp(0, d, 0x128, 0xf, 0xf, false); d += __builtin_amdgcn_update_dpp(0, d, 0x124, 0xf, 0xf, false);
                d += __builtin_amdgcn_update_dpp(0, d, 0x122, 0xf, 0xf, false); d += __builtin_amdgcn_update_dpp(0, d, 0x121, 0xf, 0xf, false);
                if ((i & 15) == c16) { dsel = d; ssel = us[k]; psel = up[k]; vsel = 4 * i + g4 <= last; }
                if (k == 3 && ((o & 3) == 3 || o == nit4 - 1)) {
                    if (vsel) { const int j = psel >> 21; const float sxj = j == 0 ? sx[0] : j == 1 ? sx[1] : j == 2 ? sx[2] : sx[3];
                        ACT[(size_t)(tb + j * tstride) * 128 + (psel & 127)] = gelu_erf((float)dsel * sxj * ssel.x) * ssel.y; }
                    vsel = false; }
            }
        }
        LDS_WAIT();
    }
}
__device__ __forceinline__ void peer_v(const int* IDX, const float* ACT, const float* GATE, const unsigned char* V8, const float* gate2, const bf16* Xin, bf16* Xout, LAS float* wscr,
                                       int vx, int rank, int nb, int tid) {
    const int lane = tid & 63, wave = __builtin_amdgcn_readfirstlane(tid >> 6), g8 = lane >> 3, c8 = lane & 7;
    const int tstride = nb * 16;
    LAS int* wl = (LAS int*)wscr; LAS unsigned char* wqb = (LAS unsigned char*)(wscr + 128);
    const unsigned char* vbase = V8 + (size_t)(vx >> 1) * (2 * MiB) + 16 * c8;
    const int col = 256 * (vx >> 1) + 32 * c8;
    const int wqo0 = (lane & 7) * 16 + (lane >> 3), wqo1 = wqo0 + 8;
    const int t0 = (rank * 8 + wave) * 2 + (vx & 1);
    if (t0 >= T) return;
    const int tlast = t0 + ((T - 1 - t0) / tstride) * tstride;
#define PV_STAGE(tt, I0, I1, A0, A1, VV, WQ4, SW) { \
        float am_ = fmaxf(fabsf(A0), fabsf(A1));   \
        am_ = fmaxf(am_, __uint_as_float(__builtin_amdgcn_update_dpp(0, __float_as_uint(am_), 0x128, 0xf, 0xf, false))); am_ = fmaxf(am_, __uint_as_float(__builtin_amdgcn_update_dpp(0, __float_as_uint(am_), 0x124, 0xf, 0xf, false))); \
        am_ = fmaxf(am_, __uint_as_float(__builtin_amdgcn_update_dpp(0, __float_as_uint(am_), 0x122, 0xf, 0xf, false))); am_ = fmaxf(am_, __uint_as_float(__builtin_amdgcn_update_dpp(0, __float_as_uint(am_), 0x121, 0xf, 0xf, false))); \
        am_ = fmaxf(fmaxf(__uint_as_float(__builtin_amdgcn_readlane(__float_as_uint(am_), 0)), __uint_as_float(__builtin_amdgcn_readlane(__float_as_uint(am_), 16))), \
                    fmaxf(__uint_as_float(__builtin_amdgcn_readlane(__float_as_uint(am_), 32)), __uint_as_float(__builtin_amdgcn_readlane(__float_as_uint(am_), 48)))); \
        const float inv_ = am_ > 0.f ? 127.f / am_ : 0.f; SW = am_ * (1.f / 127.f); \
        wl[lane] = I0; wl[64 + lane] = I1; wqb[wqo0] = (unsigned char)((int)rintf(A0 * inv_) & 255); wqb[wqo1] = (unsigned char)((int)rintf(A1 * inv_) & 255); \
        LDS_WAIT(); \
        _Pragma("unroll") for (int i_ = 0; i_ < 16; ++i_) { const int e_ = wl[8 * i_ + g8]; VV[i_] = *(const v4u*)(vbase + (size_t)(unsigned)(e_ * 128)); } \
        WQ4 = *(const LAS v4u*)(wqb + g8 * 16); LDS_WAIT(); }
#define PV_META(tt, I0, I1, A0, A1) { const size_t o_ = (size_t)(tt) * 128; I0 = IDX[o_ + lane]; I1 = IDX[o_ + 64 + lane]; A0 = ACT[o_ + lane] * GATE[o_ + lane]; A1 = ACT[o_ + 64 + lane] * GATE[o_ + 64 + lane]; }
    int i0, i1, j0, j1; float a0, a1, b0, b1;
    v4u vv[16], vvn[16], wq4, wq4n; float sw, swn;
    PV_META(t0, i0, i1, a0, a1);
    PV_STAGE(t0, i0, i1, a0, a1, vvn, wq4n, swn);
    { const int t1 = min(t0 + tstride, tlast); PV_META(t1, i0, i1, a0, a1); }
    for (int t = t0; t < T; t += tstride) {
        const int b = t >> 11, tn = min(t + tstride, tlast), tn2 = min(t + 2 * tstride, tlast);
#pragma unroll
        for (int i = 0; i < 16; ++i) vv[i] = vvn[i];
        wq4 = wq4n; sw = swn;
        PV_META(tn2, j0, j1, b0, b1);
        const u32x2 xw1 = *(const u32x2*)(Xin + (size_t)t * 1024 + col + 4 * g8); const f32x4 g21 = *(const f32x4*)(gate2 + (size_t)b * NADA + col + 4 * g8);
        PV_STAGE(tn, i0, i1, a0, a1, vvn, wq4n, swn);
        i0 = j0; i1 = j1; a0 = b0; a1 = b1;
        int acc[32], accw = 0;
#pragma unroll
        for (int i = 0; i < 32; ++i) acc[i] = 0;
#pragma unroll
        for (int q = 0; q < 4; ++q) { const int wq = (int)(q == 0 ? wq4.x : q == 1 ? wq4.y : q == 2 ? wq4.z : wq4.w);
            accw = __builtin_amdgcn_sdot4(wq, 0x01010101, accw, false);
#pragma unroll
            for (int d = 0; d < 4; ++d) {
                const unsigned ra = d == 0 ? vv[4 * q].x : d == 1 ? vv[4 * q].y : d == 2 ? vv[4 * q].z : vv[4 * q].w, rb = d == 0 ? vv[4 * q + 1].x : d == 1 ? vv[4 * q + 1].y : d == 2 ? vv[4 * q + 1].z : vv[4 * q + 1].w;
                const unsigned rc = d == 0 ? vv[4 * q + 2].x : d == 1 ? vv[4 * q + 2].y : d == 2 ? vv[4 * q + 2].z : vv[4 * q + 2].w, rd = d == 0 ? vv[4 * q + 3].x : d == 1 ? vv[4 * q + 3].y : d == 2 ? vv[4 * q + 3].z : vv[4 * q + 3].w;
#pragma unroll
                for (int h = 0; h < 2; ++h) {
                    const unsigned a = (h ? (ra >> 4) : ra) & 0x0f0f0f0fu, bb = (h ? (rb >> 4) : rb) & 0x0f0f0f0fu, c = (h ? (rc >> 4) : rc) & 0x0f0f0f0fu, dd = (h ? (rd >> 4) : rd) & 0x0f0f0f0fu;
                    const unsigned ab_lo = __builtin_amdgcn_perm(bb, a, 0x05010400u), ab_hi = __builtin_amdgcn_perm(bb, a, 0x07030602u), cd_lo = __builtin_amdgcn_perm(dd, c, 0x05010400u), cd_hi = __builtin_amdgcn_perm(dd, c, 0x07030602u);
                    acc[8 * d + 0 + h] = __builtin_amdgcn_sdot4((int)__builtin_amdgcn_perm(cd_lo, ab_lo, 0x05040100u), wq, acc[8 * d + 0 + h], false);
                    acc[8 * d + 2 + h] = __builtin_amdgcn_sdot4((int)__builtin_amdgcn_perm(cd_lo, ab_lo, 0x07060302u), wq, acc[8 * d + 2 + h], false);
                    acc[8 * d + 4 + h] = __builtin_amdgcn_sdot4((int)__builtin_amdgcn_perm(cd_hi, ab_hi, 0x05040100u), wq, acc[8 * d + 4 + h], false);
                    acc[8 * d + 6 + h] = __builtin_amdgcn_sdot4((int)__builtin_amdgcn_perm(cd_hi, ab_hi, 0x07060302u), wq, acc[8 * d + 6 + h], false); } } }
#define PV_RED(x) { x += __builtin_amdgcn_update_dpp(0, x, 0x128, 0xf, 0xf, false); \
        { auto r16 = __builtin_amdgcn_permlane16_swap((unsigned)x, (unsigned)x, false, false); x = (int)(r16[0] + r16[1]); } \
        { auto r32 = __builtin_amdgcn_permlane32_swap((unsigned)x, (unsigned)x, false, false); x = (int)(r32[0] + r32[1]); } }
#pragma unroll
        for (int i = 0; i < 32; ++i) PV_RED(acc[i]);
        PV_RED(accw);
#undef PV_RED
        { const int off8 = 8 * accw;
          int s0 = acc[0], s1 = acc[1], s2 = acc[2], s3 = acc[3];
#pragma unroll
          for (int k = 1; k < 8; ++k) { s0 = g8 == k ? acc[4 * k] : s0; s1 = g8 == k ? acc[4 * k + 1] : s1; s2 = g8 == k ? acc[4 * k + 2] : s2; s3 = g8 == k ? acc[4 * k + 3] : s3; }
          const f32x4 xo = (f32x4){bflo(xw1.x), bfhi(xw1.x), bflo(xw1.y), bfhi(xw1.y)} + g21 * ((f32x4){(float)(s0 - off8), (float)(s1 - off8), (float)(s2 - off8), (float)(s3 - off8)} * sw);
          u32x2 w; w.x = pk2(xo[0], xo[1]); w.y = pk2(xo[2], xo[3]); *(u32x2*)(Xout + (size_t)t * 1024 + col + 4 * g8) = w; }
    }
#undef PV_STAGE
#undef PV_META
}

constexpr int PH_PER_LAYER = 12, N_PHASES = 1 + DEPTH * PH_PER_LAYER + 1;
struct Args { const void* in[N_INPUTS]; float* out; unsigned char* ws; int ph_lo, ph_hi; };
static_assert(sizeof(Args) == N_INPUTS * 8 + 24, "Args has no padding");

constexpr int PTAB_OFF = LDSCTL_OFF + 1024;
__device__ __forceinline__ unsigned char* getp(LAS unsigned char* lds, int i) {
    asm volatile("" ::: "memory");
    const u32x2 v = *(volatile LAS u32x2*)(lds + PTAB_OFF + 8 * i);
    const unsigned lo = __builtin_amdgcn_readfirstlane(v.x), hi = __builtin_amdgcn_readfirstlane(v.y);
    GAS unsigned char* g = (GAS unsigned char*)(((unsigned long long)hi << 32) | lo);
    return (unsigned char*)g;
}
#define INP(i) ((const float*)getp(lds, (i)))
#define WSB() getp(lds, 30)

#define IN(k) (lo <= (k) && (k) < hi)
#define SEAM(k) do { if (MK_ONE_LAUNCH && IN(k) && IN((k) + 1)) { XcdBarrier b_; b_.bar = (unsigned*)(WSB() + WS_CTL) + CW_BAR; b_.x = xb_xcc_id(); b_.st = MISC + 8; REPS(11) xcd_barrier(b_, (wave_s << 6) | (int)__lane_id()); } } while (0)
#define PH_BEGIN(lv) int tidq; asm volatile("v_mbcnt_lo_u32_b32 %0, -1, 0\n\tv_mbcnt_hi_u32_b32 %0, -1, %0" : "=v"(tidq)); tidq |= wave_s << 6;     \
    asm volatile("" : "+v"(tidq)); const int lane = tidq & 63, wave = __builtin_amdgcn_readfirstlane(tidq >> 6); \
    int G = gridDim.x, bx = blockIdx.x, l = (lv); asm volatile("" : "+s"(G), "+s"(bx), "+s"(l)); const int gw = bx * NWAVES + wave, NGW = G * NWAVES; \
    unsigned char* ws = WSB(); LAS float* wscr = (LAS float*)(lds + RING_OFF + wave * 16384); (void)lane; (void)gw; (void)NGW; (void)ws; (void)wscr; (void)l


constexpr int PI_W = 4512, PI_K = 512, PI_U = 2048, PI_V = 2048, PI_TOTAL = PI_W + PI_K + PI_U + PI_V;
template <int NR> __device__ __forceinline__ void prep_rows_i8(const float* src, size_t src_stride, unsigned char* dst, size_t dst_stride, float* scale_slot  , int lane) {
    f32x4 v[NR][4];
#pragma unroll
    for (int rr = 0; rr < NR; ++rr) { const f32x4* s = (const f32x4*)(src + rr * src_stride) + lane * 4;
#pragma unroll
        for (int j = 0; j < 4; ++j) v[rr][j] = s[j]; }
#pragma unroll
    for (int rr = 0; rr < NR; ++rr) {
        float am = 0.f;
#pragma unroll
        for (int j = 0; j < 4; ++j) am = fmaxf(fmaxf(am, fmaxf(fabsf(v[rr][j][0]), fabsf(v[rr][j][1]))), fmaxf(fabsf(v[rr][j][2]), fabsf(v[rr][j][3])));
#pragma unroll
        for (int o = 1; o < 64; o <<= 1) am = fmaxf(am, __shfl_xor(am, o));
        const float inv = am > 0.f ? 127.f / am : 0.f;
#define Q4(x) ((unsigned)((int)rintf((x)[0] * inv) & 255) | ((unsigned)((int)rintf((x)[1] * inv) & 255) << 8) | ((unsigned)((int)rintf((x)[2] * inv) & 255) << 16) | ((unsigned)((int)rintf((x)[3] * inv) & 255) << 24))
        v4u o; o.x = Q4(v[rr][0]); o.y = Q4(v[rr][1]); o.z = Q4(v[rr][2]); o.w = Q4(v[rr][3]);
#undef Q4
        *(v4u*)(dst + rr * dst_stride) = o;
        if (lane == 0) scale_slot[2 * rr] = am * (1.f / 127.f);
    }
}
template <int NR> __device__ __forceinline__ void prep_rows_i4(const float* src, size_t src_stride, unsigned char* dst, size_t dst_stride, float* scale_slot  , int lane) {
    f32x4 v[NR][4];
#pragma unroll
    for (int rr = 0; rr < NR; ++rr) { const f32x4* s = (const f32x4*)(src + rr * src_stride) + lane * 4;
#pragma unroll
        for (int j = 0; j < 4; ++j) v[rr][j] = s[j]; }
#pragma unroll
    for (int rr = 0; rr < NR; ++rr) {
        float am = 0.f, ss = 0.f;
#pragma unroll
        for (int j = 0; j < 4; ++j) { am = fmaxf(fmaxf(am, fmaxf(fabsf(v[rr][j][0]), fabsf(v[rr][j][1]))), fmaxf(fabsf(v[rr][j][2]), fabsf(v[rr][j][3]))); ss += dot4(v[rr][j], v[rr][j]); }
#pragma unroll
        for (int o = 1; o < 64; o <<= 1) { am = fmaxf(am, __shfl_xor(am, o)); ss += __shfl_xor(ss, o); }
        am = fminf(am, 2.7f * sqrtf(ss * (1.f / 1024.f)));
        const float inv = am > 0.f ? 7.f / am : 0.f;
#define N4(x) ((unsigned)((int)fminf(fmaxf(rintf((x) * inv), -7.f), 7.f) + 8))
#define B4(x, y) (N4(x) | (N4(y) << 4))
        u32x2 o;
        o.x = B4(v[rr][0][0], v[rr][0][1]) | (B4(v[rr][0][2], v[rr][0][3]) << 8) | (B4(v[rr][1][0], v[rr][1][1]) << 16) | (B4(v[rr][1][2], v[rr][1][3]) << 24);
        o.y = B4(v[rr][2][0], v[rr][2][1]) | (B4(v[rr][2][2], v[rr][2][3]) << 8) | (B4(v[rr][3][0], v[rr][3][1]) << 16) | (B4(v[rr][3][2], v[rr][3][3]) << 24);
#undef B4
#undef N4
        *(u32x2*)(dst + rr * dst_stride) = o;
        if (lane == 0) scale_slot[2 * rr] = am * (1.f / 7.f);
    }
}
__device__ __forceinline__ void prep_item(LAS unsigned char* lds, unsigned char* ws, LAS float* wscr, int l, int r, int lane) {
    constexpr int I_WIN_ = 16 * 136, I_WQ_ = 12 * 24, I_WKV_ = 4 * 32, I_WA_ = 8 * 32, I_WM_ = 8 * 32, I_WO_ = 16 * 32, I_PW_ = 16 * 32, I_WQK_ = 8 * 32, I_WV_ = 8 * 16;
    static_assert(I_WIN_ + I_WQ_ + I_WKV_ + I_WA_ + I_WM_ + I_WO_ + I_PW_ + I_WQK_ + I_WV_ == PI_W, "weight items");
    unsigned char* wl = ws + WS_W + (size_t)l * W_LAYER;
    if (r < PI_W) {
        if (r < I_WIN_) { const GetWin g{INP(I_WIN) + (size_t)l * D * 4136}; prep_tile(g, (bf16*)(wl + WO_WIN), 1024, 64 * (r / 136), 32 * (r % 136), wscr, lane); return; } r -= I_WIN_;
        if (r < I_WQ_) { const GetWq g{INP(I_WQUP) + (size_t)l * 768 * 768, INP(I_QNG) + l * 768}; prep_tile(g, (bf16*)(wl + WO_WQ), 768, 64 * (r / 24), 32 * (r % 24), wscr, lane); return; } r -= I_WQ_;
        if (r < I_WKV_) { const GetWkv g{INP(I_WKVUP) + (size_t)l * 256 * 1024, INP(I_KVNG) + l * 256}; prep_tile(g, (bf16*)(wl + WO_WKV), 256, 64 * (r / 32), 32 * (r % 32), wscr, lane); return; } r -= I_WKV_;
        if (r < I_WA_) { const GetPlain g{INP(I_WBA) + (size_t)l * 512 * 1024, 1024}; prep_tile(g, (bf16*)(wl + WO_WA), 512, 64 * (r / 32), 32 * (r % 32), wscr, lane); return; } r -= I_WA_;
        if (r < I_WM_) { const GetPlain g{INP(I_WBM) + (size_t)l * 512 * 1024, 1024}; prep_tile(g, (bf16*)(wl + WO_WM), 512, 64 * (r / 32), 32 * (r % 32), wscr, lane); return; } r -= I_WM_;
        if (r < I_WO_) { const GetPlain g{INP(I_WOUT) + (size_t)l * 1024 * 1024, 1024}; prep_tile(g, (bf16*)(wl + WO_WO), 1024, 64 * (r / 32), 32 * (r % 32), wscr, lane); return; } r -= I_WO_;
        if (r < I_PW_) { const GetPlain g{INP(I_PWQ) + (size_t)l * 1024 * 1024, 1024}; prep_tile(g, (bf16*)(wl + WO_PWQ), 1024, 64 * (r / 32), 32 * (r % 32), wscr, lane); return; } r -= I_PW_;
        if (r < I_WQK_) { const GetWqk g{INP(I_WQM) + (size_t)l * 65536, INP(I_WKM) + (size_t)l * 65536}; prep_tile(g, (bf16*)(wl + WO_WQK), 512, 64 * (r / 32), 32 * (r % 32), wscr, lane); return; } r -= I_WQK_;
        { const GetWv g{INP(I_WVM) + (size_t)l * 65536}; prep_tile(g, (bf16*)(wl + WO_WV), 512, 64 * (r / 16), 32 * (r % 16), wscr, lane); }
        return; }
    r -= PI_W;
    if (r < PI_K) { const int o = (r * 64 + lane) * 4;
        const f32x4 v = *(const f32x4*)(INP(I_PKEYS) + (size_t)l * 131072 + o); u32x2 w; w.x = pk2(v[0], v[1]); w.y = pk2(v[2], v[3]);
        *(u32x2*)(wl + WO_KEYB + (size_t)o * 2) = w; return; }
    r -= PI_K;
    float* sc2 = (float*)(ws + WS_USC);
    if (r < PI_U) { const float* pu = INP(I_PU) + (size_t)l * 16777216;
        for (int rr = 0; rr < 8; rr += 8) { const int er = r * 8 + rr; prep_rows_i8<8>(pu + (size_t)er * 1024, 1024, ws + WS_U8 + (size_t)l * 32 * MiB + (size_t)er * 1024 + 16 * lane, 1024, sc2 + 2 * (l * 16384 + er), lane); }
        return; }
    r -= PI_U;
    { const float* pv = INP(I_PV) + (size_t)l * 16777216;
      for (int rr = 0; rr < 8; rr += 8) { const int er = r * 8 + rr;
          prep_rows_i4<8>(pv + (size_t)er * 1024, 1024, ws + WS_V8 + (size_t)l * 32 * MiB + (size_t)(lane >> 4) * (2 * MiB) + (size_t)er * 128 + 8 * (lane & 15), 128, sc2 + 2 * (l * 16384 + er) + 1, lane); } }
}
template <int lv> __device__ __forceinline__ void layer_phases(LAS unsigned char* lds, volatile LAS unsigned* MISC, const int lo, const int hi, const int wave_s) {
        const int P = 1 + lv * PH_PER_LAYER;
#define WL() (ws + WS_W + (size_t)l * W_LAYER)
#define ADAL() ((const float*)(ws + ADA_OFF) + (size_t)l * 8 * NADA)
#define XA() WSP(bf16, WS_X)
#define XB() (WSP(bf16, WS_X) + (size_t)T * D)
#define WSP(type, off) ((type*)(ws + (off)))
        if (IN(P + 0)) REPS(1) { PH_BEGIN(lv);
            if (lv == 0) rowpass_norm_mod<false>(INP(I_X), INP(I_N1G) + l * D, ADAL() + 0, ADAL() + 1024, WSP(bf16, WS_H), gw, NGW, lane);
            else rowpass_norm_mod<true>(XB(), INP(I_N1G) + l * D, ADAL() + 0, ADAL() + 1024, WSP(bf16, WS_H), gw, NGW, lane); }
        SEAM(P + 0);
        if (IN(P + 1)) REPS(2) { PH_BEGIN(lv);
            if (G == 256) {
                { pg8::Gemm g{WSP(bf16, WS_H), (const bf16*)(WL() + WO_WIN), T, 4096, D}; pg8::StaticOrder S; S.init(T, 4096, G, bx);
                  EpiProj E{WSP(bf16, WS_QLAT), WSP(bf16, WS_KVLAT), WSP(bf16, WS_UM), WSP(bf16, WS_OPRE), WSP(bf16, WS_GA), WSP(bf16, WS_GM), WSP(float, WS_SMALL)};
                  pg8::gemm_phase<EpiProj, pg8::StaticOrder, true, true>(lds + RING_OFF, g, S, E, tidq); }
                { const int kq = bx >> 6;
                  pg8::Gemm g{WSP(bf16, WS_H) + 256 * kq, (const bf16*)(WL() + WO_WIN) + (size_t)4096 * 1024 + 256 * kq, T, 256, 256, 1024}; pg8::StaticOrder S; S.init(T, 256, 64, bx & 63);
                  EpiSmallPart E{WSP(float, WS_SMALLP) + (size_t)kq * T * 64};
                  pg8::gemm_phase<EpiSmallPart, pg8::StaticOrder, true, true>(lds + RING_OFF, g, S, E, tidq); }
            } else {
                pg8::Gemm g{WSP(bf16, WS_H), (const bf16*)(WL() + WO_WIN), T, NPROJ, D}; pg8::StaticOrder S; S.init(T, NPROJ, G, bx);
                EpiProj E{WSP(bf16, WS_QLAT), WSP(bf16, WS_KVLAT), WSP(bf16, WS_UM), WSP(bf16, WS_OPRE), WSP(bf16, WS_GA), WSP(bf16, WS_GM), WSP(float, WS_SMALL)};
                pg8::gemm_phase<EpiProj, pg8::StaticOrder, true, true>(lds + RING_OFF, g, S, E, tidq);
            }
        }
        SEAM(P + 1);
        if (IN(P + 2)) REPS(3) { PH_BEGIN(lv);
            rowpass_mid(WSP(bf16, WS_QLAT), WSP(bf16, WS_KVLAT), WSP(float, WS_SMALL), (G == 256) ? WSP(float, WS_SMALLP) : (const float*)nullptr, WSP(float, WS_COS), WSP(float, WS_SIN), WSP(bf16, WS_UM), INP(I_CONVW) + l * 4 * 512, INP(I_CONVB) + l * 512,
                        INP(I_BI) + l * 4, INP(I_BF) + l * 4, WSP(float, WS_RQ), WSP(float, WS_RKV), WSP(bf16, WS_K), WSP(float, WS_LOGI), WSP(float, WS_LOGF), WSP(bf16, WS_CONV), gw, NGW, lane); }
        SEAM(P + 2);
        if (IN(P + 3)) REPS(4) {
            { PH_BEGIN(lv); pg8::Gemm g{WSP(bf16, WS_QLAT), (const bf16*)(WL() + WO_WQ), T, 768, 768}; pg8::StaticOrder S; S.init(T, 768, G, bx);
              EpiQ E{WSP(bf16, WS_Q), WSP(float, WS_RQ), WSP(float, WS_COS), WSP(float, WS_SIN)}; pg8::gemm_phase<EpiQ, pg8::StaticOrder, true, true>(lds + RING_OFF, g, S, E, tidq); }
            { PH_BEGIN(lv); pg8::Gemm g{WSP(bf16, WS_KVLAT), (const bf16*)(WL() + WO_WKV), T, 1024, 256}; pg8::StaticOrder S; S.init(T, 1024, G, bx);
              EpiKV E{WSP(bf16, WS_K), WSP(bf16, WS_V), WSP(float, WS_RKV)}; pg8::gemm_phase<EpiKV, pg8::StaticOrder, true, true>(lds + RING_OFF, g, S, E, tidq); }
            { PH_BEGIN(lv); const int c = (G == 256) ? (bx >> 7) : 0;
              pg8::Gemm g{WSP(bf16, WS_CONV) + 256 * c, (const bf16*)(WL() + WO_WQK) + (size_t)(512 * c) * 512 + 256 * c, T, 512, 256, 512}; pg8::StaticOrder S;
              if (G == 256) S.init(T, 512, 128, bx & 127); else S.init(T, 512, G, bx);
              pg8::EpiBf16<0> E{WSP(bf16, WS_QKM) + 256 * c, 1024, nullptr, 256, 512, 1.f}; pg8::gemm_phase<pg8::EpiBf16<0>, pg8::StaticOrder, true, true>(lds + RING_OFF, g, S, E, tidq); }
            { PH_BEGIN(lv); if (G != 256) {
              pg8::Gemm g{WSP(bf16, WS_CONV) + 256, (const bf16*)(WL() + WO_WQK) + (size_t)512 * 512 + 256, T, 512, 256, 512}; pg8::StaticOrder S; S.init(T, 512, G, bx);
              pg8::EpiBf16<0> E{WSP(bf16, WS_QKM) + 256, 1024, nullptr, 256, 512, 1.f}; pg8::gemm_phase<pg8::EpiBf16<0>, pg8::StaticOrder, true, true>(lds + RING_OFF, g, S, E, tidq); } }
            { PH_BEGIN(lv);
              pg8::Gemm g{WSP(bf16, WS_UM), (const bf16*)(WL() + WO_WV), T, 256, 256, 512}; pg8::StaticOrder S;
              if (G == 256) S.init(T, 256, 64, bx >= 192 ? bx - 192 : (1 << 20)); else S.init(T, 256, G, bx);
              pg8::EpiBf16<0> E{WSP(bf16, WS_VM), 512, nullptr, 0, 0, 1.f}; pg8::gemm_phase<pg8::EpiBf16<0>, pg8::StaticOrder, true, true>(lds + RING_OFF, g, S, E, tidq); }
            { PH_BEGIN(lv);
              pg8::Gemm g{WSP(bf16, WS_UM) + 256, (const bf16*)(WL() + WO_WV) + (size_t)256 * 512 + 256, T, 256, 256, 512}; pg8::StaticOrder S;
              if (G == 256) S.init(T, 256, 64, bx >= 192 ? bx - 192 : (1 << 20)); else S.init(T, 256, G, bx);
              pg8::EpiBf16<0> E{WSP(bf16, WS_VM) + 256, 512, nullptr, 0, 0, 1.f}; pg8::gemm_phase<pg8::EpiBf16<0>, pg8::StaticOrder, true, true>(lds + RING_OFF, g, S, E, tidq); }
        }
        SEAM(P + 3);
        if (IN(P + 4)) {
            REPS(5) { PH_BEGIN(lv); attn_mfma(WSP(bf16, WS_Q), WSP(bf16, WS_K), WSP(bf16, WS_V), WSP(bf16, WS_AO), lds + RING_OFF, bx, G, tidq); __syncthreads(); }
            REPS(6) { PH_BEGIN(lv); mlstm_mfma(WSP(bf16, WS_QKM), WSP(bf16, WS_VM), WSP(float, WS_LOGI), WSP(float, WS_LOGF), WSP(bf16, WS_CONV), WSP(bf16, WS_OPRE), INP(I_MHG) + l * 512, INP(I_MSKIP) + l * 512,
                          WSP(bf16, WS_OUTM), lds + RING_OFF, bx, G, tidq); }
        }
        SEAM(P + 4);
        if (IN(P + 5)) REPS(7) {
            { PH_BEGIN(lv); pg8::Gemm g{WSP(bf16, WS_AO), (const bf16*)(WL() + WO_WA), T, 1024, 512}; pg8::StaticOrder S; S.init(T, 1024, G, bx);
              EpiMerge E{WSP(bf16, WS_MERGED), WSP(bf16, WS_GA), 1}; pg8::gemm_phase<EpiMerge, pg8::StaticOrder, true, true>(lds + RING_OFF, g, S, E, tidq); }
            { PH_BEGIN(lv); pg8::Gemm g{WSP(bf16, WS_OUTM), (const bf16*)(WL() + WO_WM), T, 1024, 512}; pg8::StaticOrder S; S.init(T, 1024, G, bx);
              EpiMerge E{WSP(bf16, WS_MERGED), WSP(bf16, WS_GM), 0}; pg8::gemm_phase<EpiMerge, pg8::StaticOrder, true, true>(lds + RING_OFF, g, S, E, tidq); }
        }
        SEAM(P + 5);
        if (IN(P + 6)) REPS(8) { PH_BEGIN(lv);
            pg8::Gemm g{WSP(bf16, WS_MERGED), (const bf16*)(WL() + WO_WO), T, 1024, 1024}; pg8::StaticOrder S; S.init(T, 1024, G, bx);
            if (lv == 0) { EpiResid<false> E{INP(I_X), XA(), ADAL() + 2048}; pg8::gemm_phase<EpiResid<false>, pg8::StaticOrder, true, true>(lds + RING_OFF, g, S, E, tidq); }
            else { EpiResid<true> E{XB(), XA(), ADAL() + 2048}; pg8::gemm_phase<EpiResid<true>, pg8::StaticOrder, true, true>(lds + RING_OFF, g, S, E, tidq); }
        }
        SEAM(P + 6);
        if (IN(P + 7)) REPS(1) { PH_BEGIN(lv); rowpass_norm_mod<true>(XA(), INP(I_N2G) + l * D, ADAL() + 3072, ADAL() + 4096, WSP(bf16, WS_H), gw, NGW, lane, ws + WS_H8, WSP(float, WS_XS)); }
        SEAM(P + 7);
        if (IN(P + 8)) REPS(9) { PH_BEGIN(lv);
            pg8::Gemm g{WSP(bf16, WS_H), (const bf16*)(WL() + WO_PWQ), T, 1024, 1024}; pg8::StaticOrder S; S.init(T, 1024, G, bx);
            pg8::EpiBf16<0> E{WSP(bf16, WS_PQ), 1024, nullptr, 0, 0, 1.f}; pg8::gemm_phase<pg8::EpiBf16<0>, pg8::StaticOrder, true, true>(lds + RING_OFF, g, S, E, tidq);
        }
        SEAM(P + 8);
        if (IN(P + 9)) REPS(10) { PH_BEGIN(lv);
            peer_route(WSP(bf16, WS_PQ), (const bf16*)(WL() + WO_KEYB), WSP(int, WS_IDX), WSP(float, WS_GATE), lds + RING_OFF, bx, G, tidq); }
        SEAM(P + 9);
        if (IN(P + 10)) REPS(12) { PH_BEGIN(lv);
            int vx, rank, nb; peer_partition((const unsigned*)(ws + WS_CTL) + CW_XC, MISC, bx, G, vx, rank, nb);
            peer_u_i8(ws + WS_H8, WSP(float, WS_XS), WSP(int, WS_IDX), ws + WS_U8 + (size_t)l * 32 * MiB, WSP(f32x2v, WS_USC) + l * 16384, WSP(float, WS_ACT), wscr, vx, rank, nb, tidq); }
        SEAM(P + 10);
        if (IN(P + 11)) REPS(13) { PH_BEGIN(lv);
            int vx, rank, nb; peer_partition((const unsigned*)(ws + WS_CTL) + CW_XC, MISC, bx, G, vx, rank, nb);
            peer_v(WSP(int, WS_IDX), WSP(float, WS_ACT), WSP(float, WS_GATE), ws + WS_V8 + (size_t)l * 32 * MiB, ADAL() + 5120, XA(), XB(), wscr, vx, rank, nb, tidq);
        }
        SEAM(P + 11);
    }

__global__ void __launch_bounds__(NTHREADS, 2) fwd(Args args) {
    extern __shared__ __attribute__((aligned(16))) unsigned char lds_raw[];
    LAS unsigned char* lds = (LAS unsigned char*)lds_raw;
    volatile LAS unsigned* MISC = (volatile LAS unsigned*)(lds + MISC_OFF);
    const int tid = threadIdx.x;
    const int wave_s = __builtin_amdgcn_readfirstlane(tid >> 6);
    for (int u = tid; u < (LDS_BYTES - LDSCTL_OFF) / 4; u += NTHREADS) ((LAS unsigned*)(lds + LDSCTL_OFF))[u] = 0u;
    __syncthreads();
    if (tid == 0) { LAS unsigned long long* pt = (LAS unsigned long long*)(lds + PTAB_OFF);
#pragma unroll
        for (int i = 0; i < N_INPUTS; ++i) pt[i] = (unsigned long long)args.in[i];
        pt[29] = (unsigned long long)args.out; pt[30] = (unsigned long long)args.ws; }
    __syncthreads();
    if (MK_ONE_LAUNCH) (void)xcd_barrier_post((unsigned*)(WSB() + WS_CTL) + CW_BAR, MISC + 8);
    if (MK_ONE_LAUNCH && tid == 0) { const unsigned xc = xb_xcc_id() & 7u; MISC[12] = xb_add((unsigned*)(WSB() + WS_CTL) + CW_XC + 64 * xc, 1u); MISC[13] = xc; }
    __syncthreads();
    const int lo = args.ph_lo, hi = args.ph_hi;

    if (IN(0)) REPS(0) {
        PH_BEGIN(0);
        float* ADA = (float*)(ws + ADA_OFF);
        { const float* c = INP(I_C); const float* wada = INP(I_WADA); const float* bada = INP(I_BADA);
          for (int it = bx; it < DEPTH * 96; it += G) {
            const int ll = it / 96, cg = it % 96; const int n = cg * 64 + lane;
#pragma unroll
            for (int i = 0; i < 16; ++i) { const int e = lane + 64 * i; const int bb = e >> 7, kk = e & 127; const float cv = c[bb * D + wave * 128 + kk]; wscr[e] = cv * sigm(cv); }
            LDS_WAIT();
            const float* w = wada + (size_t)ll * D * NADA + (size_t)(wave * 128) * NADA + n;
            float a[8];
#pragma unroll
            for (int bb = 0; bb < 8; ++bb) a[bb] = 0.f;
#pragma unroll 16
            for (int kk = 0; kk < 128; ++kk) { const float wv = w[(size_t)kk * NADA];
#pragma unroll
                for (int bb = 0; bb < 8; ++bb) a[bb] += wscr[bb * 128 + kk] * wv; }
#pragma unroll
            for (int bb = 0; bb < 8; ++bb) wscr[1024 + bb * 64 + lane] = a[bb];
            __syncthreads();
            { float s = 0.f;
#pragma unroll
              for (int w8 = 0; w8 < 8; ++w8) s += ((const LAS float*)(lds + RING_OFF + w8 * 16384))[1024 + wave * 64 + lane];
              ADA[((size_t)ll * 8 + wave) * NADA + n] = s + bada[ll * NADA + n]; }
            __syncthreads();
          } }
        { const int* pos = (const int*)INP(I_POS); float* COS = (float*)(ws + WS_COS); float* SIN = (float*)(ws + WS_SIN);
          for (int idx = gw * 64 + lane; idx < T * 16; idx += NGW * 64) { const int t = idx >> 4, j = idx & 15;
              const float ang = (float)pos[t] * INV_FREQ[j];
              const double rev = (double)ang * 0.15915494309189535; const float fr = (float)(rev - rint(rev));
              COS[idx] = __builtin_amdgcn_cosf(fr); SIN[idx] = __builtin_amdgcn_sinf(fr); } }
        for (int it = gw; it < DEPTH * PI_TOTAL; it += NGW) prep_item(lds, ws, wscr, it / PI_TOTAL, it % PI_TOTAL, lane);
    }
    SEAM(0);

    layer_phases<0>(lds, MISC, lo, hi, wave_s);
    layer_phases<1>(lds, MISC, lo, hi, wave_s);
    if (IN(N_PHASES - 1)) REPS(1) { PH_BEGIN(0); rowpass_final(XB(), INP(I_FG), (float*)getp(lds, 29), gw, NGW, lane); }
#undef IN
#undef SEAM
}

extern "C" void kernel_launch(void* const* d_in, const int* in_sizes, int n_in, void* d_out, int out_size, void* d_ws, size_t ws_size, hipStream_t stream) {
    static int grid = 0;
    if (grid == 0) {
        if (n_in != N_INPUTS || in_sizes[0] != T * D || out_size != T * D || ws_size < WS_END2) {
            fprintf(stderr, "kernel_launch: unexpected shapes: n_in %d in0 %d out %d ws %zu (need %zu); nothing launched\n", n_in, n_in > 0 ? in_sizes[0] : -1, out_size, ws_size, (size_t)WS_END2); grid = -1; return; }
        int dev = 0, cus = 0, per_cu = 0;
        if (hipGetDevice(&dev) != hipSuccess || hipDeviceGetAttribute(&cus, hipDeviceAttributeMultiprocessorCount, dev) != hipSuccess) { fprintf(stderr, "kernel_launch: device query failed\n"); grid = -1; return; }
        if (hipFuncSetAttribute((const void*)fwd, hipFuncAttributeMaxDynamicSharedMemorySize, LDS_BYTES) != hipSuccess) { fprintf(stderr, "kernel_launch: hipFuncSetAttribute failed\n"); grid = -1; return; }
        if (hipOccupancyMaxActiveBlocksPerMultiprocessor(&per_cu, (const void*)fwd, NTHREADS, LDS_BYTES) != hipSuccess || per_cu < 1)
            fprintf(stderr, "kernel_launch: note: occupancy query reports %d workgroups per CU\n", per_cu);
        (void)hipGetLastError();
        grid = cus;
    }
    if (grid < 0) return;
    if (hipMemsetAsync((char*)d_ws + WS_CTL, 0, CTL_ZERO_BYTES, stream) != hipSuccess) { fprintf(stderr, "kernel_launch: memset failed\n"); return; }
    Args a{};
    for (int i = 0; i < N_INPUTS; ++i) a.in[i] = d_in[i];
    a.out = (float*)d_out; a.ws = (unsigned char*)d_ws;
#if MK_ONE_LAUNCH
    a.ph_lo = 0; a.ph_hi = N_PHASES;
    hipLaunchKernelGGL(fwd, dim3(grid), dim3(NTHREADS), LDS_BYTES, stream, a);
#else
    for (int p = 0; p < N_PHASES; ++p) { a.ph_lo = p; a.ph_hi = p + 1; hipLaunchKernelGGL(fwd, dim3(grid), dim3(NTHREADS), LDS_BYTES, stream, a); }
#endif
    const hipError_t le = hipPeekAtLastError();
    if (le != hipSuccess) fprintf(stderr, "kernel_launch: launch failed: %s\n", hipGetErrorName(le));
}
```

```cpp
#include <hip/hip_runtime.h>
#include <cstdio>
#include <cstdint>
namespace pg8 {
#define PG8_LAS __attribute__((address_space(3)))
typedef unsigned short bf16_t;
typedef short bf16x8 __attribute__((ext_vector_type(8)));
typedef float f32x4 __attribute__((ext_vector_type(4)));
typedef unsigned u32x4 __attribute__((ext_vector_type(4)));
constexpr int BM = 256, BK = 64, HALF = 128, HTB = HALF * BK * 2  , STAGE_BYTES = 8 * HTB, NXCD = 8, WGM = 8;

__host__ __device__ __forceinline__ int lds_byte(int r, int c) { const int st = (r >> 4) * 2 + (c >> 5), rr = r & 15, cc = c & 31, ob = rr * 64 + cc * 2; return st * 1024 + (ob ^ (((ob >> 9) & 1) << 5)); }
__host__ __device__ __forceinline__ void stage_rc(int b, int& R, int& C) { const int st = b / 1024, sb = b % 1024, swz = sb ^ (((sb >> 9) & 1) << 5); R = (st >> 1) * 16 + swz / 64; C = (st & 1) * 32 + (swz % 64) / 2; }
__host__ __device__ __forceinline__ int perm32(int rho) { const int n = rho >> 4, i = rho & 15; return 8 * (i >> 2) + 4 * n + (i & 3); }

struct Unit { int pm, pn; };
struct Gemm { const bf16_t* A; const bf16_t* Bt; int M, N, K; int ld = 0; };

struct StaticOrder {
    int nM, nN, nwg, G, c;
    __host__ __device__ void init(int M, int N, int G_, int c_) { nM = M / BM; nN = N / BM; nwg = nM * nN; G = G_; c = c_; }
    __host__ __device__ bool next(int i, Unit& u) const {
        const long L = (long)i * G + c; if (L >= nwg) return false;
        int wgid = (int)L; { const int q = nwg / NXCD, r = nwg % NXCD, xcd = wgid % NXCD, off = wgid / NXCD; wgid = (xcd < r ? xcd * (q + 1) : r * (q + 1) + (xcd - r) * q) + off; }
        const int nig = WGM * nN, gid = wgid / nig, fm = gid * WGM, gsz = (nM - fm) < WGM ? (nM - fm) : WGM;
        u.pm = fm + ((wgid % nig) % gsz); u.pn = (wgid % nig) / gsz; return true;
    }
    __device__ __forceinline__ void a_ready(const Unit&) const {}
    __device__ __forceinline__ void done(const Unit&) const {}
};

__device__ __forceinline__ unsigned cvt_pk_bf16(float lo, float hi) { unsigned r; asm volatile("v_cvt_pk_bf16_f32 %0, %1, %2" : "=v"(r) : "v"(lo), "v"(hi)); return r; }
typedef float f32x2 __attribute__((ext_vector_type(2)));
__device__ __forceinline__ f32x2 gelu_pk(f32x2 v) {
    const f32x2 av = __builtin_elementwise_abs(v), d = av * 0.2316418882f + 1.0f;
    f32x2 t; t.x = __builtin_amdgcn_rcpf(d.x); t.y = __builtin_amdgcn_rcpf(d.y);
    f32x2 q = t * 0.5307027145f + (-0.7265760135f); q = q * t + 0.7107068705f; q = q * t + (-0.142248368f); q = q * t + 0.127414796f; q = q * t;
    const f32x2 s = (v * v) * (-0.72134752044f);
    f32x2 e; e.x = __builtin_amdgcn_exp2f(s.x); e.y = __builtin_amdgcn_exp2f(s.y);
    const f32x2 m = v * (q * e), r = v - m;
    f32x2 o; o.x = v.x < 0.f ? m.x : r.x; o.y = v.y < 0.f ? m.y : r.y; return o;
}

template <int ACT  > struct EpiBf16 {
    static constexpr bool PERM = true, AFTER_DRAIN = false; static_assert(ACT == 0 || ACT == 1, "EpiBf16: ACT is 0 (none) or 1 (gelu_pk)");
    bf16_t* O; int ldc; const float* bias; int split_cols; size_t split_stride; float scale0;
    __device__ __forceinline__ void operator()(const f32x4 (&acc)[2][2][4][2], const Unit& u, int wr, int wc, int fr, int fq) const {
        const int row0 = u.pm * BM + wr * 64 + fr; int colt = u.pn * BM; bf16_t* base = O;
        float sc = 1.f; if (split_cols) { const int t = colt / split_cols; base += (size_t)t * split_stride; colt -= t * split_cols; if (t == 0) sc = scale0; }
        const int col0 = colt + wc * 32 + 8 * fq, bcol0 = u.pn * BM + wc * 32 + 8 * fq;
        f32x4 bv[2][2];
#pragma unroll
        for (int bj = 0; bj < 2; ++bj)
#pragma unroll
            for (int n = 0; n < 2; ++n) bv[bj][n] = bias ? *(const f32x4*)(bias + bcol0 + bj * HALF + 4 * n) : (f32x4){0.f, 0.f, 0.f, 0.f};
#pragma unroll
        for (int ai = 0; ai < 2; ++ai)
#pragma unroll
            for (int m = 0; m < 4; ++m) { bf16_t* rowp = base + (size_t)(row0 + ai * HALF + m * 16) * ldc + col0;
#pragma unroll
                for (int bj = 0; bj < 2; ++bj) { f32x4 v0 = acc[ai][bj][m][0] + bv[bj][0], v1 = acc[ai][bj][m][1] + bv[bj][1];
                    if (ACT == 1) { f32x2 a = gelu_pk((f32x2){v0[0], v0[1]}), b = gelu_pk((f32x2){v0[2], v0[3]}), c = gelu_pk((f32x2){v1[0], v1[1]}), d = gelu_pk((f32x2){v1[2], v1[3]});
                        v0 = (f32x4){a.x, a.y, b.x, b.y}; v1 = (f32x4){c.x, c.y, d.x, d.y}; }
                    v0 = v0 * sc; v1 = v1 * sc; u32x4 w; w.x = cvt_pk_bf16(v0[0], v0[1]); w.y = cvt_pk_bf16(v0[2], v0[3]); w.z = cvt_pk_bf16(v1[0], v1[1]); w.w = cvt_pk_bf16(v1[2], v1[3]);
                    *(u32x4*)(rowp + bj * HALF) = w; } }
    }
};


template <class Epi, class Sched, bool ALIGN_EPI = false, bool SP2 = false>
__device__ __forceinline__ void gemm_phase(PG8_LAS unsigned char* lds, const Gemm g, const Sched& S, const Epi& E, const int tid_in) {
    int tid_l = tid_in; asm volatile("" : "+v"(tid_l));
    const int tid = tid_l, wid = __builtin_amdgcn_readfirstlane(tid >> 6), lane = tid & 63, wr = wid >> 2, wc = wid & 3, fr = lane & 15, fq = lane >> 4;
    const int K = g.K, nt = K / BK, LD = g.ld ? g.ld : g.K;
    unsigned voffA[2], voffB[2];
#pragma unroll
    for (int i = 0; i < 2; ++i) { int R, C; stage_rc(tid * 16 + i * 8192, R, C); const int Rb = Epi::PERM ? ((R & ~31) + perm32(R & 31)) : R;
        voffA[i] = (unsigned)(R * LD + C) * 2u; voffB[i] = (unsigned)(Rb * LD + C) * 2u; }
    const size_t kstep = (size_t)(BK * 2);
    const size_t hstep = (size_t)HALF * LD * 2;
    const size_t tstep = 2 * hstep;
    const unsigned ldsw = (unsigned)wid * 1024u;
    const int aoff = lds_byte(wr * 64 + fr, fq * 8), boff = lds_byte(wc * 32 + fr, fq * 8);
#define PG8_SA(b, h) (((b) * 2 + (h)) * HTB)
#define PG8_SB(b, h) ((4 + (b) * 2 + (h)) * HTB)
#define PG8_STAGE(bufoff, gbase, voff) do { _Pragma("unroll") for (int _i = 0; _i < 2; ++_i) \
        __builtin_amdgcn_global_load_lds((const unsigned*)((const char*)(gbase) + (voff)[_i]), (PG8_LAS unsigned*)(lds + (bufoff) + ldsw + _i * 8192), 16, 0, 0); } while (0)
#define PG8_LDA(dst, b, h) do { _Pragma("unroll") for (int m = 0; m < 4; ++m) _Pragma("unroll") for (int k = 0; k < 2; ++k) dst[m][k] = *(const PG8_LAS bf16x8*)(lds + PG8_SA(b, h) + aoff + m * 2048 + k * 1024); } while (0)
#define PG8_LDB(dst, b, h) do { _Pragma("unroll") for (int n = 0; n < 2; ++n) _Pragma("unroll") for (int k = 0; k < 2; ++k) dst[n][k] = *(const PG8_LAS bf16x8*)(lds + PG8_SB(b, h) + boff + n * 2048 + k * 1024); } while (0)
#define PG8_MMA(ai, bj, At, Bt) do { __builtin_amdgcn_s_setprio(1); _Pragma("unroll") for (int m = 0; m < 4; ++m) _Pragma("unroll") for (int n = 0; n < 2; ++n) _Pragma("unroll") for (int k = 0; k < 2; ++k) \
        acc[ai][bj][m][n] = __builtin_amdgcn_mfma_f32_16x16x32_bf16(Bt[n][k], At[m][k], acc[ai][bj][m][n], 0, 0, 0); __builtin_amdgcn_s_setprio(0); } while (0)
#define PG8_WAIT_V(n) asm volatile("s_waitcnt vmcnt(" #n ")" ::: "memory")
#define PG8_WAIT_L(n) asm volatile("s_waitcnt lgkmcnt(" #n ")" ::: "memory")
#define PG8_BAR __builtin_amdgcn_s_barrier()
#define PG8_SCHED __builtin_amdgcn_sched_barrier(0)
    Unit cur, nxt; int ui = 0;
    if (!S.next(0, cur)) return;
    f32x4 acc[2][2][4][2];
#pragma unroll
    for (int a = 0; a < 2; ++a)
#pragma unroll
        for (int b = 0; b < 2; ++b)
#pragma unroll
            for (int m = 0; m < 4; ++m)
#pragma unroll
                for (int n = 0; n < 2; ++n) acc[a][b][m][n] = (f32x4){0.f, 0.f, 0.f, 0.f};
    bf16x8 At[4][2], B0[2][2], B1[2][2];
    const char* cA = (const char*)g.A + (size_t)cur.pm * tstep; const char* cB = (const char*)g.Bt + (size_t)cur.pn * tstep;
    S.a_ready(cur);
    if constexpr (SP2) {
        PG8_STAGE(PG8_SB(0, 0), cB, voffB); PG8_STAGE(PG8_SB(0, 1), cB + hstep, voffB); PG8_STAGE(PG8_SA(0, 0), cA, voffA); PG8_STAGE(PG8_SA(0, 1), cA + hstep, voffA);
        if (wr == 1) PG8_BAR;
        PG8_WAIT_V(2); PG8_BAR;
        PG8_STAGE(PG8_SB(1, 0), cB + kstep, voffB); PG8_STAGE(PG8_SA(1, 0), cA + kstep, voffA); PG8_STAGE(PG8_SB(1, 1), cB + hstep + kstep, voffB);
        PG8_WAIT_V(6); PG8_BAR;
    } else {
        PG8_STAGE(PG8_SB(0, 0), cB, voffB); PG8_STAGE(PG8_SA(0, 0), cA, voffA); PG8_STAGE(PG8_SB(0, 1), cB + hstep, voffB); PG8_STAGE(PG8_SA(0, 1), cA + hstep, voffA);
        if (wr == 1) PG8_BAR;
        PG8_WAIT_V(4); PG8_BAR;
        PG8_STAGE(PG8_SB(1, 0), cB + kstep, voffB); PG8_STAGE(PG8_SA(1, 0), cA + kstep, voffA); PG8_STAGE(PG8_SB(1, 1), cB + hstep + kstep, voffB);
        PG8_WAIT_V(6); PG8_BAR;
    }
    for (;;) {
        const bool has_next = S.next(ui + 1, nxt);
        const char* nA = has_next ? (const char*)g.A + (size_t)nxt.pm * tstep : cA; const char* nB = has_next ? (const char*)g.Bt + (size_t)nxt.pn * tstep : cB;
        for (int t = 0; t < nt; t += 2) {
            const bool last = (t == nt - 2);
            const char* a1 = cA + (size_t)(t + 1) * kstep;
            const char* a2 = last ? nA : cA + (size_t)(t + 2) * kstep; const char* b2 = last ? nB : cB + (size_t)(t + 2) * kstep;
            const char* a3 = a2 + kstep; const char* b3 = b2 + kstep;
            if (last && has_next) S.a_ready(nxt);
            if constexpr (SP2) {
            PG8_LDB(B0, 0, 0); PG8_LDB(B1, 0, 1); PG8_SCHED; PG8_LDA(At, 0, 0); PG8_STAGE(PG8_SA(1, 1), a1 + hstep, voffA);
            PG8_WAIT_V(8); PG8_WAIT_L(0); PG8_BAR; PG8_MMA(0, 0, At, B0); PG8_MMA(0, 1, At, B1); PG8_BAR; PG8_SCHED;
            PG8_LDA(At, 0, 1); PG8_STAGE(PG8_SB(0, 0), b2, voffB); PG8_STAGE(PG8_SB(0, 1), b2 + hstep, voffB); PG8_STAGE(PG8_SA(0, 0), a2, voffA);
            PG8_WAIT_V(8); PG8_WAIT_L(0); PG8_BAR; PG8_MMA(1, 0, At, B0); PG8_MMA(1, 1, At, B1); PG8_BAR; PG8_SCHED;
            PG8_LDB(B0, 1, 0); PG8_LDB(B1, 1, 1); PG8_SCHED; PG8_LDA(At, 1, 0); PG8_STAGE(PG8_SA(0, 1), a2 + hstep, voffA);
            PG8_WAIT_V(8); PG8_WAIT_L(0); PG8_BAR; PG8_MMA(0, 0, At, B0); PG8_MMA(0, 1, At, B1); PG8_BAR; PG8_SCHED;
            PG8_LDA(At, 1, 1); PG8_STAGE(PG8_SB(1, 0), b3, voffB); PG8_STAGE(PG8_SB(1, 1), b3 + hstep, voffB); PG8_STAGE(PG8_SA(1, 0), a3, voffA);
            PG8_WAIT_V(8); PG8_WAIT_L(0); PG8_BAR; PG8_MMA(1, 0, At, B0); PG8_MMA(1, 1, At, B1); PG8_BAR; PG8_SCHED;
            } else {
            PG8_LDB(B0, 0, 0); PG8_SCHED; PG8_LDA(At, 0, 0); PG8_STAGE(PG8_SA(1, 1), a1 + hstep, voffA);
            PG8_WAIT_L(8); PG8_BAR; PG8_WAIT_L(0); PG8_MMA(0, 0, At, B0); PG8_BAR; PG8_SCHED;
            PG8_LDB(B1, 0, 1); PG8_STAGE(PG8_SB(0, 0), b2, voffB);
            PG8_BAR; PG8_WAIT_L(0); PG8_MMA(0, 1, At, B1); PG8_BAR;
            PG8_LDA(At, 0, 1); PG8_STAGE(PG8_SA(0, 0), a2, voffA);
            PG8_BAR; PG8_WAIT_L(0); PG8_MMA(1, 0, At, B0); PG8_BAR; PG8_SCHED;
            PG8_STAGE(PG8_SB(0, 1), b2 + hstep, voffB);
            PG8_WAIT_V(6); PG8_BAR; PG8_MMA(1, 1, At, B1); PG8_BAR;
            PG8_LDB(B0, 1, 0); PG8_SCHED; PG8_LDA(At, 1, 0); PG8_STAGE(PG8_SA(0, 1), a2 + hstep, voffA);
            PG8_WAIT_L(8); PG8_BAR; PG8_WAIT_L(0); PG8_MMA(0, 0, At, B0); PG8_BAR; PG8_SCHED;
            PG8_LDB(B1, 1, 1); PG8_STAGE(PG8_SB(1, 0), b3, voffB);
            PG8_BAR; PG8_WAIT_L(0); PG8_MMA(0, 1, At, B1); PG8_BAR;
            PG8_LDA(At, 1, 1); PG8_STAGE(PG8_SA(1, 0), a3, voffA);
            PG8_BAR; PG8_WAIT_L(0); PG8_MMA(1, 0, At, B0); PG8_BAR; PG8_SCHED;
            PG8_STAGE(PG8_SB(1, 1), b3 + hstep, voffB);
            PG8_WAIT_V(6); PG8_BAR; PG8_MMA(1, 1, At, B1); PG8_BAR;
            }
        }
        if constexpr (ALIGN_EPI) { if (wr == 0) PG8_BAR; }
        if constexpr (!Epi::AFTER_DRAIN) { E(acc, cur, wr, wc, fr, fq); S.done(cur); }
        if (!has_next) break;
#pragma unroll
        for (int a = 0; a < 2; ++a)
#pragma unroll
            for (int b = 0; b < 2; ++b)
#pragma unroll
                for (int m = 0; m < 4; ++m)
#pragma unroll
                    for (int n = 0; n < 2; ++n) acc[a][b][m][n] = (f32x4){0.f, 0.f, 0.f, 0.f};
        cur = nxt; cA = nA; cB = nB; ++ui;
        if constexpr (ALIGN_EPI) { if (wr == 1) PG8_BAR; }
    }
    PG8_WAIT_V(0);
    if constexpr (!ALIGN_EPI) { if (wr == 0) PG8_BAR; }
    PG8_BAR;
    if constexpr (Epi::AFTER_DRAIN) { E.fused(acc, cur, wr, wc, fr, fq, lds, wid, lane); S.done(cur); }
#undef PG8_SA
#undef PG8_SB
#undef PG8_STAGE
#undef PG8_LDA
#undef PG8_LDB
#undef PG8_MMA
#undef PG8_WAIT_V
#undef PG8_WAIT_L
#undef PG8_BAR
#undef PG8_SCHED
}
}
#define GAS __attribute__((address_space(1)))
#define LAS __attribute__((address_space(3)))
typedef unsigned short bf16;
typedef unsigned v4u __attribute__((ext_vector_type(4)));
typedef float f32x4 __attribute__((ext_vector_type(4)));
typedef short bf16x8 __attribute__((ext_vector_type(8)));
typedef GAS unsigned gu32;
typedef GAS unsigned long long gu64;
#define RLX_AGENT __ATOMIC_RELAXED, __HIP_MEMORY_SCOPE_AGENT
#define LDS_WAIT() asm volatile("s_waitcnt lgkmcnt(0)" ::: "memory")
#define VM_WAIT() asm volatile("s_waitcnt vmcnt(0)" ::: "memory")
__device__ __forceinline__ unsigned long long rt() { return __builtin_amdgcn_s_memrealtime(); }
__device__ __forceinline__ unsigned f2bf(float f) { unsigned u = __builtin_bit_cast(unsigned, f); return (u + 0x7fffu + ((u >> 16) & 1u)) >> 16; }
__device__ __forceinline__ unsigned pk2(float lo, float hi) { return f2bf(lo) | (f2bf(hi) << 16); }

#define XB_TMO      128
#define XB_XCNT(j)  (256  + 64 * (j))
#define XB_XSUB(j)  (1280 + 64 * (j))
#define XB_XGEN(j)  (2304 + 64 * (j))
#define XB_TOP      3328
#define XB_TOPGEN   3392
#define XCD_BAR_WORDS 3456
#define XB_SPIN_CAP (1u << 18)

__device__ __forceinline__ unsigned xb_ld(unsigned* p)              { return __hip_atomic_load(p, __ATOMIC_RELAXED, __HIP_MEMORY_SCOPE_AGENT); }
__device__ __forceinline__ unsigned xb_add(unsigned* p, unsigned v) { return __hip_atomic_fetch_add(p, v, __ATOMIC_RELAXED, __HIP_MEMORY_SCOPE_AGENT); }
__device__ __forceinline__ unsigned xb_xcc_id() { return (unsigned)__builtin_amdgcn_s_getreg((3 << 11) | 20) & 0xFu; }
#define XB_SPIN(cond, bar) do { unsigned _sp = 0; while (cond) { __builtin_amdgcn_s_sleep(1); \
    if ((++_sp & 255u) == 0u) { if (xb_ld(&(bar)[XB_TMO])) break; if (_sp > XB_SPIN_CAP) { atomicAdd(&(bar)[XB_TMO], 1u); break; } } } } while (0)

struct XcdBarrier {
    unsigned* bar; unsigned x;
    volatile LAS unsigned* st;
};

__device__ __forceinline__ XcdBarrier xcd_barrier_post(unsigned* bar, volatile LAS unsigned* st) {
    XcdBarrier b; b.bar = bar; b.x = xb_xcc_id(); b.st = st;
    if (threadIdx.x == 0) (void)xb_add(&bar[XB_XCNT(b.x)], 1u);
    return b;
}
__device__ __forceinline__ void xcd_barrier_complete(unsigned* bar, unsigned x, unsigned& nloc, unsigned& nx) {
    const unsigned G = gridDim.x * gridDim.y * gridDim.z;
    unsigned sum, cnt, mine, sp = 0u;
    for (;;) {
        sum = 0u; cnt = 0u; mine = 0u;
#pragma unroll
        for (unsigned j = 0; j < 16; ++j) { const unsigned c = xb_ld(&bar[XB_XCNT(j)]); sum += c; cnt += (c > 0u) ? 1u : 0u; mine = (j == x) ? c : mine; }
        if (sum == G) break;
        __builtin_amdgcn_s_sleep(1);
        if ((++sp & 255u) == 0u) { if (xb_ld(&bar[XB_TMO])) break; if (sp > XB_SPIN_CAP) { atomicAdd(&bar[XB_TMO], 1u); break; } }
    }
    nloc = mine > 0u ? mine : 1u; nx = cnt > 0u ? cnt : 1u;
}

__device__ __forceinline__ void xcd_barrier(const XcdBarrier& b, const int tid_in) {
    asm volatile("s_waitcnt vmcnt(0)" ::: "memory");
    __syncthreads();
    if (tid_in == 0) {
        unsigned* bar = b.bar;
        __builtin_amdgcn_s_waitcnt(0);
        unsigned nloc = b.st[0], nx = b.st[1];
        if (nloc == 0u) { xcd_barrier_complete(bar, b.x, nloc, nx); b.st[0] = nloc; b.st[1] = nx; }
        const unsigned old = xb_add(&bar[XB_XSUB(b.x)], 1u);
        const unsigned gen = old / nloc;
        if (old + 1u == (gen + 1u) * nloc) {
            __builtin_amdgcn_fence(__ATOMIC_RELEASE, "agent");
            asm volatile("s_waitcnt vmcnt(0)" ::: "memory");
            const unsigned og = xb_add(&bar[XB_TOP], 1u);
            const unsigned tg = og / nx;
            if (og + 1u == (tg + 1u) * nx) xb_add(&bar[XB_TOPGEN], 1u);
            else XB_SPIN(xb_ld(&bar[XB_TOPGEN]) == tg, bar);
            __builtin_amdgcn_fence(__ATOMIC_ACQUIRE, "agent");
            xb_add(&bar[XB_XGEN(b.x)], 1u);
            asm volatile("s_waitcnt vmcnt(0)" ::: "memory");
        } else {
            XB_SPIN(xb_ld(&bar[XB_XGEN(b.x)]) == gen, bar);
            __builtin_amdgcn_fence(__ATOMIC_ACQUIRE, "agent");
            asm volatile("s_waitcnt vmcnt(0)" ::: "memory");
        }
    }
    __syncthreads();
}

#ifndef MK_ONE_LAUNCH
#define MK_ONE_LAUNCH 1
#endif
#ifndef PROBE_REP_MASK
#define PROBE_REP_MASK 0
#endif
#define REPS(bit) _Pragma("unroll") for (int rep_ = 0; rep_ < ((PROBE_REP_MASK >> (bit)) & 1) + 1; ++rep_)
constexpr int NWAVES = 8, NTHREADS = NWAVES * 64;
constexpr int BATCH = 8, SEQ = 2048, T = BATCH * SEQ, D = 1024, DEPTH = 2;
constexpr int NPROJ = 4352;
constexpr int N_INPUTS = 29;
constexpr int NADA = 6144;
constexpr float RMS_EPS = 1e-6f;
constexpr float QSCALE = 0.10206207261596575f * 1.4426950408889634f;
enum { I_X = 0, I_C, I_POS, I_WADA, I_BADA, I_N1G, I_WIN, I_QNG, I_WQUP, I_KVNG, I_WKVUP, I_WBA, I_CONVW, I_CONVB, I_WQM, I_WKM, I_WVM, I_BI, I_BF, I_MHG, I_MSKIP,
       I_WBM, I_WOUT, I_N2G, I_PWQ, I_PKEYS, I_PU, I_PV, I_FG };

constexpr size_t MiB = 1u << 20;
constexpr size_t WS_CTL = 0, CTL_ZERO_BYTES = 1 * MiB;
constexpr int CW_BAR = 4096;
constexpr int CW_XC = 8192;
constexpr size_t ADA_OFF = 256 * 1024;
constexpr size_t WS_COS = 1 * MiB, WS_SIN = 2 * MiB;
constexpr size_t WS_W = 3 * MiB, W_LAYER = 18 * MiB;
constexpr size_t WO_WIN = 0, WO_WQ = 8912896, WO_WKV = WO_WQ + 1179648, WO_WA = WO_WKV + 524288, WO_WM = WO_WA + 1048576, WO_WO = WO_WM + 1048576,
                 WO_PWQ = WO_WO + 2097152, WO_WQK = WO_PWQ + 2097152, WO_WV = WO_WQK + 1048576, WO_KEYB = WO_WV + 524288;
static_assert(WO_KEYB + 262144 <= W_LAYER, "weights fit");
constexpr size_t WS_X = 40 * MiB, WS_H = 104 * MiB, WS_QLAT = 136 * MiB, WS_KVLAT = 160 * MiB, WS_UM = 168 * MiB, WS_OPRE = 184 * MiB, WS_GA = 200 * MiB, WS_GM = 232 * MiB,
                 WS_SMALL = 264 * MiB, WS_RQ = 268 * MiB, WS_RKV = WS_RQ + 65536, WS_LOGI = WS_RQ + 262144, WS_LOGF = WS_RQ + 524288, WS_Q = 269 * MiB, WS_K = 293 * MiB,
                 WS_V = 317 * MiB, WS_CONV = 333 * MiB, WS_QKM = 349 * MiB, WS_VM = 381 * MiB, WS_AO = 397 * MiB, WS_OUTM = 413 * MiB, WS_U8 = 429 * MiB, WS_V8 = 445 * MiB, WS_END = 493 * MiB;
constexpr size_t WS_H8 = 493 * MiB, WS_XS = WS_RQ + 131072, WS_USC = WS_RQ + 786432;
constexpr size_t WS_END2 = 509 * MiB;
constexpr size_t WS_IDX = WS_UM, WS_GATE = WS_UM + 8 * MiB, WS_ACT = WS_OPRE;
constexpr size_t WS_SMALLP = WS_OUTM;
constexpr size_t WS_PQ = WS_QLAT, WS_MERGED = WS_QLAT;

constexpr int RING_OFF = 0, RING_BYTES = 131072;
constexpr int LDSCTL_OFF = RING_BYTES, MISC_OFF = LDSCTL_OFF + 320;
constexpr int LDS_BYTES = 147456;

typedef float f32x2v __attribute__((ext_vector_type(2)));
typedef unsigned u32x2 __attribute__((ext_vector_type(2)));

__device__ __forceinline__ float wave_sum(float v) {
#pragma unroll
    for (int o = 1; o < 64; o <<= 1) v += __shfl_xor(v, o);
    return v;
}
__device__ __forceinline__ float bflo(unsigned u) { return __uint_as_float(u << 16); }
__device__ __forceinline__ float bfhi(unsigned u) { return __uint_as_float(u & 0xffff0000u); }
__device__ __forceinline__ float sigm(float x) { return 1.f / (1.f + __expf(-x)); }
__device__ __forceinline__ float dot4(f32x4 a, f32x4 b) { return (a.x * b.x + a.y * b.y) + (a.z * b.z + a.w * b.w); }
__device__ __forceinline__ float gelu_erf(float x) { return 0.5f * x * (1.f + erff(x * 0.70710678118654752f)); }

struct EpiProj {
    static constexpr bool PERM = true, AFTER_DRAIN = false;
    bf16 *qlat, *kvlat, *um, *opre, *ga, *gm; float* small;
    __device__ __forceinline__ void operator()(const f32x4 (&acc)[2][2][4][2], const pg8::Unit& u, int wr, int wc, int fr, int fq) const {
        const int pn = u.pn; bf16* dst; int ld, cb; int mode = 0;
        if (pn < 3) { dst = qlat; ld = 768; cb = pn * 256; }
        else if (pn == 3) { dst = kvlat; ld = 256; cb = 0; }
        else if (pn < 6) { dst = um; ld = 512; cb = (pn - 4) * 256; }
        else if (pn < 8) { dst = opre; ld = 512; cb = (pn - 6) * 256; }
        else if (pn < 12) { dst = ga; ld = 1024; cb = (pn - 8) * 256; mode = 1; }
        else if (pn < 16) { dst = gm; ld = 1024; cb = (pn - 12) * 256; mode = 1; }
        else { dst = nullptr; ld = 0; cb = 0; mode = 2; }
        const int row0 = u.pm * 256 + wr * 64 + fr;
        if (mode == 2) {
            if (wc < 2) {
#pragma unroll
                for (int ai = 0; ai < 2; ++ai)
#pragma unroll
                    for (int m = 0; m < 4; ++m) { float* p = small + (size_t)(row0 + ai * 128 + m * 16) * 64 + wc * 32 + 8 * fq;
                        *(f32x4*)p = acc[ai][0][m][0]; *(f32x4*)(p + 4) = acc[ai][0][m][1]; }
            }
        } else {
#pragma unroll
            for (int ai = 0; ai < 2; ++ai)
#pragma unroll
                for (int m = 0; m < 4; ++m) { bf16* rowp = dst + (size_t)(row0 + ai * 128 + m * 16) * ld + cb + wc * 32 + 8 * fq;
#pragma unroll
                    for (int bj = 0; bj < 2; ++bj) { f32x4 v0 = acc[ai][bj][m][0], v1 = acc[ai][bj][m][1];
                        if (mode == 1) { v0 = (f32x4){sigm(v0[0]), sigm(v0[1]), sigm(v0[2]), sigm(v0[3])}; v1 = (f32x4){sigm(v1[0]), sigm(v1[1]), sigm(v1[2]), sigm(v1[3])}; }
                        v4u w; w.x = pk2(v0[0], v0[1]); w.y = pk2(v0[2], v0[3]); w.z = pk2(v1[0], v1[1]); w.w = pk2(v1[2], v1[3]);
                        *(v4u*)(rowp + bj * 128) = w; } }
        }
    }
};
struct EpiSmallPart {
    static constexpr bool PERM = true, AFTER_DRAIN = false;
    float* part;
    __device__ __forceinline__ void operator()(const f32x4 (&acc)[2][2][4][2], const pg8::Unit& u, int wr, int wc, int fr, int fq) const {
        if (wc >= 2) return;
        const int row0 = u.pm * 256 + wr * 64 + fr;
#pragma unroll
        for (int ai = 0; ai < 2; ++ai)
#pragma unroll
            for (int m = 0; m < 4; ++m) { float* p = part + (size_t)(row0 + ai * 128 + m * 16) * 64 + wc * 32 + 8 * fq;
                *(f32x4*)p = acc[ai][0][m][0]; *(f32x4*)(p + 4) = acc[ai][0][m][1]; }
    }
};
struct EpiQ {
    static constexpr bool PERM = true, AFTER_DRAIN = false;
    bf16* Q; const float* rq; const float* cosT; const float* sinT;
    __device__ __forceinline__ void operator()(const f32x4 (&acc)[2][2][4][2], const pg8::Unit& u, int wr, int wc, int fr, int fq) const {
        const int row0 = u.pm * 256 + wr * 64 + fr;
        int c0b[2], d0b[2];
#pragma unroll
        for (int bj = 0; bj < 2; ++bj) { c0b[bj] = u.pn * 256 + bj * 128 + wc * 32 + 8 * fq; d0b[bj] = c0b[bj] % 96; }
#pragma unroll
        for (int ai = 0; ai < 2; ++ai) {
            float rr[4]; f32x4 csv[4][2], snv[4][2];
#pragma unroll
            for (int m = 0; m < 4; ++m) { const int row = row0 + ai * 128 + m * 16; rr[m] = rq[row];
#pragma unroll
                for (int bj = 0; bj < 2; ++bj) { csv[m][bj] = (f32x4){1.f, 1.f, 1.f, 1.f}; snv[m][bj] = (f32x4){0.f, 0.f, 0.f, 0.f};
                    if (d0b[bj] >= 64) { const int j0 = (d0b[bj] - 64) >> 1; csv[m][bj] = *(const f32x4*)(cosT + (size_t)row * 16 + j0); snv[m][bj] = *(const f32x4*)(sinT + (size_t)row * 16 + j0); } } }
            __builtin_amdgcn_sched_barrier(0);
#pragma unroll
            for (int m = 0; m < 4; ++m) { const int row = row0 + ai * 128 + m * 16; const float r = rr[m];
#pragma unroll
                for (int bj = 0; bj < 2; ++bj) {
                    f32x4 v0 = acc[ai][bj][m][0] * r, v1 = acc[ai][bj][m][1] * r;
                    if (d0b[bj] >= 64) { const f32x4 cs = csv[m][bj], sn = snv[m][bj]; const f32x4 a0 = v0, a1 = v1;
                        v0[0] = a0[0] * cs[0] - a0[1] * sn[0]; v0[1] = a0[1] * cs[0] + a0[0] * sn[0];
                        v0[2] = a0[2] * cs[1] - a0[3] * sn[1]; v0[3] = a0[3] * cs[1] + a0[2] * sn[1];
                        v1[0] = a1[0] * cs[2] - a1[1] * sn[2]; v1[1] = a1[1] * cs[2] + a1[0] * sn[2];
                        v1[2] = a1[2] * cs[3] - a1[3] * sn[3]; v1[3] = a1[3] * cs[3] + a1[2] * sn[3]; }
                    v4u w; w.x = pk2(v0[0], v0[1]); w.y = pk2(v0[2], v0[3]); w.z = pk2(v1[0], v1[1]); w.w = pk2(v1[2], v1[3]);
                    *(v4u*)(Q + (size_t)row * 768 + c0b[bj]) = w; } }
        }
    }
};
struct EpiKV {
    static constexpr bool PERM = true, AFTER_DRAIN = false;
    bf16* K; bf16* V; const float* rkv;
    __device__ __forceinline__ void operator()(const f32x4 (&acc)[2][2][4][2], const pg8::Unit& u, int wr, int wc, int fr, int fq) const {
        const int row0 = u.pm * 256 + wr * 64 + fr;
        float rr[2][4];
#pragma unroll
        for (int ai = 0; ai < 2; ++ai)
#pragma unroll
            for (int m = 0; m < 4; ++m) rr[ai][m] = rkv[row0 + ai * 128 + m * 16];
#pragma unroll
        for (int ai = 0; ai < 2; ++ai)
#pragma unroll
            for (int m = 0; m < 4; ++m) { const int row = row0 + ai * 128 + m * 16; const float r = rr[ai][m];
#pragma unroll
                for (int bj = 0; bj < 2; ++bj) { const int c0 = u.pn * 256 + bj * 128 + wc * 32 + 8 * fq;
                    const f32x4 v0 = acc[ai][bj][m][0] * r, v1 = acc[ai][bj][m][1] * r;
                    bf16* dst = (c0 < 512) ? (K + (size_t)row * 768 + 96 * (c0 >> 6) + (c0 & 63)) : (V + (size_t)row * 512 + (c0 - 512));
                    v4u w; w.x = pk2(v0[0], v0[1]); w.y = pk2(v0[2], v0[3]); w.z = pk2(v1[0], v1[1]); w.w = pk2(v1[2], v1[3]);
                    *(v4u*)dst = w; } }
    }
};
struct EpiMerge {
    static constexpr bool PERM = true, AFTER_DRAIN = false;
    bf16* Mg; const bf16* gate; int first;
    __device__ __forceinline__ void operator()(const f32x4 (&acc)[2][2][4][2], const pg8::Unit& u, int wr, int wc, int fr, int fq) const {
        const int row0 = u.pm * 256 + wr * 64 + fr, cbase = u.pn * 256 + wc * 32 + 8 * fq;
#pragma unroll
        for (int ai = 0; ai < 2; ++ai) {
            v4u gq[4][2], oq[4][2];
#pragma unroll
            for (int m = 0; m < 4; ++m)
#pragma unroll
                for (int bj = 0; bj < 2; ++bj) { const size_t off = (size_t)(row0 + ai * 128 + m * 16) * 1024 + cbase + bj * 128;
                    gq[m][bj] = *(const v4u*)(gate + off); oq[m][bj] = first ? (v4u){0u, 0u, 0u, 0u} : *(const v4u*)(Mg + off); }
            __builtin_amdgcn_sched_barrier(0);
#pragma unroll
            for (int m = 0; m < 4; ++m)
#pragma unroll
                for (int bj = 0; bj < 2; ++bj) { const size_t off = (size_t)(row0 + ai * 128 + m * 16) * 1024 + cbase + bj * 128;
                    const v4u g = gq[m][bj], o = oq[m][bj];
                    f32x4 v0 = acc[ai][bj][m][0], v1 = acc[ai][bj][m][1];
                    v0[0] = v0[0] * bflo(g.x) + bflo(o.x); v0[1] = v0[1] * bfhi(g.x) + bfhi(o.x); v0[2] = v0[2] * bflo(g.y) + bflo(o.y); v0[3] = v0[3] * bfhi(g.y) + bfhi(o.y);
                    v1[0] = v1[0] * bflo(g.z) + bflo(o.z); v1[1] = v1[1] * bfhi(g.z) + bfhi(o.z); v1[2] = v1[2] * bflo(g.w) + bflo(o.w); v1[3] = v1[3] * bfhi(g.w) + bfhi(o.w);
                    v4u w; w.x = pk2(v0[0], v0[1]); w.y = pk2(v0[2], v0[3]); w.z = pk2(v1[0], v1[1]); w.w = pk2(v1[2], v1[3]);
                    *(v4u*)(Mg + off) = w; }
        }
    }
};
template <bool XBF> struct EpiResid {
    static constexpr bool PERM = true, AFTER_DRAIN = false;
    const void* xin; bf16* xout; const float* gate;
    __device__ __forceinline__ void operator()(const f32x4 (&acc)[2][2][4][2], const pg8::Unit& u, int wr, int wc, int fr, int fq) const {
        const int row0 = u.pm * 256 + wr * 64 + fr, b = (u.pm * 256) >> 11, cbase = u.pn * 256 + wc * 32 + 8 * fq;
        f32x4 gv[2][2];
#pragma unroll
        for (int bj = 0; bj < 2; ++bj) { const float* gp = gate + (size_t)b * NADA + cbase + bj * 128; gv[bj][0] = *(const f32x4*)gp; gv[bj][1] = *(const f32x4*)(gp + 4); }
#pragma unroll
        for (int ai = 0; ai < 2; ++ai) {
            f32x4 xv[4][2][2];
#pragma unroll
            for (int m = 0; m < 4; ++m)
#pragma unroll
                for (int bj = 0; bj < 2; ++bj) { const size_t off = (size_t)(row0 + ai * 128 + m * 16) * 1024 + cbase + bj * 128;
                    if (XBF) { const v4u w = *(const v4u*)((const bf16*)xin + off); xv[m][bj][0] = (f32x4){bflo(w.x), bfhi(w.x), bflo(w.y), bfhi(w.y)}; xv[m][bj][1] = (f32x4){bflo(w.z), bfhi(w.z), bflo(w.w), bfhi(w.w)}; }
                    else { xv[m][bj][0] = *(const f32x4*)((const float*)xin + off); xv[m][bj][1] = *(const f32x4*)((const float*)xin + off + 4); } }
            __builtin_amdgcn_sched_barrier(0);
#pragma unroll
            for (int m = 0; m < 4; ++m)
#pragma unroll
                for (int bj = 0; bj < 2; ++bj) { const size_t off = (size_t)(row0 + ai * 128 + m * 16) * 1024 + cbase + bj * 128;
                    const f32x4 o0 = xv[m][bj][0] + gv[bj][0] * acc[ai][bj][m][0], o1 = xv[m][bj][1] + gv[bj][1] * acc[ai][bj][m][1];
                    v4u w; w.x = pk2(o0[0], o0[1]); w.y = pk2(o0[2], o0[3]); w.z = pk2(o1[0], o1[1]); w.w = pk2(o1[2], o1[3]);
                    *(v4u*)(xout + off) = w; }
        }
    }
};

template <class Get> __device__ __forceinline__ void prep_tile(const Get& get, bf16* dst, int K, int k0, int n0, LAS float* scr, int lane) {
    float tv[32];
#pragma unroll
    for (int i = 0; i < 32; ++i) tv[i] = get(k0 + 2 * i + (lane >> 5), n0 + (lane & 31));
#pragma unroll
    for (int i = 0; i < 32; ++i) { const int kk = 2 * i + (lane >> 5); scr[kk * 33 + (lane & 31)] = tv[i]; }
    LDS_WAIT(); asm volatile("" ::: "memory");
    const int c = lane & 7;
#pragma unroll
    for (int j = 0; j < 4; ++j) { const int n = (lane >> 3) + 8 * j; const LAS float* s = scr + (8 * c) * 33 + n;
        v4u o; o.x = pk2(s[0 * 33], s[1 * 33]); o.y = pk2(s[2 * 33], s[3 * 33]); o.z = pk2(s[4 * 33], s[5 * 33]); o.w = pk2(s[6 * 33], s[7 * 33]);
        *(GAS v4u*)(dst + (size_t)(n0 + n) * K + k0 + 8 * c) = o; }
    LDS_WAIT(); asm volatile("" ::: "memory");
}
struct GetWin { const float* w; __device__ __forceinline__ float operator()(int k, int n) const {
    int sc; if (n < 1024) sc = n; else if (n < 2048) sc = n + 32; else if (n < 4096) sc = n + 40; else if (n < 4128) sc = n - 3072; else if (n < 4136) sc = n - 2048; else sc = -1;
    return sc < 0 ? 0.f : w[(size_t)k * 4136 + sc]; } };
struct GetWq { const float* w; const float* g; __device__ __forceinline__ float operator()(int k, int n) const {
    const int h = n / 96, dd = n % 96; const int e = dd - 64; const int sd = dd < 64 ? dd : 64 + (e >> 1) + 16 * (e & 1);
    return w[(size_t)k * 768 + h * 96 + sd] * g[k] * QSCALE; } };
struct GetWkv { const float* w; const float* g; __device__ __forceinline__ float operator()(int k, int n) const {
    const int nn = n & 511, h = nn >> 6, c = nn & 63; const int sc = h * 128 + c + ((n >= 512) ? 64 : 0);
    return w[(size_t)k * 1024 + sc] * g[k]; } };
struct GetPlain { const float* w; int N; __device__ __forceinline__ float operator()(int k, int n) const { return w[(size_t)k * N + n]; } };
struct GetWqk { const float* wq; const float* wk; __device__ __forceinline__ float operator()(int k, int n) const {
    const int c = n >> 9, part = (n >> 8) & 1, h = 2 * c + ((n >> 7) & 1), e = n & 127, kh = k >> 7, d = k & 127;
    if (kh != h) return 0.f;
    const size_t off = ((size_t)h * 128 + d) * 128 + e;
    return part ? wk[off] * 0.08838834764831845f : wq[off]; } };
struct GetWv { const float* wv; __device__ __forceinline__ float operator()(int k, int n) const {
    const int h = n >> 7, e = n & 127, kh = k >> 7, d = k & 127;
    return (kh != h) ? 0.f : wv[((size_t)h * 128 + d) * 128 + e]; } };

__device__ const float INV_FREQ[16] = { 1.0f, 0.5623413251903491f, 0.31622776601683794f, 0.1778279410038923f, 0.1f, 0.05623413251903491f, 0.031622776601683794f, 0.01778279410038923f,
    0.01f, 0.005623413251903491f, 0.0031622776601683794f, 0.001778279410038923f, 0.001f, 0.0005623413251903491f, 0.00031622776601683794f, 0.0001778279410038923f };

template <bool XBF> __device__ __forceinline__ void rowpass_norm_mod(const void* xin_, const float* g, const float* ada_shift, const float* ada_scale, bf16* hout, int gw, int NGW, int lane, unsigned char* h8 = nullptr, float* xs = nullptr) {
#define RP_LOAD(dst, row) { if (XBF) { const u32x2* p_ = (const u32x2*)((const bf16*)xin_ + (size_t)(row) * D) + lane; _Pragma("unroll") for (int j = 0; j < 4; ++j) { const u32x2 w_ = p_[64 * j]; dst[j] = (f32x4){bflo(w_.x), bfhi(w_.x), bflo(w_.y), bfhi(w_.y)}; } } \
                          else { const f32x4* p_ = (const f32x4*)((const float*)xin_ + (size_t)(row) * D) + lane; _Pragma("unroll") for (int j = 0; j < 4; ++j) dst[j] = p_[64 * j]; } }
    f32x4 vn[4];
    if (gw < T) RP_LOAD(vn, gw);
    for (int t = gw; t < T; t += NGW) {
        const int b = t >> 11;
        f32x4 v[4]; float s = 0.f;
#pragma unroll
        for (int j = 0; j < 4; ++j) { v[j] = vn[j]; s += dot4(v[j], v[j]); }
        { const int tn = (t + NGW < T) ? t + NGW : t;
          RP_LOAD(vn, tn); }
        const float r = rsqrtf(wave_sum(s) * (1.f / D) + RMS_EPS);
        unsigned long long* o8 = (unsigned long long*)(hout + (size_t)t * D) + lane;
        f32x4 ov[4]; float am = 0.f;
#pragma unroll
        for (int j = 0; j < 4; ++j) { const int col = 4 * lane + 256 * j;
            const f32x4 gg = *(const f32x4*)(g + col), sc = *(const f32x4*)(ada_scale + (size_t)b * NADA + col), sh = *(const f32x4*)(ada_shift + (size_t)b * NADA + col);
            const f32x4 o = v[j] * r * gg * (sc + 1.f) + sh; ov[j] = o;
            am = fmaxf(fmaxf(am, fmaxf(fabsf(o.x), fabsf(o.y))), fmaxf(fabsf(o.z), fabsf(o.w)));
            o8[64 * j] = (unsigned long long)pk2(o.x, o.y) | ((unsigned long long)pk2(o.z, o.w) << 32); }
        if (h8) {
#pragma unroll
            for (int o = 1; o < 64; o <<= 1) am = fmaxf(am, __shfl_xor(am, o));
            const float inv = am > 0.f ? 127.f / am : 0.f;
#pragma unroll
            for (int j = 0; j < 4; ++j) { const int q0 = (int)rintf(ov[j].x * inv), q1 = (int)rintf(ov[j].y * inv), q2 = (int)rintf(ov[j].z * inv), q3 = (int)rintf(ov[j].w * inv);
                ((unsigned*)(h8 + (size_t)t * D))[lane + 64 * j] = (unsigned)(q0 & 255) | ((unsigned)(q1 & 255) << 8) | ((unsigned)(q2 & 255) << 16) | ((unsigned)(q3 & 255) << 24); }
            if (lane == 0) xs[t] = am * (1.f / 127.f);
        }
    }
}
__device__ __forceinline__ void rowpass_final(const bf16* xin_, const float* g, float* out, int gw, int NGW, int lane) {
    constexpr bool XBF = true;
    f32x4 vn[4];
    if (gw < T) RP_LOAD(vn, gw);
    for (int t = gw; t < T; t += NGW) {
        f32x4 v[4]; float s = 0.f;
#pragma unroll
        for (int j = 0; j < 4; ++j) { v[j] = vn[j]; s += dot4(v[j], v[j]); }
        { const int tn = (t + NGW < T) ? t + NGW : t;
          RP_LOAD(vn, tn); }
        const float r = rsqrtf(wave_sum(s) * (1.f / D) + RMS_EPS);
        f32x4* o = (f32x4*)(out + (size_t)t * D) + lane;
#pragma unroll
        for (int j = 0; j < 4; ++j) { const f32x4 gg = *(const f32x4*)(g + 4 * lane + 256 * j); o[64 * j] = v[j] * r * gg; }
    }
}
#undef RP_LOAD
__device__ __forceinline__ void rowpass_mid(const bf16* qlat, const bf16* kvlat, const float* small, const float* smallp, const float* cosT, const float* sinT, const bf16* um,
                                            const float* conv_w, const float* conv_b, const float* b_i, const float* b_f,
                                            float* RQ, float* RKV, bf16* K, float* LOGI, float* LOGF, bf16* CONV, int gw, int NGW, int lane) {
    const int c0 = 8 * lane;
    f32x4 cw[4][2], cb[2];
#pragma unroll
    for (int j = 0; j < 4; ++j) { cw[j][0] = *(const f32x4*)(conv_w + j * 512 + c0); cw[j][1] = *(const f32x4*)(conv_w + j * 512 + c0 + 4); }
    cb[0] = *(const f32x4*)(conv_b + c0); cb[1] = *(const f32x4*)(conv_b + c0 + 4);
    const float bsel = (lane >= 32 && lane < 36) ? b_i[lane - 32] : (lane >= 36 && lane < 40) ? b_f[lane - 36] : 0.f;
    for (int tb = gw * 4; tb < T; tb += NGW * 4) {
        const int pos0 = tb & (SEQ - 1);
        u32x2 qv[4][3], kvv[4]; v4u uw[7]; float sv[4], cs[4], sn[4];
#pragma unroll
        for (int i = 0; i < 4; ++i) { const int t = tb + i; const u32x2* p = (const u32x2*)(qlat + (size_t)t * 768);
#pragma unroll
            for (int j = 0; j < 3; ++j) qv[i][j] = p[lane + 64 * j];
            kvv[i] = ((const u32x2*)(kvlat + (size_t)t * 256))[lane];
            sv[i] = 0.f;
            if (lane < 40) sv[i] = smallp ? ((smallp[(size_t)t * 64 + lane] + smallp[(size_t)(T + t) * 64 + lane]) + (smallp[(size_t)(2 * T + t) * 64 + lane] + smallp[(size_t)(3 * T + t) * 64 + lane]))
                                         : small[(size_t)t * 64 + lane];
            cs[i] = 0.f; sn[i] = 0.f; if (lane < 16) { cs[i] = cosT[(size_t)t * 16 + lane]; sn[i] = sinT[(size_t)t * 16 + lane]; } }
#pragma unroll
        for (int j = 0; j < 7; ++j) { uw[j] = (v4u){0u, 0u, 0u, 0u}; if (pos0 - 3 + j >= 0) uw[j] = *(const v4u*)(um + (size_t)(tb - 3 + j) * 512 + c0); }
#pragma unroll
        for (int i = 0; i < 4; ++i) { const int t = tb + i;
            float s = 0.f;
#pragma unroll
            for (int j = 0; j < 3; ++j) { const u32x2 w = qv[i][j]; const float a = bflo(w.x), b2 = bfhi(w.x), c = bflo(w.y), d = bfhi(w.y); s += (a * a + b2 * b2) + (c * c + d * d); }
            const float rq = rsqrtf(wave_sum(s) * (1.f / 768.f) + RMS_EPS);
            const u32x2 w = kvv[i]; const float a = bflo(w.x), b2 = bfhi(w.x), c = bflo(w.y), d = bfhi(w.y);
            const float rkv = rsqrtf(wave_sum((a * a + b2 * b2) + (c * c + d * d)) * (1.f / 256.f) + RMS_EPS);
            if (lane == 0) { RQ[t] = rq; RKV[t] = rkv; }
            const float x2 = __shfl(sv[i], (lane + 16) & 63);
            if (lane < 16) { const float x1 = sv[i]; const unsigned pk = pk2(x1 * cs[i] - x2 * sn[i], x2 * cs[i] + x1 * sn[i]);
#pragma unroll
                for (int h = 0; h < 8; ++h) ((unsigned*)(K + (size_t)t * 768 + 96 * h + 64))[lane] = pk; }
            else if (lane >= 32 && lane < 36) LOGI[(size_t)t * 4 + (lane - 32)] = sv[i] + bsel;
            else if (lane >= 36 && lane < 40) { const float x = sv[i] + bsel; LOGF[(size_t)t * 4 + (lane - 36)] = fminf(x, 0.f) - log1pf(expf(-fabsf(x))); }
            float acc[8];
            acc[0] = cb[0][0]; acc[1] = cb[0][1]; acc[2] = cb[0][2]; acc[3] = cb[0][3]; acc[4] = cb[1][0]; acc[5] = cb[1][1]; acc[6] = cb[1][2]; acc[7] = cb[1][3];
#pragma unroll
            for (int j = 0; j < 4; ++j) { const v4u u4 = uw[i + j];
                acc[0] += cw[j][0][0] * bflo(u4.x); acc[1] += cw[j][0][1] * bfhi(u4.x); acc[2] += cw[j][0][2] * bflo(u4.y); acc[3] += cw[j][0][3] * bfhi(u4.y);
                acc[4] += cw[j][1][0] * bflo(u4.z); acc[5] += cw[j][1][1] * bfhi(u4.z); acc[6] += cw[j][1][2] * bflo(u4.w); acc[7] += cw[j][1][3] * bfhi(u4.w); }
#pragma unroll
            for (int q = 0; q < 8; ++q) acc[q] = acc[q] * sigm(acc[q]);
            v4u o; o.x = pk2(acc[0], acc[1]); o.y = pk2(acc[2], acc[3]); o.z = pk2(acc[4], acc[5]); o.w = pk2(acc[6], acc[7]);
            *(v4u*)(CONV + (size_t)t * 512 + c0) = o; }
    }
}

typedef float f32x16 __attribute__((ext_vector_type(16)));
typedef short s16x4 __attribute__((ext_vector_type(4)));
typedef short v4i16_t __attribute__((ext_vector_type(4)));
typedef float f32x2_t __attribute__((ext_vector_type(2))); typedef __bf16 bf16x2_t __attribute__((ext_vector_type(2)));
__device__ __forceinline__ unsigned cvtpk(float lo, float hi) { f32x2_t v = {lo, hi}; bf16x2_t b = __builtin_convertvector(v, bf16x2_t); return __builtin_bit_cast(unsigned, b); }
__device__ __forceinline__ s16x4 vtr(const LAS unsigned char* p) { return __builtin_bit_cast(s16x4, __builtin_amdgcn_ds_read_tr16_b64_v4i16((LAS v4i16_t*)p)); }
__device__ __forceinline__ bf16x8 pack8(float a0, float a1, float a2, float a3, float a4, float a5, float a6, float a7) {
    v4u p; p.x = cvtpk(a0, a1); p.y = cvtpk(a2, a3); p.z = cvtpk(a4, a5); p.w = cvtpk(a6, a7); return __builtin_bit_cast(bf16x8, p); }
#define MFMA32(a, b, c) __builtin_amdgcn_mfma_f32_32x32x16_bf16((a), (b), (c), 0, 0, 0)
constexpr int AT_KB = 12288, AT_VB = 8192;
__device__ __forceinline__ void attn_mfma(const bf16* Q, const bf16* K, const bf16* V, bf16* AO, LAS unsigned char* lds, int bx, int G, int tid) {
    const int lane = tid & 63, wave = __builtin_amdgcn_readfirstlane(tid >> 6), r = lane & 31, hh = lane >> 5;
    const int i16 = lane & 15, q4 = i16 >> 2, p4 = i16 & 3, blk = (lane >> 4) & 1;
    const int vboff = (4 * hh + q4) * 64 + 32 * blk + 8 * p4;
    const int kr0 = tid / 12, kc0 = tid % 12, kr1 = (tid + 512) / 12, kc1 = (tid + 512) % 12, vr = tid >> 3, vc = tid & 7;
    const int klds0 = (kc0 >> 1) * 2048 + (kc0 & 1) * 1024 + kr0 * 16, klds1 = (kc1 >> 1) * 2048 + (kc1 & 1) * 1024 + kr1 * 16;
    const int vlds = (vc >> 2) * 4096 + (vr >> 4) * 1024 + ((vr >> 3) & 1) * 512 + (vr & 7) * 64 + (vc & 3) * 16;
    for (int pu = bx; pu < 256; pu += G) {
        const int bh = pu >> 2, b = bh >> 3, h = bh & 7;
        const bf16* kg = K + ((size_t)b * SEQ) * 768 + h * 96; const bf16* vg = V + ((size_t)b * SEQ) * 512 + h * 64;
        for (int half = 0; half < 2; ++half) {
            const int qb = half == 0 ? 7 - (pu & 3) : (pu & 3);
            const int q0w = qb * 256 + wave * 32, nkt = 4 * (qb + 1), kmax = (q0w + 31) >> 6;
            bf16x8 qf[6];
            { const bf16* qrow = Q + ((size_t)b * SEQ + q0w + r) * 768 + h * 96 + 8 * hh;
#pragma unroll
              for (int s = 0; s < 6; ++s) qf[s] = *(const bf16x8*)(qrow + 16 * s); }
            f32x16 o0, o1;
#pragma unroll
            for (int i = 0; i < 16; ++i) { o0[i] = 0.f; o1[i] = 0.f; }
            float m = 0.f, l = 0.f; f32x16 negm;
#pragma unroll
            for (int i = 0; i < 16; ++i) negm[i] = 0.f;
            v4u ka = *(const v4u*)(kg + (size_t)kr0 * 768 + kc0 * 8), kb2 = (v4u){0u, 0u, 0u, 0u}, va = *(const v4u*)(vg + (size_t)vr * 512 + vc * 8);
            if (tid < 256) kb2 = *(const v4u*)(kg + (size_t)kr1 * 768 + kc1 * 8);
            __syncthreads();
            *(LAS v4u*)(lds + klds0) = ka; if (tid < 256) *(LAS v4u*)(lds + klds1) = kb2; *(LAS v4u*)(lds + 2 * AT_KB + vlds) = va;
            __syncthreads();
            for (int kt = 0; kt < nkt; ++kt) {
                const int buf = kt & 1;
                if (kt + 1 < nkt) { const size_t k1 = (size_t)(kt + 1) * 64;
                    ka = *(const v4u*)(kg + (k1 + kr0) * 768 + kc0 * 8); if (tid < 256) kb2 = *(const v4u*)(kg + (k1 + kr1) * 768 + kc1 * 8); va = *(const v4u*)(vg + (k1 + vr) * 512 + vc * 8); }
                if (kt <= kmax) {
                    const LAS unsigned char* kb_ = lds + buf * AT_KB + hh * 1024 + r * 16; const LAS unsigned char* vb_ = lds + 2 * AT_KB + buf * AT_VB + vboff;
                    f32x16 s0, s1;
                    { bf16x8 kf0[6], kf1[6];
#pragma unroll
                      for (int s = 0; s < 6; ++s) { kf0[s] = *(const LAS bf16x8*)(kb_ + s * 2048); kf1[s] = *(const LAS bf16x8*)(kb_ + s * 2048 + 512); }
                      __builtin_amdgcn_sched_barrier(0);
                      s0 = MFMA32(kf0[0], qf[0], negm); s1 = MFMA32(kf1[0], qf[0], negm);
#pragma unroll
                      for (int s = 1; s < 6; ++s) { s0 = MFMA32(kf0[s], qf[s], s0); s1 = MFMA32(kf1[s], qf[s], s1); } }
                    if (kt * 64 + 63 > q0w) { const int qq = q0w + r - kt * 64;
#pragma unroll
                        for (int i = 0; i < 16; ++i) { const int key = (i & 3) + 8 * (i >> 2) + 4 * hh; if (key > qq) s0[i] = -INFINITY; if (key + 32 > qq) s1[i] = -INFINITY; } }
                    float mx = fmaxf(fmaxf(s0[0], s1[0]), fmaxf(s0[1], s1[1]));
#pragma unroll
                    for (int i = 2; i < 16; i += 2) mx = fmaxf(fmaxf(mx, fmaxf(s0[i], s1[i])), fmaxf(s0[i + 1], s1[i + 1]));
                    { auto r32 = __builtin_amdgcn_permlane32_swap(__float_as_uint(mx), __float_as_uint(mx), false, false); mx = fmaxf(__uint_as_float(r32[0]), __uint_as_float(r32[1])); }
                    if (kt == 0 || __builtin_amdgcn_ballot_w64(mx > 8.f) != 0ull) {
                        const float d = (kt == 0) ? mx : fmaxf(mx, 0.f), corr = (kt == 0) ? 0.f : __builtin_amdgcn_exp2f(-d);
                        m = (kt == 0) ? mx : m + d; l *= corr;
#pragma unroll
                        for (int i = 0; i < 16; ++i) { o0[i] *= corr; o1[i] *= corr; s0[i] -= d; s1[i] -= d; negm[i] = -m; } }
                    float ps = 0.f;
#pragma unroll
                    for (int i = 0; i < 16; ++i) { s0[i] = __builtin_amdgcn_exp2f(s0[i]); s1[i] = __builtin_amdgcn_exp2f(s1[i]); ps += s0[i] + s1[i]; }
                    l += ps;
                    bf16x8 pf[4];
                    pf[0] = pack8(s0[0], s0[1], s0[2], s0[3], s0[4], s0[5], s0[6], s0[7]); pf[1] = pack8(s0[8], s0[9], s0[10], s0[11], s0[12], s0[13], s0[14], s0[15]);
                    pf[2] = pack8(s1[0], s1[1], s1[2], s1[3], s1[4], s1[5], s1[6], s1[7]); pf[3] = pack8(s1[8], s1[9], s1[10], s1[11], s1[12], s1[13], s1[14], s1[15]);
                    { s16x4 vlo[8], vhi[8];
#pragma unroll
                      for (int ks = 0; ks < 4; ++ks) { vlo[ks] = vtr(vb_ + ks * 1024); vhi[ks] = vtr(vb_ + ks * 1024 + 512); vlo[4 + ks] = vtr(vb_ + 4096 + ks * 1024); vhi[4 + ks] = vtr(vb_ + 4096 + ks * 1024 + 512); }
                      __builtin_amdgcn_sched_barrier(0);
#pragma unroll
                      for (int ks = 0; ks < 4; ++ks) {
                          const bf16x8 a0 = (bf16x8){vlo[ks][0], vlo[ks][1], vlo[ks][2], vlo[ks][3], vhi[ks][0], vhi[ks][1], vhi[ks][2], vhi[ks][3]};
                          const bf16x8 a1 = (bf16x8){vlo[4 + ks][0], vlo[4 + ks][1], vlo[4 + ks][2], vlo[4 + ks][3], vhi[4 + ks][0], vhi[4 + ks][1], vhi[4 + ks][2], vhi[4 + ks][3]};
                          o0 = MFMA32(a0, pf[ks], o0); o1 = MFMA32(a1, pf[ks], o1); } }
                }
                if (kt + 1 < nkt) { LAS unsigned char* nb = lds + (buf ^ 1) * AT_KB; *(LAS v4u*)(nb + klds0) = ka; if (tid < 256) *(LAS v4u*)(nb + klds1) = kb2; *(LAS v4u*)(lds + 2 * AT_KB + (buf ^ 1) * AT_VB + vlds) = va; }
                __syncthreads();
            }
            const float inv = 1.f / (l + __shfl_xor(l, 32));
            bf16* orow = AO + ((size_t)b * SEQ + q0w + r) * 512 + h * 64 + 4 * hh;
#pragma unroll
            for (int g = 0; g < 4; ++g) { u32x2 w0, w1; w0.x = cvtpk(o0[4 * g] * inv, o0[4 * g + 1] * inv); w0.y = cvtpk(o0[4 * g + 2] * inv, o0[4 * g + 3] * inv);
                w1.x = cvtpk(o1[4 * g] * inv, o1[4 * g + 1] * inv); w1.y = cvtpk(o1[4 * g + 2] * inv, o1[4 * g + 3] * inv);
                *(u32x2*)(orow + 8 * g) = w0; *(u32x2*)(orow + 32 + 8 * g) = w1; }
        }
    }
}


constexpr int ML_KB = 16384, ML_VB = 16384, ML_BUF = 32768, ML_TAB = 3 * 32768;
__device__ __forceinline__ void mlstm_mfma(const bf16* QKM, const bf16* VM, const float* LOGI, const float* LOGF, const bf16* CONV, const bf16* OPRE, const float* ng, const float* skip,
                                           bf16* OUTM, LAS unsigned char* lds, int bx, int G, int tid) {
    const int lane = tid & 63, wave = __builtin_amdgcn_readfirstlane(tid >> 6), r = lane & 31, hh = lane >> 5;
    const int i16 = lane & 15, q4 = i16 >> 2, p4 = i16 & 3, blk = (lane >> 4) & 1;
    const int vboff = (4 * hh + q4) * 64 + 32 * blk + 8 * p4;
    int goff[4], loff[4];
#pragma unroll
    for (int q = 0; q < 4; ++q) { const int j = 4 * wave + q;
        if (j < 16) { goff[q] = lane * 1024 + 16 * (j >> 1) + 8 * (j & 1); loff[q] = (j >> 1) * 2048 + (j & 1) * 1024; }
        else { const int jv = j - 16, dq = jv >> 2, ks = jv & 3; goff[q] = (16 * ks + 8 * (lane >> 5) + ((lane >> 2) & 7)) * 512 + 32 * dq + 8 * (lane & 3); loff[q] = ML_KB + dq * 4096 + ks * 1024; } }
    const bool kwave = wave < 4;
#define ML_DMA(tile, bufi) do { _Pragma("unroll") for (int q_ = 0; q_ < 4; ++q_) { \
        const bf16* src_ = kwave ? (kg + (size_t)(tile) * 64 * 1024 + goff[q_]) : (vg + (size_t)(tile) * 64 * 512 + goff[q_]); \
        __builtin_amdgcn_global_load_lds((const unsigned*)src_, (LAS unsigned*)(lds + (bufi) * ML_BUF + loff[q_]), 16, 0, 0); } } while (0)
    LAS float* Ftab = (LAS float*)(lds + ML_TAB); LAS float* Ctab = Ftab + 2048; LAS float* wtot = Ctab + 2048;
    constexpr float L2E = 1.4426950408889634f;
    for (int pu = bx; pu < 256; pu += G) {
        const int bh = pu >> 3, p = pu & 7, b = bh >> 2, h = bh & 3;
        __syncthreads();
        { float f4[4], i4[4];
#pragma unroll
          for (int e = 0; e < 4; ++e) { const size_t row = (size_t)b * SEQ + tid * 4 + e; f4[e] = LOGF[row * 4 + h]; i4[e] = LOGI[row * 4 + h]; }
          f4[1] += f4[0]; f4[2] += f4[1]; f4[3] += f4[2];
          float x = f4[3];
          x += __uint_as_float(__builtin_amdgcn_update_dpp(0, __float_as_uint(x), 0x111, 0xf, 0xf, true)); x += __uint_as_float(__builtin_amdgcn_update_dpp(0, __float_as_uint(x), 0x112, 0xf, 0xf, true));
          x += __uint_as_float(__builtin_amdgcn_update_dpp(0, __float_as_uint(x), 0x114, 0xf, 0xf, true)); x += __uint_as_float(__builtin_amdgcn_update_dpp(0, __float_as_uint(x), 0x118, 0xf, 0xf, true));
          { const float t0 = __uint_as_float(__builtin_amdgcn_readlane(__float_as_uint(x), 15)), t1 = __uint_as_float(__builtin_amdgcn_readlane(__float_as_uint(x), 31)), t2 = __uint_as_float(__builtin_amdgcn_readlane(__float_as_uint(x), 47));
            const int row = lane >> 4; x += (row >= 1 ? t0 : 0.f) + (row >= 2 ? t1 : 0.f) + (row >= 3 ? t2 : 0.f); }
          if (lane == 63) wtot[wave] = x;
          __syncthreads();
          float base = x - f4[3];
          for (int w = 0; w < wave; ++w) base += wtot[w];
#pragma unroll
          for (int e = 0; e < 4; ++e) { const float F = base + f4[e]; Ftab[tid * 4 + e] = F * L2E; Ctab[tid * 4 + e] = (i4[e] - F) * L2E; } }
        __syncthreads();
        const int grp = wave >> 2, w4 = wave & 3;
        const int q0w = (grp == 0 ? 128 * p : 128 * (15 - p)) + 32 * w4, kmax = (q0w + 31) >> 6, nkt = 2 * (16 - p);
        const size_t trow = (size_t)b * SEQ + q0w + r;
        bf16x8 qf[8];
        { const bf16* qrow = QKM + trow * 1024 + h * 128 + 8 * hh;
#pragma unroll
          for (int s = 0; s < 8; ++s) qf[s] = *(const bf16x8*)(qrow + 16 * s); }
        const float Ft = Ftab[q0w + r], Ft0 = Ftab[q0w];
        LAS float* wt = Ctab + 2048 + 64 + wave * 64;
        f32x16 o[4];
#pragma unroll
        for (int d = 0; d < 4; ++d)
#pragma unroll
            for (int i = 0; i < 16; ++i) o[d][i] = 0.f;
        float den = 0.f;
        const bf16* kg = QKM + ((size_t)b * SEQ) * 1024 + 512 + h * 128; const bf16* vg = VM + ((size_t)b * SEQ) * 512 + h * 128;
        ML_DMA(0, 0);
        if (nkt > 1) { ML_DMA(1, 1); asm volatile("s_waitcnt vmcnt(4)" ::: "memory"); } else asm volatile("s_waitcnt vmcnt(0)" ::: "memory");
        asm volatile("s_waitcnt lgkmcnt(0)" ::: "memory"); __builtin_amdgcn_s_barrier(); asm volatile("" ::: "memory");
        for (int kt = 0; kt < nkt; ++kt) {
            const int buf = kt % 3;
            if (kt + 2 < nkt) ML_DMA(kt + 2, (kt + 2) % 3);
            if (kt <= kmax) {
                const LAS unsigned char* kb_ = lds + buf * ML_BUF + hh * 1024 + r * 16; const LAS unsigned char* vb_ = lds + buf * ML_BUF + ML_KB + vboff;
                f32x16 s0, s1;
#pragma unroll
                for (int i = 0; i < 16; ++i) { s0[i] = 0.f; s1[i] = 0.f; }
#pragma unroll
                for (int sh = 0; sh < 2; ++sh) { bf16x8 kf0[4], kf1[4];
#pragma unroll
                  for (int s = 0; s < 4; ++s) { kf0[s] = *(const LAS bf16x8*)(kb_ + (4 * sh + s) * 2048); kf1[s] = *(const LAS bf16x8*)(kb_ + (4 * sh + s) * 2048 + 512); }
                  __builtin_amdgcn_sched_barrier(0);
#pragma unroll
                  for (int s = 0; s < 4; ++s) { s0 = MFMA32(kf0[s], qf[4 * sh + s], s0); s1 = MFMA32(kf1[s], qf[4 * sh + s], s1); } }
                const int qq = q0w + r - kt * 64;
                const bool diag = kt * 64 + 63 > q0w;
                wt[lane] = __builtin_amdgcn_exp2f(Ctab[kt * 64 + lane] + Ft0);
                LDS_WAIT();
                const LAS float* ct = wt + 4 * hh;
                float ps = 0.f;
#pragma unroll
                for (int g = 0; g < 4; ++g) { const f32x4 c0v = *(const LAS f32x4*)(ct + 8 * g), c1v = *(const LAS f32x4*)(ct + 32 + 8 * g);
#pragma unroll
                    for (int e = 0; e < 4; ++e) { const int i = 4 * g + e, key = e + 8 * g + 4 * hh;
                        float w0 = c0v[e], w1 = c1v[e];
                        if (diag) { w0 = (key <= qq) ? w0 : 0.f; w1 = (key + 32 <= qq) ? w1 : 0.f; }
                        s0[i] *= w0; s1[i] *= w1; ps += s0[i] + s1[i]; } }
                den += ps;
                bf16x8 pf[4];
                pf[0] = pack8(s0[0], s0[1], s0[2], s0[3], s0[4], s0[5], s0[6], s0[7]); pf[1] = pack8(s0[8], s0[9], s0[10], s0[11], s0[12], s0[13], s0[14], s0[15]);
                pf[2] = pack8(s1[0], s1[1], s1[2], s1[3], s1[4], s1[5], s1[6], s1[7]); pf[3] = pack8(s1[8], s1[9], s1[10], s1[11], s1[12], s1[13], s1[14], s1[15]);
#pragma unroll
                for (int ks = 0; ks < 4; ++ks) { s16x4 vlo[4], vhi[4];
#pragma unroll
                    for (int d = 0; d < 4; ++d) { vlo[d] = vtr(vb_ + d * 4096 + ks * 1024); vhi[d] = vtr(vb_ + d * 4096 + ks * 1024 + 512); }
                    __builtin_amdgcn_sched_barrier(0);
#pragma unroll
                    for (int d = 0; d < 4; ++d) { const s16x4 lo = vlo[d], hi = vhi[d];
                        const bf16x8 av = (bf16x8){lo[0], lo[1], lo[2], lo[3], hi[0], hi[1], hi[2], hi[3]};
                        o[d] = MFMA32(av, pf[ks], o[d]); } }
            }
            if (kt + 2 < nkt) asm volatile("s_waitcnt vmcnt(4)" ::: "memory"); else asm volatile("s_waitcnt vmcnt(0)" ::: "memory");
            asm volatile("s_waitcnt lgkmcnt(0)" ::: "memory"); __builtin_amdgcn_s_barrier(); asm volatile("" ::: "memory");
        }
        const float kap = __builtin_amdgcn_exp2f(Ft - Ft0);
        const float dt = (den + __shfl_xor(den, 32)) * kap;
        const float inv = kap / fmaxf(fabsf(dt), 1.f);
        float sm = 0.f;
#pragma unroll
        for (int d = 0; d < 4; ++d)
#pragma unroll
            for (int i = 0; i < 16; ++i) { o[d][i] *= inv; sm += o[d][i]; }
        sm += __shfl_xor(sm, 32);
        const float mu = sm * (1.f / 128.f);
        float vs = 0.f;
#pragma unroll
        for (int d = 0; d < 4; ++d)
#pragma unroll
            for (int i = 0; i < 16; ++i) { const float dlt = o[d][i] - mu; vs += dlt * dlt; }
        vs += __shfl_xor(vs, 32);
        const float rstd = rsqrtf(vs * (1.f / 128.f) + RMS_EPS);
#pragma unroll
        for (int d = 0; d < 4; ++d)
#pragma unroll
            for (int g = 0; g < 4; ++g) { const int ch = h * 128 + 32 * d + 8 * g + 4 * hh; const size_t off = trow * 512 + ch;
                const u32x2 cv = *(const u32x2*)(CONV + off), ov = *(const u32x2*)(OPRE + off); const f32x4 gg = *(const f32x4*)(ng + ch), sk = *(const f32x4*)(skip + ch);
                const float y0 = sigm(bflo(ov.x)) * ((o[d][4 * g] - mu) * rstd * gg[0] + sk[0] * bflo(cv.x)), y1 = sigm(bfhi(ov.x)) * ((o[d][4 * g + 1] - mu) * rstd * gg[1] + sk[1] * bfhi(cv.x));
                const float y2 = sigm(bflo(ov.y)) * ((o[d][4 * g + 2] - mu) * rstd * gg[2] + sk[2] * bflo(cv.y)), y3 = sigm(bfhi(ov.y)) * ((o[d][4 * g + 3] - mu) * rstd * gg[3] + sk[3] * bfhi(cv.y));
                u32x2 w; w.x = cvtpk(y0, y1); w.y = cvtpk(y2, y3); *(u32x2*)(OUTM + off) = w; }
    }
#undef ML_DMA
}

template <int N> __device__ __forceinline__ void bitonic_sort_desc(float (&v)[N]) {
#pragma unroll
    for (int k = 2; k <= N; k <<= 1)
#pragma unroll
        for (int j = k >> 1; j > 0; j >>= 1)
#pragma unroll
            for (int i = 0; i < N; ++i) { const int l = i ^ j; if (l > i) { const bool desc = ((i & k) == 0); const float a = v[i], b = v[l], hi = fmaxf(a, b), lo = fminf(a, b); v[i] = desc ? hi : lo; v[l] = desc ? lo : hi; } }
}
__device__ __forceinline__ void top16_merge(float (&a)[16], const float (&b)[16]) {
#pragma unroll
    for (int i = 0; i < 16; ++i) a[i] = fmaxf(a[i], b[15 - i]);
#pragma unroll
    for (int j = 8; j > 0; j >>= 1)
#pragma unroll
        for (int i = 0; i < 16; ++i) { const int l = i ^ j; if (l > i) { const float x = a[i], y = a[l]; a[i] = fmaxf(x, y); a[l] = fminf(x, y); } }
}
constexpr int PE_EIDX = 0, PE_EGATE = 16384, PE_KEYT = 32768;
__device__ __forceinline__ void peer_route(const bf16* PQ, const bf16* KEYB, int* IDX, float* GATE, LAS unsigned char* lds, int bx, int G, int tid) {
    const int lane = tid & 63, wave = __builtin_amdgcn_readfirstlane(tid >> 6), r = lane & 31, hh = lane >> 5;
    LAS unsigned char* keyt = lds + PE_KEYT + (wave * 32 + r) * 32;
    for (int grp = bx; grp < T / 32; grp += G) {
        const int t0 = grp * 32;
        { const int h = wave;
          int rq = r; asm volatile("" : "+v"(rq));
          float top[2][16];
#pragma unroll
          for (int p = 0; p < 2; ++p) {
              bf16x8 qf[4];
              { const bf16* qrow = PQ + (size_t)(t0 + rq) * 1024 + h * 128 + p * 64 + 8 * hh;
#pragma unroll
                for (int s = 0; s < 4; ++s) qf[s] = *(const bf16x8*)(qrow + 16 * s); }
              const bf16* kb = KEYB + ((size_t)(h * 2 + p) * 128 + rq) * 64 + 8 * hh;
              float sv[4][16];
#pragma unroll
              for (int kt = 0; kt < 4; ++kt) { f32x16 acc;
#pragma unroll
                  for (int i = 0; i < 16; ++i) acc[i] = 0.f;
#pragma unroll
                  for (int s = 0; s < 4; ++s) { const bf16x8 a = *(const bf16x8*)(kb + (size_t)(32 * kt) * 64 + 16 * s); acc = MFMA32(a, qf[s], acc); }
#pragma unroll
                  for (int i = 0; i < 16; ++i) { const unsigned key = (unsigned)(32 * kt + (i & 3) + 8 * (i >> 2)) + 4u * (unsigned)hh; sv[kt][i] = __uint_as_float((__float_as_uint(acc[i]) & ~127u) | key); } }
              bitonic_sort_desc<16>(sv[0]); bitonic_sort_desc<16>(sv[1]); bitonic_sort_desc<16>(sv[2]); bitonic_sort_desc<16>(sv[3]);
              top16_merge(sv[0], sv[1]); top16_merge(sv[2], sv[3]); top16_merge(sv[0], sv[2]);
              float pr[16];
#pragma unroll
              for (int i = 0; i < 16; ++i) { auto r32 = __builtin_amdgcn_permlane32_swap(__float_as_uint(sv[0][i]), __float_as_uint(sv[0][i]), false, false); pr[i] = __uint_as_float(hh ? r32[0] : r32[1]); }
              top16_merge(sv[0], pr);
#pragma unroll
              for (int i = 0; i < 16; ++i) top[p][i] = sv[0][i];
          }
          if (hh == 0) {
#pragma unroll
              for (int i = 0; i < 16; ++i) { keyt[i] = (unsigned char)(__float_as_uint(top[0][i]) & 127u); keyt[16 + i] = (unsigned char)(__float_as_uint(top[1][i]) & 127u); } }
          float cs[4][16];
#define PSUM(a, b) __uint_as_float((__float_as_uint(top[0][a] + top[1][b]) & ~255u) | (unsigned)((a) * 16 + (b)))
#pragma unroll
          for (int b2 = 0; b2 < 16; ++b2) cs[0][b2] = PSUM(0, b2);
#pragma unroll
          for (int b2 = 0; b2 < 8; ++b2) cs[1][b2] = PSUM(1, b2);
#pragma unroll
          for (int a2 = 8; a2 < 16; ++a2) cs[1][a2] = PSUM(a2, 0);
#pragma unroll
          for (int b2 = 0; b2 < 5; ++b2) cs[2][b2] = PSUM(2, b2);
#pragma unroll
          for (int b2 = 0; b2 < 4; ++b2) cs[2][5 + b2] = PSUM(3, b2);
#pragma unroll
          for (int b2 = 0; b2 < 3; ++b2) cs[2][9 + b2] = PSUM(4, b2);
          cs[2][12] = PSUM(5, 0); cs[2][13] = PSUM(5, 1); cs[2][14] = PSUM(6, 0); cs[2][15] = PSUM(6, 1);
          cs[3][0] = PSUM(7, 0); cs[3][1] = PSUM(7, 1);
#undef PSUM
#pragma unroll
          for (int i = 2; i < 16; ++i) cs[3][i] = -3.0e38f;
          bitonic_sort_desc<16>(cs[0]); bitonic_sort_desc<16>(cs[1]); bitonic_sort_desc<16>(cs[2]); bitonic_sort_desc<16>(cs[3]);
          top16_merge(cs[0], cs[1]); top16_merge(cs[2], cs[3]); top16_merge(cs[0], cs[2]);
          LDS_WAIT();
          float ev[16], den = 0.f; const float mx = __uint_as_float(__float_as_uint(cs[0][0]) & ~255u);
#pragma unroll
          for (int k = 0; k < 16; ++k) { ev[k] = __expf(__uint_as_float(__float_as_uint(cs[0][k]) & ~255u) - mx); den += ev[k]; }
          const float rden = 1.f / den;
          if (hh == 0) {
#pragma unroll
              for (int k = 0; k < 16; ++k) { const unsigned code = __float_as_uint(cs[0][k]) & 255u; const int e = (int)keyt[code >> 4] * 128 + (int)keyt[16 + (code & 15u)];
                  IDX[(size_t)(t0 + r) * 128 + h * 16 + k] = e; GATE[(size_t)(t0 + r) * 128 + h * 16 + k] = ev[k] * rden; } }
        }
    }
}
__device__ __forceinline__ void peer_partition(const unsigned* xc_cnt, volatile LAS unsigned* MISC, int bx, int G, int& vx, int& rank, int& nb) {
    bool use_xcc = MK_ONE_LAUNCH != 0; unsigned mine = 0u; const unsigned myx = MISC[13];
    if (use_xcc) { unsigned sum = 0u;
#pragma unroll
        for (unsigned j = 0; j < 8; ++j) { const unsigned c = __hip_atomic_load(xc_cnt + 64 * j, __ATOMIC_RELAXED, __HIP_MEMORY_SCOPE_AGENT); use_xcc = use_xcc && (c > 0u); sum += c; mine = (j == myx) ? c : mine; }
        use_xcc = use_xcc && (sum == (unsigned)G); }
    if (use_xcc) { vx = (int)myx; rank = (int)MISC[12]; nb = (int)mine; } else { vx = bx & 7; rank = bx >> 3; nb = (G - vx + 7) >> 3; }
    vx = __builtin_amdgcn_readfirstlane(vx); rank = __builtin_amdgcn_readfirstlane(rank); nb = __builtin_amdgcn_readfirstlane(nb);
}
__device__ __forceinline__ void peer_u_i8(const unsigned char* H8, const float* XS, const int* IDX, const unsigned char* U8, const f32x2v* SC2, float* ACT, LAS float* wscr, int vx, int rank, int nb, int tid) {
    const int lane = tid & 63, wave = __builtin_amdgcn_readfirstlane(tid >> 6), g4 = lane >> 4, c16 = lane & 15;
    const int tstride = nb * 8;
    LAS int* clist = (LAS int*)wscr;
    LAS unsigned char* xs = (LAS unsigned char*)(wscr + 512);
    const unsigned long long lt = (1ull << lane) - 1ull;
    const unsigned char* ubase = U8 + 16 * c16;
    int ni[8];
    { const int tb = rank * 8 + wave;
#pragma unroll
      for (int j = 0; j < 4; ++j) { const int tj = tb + j * tstride; const bool ok = tj < T; ni[2 * j] = ok ? IDX[(size_t)tj * 128 + lane] : 0x7fffffff; ni[2 * j + 1] = ok ? IDX[(size_t)tj * 128 + 64 + lane] : 0x7fffffff; } }
    for (int tb = rank * 8 + wave; tb < T; tb += 4 * tstride) {
        int ntot = 0;
#pragma unroll
        for (int j = 0; j < 4; ++j) { const int e0 = ni[2 * j], e1 = ni[2 * j + 1]; const bool f0 = (e0 >> 11) == vx, f1 = (e1 >> 11) == vx;
            const unsigned long long m0 = __ballot(f0), m1 = __ballot(f1); const int n0 = __popcll(m0);
            if (f0) clist[ntot + __popcll(m0 & lt)] = (j << 21) | (e0 << 7) | lane;
            if (f1) clist[ntot + n0 + __popcll(m1 & lt)] = (j << 21) | (e1 << 7) | (64 + lane);
            ntot += n0 + __popcll(m1); }
        v4u xr[4]; float sx[4];
#pragma unroll
        for (int j = 0; j < 4; ++j) { const int tj = tb + j * tstride, tl = tj < T ? tj : tb; xr[j] = *(const v4u*)(H8 + (size_t)tl * 1024 + 16 * lane); sx[j] = XS[tl]; }
        { const int tn = tb + 4 * tstride;
#pragma unroll
          for (int j = 0; j < 4; ++j) { const int tj = tn + j * tstride; const bool ok = tj < T; ni[2 * j] = ok ? IDX[(size_t)tj * 128 + lane] : 0x7fffffff; ni[2 * j + 1] = ok ? IDX[(size_t)tj * 128 + 64 + lane] : 0x7fffffff; } }
        if (ntot == 0) continue;
#pragma unroll
        for (int j = 0; j < 4; ++j) *(LAS v4u*)(xs + j * 1024 + 16 * lane) = xr[j];
        LDS_WAIT();
        const int last = ntot - 1, nit = (ntot + 3) >> 2, nit4 = (nit + 3) >> 2;
        v4u ub[4][4]; f32x2v us[4]; int up[4];
#pragma unroll
        for (int k = 0; k < 3; ++k) { const int p = min(4 * k + g4, last); const int pk = clist[p]; up[k] = pk; const unsigned eo = (unsigned)((pk >> 7) & 16383) * 1024u; us[k] = SC2[(pk >> 7) & 16383];
#pragma unroll
            for (int jj = 0; jj < 4; ++jj) ub[k][jj] = *(const v4u*)(ubase + eo + 256 * jj); }
        int dsel = 0, psel = 0; f32x2v ssel = (f32x2v){0.f, 0.f}; bool vsel = false;
#pragma unroll 1
        for (int o = 0; o < nit4; ++o) {
#pragma unroll
            for (int k = 0; k < 4; ++k) {
                const int i = 4 * o + k;
                { const int p = min(4 * (i + 3) + g4, last); const int pk = clist[p]; up[(k + 3) & 3] = pk; const unsigned eo = (unsigned)((pk >> 7) & 16383) * 1024u; us[(k + 3) & 3] = SC2[(pk >> 7) & 16383];
#pragma unroll
                  for (int jj = 0; jj < 4; ++jj) ub[(k + 3) & 3][jj] = *(const v4u*)(ubase + eo + 256 * jj); }
                const LAS unsigned char* xp = xs + (up[k] >> 21) * 1024 + 16 * c16;
                v4u xq[4];
#pragma unroll
                for (int jj = 0; jj < 4; ++jj) xq[jj] = *(const LAS v4u*)(xp + 256 * jj);
                int a0 = 0, a1 = 0, a2 = 0, a3 = 0;
#pragma unroll
                for (int jj = 0; jj < 4; ++jj) {
                    a0 = __builtin_amdgcn_sdot4((int)xq[jj].x, (int)ub[k][jj].x, a0, false); a1 = __builtin_amdgcn_sdot4((int)xq[jj].y, (int)ub[k][jj].y, a1, false);
                    a2 = __builtin_amdgcn_sdot4((int)xq[jj].z, (int)ub[k][jj].z, a2, false); a3 = __builtin_amdgcn_sdot4((int)xq[jj].w, (int)ub[k][jj].w, a3, false); }
                int d = (a0 + a1) + (a2 + a3);
                d += __builtin_amdgcn_update_dpp(0, d, 0x128, 0xf, 0xf, false); d += __builtin_amdgcn_update_dpp(0, d, 0x124, 0xf, 0xf, false);
                d += __builtin_amdgcn_update_dpp(0, d, 0x122, 0xf, 0xf, false); d += __builtin_amdgcn_update_dpp(0, d, 0x121, 0xf, 0xf, false);
                if ((i & 15) == c16) { dsel = d; ssel = us[k]; psel = up[k]; vsel = 4 * i + g4 <= last; }
                if (k == 3 && ((o & 3) == 3 || o == nit4 - 1)) {
                    if (vsel) { const int j = psel >> 21; const float sxj = j == 0 ? sx[0] : j == 1 ? sx[1] : j == 2 ? sx[2] : sx[3];
                        ACT[(size_t)(tb + j * tstride) * 128 + (psel & 127)] = gelu_erf((float)dsel * sxj * ssel.x) * ssel.y; }
                    vsel = false; }
            }
        }
        LDS_WAIT();
    }
}
__device__ __forceinline__ void peer_v(const int* IDX, const float* ACT, const float* GATE, const unsigned char* V8, const float* gate2, const bf16* Xin, bf16* Xout, LAS float* wscr,
                                       int vx, int rank, int nb, int tid) {
    const int lane = tid & 63, wave = __builtin_amdgcn_readfirstlane(tid >> 6), g8 = lane >> 3, c8 = lane & 7;
    const int tstride = nb * 16;
    LAS int* wl = (LAS int*)wscr; LAS unsigned char* wqb = (LAS unsigned char*)(wscr + 128);
    const unsigned char* vbase = V8 + (size_t)(vx >> 1) * (2 * MiB); const int voff = 16 * c8;
    const int col = 256 * (vx >> 1) + 32 * c8;
    const int wqo0 = (lane & 7) * 16 + (lane >> 3), wqo1 = wqo0 + 8;
    const int t0 = (rank * 8 + wave) * 2 + (vx & 1);
    if (t0 >= T) return;
    const int tlast = t0 + ((T - 1 - t0) / tstride) * tstride;
#define PV_STAGE(tt, I0, I1, A0, A1, VV, WQ4, SW) { \
        float am_ = fmaxf(fabsf(A0), fabsf(A1));   \
        am_ = fmaxf(am_, __uint_as_float(__builtin_amdgcn_update_dpp(0, __float_as_uint(am_), 0x128, 0xf, 0xf, false))); am_ = fmaxf(am_, __uint_as_float(__builtin_amdgcn_update_dpp(0, __float_as_uint(am_), 0x124, 0xf, 0xf, false))); \
        am_ = fmaxf(am_, __uint_as_float(__builtin_amdgcn_update_dpp(0, __float_as_uint(am_), 0x122, 0xf, 0xf, false))); am_ = fmaxf(am_, __uint_as_float(__builtin_amdgcn_update_dpp(0, __float_as_uint(am_), 0x121, 0xf, 0xf, false))); \
        am_ = fmaxf(fmaxf(__uint_as_float(__builtin_amdgcn_readlane(__float_as_uint(am_), 0)), __uint_as_float(__builtin_amdgcn_readlane(__float_as_uint(am_), 16))), \
                    fmaxf(__uint_as_float(__builtin_amdgcn_readlane(__float_as_uint(am_), 32)), __uint_as_float(__builtin_amdgcn_readlane(__float_as_uint(am_), 48)))); \
        const float inv_ = am_ > 0.f ? 127.f / am_ : 0.f; SW = am_ * (1.f / 127.f); \
        wl[lane] = I0; wl[64 + lane] = I1; wqb[wqo0] = (unsigned char)((int)rintf(A0 * inv_) & 255); wqb[wqo1] = (unsigned char)((int)rintf(A1 * inv_) & 255); \
        LDS_WAIT(); \
        _Pragma("unroll") for (int i_ = 0; i_ < 16; ++i_) { const int e_ = wl[8 * i_ + g8]; VV[i_] = *(const v4u*)(vbase + (size_t)(unsigned)(e_ * 128 + voff)); } \
        WQ4 = *(const LAS v4u*)(wqb + g8 * 16); LDS_WAIT(); }
#define PV_META(tt, I0, I1, A0, A1) { const size_t o_ = (size_t)(tt) * 128; I0 = IDX[o_ + lane]; I1 = IDX[o_ + 64 + lane]; A0 = ACT[o_ + lane] * GATE[o_ + lane]; A1 = ACT[o_ + 64 + lane] * GATE[o_ + 64 + lane]; }
    int i0, i1, j0, j1; float a0, a1, b0, b1;
    v4u vv[16], vvn[16], wq4, wq4n; float sw, swn;
    PV_META(t0, i0, i1, a0, a1);
    PV_STAGE(t0, i0, i1, a0, a1, vvn, wq4n, swn);
    { const int t1 = min(t0 + tstride, tlast); PV_META(t1, i0, i1, a0, a1); }
#pragma unroll 2
    for (int t = t0; t < T; t += tstride) {
        const int b = t >> 11, tn = min(t + tstride, tlast), tn2 = min(t + 2 * tstride, tlast);
#pragma unroll
        for (int i = 0; i < 16; ++i) vv[i] = vvn[i];
        wq4 = wq4n; sw = swn;
        PV_META(tn2, j0, j1, b0, b1);
        const u32x2 xw1 = *(const u32x2*)(Xin + (size_t)t * 1024 + col + 4 * g8); const f32x4 g21 = *(const f32x4*)(gate2 + (size_t)b * NADA + col + 4 * g8);
        PV_STAGE(tn, i0, i1, a0, a1, vvn, wq4n, swn);
        i0 = j0; i1 = j1; a0 = b0; a1 = b1;
        int accA[16], accB[16], accw = 0;
#pragma unroll
        for (int i = 0; i < 16; ++i) { accA[i] = 0; accB[i] = 0; }
#pragma unroll
        for (int q = 0; q < 4; ++q) { const int wq = (int)(q == 0 ? wq4.x : q == 1 ? wq4.y : q == 2 ? wq4.z : wq4.w);
            accw = __builtin_amdgcn_sdot4(wq, 0x01010101, accw, false);
#pragma unroll
            for (int d = 0; d < 4; ++d) {
                const unsigned ra = d == 0 ? vv[4 * q].x : d == 1 ? vv[4 * q].y : d == 2 ? vv[4 * q].z : vv[4 * q].w, rb = d == 0 ? vv[4 * q + 1].x : d == 1 ? vv[4 * q + 1].y : d == 2 ? vv[4 * q + 1].z : vv[4 * q + 1].w;
                const unsigned rc = d == 0 ? vv[4 * q + 2].x : d == 1 ? vv[4 * q + 2].y : d == 2 ? vv[4 * q + 2].z : vv[4 * q + 2].w, rd = d == 0 ? vv[4 * q + 3].x : d == 1 ? vv[4 * q + 3].y : d == 2 ? vv[4 * q + 3].z : vv[4 * q + 3].w;
                const unsigned ab_lo = __builtin_amdgcn_perm(rb, ra, 0x05010400u), ab_hi = __builtin_amdgcn_perm(rb, ra, 0x07030602u), cd_lo = __builtin_amdgcn_perm(rd, rc, 0x05010400u), cd_hi = __builtin_amdgcn_perm(rd, rc, 0x07030602u);
                const unsigned t0 = __builtin_amdgcn_perm(cd_lo, ab_lo, 0x05040100u), t1 = __builtin_amdgcn_perm(cd_lo, ab_lo, 0x07060302u), t2 = __builtin_amdgcn_perm(cd_hi, ab_hi, 0x05040100u), t3 = __builtin_amdgcn_perm(cd_hi, ab_hi, 0x07060302u);
                accA[4 * d + 0] = __builtin_amdgcn_sdot4((int)t0, wq, accA[4 * d + 0], false); accB[4 * d + 0] = __builtin_amdgcn_sdot4((int)(t0 & 0x0f0f0f0fu), wq, accB[4 * d + 0], false);
                accA[4 * d + 1] = __builtin_amdgcn_sdot4((int)t1, wq, accA[4 * d + 1], false); accB[4 * d + 1] = __builtin_amdgcn_sdot4((int)(t1 & 0x0f0f0f0fu), wq, accB[4 * d + 1], false);
                accA[4 * d + 2] = __builtin_amdgcn_sdot4((int)t2, wq, accA[4 * d + 2], false); accB[4 * d + 2] = __builtin_amdgcn_sdot4((int)(t2 & 0x0f0f0f0fu), wq, accB[4 * d + 2], false);
                accA[4 * d + 3] = __builtin_amdgcn_sdot4((int)t3, wq, accA[4 * d + 3], false); accB[4 * d + 3] = __builtin_amdgcn_sdot4((int)(t3 & 0x0f0f0f0fu), wq, accB[4 * d + 3], false); } }
#define PV_SW16(X, Y) { auto r_ = __builtin_amdgcn_permlane16_swap((unsigned)(X), (unsigned)(Y), false, false); X = (int)(r_[0] + r_[1]); }
#define PV_SW32(X, Y) { auto r_ = __builtin_amdgcn_permlane32_swap((unsigned)(X), (unsigned)(Y), false, false); X = (int)(r_[0] + r_[1]); }
#pragma unroll
        for (int hh = 0; hh < 2; ++hh)
#pragma unroll
            for (int mm = 0; mm < 4; ++mm) { const int mi = 8 * hh + mm; PV_SW16(accA[mi], accA[mi + 4]); PV_SW16(accB[mi], accB[mi + 4]); }
#pragma unroll
        for (int mi = 0; mi < 4; ++mi) { PV_SW32(accA[mi], accA[mi + 8]); PV_SW32(accB[mi], accB[mi + 8]); }
        { const bool b3 = (lane & 8) != 0;
#pragma unroll
          for (int mi = 0; mi < 2; ++mi) {
              { const int keep = b3 ? accA[mi + 2] : accA[mi], send = b3 ? accA[mi] : accA[mi + 2]; accA[mi] = keep + __builtin_amdgcn_update_dpp(0, send, 0x128, 0xf, 0xf, false); }
              { const int keep = b3 ? accB[mi + 2] : accB[mi], send = b3 ? accB[mi] : accB[mi + 2]; accB[mi] = keep + __builtin_amdgcn_update_dpp(0, send, 0x128, 0xf, 0xf, false); } } }
        accw += __builtin_amdgcn_update_dpp(0, accw, 0x128, 0xf, 0xf, false); PV_SW16(accw, accw); PV_SW32(accw, accw);
#undef PV_SW16
#undef PV_SW32
        { const int off8 = 8 * accw;
          const int s0 = accB[0] - off8, s1 = (accA[0] - accB[0]) >> 4, s2 = accB[1] - off8, s3 = (accA[1] - accB[1]) >> 4;
          const f32x4 xo = (f32x4){bflo(xw1.x), bfhi(xw1.x), bflo(xw1.y), bfhi(xw1.y)} + g21 * ((f32x4){(float)s0, (float)s1, (float)s2, (float)s3} * sw);
          u32x2 w; w.x = pk2(xo[0], xo[1]); w.y = pk2(xo[2], xo[3]); *(u32x2*)(Xout + (size_t)t * 1024 + col + 4 * g8) = w; }
    }
#undef PV_STAGE
#undef PV_META
}

constexpr int PH_PER_LAYER = 12, N_PHASES = 1 + DEPTH * PH_PER_LAYER + 1;
struct Args { const void* in[N_INPUTS]; float* out; unsigned char* ws; int ph_lo, ph_hi; };
static_assert(sizeof(Args) == N_INPUTS * 8 + 24, "Args has no padding");

constexpr int PTAB_OFF = LDSCTL_OFF + 1024;
__device__ __forceinline__ unsigned char* getp(LAS unsigned char* lds, int i) {
    asm volatile("" ::: "memory");
    const u32x2 v = *(volatile LAS u32x2*)(lds + PTAB_OFF + 8 * i);
    const unsigned lo = __builtin_amdgcn_readfirstlane(v.x), hi = __builtin_amdgcn_readfirstlane(v.y);
    GAS unsigned char* g = (GAS unsigned char*)(((unsigned long long)hi << 32) | lo);
    return (unsigned char*)g;
}
#define INP(i) ((const float*)getp(lds, (i)))
#define WSB() getp(lds, 30)

#define IN(k) (lo <= (k) && (k) < hi)
#define SEAM(k) do { if (MK_ONE_LAUNCH && IN(k) && IN((k) + 1)) { XcdBarrier b_; b_.bar = (unsigned*)(WSB() + WS_CTL) + CW_BAR; b_.x = xb_xcc_id(); b_.st = MISC + 8; REPS(11) xcd_barrier(b_, (wave_s << 6) | (int)__lane_id()); } } while (0)
#define PH_BEGIN(lv) int tidq; asm volatile("v_mbcnt_lo_u32_b32 %0, -1, 0\n\tv_mbcnt_hi_u32_b32 %0, -1, %0" : "=v"(tidq)); tidq |= wave_s << 6;     \
    asm volatile("" : "+v"(tidq)); const int lane = tidq & 63, wave = __builtin_amdgcn_readfirstlane(tidq >> 6); \
    int G = gridDim.x, bx = blockIdx.x, l = (lv); asm volatile("" : "+s"(G), "+s"(bx), "+s"(l)); const int gw = bx * NWAVES + wave, NGW = G * NWAVES; \
    unsigned char* ws = WSB(); LAS float* wscr = (LAS float*)(lds + RING_OFF + wave * 16384); (void)lane; (void)gw; (void)NGW; (void)ws; (void)wscr; (void)l


constexpr int PI_W = 4512, PI_K = 512, PI_U = 2048, PI_V = 2048, PI_TOTAL = PI_W + PI_K + PI_U + PI_V;
template <int NR> __device__ __forceinline__ void prep_rows_i8(const float* src, size_t src_stride, unsigned char* dst, size_t dst_stride, float* scale_slot  , int lane) {
    f32x4 v[NR][4];
#pragma unroll
    for (int rr = 0; rr < NR; ++rr) { const f32x4* s = (const f32x4*)(src + rr * src_stride) + lane * 4;
#pragma unroll
        for (int j = 0; j < 4; ++j) v[rr][j] = s[j]; }
#pragma unroll
    for (int rr = 0; rr < NR; ++rr) {
        float am = 0.f;
#pragma unroll
        for (int j = 0; j < 4; ++j) am = fmaxf(fmaxf(am, fmaxf(fabsf(v[rr][j][0]), fabsf(v[rr][j][1]))), fmaxf(fabsf(v[rr][j][2]), fabsf(v[rr][j][3])));
#pragma unroll
        for (int o = 1; o < 64; o <<= 1) am = fmaxf(am, __shfl_xor(am, o));
        const float inv = am > 0.f ? 127.f / am : 0.f;
#define Q4(x) ((unsigned)((int)rintf((x)[0] * inv) & 255) | ((unsigned)((int)rintf((x)[1] * inv) & 255) << 8) | ((unsigned)((int)rintf((x)[2] * inv) & 255) << 16) | ((unsigned)((int)rintf((x)[3] * inv) & 255) << 24))
        v4u o; o.x = Q4(v[rr][0]); o.y = Q4(v[rr][1]); o.z = Q4(v[rr][2]); o.w = Q4(v[rr][3]);
#undef Q4
        *(v4u*)(dst + rr * dst_stride) = o;
        if (lane == 0) scale_slot[2 * rr] = am * (1.f / 127.f);
    }
}
template <int NR> __device__ __forceinline__ void prep_rows_i4(const float* src, size_t src_stride, unsigned char* dst, size_t dst_stride, float* scale_slot  , int lane) {
    f32x4 v[NR][4];
#pragma unroll
    for (int rr = 0; rr < NR; ++rr) { const f32x4* s = (const f32x4*)(src + rr * src_stride) + lane * 4;
#pragma unroll
        for (int j = 0; j < 4; ++j) v[rr][j] = s[j]; }
#pragma unroll
    for (int rr = 0; rr < NR; ++rr) {
        float am = 0.f, ss = 0.f;
#pragma unroll
        for (int j = 0; j < 4; ++j) { am = fmaxf(fmaxf(am, fmaxf(fabsf(v[rr][j][0]), fabsf(v[rr][j][1]))), fmaxf(fabsf(v[rr][j][2]), fabsf(v[rr][j][3]))); ss += dot4(v[rr][j], v[rr][j]); }
#pragma unroll
        for (int o = 1; o < 64; o <<= 1) { am = fmaxf(am, __shfl_xor(am, o)); ss += __shfl_xor(ss, o); }
        am = fminf(am, 2.7f * sqrtf(ss * (1.f / 1024.f)));
        const float inv = am > 0.f ? 7.f / am : 0.f;
#define N4(x) ((unsigned)((int)fminf(fmaxf(rintf((x) * inv), -7.f), 7.f) + 8))
#define H4(x) ((unsigned)((int)fminf(fmaxf(rintf((x) * inv), -7.f), 7.f)) & 15u)
#define B4(x, y) (N4(x) | (H4(y) << 4))
        u32x2 o;
        o.x = B4(v[rr][0][0], v[rr][0][1]) | (B4(v[rr][0][2], v[rr][0][3]) << 8) | (B4(v[rr][1][0], v[rr][1][1]) << 16) | (B4(v[rr][1][2], v[rr][1][3]) << 24);
        o.y = B4(v[rr][2][0], v[rr][2][1]) | (B4(v[rr][2][2], v[rr][2][3]) << 8) | (B4(v[rr][3][0], v[rr][3][1]) << 16) | (B4(v[rr][3][2], v[rr][3][3]) << 24);
#undef B4
#undef H4
#undef N4
        *(u32x2*)(dst + rr * dst_stride) = o;
        if (lane == 0) scale_slot[2 * rr] = am * (1.f / 7.f);
    }
}
__device__ __forceinline__ void prep_item(LAS unsigned char* lds, unsigned char* ws, LAS float* wscr, int l, int r, int lane) {
    constexpr int I_WIN_ = 16 * 136, I_WQ_ = 12 * 24, I_WKV_ = 4 * 32, I_WA_ = 8 * 32, I_WM_ = 8 * 32, I_WO_ = 16 * 32, I_PW_ = 16 * 32, I_WQK_ = 8 * 32, I_WV_ = 8 * 16;
    static_assert(I_WIN_ + I_WQ_ + I_WKV_ + I_WA_ + I_WM_ + I_WO_ + I_PW_ + I_WQK_ + I_WV_ == PI_W, "weight items");
    unsigned char* wl = ws + WS_W + (size_t)l * W_LAYER;
    if (r < PI_W) {
        if (r < I_WIN_) { const GetWin g{INP(I_WIN) + (size_t)l * D * 4136}; prep_tile(g, (bf16*)(wl + WO_WIN), 1024, 64 * (r / 136), 32 * (r % 136), wscr, lane); return; } r -= I_WIN_;
        if (r < I_WQ_) { const GetWq g{INP(I_WQUP) + (size_t)l * 768 * 768, INP(I_QNG) + l * 768}; prep_tile(g, (bf16*)(wl + WO_WQ), 768, 64 * (r / 24), 32 * (r % 24), wscr, lane); return; } r -= I_WQ_;
        if (r < I_WKV_) { const GetWkv g{INP(I_WKVUP) + (size_t)l * 256 * 1024, INP(I_KVNG) + l * 256}; prep_tile(g, (bf16*)(wl + WO_WKV), 256, 64 * (r / 32), 32 * (r % 32), wscr, lane); return; } r -= I_WKV_;
        if (r < I_WA_) { const GetPlain g{INP(I_WBA) + (size_t)l * 512 * 1024, 1024}; prep_tile(g, (bf16*)(wl + WO_WA), 512, 64 * (r / 32), 32 * (r % 32), wscr, lane); return; } r -= I_WA_;
        if (r < I_WM_) { const GetPlain g{INP(I_WBM) + (size_t)l * 512 * 1024, 1024}; prep_tile(g, (bf16*)(wl + WO_WM), 512, 64 * (r / 32), 32 * (r % 32), wscr, lane); return; } r -= I_WM_;
        if (r < I_WO_) { const GetPlain g{INP(I_WOUT) + (size_t)l * 1024 * 1024, 1024}; prep_tile(g, (bf16*)(wl + WO_WO), 1024, 64 * (r / 32), 32 * (r % 32), wscr, lane); return; } r -= I_WO_;
        if (r < I_PW_) { const GetPlain g{INP(I_PWQ) + (size_t)l * 1024 * 1024, 1024}; prep_tile(g, (bf16*)(wl + WO_PWQ), 1024, 64 * (r / 32), 32 * (r % 32), wscr, lane); return; } r -= I_PW_;
        if (r < I_WQK_) { const GetWqk g{INP(I_WQM) + (size_t)l * 65536, INP(I_WKM) + (size_t)l * 65536}; prep_tile(g, (bf16*)(wl + WO_WQK), 512, 64 * (r / 32), 32 * (r % 32), wscr, lane); return; } r -= I_WQK_;
        { const GetWv g{INP(I_WVM) + (size_t)l * 65536}; prep_tile(g, (bf16*)(wl + WO_WV), 512, 64 * (r / 16), 32 * (r % 16), wscr, lane); }
        return; }
    r -= PI_W;
    if (r < PI_K) { const int o = (r * 64 + lane) * 4;
        const f32x4 v = *(const f32x4*)(INP(I_PKEYS) + (size_t)l * 131072 + o); u32x2 w; w.x = pk2(v[0], v[1]); w.y = pk2(v[2], v[3]);
        *(u32x2*)(wl + WO_KEYB + (size_t)o * 2) = w; return; }
    r -= PI_K;
    float* sc2 = (float*)(ws + WS_USC);
    if (r < PI_U) { const float* pu = INP(I_PU) + (size_t)l * 16777216;
        for (int rr = 0; rr < 8; rr += 8) { const int er = r * 8 + rr; prep_rows_i8<8>(pu + (size_t)er * 1024, 1024, ws + WS_U8 + (size_t)l * 32 * MiB + (size_t)er * 1024 + 16 * lane, 1024, sc2 + 2 * (l * 16384 + er), lane); }
        return; }
    r -= PI_U;
    { const float* pv = INP(I_PV) + (size_t)l * 16777216;
      for (int rr = 0; rr < 8; rr += 8) { const int er = r * 8 + rr;
          prep_rows_i4<8>(pv + (size_t)er * 1024, 1024, ws + WS_V8 + (size_t)l * 32 * MiB + (size_t)(lane >> 4) * (2 * MiB) + (size_t)er * 128 + 8 * (lane & 15), 128, sc2 + 2 * (l * 16384 + er) + 1, lane); } }
}
template <int lv> __device__ __forceinline__ void layer_phases(LAS unsigned char* lds, volatile LAS unsigned* MISC, const int lo, const int hi, const int wave_s) {
        const int P = 1 + lv * PH_PER_LAYER;
#define WL() (ws + WS_W + (size_t)l * W_LAYER)
#define ADAL() ((const float*)(ws + ADA_OFF) + (size_t)l * 8 * NADA)
#define XA() WSP(bf16, WS_X)
#define XB() (WSP(bf16, WS_X) + (size_t)T * D)
#define WSP(type, off) ((type*)(ws + (off)))
        if (IN(P + 0)) REPS(1) { PH_BEGIN(lv);
            if (lv == 0) rowpass_norm_mod<false>(INP(I_X), INP(I_N1G) + l * D, ADAL() + 0, ADAL() + 1024, WSP(bf16, WS_H), gw, NGW, lane);
            else rowpass_norm_mod<true>(XB(), INP(I_N1G) + l * D, ADAL() + 0, ADAL() + 1024, WSP(bf16, WS_H), gw, NGW, lane); }
        SEAM(P + 0);
        if (IN(P + 1)) REPS(2) { PH_BEGIN(lv);
            if (G == 256) {
                { pg8::Gemm g{WSP(bf16, WS_H), (const bf16*)(WL() + WO_WIN), T, 4096, D}; pg8::StaticOrder S; S.init(T, 4096, G, bx);
                  EpiProj E{WSP(bf16, WS_QLAT), WSP(bf16, WS_KVLAT), WSP(bf16, WS_UM), WSP(bf16, WS_OPRE), WSP(bf16, WS_GA), WSP(bf16, WS_GM), WSP(float, WS_SMALL)};
                  pg8::gemm_phase<EpiProj, pg8::StaticOrder, true, true>(lds + RING_OFF, g, S, E, tidq); }
                { const int kq = bx >> 6;
                  pg8::Gemm g{WSP(bf16, WS_H) + 256 * kq, (const bf16*)(WL() + WO_WIN) + (size_t)4096 * 1024 + 256 * kq, T, 256, 256, 1024}; pg8::StaticOrder S; S.init(T, 256, 64, bx & 63);
                  EpiSmallPart E{WSP(float, WS_SMALLP) + (size_t)kq * T * 64};
                  pg8::gemm_phase<EpiSmallPart, pg8::StaticOrder, true, true>(lds + RING_OFF, g, S, E, tidq); }
            } else {
                pg8::Gemm g{WSP(bf16, WS_H), (const bf16*)(WL() + WO_WIN), T, NPROJ, D}; pg8::StaticOrder S; S.init(T, NPROJ, G, bx);
                EpiProj E{WSP(bf16, WS_QLAT), WSP(bf16, WS_KVLAT), WSP(bf16, WS_UM), WSP(bf16, WS_OPRE), WSP(bf16, WS_GA), WSP(bf16, WS_GM), WSP(float, WS_SMALL)};
                pg8::gemm_phase<EpiProj, pg8::StaticOrder, true, true>(lds + RING_OFF, g, S, E, tidq);
            }
        }
        SEAM(P + 1);
        if (IN(P + 2)) REPS(3) { PH_BEGIN(lv);
            rowpass_mid(WSP(bf16, WS_QLAT), WSP(bf16, WS_KVLAT), WSP(float, WS_SMALL), (G == 256) ? WSP(float, WS_SMALLP) : (const float*)nullptr, WSP(float, WS_COS), WSP(float, WS_SIN), WSP(bf16, WS_UM), INP(I_CONVW) + l * 4 * 512, INP(I_CONVB) + l * 512,
                        INP(I_BI) + l * 4, INP(I_BF) + l * 4, WSP(float, WS_RQ), WSP(float, WS_RKV), WSP(bf16, WS_K), WSP(float, WS_LOGI), WSP(float, WS_LOGF), WSP(bf16, WS_CONV), gw, NGW, lane); }
        SEAM(P + 2);
        if (IN(P + 3)) REPS(4) {
            { PH_BEGIN(lv); pg8::Gemm g{WSP(bf16, WS_QLAT), (const bf16*)(WL() + WO_WQ), T, 768, 768}; pg8::StaticOrder S; S.init(T, 768, G, bx);
              EpiQ E{WSP(bf16, WS_Q), WSP(float, WS_RQ), WSP(float, WS_COS), WSP(float, WS_SIN)}; pg8::gemm_phase<EpiQ, pg8::StaticOrder, true, true>(lds + RING_OFF, g, S, E, tidq); }
            { PH_BEGIN(lv); pg8::Gemm g{WSP(bf16, WS_KVLAT), (const bf16*)(WL() + WO_WKV), T, 1024, 256}; pg8::StaticOrder S; S.init(T, 1024, G, bx);
              EpiKV E{WSP(bf16, WS_K), WSP(bf16, WS_V), WSP(float, WS_RKV)}; pg8::gemm_phase<EpiKV, pg8::StaticOrder, true, true>(lds + RING_OFF, g, S, E, tidq); }
            { PH_BEGIN(lv); const int c = (G == 256) ? (bx >> 7) : 0;
              pg8::Gemm g{WSP(bf16, WS_CONV) + 256 * c, (const bf16*)(WL() + WO_WQK) + (size_t)(512 * c) * 512 + 256 * c, T, 512, 256, 512}; pg8::StaticOrder S;
              if (G == 256) S.init(T, 512, 128, bx & 127); else S.init(T, 512, G, bx);
              pg8::EpiBf16<0> E{WSP(bf16, WS_QKM) + 256 * c, 1024, nullptr, 256, 512, 1.f}; pg8::gemm_phase<pg8::EpiBf16<0>, pg8::StaticOrder, true, true>(lds + RING_OFF, g, S, E, tidq); }
            { PH_BEGIN(lv); if (G != 256) {
              pg8::Gemm g{WSP(bf16, WS_CONV) + 256, (const bf16*)(WL() + WO_WQK) + (size_t)512 * 512 + 256, T, 512, 256, 512}; pg8::StaticOrder S; S.init(T, 512, G, bx);
              pg8::EpiBf16<0> E{WSP(bf16, WS_QKM) + 256, 1024, nullptr, 256, 512, 1.f}; pg8::gemm_phase<pg8::EpiBf16<0>, pg8::StaticOrder, true, true>(lds + RING_OFF, g, S, E, tidq); } }
            { PH_BEGIN(lv);
              pg8::Gemm g{WSP(bf16, WS_UM), (const bf16*)(WL() + WO_WV), T, 256, 256, 512}; pg8::StaticOrder S;
              if (G == 256) S.init(T, 256, 64, bx >= 192 ? bx - 192 : (1 << 20)); else S.init(T, 256, G, bx);
              pg8::EpiBf16<0> E{WSP(bf16, WS_VM), 512, nullptr, 0, 0, 1.f}; pg8::gemm_phase<pg8::EpiBf16<0>, pg8::StaticOrder, true, true>(lds + RING_OFF, g, S, E, tidq); }
            { PH_BEGIN(lv);
              pg8::Gemm g{WSP(bf16, WS_UM) + 256, (const bf16*)(WL() + WO_WV) + (size_t)256 * 512 + 256, T, 256, 256, 512}; pg8::StaticOrder S;
              if (G == 256) S.init(T, 256, 64, bx >= 192 ? bx - 192 : (1 << 20)); else S.init(T, 256, G, bx);
              pg8::EpiBf16<0> E{WSP(bf16, WS_VM) + 256, 512, nullptr, 0, 0, 1.f}; pg8::gemm_phase<pg8::EpiBf16<0>, pg8::StaticOrder, true, true>(lds + RING_OFF, g, S, E, tidq); }
        }
        SEAM(P + 3);
        if (IN(P + 4)) {
            REPS(5) { PH_BEGIN(lv); attn_mfma(WSP(bf16, WS_Q), WSP(bf16, WS_K), WSP(bf16, WS_V), WSP(bf16, WS_AO), lds + RING_OFF, bx, G, tidq); __syncthreads(); }
            REPS(6) { PH_BEGIN(lv); mlstm_mfma(WSP(bf16, WS_QKM), WSP(bf16, WS_VM), WSP(float, WS_LOGI), WSP(float, WS_LOGF), WSP(bf16, WS_CONV), WSP(bf16, WS_OPRE), INP(I_MHG) + l * 512, INP(I_MSKIP) + l * 512,
                          WSP(bf16, WS_OUTM), lds + RING_OFF, bx, G, tidq); }
        }
        SEAM(P + 4);
        if (IN(P + 5)) REPS(7) {
            { PH_BEGIN(lv); pg8::Gemm g{WSP(bf16, WS_AO), (const bf16*)(WL() + WO_WA), T, 1024, 512}; pg8::StaticOrder S; S.init(T, 1024, G, bx);
              EpiMerge E{WSP(bf16, WS_MERGED), WSP(bf16, WS_GA), 1}; pg8::gemm_phase<EpiMerge, pg8::StaticOrder, true, true>(lds + RING_OFF, g, S, E, tidq); }
            { PH_BEGIN(lv); pg8::Gemm g{WSP(bf16, WS_OUTM), (const bf16*)(WL() + WO_WM), T, 1024, 512}; pg8::StaticOrder S; S.init(T, 1024, G, bx);
              EpiMerge E{WSP(bf16, WS_MERGED), WSP(bf16, WS_GM), 0}; pg8::gemm_phase<EpiMerge, pg8::StaticOrder, true, true>(lds + RING_OFF, g, S, E, tidq); }
        }
        SEAM(P + 5);
        if (IN(P + 6)) REPS(8) { PH_BEGIN(lv);
            pg8::Gemm g{WSP(bf16, WS_MERGED), (const bf16*)(WL() + WO_WO), T, 1024, 1024}; pg8::StaticOrder S; S.init(T, 1024, G, bx);
            if (lv == 0) { EpiResid<false> E{INP(I_X), XA(), ADAL() + 2048}; pg8::gemm_phase<EpiResid<false>, pg8::StaticOrder, true, true>(lds + RING_OFF, g, S, E, tidq); }
            else { EpiResid<true> E{XB(), XA(), ADAL() + 2048}; pg8::gemm_phase<EpiResid<true>, pg8::StaticOrder, true, true>(lds + RING_OFF, g, S, E, tidq); }
        }
        SEAM(P + 6);
        if (IN(P + 7)) REPS(1) { PH_BEGIN(lv); rowpass_norm_mod<true>(XA(), INP(I_N2G) + l * D, ADAL() + 3072, ADAL() + 4096, WSP(bf16, WS_H), gw, NGW, lane, ws + WS_H8, WSP(float, WS_XS)); }
        SEAM(P + 7);
        if (IN(P + 8)) REPS(9) { PH_BEGIN(lv);
            pg8::Gemm g{WSP(bf16, WS_H), (const bf16*)(WL() + WO_PWQ), T, 1024, 1024}; pg8::StaticOrder S; S.init(T, 1024, G, bx);
            pg8::EpiBf16<0> E{WSP(bf16, WS_PQ), 1024, nullptr, 0, 0, 1.f}; pg8::gemm_phase<pg8::EpiBf16<0>, pg8::StaticOrder, true, true>(lds + RING_OFF, g, S, E, tidq);
        }
        SEAM(P + 8);
        if (IN(P + 9)) REPS(10) { PH_BEGIN(lv);
            peer_route(WSP(bf16, WS_PQ), (const bf16*)(WL() + WO_KEYB), WSP(int, WS_IDX), WSP(float, WS_GATE), lds + RING_OFF, bx, G, tidq); }
        SEAM(P + 9);
        if (IN(P + 10)) REPS(12) { PH_BEGIN(lv);
            int vx, rank, nb; peer_partition((const unsigned*)(ws + WS_CTL) + CW_XC, MISC, bx, G, vx, rank, nb);
            peer_u_i8(ws + WS_H8, WSP(float, WS_XS), WSP(int, WS_IDX), ws + WS_U8 + (size_t)l * 32 * MiB, WSP(f32x2v, WS_USC) + l * 16384, WSP(float, WS_ACT), wscr, vx, rank, nb, tidq); }
        SEAM(P + 10);
        if (IN(P + 11)) REPS(13) { PH_BEGIN(lv);
            int vx, rank, nb; peer_partition((const unsigned*)(ws + WS_CTL) + CW_XC, MISC, bx, G, vx, rank, nb);
            peer_v(WSP(int, WS_IDX), WSP(float, WS_ACT), WSP(float, WS_GATE), ws + WS_V8 + (size_t)l * 32 * MiB, ADAL() + 5120, XA(), XB(), wscr, vx, rank, nb, tidq);
        }
        SEAM(P + 11);
    }

__global__ void __launch_bounds__(NTHREADS, 2) fwd(Args args) {
    extern __shared__ __attribute__((aligned(16))) unsigned char lds_raw[];
    LAS unsigned char* lds = (LAS unsigned char*)lds_raw;
    volatile LAS unsigned* MISC = (volatile LAS unsigned*)(lds + MISC_OFF);
    const int tid = threadIdx.x;
    const int wave_s = __builtin_amdgcn_readfirstlane(tid >> 6);
    for (int u = tid; u < (LDS_BYTES - LDSCTL_OFF) / 4; u += NTHREADS) ((LAS unsigned*)(lds + LDSCTL_OFF))[u] = 0u;
    __syncthreads();
    if (tid == 0) { LAS unsigned long long* pt = (LAS unsigned long long*)(lds + PTAB_OFF);
#pragma unroll
        for (int i = 0; i < N_INPUTS; ++i) pt[i] = (unsigned long long)args.in[i];
        pt[29] = (unsigned long long)args.out; pt[30] = (unsigned long long)args.ws; }
    __syncthreads();
    if (MK_ONE_LAUNCH) (void)xcd_barrier_post((unsigned*)(WSB() + WS_CTL) + CW_BAR, MISC + 8);
    if (MK_ONE_LAUNCH && tid == 0) { const unsigned xc = xb_xcc_id() & 7u; MISC[12] = xb_add((unsigned*)(WSB() + WS_CTL) + CW_XC + 64 * xc, 1u); MISC[13] = xc; }
    __syncthreads();
    const int lo = args.ph_lo, hi = args.ph_hi;

    if (IN(0)) REPS(0) {
        PH_BEGIN(0);
        float* ADA = (float*)(ws + ADA_OFF);
        { const float* c = INP(I_C); const float* wada = INP(I_WADA); const float* bada = INP(I_BADA);
          for (int it = bx; it < DEPTH * 96; it += G) {
            const int ll = it / 96, cg = it % 96; const int n = cg * 64 + lane;
#pragma unroll
            for (int i = 0; i < 16; ++i) { const int e = lane + 64 * i; const int bb = e >> 7, kk = e & 127; const float cv = c[bb * D + wave * 128 + kk]; wscr[e] = cv * sigm(cv); }
            LDS_WAIT();
            const float* w = wada + (size_t)ll * D * NADA + (size_t)(wave * 128) * NADA + n;
            float a[8];
#pragma unroll
            for (int bb = 0; bb < 8; ++bb) a[bb] = 0.f;
#pragma unroll 16
            for (int kk = 0; kk < 128; ++kk) { const float wv = w[(size_t)kk * NADA];
#pragma unroll
                for (int bb = 0; bb < 8; ++bb) a[bb] += wscr[bb * 128 + kk] * wv; }
#pragma unroll
            for (int bb = 0; bb < 8; ++bb) wscr[1024 + bb * 64 + lane] = a[bb];
            __syncthreads();
            { float s = 0.f;
#pragma unroll
              for (int w8 = 0; w8 < 8; ++w8) s += ((const LAS float*)(lds + RING_OFF + w8 * 16384))[1024 + wave * 64 + lane];
              ADA[((size_t)ll * 8 + wave) * NADA + n] = s + bada[ll * NADA + n]; }
            __syncthreads();
          } }
        { const int* pos = (const int*)INP(I_POS); float* COS = (float*)(ws + WS_COS); float* SIN = (float*)(ws + WS_SIN);
          for (int idx = gw * 64 + lane; idx < T * 16; idx += NGW * 64) { const int t = idx >> 4, j = idx & 15;
              const float ang = (float)pos[t] * INV_FREQ[j];
              const double rev = (double)ang * 0.15915494309189535; const float fr = (float)(rev - rint(rev));
              COS[idx] = __builtin_amdgcn_cosf(fr); SIN[idx] = __builtin_amdgcn_sinf(fr); } }
        for (int it = gw; it < DEPTH * PI_TOTAL; it += NGW) prep_item(lds, ws, wscr, it / PI_TOTAL, it % PI_TOTAL, lane);
    }
    SEAM(0);

    layer_phases<0>(lds, MISC, lo, hi, wave_s);
    layer_phases<1>(lds, MISC, lo, hi, wave_s);
    if (IN(N_PHASES - 1)) REPS(1) { PH_BEGIN(0); rowpass_final(XB(), INP(I_FG), (float*)getp(lds, 29), gw, NGW, lane); }
#undef IN
#undef SEAM
}

extern "C" void kernel_launch(void* const* d_in, const int* in_sizes, int n_in, void* d_out, int out_size, void* d_ws, size_t ws_size, hipStream_t stream) {
    static int grid = 0;
    if (grid == 0) {
        if (n_in != N_INPUTS || in_sizes[0] != T * D || out_size != T * D || ws_size < WS_END2) {
            fprintf(stderr, "kernel_launch: unexpected shapes: n_in %d in0 %d out %d ws %zu (need %zu); nothing launched\n", n_in, n_in > 0 ? in_sizes[0] : -1, out_size, ws_size, (size_t)WS_END2); grid = -1; return; }
        int dev = 0, cus = 0, per_cu = 0;
        if (hipGetDevice(&dev) != hipSuccess || hipDeviceGetAttribute(&cus, hipDeviceAttributeMultiprocessorCount, dev) != hipSuccess) { fprintf(stderr, "kernel_launch: device query failed\n"); grid = -1; return; }
        if (hipFuncSetAttribute((const void*)fwd, hipFuncAttributeMaxDynamicSharedMemorySize, LDS_BYTES) != hipSuccess) { fprintf(stderr, "kernel_launch: hipFuncSetAttribute failed\n"); grid = -1; return; }
        if (hipOccupancyMaxActiveBlocksPerMultiprocessor(&per_cu, (const void*)fwd, NTHREADS, LDS_BYTES) != hipSuccess || per_cu < 1)
            fprintf(stderr, "kernel_launch: note: occupancy query reports %d workgroups per CU\n", per_cu);
        (void)hipGetLastError();
        grid = cus;
    }
    if (grid < 0) return;
    if (hipMemsetAsync((char*)d_ws + WS_CTL, 0, CTL_ZERO_BYTES, stream) != hipSuccess) { fprintf(stderr, "kernel_launch: memset failed\n"); return; }
    Args a{};
    for (int i = 0; i < N_INPUTS; ++i) a.in[i] = d_in[i];
    a.out = (float*)d_out; a.ws = (unsigned char*)d_ws;
#if MK_ONE_LAUNCH
    a.ph_lo = 0; a.ph_hi = N_PHASES;
    hipLaunchKernelGGL(fwd, dim3(grid), dim3(NTHREADS), LDS_BYTES, stream, a);
#else
    for (int p = 0; p < N_PHASES; ++p) { a.ph_lo = p; a.ph_hi = p + 1; hipLaunchKernelGGL(fwd, dim3(grid), dim3(NTHREADS), LDS_BYTES, stream, a); }
#endif
    const hipError_t le = hipPeekAtLastError();
    if (le != hipSuccess) fprintf(stderr, "kernel_launch: launch failed: %s\n", hipGetErrorName(le));
}
```

```cpp
#include <hip/hip_runtime.h>
#include <cstdio>
#include <cstdint>
#ifndef WT_STORES
#define WT_STORES 0
#endif
template <class V> __device__ __forceinline__ void st_wt(void* p, const V v) {
    static_assert(sizeof(V) == 16 || sizeof(V) == 8 || sizeof(V) == 4, "store width");
#if WT_STORES
    if constexpr (sizeof(V) == 16) asm volatile("global_store_dwordx4 %0, %1, off sc1\n\ts_nop 1" :: "v"(p), "v"(v) : "memory");
    else if constexpr (sizeof(V) == 8) asm volatile("global_store_dwordx2 %0, %1, off sc1\n\ts_nop 1" :: "v"(p), "v"(v) : "memory");
    else asm volatile("global_store_dword %0, %1, off sc1\n\ts_nop 1" :: "v"(p), "v"(v) : "memory");
#else
    *(V*)p = v;
#endif
}
#define GSTF(ptr, val) st_wt((void*)(ptr), (val))
template <class V> __device__ __forceinline__ void st_plain(void* p, const V v) { *(V*)p = v; }
#define GST(ptr, val) st_plain((void*)(ptr), (val))
namespace pg8 {
#define PG8_LAS __attribute__((address_space(3)))
typedef unsigned short bf16_t;
typedef short bf16x8 __attribute__((ext_vector_type(8)));
typedef float f32x4 __attribute__((ext_vector_type(4)));
typedef unsigned u32x4 __attribute__((ext_vector_type(4)));
constexpr int BM = 256, BK = 64, HALF = 128, HTB = HALF * BK * 2  , STAGE_BYTES = 8 * HTB, NXCD = 8, WGM = 8;

__host__ __device__ __forceinline__ int lds_byte(int r, int c) { const int st = (r >> 4) * 2 + (c >> 5), rr = r & 15, cc = c & 31, ob = rr * 64 + cc * 2; return st * 1024 + (ob ^ (((ob >> 9) & 1) << 5)); }
__host__ __device__ __forceinline__ void stage_rc(int b, int& R, int& C) { const int st = b / 1024, sb = b % 1024, swz = sb ^ (((sb >> 9) & 1) << 5); R = (st >> 1) * 16 + swz / 64; C = (st & 1) * 32 + (swz % 64) / 2; }
__host__ __device__ __forceinline__ int perm32(int rho) { const int n = rho >> 4, i = rho & 15; return 8 * (i >> 2) + 4 * n + (i & 3); }

struct Unit { int pm, pn; };
struct Gemm { const bf16_t* A; const bf16_t* Bt; int M, N, K; int ld = 0; };

struct StaticOrder {
    int nM, nN, nwg, G, c;
    __host__ __device__ void init(int M, int N, int G_, int c_) { nM = M / BM; nN = N / BM; nwg = nM * nN; G = G_; c = c_; }
    __host__ __device__ bool next(int i, Unit& u) const {
        const long L = (long)i * G + c; if (L >= nwg) return false;
        int wgid = (int)L; { const int q = nwg / NXCD, r = nwg % NXCD, xcd = wgid % NXCD, off = wgid / NXCD; wgid = (xcd < r ? xcd * (q + 1) : r * (q + 1) + (xcd - r) * q) + off; }
        const int nig = WGM * nN, gid = wgid / nig, fm = gid * WGM, gsz = (nM - fm) < WGM ? (nM - fm) : WGM;
        u.pm = fm + ((wgid % nig) % gsz); u.pn = (wgid % nig) / gsz; return true;
    }
    __device__ __forceinline__ void a_ready(const Unit&) const {}
    __device__ __forceinline__ void done(const Unit&) const {}
};

__device__ __forceinline__ unsigned cvt_pk_bf16(float lo, float hi) { unsigned r; asm volatile("v_cvt_pk_bf16_f32 %0, %1, %2" : "=v"(r) : "v"(lo), "v"(hi)); return r; }
typedef float f32x2 __attribute__((ext_vector_type(2)));
__device__ __forceinline__ f32x2 gelu_pk(f32x2 v) {
    const f32x2 av = __builtin_elementwise_abs(v), d = av * 0.2316418882f + 1.0f;
    f32x2 t; t.x = __builtin_amdgcn_rcpf(d.x); t.y = __builtin_amdgcn_rcpf(d.y);
    f32x2 q = t * 0.5307027145f + (-0.7265760135f); q = q * t + 0.7107068705f; q = q * t + (-0.142248368f); q = q * t + 0.127414796f; q = q * t;
    const f32x2 s = (v * v) * (-0.72134752044f);
    f32x2 e; e.x = __builtin_amdgcn_exp2f(s.x); e.y = __builtin_amdgcn_exp2f(s.y);
    const f32x2 m = v * (q * e), r = v - m;
    f32x2 o; o.x = v.x < 0.f ? m.x : r.x; o.y = v.y < 0.f ? m.y : r.y; return o;
}

template <int ACT  > struct EpiBf16 {
    static constexpr bool PERM = true, AFTER_DRAIN = false; static_assert(ACT == 0 || ACT == 1, "EpiBf16: ACT is 0 (none) or 1 (gelu_pk)");
    bf16_t* O; int ldc; const float* bias; int split_cols; size_t split_stride; float scale0;
    __device__ __forceinline__ void operator()(const f32x4 (&acc)[2][2][4][2], const Unit& u, int wr, int wc, int fr, int fq) const {
        const int row0 = u.pm * BM + wr * 64 + fr; int colt = u.pn * BM; bf16_t* base = O;
        float sc = 1.f; if (split_cols) { const int t = colt / split_cols; base += (size_t)t * split_stride; colt -= t * split_cols; if (t == 0) sc = scale0; }
        const int col0 = colt + wc * 32 + 8 * fq, bcol0 = u.pn * BM + wc * 32 + 8 * fq;
        f32x4 bv[2][2];
#pragma unroll
        for (int bj = 0; bj < 2; ++bj)
#pragma unroll
            for (int n = 0; n < 2; ++n) bv[bj][n] = bias ? *(const f32x4*)(bias + bcol0 + bj * HALF + 4 * n) : (f32x4){0.f, 0.f, 0.f, 0.f};
#pragma unroll
        for (int ai = 0; ai < 2; ++ai)
#pragma unroll
            for (int m = 0; m < 4; ++m) { bf16_t* rowp = base + (size_t)(row0 + ai * HALF + m * 16) * ldc + col0;
#pragma unroll
                for (int bj = 0; bj < 2; ++bj) { f32x4 v0 = acc[ai][bj][m][0] + bv[bj][0], v1 = acc[ai][bj][m][1] + bv[bj][1];
                    if (ACT == 1) { f32x2 a = gelu_pk((f32x2){v0[0], v0[1]}), b = gelu_pk((f32x2){v0[2], v0[3]}), c = gelu_pk((f32x2){v1[0], v1[1]}), d = gelu_pk((f32x2){v1[2], v1[3]});
                        v0 = (f32x4){a.x, a.y, b.x, b.y}; v1 = (f32x4){c.x, c.y, d.x, d.y}; }
                    v0 = v0 * sc; v1 = v1 * sc; u32x4 w; w.x = cvt_pk_bf16(v0[0], v0[1]); w.y = cvt_pk_bf16(v0[2], v0[3]); w.z = cvt_pk_bf16(v1[0], v1[1]); w.w = cvt_pk_bf16(v1[2], v1[3]);
                    GST(rowp + bj * HALF, w); } }
    }
};


template <class Epi, class Sched, bool ALIGN_EPI = false, bool SP2 = false>
__device__ __forceinline__ void gemm_phase(PG8_LAS unsigned char* lds, const Gemm g, const Sched& S, const Epi& E, const int tid_in) {
    int tid_l = tid_in; asm volatile("" : "+v"(tid_l));
    const int tid = tid_l, wid = __builtin_amdgcn_readfirstlane(tid >> 6), lane = tid & 63, wr = wid >> 2, wc = wid & 3, fr = lane & 15, fq = lane >> 4;
    const int K = g.K, nt = K / BK, LD = g.ld ? g.ld : g.K;
    unsigned voffA[2], voffB[2];
#pragma unroll
    for (int i = 0; i < 2; ++i) { int R, C; stage_rc(tid * 16 + i * 8192, R, C); const int Rb = Epi::PERM ? ((R & ~31) + perm32(R & 31)) : R;
        voffA[i] = (unsigned)(R * LD + C) * 2u; voffB[i] = (unsigned)(Rb * LD + C) * 2u; }
    const size_t kstep = (size_t)(BK * 2);
    const size_t hstep = (size_t)HALF * LD * 2;
    const size_t tstep = 2 * hstep;
    const unsigned ldsw = (unsigned)wid * 1024u;
    const int aoff = lds_byte(wr * 64 + fr, fq * 8), boff = lds_byte(wc * 32 + fr, fq * 8);
#define PG8_SA(b, h) (((b) * 2 + (h)) * HTB)
#define PG8_SB(b, h) ((4 + (b) * 2 + (h)) * HTB)
#define PG8_STAGE(bufoff, gbase, voff) do { _Pragma("unroll") for (int _i = 0; _i < 2; ++_i) \
        __builtin_amdgcn_global_load_lds((const unsigned*)((const char*)(gbase) + (voff)[_i]), (PG8_LAS unsigned*)(lds + (bufoff) + ldsw + _i * 8192), 16, 0, 0); } while (0)
#define PG8_LDA(dst, b, h) do { _Pragma("unroll") for (int m = 0; m < 4; ++m) _Pragma("unroll") for (int k = 0; k < 2; ++k) dst[m][k] = *(const PG8_LAS bf16x8*)(lds + PG8_SA(b, h) + aoff + m * 2048 + k * 1024); } while (0)
#define PG8_LDB(dst, b, h) do { _Pragma("unroll") for (int n = 0; n < 2; ++n) _Pragma("unroll") for (int k = 0; k < 2; ++k) dst[n][k] = *(const PG8_LAS bf16x8*)(lds + PG8_SB(b, h) + boff + n * 2048 + k * 1024); } while (0)
#define PG8_MMA(ai, bj, At, Bt) do { __builtin_amdgcn_s_setprio(1); _Pragma("unroll") for (int m = 0; m < 4; ++m) _Pragma("unroll") for (int n = 0; n < 2; ++n) _Pragma("unroll") for (int k = 0; k < 2; ++k) \
        acc[ai][bj][m][n] = __builtin_amdgcn_mfma_f32_16x16x32_bf16(Bt[n][k], At[m][k], acc[ai][bj][m][n], 0, 0, 0); __builtin_amdgcn_s_setprio(0); } while (0)
#define PG8_WAIT_V(n) asm volatile("s_waitcnt vmcnt(" #n ")" ::: "memory")
#define PG8_WAIT_L(n) asm volatile("s_waitcnt lgkmcnt(" #n ")" ::: "memory")
#define PG8_BAR __builtin_amdgcn_s_barrier()
#define PG8_SCHED __builtin_amdgcn_sched_barrier(0)
    Unit cur, nxt; int ui = 0;
    if (!S.next(0, cur)) return;
    f32x4 acc[2][2][4][2];
#pragma unroll
    for (int a = 0; a < 2; ++a)
#pragma unroll
        for (int b = 0; b < 2; ++b)
#pragma unroll
            for (int m = 0; m < 4; ++m)
#pragma unroll
                for (int n = 0; n < 2; ++n) acc[a][b][m][n] = (f32x4){0.f, 0.f, 0.f, 0.f};
    bf16x8 At[4][2], B0[2][2], B1[2][2];
    const char* cA = (const char*)g.A + (size_t)cur.pm * tstep; const char* cB = (const char*)g.Bt + (size_t)cur.pn * tstep;
    S.a_ready(cur);
    if constexpr (SP2) {
        PG8_STAGE(PG8_SB(0, 0), cB, voffB); PG8_STAGE(PG8_SB(0, 1), cB + hstep, voffB); PG8_STAGE(PG8_SA(0, 0), cA, voffA); PG8_STAGE(PG8_SA(0, 1), cA + hstep, voffA);
        if (wr == 1) PG8_BAR;
        PG8_WAIT_V(2); PG8_BAR;
        PG8_STAGE(PG8_SB(1, 0), cB + kstep, voffB); PG8_STAGE(PG8_SA(1, 0), cA + kstep, voffA); PG8_STAGE(PG8_SB(1, 1), cB + hstep + kstep, voffB);
        PG8_WAIT_V(6); PG8_BAR;
    } else {
        PG8_STAGE(PG8_SB(0, 0), cB, voffB); PG8_STAGE(PG8_SA(0, 0), cA, voffA); PG8_STAGE(PG8_SB(0, 1), cB + hstep, voffB); PG8_STAGE(PG8_SA(0, 1), cA + hstep, voffA);
        if (wr == 1) PG8_BAR;
        PG8_WAIT_V(4); PG8_BAR;
        PG8_STAGE(PG8_SB(1, 0), cB + kstep, voffB); PG8_STAGE(PG8_SA(1, 0), cA + kstep, voffA); PG8_STAGE(PG8_SB(1, 1), cB + hstep + kstep, voffB);
        PG8_WAIT_V(6); PG8_BAR;
    }
    for (;;) {
        const bool has_next = S.next(ui + 1, nxt);
        const char* nA = has_next ? (const char*)g.A + (size_t)nxt.pm * tstep : cA; const char* nB = has_next ? (const char*)g.Bt + (size_t)nxt.pn * tstep : cB;
        for (int t = 0; t < nt; t += 2) {
            const bool last = (t == nt - 2);
            const char* a1 = cA + (size_t)(t + 1) * kstep;
            const char* a2 = last ? nA : cA + (size_t)(t + 2) * kstep; const char* b2 = last ? nB : cB + (size_t)(t + 2) * kstep;
            const char* a3 = a2 + kstep; const char* b3 = b2 + kstep;
            if (last && has_next) S.a_ready(nxt);
            if constexpr (SP2) {
            PG8_LDB(B0, 0, 0); PG8_LDB(B1, 0, 1); PG8_SCHED; PG8_LDA(At, 0, 0); PG8_STAGE(PG8_SA(1, 1), a1 + hstep, voffA);
            PG8_WAIT_V(8); PG8_WAIT_L(0); PG8_BAR; PG8_MMA(0, 0, At, B0); PG8_MMA(0, 1, At, B1); PG8_BAR; PG8_SCHED;
            PG8_LDA(At, 0, 1); PG8_STAGE(PG8_SB(0, 0), b2, voffB); PG8_STAGE(PG8_SB(0, 1), b2 + hstep, voffB); PG8_STAGE(PG8_SA(0, 0), a2, voffA);
            PG8_WAIT_V(8); PG8_WAIT_L(0); PG8_BAR; PG8_MMA(1, 0, At, B0); PG8_MMA(1, 1, At, B1); PG8_BAR; PG8_SCHED;
            PG8_LDB(B0, 1, 0); PG8_LDB(B1, 1, 1); PG8_SCHED; PG8_LDA(At, 1, 0); PG8_STAGE(PG8_SA(0, 1), a2 + hstep, voffA);
            PG8_WAIT_V(8); PG8_WAIT_L(0); PG8_BAR; PG8_MMA(0, 0, At, B0); PG8_MMA(0, 1, At, B1); PG8_BAR; PG8_SCHED;
            PG8_LDA(At, 1, 1); PG8_STAGE(PG8_SB(1, 0), b3, voffB); PG8_STAGE(PG8_SB(1, 1), b3 + hstep, voffB); PG8_STAGE(PG8_SA(1, 0), a3, voffA);
            PG8_WAIT_V(8); PG8_WAIT_L(0); PG8_BAR; PG8_MMA(1, 0, At, B0); PG8_MMA(1, 1, At, B1); PG8_BAR; PG8_SCHED;
            } else {
            PG8_LDB(B0, 0, 0); PG8_SCHED; PG8_LDA(At, 0, 0); PG8_STAGE(PG8_SA(1, 1), a1 + hstep, voffA);
            PG8_WAIT_L(8); PG8_BAR; PG8_WAIT_L(0); PG8_MMA(0, 0, At, B0); PG8_BAR; PG8_SCHED;
            PG8_LDB(B1, 0, 1); PG8_STAGE(PG8_SB(0, 0), b2, voffB);
            PG8_BAR; PG8_WAIT_L(0); PG8_MMA(0, 1, At, B1); PG8_BAR;
            PG8_LDA(At, 0, 1); PG8_STAGE(PG8_SA(0, 0), a2, voffA);
            PG8_BAR; PG8_WAIT_L(0); PG8_MMA(1, 0, At, B0); PG8_BAR; PG8_SCHED;
            PG8_STAGE(PG8_SB(0, 1), b2 + hstep, voffB);
            PG8_WAIT_V(6); PG8_BAR; PG8_MMA(1, 1, At, B1); PG8_BAR;
            PG8_LDB(B0, 1, 0); PG8_SCHED; PG8_LDA(At, 1, 0); PG8_STAGE(PG8_SA(0, 1), a2 + hstep, voffA);
            PG8_WAIT_L(8); PG8_BAR; PG8_WAIT_L(0); PG8_MMA(0, 0, At, B0); PG8_BAR; PG8_SCHED;
            PG8_LDB(B1, 1, 1); PG8_STAGE(PG8_SB(1, 0), b3, voffB);
            PG8_BAR; PG8_WAIT_L(0); PG8_MMA(0, 1, At, B1); PG8_BAR;
            PG8_LDA(At, 1, 1); PG8_STAGE(PG8_SA(1, 0), a3, voffA);
            PG8_BAR; PG8_WAIT_L(0); PG8_MMA(1, 0, At, B0); PG8_BAR; PG8_SCHED;
            PG8_STAGE(PG8_SB(1, 1), b3 + hstep, voffB);
            PG8_WAIT_V(6); PG8_BAR; PG8_MMA(1, 1, At, B1); PG8_BAR;
            }
        }
        if constexpr (ALIGN_EPI) { if (wr == 0) PG8_BAR; }
        if constexpr (!Epi::AFTER_DRAIN) { E(acc, cur, wr, wc, fr, fq); S.done(cur); }
        if (!has_next) break;
#pragma unroll
        for (int a = 0; a < 2; ++a)
#pragma unroll
            for (int b = 0; b < 2; ++b)
#pragma unroll
                for (int m = 0; m < 4; ++m)
#pragma unroll
                    for (int n = 0; n < 2; ++n) acc[a][b][m][n] = (f32x4){0.f, 0.f, 0.f, 0.f};
        cur = nxt; cA = nA; cB = nB; ++ui;
        if constexpr (ALIGN_EPI) { if (wr == 1) PG8_BAR; }
    }
    PG8_WAIT_V(0);
    if constexpr (!ALIGN_EPI) { if (wr == 0) PG8_BAR; }
    PG8_BAR;
    if constexpr (Epi::AFTER_DRAIN) { E.fused(acc, cur, wr, wc, fr, fq, lds, wid, lane); S.done(cur); }
#undef PG8_SA
#undef PG8_SB
#undef PG8_STAGE
#undef PG8_LDA
#undef PG8_LDB
#undef PG8_MMA
#undef PG8_WAIT_V
#undef PG8_WAIT_L
#undef PG8_BAR
#undef PG8_SCHED
}
}
#define GAS __attribute__((address_space(1)))
#define LAS __attribute__((address_space(3)))
typedef unsigned short bf16;
typedef unsigned v4u __attribute__((ext_vector_type(4)));
typedef float f32x4 __attribute__((ext_vector_type(4)));
typedef short bf16x8 __attribute__((ext_vector_type(8)));
typedef GAS unsigned gu32;
typedef GAS unsigned long long gu64;
#define RLX_AGENT __ATOMIC_RELAXED, __HIP_MEMORY_SCOPE_AGENT
#define LDS_WAIT() asm volatile("s_waitcnt lgkmcnt(0)" ::: "memory")
#define VM_WAIT() asm volatile("s_waitcnt vmcnt(0)" ::: "memory")
__device__ __forceinline__ unsigned long long rt() { return __builtin_amdgcn_s_memrealtime(); }
__device__ __forceinline__ unsigned f2bf(float f) { unsigned u = __builtin_bit_cast(unsigned, f); return (u + 0x7fffu + ((u >> 16) & 1u)) >> 16; }
__device__ __forceinline__ unsigned pk2(float lo, float hi) { return f2bf(lo) | (f2bf(hi) << 16); }

#define XB_TMO      128
#define XB_XCNT(j)  (256  + 64 * (j))
#define XB_XSUB(j)  (1280 + 64 * (j))
#define XB_XGEN(j)  (2304 + 64 * (j))
#define XB_TOP      3328
#define XB_TOPGEN   3392
#define XCD_BAR_WORDS 3456
#define XB_SPIN_CAP (1u << 18)

__device__ __forceinline__ unsigned xb_ld(unsigned* p)              { return __hip_atomic_load(p, __ATOMIC_RELAXED, __HIP_MEMORY_SCOPE_AGENT); }
__device__ __forceinline__ unsigned xb_add(unsigned* p, unsigned v) { return __hip_atomic_fetch_add(p, v, __ATOMIC_RELAXED, __HIP_MEMORY_SCOPE_AGENT); }
__device__ __forceinline__ unsigned xb_xcc_id() { return (unsigned)__builtin_amdgcn_s_getreg((3 << 11) | 20) & 0xFu; }
#define XB_SPIN(cond, bar) do { unsigned _sp = 0; while (cond) { __builtin_amdgcn_s_sleep(1); \
    if ((++_sp & 255u) == 0u) { if (xb_ld(&(bar)[XB_TMO])) break; if (_sp > XB_SPIN_CAP) { atomicAdd(&(bar)[XB_TMO], 1u); break; } } } } while (0)

struct XcdBarrier {
    unsigned* bar; unsigned x;
    volatile LAS unsigned* st;
};

__device__ __forceinline__ XcdBarrier xcd_barrier_post(unsigned* bar, volatile LAS unsigned* st) {
    XcdBarrier b; b.bar = bar; b.x = xb_xcc_id(); b.st = st;
    if (threadIdx.x == 0) (void)xb_add(&bar[XB_XCNT(b.x)], 1u);
    return b;
}
__device__ __forceinline__ void xcd_barrier_complete(unsigned* bar, unsigned x, unsigned& nloc, unsigned& nx) {
    const unsigned G = gridDim.x * gridDim.y * gridDim.z;
    unsigned sum, cnt, mine, sp = 0u;
    for (;;) {
        sum = 0u; cnt = 0u; mine = 0u;
#pragma unroll
        for (unsigned j = 0; j < 16; ++j) { const unsigned c = xb_ld(&bar[XB_XCNT(j)]); sum += c; cnt += (c > 0u) ? 1u : 0u; mine = (j == x) ? c : mine; }
        if (sum == G) break;
        __builtin_amdgcn_s_sleep(1);
        if ((++sp & 255u) == 0u) { if (xb_ld(&bar[XB_TMO])) break; if (sp > XB_SPIN_CAP) { atomicAdd(&bar[XB_TMO], 1u); break; } }
    }
    nloc = mine > 0u ? mine : 1u; nx = cnt > 0u ? cnt : 1u;
}

__device__ __forceinline__ void xcd_barrier(const XcdBarrier& b, const int tid_in) {
    asm volatile("s_waitcnt vmcnt(0)" ::: "memory");
    __syncthreads();
    if (tid_in == 0) {
        unsigned* bar = b.bar;
        __builtin_amdgcn_s_waitcnt(0);
        unsigned nloc = b.st[0], nx = b.st[1];
        if (nloc == 0u) { xcd_barrier_complete(bar, b.x, nloc, nx); b.st[0] = nloc; b.st[1] = nx; }
        const unsigned old = xb_add(&bar[XB_XSUB(b.x)], 1u);
        const unsigned gen = old / nloc;
        if (old + 1u == (gen + 1u) * nloc) {
            __builtin_amdgcn_fence(__ATOMIC_RELEASE, "agent");
            asm volatile("s_waitcnt vmcnt(0)" ::: "memory");
            const unsigned og = xb_add(&bar[XB_TOP], 1u);
            const unsigned tg = og / nx;
            if (og + 1u == (tg + 1u) * nx) xb_add(&bar[XB_TOPGEN], 1u);
            else XB_SPIN(xb_ld(&bar[XB_TOPGEN]) == tg, bar);
            __builtin_amdgcn_fence(__ATOMIC_ACQUIRE, "agent");
            xb_add(&bar[XB_XGEN(b.x)], 1u);
            asm volatile("s_waitcnt vmcnt(0)" ::: "memory");
        } else {
            XB_SPIN(xb_ld(&bar[XB_XGEN(b.x)]) == gen, bar);
            __builtin_amdgcn_fence(__ATOMIC_ACQUIRE, "agent");
            asm volatile("s_waitcnt vmcnt(0)" ::: "memory");
        }
    }
    __syncthreads();
}

#ifndef MK_ONE_LAUNCH
#define MK_ONE_LAUNCH 1
#endif
#ifndef PROBE_REP_MASK
#define PROBE_REP_MASK 0
#endif
#define REPS(bit) _Pragma("unroll") for (int rep_ = 0; rep_ < ((PROBE_REP_MASK >> (bit)) & 1) + 1; ++rep_)
constexpr int NWAVES = 8, NTHREADS = NWAVES * 64;
constexpr int BATCH = 8, SEQ = 2048, T = BATCH * SEQ, D = 1024, DEPTH = 2;
constexpr int NPROJ = 4352;
constexpr int N_INPUTS = 29;
constexpr int NADA = 6144;
constexpr float RMS_EPS = 1e-6f;
constexpr float QSCALE = 0.10206207261596575f * 1.4426950408889634f;
enum { I_X = 0, I_C, I_POS, I_WADA, I_BADA, I_N1G, I_WIN, I_QNG, I_WQUP, I_KVNG, I_WKVUP, I_WBA, I_CONVW, I_CONVB, I_WQM, I_WKM, I_WVM, I_BI, I_BF, I_MHG, I_MSKIP,
       I_WBM, I_WOUT, I_N2G, I_PWQ, I_PKEYS, I_PU, I_PV, I_FG };

constexpr size_t MiB = 1u << 20;
constexpr size_t WS_CTL = 0, CTL_ZERO_BYTES = 1 * MiB;
constexpr int CW_BAR = 4096;
constexpr int CW_XC = 8192;
constexpr size_t ADA_OFF = 256 * 1024;
constexpr size_t WS_COS = 1 * MiB, WS_SIN = 2 * MiB;
constexpr size_t WS_W = 3 * MiB, W_LAYER = 18 * MiB;
constexpr size_t WO_WIN = 0, WO_WQ = 8912896, WO_WKV = WO_WQ + 1179648, WO_WA = WO_WKV + 524288, WO_WM = WO_WA + 1048576, WO_WO = WO_WM + 1048576,
                 WO_PWQ = WO_WO + 2097152, WO_WQK = WO_PWQ + 2097152, WO_WV = WO_WQK + 1048576, WO_KEYB = WO_WV + 524288;
static_assert(WO_KEYB + 262144 <= W_LAYER, "weights fit");
constexpr size_t WS_X = 40 * MiB, WS_H = 104 * MiB, WS_QLAT = 136 * MiB, WS_KVLAT = 160 * MiB, WS_UM = 168 * MiB, WS_OPRE = 184 * MiB, WS_GA = 200 * MiB, WS_GM = 232 * MiB,
                 WS_SMALL = 264 * MiB, WS_RQ = 268 * MiB, WS_RKV = WS_RQ + 65536, WS_LOGI = WS_RQ + 262144, WS_LOGF = WS_RQ + 524288, WS_Q = 269 * MiB, WS_K = 293 * MiB,
                 WS_V = 317 * MiB, WS_CONV = 333 * MiB, WS_QKM = 349 * MiB, WS_VM = 381 * MiB, WS_AO = 397 * MiB, WS_OUTM = 413 * MiB, WS_U8 = 429 * MiB, WS_V8 = 445 * MiB, WS_END = 493 * MiB;
constexpr size_t WS_H8 = 493 * MiB, WS_XS = WS_RQ + 131072, WS_USC = WS_RQ + 786432;
constexpr size_t WS_END2 = 509 * MiB;
constexpr size_t WS_IDX = WS_UM, WS_GATE = WS_UM + 8 * MiB, WS_ACT = WS_OPRE;
constexpr size_t WS_SMALLP = WS_OUTM;
constexpr size_t WS_PQ = WS_QLAT, WS_MERGED = WS_QLAT;

constexpr int RING_OFF = 0, RING_BYTES = 131072;
constexpr int LDSCTL_OFF = RING_BYTES, MISC_OFF = LDSCTL_OFF + 320;
constexpr int LDS_BYTES = 147456;

typedef float f32x2v __attribute__((ext_vector_type(2)));
typedef unsigned u32x2 __attribute__((ext_vector_type(2)));

__device__ __forceinline__ float wave_sum(float v) {
#pragma unroll
    for (int o = 1; o < 64; o <<= 1) v += __shfl_xor(v, o);
    return v;
}
__device__ __forceinline__ float bflo(unsigned u) { return __uint_as_float(u << 16); }
__device__ __forceinline__ float bfhi(unsigned u) { return __uint_as_float(u & 0xffff0000u); }
__device__ __forceinline__ float sigm(float x) { return 1.f / (1.f + __expf(-x)); }
__device__ __forceinline__ float dot4(f32x4 a, f32x4 b) { return (a.x * b.x + a.y * b.y) + (a.z * b.z + a.w * b.w); }
__device__ __forceinline__ float gelu_erf(float x) { return 0.5f * x * (1.f + erff(x * 0.70710678118654752f)); }

struct EpiProj {
    static constexpr bool PERM = true, AFTER_DRAIN = false;
    bf16 *qlat, *kvlat, *um, *opre, *ga, *gm; float* small;
    __device__ __forceinline__ void operator()(const f32x4 (&acc)[2][2][4][2], const pg8::Unit& u, int wr, int wc, int fr, int fq) const {
        const int pn = u.pn; bf16* dst; int ld, cb; int mode = 0;
        if (pn < 3) { dst = qlat; ld = 768; cb = pn * 256; }
        else if (pn == 3) { dst = kvlat; ld = 256; cb = 0; }
        else if (pn < 6) { dst = um; ld = 512; cb = (pn - 4) * 256; }
        else if (pn < 8) { dst = opre; ld = 512; cb = (pn - 6) * 256; }
        else if (pn < 12) { dst = ga; ld = 1024; cb = (pn - 8) * 256; mode = 1; }
        else if (pn < 16) { dst = gm; ld = 1024; cb = (pn - 12) * 256; mode = 1; }
        else { dst = nullptr; ld = 0; cb = 0; mode = 2; }
        const int row0 = u.pm * 256 + wr * 64 + fr;
        if (mode == 2) {
            if (wc < 2) {
#pragma unroll
                for (int ai = 0; ai < 2; ++ai)
#pragma unroll
                    for (int m = 0; m < 4; ++m) { float* p = small + (size_t)(row0 + ai * 128 + m * 16) * 64 + wc * 32 + 8 * fq;
                        GST(p, acc[ai][0][m][0]); GST(p + 4, acc[ai][0][m][1]); }
            }
        } else {
#pragma unroll
            for (int ai = 0; ai < 2; ++ai)
#pragma unroll
                for (int m = 0; m < 4; ++m) { bf16* rowp = dst + (size_t)(row0 + ai * 128 + m * 16) * ld + cb + wc * 32 + 8 * fq;
#pragma unroll
                    for (int bj = 0; bj < 2; ++bj) { f32x4 v0 = acc[ai][bj][m][0], v1 = acc[ai][bj][m][1];
                        if (mode == 1) { v0 = (f32x4){sigm(v0[0]), sigm(v0[1]), sigm(v0[2]), sigm(v0[3])}; v1 = (f32x4){sigm(v1[0]), sigm(v1[1]), sigm(v1[2]), sigm(v1[3])}; }
                        v4u w; w.x = pk2(v0[0], v0[1]); w.y = pk2(v0[2], v0[3]); w.z = pk2(v1[0], v1[1]); w.w = pk2(v1[2], v1[3]);
                        GST(rowp + bj * 128, w); } }
        }
    }
};
struct EpiSmallPart {
    static constexpr bool PERM = true, AFTER_DRAIN = false;
    float* part;
    __device__ __forceinline__ void operator()(const f32x4 (&acc)[2][2][4][2], const pg8::Unit& u, int wr, int wc, int fr, int fq) const {
        if (wc >= 2) return;
        const int row0 = u.pm * 256 + wr * 64 + fr;
#pragma unroll
        for (int ai = 0; ai < 2; ++ai)
#pragma unroll
            for (int m = 0; m < 4; ++m) { float* p = part + (size_t)(row0 + ai * 128 + m * 16) * 64 + wc * 32 + 8 * fq;
                GST(p, acc[ai][0][m][0]); GST(p + 4, acc[ai][0][m][1]); }
    }
};
struct EpiQ {
    static constexpr bool PERM = true, AFTER_DRAIN = false;
    bf16* Q; const float* rq; const float* cosT; const float* sinT;
    __device__ __forceinline__ void operator()(const f32x4 (&acc)[2][2][4][2], const pg8::Unit& u, int wr, int wc, int fr, int fq) const {
        const int row0 = u.pm * 256 + wr * 64 + fr;
        int c0b[2], d0b[2];
#pragma unroll
        for (int bj = 0; bj < 2; ++bj) { c0b[bj] = u.pn * 256 + bj * 128 + wc * 32 + 8 * fq; d0b[bj] = c0b[bj] % 96; }
#pragma unroll
        for (int ai = 0; ai < 2; ++ai) {
            float rr[4]; f32x4 csv[4][2], snv[4][2];
#pragma unroll
            for (int m = 0; m < 4; ++m) { const int row = row0 + ai * 128 + m * 16; rr[m] = rq[row];
#pragma unroll
                for (int bj = 0; bj < 2; ++bj) { csv[m][bj] = (f32x4){1.f, 1.f, 1.f, 1.f}; snv[m][bj] = (f32x4){0.f, 0.f, 0.f, 0.f};
                    if (d0b[bj] >= 64) { const int j0 = (d0b[bj] - 64) >> 1; csv[m][bj] = *(const f32x4*)(cosT + (size_t)row * 16 + j0); snv[m][bj] = *(const f32x4*)(sinT + (size_t)row * 16 + j0); } } }
            __builtin_amdgcn_sched_barrier(0);
#pragma unroll
            for (int m = 0; m < 4; ++m) { const int row = row0 + ai * 128 + m * 16; const float r = rr[m];
#pragma unroll
                for (int bj = 0; bj < 2; ++bj) {
                    f32x4 v0 = acc[ai][bj][m][0] * r, v1 = acc[ai][bj][m][1] * r;
                    if (d0b[bj] >= 64) { const f32x4 cs = csv[m][bj], sn = snv[m][bj]; const f32x4 a0 = v0, a1 = v1;
                        v0[0] = a0[0] * cs[0] - a0[1] * sn[0]; v0[1] = a0[1] * cs[0] + a0[0] * sn[0];
                        v0[2] = a0[2] * cs[1] - a0[3] * sn[1]; v0[3] = a0[3] * cs[1] + a0[2] * sn[1];
                        v1[0] = a1[0] * cs[2] - a1[1] * sn[2]; v1[1] = a1[1] * cs[2] + a1[0] * sn[2];
                        v1[2] = a1[2] * cs[3] - a1[3] * sn[3]; v1[3] = a1[3] * cs[3] + a1[2] * sn[3]; }
                    v4u w; w.x = pk2(v0[0], v0[1]); w.y = pk2(v0[2], v0[3]); w.z = pk2(v1[0], v1[1]); w.w = pk2(v1[2], v1[3]);
                    GST(Q + (size_t)row * 768 + c0b[bj], w); } }
        }
    }
};
struct EpiKV {
    static constexpr bool PERM = true, AFTER_DRAIN = false;
    bf16* K; bf16* V; const float* rkv;
    __device__ __forceinline__ void operator()(const f32x4 (&acc)[2][2][4][2], const pg8::Unit& u, int wr, int wc, int fr, int fq) const {
        const int row0 = u.pm * 256 + wr * 64 + fr;
        float rr[2][4];
#pragma unroll
        for (int ai = 0; ai < 2; ++ai)
#pragma unroll
            for (int m = 0; m < 4; ++m) rr[ai][m] = rkv[row0 + ai * 128 + m * 16];
#pragma unroll
        for (int ai = 0; ai < 2; ++ai)
#pragma unroll
            for (int m = 0; m < 4; ++m) { const int row = row0 + ai * 128 + m * 16; const float r = rr[ai][m];
#pragma unroll
                for (int bj = 0; bj < 2; ++bj) { const int c0 = u.pn * 256 + bj * 128 + wc * 32 + 8 * fq;
                    const f32x4 v0 = acc[ai][bj][m][0] * r, v1 = acc[ai][bj][m][1] * r;
                    bf16* dst = (c0 < 512) ? (K + (size_t)row * 768 + 96 * (c0 >> 6) + (c0 & 63)) : (V + (size_t)row * 512 + (c0 - 512));
                    v4u w; w.x = pk2(v0[0], v0[1]); w.y = pk2(v0[2], v0[3]); w.z = pk2(v1[0], v1[1]); w.w = pk2(v1[2], v1[3]);
                    GST(dst, w); } }
    }
};
struct EpiMerge {
    static constexpr bool PERM = true, AFTER_DRAIN = false;
    bf16* Mg; const bf16* gate; int first;
    __device__ __forceinline__ void operator()(const f32x4 (&acc)[2][2][4][2], const pg8::Unit& u, int wr, int wc, int fr, int fq) const {
        const int row0 = u.pm * 256 + wr * 64 + fr, cbase = u.pn * 256 + wc * 32 + 8 * fq;
#pragma unroll
        for (int ai = 0; ai < 2; ++ai) {
            v4u gq[4][2], oq[4][2];
#pragma unroll
            for (int m = 0; m < 4; ++m)
#pragma unroll
                for (int bj = 0; bj < 2; ++bj) { const size_t off = (size_t)(row0 + ai * 128 + m * 16) * 1024 + cbase + bj * 128;
                    gq[m][bj] = *(const v4u*)(gate + off); oq[m][bj] = first ? (v4u){0u, 0u, 0u, 0u} : *(const v4u*)(Mg + off); }
            __builtin_amdgcn_sched_barrier(0);
#pragma unroll
            for (int m = 0; m < 4; ++m)
#pragma unroll
                for (int bj = 0; bj < 2; ++bj) { const size_t off = (size_t)(row0 + ai * 128 + m * 16) * 1024 + cbase + bj * 128;
                    const v4u g = gq[m][bj], o = oq[m][bj];
                    f32x4 v0 = acc[ai][bj][m][0], v1 = acc[ai][bj][m][1];
                    v0[0] = v0[0] * bflo(g.x) + bflo(o.x); v0[1] = v0[1] * bfhi(g.x) + bfhi(o.x); v0[2] = v0[2] * bflo(g.y) + bflo(o.y); v0[3] = v0[3] * bfhi(g.y) + bfhi(o.y);
                    v1[0] = v1[0] * bflo(g.z) + bflo(o.z); v1[1] = v1[1] * bfhi(g.z) + bfhi(o.z); v1[2] = v1[2] * bflo(g.w) + bflo(o.w); v1[3] = v1[3] * bfhi(g.w) + bfhi(o.w);
                    v4u w; w.x = pk2(v0[0], v0[1]); w.y = pk2(v0[2], v0[3]); w.z = pk2(v1[0], v1[1]); w.w = pk2(v1[2], v1[3]);
                    GST(Mg + off, w); }
        }
    }
};
struct MergeOrder {
    pg8::StaticOrder base;
    __device__ __forceinline__ bool next(int i, pg8::Unit& u) const { pg8::Unit v; if (!base.next(i >> 1, v)) return false; u.pm = v.pm + ((i & 1) ? T / 256 : 0); u.pn = v.pn + ((i & 1) ? 4 : 0); return true; }
    __device__ __forceinline__ void a_ready(const pg8::Unit&) const {}
    __device__ __forceinline__ void done(const pg8::Unit&) const {}
};
struct EpiMerge2 {
    static constexpr bool PERM = true, AFTER_DRAIN = false;
    bf16* Mg; const bf16* ga; const bf16* gm;
    __device__ __forceinline__ void operator()(const f32x4 (&acc)[2][2][4][2], const pg8::Unit& u, int wr, int wc, int fr, int fq) const {
        const bool second = u.pn >= 4; const pg8::Unit v{second ? u.pm - T / 256 : u.pm, second ? u.pn - 4 : u.pn};
        const EpiMerge e{Mg, second ? gm : ga, second ? 0 : 1}; e(acc, v, wr, wc, fr, fq); }
};
template <bool XBF> struct EpiResid {
    static constexpr bool PERM = true, AFTER_DRAIN = false;
    const void* xin; bf16* xout; const float* gate;
    __device__ __forceinline__ void operator()(const f32x4 (&acc)[2][2][4][2], const pg8::Unit& u, int wr, int wc, int fr, int fq) const {
        const int row0 = u.pm * 256 + wr * 64 + fr, b = (u.pm * 256) >> 11, cbase = u.pn * 256 + wc * 32 + 8 * fq;
        f32x4 gv[2][2];
#pragma unroll
        for (int bj = 0; bj < 2; ++bj) { const float* gp = gate + (size_t)b * NADA + cbase + bj * 128; gv[bj][0] = *(const f32x4*)gp; gv[bj][1] = *(const f32x4*)(gp + 4); }
#pragma unroll
        for (int ai = 0; ai < 2; ++ai) {
            f32x4 xv[4][2][2];
#pragma unroll
            for (int m = 0; m < 4; ++m)
#pragma unroll
                for (int bj = 0; bj < 2; ++bj) { const size_t off = (size_t)(row0 + ai * 128 + m * 16) * 1024 + cbase + bj * 128;
                    if (XBF) { const v4u w = *(const v4u*)((const bf16*)xin + off); xv[m][bj][0] = (f32x4){bflo(w.x), bfhi(w.x), bflo(w.y), bfhi(w.y)}; xv[m][bj][1] = (f32x4){bflo(w.z), bfhi(w.z), bflo(w.w), bfhi(w.w)}; }
                    else { xv[m][bj][0] = *(const f32x4*)((const float*)xin + off); xv[m][bj][1] = *(const f32x4*)((const float*)xin + off + 4); } }
            __builtin_amdgcn_sched_barrier(0);
#pragma unroll
            for (int m = 0; m < 4; ++m)
#pragma unroll
                for (int bj = 0; bj < 2; ++bj) { const size_t off = (size_t)(row0 + ai * 128 + m * 16) * 1024 + cbase + bj * 128;
                    const f32x4 o0 = xv[m][bj][0] + gv[bj][0] * acc[ai][bj][m][0], o1 = xv[m][bj][1] + gv[bj][1] * acc[ai][bj][m][1];
                    v4u w; w.x = pk2(o0[0], o0[1]); w.y = pk2(o0[2], o0[3]); w.z = pk2(o1[0], o1[1]); w.w = pk2(o1[2], o1[3]);
                    GST(xout + off, w); }
        }
    }
};

template <class Get> __device__ __forceinline__ void prep_tile(const Get& get, bf16* dst, int K, int k0, int n0, LAS float* scr, int lane) {
    float tv[32];
#pragma unroll
    for (int i = 0; i < 32; ++i) tv[i] = get(k0 + 2 * i + (lane >> 5), n0 + (lane & 31));
#pragma unroll
    for (int i = 0; i < 32; ++i) { const int kk = 2 * i + (lane >> 5); scr[kk * 33 + (lane & 31)] = tv[i]; }
    LDS_WAIT(); asm volatile("" ::: "memory");
    const int c = lane & 7;
#pragma unroll
    for (int j = 0; j < 4; ++j) { const int n = (lane >> 3) + 8 * j; const LAS float* s = scr + (8 * c) * 33 + n;
        v4u o; o.x = pk2(s[0 * 33], s[1 * 33]); o.y = pk2(s[2 * 33], s[3 * 33]); o.z = pk2(s[4 * 33], s[5 * 33]); o.w = pk2(s[6 * 33], s[7 * 33]);
        *(GAS v4u*)(dst + (size_t)(n0 + n) * K + k0 + 8 * c) = o; }
    LDS_WAIT(); asm volatile("" ::: "memory");
}
struct GetWin { const float* w; __device__ __forceinline__ float operator()(int k, int n) const {
    int sc; if (n < 1024) sc = n; else if (n < 2048) sc = n + 32; else if (n < 4096) sc = n + 40; else if (n < 4128) sc = n - 3072; else if (n < 4136) sc = n - 2048; else sc = -1;
    return sc < 0 ? 0.f : w[(size_t)k * 4136 + sc]; } };
struct GetWq { const float* w; const float* g; __device__ __forceinline__ float operator()(int k, int n) const {
    const int h = n / 96, dd = n % 96; const int e = dd - 64; const int sd = dd < 64 ? dd : 64 + (e >> 1) + 16 * (e & 1);
    return w[(size_t)k * 768 + h * 96 + sd] * g[k] * QSCALE; } };
struct GetWkv { const float* w; const float* g; __device__ __forceinline__ float operator()(int k, int n) const {
    const int nn = n & 511, h = nn >> 6, c = nn & 63; const int sc = h * 128 + c + ((n >= 512) ? 64 : 0);
    return w[(size_t)k * 1024 + sc] * g[k]; } };
struct GetPlain { const float* w; int N; __device__ __forceinline__ float operator()(int k, int n) const { return w[(size_t)k * N + n]; } };
struct GetWqk { const float* wq; const float* wk; __device__ __forceinline__ float operator()(int k, int n) const {
    const int c = n >> 9, part = (n >> 8) & 1, h = 2 * c + ((n >> 7) & 1), e = n & 127, kh = k >> 7, d = k & 127;
    if (kh != h) return 0.f;
    const size_t off = ((size_t)h * 128 + d) * 128 + e;
    return part ? wk[off] * 0.08838834764831845f : wq[off]; } };
struct GetWv { const float* wv; __device__ __forceinline__ float operator()(int k, int n) const {
    const int h = n >> 7, e = n & 127, kh = k >> 7, d = k & 127;
    return (kh != h) ? 0.f : wv[((size_t)h * 128 + d) * 128 + e]; } };

__device__ const float INV_FREQ[16] = { 1.0f, 0.5623413251903491f, 0.31622776601683794f, 0.1778279410038923f, 0.1f, 0.05623413251903491f, 0.031622776601683794f, 0.01778279410038923f,
    0.01f, 0.005623413251903491f, 0.0031622776601683794f, 0.001778279410038923f, 0.001f, 0.0005623413251903491f, 0.00031622776601683794f, 0.0001778279410038923f };

template <bool XBF> __device__ __forceinline__ void rowpass_norm_mod(const void* xin_, const float* g, const float* ada_shift, const float* ada_scale, bf16* hout, int gw, int NGW, int lane, unsigned char* h8 = nullptr, float* xs = nullptr) {
#define RP_LOAD(dst, row) { if (XBF) { const u32x2* p_ = (const u32x2*)((const bf16*)xin_ + (size_t)(row) * D) + lane; _Pragma("unroll") for (int j = 0; j < 4; ++j) { const u32x2 w_ = p_[64 * j]; dst[j] = (f32x4){bflo(w_.x), bfhi(w_.x), bflo(w_.y), bfhi(w_.y)}; } } \
                          else { const f32x4* p_ = (const f32x4*)((const float*)xin_ + (size_t)(row) * D) + lane; _Pragma("unroll") for (int j = 0; j < 4; ++j) dst[j] = p_[64 * j]; } }
    f32x4 vn[4];
    if (gw < T) RP_LOAD(vn, gw);
    for (int t = gw; t < T; t += NGW) {
        const int b = t >> 11;
        f32x4 v[4]; float s = 0.f;
#pragma unroll
        for (int j = 0; j < 4; ++j) { v[j] = vn[j]; s += dot4(v[j], v[j]); }
        { const int tn = (t + NGW < T) ? t + NGW : t;
          RP_LOAD(vn, tn); }
        const float r = rsqrtf(wave_sum(s) * (1.f / D) + RMS_EPS);
        unsigned long long* o8 = (unsigned long long*)(hout + (size_t)t * D) + lane;
        f32x4 ov[4]; float am = 0.f;
#pragma unroll
        for (int j = 0; j < 4; ++j) { const int col = 4 * lane + 256 * j;
            const f32x4 gg = *(const f32x4*)(g + col), sc = *(const f32x4*)(ada_scale + (size_t)b * NADA + col), sh = *(const f32x4*)(ada_shift + (size_t)b * NADA + col);
            const f32x4 o = v[j] * r * gg * (sc + 1.f) + sh; ov[j] = o;
            am = fmaxf(fmaxf(am, fmaxf(fabsf(o.x), fabsf(o.y))), fmaxf(fabsf(o.z), fabsf(o.w)));
            GSTF(o8 + 64 * j, (unsigned long long)pk2(o.x, o.y) | ((unsigned long long)pk2(o.z, o.w) << 32)); }
        if (h8) {
#pragma unroll
            for (int o = 1; o < 64; o <<= 1) am = fmaxf(am, __shfl_xor(am, o));
            const float inv = am > 0.f ? 127.f / am : 0.f;
#pragma unroll
            for (int j = 0; j < 4; ++j) { const int q0 = (int)rintf(ov[j].x * inv), q1 = (int)rintf(ov[j].y * inv), q2 = (int)rintf(ov[j].z * inv), q3 = (int)rintf(ov[j].w * inv);
                GSTF((unsigned*)(h8 + (size_t)t * D) + lane + 64 * j, (unsigned)(q0 & 255) | ((unsigned)(q1 & 255) << 8) | ((unsigned)(q2 & 255) << 16) | ((unsigned)(q3 & 255) << 24)); }
            if (lane == 0) xs[t] = am * (1.f / 127.f);
        }
    }
}
__device__ __forceinline__ void rowpass_final(const bf16* xin_, const float* g, float* out, int gw, int NGW, int lane) {
    constexpr bool XBF = true;
    f32x4 vn[4];
    if (gw < T) RP_LOAD(vn, gw);
    for (int t = gw; t < T; t += NGW) {
        f32x4 v[4]; float s = 0.f;
#pragma unroll
        for (int j = 0; j < 4; ++j) { v[j] = vn[j]; s += dot4(v[j], v[j]); }
        { const int tn = (t + NGW < T) ? t + NGW : t;
          RP_LOAD(vn, tn); }
        const float r = rsqrtf(wave_sum(s) * (1.f / D) + RMS_EPS);
        f32x4* o = (f32x4*)(out + (size_t)t * D) + lane;
#pragma unroll
        for (int j = 0; j < 4; ++j) { const f32x4 gg = *(const f32x4*)(g + 4 * lane + 256 * j); o[64 * j] = v[j] * r * gg; }
    }
}
#undef RP_LOAD
__device__ __forceinline__ void rowpass_mid(const bf16* qlat, const bf16* kvlat, const float* small, const float* smallp, const float* cosT, const float* sinT, const bf16* um,
                                            const float* conv_w, const float* conv_b, const float* b_i, const float* b_f,
                                            float* RQ, float* RKV, bf16* K, float* LOGI, float* LOGF, bf16* CONV, int gw, int NGW, int lane) {
    const int c0 = 8 * lane;
    f32x4 cw[4][2], cb[2];
#pragma unroll
    for (int j = 0; j < 4; ++j) { cw[j][0] = *(const f32x4*)(conv_w + j * 512 + c0); cw[j][1] = *(const f32x4*)(conv_w + j * 512 + c0 + 4); }
    cb[0] = *(const f32x4*)(conv_b + c0); cb[1] = *(const f32x4*)(conv_b + c0 + 4);
    const float bsel = (lane >= 32 && lane < 36) ? b_i[lane - 32] : (lane >= 36 && lane < 40) ? b_f[lane - 36] : 0.f;
    for (int tb = gw * 4; tb < T; tb += NGW * 4) {
        const int pos0 = tb & (SEQ - 1);
        u32x2 qv[4][3], kvv[4]; v4u uw[7]; float sv[4], cs[4], sn[4];
#pragma unroll
        for (int i = 0; i < 4; ++i) { const int t = tb + i; const u32x2* p = (const u32x2*)(qlat + (size_t)t * 768);
#pragma unroll
            for (int j = 0; j < 3; ++j) qv[i][j] = p[lane + 64 * j];
            kvv[i] = ((const u32x2*)(kvlat + (size_t)t * 256))[lane];
            sv[i] = 0.f;
            if (lane < 40) sv[i] = smallp ? ((smallp[(size_t)t * 64 + lane] + smallp[(size_t)(T + t) * 64 + lane]) + (smallp[(size_t)(2 * T + t) * 64 + lane] + smallp[(size_t)(3 * T + t) * 64 + lane]))
                                         : small[(size_t)t * 64 + lane];
            cs[i] = 0.f; sn[i] = 0.f; if (lane < 16) { cs[i] = cosT[(size_t)t * 16 + lane]; sn[i] = sinT[(size_t)t * 16 + lane]; } }
#pragma unroll
        for (int j = 0; j < 7; ++j) { uw[j] = (v4u){0u, 0u, 0u, 0u}; if (pos0 - 3 + j >= 0) uw[j] = *(const v4u*)(um + (size_t)(tb - 3 + j) * 512 + c0); }
#pragma unroll
        for (int i = 0; i < 4; ++i) { const int t = tb + i;
            float s = 0.f;
#pragma unroll
            for (int j = 0; j < 3; ++j) { const u32x2 w = qv[i][j]; const float a = bflo(w.x), b2 = bfhi(w.x), c = bflo(w.y), d = bfhi(w.y); s += (a * a + b2 * b2) + (c * c + d * d); }
            const float rq = rsqrtf(wave_sum(s) * (1.f / 768.f) + RMS_EPS);
            const u32x2 w = kvv[i]; const float a = bflo(w.x), b2 = bfhi(w.x), c = bflo(w.y), d = bfhi(w.y);
            const float rkv = rsqrtf(wave_sum((a * a + b2 * b2) + (c * c + d * d)) * (1.f / 256.f) + RMS_EPS);
            if (lane == 0) { RQ[t] = rq; RKV[t] = rkv; }
            const float x2 = __shfl(sv[i], (lane + 16) & 63);
            if (lane < 16) { const float x1 = sv[i]; const unsigned pk = pk2(x1 * cs[i] - x2 * sn[i], x2 * cs[i] + x1 * sn[i]);
#pragma unroll
                for (int h = 0; h < 8; ++h) ((unsigned*)(K + (size_t)t * 768 + 96 * h + 64))[lane] = pk; }
            else if (lane >= 32 && lane < 36) LOGI[(size_t)t * 4 + (lane - 32)] = sv[i] + bsel;
            else if (lane >= 36 && lane < 40) { const float x = sv[i] + bsel; LOGF[(size_t)t * 4 + (lane - 36)] = fminf(x, 0.f) - log1pf(expf(-fabsf(x))); }
            float acc[8];
            acc[0] = cb[0][0]; acc[1] = cb[0][1]; acc[2] = cb[0][2]; acc[3] = cb[0][3]; acc[4] = cb[1][0]; acc[5] = cb[1][1]; acc[6] = cb[1][2]; acc[7] = cb[1][3];
#pragma unroll
            for (int j = 0; j < 4; ++j) { const v4u u4 = uw[i + j];
                acc[0] += cw[j][0][0] * bflo(u4.x); acc[1] += cw[j][0][1] * bfhi(u4.x); acc[2] += cw[j][0][2] * bflo(u4.y); acc[3] += cw[j][0][3] * bfhi(u4.y);
                acc[4] += cw[j][1][0] * bflo(u4.z); acc[5] += cw[j][1][1] * bfhi(u4.z); acc[6] += cw[j][1][2] * bflo(u4.w); acc[7] += cw[j][1][3] * bfhi(u4.w); }
#pragma unroll
            for (int q = 0; q < 8; ++q) acc[q] = acc[q] * sigm(acc[q]);
            v4u o; o.x = pk2(acc[0], acc[1]); o.y = pk2(acc[2], acc[3]); o.z = pk2(acc[4], acc[5]); o.w = pk2(acc[6], acc[7]);
            GSTF(CONV + (size_t)t * 512 + c0, o); }
    }
}

typedef float f32x16 __attribute__((ext_vector_type(16)));
typedef short s16x4 __attribute__((ext_vector_type(4)));
typedef short v4i16_t __attribute__((ext_vector_type(4)));
typedef float f32x2_t __attribute__((ext_vector_type(2))); typedef __bf16 bf16x2_t __attribute__((ext_vector_type(2)));
__device__ __forceinline__ unsigned cvtpk(float lo, float hi) { f32x2_t v = {lo, hi}; bf16x2_t b = __builtin_convertvector(v, bf16x2_t); return __builtin_bit_cast(unsigned, b); }
__device__ __forceinline__ s16x4 vtr(const LAS unsigned char* p) { return __builtin_bit_cast(s16x4, __builtin_amdgcn_ds_read_tr16_b64_v4i16((LAS v4i16_t*)p)); }
__device__ __forceinline__ bf16x8 pack8(float a0, float a1, float a2, float a3, float a4, float a5, float a6, float a7) {
    v4u p; p.x = cvtpk(a0, a1); p.y = cvtpk(a2, a3); p.z = cvtpk(a4, a5); p.w = cvtpk(a6, a7); return __builtin_bit_cast(bf16x8, p); }
#define MFMA32(a, b, c) __builtin_amdgcn_mfma_f32_32x32x16_bf16((a), (b), (c), 0, 0, 0)
constexpr int AT_KB = 12288, AT_VB = 8192;
__device__ __forceinline__ void attn_mfma(const bf16* Q, const bf16* K, const bf16* V, bf16* AO, LAS unsigned char* lds, int bx, int G, int tid) {
    const int lane = tid & 63, wave = __builtin_amdgcn_readfirstlane(tid >> 6), r = lane & 31, hh = lane >> 5;
    const int i16 = lane & 15, q4 = i16 >> 2, p4 = i16 & 3, blk = (lane >> 4) & 1;
    const int vboff = (4 * hh + q4) * 64 + 32 * blk + 8 * p4;
    const int kr0 = tid / 12, kc0 = tid % 12, kr1 = (tid + 512) / 12, kc1 = (tid + 512) % 12, vr = tid >> 3, vc = tid & 7;
    const int klds0 = (kc0 >> 1) * 2048 + (kc0 & 1) * 1024 + kr0 * 16, klds1 = (kc1 >> 1) * 2048 + (kc1 & 1) * 1024 + kr1 * 16;
    const int vlds = (vc >> 2) * 4096 + (vr >> 4) * 1024 + ((vr >> 3) & 1) * 512 + (vr & 7) * 64 + (vc & 3) * 16;
    for (int pu = bx; pu < 256; pu += G) {
        const int bh = pu >> 2, b = bh >> 3, h = bh & 7;
        const bf16* kg = K + ((size_t)b * SEQ) * 768 + h * 96; const bf16* vg = V + ((size_t)b * SEQ) * 512 + h * 64;
        for (int half = 0; half < 2; ++half) {
            const int qb = half == 0 ? 7 - (pu & 3) : (pu & 3);
            const int q0w = qb * 256 + wave * 32, nkt = 4 * (qb + 1), kmax = (q0w + 31) >> 6;
            bf16x8 qf[6];
            { const bf16* qrow = Q + ((size_t)b * SEQ + q0w + r) * 768 + h * 96 + 8 * hh;
#pragma unroll
              for (int s = 0; s < 6; ++s) qf[s] = *(const bf16x8*)(qrow + 16 * s); }
            f32x16 o0, o1;
#pragma unroll
            for (int i = 0; i < 16; ++i) { o0[i] = 0.f; o1[i] = 0.f; }
            float m = 0.f, l = 0.f; f32x16 negm;
#pragma unroll
            for (int i = 0; i < 16; ++i) negm[i] = 0.f;
            v4u ka = *(const v4u*)(kg + (size_t)kr0 * 768 + kc0 * 8), kb2 = (v4u){0u, 0u, 0u, 0u}, va = *(const v4u*)(vg + (size_t)vr * 512 + vc * 8);
            if (tid < 256) kb2 = *(const v4u*)(kg + (size_t)kr1 * 768 + kc1 * 8);
            __syncthreads();
            *(LAS v4u*)(lds + klds0) = ka; if (tid < 256) *(LAS v4u*)(lds + klds1) = kb2; *(LAS v4u*)(lds + 2 * AT_KB + vlds) = va;
            __syncthreads();
            for (int kt = 0; kt < nkt; ++kt) {
                const int buf = kt & 1;
                if (kt + 1 < nkt) { const size_t k1 = (size_t)(kt + 1) * 64;
                    ka = *(const v4u*)(kg + (k1 + kr0) * 768 + kc0 * 8); if (tid < 256) kb2 = *(const v4u*)(kg + (k1 + kr1) * 768 + kc1 * 8); va = *(const v4u*)(vg + (k1 + vr) * 512 + vc * 8); }
                if (kt <= kmax) {
                    const LAS unsigned char* kb_ = lds + buf * AT_KB + hh * 1024 + r * 16; const LAS unsigned char* vb_ = lds + 2 * AT_KB + buf * AT_VB + vboff;
                    f32x16 s0, s1;
                    { bf16x8 kf0[6], kf1[6];
#pragma unroll
                      for (int s = 0; s < 6; ++s) { kf0[s] = *(const LAS bf16x8*)(kb_ + s * 2048); kf1[s] = *(const LAS bf16x8*)(kb_ + s * 2048 + 512); }
                      __builtin_amdgcn_sched_barrier(0);
                      s0 = MFMA32(kf0[0], qf[0], negm); s1 = MFMA32(kf1[0], qf[0], negm);
#pragma unroll
                      for (int s = 1; s < 6; ++s) { s0 = MFMA32(kf0[s], qf[s], s0); s1 = MFMA32(kf1[s], qf[s], s1); } }
                    if (kt * 64 + 63 > q0w) { const int qq = q0w + r - kt * 64;
#pragma unroll
                        for (int i = 0; i < 16; ++i) { const int key = (i & 3) + 8 * (i >> 2) + 4 * hh; if (key > qq) s0[i] = -INFINITY; if (key + 32 > qq) s1[i] = -INFINITY; } }
                    float mx = fmaxf(fmaxf(s0[0], s1[0]), fmaxf(s0[1], s1[1]));
#pragma unroll
                    for (int i = 2; i < 16; i += 2) mx = fmaxf(fmaxf(mx, fmaxf(s0[i], s1[i])), fmaxf(s0[i + 1], s1[i + 1]));
                    { auto r32 = __builtin_amdgcn_permlane32_swap(__float_as_uint(mx), __float_as_uint(mx), false, false); mx = fmaxf(__uint_as_float(r32[0]), __uint_as_float(r32[1])); }
                    if (kt == 0 || __builtin_amdgcn_ballot_w64(mx > 8.f) != 0ull) {
                        const float d = (kt == 0) ? mx : fmaxf(mx, 0.f), corr = (kt == 0) ? 0.f : __builtin_amdgcn_exp2f(-d);
                        m = (kt == 0) ? mx : m + d; l *= corr;
#pragma unroll
                        for (int i = 0; i < 16; ++i) { o0[i] *= corr; o1[i] *= corr; s0[i] -= d; s1[i] -= d; negm[i] = -m; } }
                    float ps = 0.f;
#pragma unroll
                    for (int i = 0; i < 16; ++i) { s0[i] = __builtin_amdgcn_exp2f(s0[i]); s1[i] = __builtin_amdgcn_exp2f(s1[i]); ps += s0[i] + s1[i]; }
                    l += ps;
                    bf16x8 pf[4];
                    pf[0] = pack8(s0[0], s0[1], s0[2], s0[3], s0[4], s0[5], s0[6], s0[7]); pf[1] = pack8(s0[8], s0[9], s0[10], s0[11], s0[12], s0[13], s0[14], s0[15]);
                    pf[2] = pack8(s1[0], s1[1], s1[2], s1[3], s1[4], s1[5], s1[6], s1[7]); pf[3] = pack8(s1[8], s1[9], s1[10], s1[11], s1[12], s1[13], s1[14], s1[15]);
                    { s16x4 vlo[8], vhi[8];
#pragma unroll
                      for (int ks = 0; ks < 4; ++ks) { vlo[ks] = vtr(vb_ + ks * 1024); vhi[ks] = vtr(vb_ + ks * 1024 + 512); vlo[4 + ks] = vtr(vb_ + 4096 + ks * 1024); vhi[4 + ks] = vtr(vb_ + 4096 + ks * 1024 + 512); }
                      __builtin_amdgcn_sched_barrier(0);
#pragma unroll
                      for (int ks = 0; ks < 4; ++ks) {
                          const bf16x8 a0 = (bf16x8){vlo[ks][0], vlo[ks][1], vlo[ks][2], vlo[ks][3], vhi[ks][0], vhi[ks][1], vhi[ks][2], vhi[ks][3]};
                          const bf16x8 a1 = (bf16x8){vlo[4 + ks][0], vlo[4 + ks][1], vlo[4 + ks][2], vlo[4 + ks][3], vhi[4 + ks][0], vhi[4 + ks][1], vhi[4 + ks][2], vhi[4 + ks][3]};
                          o0 = MFMA32(a0, pf[ks], o0); o1 = MFMA32(a1, pf[ks], o1); } }
                }
                if (kt + 1 < nkt) { LAS unsigned char* nb = lds + (buf ^ 1) * AT_KB; *(LAS v4u*)(nb + klds0) = ka; if (tid < 256) *(LAS v4u*)(nb + klds1) = kb2; *(LAS v4u*)(lds + 2 * AT_KB + (buf ^ 1) * AT_VB + vlds) = va; }
                __syncthreads();
            }
            const float inv = 1.f / (l + __shfl_xor(l, 32));
            bf16* orow = AO + ((size_t)b * SEQ + q0w + r) * 512 + h * 64 + 4 * hh;
#pragma unroll
            for (int g = 0; g < 4; ++g) { u32x2 w0, w1; w0.x = cvtpk(o0[4 * g] * inv, o0[4 * g + 1] * inv); w0.y = cvtpk(o0[4 * g + 2] * inv, o0[4 * g + 3] * inv);
                w1.x = cvtpk(o1[4 * g] * inv, o1[4 * g + 1] * inv); w1.y = cvtpk(o1[4 * g + 2] * inv, o1[4 * g + 3] * inv);
                GST(orow + 8 * g, w0); GST(orow + 32 + 8 * g, w1); }
        }
    }
}


constexpr int ML_KB = 16384, ML_VB = 16384, ML_BUF = 32768, ML_TAB = 3 * 32768;
__device__ __forceinline__ void mlstm_mfma(const bf16* QKM, const bf16* VM, const float* LOGI, const float* LOGF, const bf16* CONV, const bf16* OPRE, const float* ng, const float* skip,
                                           bf16* OUTM, LAS unsigned char* lds, int bx, int G, int tid) {
    const int lane = tid & 63, wave = __builtin_amdgcn_readfirstlane(tid >> 6), r = lane & 31, hh = lane >> 5;
    const int i16 = lane & 15, q4 = i16 >> 2, p4 = i16 & 3, blk = (lane >> 4) & 1;
    const int vboff = (4 * hh + q4) * 64 + 32 * blk + 8 * p4;
    int goff[4], loff[4];
#pragma unroll
    for (int q = 0; q < 4; ++q) { const int j = 4 * wave + q;
        if (j < 16) { goff[q] = lane * 1024 + 16 * (j >> 1) + 8 * (j & 1); loff[q] = (j >> 1) * 2048 + (j & 1) * 1024; }
        else { const int jv = j - 16, dq = jv >> 2, ks = jv & 3; goff[q] = (16 * ks + 8 * (lane >> 5) + ((lane >> 2) & 7)) * 512 + 32 * dq + 8 * (lane & 3); loff[q] = ML_KB + dq * 4096 + ks * 1024; } }
    const bool kwave = wave < 4;
#define ML_DMA(tile, bufi) do { _Pragma("unroll") for (int q_ = 0; q_ < 4; ++q_) { \
        const bf16* src_ = kwave ? (kg + (size_t)(tile) * 64 * 1024 + goff[q_]) : (vg + (size_t)(tile) * 64 * 512 + goff[q_]); \
        __builtin_amdgcn_global_load_lds((const unsigned*)src_, (LAS unsigned*)(lds + (bufi) * ML_BUF + loff[q_]), 16, 0, 0); } } while (0)
    LAS float* Ftab = (LAS float*)(lds + ML_TAB); LAS float* Ctab = Ftab + 2048; LAS float* wtot = Ctab + 2048;
    constexpr float L2E = 1.4426950408889634f;
    for (int pu = bx; pu < 256; pu += G) {
        const int bh = pu >> 3, p = pu & 7, b = bh >> 2, h = bh & 3;
        __syncthreads();
        { float f4[4], i4[4];
#pragma unroll
          for (int e = 0; e < 4; ++e) { const size_t row = (size_t)b * SEQ + tid * 4 + e; f4[e] = LOGF[row * 4 + h]; i4[e] = LOGI[row * 4 + h]; }
          f4[1] += f4[0]; f4[2] += f4[1]; f4[3] += f4[2];
          float x = f4[3];
          x += __uint_as_float(__builtin_amdgcn_update_dpp(0, __float_as_uint(x), 0x111, 0xf, 0xf, true)); x += __uint_as_float(__builtin_amdgcn_update_dpp(0, __float_as_uint(x), 0x112, 0xf, 0xf, true));
          x += __uint_as_float(__builtin_amdgcn_update_dpp(0, __float_as_uint(x), 0x114, 0xf, 0xf, true)); x += __uint_as_float(__builtin_amdgcn_update_dpp(0, __float_as_uint(x), 0x118, 0xf, 0xf, true));
          { const float t0 = __uint_as_float(__builtin_amdgcn_readlane(__float_as_uint(x), 15)), t1 = __uint_as_float(__builtin_amdgcn_readlane(__float_as_uint(x), 31)), t2 = __uint_as_float(__builtin_amdgcn_readlane(__float_as_uint(x), 47));
            const int row = lane >> 4; x += (row >= 1 ? t0 : 0.f) + (row >= 2 ? t1 : 0.f) + (row >= 3 ? t2 : 0.f); }
          if (lane == 63) wtot[wave] = x;
          __syncthreads();
          float base = x - f4[3];
          for (int w = 0; w < wave; ++w) base += wtot[w];
#pragma unroll
          for (int e = 0; e < 4; ++e) { const float F = base + f4[e]; Ftab[tid * 4 + e] = F * L2E; Ctab[tid * 4 + e] = (i4[e] - F) * L2E; } }
        __syncthreads();
        const int grp = wave >> 2, w4 = wave & 3;
        const int q0w = (grp == 0 ? 128 * p : 128 * (15 - p)) + 32 * w4, kmax = (q0w + 31) >> 6, nkt = 2 * (16 - p);
        const size_t trow = (size_t)b * SEQ + q0w + r;
        bf16x8 qf[8];
        { const bf16* qrow = QKM + trow * 1024 + h * 128 + 8 * hh;
#pragma unroll
          for (int s = 0; s < 8; ++s) qf[s] = *(const bf16x8*)(qrow + 16 * s); }
        const float Ft = Ftab[q0w + r], Ft0 = Ftab[q0w];
        LAS float* wt = Ctab + 2048 + 64 + wave * 64;
        f32x16 o[4];
#pragma unroll
        for (int d = 0; d < 4; ++d)
#pragma unroll
            for (int i = 0; i < 16; ++i) o[d][i] = 0.f;
        float den = 0.f;
        const bf16* kg = QKM + ((size_t)b * SEQ) * 1024 + 512 + h * 128; const bf16* vg = VM + ((size_t)b * SEQ) * 512 + h * 128;
        ML_DMA(0, 0);
        if (nkt > 1) { ML_DMA(1, 1); asm volatile("s_waitcnt vmcnt(4)" ::: "memory"); } else asm volatile("s_waitcnt vmcnt(0)" ::: "memory");
        asm volatile("s_waitcnt lgkmcnt(0)" ::: "memory"); __builtin_amdgcn_s_barrier(); asm volatile("" ::: "memory");
        for (int kt = 0; kt < nkt; ++kt) {
            const int buf = kt % 3;
            if (kt + 2 < nkt) ML_DMA(kt + 2, (kt + 2) % 3);
            if (kt <= kmax) {
                const LAS unsigned char* kb_ = lds + buf * ML_BUF + hh * 1024 + r * 16; const LAS unsigned char* vb_ = lds + buf * ML_BUF + ML_KB + vboff;
                f32x16 s0, s1;
#pragma unroll
                for (int i = 0; i < 16; ++i) { s0[i] = 0.f; s1[i] = 0.f; }
#pragma unroll
                for (int sh = 0; sh < 2; ++sh) { bf16x8 kf0[4], kf1[4];
#pragma unroll
                  for (int s = 0; s < 4; ++s) { kf0[s] = *(const LAS bf16x8*)(kb_ + (4 * sh + s) * 2048); kf1[s] = *(const LAS bf16x8*)(kb_ + (4 * sh + s) * 2048 + 512); }
                  __builtin_amdgcn_sched_barrier(0);
#pragma unroll
                  for (int s = 0; s < 4; ++s) { s0 = MFMA32(kf0[s], qf[4 * sh + s], s0); s1 = MFMA32(kf1[s], qf[4 * sh + s], s1); } }
                const int qq = q0w + r - kt * 64;
                const bool diag = kt * 64 + 63 > q0w;
                wt[lane] = __builtin_amdgcn_exp2f(Ctab[kt * 64 + lane] + Ft0);
                LDS_WAIT();
                const LAS float* ct = wt + 4 * hh;
                float ps = 0.f;
#pragma unroll
                for (int g = 0; g < 4; ++g) { const f32x4 c0v = *(const LAS f32x4*)(ct + 8 * g), c1v = *(const LAS f32x4*)(ct + 32 + 8 * g);
#pragma unroll
                    for (int e = 0; e < 4; ++e) { const int i = 4 * g + e, key = e + 8 * g + 4 * hh;
                        float w0 = c0v[e], w1 = c1v[e];
                        if (diag) { w0 = (key <= qq) ? w0 : 0.f; w1 = (key + 32 <= qq) ? w1 : 0.f; }
                        s0[i] *= w0; s1[i] *= w1; ps += s0[i] + s1[i]; } }
                den += ps;
                bf16x8 pf[4];
                pf[0] = pack8(s0[0], s0[1], s0[2], s0[3], s0[4], s0[5], s0[6], s0[7]); pf[1] = pack8(s0[8], s0[9], s0[10], s0[11], s0[12], s0[13], s0[14], s0[15]);
                pf[2] = pack8(s1[0], s1[1], s1[2], s1[3], s1[4], s1[5], s1[6], s1[7]); pf[3] = pack8(s1[8], s1[9], s1[10], s1[11], s1[12], s1[13], s1[14], s1[15]);
#pragma unroll
                for (int ks = 0; ks < 4; ++ks) { s16x4 vlo[4], vhi[4];
#pragma unroll
                    for (int d = 0; d < 4; ++d) { vlo[d] = vtr(vb_ + d * 4096 + ks * 1024); vhi[d] = vtr(vb_ + d * 4096 + ks * 1024 + 512); }
                    __builtin_amdgcn_sched_barrier(0);
#pragma unroll
                    for (int d = 0; d < 4; ++d) { const s16x4 lo = vlo[d], hi = vhi[d];
                        const bf16x8 av = (bf16x8){lo[0], lo[1], lo[2], lo[3], hi[0], hi[1], hi[2], hi[3]};
                        o[d] = MFMA32(av, pf[ks], o[d]); } }
            }
            if (kt + 2 < nkt) asm volatile("s_waitcnt vmcnt(4)" ::: "memory"); else asm volatile("s_waitcnt vmcnt(0)" ::: "memory");
            asm volatile("s_waitcnt lgkmcnt(0)" ::: "memory"); __builtin_amdgcn_s_barrier(); asm volatile("" ::: "memory");
        }
        const float kap = __builtin_amdgcn_exp2f(Ft - Ft0);
        const float dt = (den + __shfl_xor(den, 32)) * kap;
        const float inv = kap / fmaxf(fabsf(dt), 1.f);
        float sm = 0.f;
#pragma unroll
        for (int d = 0; d < 4; ++d)
#pragma unroll
            for (int i = 0; i < 16; ++i) { o[d][i] *= inv; sm += o[d][i]; }
        sm += __shfl_xor(sm, 32);
        const float mu = sm * (1.f / 128.f);
        float vs = 0.f;
#pragma unroll
        for (int d = 0; d < 4; ++d)
#pragma unroll
            for (int i = 0; i < 16; ++i) { const float dlt = o[d][i] - mu; vs += dlt * dlt; }
        vs += __shfl_xor(vs, 32);
        const float rstd = rsqrtf(vs * (1.f / 128.f) + RMS_EPS);
#pragma unroll
        for (int d = 0; d < 4; ++d)
#pragma unroll
            for (int g = 0; g < 4; ++g) { const int ch = h * 128 + 32 * d + 8 * g + 4 * hh; const size_t off = trow * 512 + ch;
                const u32x2 cv = *(const u32x2*)(CONV + off), ov = *(const u32x2*)(OPRE + off); const f32x4 gg = *(const f32x4*)(ng + ch), sk = *(const f32x4*)(skip + ch);
                const float y0 = sigm(bflo(ov.x)) * ((o[d][4 * g] - mu) * rstd * gg[0] + sk[0] * bflo(cv.x)), y1 = sigm(bfhi(ov.x)) * ((o[d][4 * g + 1] - mu) * rstd * gg[1] + sk[1] * bfhi(cv.x));
                const float y2 = sigm(bflo(ov.y)) * ((o[d][4 * g + 2] - mu) * rstd * gg[2] + sk[2] * bflo(cv.y)), y3 = sigm(bfhi(ov.y)) * ((o[d][4 * g + 3] - mu) * rstd * gg[3] + sk[3] * bfhi(cv.y));
                u32x2 w; w.x = cvtpk(y0, y1); w.y = cvtpk(y2, y3); GST(OUTM + off, w); }
    }
#undef ML_DMA
}

template <int N> __device__ __forceinline__ void bitonic_sort_desc(float (&v)[N]) {
#pragma unroll
    for (int k = 2; k <= N; k <<= 1)
#pragma unroll
        for (int j = k >> 1; j > 0; j >>= 1)
#pragma unroll
            for (int i = 0; i < N; ++i) { const int l = i ^ j; if (l > i) { const bool desc = ((i & k) == 0); const float a = v[i], b = v[l], hi = fmaxf(a, b), lo = fminf(a, b); v[i] = desc ? hi : lo; v[l] = desc ? lo : hi; } }
}
__device__ __forceinline__ void top16_merge(float (&a)[16], const float (&b)[16]) {
#pragma unroll
    for (int i = 0; i < 16; ++i) a[i] = fmaxf(a[i], b[15 - i]);
#pragma unroll
    for (int j = 8; j > 0; j >>= 1)
#pragma unroll
        for (int i = 0; i < 16; ++i) { const int l = i ^ j; if (l > i) { const float x = a[i], y = a[l]; a[i] = fmaxf(x, y); a[l] = fminf(x, y); } }
}
constexpr int PE_EIDX = 0, PE_EGATE = 16384, PE_KEYT = 32768;
__device__ __forceinline__ void peer_route(const bf16* PQ, const bf16* KEYB, int* IDX, float* GATE, LAS unsigned char* lds, int bx, int G, int tid) {
    const int lane = tid & 63, wave = __builtin_amdgcn_readfirstlane(tid >> 6), r = lane & 31, hh = lane >> 5;
    LAS unsigned char* keyt = lds + PE_KEYT + (wave * 32 + r) * 32;
    for (int grp = bx; grp < T / 32; grp += G) {
        const int t0 = grp * 32;
        { const int h = wave;
          int rq = r; asm volatile("" : "+v"(rq));
          float top[2][16];
#pragma unroll
          for (int p = 0; p < 2; ++p) {
              bf16x8 qf[4];
              { const bf16* qrow = PQ + (size_t)(t0 + rq) * 1024 + h * 128 + p * 64 + 8 * hh;
#pragma unroll
                for (int s = 0; s < 4; ++s) qf[s] = *(const bf16x8*)(qrow + 16 * s); }
              const bf16* kb = KEYB + ((size_t)(h * 2 + p) * 128 + rq) * 64 + 8 * hh;
              float sv[4][16];
#pragma unroll
              for (int kt = 0; kt < 4; ++kt) { f32x16 acc;
#pragma unroll
                  for (int i = 0; i < 16; ++i) acc[i] = 0.f;
#pragma unroll
                  for (int s = 0; s < 4; ++s) { const bf16x8 a = *(const bf16x8*)(kb + (size_t)(32 * kt) * 64 + 16 * s); acc = MFMA32(a, qf[s], acc); }
#pragma unroll
                  for (int i = 0; i < 16; ++i) { const unsigned key = (unsigned)(32 * kt + (i & 3) + 8 * (i >> 2)) + 4u * (unsigned)hh; sv[kt][i] = __uint_as_float((__float_as_uint(acc[i]) & ~127u) | key); } }
              bitonic_sort_desc<16>(sv[0]); bitonic_sort_desc<16>(sv[1]); bitonic_sort_desc<16>(sv[2]); bitonic_sort_desc<16>(sv[3]);
              top16_merge(sv[0], sv[1]); top16_merge(sv[2], sv[3]); top16_merge(sv[0], sv[2]);
              float pr[16];
#pragma unroll
              for (int i = 0; i < 16; ++i) { auto r32 = __builtin_amdgcn_permlane32_swap(__float_as_uint(sv[0][i]), __float_as_uint(sv[0][i]), false, false); pr[i] = __uint_as_float(hh ? r32[0] : r32[1]); }
              top16_merge(sv[0], pr);
#pragma unroll
              for (int i = 0; i < 16; ++i) top[p][i] = sv[0][i];
          }
          if (hh == 0) {
#pragma unroll
              for (int i = 0; i < 16; ++i) { keyt[i] = (unsigned char)(__float_as_uint(top[0][i]) & 127u); keyt[16 + i] = (unsigned char)(__float_as_uint(top[1][i]) & 127u); } }
          float cs[4][16];
#define PSUM(a, b) __uint_as_float((__float_as_uint(top[0][a] + top[1][b]) & ~255u) | (unsigned)((a) * 16 + (b)))
#pragma unroll
          for (int b2 = 0; b2 < 16; ++b2) cs[0][b2] = PSUM(0, b2);
#pragma unroll
          for (int b2 = 0; b2 < 8; ++b2) cs[1][b2] = PSUM(1, b2);
#pragma unroll
          for (int a2 = 8; a2 < 16; ++a2) cs[1][a2] = PSUM(a2, 0);
#pragma unroll
          for (int b2 = 0; b2 < 5; ++b2) cs[2][b2] = PSUM(2, b2);
#pragma unroll
          for (int b2 = 0; b2 < 4; ++b2) cs[2][5 + b2] = PSUM(3, b2);
#pragma unroll
          for (int b2 = 0; b2 < 3; ++b2) cs[2][9 + b2] = PSUM(4, b2);
          cs[2][12] = PSUM(5, 0); cs[2][13] = PSUM(5, 1); cs[2][14] = PSUM(6, 0); cs[2][15] = PSUM(6, 1);
          cs[3][0] = PSUM(7, 0); cs[3][1] = PSUM(7, 1);
#undef PSUM
#pragma unroll
          for (int i = 2; i < 16; ++i) cs[3][i] = -3.0e38f;
          bitonic_sort_desc<16>(cs[0]); bitonic_sort_desc<16>(cs[1]); bitonic_sort_desc<16>(cs[2]); bitonic_sort_desc<16>(cs[3]);
          top16_merge(cs[0], cs[1]); top16_merge(cs[2], cs[3]); top16_merge(cs[0], cs[2]);
          LDS_WAIT();
          float ev[16], den = 0.f; const float mx = __uint_as_float(__float_as_uint(cs[0][0]) & ~255u);
#pragma unroll
          for (int k = 0; k < 16; ++k) { ev[k] = __expf(__uint_as_float(__float_as_uint(cs[0][k]) & ~255u) - mx); den += ev[k]; }
          const float rden = 1.f / den;
          if (hh == 0) {
#pragma unroll
              for (int k = 0; k < 16; ++k) { const unsigned code = __float_as_uint(cs[0][k]) & 255u; const int e = (int)keyt[code >> 4] * 128 + (int)keyt[16 + (code & 15u)];
                  GST(IDX + (size_t)(t0 + r) * 128 + h * 16 + k, e); GST(GATE + (size_t)(t0 + r) * 128 + h * 16 + k, ev[k] * rden); } }
        }
    }
}
__device__ __forceinline__ void peer_partition(const unsigned* xc_cnt, volatile LAS unsigned* MISC, int bx, int G, int& vx, int& rank, int& nb) {
    bool use_xcc = MK_ONE_LAUNCH != 0; unsigned mine = 0u; const unsigned myx = MISC[13];
    if (use_xcc) { unsigned sum = 0u;
#pragma unroll
        for (unsigned j = 0; j < 8; ++j) { const unsigned c = __hip_atomic_load(xc_cnt + 64 * j, __ATOMIC_RELAXED, __HIP_MEMORY_SCOPE_AGENT); use_xcc = use_xcc && (c > 0u); sum += c; mine = (j == myx) ? c : mine; }
        use_xcc = use_xcc && (sum == (unsigned)G); }
    if (use_xcc) { vx = (int)myx; rank = (int)MISC[12]; nb = (int)mine; } else { vx = bx & 7; rank = bx >> 3; nb = (G - vx + 7) >> 3; }
    vx = __builtin_amdgcn_readfirstlane(vx); rank = __builtin_amdgcn_readfirstlane(rank); nb = __builtin_amdgcn_readfirstlane(nb);
}
__device__ __forceinline__ void peer_u_i8(const unsigned char* H8, const float* XS, const int* IDX, const unsigned char* U8, const f32x2v* SC2, float* ACT, LAS float* wscr, int vx, int rank, int nb, int tid) {
    const int lane = tid & 63, wave = __builtin_amdgcn_readfirstlane(tid >> 6), g4 = lane >> 4, c16 = lane & 15;
    const int tstride = nb * 8;
    LAS int* clist = (LAS int*)wscr;
    LAS unsigned char* xs = (LAS unsigned char*)(wscr + 512);
    const unsigned long long lt = (1ull << lane) - 1ull;
    const unsigned char* ubase = U8 + 16 * c16;
    int ni[8];
    { const int tb = rank * 8 + wave;
#pragma unroll
      for (int j = 0; j < 4; ++j) { const int tj = tb + j * tstride; const bool ok = tj < T; ni[2 * j] = ok ? IDX[(size_t)tj * 128 + lane] : 0x7fffffff; ni[2 * j + 1] = ok ? IDX[(size_t)tj * 128 + 64 + lane] : 0x7fffffff; } }
    for (int tb = rank * 8 + wave; tb < T; tb += 4 * tstride) {
        int ntot = 0;
#pragma unroll
        for (int j = 0; j < 4; ++j) { const int e0 = ni[2 * j], e1 = ni[2 * j + 1]; const bool f0 = (e0 >> 11) == vx, f1 = (e1 >> 11) == vx;
            const unsigned long long m0 = __ballot(f0), m1 = __ballot(f1); const int n0 = __popcll(m0);
            if (f0) clist[ntot + __popcll(m0 & lt)] = (j << 21) | (e0 << 7) | lane;
            if (f1) clist[ntot + n0 + __popcll(m1 & lt)] = (j << 21) | (e1 << 7) | (64 + lane);
            ntot += n0 + __popcll(m1); }
        v4u xr[4]; float sx[4]; int sxl[4];
#pragma unroll
        for (int j = 0; j < 4; ++j) { const int tj = tb + j * tstride, tl = tj < T ? tj : tb; xr[j] = *(const v4u*)(H8 + (size_t)tl * 1024 + 16 * lane); sx[j] = XS[tl]; }
        { const int tn = tb + 4 * tstride;
#pragma unroll
          for (int j = 0; j < 4; ++j) { const int tj = tn + j * tstride; const bool ok = tj < T; ni[2 * j] = ok ? IDX[(size_t)tj * 128 + lane] : 0x7fffffff; ni[2 * j + 1] = ok ? IDX[(size_t)tj * 128 + 64 + lane] : 0x7fffffff; } }
        if (ntot == 0) continue;
#pragma unroll
        for (int j = 0; j < 4; ++j) { *(LAS v4u*)(xs + j * 1024 + 16 * lane) = xr[j];
            int s = __builtin_amdgcn_sdot4((int)xr[j].x, 0x01010101, 0, false); s = __builtin_amdgcn_sdot4((int)xr[j].y, 0x01010101, s, false);
            s = __builtin_amdgcn_sdot4((int)xr[j].z, 0x01010101, s, false); s = __builtin_amdgcn_sdot4((int)xr[j].w, 0x01010101, s, false);
            s = (lane & 16) ? 0 : s;
            s += __builtin_amdgcn_update_dpp(0, s, 0x128, 0xf, 0xf, false); s += __builtin_amdgcn_update_dpp(0, s, 0x124, 0xf, 0xf, false);
            s += __builtin_amdgcn_update_dpp(0, s, 0x122, 0xf, 0xf, false); s += __builtin_amdgcn_update_dpp(0, s, 0x121, 0xf, 0xf, false);
            sxl[j] = __builtin_amdgcn_readlane(s, 0) + __builtin_amdgcn_readlane(s, 32); }
        LDS_WAIT();
        const int last = ntot - 1, nit = (ntot + 3) >> 2, nit4 = (nit + 3) >> 2;
        v4u ub[4][2]; f32x2v us[4]; int up[4];
#pragma unroll
        for (int k = 0; k < 3; ++k) { const int p = min(4 * k + g4, last); const int pk = clist[p]; up[k] = pk; const unsigned eo = (unsigned)((pk >> 7) & 16383) * 512u; us[k] = SC2[(pk >> 7) & 16383];
#pragma unroll
            for (int jj = 0; jj < 2; ++jj) ub[k][jj] = *(const v4u*)(ubase + eo + 256 * jj);
            __builtin_amdgcn_sched_barrier(0); }
        int dsel = 0, psel = 0; f32x2v ssel = (f32x2v){0.f, 0.f}; bool vsel = false;
#pragma unroll 1
        for (int o = 0; o < nit4; ++o) {
#pragma unroll
            for (int k = 0; k < 4; ++k) {
                const int i = 4 * o + k;
                { const int p = min(4 * (i + 3) + g4, last); const int pk = clist[p]; up[(k + 3) & 3] = pk; const unsigned eo = (unsigned)((pk >> 7) & 16383) * 512u; us[(k + 3) & 3] = SC2[(pk >> 7) & 16383];
#pragma unroll
                  for (int jj = 0; jj < 2; ++jj) ub[(k + 3) & 3][jj] = *(const v4u*)(ubase + eo + 256 * jj); }
                const LAS unsigned char* xp = xs + (up[k] >> 21) * 1024 + 16 * c16;
                v4u xq[4];
#pragma unroll
                for (int jj = 0; jj < 4; ++jj) xq[jj] = *(const LAS v4u*)(xp + 256 * jj);
                int a0 = 0, a1 = 0, h0 = 0, h1 = 0;
#pragma unroll
                for (int jj = 0; jj < 2; ++jj) { const v4u w = ub[k][jj], xl = xq[2 * jj], xh = xq[2 * jj + 1];
                    a0 = __builtin_amdgcn_sdot4((int)(w.x & 0x0f0f0f0fu), (int)xl.x, a0, false); h0 = __builtin_amdgcn_sdot4((int)(w.x & 0xf0f0f0f0u), (int)xh.x, h0, false);
                    a1 = __builtin_amdgcn_sdot4((int)(w.y & 0x0f0f0f0fu), (int)xl.y, a1, false); h1 = __builtin_amdgcn_sdot4((int)(w.y & 0xf0f0f0f0u), (int)xh.y, h1, false);
                    a0 = __builtin_amdgcn_sdot4((int)(w.z & 0x0f0f0f0fu), (int)xl.z, a0, false); h0 = __builtin_amdgcn_sdot4((int)(w.z & 0xf0f0f0f0u), (int)xh.z, h0, false);
                    a1 = __builtin_amdgcn_sdot4((int)(w.w & 0x0f0f0f0fu), (int)xl.w, a1, false); h1 = __builtin_amdgcn_sdot4((int)(w.w & 0xf0f0f0f0u), (int)xh.w, h1, false); }
                int d = (a0 + a1) + ((h0 + h1) >> 4);
                d += __builtin_amdgcn_update_dpp(0, d, 0x128, 0xf, 0xf, false); d += __builtin_amdgcn_update_dpp(0, d, 0x124, 0xf, 0xf, false);
                d += __builtin_amdgcn_update_dpp(0, d, 0x122, 0xf, 0xf, false); d += __builtin_amdgcn_update_dpp(0, d, 0x121, 0xf, 0xf, false);
                if ((i & 15) == c16) { dsel = d; ssel = us[k]; psel = up[k]; vsel = 4 * i + g4 <= last; }
                if (k == 3 && ((o & 3) == 3 || o == nit4 - 1)) {
                    if (vsel) { const int j = psel >> 21; const float sxj = j == 0 ? sx[0] : j == 1 ? sx[1] : j == 2 ? sx[2] : sx[3]; const int slj = j == 0 ? sxl[0] : j == 1 ? sxl[1] : j == 2 ? sxl[2] : sxl[3];
                        GST(ACT + (size_t)(tb + j * tstride) * 128 + (psel & 127), gelu_erf((float)(dsel - 8 * slj) * sxj * ssel.x) * ssel.y); }
                    vsel = false; }
            }
        }
        LDS_WAIT();
    }
}
__device__ __forceinline__ void peer_v(const int* IDX, const float* ACT, const float* GATE, const unsigned char* V8, const float* gate2, const bf16* Xin, bf16* Xout, LAS float* wscr,
                                       int vx, int rank, int nb, int tid) {
    const int lane = tid & 63, wave = __builtin_amdgcn_readfirstlane(tid >> 6), g8 = lane >> 3, c8 = lane & 7;
    const int tstride = nb * 16;
    LAS int* wl = (LAS int*)wscr; LAS unsigned char* wqb = (LAS unsigned char*)(wscr + 128);
    const unsigned char* vbase = V8 + (size_t)(vx >> 1) * (2 * MiB); const int voff = 16 * c8;
    const int col = 256 * (vx >> 1) + 32 * c8;
    const int wqo0 = (lane & 7) * 16 + (lane >> 3), wqo1 = wqo0 + 8;
    const int t0 = (rank * 8 + wave) * 2 + (vx & 1);
    if (t0 >= T) return;
    const int tlast = t0 + ((T - 1 - t0) / tstride) * tstride;
#define PV_STAGE(tt, I0, I1, A0, A1, VV, WQ4, SW) { \
        float am_ = fmaxf(fabsf(A0), fabsf(A1));   \
        am_ = fmaxf(am_, __uint_as_float(__builtin_amdgcn_update_dpp(0, __float_as_uint(am_), 0x128, 0xf, 0xf, false))); am_ = fmaxf(am_, __uint_as_float(__builtin_amdgcn_update_dpp(0, __float_as_uint(am_), 0x124, 0xf, 0xf, false))); \
        am_ = fmaxf(am_, __uint_as_float(__builtin_amdgcn_update_dpp(0, __float_as_uint(am_), 0x122, 0xf, 0xf, false))); am_ = fmaxf(am_, __uint_as_float(__builtin_amdgcn_update_dpp(0, __float_as_uint(am_), 0x121, 0xf, 0xf, false))); \
        am_ = fmaxf(fmaxf(__uint_as_float(__builtin_amdgcn_readlane(__float_as_uint(am_), 0)), __uint_as_float(__builtin_amdgcn_readlane(__float_as_uint(am_), 16))), \
                    fmaxf(__uint_as_float(__builtin_amdgcn_readlane(__float_as_uint(am_), 32)), __uint_as_float(__builtin_amdgcn_readlane(__float_as_uint(am_), 48)))); \
        const float inv_ = am_ > 0.f ? 127.f / am_ : 0.f; SW = am_ * (1.f / 127.f); \
        wl[lane] = I0; wl[64 + lane] = I1; wqb[wqo0] = (unsigned char)((int)rintf(A0 * inv_) & 255); wqb[wqo1] = (unsigned char)((int)rintf(A1 * inv_) & 255); \
        LDS_WAIT(); \
        _Pragma("unroll") for (int i_ = 0; i_ < 16; ++i_) { const int e_ = wl[8 * i_ + g8]; VV[i_] = *(const v4u*)(vbase + (size_t)(unsigned)(e_ * 128 + voff)); } \
        WQ4 = *(const LAS v4u*)(wqb + g8 * 16); LDS_WAIT(); }
#define PV_META(tt, I0, I1, A0, A1) { const size_t o_ = (size_t)(tt) * 128; I0 = IDX[o_ + lane]; I1 = IDX[o_ + 64 + lane]; A0 = ACT[o_ + lane] * GATE[o_ + lane]; A1 = ACT[o_ + 64 + lane] * GATE[o_ + 64 + lane]; }
    int i0, i1, j0, j1; float a0, a1, b0, b1;
    v4u vv[16], vvn[16], wq4, wq4n; float sw, swn;
    PV_META(t0, i0, i1, a0, a1);
    PV_STAGE(t0, i0, i1, a0, a1, vvn, wq4n, swn);
    { const int t1 = min(t0 + tstride, tlast); PV_META(t1, i0, i1, a0, a1); }
#pragma unroll 2
    for (int t = t0; t < T; t += tstride) {
        const int b = t >> 11, tn = min(t + tstride, tlast), tn2 = min(t + 2 * tstride, tlast);
#pragma unroll
        for (int i = 0; i < 16; ++i) vv[i] = vvn[i];
        wq4 = wq4n; sw = swn;
        PV_META(tn2, j0, j1, b0, b1);
        const u32x2 xw1 = *(const u32x2*)(Xin + (size_t)t * 1024 + col + 4 * g8); const f32x4 g21 = *(const f32x4*)(gate2 + (size_t)b * NADA + col + 4 * g8);
        PV_STAGE(tn, i0, i1, a0, a1, vvn, wq4n, swn);
        i0 = j0; i1 = j1; a0 = b0; a1 = b1;
        int accA[16], accB[16], accw = 0;
#pragma unroll
        for (int i = 0; i < 16; ++i) { accA[i] = 0; accB[i] = 0; }
#pragma unroll
        for (int q = 0; q < 4; ++q) { const int wq = (int)(q == 0 ? wq4.x : q == 1 ? wq4.y : q == 2 ? wq4.z : wq4.w);
            accw = __builtin_amdgcn_sdot4(wq, 0x01010101, accw, false);
#pragma unroll
            for (int d = 0; d < 4; ++d) {
                const unsigned ra = d == 0 ? vv[4 * q].x : d == 1 ? vv[4 * q].y : d == 2 ? vv[4 * q].z : vv[4 * q].w, rb = d == 0 ? vv[4 * q + 1].x : d == 1 ? vv[4 * q + 1].y : d == 2 ? vv[4 * q + 1].z : vv[4 * q + 1].w;
                const unsigned rc = d == 0 ? vv[4 * q + 2].x : d == 1 ? vv[4 * q + 2].y : d == 2 ? vv[4 * q + 2].z : vv[4 * q + 2].w, rd = d == 0 ? vv[4 * q + 3].x : d == 1 ? vv[4 * q + 3].y : d == 2 ? vv[4 * q + 3].z : vv[4 * q + 3].w;
                const unsigned ab_lo = __builtin_amdgcn_perm(rb, ra, 0x05010400u), ab_hi = __builtin_amdgcn_perm(rb, ra, 0x07030602u), cd_lo = __builtin_amdgcn_perm(rd, rc, 0x05010400u), cd_hi = __builtin_amdgcn_perm(rd, rc, 0x07030602u);
                const unsigned t0 = __builtin_amdgcn_perm(cd_lo, ab_lo, 0x05040100u), t1 = __builtin_amdgcn_perm(cd_lo, ab_lo, 0x07060302u), t2 = __builtin_amdgcn_perm(cd_hi, ab_hi, 0x05040100u), t3 = __builtin_amdgcn_perm(cd_hi, ab_hi, 0x07060302u);
                accA[4 * d + 0] = __builtin_amdgcn_sdot4((int)t0, wq, accA[4 * d + 0], false); accB[4 * d + 0] = __builtin_amdgcn_sdot4((int)(t0 & 0x0f0f0f0fu), wq, accB[4 * d + 0], false);
                accA[4 * d + 1] = __builtin_amdgcn_sdot4((int)t1, wq, accA[4 * d + 1], false); accB[4 * d + 1] = __builtin_amdgcn_sdot4((int)(t1 & 0x0f0f0f0fu), wq, accB[4 * d + 1], false);
                accA[4 * d + 2] = __builtin_amdgcn_sdot4((int)t2, wq, accA[4 * d + 2], false); accB[4 * d + 2] = __builtin_amdgcn_sdot4((int)(t2 & 0x0f0f0f0fu), wq, accB[4 * d + 2], false);
                accA[4 * d + 3] = __builtin_amdgcn_sdot4((int)t3, wq, accA[4 * d + 3], false); accB[4 * d + 3] = __builtin_amdgcn_sdot4((int)(t3 & 0x0f0f0f0fu), wq, accB[4 * d + 3], false); } }
#define PV_SW16(X, Y) { auto r_ = __builtin_amdgcn_permlane16_swap((unsigned)(X), (unsigned)(Y), false, false); X = (int)(r_[0] + r_[1]); }
#define PV_SW32(X, Y) { auto r_ = __builtin_amdgcn_permlane32_swap((unsigned)(X), (unsigned)(Y), false, false); X = (int)(r_[0] + r_[1]); }
#pragma unroll
        for (int hh = 0; hh < 2; ++hh)
#pragma unroll
            for (int mm = 0; mm < 4; ++mm) { const int mi = 8 * hh + mm; PV_SW16(accA[mi], accA[mi + 4]); PV_SW16(accB[mi], accB[mi + 4]); }
#pragma unroll
        for (int mi = 0; mi < 4; ++mi) { PV_SW32(accA[mi], accA[mi + 8]); PV_SW32(accB[mi], accB[mi + 8]); }
        { const bool b3 = (lane & 8) != 0;
#pragma unroll
          for (int mi = 0; mi < 2; ++mi) {
              { const int keep = b3 ? accA[mi + 2] : accA[mi], send = b3 ? accA[mi] : accA[mi + 2]; accA[mi] = keep + __builtin_amdgcn_update_dpp(0, send, 0x128, 0xf, 0xf, false); }
              { const int keep = b3 ? accB[mi + 2] : accB[mi], send = b3 ? accB[mi] : accB[mi + 2]; accB[mi] = keep + __builtin_amdgcn_update_dpp(0, send, 0x128, 0xf, 0xf, false); } } }
        accw += __builtin_amdgcn_update_dpp(0, accw, 0x128, 0xf, 0xf, false); PV_SW16(accw, accw); PV_SW32(accw, accw);
#undef PV_SW16
#undef PV_SW32
        { const int off8 = 8 * accw;
          const int s0 = accB[0] - off8, s1 = (accA[0] - accB[0]) >> 4, s2 = accB[1] - off8, s3 = (accA[1] - accB[1]) >> 4;
          const f32x4 xo = (f32x4){bflo(xw1.x), bfhi(xw1.x), bflo(xw1.y), bfhi(xw1.y)} + g21 * ((f32x4){(float)s0, (float)s1, (float)s2, (float)s3} * sw);
          u32x2 w; w.x = pk2(xo[0], xo[1]); w.y = pk2(xo[2], xo[3]); GSTF(Xout + (size_t)t * 1024 + col + 4 * g8, w); }
    }
#undef PV_STAGE
#undef PV_META
}

constexpr int PH_PER_LAYER = 12, N_PHASES = 1 + DEPTH * PH_PER_LAYER + 1;
struct Args { const void* in[N_INPUTS]; float* out; unsigned char* ws; int ph_lo, ph_hi; };
static_assert(sizeof(Args) == N_INPUTS * 8 + 24, "Args has no padding");

constexpr int PTAB_OFF = LDSCTL_OFF + 1024;
__device__ __forceinline__ unsigned char* getp(LAS unsigned char* lds, int i) {
    asm volatile("" ::: "memory");
    const u32x2 v = *(volatile LAS u32x2*)(lds + PTAB_OFF + 8 * i);
    const unsigned lo = __builtin_amdgcn_readfirstlane(v.x), hi = __builtin_amdgcn_readfirstlane(v.y);
    GAS unsigned char* g = (GAS unsigned char*)(((unsigned long long)hi << 32) | lo);
    return (unsigned char*)g;
}
#define INP(i) ((const float*)getp(lds, (i)))
#define WSB() getp(lds, 30)

#define IN(k) (lo <= (k) && (k) < hi)
#define SEAM(k) do { if (MK_ONE_LAUNCH && IN(k) && IN((k) + 1)) { XcdBarrier b_; b_.bar = (unsigned*)(WSB() + WS_CTL) + CW_BAR; b_.x = xb_xcc_id(); b_.st = MISC + 8; REPS(11) xcd_barrier(b_, (wave_s << 6) | (int)__lane_id()); } } while (0)
#define PH_BEGIN(lv) int tidq; asm volatile("v_mbcnt_lo_u32_b32 %0, -1, 0\n\tv_mbcnt_hi_u32_b32 %0, -1, %0" : "=v"(tidq)); tidq |= wave_s << 6;     \
    asm volatile("" : "+v"(tidq)); const int lane = tidq & 63, wave = __builtin_amdgcn_readfirstlane(tidq >> 6); \
    int G = gridDim.x, bx = blockIdx.x, l = (lv); asm volatile("" : "+s"(G), "+s"(bx), "+s"(l)); const int gw = bx * NWAVES + wave, NGW = G * NWAVES; \
    unsigned char* ws = WSB(); LAS float* wscr = (LAS float*)(lds + RING_OFF + wave * 16384); (void)lane; (void)gw; (void)NGW; (void)ws; (void)wscr; (void)l


constexpr int PI_W = 4512, PI_K = 512, PI_U = 2048, PI_V = 2048, PI_TOTAL = PI_W + PI_K + PI_U + PI_V;
template <int NR> __device__ __forceinline__ void prep_rows_i8(const float* src, size_t src_stride, unsigned char* dst, size_t dst_stride, float* scale_slot  , int lane) {
    f32x4 v[NR][4];
#pragma unroll
    for (int rr = 0; rr < NR; ++rr) { const f32x4* s = (const f32x4*)(src + rr * src_stride) + lane * 4;
#pragma unroll
        for (int j = 0; j < 4; ++j) v[rr][j] = s[j]; }
#pragma unroll
    for (int rr = 0; rr < NR; ++rr) {
        float am = 0.f;
#pragma unroll
        for (int j = 0; j < 4; ++j) am = fmaxf(fmaxf(am, fmaxf(fabsf(v[rr][j][0]), fabsf(v[rr][j][1]))), fmaxf(fabsf(v[rr][j][2]), fabsf(v[rr][j][3])));
#pragma unroll
        for (int o = 1; o < 64; o <<= 1) am = fmaxf(am, __shfl_xor(am, o));
        const float inv = am > 0.f ? 127.f / am : 0.f;
#define Q4(x) ((unsigned)((int)rintf((x)[0] * inv) & 255) | ((unsigned)((int)rintf((x)[1] * inv) & 255) << 8) | ((unsigned)((int)rintf((x)[2] * inv) & 255) << 16) | ((unsigned)((int)rintf((x)[3] * inv) & 255) << 24))
        v4u o; o.x = Q4(v[rr][0]); o.y = Q4(v[rr][1]); o.z = Q4(v[rr][2]); o.w = Q4(v[rr][3]);
#undef Q4
        *(v4u*)(dst + rr * dst_stride) = o;
        if (lane == 0) scale_slot[2 * rr] = am * (1.f / 127.f);
    }
}
template <int NR> __device__ __forceinline__ void prep_rows_i4(const float* src, size_t src_stride, unsigned char* dst, size_t dst_stride, float* scale_slot  , int lane) {
    f32x4 v[NR][4];
#pragma unroll
    for (int rr = 0; rr < NR; ++rr) { const f32x4* s = (const f32x4*)(src + rr * src_stride) + lane * 4;
#pragma unroll
        for (int j = 0; j < 4; ++j) v[rr][j] = s[j]; }
#pragma unroll
    for (int rr = 0; rr < NR; ++rr) {
        float am = 0.f, ss = 0.f;
#pragma unroll
        for (int j = 0; j < 4; ++j) { am = fmaxf(fmaxf(am, fmaxf(fabsf(v[rr][j][0]), fabsf(v[rr][j][1]))), fmaxf(fabsf(v[rr][j][2]), fabsf(v[rr][j][3]))); ss += dot4(v[rr][j], v[rr][j]); }
#pragma unroll
        for (int o = 1; o < 64; o <<= 1) { am = fmaxf(am, __shfl_xor(am, o)); ss += __shfl_xor(ss, o); }
        am = fminf(am, 2.7f * sqrtf(ss * (1.f / 1024.f)));
        const float inv = am > 0.f ? 7.f / am : 0.f;
#define N4(x) ((unsigned)((int)fminf(fmaxf(rintf((x) * inv), -7.f), 7.f) + 8))
#define H4(x) ((unsigned)((int)fminf(fmaxf(rintf((x) * inv), -7.f), 7.f)) & 15u)
#define B4(x, y) (N4(x) | (H4(y) << 4))
        u32x2 o;
        o.x = B4(v[rr][0][0], v[rr][0][1]) | (B4(v[rr][0][2], v[rr][0][3]) << 8) | (B4(v[rr][1][0], v[rr][1][1]) << 16) | (B4(v[rr][1][2], v[rr][1][3]) << 24);
        o.y = B4(v[rr][2][0], v[rr][2][1]) | (B4(v[rr][2][2], v[rr][2][3]) << 8) | (B4(v[rr][3][0], v[rr][3][1]) << 16) | (B4(v[rr][3][2], v[rr][3][3]) << 24);
#undef B4
#undef H4
#undef N4
        *(u32x2*)(dst + rr * dst_stride) = o;
        if (lane == 0) scale_slot[2 * rr] = am * (1.f / 7.f);
    }
}
template <int NR> __device__ __forceinline__ void prep_rows_u4(const float* src, size_t src_stride, unsigned char* dst, size_t dst_stride, float* scale_slot  , int lane) {
    f32x4 v[NR][4];
    const int c = 512 * (lane >> 5) + 8 * (lane & 31);
#pragma unroll
    for (int rr = 0; rr < NR; ++rr) { const float* s = src + rr * src_stride + c;
        v[rr][0] = *(const f32x4*)s; v[rr][1] = *(const f32x4*)(s + 4); v[rr][2] = *(const f32x4*)(s + 256); v[rr][3] = *(const f32x4*)(s + 260); }
#pragma unroll
    for (int rr = 0; rr < NR; ++rr) {
        float am = 0.f, ss = 0.f;
#pragma unroll
        for (int j = 0; j < 4; ++j) { am = fmaxf(fmaxf(am, fmaxf(fabsf(v[rr][j][0]), fabsf(v[rr][j][1]))), fmaxf(fabsf(v[rr][j][2]), fabsf(v[rr][j][3]))); ss += dot4(v[rr][j], v[rr][j]); }
#pragma unroll
        for (int o = 1; o < 64; o <<= 1) { am = fmaxf(am, __shfl_xor(am, o)); ss += __shfl_xor(ss, o); }
        am = fminf(am, 2.7f * sqrtf(ss * (1.f / 1024.f)));
        const float inv = am > 0.f ? 7.f / am : 0.f;
#define N4(x) ((unsigned)((int)fminf(fmaxf(rintf((x) * inv), -7.f), 7.f) + 8))
#define H4(x) ((unsigned)((int)fminf(fmaxf(rintf((x) * inv), -7.f), 7.f)) & 15u)
#define B4(x, y) (N4(x) | (H4(y) << 4))
        u32x2 o;
        o.x = B4(v[rr][0][0], v[rr][2][0]) | (B4(v[rr][0][1], v[rr][2][1]) << 8) | (B4(v[rr][0][2], v[rr][2][2]) << 16) | (B4(v[rr][0][3], v[rr][2][3]) << 24);
        o.y = B4(v[rr][1][0], v[rr][3][0]) | (B4(v[rr][1][1], v[rr][3][1]) << 8) | (B4(v[rr][1][2], v[rr][3][2]) << 16) | (B4(v[rr][1][3], v[rr][3][3]) << 24);
#undef B4
#undef H4
#undef N4
        *(u32x2*)(dst + rr * dst_stride) = o;
        if (lane == 0) scale_slot[2 * rr] = am * (1.f / 7.f);
    }
}
__device__ __forceinline__ void prep_item(LAS unsigned char* lds, unsigned char* ws, LAS float* wscr, int l, int r, int lane) {
    constexpr int I_WIN_ = 16 * 136, I_WQ_ = 12 * 24, I_WKV_ = 4 * 32, I_WA_ = 8 * 32, I_WM_ = 8 * 32, I_WO_ = 16 * 32, I_PW_ = 16 * 32, I_WQK_ = 8 * 32, I_WV_ = 8 * 16;
    static_assert(I_WIN_ + I_WQ_ + I_WKV_ + I_WA_ + I_WM_ + I_WO_ + I_PW_ + I_WQK_ + I_WV_ == PI_W, "weight items");
    unsigned char* wl = ws + WS_W + (size_t)l * W_LAYER;
    if (r < PI_W) {
        if (r < I_WIN_) { const GetWin g{INP(I_WIN) + (size_t)l * D * 4136}; prep_tile(g, (bf16*)(wl + WO_WIN), 1024, 64 * (r / 136), 32 * (r % 136), wscr, lane); return; } r -= I_WIN_;
        if (r < I_WQ_) { const GetWq g{INP(I_WQUP) + (size_t)l * 768 * 768, INP(I_QNG) + l * 768}; prep_tile(g, (bf16*)(wl + WO_WQ), 768, 64 * (r / 24), 32 * (r % 24), wscr, lane); return; } r -= I_WQ_;
        if (r < I_WKV_) { const GetWkv g{INP(I_WKVUP) + (size_t)l * 256 * 1024, INP(I_KVNG) + l * 256}; prep_tile(g, (bf16*)(wl + WO_WKV), 256, 64 * (r / 32), 32 * (r % 32), wscr, lane); return; } r -= I_WKV_;
        if (r < I_WA_) { const GetPlain g{INP(I_WBA) + (size_t)l * 512 * 1024, 1024}; prep_tile(g, (bf16*)(wl + WO_WA), 512, 64 * (r / 32), 32 * (r % 32), wscr, lane); return; } r -= I_WA_;
        if (r < I_WM_) { const GetPlain g{INP(I_WBM) + (size_t)l * 512 * 1024, 1024}; prep_tile(g, (bf16*)(wl + WO_WM), 512, 64 * (r / 32), 32 * (r % 32), wscr, lane); return; } r -= I_WM_;
        if (r < I_WO_) { const GetPlain g{INP(I_WOUT) + (size_t)l * 1024 * 1024, 1024}; prep_tile(g, (bf16*)(wl + WO_WO), 1024, 64 * (r / 32), 32 * (r % 32), wscr, lane); return; } r -= I_WO_;
        if (r < I_PW_) { const GetPlain g{INP(I_PWQ) + (size_t)l * 1024 * 1024, 1024}; prep_tile(g, (bf16*)(wl + WO_PWQ), 1024, 64 * (r / 32), 32 * (r % 32), wscr, lane); return; } r -= I_PW_;
        if (r < I_WQK_) { const GetWqk g{INP(I_WQM) + (size_t)l * 65536, INP(I_WKM) + (size_t)l * 65536}; prep_tile(g, (bf16*)(wl + WO_WQK), 512, 64 * (r / 32), 32 * (r % 32), wscr, lane); return; } r -= I_WQK_;
        { const GetWv g{INP(I_WVM) + (size_t)l * 65536}; prep_tile(g, (bf16*)(wl + WO_WV), 512, 64 * (r / 16), 32 * (r % 16), wscr, lane); }
        return; }
    r -= PI_W;
    if (r < PI_K) { const int o = (r * 64 + lane) * 4;
        const f32x4 v = *(const f32x4*)(INP(I_PKEYS) + (size_t)l * 131072 + o); u32x2 w; w.x = pk2(v[0], v[1]); w.y = pk2(v[2], v[3]);
        *(u32x2*)(wl + WO_KEYB + (size_t)o * 2) = w; return; }
    r -= PI_K;
    float* sc2 = (float*)(ws + WS_USC);
    if (r < PI_U) { const float* pu = INP(I_PU) + (size_t)l * 16777216;
        for (int rr = 0; rr < 8; rr += 8) { const int er = r * 8 + rr; prep_rows_u4<8>(pu + (size_t)er * 1024, 1024, ws + WS_U8 + (size_t)l * 32 * MiB + (size_t)er * 512 + 8 * lane, 512, sc2 + 2 * (l * 16384 + er), lane); }
        return; }
    r -= PI_U;
    { const float* pv = INP(I_PV) + (size_t)l * 16777216;
      for (int rr = 0; rr < 8; rr += 8) { const int er = r * 8 + rr;
          prep_rows_i4<8>(pv + (size_t)er * 1024, 1024, ws + WS_V8 + (size_t)l * 32 * MiB + (size_t)(lane >> 4) * (2 * MiB) + (size_t)er * 128 + 8 * (lane & 15), 128, sc2 + 2 * (l * 16384 + er) + 1, lane); } }
}
template <int lv> __device__ __forceinline__ void layer_phases(LAS unsigned char* lds, volatile LAS unsigned* MISC, const int lo, const int hi, const int wave_s) {
        const int P = 1 + lv * PH_PER_LAYER;
#define WL() (ws + WS_W + (size_t)l * W_LAYER)
#define ADAL() ((const float*)(ws + ADA_OFF) + (size_t)l * 8 * NADA)
#define XA() WSP(bf16, WS_X)
#define XB() (WSP(bf16, WS_X) + (size_t)T * D)
#define WSP(type, off) ((type*)(ws + (off)))
        if (IN(P + 0)) REPS(1) { PH_BEGIN(lv);
            if (lv == 0) rowpass_norm_mod<false>(INP(I_X), INP(I_N1G) + l * D, ADAL() + 0, ADAL() + 1024, WSP(bf16, WS_H), gw, NGW, lane);
            else rowpass_norm_mod<true>(XB(), INP(I_N1G) + l * D, ADAL() + 0, ADAL() + 1024, WSP(bf16, WS_H), gw, NGW, lane); }
        SEAM(P + 0);
        if (IN(P + 1)) REPS(2) { PH_BEGIN(lv);
            if (G == 256) {
                { pg8::Gemm g{WSP(bf16, WS_H), (const bf16*)(WL() + WO_WIN), T, 4096, D}; pg8::StaticOrder S; S.init(T, 4096, G, bx);
                  EpiProj E{WSP(bf16, WS_QLAT), WSP(bf16, WS_KVLAT), WSP(bf16, WS_UM), WSP(bf16, WS_OPRE), WSP(bf16, WS_GA), WSP(bf16, WS_GM), WSP(float, WS_SMALL)};
                  pg8::gemm_phase<EpiProj, pg8::StaticOrder, true, true>(lds + RING_OFF, g, S, E, tidq); }
                { const int kq = bx >> 6;
                  pg8::Gemm g{WSP(bf16, WS_H) + 256 * kq, (const bf16*)(WL() + WO_WIN) + (size_t)4096 * 1024 + 256 * kq, T, 256, 256, 1024}; pg8::StaticOrder S; S.init(T, 256, 64, bx & 63);
                  EpiSmallPart E{WSP(float, WS_SMALLP) + (size_t)kq * T * 64};
                  pg8::gemm_phase<EpiSmallPart, pg8::StaticOrder, true, true>(lds + RING_OFF, g, S, E, tidq); }
            } else {
                pg8::Gemm g{WSP(bf16, WS_H), (const bf16*)(WL() + WO_WIN), T, NPROJ, D}; pg8::StaticOrder S; S.init(T, NPROJ, G, bx);
                EpiProj E{WSP(bf16, WS_QLAT), WSP(bf16, WS_KVLAT), WSP(bf16, WS_UM), WSP(bf16, WS_OPRE), WSP(bf16, WS_GA), WSP(bf16, WS_GM), WSP(float, WS_SMALL)};
                pg8::gemm_phase<EpiProj, pg8::StaticOrder, true, true>(lds + RING_OFF, g, S, E, tidq);
            }
        }
        SEAM(P + 1);
        if (IN(P + 2)) REPS(3) { PH_BEGIN(lv);
            rowpass_mid(WSP(bf16, WS_QLAT), WSP(bf16, WS_KVLAT), WSP(float, WS_SMALL), (G == 256) ? WSP(float, WS_SMALLP) : (const float*)nullptr, WSP(float, WS_COS), WSP(float, WS_SIN), WSP(bf16, WS_UM), INP(I_CONVW) + l * 4 * 512, INP(I_CONVB) + l * 512,
                        INP(I_BI) + l * 4, INP(I_BF) + l * 4, WSP(float, WS_RQ), WSP(float, WS_RKV), WSP(bf16, WS_K), WSP(float, WS_LOGI), WSP(float, WS_LOGF), WSP(bf16, WS_CONV), gw, NGW, lane); }
        SEAM(P + 2);
        if (IN(P + 3)) REPS(4) {
            { PH_BEGIN(lv); pg8::Gemm g{WSP(bf16, WS_QLAT), (const bf16*)(WL() + WO_WQ), T, 768, 768}; pg8::StaticOrder S; S.init(T, 768, G, bx);
              EpiQ E{WSP(bf16, WS_Q), WSP(float, WS_RQ), WSP(float, WS_COS), WSP(float, WS_SIN)}; pg8::gemm_phase<EpiQ, pg8::StaticOrder, true, true>(lds + RING_OFF, g, S, E, tidq); }
            { PH_BEGIN(lv); pg8::Gemm g{WSP(bf16, WS_KVLAT), (const bf16*)(WL() + WO_WKV), T, 1024, 256}; pg8::StaticOrder S; S.init(T, 1024, G, bx);
              EpiKV E{WSP(bf16, WS_K), WSP(bf16, WS_V), WSP(float, WS_RKV)}; pg8::gemm_phase<EpiKV, pg8::StaticOrder, true, true>(lds + RING_OFF, g, S, E, tidq); }
            { PH_BEGIN(lv); const int c = (G == 256) ? (bx >> 7) : 0;
              pg8::Gemm g{WSP(bf16, WS_CONV) + 256 * c, (const bf16*)(WL() + WO_WQK) + (size_t)(512 * c) * 512 + 256 * c, T, 512, 256, 512}; pg8::StaticOrder S;
              if (G == 256) S.init(T, 512, 128, bx & 127); else S.init(T, 512, G, bx);
              pg8::EpiBf16<0> E{WSP(bf16, WS_QKM) + 256 * c, 1024, nullptr, 256, 512, 1.f}; pg8::gemm_phase<pg8::EpiBf16<0>, pg8::StaticOrder, true, true>(lds + RING_OFF, g, S, E, tidq); }
            { PH_BEGIN(lv); if (G != 256) {
              pg8::Gemm g{WSP(bf16, WS_CONV) + 256, (const bf16*)(WL() + WO_WQK) + (size_t)512 * 512 + 256, T, 512, 256, 512}; pg8::StaticOrder S; S.init(T, 512, G, bx);
              pg8::EpiBf16<0> E{WSP(bf16, WS_QKM) + 256, 1024, nullptr, 256, 512, 1.f}; pg8::gemm_phase<pg8::EpiBf16<0>, pg8::StaticOrder, true, true>(lds + RING_OFF, g, S, E, tidq); } }
            { PH_BEGIN(lv);
              pg8::Gemm g{WSP(bf16, WS_UM), (const bf16*)(WL() + WO_WV), T, 256, 256, 512}; pg8::StaticOrder S;
              if (G == 256) S.init(T, 256, 64, bx >= 192 ? bx - 192 : (1 << 20)); else S.init(T, 256, G, bx);
              pg8::EpiBf16<0> E{WSP(bf16, WS_VM), 512, nullptr, 0, 0, 1.f}; pg8::gemm_phase<pg8::EpiBf16<0>, pg8::StaticOrder, true, true>(lds + RING_OFF, g, S, E, tidq); }
            { PH_BEGIN(lv);
              pg8::Gemm g{WSP(bf16, WS_UM) + 256, (const bf16*)(WL() + WO_WV) + (size_t)256 * 512 + 256, T, 256, 256, 512}; pg8::StaticOrder S;
              if (G == 256) S.init(T, 256, 64, bx >= 192 ? bx - 192 : (1 << 20)); else S.init(T, 256, G, bx);
              pg8::EpiBf16<0> E{WSP(bf16, WS_VM) + 256, 512, nullptr, 0, 0, 1.f}; pg8::gemm_phase<pg8::EpiBf16<0>, pg8::StaticOrder, true, true>(lds + RING_OFF, g, S, E, tidq); }
        }
        SEAM(P + 3);
        if (IN(P + 4)) {
            REPS(5) { PH_BEGIN(lv); attn_mfma(WSP(bf16, WS_Q), WSP(bf16, WS_K), WSP(bf16, WS_V), WSP(bf16, WS_AO), lds + RING_OFF, bx, G, tidq); __syncthreads(); }
            REPS(6) { PH_BEGIN(lv); mlstm_mfma(WSP(bf16, WS_QKM), WSP(bf16, WS_VM), WSP(float, WS_LOGI), WSP(float, WS_LOGF), WSP(bf16, WS_CONV), WSP(bf16, WS_OPRE), INP(I_MHG) + l * 512, INP(I_MSKIP) + l * 512,
                          WSP(bf16, WS_OUTM), lds + RING_OFF, bx, G, tidq); }
        }
        SEAM(P + 4);
        if (IN(P + 5)) REPS(7) {
            static_assert(WS_OUTM == WS_AO + (size_t)T * 512 * 2 && WO_WM == WO_WA + 1024 * 512 * 2, "the merge stream needs AO | OUTM and Wa | Wm adjacent");
            { PH_BEGIN(lv); pg8::Gemm g{WSP(bf16, WS_AO), (const bf16*)(WL() + WO_WA), 2 * T, 2048, 512}; MergeOrder S; S.base.init(T, 1024, G, bx);
              EpiMerge2 E{WSP(bf16, WS_MERGED), WSP(bf16, WS_GA), WSP(bf16, WS_GM)}; pg8::gemm_phase<EpiMerge2, MergeOrder, true, true>(lds + RING_OFF, g, S, E, tidq); }
        }
        SEAM(P + 5);
        if (IN(P + 6)) REPS(8) { PH_BEGIN(lv);
            pg8::Gemm g{WSP(bf16, WS_MERGED), (const bf16*)(WL() + WO_WO), T, 1024, 1024}; pg8::StaticOrder S; S.init(T, 1024, G, bx);
            if (lv == 0) { EpiResid<false> E{INP(I_X), XA(), ADAL() + 2048}; pg8::gemm_phase<EpiResid<false>, pg8::StaticOrder, true, true>(lds + RING_OFF, g, S, E, tidq); }
            else { EpiResid<true> E{XB(), XA(), ADAL() + 2048}; pg8::gemm_phase<EpiResid<true>, pg8::StaticOrder, true, true>(lds + RING_OFF, g, S, E, tidq); }
        }
        SEAM(P + 6);
        if (IN(P + 7)) REPS(1) { PH_BEGIN(lv); rowpass_norm_mod<true>(XA(), INP(I_N2G) + l * D, ADAL() + 3072, ADAL() + 4096, WSP(bf16, WS_H), gw, NGW, lane, ws + WS_H8, WSP(float, WS_XS)); }
        SEAM(P + 7);
        if (IN(P + 8)) REPS(9) { PH_BEGIN(lv);
            pg8::Gemm g{WSP(bf16, WS_H), (const bf16*)(WL() + WO_PWQ), T, 1024, 1024}; pg8::StaticOrder S; S.init(T, 1024, G, bx);
            pg8::EpiBf16<0> E{WSP(bf16, WS_PQ), 1024, nullptr, 0, 0, 1.f}; pg8::gemm_phase<pg8::EpiBf16<0>, pg8::StaticOrder, true, true>(lds + RING_OFF, g, S, E, tidq);
        }
        SEAM(P + 8);
        if (IN(P + 9)) REPS(10) { PH_BEGIN(lv);
            peer_route(WSP(bf16, WS_PQ), (const bf16*)(WL() + WO_KEYB), WSP(int, WS_IDX), WSP(float, WS_GATE), lds + RING_OFF, bx, G, tidq); }
        SEAM(P + 9);
        if (IN(P + 10)) REPS(12) { PH_BEGIN(lv);
            int vx, rank, nb; peer_partition((const unsigned*)(ws + WS_CTL) + CW_XC, MISC, bx, G, vx, rank, nb);
            peer_u_i8(ws + WS_H8, WSP(float, WS_XS), WSP(int, WS_IDX), ws + WS_U8 + (size_t)l * 32 * MiB, WSP(f32x2v, WS_USC) + l * 16384, WSP(float, WS_ACT), wscr, vx, rank, nb, tidq); }
        SEAM(P + 10);
        if (IN(P + 11)) REPS(13) { PH_BEGIN(lv);
            int vx, rank, nb; peer_partition((const unsigned*)(ws + WS_CTL) + CW_XC, MISC, bx, G, vx, rank, nb);
            peer_v(WSP(int, WS_IDX), WSP(float, WS_ACT), WSP(float, WS_GATE), ws + WS_V8 + (size_t)l * 32 * MiB, ADAL() + 5120, XA(), XB(), wscr, vx, rank, nb, tidq);
        }
        SEAM(P + 11);
    }

__global__ void __launch_bounds__(NTHREADS, 2) fwd(Args args) {
    extern __shared__ __attribute__((aligned(16))) unsigned char lds_raw[];
    LAS unsigned char* lds = (LAS unsigned char*)lds_raw;
    volatile LAS unsigned* MISC = (volatile LAS unsigned*)(lds + MISC_OFF);
    const int tid = threadIdx.x;
    const int wave_s = __builtin_amdgcn_readfirstlane(tid >> 6);
    for (int u = tid; u < (LDS_BYTES - LDSCTL_OFF) / 4; u += NTHREADS) ((LAS unsigned*)(lds + LDSCTL_OFF))[u] = 0u;
    __syncthreads();
    if (tid == 0) { LAS unsigned long long* pt = (LAS unsigned long long*)(lds + PTAB_OFF);
#pragma unroll
        for (int i = 0; i < N_INPUTS; ++i) pt[i] = (unsigned long long)args.in[i];
        pt[29] = (unsigned long long)args.out; pt[30] = (unsigned long long)args.ws; }
    __syncthreads();
    if (MK_ONE_LAUNCH) (void)xcd_barrier_post((unsigned*)(WSB() + WS_CTL) + CW_BAR, MISC + 8);
    if (MK_ONE_LAUNCH && tid == 0) { const unsigned xc = xb_xcc_id() & 7u; MISC[12] = xb_add((unsigned*)(WSB() + WS_CTL) + CW_XC + 64 * xc, 1u); MISC[13] = xc; }
    __syncthreads();
    const int lo = args.ph_lo, hi = args.ph_hi;

    if (IN(0)) REPS(0) {
        PH_BEGIN(0);
        float* ADA = (float*)(ws + ADA_OFF);
        { const float* c = INP(I_C); const float* wada = INP(I_WADA); const float* bada = INP(I_BADA);
          for (int it = bx; it < DEPTH * 96; it += G) {
            const int ll = it / 96, cg = it % 96; const int n = cg * 64 + lane;
#pragma unroll
            for (int i = 0; i < 16; ++i) { const int e = lane + 64 * i; const int bb = e >> 7, kk = e & 127; const float cv = c[bb * D + wave * 128 + kk]; wscr[e] = cv * sigm(cv); }
            LDS_WAIT();
            const float* w = wada + (size_t)ll * D * NADA + (size_t)(wave * 128) * NADA + n;
            float a[8];
#pragma unroll
            for (int bb = 0; bb < 8; ++bb) a[bb] = 0.f;
#pragma unroll 16
            for (int kk = 0; kk < 128; ++kk) { const float wv = w[(size_t)kk * NADA];
#pragma unroll
                for (int bb = 0; bb < 8; ++bb) a[bb] += wscr[bb * 128 + kk] * wv; }
#pragma unroll
            for (int bb = 0; bb < 8; ++bb) wscr[1024 + bb * 64 + lane] = a[bb];
            __syncthreads();
            { float s = 0.f;
#pragma unroll
              for (int w8 = 0; w8 < 8; ++w8) s += ((const LAS float*)(lds + RING_OFF + w8 * 16384))[1024 + wave * 64 + lane];
              ADA[((size_t)ll * 8 + wave) * NADA + n] = s + bada[ll * NADA + n]; }
            __syncthreads();
          } }
        { const int* pos = (const int*)INP(I_POS); float* COS = (float*)(ws + WS_COS); float* SIN = (float*)(ws + WS_SIN);
          for (int idx = gw * 64 + lane; idx < T * 16; idx += NGW * 64) { const int t = idx >> 4, j = idx & 15;
              const float ang = (float)pos[t] * INV_FREQ[j];
              const double rev = (double)ang * 0.15915494309189535; const float fr = (float)(rev - rint(rev));
              COS[idx] = __builtin_amdgcn_cosf(fr); SIN[idx] = __builtin_amdgcn_sinf(fr); } }
        for (int it = gw; it < DEPTH * PI_TOTAL; it += NGW) prep_item(lds, ws, wscr, it / PI_TOTAL, it % PI_TOTAL, lane);
    }
    SEAM(0);

    layer_phases<0>(lds, MISC, lo, hi, wave_s);
    layer_phases<1>(lds, MISC, lo, hi, wave_s);
    if (IN(N_PHASES - 1)) REPS(1) { PH_BEGIN(0); rowpass_final(XB(), INP(I_FG), (float*)getp(lds, 29), gw, NGW, lane); }
#undef IN
#undef SEAM
}

extern "C" void kernel_launch(void* const* d_in, const int* in_sizes, int n_in, void* d_out, int out_size, void* d_ws, size_t ws_size, hipStream_t stream) {
    static int grid = 0;
    if (grid == 0) {
        if (n_in != N_INPUTS || in_sizes[0] != T * D || out_size != T * D || ws_size < WS_END2) {
            fprintf(stderr, "kernel_launch: unexpected shapes: n_in %d in0 %d out %d ws %zu (need %zu); nothing launched\n", n_in, n_in > 0 ? in_sizes[0] : -1, out_size, ws_size, (size_t)WS_END2); grid = -1; return; }
        int dev = 0, cus = 0, per_cu = 0;
        if (hipGetDevice(&dev) != hipSuccess || hipDeviceGetAttribute(&cus, hipDeviceAttributeMultiprocessorCount, dev) != hipSuccess) { fprintf(stderr, "kernel_launch: device query failed\n"); grid = -1; return; }
        if (hipFuncSetAttribute((const void*)fwd, hipFuncAttributeMaxDynamicSharedMemorySize, LDS_BYTES) != hipSuccess) { fprintf(stderr, "kernel_launch: hipFuncSetAttribute failed\n"); grid = -1; return; }
        if (hipOccupancyMaxActiveBlocksPerMultiprocessor(&per_cu, (const void*)fwd, NTHREADS, LDS_BYTES) != hipSuccess || per_cu < 1)
            fprintf(stderr, "kernel_launch: note: occupancy query reports %d workgroups per CU\n", per_cu);
        (void)hipGetLastError();
        grid = cus;
    }
    if (grid < 0) return;
    if (hipMemsetAsync((char*)d_ws + WS_CTL, 0, CTL_ZERO_BYTES, stream) != hipSuccess) { fprintf(stderr, "kernel_launch: memset failed\n"); return; }
    Args a{};
    for (int i = 0; i < N_INPUTS; ++i) a.in[i] = d_in[i];
    a.out = (float*)d_out; a.ws = (unsigned char*)d_ws;
#if MK_ONE_LAUNCH
    a.ph_lo = 0; a.ph_hi = N_PHASES;
    hipLaunchKernelGGL(fwd, dim3(grid), dim3(NTHREADS), LDS_BYTES, stream, a);
#else
    for (int p = 0; p < N_PHASES; ++p) { a.ph_lo = p; a.ph_hi = p + 1; hipLaunchKernelGGL(fwd, dim3(grid), dim3(NTHREADS), LDS_BYTES, stream, a); }
#endif
    const hipError_t le = hipPeekAtLastError();
    if (le != hipSuccess) fprintf(stderr, "kernel_launch: launch failed: %s\n", hipGetErrorName(le));
}
```

```cpp
#include <hip/hip_runtime.h>
#include <cstdio>
#include <cstdint>
#ifndef WT_STORES
#define WT_STORES 0
#endif
template <class V> __device__ __forceinline__ void st_wt(void* p, const V v) {
    static_assert(sizeof(V) == 16 || sizeof(V) == 8 || sizeof(V) == 4, "store width");
#if WT_STORES
    if constexpr (sizeof(V) == 16) asm volatile("global_store_dwordx4 %0, %1, off sc1\n\ts_nop 1" :: "v"(p), "v"(v) : "memory");
    else if constexpr (sizeof(V) == 8) asm volatile("global_store_dwordx2 %0, %1, off sc1\n\ts_nop 1" :: "v"(p), "v"(v) : "memory");
    else asm volatile("global_store_dword %0, %1, off sc1\n\ts_nop 1" :: "v"(p), "v"(v) : "memory");
#else
    *(V*)p = v;
#endif
}
#define GSTF(ptr, val) st_wt((void*)(ptr), (val))
template <class V> __device__ __forceinline__ void st_plain(void* p, const V v) { *(V*)p = v; }
#define GST(ptr, val) st_plain((void*)(ptr), (val))
namespace pg8 {
#define PG8_LAS __attribute__((address_space(3)))
typedef unsigned short bf16_t;
typedef short bf16x8 __attribute__((ext_vector_type(8)));
typedef float f32x4 __attribute__((ext_vector_type(4)));
typedef unsigned u32x4 __attribute__((ext_vector_type(4)));
constexpr int BM = 256, BK = 64, HALF = 128, HTB = HALF * BK * 2  , STAGE_BYTES = 8 * HTB, NXCD = 8, WGM = 8;

__host__ __device__ __forceinline__ int lds_byte(int r, int c) { const int st = (r >> 4) * 2 + (c >> 5), rr = r & 15, cc = c & 31, ob = rr * 64 + cc * 2; return st * 1024 + (ob ^ (((ob >> 9) & 1) << 5)); }
__host__ __device__ __forceinline__ void stage_rc(int b, int& R, int& C) { const int st = b / 1024, sb = b % 1024, swz = sb ^ (((sb >> 9) & 1) << 5); R = (st >> 1) * 16 + swz / 64; C = (st & 1) * 32 + (swz % 64) / 2; }
__host__ __device__ __forceinline__ int perm32(int rho) { const int n = rho >> 4, i = rho & 15; return 8 * (i >> 2) + 4 * n + (i & 3); }

struct Unit { int pm, pn; };
struct Gemm { const bf16_t* A; const bf16_t* Bt; int M, N, K; int ld = 0; };

struct StaticOrder {
    int nM, nN, nwg, G, c;
    __host__ __device__ void init(int M, int N, int G_, int c_) { nM = M / BM; nN = N / BM; nwg = nM * nN; G = G_; c = c_; }
    __host__ __device__ bool next(int i, Unit& u) const {
        const long L = (long)i * G + c; if (L >= nwg) return false;
        int wgid = (int)L; { const int q = nwg / NXCD, r = nwg % NXCD, xcd = wgid % NXCD, off = wgid / NXCD; wgid = (xcd < r ? xcd * (q + 1) : r * (q + 1) + (xcd - r) * q) + off; }
        const int nig = WGM * nN, gid = wgid / nig, fm = gid * WGM, gsz = (nM - fm) < WGM ? (nM - fm) : WGM;
        u.pm = fm + ((wgid % nig) % gsz); u.pn = (wgid % nig) / gsz; return true;
    }
    __device__ __forceinline__ void a_ready(const Unit&) const {}
    __device__ __forceinline__ void done(const Unit&) const {}
};

__device__ __forceinline__ unsigned cvt_pk_bf16(float lo, float hi) { unsigned r; asm volatile("v_cvt_pk_bf16_f32 %0, %1, %2" : "=v"(r) : "v"(lo), "v"(hi)); return r; }
typedef float f32x2 __attribute__((ext_vector_type(2)));
__device__ __forceinline__ f32x2 gelu_pk(f32x2 v) {
    const f32x2 av = __builtin_elementwise_abs(v), d = av * 0.2316418882f + 1.0f;
    f32x2 t; t.x = __builtin_amdgcn_rcpf(d.x); t.y = __builtin_amdgcn_rcpf(d.y);
    f32x2 q = t * 0.5307027145f + (-0.7265760135f); q = q * t + 0.7107068705f; q = q * t + (-0.142248368f); q = q * t + 0.127414796f; q = q * t;
    const f32x2 s = (v * v) * (-0.72134752044f);
    f32x2 e; e.x = __builtin_amdgcn_exp2f(s.x); e.y = __builtin_amdgcn_exp2f(s.y);
    const f32x2 m = v * (q * e), r = v - m;
    f32x2 o; o.x = v.x < 0.f ? m.x : r.x; o.y = v.y < 0.f ? m.y : r.y; return o;
}

template <int ACT  > struct EpiBf16 {
    static constexpr bool PERM = true, AFTER_DRAIN = false; static_assert(ACT == 0 || ACT == 1, "EpiBf16: ACT is 0 (none) or 1 (gelu_pk)");
    bf16_t* O; int ldc; const float* bias; int split_cols; size_t split_stride; float scale0;
    __device__ __forceinline__ void operator()(const f32x4 (&acc)[2][2][4][2], const Unit& u, int wr, int wc, int fr, int fq) const {
        const int row0 = u.pm * BM + wr * 64 + fr; int colt = u.pn * BM; bf16_t* base = O;
        float sc = 1.f; if (split_cols) { const int t = colt / split_cols; base += (size_t)t * split_stride; colt -= t * split_cols; if (t == 0) sc = scale0; }
        const int col0 = colt + wc * 32 + 8 * fq, bcol0 = u.pn * BM + wc * 32 + 8 * fq;
        f32x4 bv[2][2];
#pragma unroll
        for (int bj = 0; bj < 2; ++bj)
#pragma unroll
            for (int n = 0; n < 2; ++n) bv[bj][n] = bias ? *(const f32x4*)(bias + bcol0 + bj * HALF + 4 * n) : (f32x4){0.f, 0.f, 0.f, 0.f};
#pragma unroll
        for (int ai = 0; ai < 2; ++ai)
#pragma unroll
            for (int m = 0; m < 4; ++m) { bf16_t* rowp = base + (size_t)(row0 + ai * HALF + m * 16) * ldc + col0;
#pragma unroll
                for (int bj = 0; bj < 2; ++bj) { f32x4 v0 = acc[ai][bj][m][0] + bv[bj][0], v1 = acc[ai][bj][m][1] + bv[bj][1];
                    if (ACT == 1) { f32x2 a = gelu_pk((f32x2){v0[0], v0[1]}), b = gelu_pk((f32x2){v0[2], v0[3]}), c = gelu_pk((f32x2){v1[0], v1[1]}), d = gelu_pk((f32x2){v1[2], v1[3]});
                        v0 = (f32x4){a.x, a.y, b.x, b.y}; v1 = (f32x4){c.x, c.y, d.x, d.y}; }
                    v0 = v0 * sc; v1 = v1 * sc; u32x4 w; w.x = cvt_pk_bf16(v0[0], v0[1]); w.y = cvt_pk_bf16(v0[2], v0[3]); w.z = cvt_pk_bf16(v1[0], v1[1]); w.w = cvt_pk_bf16(v1[2], v1[3]);
                    GST(rowp + bj * HALF, w); } }
    }
};


template <class Epi, class Sched, bool ALIGN_EPI = false, bool SP2 = false>
__device__ __forceinline__ void gemm_phase(PG8_LAS unsigned char* lds, const Gemm g, const Sched& S, const Epi& E, const int tid_in) {
    int tid_l = tid_in; asm volatile("" : "+v"(tid_l));
    const int tid = tid_l, wid = __builtin_amdgcn_readfirstlane(tid >> 6), lane = tid & 63, wr = wid >> 2, wc = wid & 3, fr = lane & 15, fq = lane >> 4;
    const int K = g.K, nt = K / BK, LD = g.ld ? g.ld : g.K;
    unsigned voffA[2], voffB[2];
#pragma unroll
    for (int i = 0; i < 2; ++i) { int R, C; stage_rc(tid * 16 + i * 8192, R, C); const int Rb = Epi::PERM ? ((R & ~31) + perm32(R & 31)) : R;
        voffA[i] = (unsigned)(R * LD + C) * 2u; voffB[i] = (unsigned)(Rb * LD + C) * 2u; }
    const size_t kstep = (size_t)(BK * 2);
    const size_t hstep = (size_t)HALF * LD * 2;
    const size_t tstep = 2 * hstep;
    const unsigned ldsw = (unsigned)wid * 1024u;
    const int aoff = lds_byte(wr * 64 + fr, fq * 8), boff = lds_byte(wc * 32 + fr, fq * 8);
#define PG8_SA(b, h) (((b) * 2 + (h)) * HTB)
#define PG8_SB(b, h) ((4 + (b) * 2 + (h)) * HTB)
#define PG8_STAGE(bufoff, gbase, voff) do { _Pragma("unroll") for (int _i = 0; _i < 2; ++_i) \
        __builtin_amdgcn_global_load_lds((const unsigned*)((const char*)(gbase) + (voff)[_i]), (PG8_LAS unsigned*)(lds + (bufoff) + ldsw + _i * 8192), 16, 0, 0); } while (0)
#define PG8_LDA(dst, b, h) do { _Pragma("unroll") for (int m = 0; m < 4; ++m) _Pragma("unroll") for (int k = 0; k < 2; ++k) dst[m][k] = *(const PG8_LAS bf16x8*)(lds + PG8_SA(b, h) + aoff + m * 2048 + k * 1024); } while (0)
#define PG8_LDB(dst, b, h) do { _Pragma("unroll") for (int n = 0; n < 2; ++n) _Pragma("unroll") for (int k = 0; k < 2; ++k) dst[n][k] = *(const PG8_LAS bf16x8*)(lds + PG8_SB(b, h) + boff + n * 2048 + k * 1024); } while (0)
#define PG8_MMA(ai, bj, At, Bt) do { __builtin_amdgcn_s_setprio(1); _Pragma("unroll") for (int m = 0; m < 4; ++m) _Pragma("unroll") for (int n = 0; n < 2; ++n) _Pragma("unroll") for (int k = 0; k < 2; ++k) \
        acc[ai][bj][m][n] = __builtin_amdgcn_mfma_f32_16x16x32_bf16(Bt[n][k], At[m][k], acc[ai][bj][m][n], 0, 0, 0); __builtin_amdgcn_s_setprio(0); } while (0)
#define PG8_WAIT_V(n) asm volatile("s_waitcnt vmcnt(" #n ")" ::: "memory")
#define PG8_WAIT_L(n) asm volatile("s_waitcnt lgkmcnt(" #n ")" ::: "memory")
#define PG8_BAR __builtin_amdgcn_s_barrier()
#define PG8_SCHED __builtin_amdgcn_sched_barrier(0)
    Unit cur, nxt; int ui = 0;
    if (!S.next(0, cur)) return;
    f32x4 acc[2][2][4][2];
#pragma unroll
    for (int a = 0; a < 2; ++a)
#pragma unroll
        for (int b = 0; b < 2; ++b)
#pragma unroll
            for (int m = 0; m < 4; ++m)
#pragma unroll
                for (int n = 0; n < 2; ++n) acc[a][b][m][n] = (f32x4){0.f, 0.f, 0.f, 0.f};
    bf16x8 At[4][2], B0[2][2], B1[2][2];
    const char* cA = (const char*)g.A + (size_t)cur.pm * tstep; const char* cB = (const char*)g.Bt + (size_t)cur.pn * tstep;
    S.a_ready(cur);
    if constexpr (SP2) {
        PG8_STAGE(PG8_SB(0, 0), cB, voffB); PG8_STAGE(PG8_SB(0, 1), cB + hstep, voffB); PG8_STAGE(PG8_SA(0, 0), cA, voffA); PG8_STAGE(PG8_SA(0, 1), cA + hstep, voffA);
        if (wr == 1) PG8_BAR;
        PG8_WAIT_V(2); PG8_BAR;
        PG8_STAGE(PG8_SB(1, 0), cB + kstep, voffB); PG8_STAGE(PG8_SA(1, 0), cA + kstep, voffA); PG8_STAGE(PG8_SB(1, 1), cB + hstep + kstep, voffB);
        PG8_WAIT_V(6); PG8_BAR;
    } else {
        PG8_STAGE(PG8_SB(0, 0), cB, voffB); PG8_STAGE(PG8_SA(0, 0), cA, voffA); PG8_STAGE(PG8_SB(0, 1), cB + hstep, voffB); PG8_STAGE(PG8_SA(0, 1), cA + hstep, voffA);
        if (wr == 1) PG8_BAR;
        PG8_WAIT_V(4); PG8_BAR;
        PG8_STAGE(PG8_SB(1, 0), cB + kstep, voffB); PG8_STAGE(PG8_SA(1, 0), cA + kstep, voffA); PG8_STAGE(PG8_SB(1, 1), cB + hstep + kstep, voffB);
        PG8_WAIT_V(6); PG8_BAR;
    }
    for (;;) {
        const bool has_next = S.next(ui + 1, nxt);
        const char* nA = has_next ? (const char*)g.A + (size_t)nxt.pm * tstep : cA; const char* nB = has_next ? (const char*)g.Bt + (size_t)nxt.pn * tstep : cB;
        for (int t = 0; t < nt; t += 2) {
            const bool last = (t == nt - 2);
            const char* a1 = cA + (size_t)(t + 1) * kstep;
            const char* a2 = last ? nA : cA + (size_t)(t + 2) * kstep; const char* b2 = last ? nB : cB + (size_t)(t + 2) * kstep;
            const char* a3 = a2 + kstep; const char* b3 = b2 + kstep;
            if (last && has_next) S.a_ready(nxt);
            if constexpr (SP2) {
            PG8_LDB(B0, 0, 0); PG8_LDB(B1, 0, 1); PG8_SCHED; PG8_LDA(At, 0, 0); PG8_STAGE(PG8_SA(1, 1), a1 + hstep, voffA);
            PG8_WAIT_V(8); PG8_WAIT_L(0); PG8_BAR; PG8_MMA(0, 0, At, B0); PG8_MMA(0, 1, At, B1); PG8_BAR; PG8_SCHED;
            PG8_LDA(At, 0, 1); PG8_STAGE(PG8_SB(0, 0), b2, voffB); PG8_STAGE(PG8_SB(0, 1), b2 + hstep, voffB); PG8_STAGE(PG8_SA(0, 0), a2, voffA);
            PG8_WAIT_V(8); PG8_WAIT_L(0); PG8_BAR; PG8_MMA(1, 0, At, B0); PG8_MMA(1, 1, At, B1); PG8_BAR; PG8_SCHED;
            PG8_LDB(B0, 1, 0); PG8_LDB(B1, 1, 1); PG8_SCHED; PG8_LDA(At, 1, 0); PG8_STAGE(PG8_SA(0, 1), a2 + hstep, voffA);
            PG8_WAIT_V(8); PG8_WAIT_L(0); PG8_BAR; PG8_MMA(0, 0, At, B0); PG8_MMA(0, 1, At, B1); PG8_BAR; PG8_SCHED;
            PG8_LDA(At, 1, 1); PG8_STAGE(PG8_SB(1, 0), b3, voffB); PG8_STAGE(PG8_SB(1, 1), b3 + hstep, voffB); PG8_STAGE(PG8_SA(1, 0), a3, voffA);
            PG8_WAIT_V(8); PG8_WAIT_L(0); PG8_BAR; PG8_MMA(1, 0, At, B0); PG8_MMA(1, 1, At, B1); PG8_BAR; PG8_SCHED;
            } else {
            PG8_LDB(B0, 0, 0); PG8_SCHED; PG8_LDA(At, 0, 0); PG8_STAGE(PG8_SA(1, 1), a1 + hstep, voffA);
            PG8_WAIT_L(8); PG8_BAR; PG8_WAIT_L(0); PG8_MMA(0, 0, At, B0); PG8_BAR; PG8_SCHED;
            PG8_LDB(B1, 0, 1); PG8_STAGE(PG8_SB(0, 0), b2, voffB);
            PG8_BAR; PG8_WAIT_L(0); PG8_MMA(0, 1, At, B1); PG8_BAR;
            PG8_LDA(At, 0, 1); PG8_STAGE(PG8_SA(0, 0), a2, voffA);
            PG8_BAR; PG8_WAIT_L(0); PG8_MMA(1, 0, At, B0); PG8_BAR; PG8_SCHED;
            PG8_STAGE(PG8_SB(0, 1), b2 + hstep, voffB);
            PG8_WAIT_V(6); PG8_BAR; PG8_MMA(1, 1, At, B1); PG8_BAR;
            PG8_LDB(B0, 1, 0); PG8_SCHED; PG8_LDA(At, 1, 0); PG8_STAGE(PG8_SA(0, 1), a2 + hstep, voffA);
            PG8_WAIT_L(8); PG8_BAR; PG8_WAIT_L(0); PG8_MMA(0, 0, At, B0); PG8_BAR; PG8_SCHED;
            PG8_LDB(B1, 1, 1); PG8_STAGE(PG8_SB(1, 0), b3, voffB);
            PG8_BAR; PG8_WAIT_L(0); PG8_MMA(0, 1, At, B1); PG8_BAR;
            PG8_LDA(At, 1, 1); PG8_STAGE(PG8_SA(1, 0), a3, voffA);
            PG8_BAR; PG8_WAIT_L(0); PG8_MMA(1, 0, At, B0); PG8_BAR; PG8_SCHED;
            PG8_STAGE(PG8_SB(1, 1), b3 + hstep, voffB);
            PG8_WAIT_V(6); PG8_BAR; PG8_MMA(1, 1, At, B1); PG8_BAR;
            }
        }
        if constexpr (ALIGN_EPI) { if (wr == 0) PG8_BAR; }
        if constexpr (!Epi::AFTER_DRAIN) { E(acc, cur, wr, wc, fr, fq); S.done(cur); }
        if (!has_next) break;
#pragma unroll
        for (int a = 0; a < 2; ++a)
#pragma unroll
            for (int b = 0; b < 2; ++b)
#pragma unroll
                for (int m = 0; m < 4; ++m)
#pragma unroll
                    for (int n = 0; n < 2; ++n) acc[a][b][m][n] = (f32x4){0.f, 0.f, 0.f, 0.f};
        cur = nxt; cA = nA; cB = nB; ++ui;
        if constexpr (ALIGN_EPI) { if (wr == 1) PG8_BAR; }
    }
    PG8_WAIT_V(0);
    if constexpr (!ALIGN_EPI) { if (wr == 0) PG8_BAR; }
    PG8_BAR;
    if constexpr (Epi::AFTER_DRAIN) { E.fused(acc, cur, wr, wc, fr, fq, lds, wid, lane); S.done(cur); }
#undef PG8_SA
#undef PG8_SB
#undef PG8_STAGE
#undef PG8_LDA
#undef PG8_LDB
#undef PG8_MMA
#undef PG8_WAIT_V
#undef PG8_WAIT_L
#undef PG8_BAR
#undef PG8_SCHED
}
}
#define GAS __attribute__((address_space(1)))
#define LAS __attribute__((address_space(3)))
typedef unsigned short bf16;
typedef unsigned v4u __attribute__((ext_vector_type(4)));
typedef float f32x4 __attribute__((ext_vector_type(4)));
typedef short bf16x8 __attribute__((ext_vector_type(8)));
typedef GAS unsigned gu32;
typedef GAS unsigned long long gu64;
#define RLX_AGENT __ATOMIC_RELAXED, __HIP_MEMORY_SCOPE_AGENT
#define LDS_WAIT() asm volatile("s_waitcnt lgkmcnt(0)" ::: "memory")
#define VM_WAIT() asm volatile("s_waitcnt vmcnt(0)" ::: "memory")
__device__ __forceinline__ unsigned long long rt() { return __builtin_amdgcn_s_memrealtime(); }
__device__ __forceinline__ unsigned f2bf(float f) { unsigned u = __builtin_bit_cast(unsigned, f); return (u + 0x7fffu + ((u >> 16) & 1u)) >> 16; }
__device__ __forceinline__ unsigned pk2(float lo, float hi) { return f2bf(lo) | (f2bf(hi) << 16); }

#define XB_TMO      128
#define XB_XCNT(j)  (256  + 64 * (j))
#define XB_XSUB(j)  (1280 + 64 * (j))
#define XB_XGEN(j)  (2304 + 64 * (j))
#define XB_TOP      3328
#define XB_TOPGEN   3392
#define XCD_BAR_WORDS 3456
#define XB_SPIN_CAP (1u << 18)

__device__ __forceinline__ unsigned xb_ld(unsigned* p)              { return __hip_atomic_load(p, __ATOMIC_RELAXED, __HIP_MEMORY_SCOPE_AGENT); }
__device__ __forceinline__ unsigned xb_add(unsigned* p, unsigned v) { return __hip_atomic_fetch_add(p, v, __ATOMIC_RELAXED, __HIP_MEMORY_SCOPE_AGENT); }
__device__ __forceinline__ unsigned xb_xcc_id() { return (unsigned)__builtin_amdgcn_s_getreg((3 << 11) | 20) & 0xFu; }
#define XB_SPIN(cond, bar) do { unsigned _sp = 0; while (cond) { __builtin_amdgcn_s_sleep(1); \
    if ((++_sp & 255u) == 0u) { if (xb_ld(&(bar)[XB_TMO])) break; if (_sp > XB_SPIN_CAP) { atomicAdd(&(bar)[XB_TMO], 1u); break; } } } } while (0)

struct XcdBarrier {
    unsigned* bar; unsigned x;
    volatile LAS unsigned* st;
};

__device__ __forceinline__ XcdBarrier xcd_barrier_post(unsigned* bar, volatile LAS unsigned* st) {
    XcdBarrier b; b.bar = bar; b.x = xb_xcc_id(); b.st = st;
    if (threadIdx.x == 0) (void)xb_add(&bar[XB_XCNT(b.x)], 1u);
    return b;
}
__device__ __forceinline__ void xcd_barrier_complete(unsigned* bar, unsigned x, unsigned& nloc, unsigned& nx) {
    const unsigned G = gridDim.x * gridDim.y * gridDim.z;
    unsigned sum, cnt, mine, sp = 0u;
    for (;;) {
        sum = 0u; cnt = 0u; mine = 0u;
#pragma unroll
        for (unsigned j = 0; j < 16; ++j) { const unsigned c = xb_ld(&bar[XB_XCNT(j)]); sum += c; cnt += (c > 0u) ? 1u : 0u; mine = (j == x) ? c : mine; }
        if (sum == G) break;
        __builtin_amdgcn_s_sleep(1);
        if ((++sp & 255u) == 0u) { if (xb_ld(&bar[XB_TMO])) break; if (sp > XB_SPIN_CAP) { atomicAdd(&bar[XB_TMO], 1u); break; } }
    }
    nloc = mine > 0u ? mine : 1u; nx = cnt > 0u ? cnt : 1u;
}

__device__ __forceinline__ void xcd_barrier(const XcdBarrier& b, const int tid_in) {
    asm volatile("s_waitcnt vmcnt(0)" ::: "memory");
    __syncthreads();
    if (tid_in == 0) {
        unsigned* bar = b.bar;
        __builtin_amdgcn_s_waitcnt(0);
        unsigned nloc = b.st[0], nx = b.st[1];
        if (nloc == 0u) { xcd_barrier_complete(bar, b.x, nloc, nx); b.st[0] = nloc; b.st[1] = nx; }
        const unsigned old = xb_add(&bar[XB_XSUB(b.x)], 1u);
        const unsigned gen = old / nloc;
        if (old + 1u == (gen + 1u) * nloc) {
            __builtin_amdgcn_fence(__ATOMIC_RELEASE, "agent");
            asm volatile("s_waitcnt vmcnt(0)" ::: "memory");
            const unsigned og = xb_add(&bar[XB_TOP], 1u);
            const unsigned tg = og / nx;
            if (og + 1u == (tg + 1u) * nx) xb_add(&bar[XB_TOPGEN], 1u);
            else XB_SPIN(xb_ld(&bar[XB_TOPGEN]) == tg, bar);
            __builtin_amdgcn_fence(__ATOMIC_ACQUIRE, "agent");
            xb_add(&bar[XB_XGEN(b.x)], 1u);
            asm volatile("s_waitcnt vmcnt(0)" ::: "memory");
        } else {
            XB_SPIN(xb_ld(&bar[XB_XGEN(b.x)]) == gen, bar);
            __builtin_amdgcn_fence(__ATOMIC_ACQUIRE, "agent");
            asm volatile("s_waitcnt vmcnt(0)" ::: "memory");
        }
    }
    __syncthreads();
}

#ifndef MK_ONE_LAUNCH
#define MK_ONE_LAUNCH 1
#endif
#ifndef PROBE_REP_MASK
#define PROBE_REP_MASK 0
#endif
#define REPS(bit) _Pragma("unroll") for (int rep_ = 0; rep_ < ((PROBE_REP_MASK >> (bit)) & 1) + 1; ++rep_)
constexpr int NWAVES = 8, NTHREADS = NWAVES * 64;
constexpr int BATCH = 8, SEQ = 2048, T = BATCH * SEQ, D = 1024, DEPTH = 2;
constexpr int NPROJ = 4352;
constexpr int N_INPUTS = 29;
constexpr int NADA = 6144;
constexpr float RMS_EPS = 1e-6f;
constexpr float QSCALE = 0.10206207261596575f * 1.4426950408889634f;
enum { I_X = 0, I_C, I_POS, I_WADA, I_BADA, I_N1G, I_WIN, I_QNG, I_WQUP, I_KVNG, I_WKVUP, I_WBA, I_CONVW, I_CONVB, I_WQM, I_WKM, I_WVM, I_BI, I_BF, I_MHG, I_MSKIP,
       I_WBM, I_WOUT, I_N2G, I_PWQ, I_PKEYS, I_PU, I_PV, I_FG };

constexpr size_t MiB = 1u << 20;
constexpr size_t WS_CTL = 0, CTL_ZERO_BYTES = 1 * MiB;
constexpr int CW_BAR = 4096;
constexpr int CW_XC = 8192;
constexpr size_t ADA_OFF = 256 * 1024;
constexpr size_t WS_COS = 1 * MiB, WS_SIN = 2 * MiB;
constexpr size_t WS_W = 3 * MiB, W_LAYER = 18 * MiB;
constexpr size_t WO_WIN = 0, WO_WQ = 8912896, WO_WKV = WO_WQ + 1179648, WO_WA = WO_WKV + 524288, WO_WM = WO_WA + 1048576, WO_WO = WO_WM + 1048576,
                 WO_PWQ = WO_WO + 2097152, WO_WQK = WO_PWQ + 2097152, WO_WV = WO_WQK + 1048576, WO_KEYB = WO_WV + 524288;
static_assert(WO_KEYB + 262144 <= W_LAYER, "weights fit");
constexpr size_t WS_X = 40 * MiB, WS_H = 104 * MiB, WS_QLAT = 136 * MiB, WS_KVLAT = 160 * MiB, WS_UM = 168 * MiB, WS_OPRE = 184 * MiB, WS_GA = 200 * MiB, WS_GM = 232 * MiB,
                 WS_SMALL = 264 * MiB, WS_RQ = 268 * MiB, WS_RKV = WS_RQ + 65536, WS_LOGI = WS_RQ + 262144, WS_LOGF = WS_RQ + 524288, WS_Q = 269 * MiB, WS_K = 293 * MiB,
                 WS_V = 317 * MiB, WS_CONV = 333 * MiB, WS_QKM = 349 * MiB, WS_VM = 381 * MiB, WS_AO = 397 * MiB, WS_OUTM = 413 * MiB, WS_U8 = 429 * MiB, WS_V8 = 445 * MiB, WS_END = 493 * MiB;
constexpr size_t WS_H8 = 493 * MiB, WS_XS = WS_RQ + 131072, WS_USC = WS_RQ + 786432;
constexpr size_t WS_END2 = 509 * MiB;
constexpr size_t WS_IDX = WS_UM, WS_GATE = WS_UM + 8 * MiB, WS_ACT = WS_OPRE;
constexpr size_t WS_SMALLP = WS_OUTM;
constexpr size_t WS_PQ = WS_QLAT, WS_MERGED = WS_QLAT;

constexpr int RING_OFF = 0, RING_BYTES = 131072;
constexpr int LDSCTL_OFF = RING_BYTES, MISC_OFF = LDSCTL_OFF + 320;
constexpr int LDS_BYTES = 147456;

typedef float f32x2v __attribute__((ext_vector_type(2)));
typedef unsigned u32x2 __attribute__((ext_vector_type(2)));

__device__ __forceinline__ float wave_sum(float v) {
#pragma unroll
    for (int o = 1; o < 64; o <<= 1) v += __shfl_xor(v, o);
    return v;
}
__device__ __forceinline__ float bflo(unsigned u) { return __uint_as_float(u << 16); }
__device__ __forceinline__ float bfhi(unsigned u) { return __uint_as_float(u & 0xffff0000u); }
__device__ __forceinline__ float sigm(float x) { return 1.f / (1.f + __expf(-x)); }
__device__ __forceinline__ float dot4(f32x4 a, f32x4 b) { return (a.x * b.x + a.y * b.y) + (a.z * b.z + a.w * b.w); }
__device__ __forceinline__ float gelu_erf(float x) { return 0.5f * x * (1.f + erff(x * 0.70710678118654752f)); }

struct EpiProj {
    static constexpr bool PERM = true, AFTER_DRAIN = false;
    bf16 *qlat, *kvlat, *um, *opre, *ga, *gm; float* small;
    __device__ __forceinline__ void operator()(const f32x4 (&acc)[2][2][4][2], const pg8::Unit& u, int wr, int wc, int fr, int fq) const {
        const int pn = u.pn; bf16* dst; int ld, cb; int mode = 0;
        if (pn < 3) { dst = qlat; ld = 768; cb = pn * 256; }
        else if (pn == 3) { dst = kvlat; ld = 256; cb = 0; }
        else if (pn < 6) { dst = um; ld = 512; cb = (pn - 4) * 256; }
        else if (pn < 8) { dst = opre; ld = 512; cb = (pn - 6) * 256; }
        else if (pn < 12) { dst = ga; ld = 1024; cb = (pn - 8) * 256; mode = 1; }
        else if (pn < 16) { dst = gm; ld = 1024; cb = (pn - 12) * 256; mode = 1; }
        else { dst = nullptr; ld = 0; cb = 0; mode = 2; }
        const int row0 = u.pm * 256 + wr * 64 + fr;
        if (mode == 2) {
            if (wc < 2) {
#pragma unroll
                for (int ai = 0; ai < 2; ++ai)
#pragma unroll
                    for (int m = 0; m < 4; ++m) { float* p = small + (size_t)(row0 + ai * 128 + m * 16) * 64 + wc * 32 + 8 * fq;
                        GST(p, acc[ai][0][m][0]); GST(p + 4, acc[ai][0][m][1]); }
            }
        } else {
#pragma unroll
            for (int ai = 0; ai < 2; ++ai)
#pragma unroll
                for (int m = 0; m < 4; ++m) { bf16* rowp = dst + (size_t)(row0 + ai * 128 + m * 16) * ld + cb + wc * 32 + 8 * fq;
#pragma unroll
                    for (int bj = 0; bj < 2; ++bj) { f32x4 v0 = acc[ai][bj][m][0], v1 = acc[ai][bj][m][1];
                        if (mode == 1) { v0 = (f32x4){sigm(v0[0]), sigm(v0[1]), sigm(v0[2]), sigm(v0[3])}; v1 = (f32x4){sigm(v1[0]), sigm(v1[1]), sigm(v1[2]), sigm(v1[3])}; }
                        v4u w; w.x = pk2(v0[0], v0[1]); w.y = pk2(v0[2], v0[3]); w.z = pk2(v1[0], v1[1]); w.w = pk2(v1[2], v1[3]);
                        GST(rowp + bj * 128, w); } }
        }
    }
};
struct EpiSmallPart {
    static constexpr bool PERM = true, AFTER_DRAIN = false;
    float* part;
    __device__ __forceinline__ void operator()(const f32x4 (&acc)[2][2][4][2], const pg8::Unit& u, int wr, int wc, int fr, int fq) const {
        if (wc >= 2) return;
        const int row0 = u.pm * 256 + wr * 64 + fr;
#pragma unroll
        for (int ai = 0; ai < 2; ++ai)
#pragma unroll
            for (int m = 0; m < 4; ++m) { float* p = part + (size_t)(row0 + ai * 128 + m * 16) * 64 + wc * 32 + 8 * fq;
                GST(p, acc[ai][0][m][0]); GST(p + 4, acc[ai][0][m][1]); }
    }
};
struct EpiQ {
    static constexpr bool PERM = true, AFTER_DRAIN = false;
    bf16* Q; const float* rq; const float* cosT; const float* sinT;
    __device__ __forceinline__ void operator()(const f32x4 (&acc)[2][2][4][2], const pg8::Unit& u, int wr, int wc, int fr, int fq) const {
        const int row0 = u.pm * 256 + wr * 64 + fr;
        int c0b[2], d0b[2];
#pragma unroll
        for (int bj = 0; bj < 2; ++bj) { c0b[bj] = u.pn * 256 + bj * 128 + wc * 32 + 8 * fq; d0b[bj] = c0b[bj] % 96; }
#pragma unroll
        for (int ai = 0; ai < 2; ++ai) {
            float rr[4]; f32x4 csv[4][2], snv[4][2];
#pragma unroll
            for (int m = 0; m < 4; ++m) { const int row = row0 + ai * 128 + m * 16; rr[m] = rq[row];
#pragma unroll
                for (int bj = 0; bj < 2; ++bj) { csv[m][bj] = (f32x4){1.f, 1.f, 1.f, 1.f}; snv[m][bj] = (f32x4){0.f, 0.f, 0.f, 0.f};
                    if (d0b[bj] >= 64) { const int j0 = (d0b[bj] - 64) >> 1; csv[m][bj] = *(const f32x4*)(cosT + (size_t)row * 16 + j0); snv[m][bj] = *(const f32x4*)(sinT + (size_t)row * 16 + j0); } } }
            __builtin_amdgcn_sched_barrier(0);
#pragma unroll
            for (int m = 0; m < 4; ++m) { const int row = row0 + ai * 128 + m * 16; const float r = rr[m];
#pragma unroll
                for (int bj = 0; bj < 2; ++bj) {
                    f32x4 v0 = acc[ai][bj][m][0] * r, v1 = acc[ai][bj][m][1] * r;
                    if (d0b[bj] >= 64) { const f32x4 cs = csv[m][bj], sn = snv[m][bj]; const f32x4 a0 = v0, a1 = v1;
                        v0[0] = a0[0] * cs[0] - a0[1] * sn[0]; v0[1] = a0[1] * cs[0] + a0[0] * sn[0];
                        v0[2] = a0[2] * cs[1] - a0[3] * sn[1]; v0[3] = a0[3] * cs[1] + a0[2] * sn[1];
                        v1[0] = a1[0] * cs[2] - a1[1] * sn[2]; v1[1] = a1[1] * cs[2] + a1[0] * sn[2];
                        v1[2] = a1[2] * cs[3] - a1[3] * sn[3]; v1[3] = a1[3] * cs[3] + a1[2] * sn[3]; }
                    v4u w; w.x = pk2(v0[0], v0[1]); w.y = pk2(v0[2], v0[3]); w.z = pk2(v1[0], v1[1]); w.w = pk2(v1[2], v1[3]);
                    GST(Q + (size_t)row * 768 + c0b[bj], w); } }
        }
    }
};
struct EpiKV {
    static constexpr bool PERM = true, AFTER_DRAIN = false;
    bf16* K; bf16* V; const float* rkv;
    __device__ __forceinline__ void operator()(const f32x4 (&acc)[2][2][4][2], const pg8::Unit& u, int wr, int wc, int fr, int fq) const {
        const int row0 = u.pm * 256 + wr * 64 + fr;
        float rr[2][4];
#pragma unroll
        for (int ai = 0; ai < 2; ++ai)
#pragma unroll
            for (int m = 0; m < 4; ++m) rr[ai][m] = rkv[row0 + ai * 128 + m * 16];
#pragma unroll
        for (int ai = 0; ai < 2; ++ai)
#pragma unroll
            for (int m = 0; m < 4; ++m) { const int row = row0 + ai * 128 + m * 16; const float r = rr[ai][m];
#pragma unroll
                for (int bj = 0; bj < 2; ++bj) { const int c0 = u.pn * 256 + bj * 128 + wc * 32 + 8 * fq;
                    const f32x4 v0 = acc[ai][bj][m][0] * r, v1 = acc[ai][bj][m][1] * r;
                    bf16* dst = (c0 < 512) ? (K + (size_t)row * 768 + 96 * (c0 >> 6) + (c0 & 63)) : (V + (size_t)row * 512 + (c0 - 512));
                    v4u w; w.x = pk2(v0[0], v0[1]); w.y = pk2(v0[2], v0[3]); w.z = pk2(v1[0], v1[1]); w.w = pk2(v1[2], v1[3]);
                    GST(dst, w); } }
    }
};
struct EpiMerge {
    static constexpr bool PERM = true, AFTER_DRAIN = false;
    bf16* Mg; const bf16* gate; int first;
    __device__ __forceinline__ void operator()(const f32x4 (&acc)[2][2][4][2], const pg8::Unit& u, int wr, int wc, int fr, int fq) const {
        const int row0 = u.pm * 256 + wr * 64 + fr, cbase = u.pn * 256 + wc * 32 + 8 * fq;
#pragma unroll
        for (int ai = 0; ai < 2; ++ai) {
            v4u gq[4][2], oq[4][2];
#pragma unroll
            for (int m = 0; m < 4; ++m)
#pragma unroll
                for (int bj = 0; bj < 2; ++bj) { const size_t off = (size_t)(row0 + ai * 128 + m * 16) * 1024 + cbase + bj * 128;
                    gq[m][bj] = *(const v4u*)(gate + off); oq[m][bj] = first ? (v4u){0u, 0u, 0u, 0u} : *(const v4u*)(Mg + off); }
            __builtin_amdgcn_sched_barrier(0);
#pragma unroll
            for (int m = 0; m < 4; ++m)
#pragma unroll
                for (int bj = 0; bj < 2; ++bj) { const size_t off = (size_t)(row0 + ai * 128 + m * 16) * 1024 + cbase + bj * 128;
                    const v4u g = gq[m][bj], o = oq[m][bj];
                    f32x4 v0 = acc[ai][bj][m][0], v1 = acc[ai][bj][m][1];
                    v0[0] = v0[0] * bflo(g.x) + bflo(o.x); v0[1] = v0[1] * bfhi(g.x) + bfhi(o.x); v0[2] = v0[2] * bflo(g.y) + bflo(o.y); v0[3] = v0[3] * bfhi(g.y) + bfhi(o.y);
                    v1[0] = v1[0] * bflo(g.z) + bflo(o.z); v1[1] = v1[1] * bfhi(g.z) + bfhi(o.z); v1[2] = v1[2] * bflo(g.w) + bflo(o.w); v1[3] = v1[3] * bfhi(g.w) + bfhi(o.w);
                    v4u w; w.x = pk2(v0[0], v0[1]); w.y = pk2(v0[2], v0[3]); w.z = pk2(v1[0], v1[1]); w.w = pk2(v1[2], v1[3]);
                    GST(Mg + off, w); }
        }
    }
};
struct MergeOrder {
    pg8::StaticOrder base;
    __device__ __forceinline__ bool next(int i, pg8::Unit& u) const { pg8::Unit v; if (!base.next(i >> 1, v)) return false; u.pm = v.pm + ((i & 1) ? T / 256 : 0); u.pn = v.pn + ((i & 1) ? 4 : 0); return true; }
    __device__ __forceinline__ void a_ready(const pg8::Unit&) const {}
    __device__ __forceinline__ void done(const pg8::Unit&) const {}
};
struct EpiMerge2 {
    static constexpr bool PERM = true, AFTER_DRAIN = false;
    bf16* Mg; const bf16* ga; const bf16* gm;
    __device__ __forceinline__ void operator()(const f32x4 (&acc)[2][2][4][2], const pg8::Unit& u, int wr, int wc, int fr, int fq) const {
        const bool second = u.pn >= 4; const pg8::Unit v{second ? u.pm - T / 256 : u.pm, second ? u.pn - 4 : u.pn};
        const EpiMerge e{Mg, second ? gm : ga, second ? 0 : 1}; e(acc, v, wr, wc, fr, fq); }
};
template <bool XBF> struct EpiResid {
    static constexpr bool PERM = true, AFTER_DRAIN = false;
    const void* xin; bf16* xout; const float* gate;
    __device__ __forceinline__ void operator()(const f32x4 (&acc)[2][2][4][2], const pg8::Unit& u, int wr, int wc, int fr, int fq) const {
        const int row0 = u.pm * 256 + wr * 64 + fr, b = (u.pm * 256) >> 11, cbase = u.pn * 256 + wc * 32 + 8 * fq;
        f32x4 gv[2][2];
#pragma unroll
        for (int bj = 0; bj < 2; ++bj) { const float* gp = gate + (size_t)b * NADA + cbase + bj * 128; gv[bj][0] = *(const f32x4*)gp; gv[bj][1] = *(const f32x4*)(gp + 4); }
#pragma unroll
        for (int ai = 0; ai < 2; ++ai) {
            f32x4 xv[4][2][2];
#pragma unroll
            for (int m = 0; m < 4; ++m)
#pragma unroll
                for (int bj = 0; bj < 2; ++bj) { const size_t off = (size_t)(row0 + ai * 128 + m * 16) * 1024 + cbase + bj * 128;
                    if (XBF) { const v4u w = *(const v4u*)((const bf16*)xin + off); xv[m][bj][0] = (f32x4){bflo(w.x), bfhi(w.x), bflo(w.y), bfhi(w.y)}; xv[m][bj][1] = (f32x4){bflo(w.z), bfhi(w.z), bflo(w.w), bfhi(w.w)}; }
                    else { xv[m][bj][0] = *(const f32x4*)((const float*)xin + off); xv[m][bj][1] = *(const f32x4*)((const float*)xin + off + 4); } }
            __builtin_amdgcn_sched_barrier(0);
#pragma unroll
            for (int m = 0; m < 4; ++m)
#pragma unroll
                for (int bj = 0; bj < 2; ++bj) { const size_t off = (size_t)(row0 + ai * 128 + m * 16) * 1024 + cbase + bj * 128;
                    const f32x4 o0 = xv[m][bj][0] + gv[bj][0] * acc[ai][bj][m][0], o1 = xv[m][bj][1] + gv[bj][1] * acc[ai][bj][m][1];
                    v4u w; w.x = pk2(o0[0], o0[1]); w.y = pk2(o0[2], o0[3]); w.z = pk2(o1[0], o1[1]); w.w = pk2(o1[2], o1[3]);
                    GST(xout + off, w); }
        }
    }
};

template <class Get> __device__ __forceinline__ void prep_tile(const Get& get, bf16* dst, int K, int k0, int n0, LAS float* scr, int lane) {
    float tv[32];
#pragma unroll
    for (int i = 0; i < 32; ++i) tv[i] = get(k0 + 2 * i + (lane >> 5), n0 + (lane & 31));
#pragma unroll
    for (int i = 0; i < 32; ++i) { const int kk = 2 * i + (lane >> 5); scr[kk * 33 + (lane & 31)] = tv[i]; }
    LDS_WAIT(); asm volatile("" ::: "memory");
    const int c = lane & 7;
#pragma unroll
    for (int j = 0; j < 4; ++j) { const int n = (lane >> 3) + 8 * j; const LAS float* s = scr + (8 * c) * 33 + n;
        v4u o; o.x = pk2(s[0 * 33], s[1 * 33]); o.y = pk2(s[2 * 33], s[3 * 33]); o.z = pk2(s[4 * 33], s[5 * 33]); o.w = pk2(s[6 * 33], s[7 * 33]);
        *(GAS v4u*)(dst + (size_t)(n0 + n) * K + k0 + 8 * c) = o; }
    LDS_WAIT(); asm volatile("" ::: "memory");
}
struct GetWin { const float* w; __device__ __forceinline__ float operator()(int k, int n) const {
    int sc; if (n < 1024) sc = n; else if (n < 2048) sc = n + 32; else if (n < 4096) sc = n + 40; else if (n < 4128) sc = n - 3072; else if (n < 4136) sc = n - 2048; else sc = -1;
    return sc < 0 ? 0.f : w[(size_t)k * 4136 + sc]; } };
struct GetWq { const float* w; const float* g; __device__ __forceinline__ float operator()(int k, int n) const {
    const int h = n / 96, dd = n % 96; const int e = dd - 64; const int sd = dd < 64 ? dd : 64 + (e >> 1) + 16 * (e & 1);
    return w[(size_t)k * 768 + h * 96 + sd] * g[k] * QSCALE; } };
struct GetWkv { const float* w; const float* g; __device__ __forceinline__ float operator()(int k, int n) const {
    const int nn = n & 511, h = nn >> 6, c = nn & 63; const int sc = h * 128 + c + ((n >= 512) ? 64 : 0);
    return w[(size_t)k * 1024 + sc] * g[k]; } };
struct GetPlain { const float* w; int N; __device__ __forceinline__ float operator()(int k, int n) const { return w[(size_t)k * N + n]; } };
struct GetWqk { const float* wq; const float* wk; __device__ __forceinline__ float operator()(int k, int n) const {
    const int c = n >> 9, part = (n >> 8) & 1, h = 2 * c + ((n >> 7) & 1), e = n & 127, kh = k >> 7, d = k & 127;
    if (kh != h) return 0.f;
    const size_t off = ((size_t)h * 128 + d) * 128 + e;
    return part ? wk[off] * 0.08838834764831845f : wq[off]; } };
struct GetWv { const float* wv; __device__ __forceinline__ float operator()(int k, int n) const {
    const int h = n >> 7, e = n & 127, kh = k >> 7, d = k & 127;
    return (kh != h) ? 0.f : wv[((size_t)h * 128 + d) * 128 + e]; } };

__device__ const float INV_FREQ[16] = { 1.0f, 0.5623413251903491f, 0.31622776601683794f, 0.1778279410038923f, 0.1f, 0.05623413251903491f, 0.031622776601683794f, 0.01778279410038923f,
    0.01f, 0.005623413251903491f, 0.0031622776601683794f, 0.001778279410038923f, 0.001f, 0.0005623413251903491f, 0.00031622776601683794f, 0.0001778279410038923f };

template <bool XBF> __device__ __forceinline__ void rowpass_norm_mod(const void* xin_, const float* g, const float* ada_shift, const float* ada_scale, bf16* hout, int gw, int NGW, int lane, unsigned char* h8 = nullptr, float* xs = nullptr) {
#define RP_LOAD(dst, row) { if (XBF) { const u32x2* p_ = (const u32x2*)((const bf16*)xin_ + (size_t)(row) * D) + lane; _Pragma("unroll") for (int j = 0; j < 4; ++j) { const u32x2 w_ = p_[64 * j]; dst[j] = (f32x4){bflo(w_.x), bfhi(w_.x), bflo(w_.y), bfhi(w_.y)}; } } \
                          else { const f32x4* p_ = (const f32x4*)((const float*)xin_ + (size_t)(row) * D) + lane; _Pragma("unroll") for (int j = 0; j < 4; ++j) dst[j] = p_[64 * j]; } }
    f32x4 vn[4];
    if (gw < T) RP_LOAD(vn, gw);
    for (int t = gw; t < T; t += NGW) {
        const int b = t >> 11;
        f32x4 v[4]; float s = 0.f;
#pragma unroll
        for (int j = 0; j < 4; ++j) { v[j] = vn[j]; s += dot4(v[j], v[j]); }
        { const int tn = (t + NGW < T) ? t + NGW : t;
          RP_LOAD(vn, tn); }
        const float r = rsqrtf(wave_sum(s) * (1.f / D) + RMS_EPS);
        unsigned long long* o8 = (unsigned long long*)(hout + (size_t)t * D) + lane;
        f32x4 ov[4]; float am = 0.f;
#pragma unroll
        for (int j = 0; j < 4; ++j) { const int col = 4 * lane + 256 * j;
            const f32x4 gg = *(const f32x4*)(g + col), sc = *(const f32x4*)(ada_scale + (size_t)b * NADA + col), sh = *(const f32x4*)(ada_shift + (size_t)b * NADA + col);
            const f32x4 o = v[j] * r * gg * (sc + 1.f) + sh; ov[j] = o;
            am = fmaxf(fmaxf(am, fmaxf(fabsf(o.x), fabsf(o.y))), fmaxf(fabsf(o.z), fabsf(o.w)));
            GSTF(o8 + 64 * j, (unsigned long long)pk2(o.x, o.y) | ((unsigned long long)pk2(o.z, o.w) << 32)); }
        if (h8) {
#pragma unroll
            for (int o = 1; o < 64; o <<= 1) am = fmaxf(am, __shfl_xor(am, o));
            const float inv = am > 0.f ? 127.f / am : 0.f;
#pragma unroll
            for (int j = 0; j < 4; ++j) { const int q0 = (int)rintf(ov[j].x * inv), q1 = (int)rintf(ov[j].y * inv), q2 = (int)rintf(ov[j].z * inv), q3 = (int)rintf(ov[j].w * inv);
                GSTF((unsigned*)(h8 + (size_t)t * D) + lane + 64 * j, (unsigned)(q0 & 255) | ((unsigned)(q1 & 255) << 8) | ((unsigned)(q2 & 255) << 16) | ((unsigned)(q3 & 255) << 24)); }
            if (lane == 0) xs[t] = am * (1.f / 127.f);
        }
    }
}
__device__ __forceinline__ void rowpass_final(const bf16* xin_, const float* g, float* out, int gw, int NGW, int lane) {
    constexpr bool XBF = true;
    f32x4 vn[4];
    if (gw < T) RP_LOAD(vn, gw);
    for (int t = gw; t < T; t += NGW) {
        f32x4 v[4]; float s = 0.f;
#pragma unroll
        for (int j = 0; j < 4; ++j) { v[j] = vn[j]; s += dot4(v[j], v[j]); }
        { const int tn = (t + NGW < T) ? t + NGW : t;
          RP_LOAD(vn, tn); }
        const float r = rsqrtf(wave_sum(s) * (1.f / D) + RMS_EPS);
        f32x4* o = (f32x4*)(out + (size_t)t * D) + lane;
#pragma unroll
        for (int j = 0; j < 4; ++j) { const f32x4 gg = *(const f32x4*)(g + 4 * lane + 256 * j); o[64 * j] = v[j] * r * gg; }
    }
}
#undef RP_LOAD
__device__ __forceinline__ void rowpass_mid(const bf16* qlat, const bf16* kvlat, const float* small, const float* smallp, const float* cosT, const float* sinT, const bf16* um,
                                            const float* conv_w, const float* conv_b, const float* b_i, const float* b_f,
                                            float* RQ, float* RKV, bf16* K, float* LOGI, float* LOGF, bf16* CONV, int gw, int NGW, int lane) {
    const int c0 = 8 * lane;
    f32x4 cw[4][2], cb[2];
#pragma unroll
    for (int j = 0; j < 4; ++j) { cw[j][0] = *(const f32x4*)(conv_w + j * 512 + c0); cw[j][1] = *(const f32x4*)(conv_w + j * 512 + c0 + 4); }
    cb[0] = *(const f32x4*)(conv_b + c0); cb[1] = *(const f32x4*)(conv_b + c0 + 4);
    const float bsel = (lane >= 32 && lane < 36) ? b_i[lane - 32] : (lane >= 36 && lane < 40) ? b_f[lane - 36] : 0.f;
    for (int tb = gw * 4; tb < T; tb += NGW * 4) {
        const int pos0 = tb & (SEQ - 1);
        u32x2 qv[4][3], kvv[4]; v4u uw[7]; float sv[4], cs[4], sn[4];
#pragma unroll
        for (int i = 0; i < 4; ++i) { const int t = tb + i; const u32x2* p = (const u32x2*)(qlat + (size_t)t * 768);
#pragma unroll
            for (int j = 0; j < 3; ++j) qv[i][j] = p[lane + 64 * j];
            kvv[i] = ((const u32x2*)(kvlat + (size_t)t * 256))[lane];
            sv[i] = 0.f;
            if (lane < 40) sv[i] = smallp ? ((smallp[(size_t)t * 64 + lane] + smallp[(size_t)(T + t) * 64 + lane]) + (smallp[(size_t)(2 * T + t) * 64 + lane] + smallp[(size_t)(3 * T + t) * 64 + lane]))
                                         : small[(size_t)t * 64 + lane];
            cs[i] = 0.f; sn[i] = 0.f; if (lane < 16) { cs[i] = cosT[(size_t)t * 16 + lane]; sn[i] = sinT[(size_t)t * 16 + lane]; } }
#pragma unroll
        for (int j = 0; j < 7; ++j) { uw[j] = (v4u){0u, 0u, 0u, 0u}; if (pos0 - 3 + j >= 0) uw[j] = *(const v4u*)(um + (size_t)(tb - 3 + j) * 512 + c0); }
#pragma unroll
        for (int i = 0; i < 4; ++i) { const int t = tb + i;
            float s = 0.f;
#pragma unroll
            for (int j = 0; j < 3; ++j) { const u32x2 w = qv[i][j]; const float a = bflo(w.x), b2 = bfhi(w.x), c = bflo(w.y), d = bfhi(w.y); s += (a * a + b2 * b2) + (c * c + d * d); }
            const float rq = rsqrtf(wave_sum(s) * (1.f / 768.f) + RMS_EPS);
            const u32x2 w = kvv[i]; const float a = bflo(w.x), b2 = bfhi(w.x), c = bflo(w.y), d = bfhi(w.y);
            const float rkv = rsqrtf(wave_sum((a * a + b2 * b2) + (c * c + d * d)) * (1.f / 256.f) + RMS_EPS);
            if (lane == 0) { RQ[t] = rq; RKV[t] = rkv; }
            const float x2 = __shfl(sv[i], (lane + 16) & 63);
            if (lane < 16) { const float x1 = sv[i]; const unsigned pk = pk2(x1 * cs[i] - x2 * sn[i], x2 * cs[i] + x1 * sn[i]);
#pragma unroll
                for (int h = 0; h < 8; ++h) ((unsigned*)(K + (size_t)t * 768 + 96 * h + 64))[lane] = pk; }
            else if (lane >= 32 && lane < 36) LOGI[(size_t)t * 4 + (lane - 32)] = sv[i] + bsel;
            else if (lane >= 36 && lane < 40) { const float x = sv[i] + bsel; LOGF[(size_t)t * 4 + (lane - 36)] = fminf(x, 0.f) - log1pf(expf(-fabsf(x))); }
            float acc[8];
            acc[0] = cb[0][0]; acc[1] = cb[0][1]; acc[2] = cb[0][2]; acc[3] = cb[0][3]; acc[4] = cb[1][0]; acc[5] = cb[1][1]; acc[6] = cb[1][2]; acc[7] = cb[1][3];
#pragma unroll
            for (int j = 0; j < 4; ++j) { const v4u u4 = uw[i + j];
                acc[0] += cw[j][0][0] * bflo(u4.x); acc[1] += cw[j][0][1] * bfhi(u4.x); acc[2] += cw[j][0][2] * bflo(u4.y); acc[3] += cw[j][0][3] * bfhi(u4.y);
                acc[4] += cw[j][1][0] * bflo(u4.z); acc[5] += cw[j][1][1] * bfhi(u4.z); acc[6] += cw[j][1][2] * bflo(u4.w); acc[7] += cw[j][1][3] * bfhi(u4.w); }
#pragma unroll
            for (int q = 0; q < 8; ++q) acc[q] = acc[q] * sigm(acc[q]);
            v4u o; o.x = pk2(acc[0], acc[1]); o.y = pk2(acc[2], acc[3]); o.z = pk2(acc[4], acc[5]); o.w = pk2(acc[6], acc[7]);
            GSTF(CONV + (size_t)t * 512 + c0, o); }
    }
}

typedef float f32x16 __attribute__((ext_vector_type(16)));
typedef short s16x4 __attribute__((ext_vector_type(4)));
typedef short v4i16_t __attribute__((ext_vector_type(4)));
typedef float f32x2_t __attribute__((ext_vector_type(2))); typedef __bf16 bf16x2_t __attribute__((ext_vector_type(2)));
__device__ __forceinline__ unsigned cvtpk(float lo, float hi) { f32x2_t v = {lo, hi}; bf16x2_t b = __builtin_convertvector(v, bf16x2_t); return __builtin_bit_cast(unsigned, b); }
__device__ __forceinline__ s16x4 vtr(const LAS unsigned char* p) { return __builtin_bit_cast(s16x4, __builtin_amdgcn_ds_read_tr16_b64_v4i16((LAS v4i16_t*)p)); }
__device__ __forceinline__ bf16x8 pack8(float a0, float a1, float a2, float a3, float a4, float a5, float a6, float a7) {
    v4u p; p.x = cvtpk(a0, a1); p.y = cvtpk(a2, a3); p.z = cvtpk(a4, a5); p.w = cvtpk(a6, a7); return __builtin_bit_cast(bf16x8, p); }
#define MFMA32(a, b, c) __builtin_amdgcn_mfma_f32_32x32x16_bf16((a), (b), (c), 0, 0, 0)
constexpr int AT_KB = 12288, AT_VB = 8192;
__device__ __forceinline__ void attn_mfma(const bf16* Q, const bf16* K, const bf16* V, bf16* AO, LAS unsigned char* lds, int bx, int G, int tid) {
    const int lane = tid & 63, wave = __builtin_amdgcn_readfirstlane(tid >> 6), r = lane & 31, hh = lane >> 5;
    const int i16 = lane & 15, q4 = i16 >> 2, p4 = i16 & 3, blk = (lane >> 4) & 1;
    const int vboff = (4 * hh + q4) * 64 + 32 * blk + 8 * p4;
    const int kr0 = tid / 12, kc0 = tid % 12, kr1 = (tid + 512) / 12, kc1 = (tid + 512) % 12, vr = tid >> 3, vc = tid & 7;
    const int klds0 = (kc0 >> 1) * 2048 + (kc0 & 1) * 1024 + kr0 * 16, klds1 = (kc1 >> 1) * 2048 + (kc1 & 1) * 1024 + kr1 * 16;
    const int vlds = (vc >> 2) * 4096 + (vr >> 4) * 1024 + ((vr >> 3) & 1) * 512 + (vr & 7) * 64 + (vc & 3) * 16;
    for (int pu = bx; pu < 256; pu += G) {
        const int bh = pu >> 2, b = bh >> 3, h = bh & 7;
        const bf16* kg = K + ((size_t)b * SEQ) * 768 + h * 96; const bf16* vg = V + ((size_t)b * SEQ) * 512 + h * 64;
        for (int half = 0; half < 2; ++half) {
            const int qb = half == 0 ? 7 - (pu & 3) : (pu & 3);
            const int q0w = qb * 256 + wave * 32, nkt = 4 * (qb + 1), kmax = (q0w + 31) >> 6;
            bf16x8 qf[6];
            { const bf16* qrow = Q + ((size_t)b * SEQ + q0w + r) * 768 + h * 96 + 8 * hh;
#pragma unroll
              for (int s = 0; s < 6; ++s) qf[s] = *(const bf16x8*)(qrow + 16 * s); }
            f32x16 o0, o1;
#pragma unroll
            for (int i = 0; i < 16; ++i) { o0[i] = 0.f; o1[i] = 0.f; }
            float m = 0.f, l = 0.f; f32x16 negm;
#pragma unroll
            for (int i = 0; i < 16; ++i) negm[i] = 0.f;
            v4u ka = *(const v4u*)(kg + (size_t)kr0 * 768 + kc0 * 8), kb2 = (v4u){0u, 0u, 0u, 0u}, va = *(const v4u*)(vg + (size_t)vr * 512 + vc * 8);
            if (tid < 256) kb2 = *(const v4u*)(kg + (size_t)kr1 * 768 + kc1 * 8);
            __syncthreads();
            *(LAS v4u*)(lds + klds0) = ka; if (tid < 256) *(LAS v4u*)(lds + klds1) = kb2; *(LAS v4u*)(lds + 2 * AT_KB + vlds) = va;
            __syncthreads();
            for (int kt = 0; kt < nkt; ++kt) {
                const int buf = kt & 1;
                if (kt + 1 < nkt) { const size_t k1 = (size_t)(kt + 1) * 64;
                    ka = *(const v4u*)(kg + (k1 + kr0) * 768 + kc0 * 8); if (tid < 256) kb2 = *(const v4u*)(kg + (k1 + kr1) * 768 + kc1 * 8); va = *(const v4u*)(vg + (k1 + vr) * 512 + vc * 8); }
                if (kt <= kmax) {
                    const LAS unsigned char* kb_ = lds + buf * AT_KB + hh * 1024 + r * 16; const LAS unsigned char* vb_ = lds + 2 * AT_KB + buf * AT_VB + vboff;
                    f32x16 s0, s1;
                    { bf16x8 kf0[6], kf1[6];
#pragma unroll
                      for (int s = 0; s < 6; ++s) { kf0[s] = *(const LAS bf16x8*)(kb_ + s * 2048); kf1[s] = *(const LAS bf16x8*)(kb_ + s * 2048 + 512); }
                      __builtin_amdgcn_sched_barrier(0);
                      s0 = MFMA32(kf0[0], qf[0], negm); s1 = MFMA32(kf1[0], qf[0], negm);
#pragma unroll
                      for (int s = 1; s < 6; ++s) { s0 = MFMA32(kf0[s], qf[s], s0); s1 = MFMA32(kf1[s], qf[s], s1); } }
                    if (kt * 64 + 63 > q0w) { const int qq = q0w + r - kt * 64;
#pragma unroll
                        for (int i = 0; i < 16; ++i) { const int key = (i & 3) + 8 * (i >> 2) + 4 * hh; if (key > qq) s0[i] = -INFINITY; if (key + 32 > qq) s1[i] = -INFINITY; } }
                    float mx = fmaxf(fmaxf(s0[0], s1[0]), fmaxf(s0[1], s1[1]));
#pragma unroll
                    for (int i = 2; i < 16; i += 2) mx = fmaxf(fmaxf(mx, fmaxf(s0[i], s1[i])), fmaxf(s0[i + 1], s1[i + 1]));
                    { auto r32 = __builtin_amdgcn_permlane32_swap(__float_as_uint(mx), __float_as_uint(mx), false, false); mx = fmaxf(__uint_as_float(r32[0]), __uint_as_float(r32[1])); }
                    if (kt == 0 || __builtin_amdgcn_ballot_w64(mx > 8.f) != 0ull) {
                        const float d = (kt == 0) ? mx : fmaxf(mx, 0.f), corr = (kt == 0) ? 0.f : __builtin_amdgcn_exp2f(-d);
                        m = (kt == 0) ? mx : m + d; l *= corr;
#pragma unroll
                        for (int i = 0; i < 16; ++i) { o0[i] *= corr; o1[i] *= corr; s0[i] -= d; s1[i] -= d; negm[i] = -m; } }
                    float ps = 0.f;
#pragma unroll
                    for (int i = 0; i < 16; ++i) { s0[i] = __builtin_amdgcn_exp2f(s0[i]); s1[i] = __builtin_amdgcn_exp2f(s1[i]); ps += s0[i] + s1[i]; }
                    l += ps;
                    bf16x8 pf[4];
                    pf[0] = pack8(s0[0], s0[1], s0[2], s0[3], s0[4], s0[5], s0[6], s0[7]); pf[1] = pack8(s0[8], s0[9], s0[10], s0[11], s0[12], s0[13], s0[14], s0[15]);
                    pf[2] = pack8(s1[0], s1[1], s1[2], s1[3], s1[4], s1[5], s1[6], s1[7]); pf[3] = pack8(s1[8], s1[9], s1[10], s1[11], s1[12], s1[13], s1[14], s1[15]);
                    { s16x4 vlo[8], vhi[8];
#pragma unroll
                      for (int ks = 0; ks < 4; ++ks) { vlo[ks] = vtr(vb_ + ks * 1024); vhi[ks] = vtr(vb_ + ks * 1024 + 512); vlo[4 + ks] = vtr(vb_ + 4096 + ks * 1024); vhi[4 + ks] = vtr(vb_ + 4096 + ks * 1024 + 512); }
                      __builtin_amdgcn_sched_barrier(0);
#pragma unroll
                      for (int ks = 0; ks < 4; ++ks) {
                          const bf16x8 a0 = (bf16x8){vlo[ks][0], vlo[ks][1], vlo[ks][2], vlo[ks][3], vhi[ks][0], vhi[ks][1], vhi[ks][2], vhi[ks][3]};
                          const bf16x8 a1 = (bf16x8){vlo[4 + ks][0], vlo[4 + ks][1], vlo[4 + ks][2], vlo[4 + ks][3], vhi[4 + ks][0], vhi[4 + ks][1], vhi[4 + ks][2], vhi[4 + ks][3]};
                          o0 = MFMA32(a0, pf[ks], o0); o1 = MFMA32(a1, pf[ks], o1); } }
                }
                if (kt + 1 < nkt) { LAS unsigned char* nb = lds + (buf ^ 1) * AT_KB; *(LAS v4u*)(nb + klds0) = ka; if (tid < 256) *(LAS v4u*)(nb + klds1) = kb2; *(LAS v4u*)(lds + 2 * AT_KB + (buf ^ 1) * AT_VB + vlds) = va; }
                __syncthreads();
            }
            const float inv = 1.f / (l + __shfl_xor(l, 32));
            bf16* orow = AO + ((size_t)b * SEQ + q0w + r) * 512 + h * 64 + 4 * hh;
#pragma unroll
            for (int g = 0; g < 4; ++g) { u32x2 w0, w1; w0.x = cvtpk(o0[4 * g] * inv, o0[4 * g + 1] * inv); w0.y = cvtpk(o0[4 * g + 2] * inv, o0[4 * g + 3] * inv);
                w1.x = cvtpk(o1[4 * g] * inv, o1[4 * g + 1] * inv); w1.y = cvtpk(o1[4 * g + 2] * inv, o1[4 * g + 3] * inv);
                GST(orow + 8 * g, w0); GST(orow + 32 + 8 * g, w1); }
        }
    }
}


constexpr int ML_KB = 16384, ML_VB = 16384, ML_BUF = 32768, ML_TAB = 3 * 32768;
__device__ __forceinline__ void mlstm_mfma(const bf16* QKM, const bf16* VM, const float* LOGI, const float* LOGF, const bf16* CONV, const bf16* OPRE, const float* ng, const float* skip,
                                           bf16* OUTM, LAS unsigned char* lds, int bx, int G, int tid) {
    const int lane = tid & 63, wave = __builtin_amdgcn_readfirstlane(tid >> 6), r = lane & 31, hh = lane >> 5;
    const int i16 = lane & 15, q4 = i16 >> 2, p4 = i16 & 3, blk = (lane >> 4) & 1;
    const int vboff = (4 * hh + q4) * 64 + 32 * blk + 8 * p4;
    int goff[4], loff[4];
#pragma unroll
    for (int q = 0; q < 4; ++q) { const int j = 4 * wave + q;
        if (j < 16) { goff[q] = lane * 1024 + 16 * (j >> 1) + 8 * (j & 1); loff[q] = (j >> 1) * 2048 + (j & 1) * 1024; }
        else { const int jv = j - 16, dq = jv >> 2, ks = jv & 3; goff[q] = (16 * ks + 8 * (lane >> 5) + ((lane >> 2) & 7)) * 512 + 32 * dq + 8 * (lane & 3); loff[q] = ML_KB + dq * 4096 + ks * 1024; } }
    const bool kwave = wave < 4;
#define ML_DMA(tile, bufi) do { _Pragma("unroll") for (int q_ = 0; q_ < 4; ++q_) { \
        const bf16* src_ = kwave ? (kg + (size_t)(tile) * 64 * 1024 + goff[q_]) : (vg + (size_t)(tile) * 64 * 512 + goff[q_]); \
        __builtin_amdgcn_global_load_lds((const unsigned*)src_, (LAS unsigned*)(lds + (bufi) * ML_BUF + loff[q_]), 16, 0, 0); } } while (0)
    LAS float* Ftab = (LAS float*)(lds + ML_TAB); LAS float* Ctab = Ftab + 2048; LAS float* wtot = Ctab + 2048;
    constexpr float L2E = 1.4426950408889634f;
    for (int pu = bx; pu < 256; pu += G) {
        const int bh = pu >> 3, p = pu & 7, b = bh >> 2, h = bh & 3;
        __syncthreads();
        { float f4[4], i4[4];
#pragma unroll
          for (int e = 0; e < 4; ++e) { const size_t row = (size_t)b * SEQ + tid * 4 + e; f4[e] = LOGF[row * 4 + h]; i4[e] = LOGI[row * 4 + h]; }
          f4[1] += f4[0]; f4[2] += f4[1]; f4[3] += f4[2];
          float x = f4[3];
          x += __uint_as_float(__builtin_amdgcn_update_dpp(0, __float_as_uint(x), 0x111, 0xf, 0xf, true)); x += __uint_as_float(__builtin_amdgcn_update_dpp(0, __float_as_uint(x), 0x112, 0xf, 0xf, true));
          x += __uint_as_float(__builtin_amdgcn_update_dpp(0, __float_as_uint(x), 0x114, 0xf, 0xf, true)); x += __uint_as_float(__builtin_amdgcn_update_dpp(0, __float_as_uint(x), 0x118, 0xf, 0xf, true));
          { const float t0 = __uint_as_float(__builtin_amdgcn_readlane(__float_as_uint(x), 15)), t1 = __uint_as_float(__builtin_amdgcn_readlane(__float_as_uint(x), 31)), t2 = __uint_as_float(__builtin_amdgcn_readlane(__float_as_uint(x), 47));
            const int row = lane >> 4; x += (row >= 1 ? t0 : 0.f) + (row >= 2 ? t1 : 0.f) + (row >= 3 ? t2 : 0.f); }
          if (lane == 63) wtot[wave] = x;
          __syncthreads();
          float base = x - f4[3];
          for (int w = 0; w < wave; ++w) base += wtot[w];
#pragma unroll
          for (int e = 0; e < 4; ++e) { const float F = base + f4[e]; Ftab[tid * 4 + e] = F * L2E; Ctab[tid * 4 + e] = (i4[e] - F) * L2E; } }
        __syncthreads();
        const int grp = wave >> 2, w4 = wave & 3;
        const int q0w = (grp == 0 ? 128 * p : 128 * (15 - p)) + 32 * w4, kmax = (q0w + 31) >> 6, nkt = 2 * (16 - p);
        const size_t trow = (size_t)b * SEQ + q0w + r;
        bf16x8 qf[8];
        { const bf16* qrow = QKM + trow * 1024 + h * 128 + 8 * hh;
#pragma unroll
          for (int s = 0; s < 8; ++s) qf[s] = *(const bf16x8*)(qrow + 16 * s); }
        const float Ft = Ftab[q0w + r], Ft0 = Ftab[q0w];
        LAS float* wt = Ctab + 2048 + 64 + wave * 64;
        f32x16 o[4];
#pragma unroll
        for (int d = 0; d < 4; ++d)
#pragma unroll
            for (int i = 0; i < 16; ++i) o[d][i] = 0.f;
        float den = 0.f;
        const bf16* kg = QKM + ((size_t)b * SEQ) * 1024 + 512 + h * 128; const bf16* vg = VM + ((size_t)b * SEQ) * 512 + h * 128;
        ML_DMA(0, 0);
        if (nkt > 1) { ML_DMA(1, 1); asm volatile("s_waitcnt vmcnt(4)" ::: "memory"); } else asm volatile("s_waitcnt vmcnt(0)" ::: "memory");
        asm volatile("s_waitcnt lgkmcnt(0)" ::: "memory"); __builtin_amdgcn_s_barrier(); asm volatile("" ::: "memory");
        for (int kt = 0; kt < nkt; ++kt) {
            const int buf = kt % 3;
            if (kt + 2 < nkt) ML_DMA(kt + 2, (kt + 2) % 3);
            if (kt <= kmax) {
                const LAS unsigned char* kb_ = lds + buf * ML_BUF + hh * 1024 + r * 16; const LAS unsigned char* vb_ = lds + buf * ML_BUF + ML_KB + vboff;
                f32x16 s0, s1;
#pragma unroll
                for (int i = 0; i < 16; ++i) { s0[i] = 0.f; s1[i] = 0.f; }
#pragma unroll
                for (int sh = 0; sh < 2; ++sh) { bf16x8 kf0[4], kf1[4];
#pragma unroll
                  for (int s = 0; s < 4; ++s) { kf0[s] = *(const LAS bf16x8*)(kb_ + (4 * sh + s) * 2048); kf1[s] = *(const LAS bf16x8*)(kb_ + (4 * sh + s) * 2048 + 512); }
                  __builtin_amdgcn_sched_barrier(0);
#pragma unroll
                  for (int s = 0; s < 4; ++s) { s0 = MFMA32(kf0[s], qf[4 * sh + s], s0); s1 = MFMA32(kf1[s], qf[4 * sh + s], s1); } }
                const int qq = q0w + r - kt * 64;
                const bool diag = kt * 64 + 63 > q0w;
                wt[lane] = __builtin_amdgcn_exp2f(Ctab[kt * 64 + lane] + Ft0);
                LDS_WAIT();
                const LAS float* ct = wt + 4 * hh;
                float ps = 0.f;
#pragma unroll
                for (int g = 0; g < 4; ++g) { const f32x4 c0v = *(const LAS f32x4*)(ct + 8 * g), c1v = *(const LAS f32x4*)(ct + 32 + 8 * g);
#pragma unroll
                    for (int e = 0; e < 4; ++e) { const int i = 4 * g + e, key = e + 8 * g + 4 * hh;
                        float w0 = c0v[e], w1 = c1v[e];
                        if (diag) { w0 = (key <= qq) ? w0 : 0.f; w1 = (key + 32 <= qq) ? w1 : 0.f; }
                        s0[i] *= w0; s1[i] *= w1; ps += s0[i] + s1[i]; } }
                den += ps;
                bf16x8 pf[4];
                pf[0] = pack8(s0[0], s0[1], s0[2], s0[3], s0[4], s0[5], s0[6], s0[7]); pf[1] = pack8(s0[8], s0[9], s0[10], s0[11], s0[12], s0[13], s0[14], s0[15]);
                pf[2] = pack8(s1[0], s1[1], s1[2], s1[3], s1[4], s1[5], s1[6], s1[7]); pf[3] = pack8(s1[8], s1[9], s1[10], s1[11], s1[12], s1[13], s1[14], s1[15]);
#pragma unroll
                for (int ks = 0; ks < 4; ++ks) { s16x4 vlo[4], vhi[4];
#pragma unroll
                    for (int d = 0; d < 4; ++d) { vlo[d] = vtr(vb_ + d * 4096 + ks * 1024); vhi[d] = vtr(vb_ + d * 4096 + ks * 1024 + 512); }
                    __builtin_amdgcn_sched_barrier(0);
#pragma unroll
                    for (int d = 0; d < 4; ++d) { const s16x4 lo = vlo[d], hi = vhi[d];
                        const bf16x8 av = (bf16x8){lo[0], lo[1], lo[2], lo[3], hi[0], hi[1], hi[2], hi[3]};
                        o[d] = MFMA32(av, pf[ks], o[d]); } }
            }
            if (kt + 2 < nkt) asm volatile("s_waitcnt vmcnt(4)" ::: "memory"); else asm volatile("s_waitcnt vmcnt(0)" ::: "memory");
            asm volatile("s_waitcnt lgkmcnt(0)" ::: "memory"); __builtin_amdgcn_s_barrier(); asm volatile("" ::: "memory");
        }
        const float kap = __builtin_amdgcn_exp2f(Ft - Ft0);
        const float dt = (den + __shfl_xor(den, 32)) * kap;
        const float inv = kap / fmaxf(fabsf(dt), 1.f);
        float sm = 0.f;
#pragma unroll
        for (int d = 0; d < 4; ++d)
#pragma unroll
            for (int i = 0; i < 16; ++i) { o[d][i] *= inv; sm += o[d][i]; }
        sm += __shfl_xor(sm, 32);
        const float mu = sm * (1.f / 128.f);
        float vs = 0.f;
#pragma unroll
        for (int d = 0; d < 4; ++d)
#pragma unroll
            for (int i = 0; i < 16; ++i) { const float dlt = o[d][i] - mu; vs += dlt * dlt; }
        vs += __shfl_xor(vs, 32);
        const float rstd = rsqrtf(vs * (1.f / 128.f) + RMS_EPS);
#pragma unroll
        for (int d = 0; d < 4; ++d)
#pragma unroll
            for (int g = 0; g < 4; ++g) { const int ch = h * 128 + 32 * d + 8 * g + 4 * hh; const size_t off = trow * 512 + ch;
                const u32x2 cv = *(const u32x2*)(CONV + off), ov = *(const u32x2*)(OPRE + off); const f32x4 gg = *(const f32x4*)(ng + ch), sk = *(const f32x4*)(skip + ch);
                const float y0 = sigm(bflo(ov.x)) * ((o[d][4 * g] - mu) * rstd * gg[0] + sk[0] * bflo(cv.x)), y1 = sigm(bfhi(ov.x)) * ((o[d][4 * g + 1] - mu) * rstd * gg[1] + sk[1] * bfhi(cv.x));
                const float y2 = sigm(bflo(ov.y)) * ((o[d][4 * g + 2] - mu) * rstd * gg[2] + sk[2] * bflo(cv.y)), y3 = sigm(bfhi(ov.y)) * ((o[d][4 * g + 3] - mu) * rstd * gg[3] + sk[3] * bfhi(cv.y));
                u32x2 w; w.x = cvtpk(y0, y1); w.y = cvtpk(y2, y3); GST(OUTM + off, w); }
    }
#undef ML_DMA
}

template <int N> __device__ __forceinline__ void bitonic_sort_desc(float (&v)[N]) {
#pragma unroll
    for (int k = 2; k <= N; k <<= 1)
#pragma unroll
        for (int j = k >> 1; j > 0; j >>= 1)
#pragma unroll
            for (int i = 0; i < N; ++i) { const int l = i ^ j; if (l > i) { const bool desc = ((i & k) == 0); const float a = v[i], b = v[l], hi = fmaxf(a, b), lo = fminf(a, b); v[i] = desc ? hi : lo; v[l] = desc ? lo : hi; } }
}
__device__ __forceinline__ void top16_merge(float (&a)[16], const float (&b)[16]) {
#pragma unroll
    for (int i = 0; i < 16; ++i) a[i] = fmaxf(a[i], b[15 - i]);
#pragma unroll
    for (int j = 8; j > 0; j >>= 1)
#pragma unroll
        for (int i = 0; i < 16; ++i) { const int l = i ^ j; if (l > i) { const float x = a[i], y = a[l]; a[i] = fmaxf(x, y); a[l] = fminf(x, y); } }
}
constexpr int PE_EIDX = 0, PE_EGATE = 16384, PE_KEYT = 32768;
__device__ __forceinline__ void peer_route(const bf16* PQ, const bf16* KEYB, int* IDX, float* GATE, LAS unsigned char* lds, int bx, int G, int tid) {
    const int lane = tid & 63, wave = __builtin_amdgcn_readfirstlane(tid >> 6), r = lane & 31, hh = lane >> 5;
    LAS unsigned char* keyt = lds + PE_KEYT + (wave * 32 + r) * 32;
    for (int grp = bx; grp < T / 32; grp += G) {
        const int t0 = grp * 32;
        { const int h = wave;
          int rq = r; asm volatile("" : "+v"(rq));
          float top[2][16];
#pragma unroll
          for (int p = 0; p < 2; ++p) {
              bf16x8 qf[4];
              { const bf16* qrow = PQ + (size_t)(t0 + rq) * 1024 + h * 128 + p * 64 + 8 * hh;
#pragma unroll
                for (int s = 0; s < 4; ++s) qf[s] = *(const bf16x8*)(qrow + 16 * s); }
              const bf16* kb = KEYB + ((size_t)(h * 2 + p) * 128 + rq) * 64 + 8 * hh;
              float sv[4][16];
#pragma unroll
              for (int kt = 0; kt < 4; ++kt) { f32x16 acc;
#pragma unroll
                  for (int i = 0; i < 16; ++i) acc[i] = 0.f;
#pragma unroll
                  for (int s = 0; s < 4; ++s) { const bf16x8 a = *(const bf16x8*)(kb + (size_t)(32 * kt) * 64 + 16 * s); acc = MFMA32(a, qf[s], acc); }
#pragma unroll
                  for (int i = 0; i < 16; ++i) { const unsigned key = (unsigned)(32 * kt + (i & 3) + 8 * (i >> 2)) + 4u * (unsigned)hh; sv[kt][i] = __uint_as_float((__float_as_uint(acc[i]) & ~127u) | key); } }
              bitonic_sort_desc<16>(sv[0]); bitonic_sort_desc<16>(sv[1]); bitonic_sort_desc<16>(sv[2]); bitonic_sort_desc<16>(sv[3]);
              top16_merge(sv[0], sv[1]); top16_merge(sv[2], sv[3]); top16_merge(sv[0], sv[2]);
              float pr[16];
#pragma unroll
              for (int i = 0; i < 16; ++i) { auto r32 = __builtin_amdgcn_permlane32_swap(__float_as_uint(sv[0][i]), __float_as_uint(sv[0][i]), false, false); pr[i] = __uint_as_float(hh ? r32[0] : r32[1]); }
              top16_merge(sv[0], pr);
#pragma unroll
              for (int i = 0; i < 16; ++i) top[p][i] = sv[0][i];
          }
          if (hh == 0) {
#pragma unroll
              for (int i = 0; i < 16; ++i) { keyt[i] = (unsigned char)(__float_as_uint(top[0][i]) & 127u); keyt[16 + i] = (unsigned char)(__float_as_uint(top[1][i]) & 127u); } }
          float cs[4][16];
#define PSUM(a, b) __uint_as_float((__float_as_uint(top[0][a] + top[1][b]) & ~255u) | (unsigned)((a) * 16 + (b)))
#pragma unroll
          for (int b2 = 0; b2 < 16; ++b2) cs[0][b2] = PSUM(0, b2);
#pragma unroll
          for (int b2 = 0; b2 < 8; ++b2) cs[1][b2] = PSUM(1, b2);
#pragma unroll
          for (int a2 = 8; a2 < 16; ++a2) cs[1][a2] = PSUM(a2, 0);
#pragma unroll
          for (int b2 = 0; b2 < 5; ++b2) cs[2][b2] = PSUM(2, b2);
#pragma unroll
          for (int b2 = 0; b2 < 4; ++b2) cs[2][5 + b2] = PSUM(3, b2);
#pragma unroll
          for (int b2 = 0; b2 < 3; ++b2) cs[2][9 + b2] = PSUM(4, b2);
          cs[2][12] = PSUM(5, 0); cs[2][13] = PSUM(5, 1); cs[2][14] = PSUM(6, 0); cs[2][15] = PSUM(6, 1);
          cs[3][0] = PSUM(7, 0); cs[3][1] = PSUM(7, 1);
#undef PSUM
#pragma unroll
          for (int i = 2; i < 16; ++i) cs[3][i] = -3.0e38f;
          bitonic_sort_desc<16>(cs[0]); bitonic_sort_desc<16>(cs[1]); bitonic_sort_desc<16>(cs[2]); bitonic_sort_desc<16>(cs[3]);
          top16_merge(cs[0], cs[1]); top16_merge(cs[2], cs[3]); top16_merge(cs[0], cs[2]);
          LDS_WAIT();
          float ev[16], den = 0.f; const float mx = __uint_as_float(__float_as_uint(cs[0][0]) & ~255u);
#pragma unroll
          for (int k = 0; k < 16; ++k) { ev[k] = __expf(__uint_as_float(__float_as_uint(cs[0][k]) & ~255u) - mx); den += ev[k]; }
          const float rden = 1.f / den;
          if (hh == 0) {
#pragma unroll
              for (int k = 0; k < 16; ++k) { const unsigned code = __float_as_uint(cs[0][k]) & 255u; const int e = (int)keyt[code >> 4] * 128 + (int)keyt[16 + (code & 15u)];
                  GST(IDX + (size_t)(t0 + r) * 128 + h * 16 + k, e); GST(GATE + (size_t)(t0 + r) * 128 + h * 16 + k, ev[k] * rden); } }
        }
    }
}
__device__ __forceinline__ void peer_partition(const unsigned* xc_cnt, volatile LAS unsigned* MISC, int bx, int G, int& vx, int& rank, int& nb) {
    bool use_xcc = MK_ONE_LAUNCH != 0; unsigned mine = 0u; const unsigned myx = MISC[13];
    if (use_xcc) { unsigned sum = 0u;
#pragma unroll
        for (unsigned j = 0; j < 8; ++j) { const unsigned c = __hip_atomic_load(xc_cnt + 64 * j, __ATOMIC_RELAXED, __HIP_MEMORY_SCOPE_AGENT); use_xcc = use_xcc && (c > 0u); sum += c; mine = (j == myx) ? c : mine; }
        use_xcc = use_xcc && (sum == (unsigned)G); }
    if (use_xcc) { vx = (int)myx; rank = (int)MISC[12]; nb = (int)mine; } else { vx = bx & 7; rank = bx >> 3; nb = (G - vx + 7) >> 3; }
    vx = __builtin_amdgcn_readfirstlane(vx); rank = __builtin_amdgcn_readfirstlane(rank); nb = __builtin_amdgcn_readfirstlane(nb);
}
__device__ __forceinline__ void peer_u_i8(const unsigned char* H8, const float* XS, const int* IDX, const unsigned char* U8, const f32x2v* SC2, float* ACT, LAS float* wscr, int vx, int rank, int nb, int tid) {
    const int lane = tid & 63, wave = __builtin_amdgcn_readfirstlane(tid >> 6), g4 = lane >> 4, c16 = lane & 15;
    const int tstride = nb * 8;
    LAS int* clist = (LAS int*)wscr;
    LAS unsigned char* xs = (LAS unsigned char*)(wscr + 512);
    const unsigned long long lt = (1ull << lane) - 1ull;
    const unsigned char* ubase = U8 + 16 * c16;
    int ni[8];
    { const int tb = rank * 8 + wave;
#pragma unroll
      for (int j = 0; j < 4; ++j) { const int tj = tb + j * tstride; const bool ok = tj < T; ni[2 * j] = ok ? IDX[(size_t)tj * 128 + lane] : 0x7fffffff; ni[2 * j + 1] = ok ? IDX[(size_t)tj * 128 + 64 + lane] : 0x7fffffff; } }
    for (int tb = rank * 8 + wave; tb < T; tb += 4 * tstride) {
        int ntot = 0;
#pragma unroll
        for (int j = 0; j < 4; ++j) { const int e0 = ni[2 * j], e1 = ni[2 * j + 1]; const bool f0 = (e0 >> 11) == vx, f1 = (e1 >> 11) == vx;
            const unsigned long long m0 = __ballot(f0), m1 = __ballot(f1); const int n0 = __popcll(m0);
            if (f0) clist[ntot + __popcll(m0 & lt)] = (j << 21) | (e0 << 7) | lane;
            if (f1) clist[ntot + n0 + __popcll(m1 & lt)] = (j << 21) | (e1 << 7) | (64 + lane);
            ntot += n0 + __popcll(m1); }
        v4u xr[4]; float sx[4]; int sxl[4];
#pragma unroll
        for (int j = 0; j < 4; ++j) { const int tj = tb + j * tstride, tl = tj < T ? tj : tb; xr[j] = *(const v4u*)(H8 + (size_t)tl * 1024 + 16 * lane); sx[j] = XS[tl]; }
        { const int tn = tb + 4 * tstride;
#pragma unroll
          for (int j = 0; j < 4; ++j) { const int tj = tn + j * tstride; const bool ok = tj < T; ni[2 * j] = ok ? IDX[(size_t)tj * 128 + lane] : 0x7fffffff; ni[2 * j + 1] = ok ? IDX[(size_t)tj * 128 + 64 + lane] : 0x7fffffff; } }
        if (ntot == 0) continue;
#pragma unroll
        for (int j = 0; j < 4; ++j) { *(LAS v4u*)(xs + j * 1024 + 16 * lane) = xr[j];
            int s = __builtin_amdgcn_sdot4((int)xr[j].x, 0x01010101, 0, false); s = __builtin_amdgcn_sdot4((int)xr[j].y, 0x01010101, s, false);
            s = __builtin_amdgcn_sdot4((int)xr[j].z, 0x01010101, s, false); s = __builtin_amdgcn_sdot4((int)xr[j].w, 0x01010101, s, false);
            s = (lane & 16) ? 0 : s;
            s += __builtin_amdgcn_update_dpp(0, s, 0x128, 0xf, 0xf, false); s += __builtin_amdgcn_update_dpp(0, s, 0x124, 0xf, 0xf, false);
            s += __builtin_amdgcn_update_dpp(0, s, 0x122, 0xf, 0xf, false); s += __builtin_amdgcn_update_dpp(0, s, 0x121, 0xf, 0xf, false);
            sxl[j] = __builtin_amdgcn_readlane(s, 0) + __builtin_amdgcn_readlane(s, 32); }
        LDS_WAIT();
        const int last = ntot - 1, nit = (ntot + 3) >> 2, nit4 = (nit + 3) >> 2;
        v4u ub[4][2]; f32x2v us[4]; int up[4];
#pragma unroll
        for (int k = 0; k < 3; ++k) { const int p = min(4 * k + g4, last); const int pk = clist[p]; up[k] = pk; const unsigned eo = (unsigned)((pk >> 7) & 16383) * 512u; us[k] = SC2[(pk >> 7) & 16383];
#pragma unroll
            for (int jj = 0; jj < 2; ++jj) ub[k][jj] = *(const v4u*)(ubase + eo + 256 * jj);
            __builtin_amdgcn_sched_barrier(0); }
        int dsel = 0, psel = 0; f32x2v ssel = (f32x2v){0.f, 0.f}; bool vsel = false;
#pragma unroll 1
        for (int o = 0; o < nit4; ++o) {
#pragma unroll
            for (int k = 0; k < 4; ++k) {
                const int i = 4 * o + k;
                { const int p = min(4 * (i + 3) + g4, last); const int pk = clist[p]; up[(k + 3) & 3] = pk; const unsigned eo = (unsigned)((pk >> 7) & 16383) * 512u; us[(k + 3) & 3] = SC2[(pk >> 7) & 16383];
#pragma unroll
                  for (int jj = 0; jj < 2; ++jj) ub[(k + 3) & 3][jj] = *(const v4u*)(ubase + eo + 256 * jj); }
                const LAS unsigned char* xp = xs + (up[k] >> 21) * 1024 + 16 * c16;
                v4u xq[4];
#pragma unroll
                for (int jj = 0; jj < 4; ++jj) xq[jj] = *(const LAS v4u*)(xp + 256 * jj);
                int a0 = 0, a1 = 0, h0 = 0, h1 = 0;
#pragma unroll
                for (int jj = 0; jj < 2; ++jj) { const v4u w = ub[k][jj], xl = xq[2 * jj], xh = xq[2 * jj + 1];
                    a0 = __builtin_amdgcn_sdot4((int)(w.x & 0x0f0f0f0fu), (int)xl.x, a0, false); h0 = __builtin_amdgcn_sdot4((int)(w.x & 0xf0f0f0f0u), (int)xh.x, h0, false);
                    a1 = __builtin_amdgcn_sdot4((int)(w.y & 0x0f0f0f0fu), (int)xl.y, a1, false); h1 = __builtin_amdgcn_sdot4((int)(w.y & 0xf0f0f0f0u), (int)xh.y, h1, false);
                    a0 = __builtin_amdgcn_sdot4((int)(w.z & 0x0f0f0f0fu), (int)xl.z, a0, false); h0 = __builtin_amdgcn_sdot4((int)(w.z & 0xf0f0f0f0u), (int)xh.z, h0, false);
                    a1 = __builtin_amdgcn_sdot4((int)(w.w & 0x0f0f0f0fu), (int)xl.w, a1, false); h1 = __builtin_amdgcn_sdot4((int)(w.w & 0xf0f0f0f0u), (int)xh.w, h1, false); }
                int d = (a0 + a1) + ((h0 + h1) >> 4);
                d += __builtin_amdgcn_update_dpp(0, d, 0x128, 0xf, 0xf, false); d += __builtin_amdgcn_update_dpp(0, d, 0x124, 0xf, 0xf, false);
                d += __builtin_amdgcn_update_dpp(0, d, 0x122, 0xf, 0xf, false); d += __builtin_amdgcn_update_dpp(0, d, 0x121, 0xf, 0xf, false);
                if ((i & 15) == c16) { dsel = d; ssel = us[k]; psel = up[k]; vsel = 4 * i + g4 <= last; }
                if (k == 3 && ((o & 3) == 3 || o == nit4 - 1)) {
                    if (vsel) { const int j = psel >> 21; const float sxj = j == 0 ? sx[0] : j == 1 ? sx[1] : j == 2 ? sx[2] : sx[3]; const int slj = j == 0 ? sxl[0] : j == 1 ? sxl[1] : j == 2 ? sxl[2] : sxl[3];
                        GST(ACT + (size_t)(tb + j * tstride) * 128 + (psel & 127), gelu_erf((float)(dsel - 8 * slj) * sxj * ssel.x) * ssel.y); }
                    vsel = false; }
            }
        }
        LDS_WAIT();
    }
}
__device__ __forceinline__ void peer_v(const int* IDX, const float* ACT, const float* GATE, const unsigned char* V8, const float* gate2, const bf16* Xin, bf16* Xout, LAS float* wscr,
                                       int vx, int rank, int nb, int tid) {
    const int lane = tid & 63, wave = __builtin_amdgcn_readfirstlane(tid >> 6), g8 = lane >> 3, c8 = lane & 7;
    const int tstride = nb * 16;
    LAS int* wl = (LAS int*)wscr; LAS unsigned char* wqb = (LAS unsigned char*)(wscr + 128);
    const unsigned char* vbase = V8 + (size_t)(vx >> 1) * (2 * MiB); const int voff = 16 * c8;
    const int col = 256 * (vx >> 1) + 32 * c8;
    const int wqo0 = (lane & 7) * 16 + (lane >> 3), wqo1 = wqo0 + 8;
    const int t0 = (rank * 8 + wave) * 2 + (vx & 1);
    if (t0 >= T) return;
    const int tlast = t0 + ((T - 1 - t0) / tstride) * tstride;
#define PV_STAGE(tt, I0, I1, A0, A1, VV, WQ4, SW) { \
        float am_ = fmaxf(fabsf(A0), fabsf(A1));   \
        am_ = fmaxf(am_, __uint_as_float(__builtin_amdgcn_update_dpp(0, __float_as_uint(am_), 0x128, 0xf, 0xf, false))); am_ = fmaxf(am_, __uint_as_float(__builtin_amdgcn_update_dpp(0, __float_as_uint(am_), 0x124, 0xf, 0xf, false))); \
        am_ = fmaxf(am_, __uint_as_float(__builtin_amdgcn_update_dpp(0, __float_as_uint(am_), 0x122, 0xf, 0xf, false))); am_ = fmaxf(am_, __uint_as_float(__builtin_amdgcn_update_dpp(0, __float_as_uint(am_), 0x121, 0xf, 0xf, false))); \
        am_ = fmaxf(fmaxf(__uint_as_float(__builtin_amdgcn_readlane(__float_as_uint(am_), 0)), __uint_as_float(__builtin_amdgcn_readlane(__float_as_uint(am_), 16))), \
                    fmaxf(__uint_as_float(__builtin_amdgcn_readlane(__float_as_uint(am_), 32)), __uint_as_float(__builtin_amdgcn_readlane(__float_as_uint(am_), 48)))); \
        const float inv_ = am_ > 0.f ? 127.f / am_ : 0.f; SW = am_ * (1.f / 127.f); \
        wl[lane] = I0; wl[64 + lane] = I1; wqb[wqo0] = (unsigned char)((int)rintf(A0 * inv_) & 255); wqb[wqo1] = (unsigned char)((int)rintf(A1 * inv_) & 255); \
        LDS_WAIT(); \
        _Pragma("unroll") for (int i_ = 0; i_ < 16; ++i_) { const int e_ = wl[8 * i_ + g8]; VV[i_] = *(const v4u*)(vbase + (size_t)(unsigned)(e_ * 128 + voff)); } \
        WQ4 = *(const LAS v4u*)(wqb + g8 * 16); LDS_WAIT(); }
#define PV_META(tt, I0, I1, A0, A1) { const size_t o_ = (size_t)(tt) * 128; I0 = IDX[o_ + lane]; I1 = IDX[o_ + 64 + lane]; A0 = ACT[o_ + lane] * GATE[o_ + lane]; A1 = ACT[o_ + 64 + lane] * GATE[o_ + 64 + lane]; }
    int i0, i1, j0, j1; float a0, a1, b0, b1;
    v4u vvA[16], vvB[16], wq4A, wq4B; float swA, swB;
    PV_META(t0, i0, i1, a0, a1);
    PV_STAGE(t0, i0, i1, a0, a1, vvA, wq4A, swA);
    { const int t1 = min(t0 + tstride, tlast); PV_META(t1, i0, i1, a0, a1); }
    auto body = [&](const int t, const v4u (&vv)[16], const v4u& wq4, const float& sw, v4u (&vvn)[16], v4u& wq4n, float& swn) __attribute__((always_inline)) {
        const int b = t >> 11, tn = min(t + tstride, tlast), tn2 = min(t + 2 * tstride, tlast);
        PV_META(tn2, j0, j1, b0, b1);
        const u32x2 xw1 = *(const u32x2*)(Xin + (size_t)t * 1024 + col + 4 * g8); const f32x4 g21 = *(const f32x4*)(gate2 + (size_t)b * NADA + col + 4 * g8);
        PV_STAGE(tn, i0, i1, a0, a1, vvn, wq4n, swn);
        i0 = j0; i1 = j1; a0 = b0; a1 = b1;
        int accA[16], accB[16], accw = 0;
#pragma unroll
        for (int i = 0; i < 16; ++i) { accA[i] = 0; accB[i] = 0; }
#pragma unroll
        for (int q = 0; q < 4; ++q) { const int wq = (int)(q == 0 ? wq4.x : q == 1 ? wq4.y : q == 2 ? wq4.z : wq4.w);
            accw = __builtin_amdgcn_sdot4(wq, 0x01010101, accw, false);
#pragma unroll
            for (int d = 0; d < 4; ++d) {
                const unsigned ra = d == 0 ? vv[4 * q].x : d == 1 ? vv[4 * q].y : d == 2 ? vv[4 * q].z : vv[4 * q].w, rb = d == 0 ? vv[4 * q + 1].x : d == 1 ? vv[4 * q + 1].y : d == 2 ? vv[4 * q + 1].z : vv[4 * q + 1].w;
                const unsigned rc = d == 0 ? vv[4 * q + 2].x : d == 1 ? vv[4 * q + 2].y : d == 2 ? vv[4 * q + 2].z : vv[4 * q + 2].w, rd = d == 0 ? vv[4 * q + 3].x : d == 1 ? vv[4 * q + 3].y : d == 2 ? vv[4 * q + 3].z : vv[4 * q + 3].w;
                const unsigned ab_lo = __builtin_amdgcn_perm(rb, ra, 0x05010400u), ab_hi = __builtin_amdgcn_perm(rb, ra, 0x07030602u), cd_lo = __builtin_amdgcn_perm(rd, rc, 0x05010400u), cd_hi = __builtin_amdgcn_perm(rd, rc, 0x07030602u);
                const unsigned t0 = __builtin_amdgcn_perm(cd_lo, ab_lo, 0x05040100u), t1 = __builtin_amdgcn_perm(cd_lo, ab_lo, 0x07060302u), t2 = __builtin_amdgcn_perm(cd_hi, ab_hi, 0x05040100u), t3 = __builtin_amdgcn_perm(cd_hi, ab_hi, 0x07060302u);
                accA[4 * d + 0] = __builtin_amdgcn_sdot4((int)t0, wq, accA[4 * d + 0], false); accB[4 * d + 0] = __builtin_amdgcn_sdot4((int)(t0 & 0x0f0f0f0fu), wq, accB[4 * d + 0], false);
                accA[4 * d + 1] = __builtin_amdgcn_sdot4((int)t1, wq, accA[4 * d + 1], false); accB[4 * d + 1] = __builtin_amdgcn_sdot4((int)(t1 & 0x0f0f0f0fu), wq, accB[4 * d + 1], false);
                accA[4 * d + 2] = __builtin_amdgcn_sdot4((int)t2, wq, accA[4 * d + 2], false); accB[4 * d + 2] = __builtin_amdgcn_sdot4((int)(t2 & 0x0f0f0f0fu), wq, accB[4 * d + 2], false);
                accA[4 * d + 3] = __builtin_amdgcn_sdot4((int)t3, wq, accA[4 * d + 3], false); accB[4 * d + 3] = __builtin_amdgcn_sdot4((int)(t3 & 0x0f0f0f0fu), wq, accB[4 * d + 3], false); } }
#define PV_SW16(X, Y) { auto r_ = __builtin_amdgcn_permlane16_swap((unsigned)(X), (unsigned)(Y), false, false); X = (int)(r_[0] + r_[1]); }
#define PV_SW32(X, Y) { auto r_ = __builtin_amdgcn_permlane32_swap((unsigned)(X), (unsigned)(Y), false, false); X = (int)(r_[0] + r_[1]); }
#pragma unroll
        for (int hh = 0; hh < 2; ++hh)
#pragma unroll
            for (int mm = 0; mm < 4; ++mm) { const int mi = 8 * hh + mm; PV_SW16(accA[mi], accA[mi + 4]); PV_SW16(accB[mi], accB[mi + 4]); }
#pragma unroll
        for (int mi = 0; mi < 4; ++mi) { PV_SW32(accA[mi], accA[mi + 8]); PV_SW32(accB[mi], accB[mi + 8]); }
        { const bool b3 = (lane & 8) != 0;
#pragma unroll
          for (int mi = 0; mi < 2; ++mi) {
              { const int keep = b3 ? accA[mi + 2] : accA[mi], send = b3 ? accA[mi] : accA[mi + 2]; accA[mi] = keep + __builtin_amdgcn_update_dpp(0, send, 0x128, 0xf, 0xf, false); }
              { const int keep = b3 ? accB[mi + 2] : accB[mi], send = b3 ? accB[mi] : accB[mi + 2]; accB[mi] = keep + __builtin_amdgcn_update_dpp(0, send, 0x128, 0xf, 0xf, false); } } }
        accw += __builtin_amdgcn_update_dpp(0, accw, 0x128, 0xf, 0xf, false); PV_SW16(accw, accw); PV_SW32(accw, accw);
#undef PV_SW16
#undef PV_SW32
        { const int off8 = 8 * accw;
          const int s0 = accB[0] - off8, s1 = (accA[0] - accB[0]) >> 4, s2 = accB[1] - off8, s3 = (accA[1] - accB[1]) >> 4;
          const f32x4 xo = (f32x4){bflo(xw1.x), bfhi(xw1.x), bflo(xw1.y), bfhi(xw1.y)} + g21 * ((f32x4){(float)s0, (float)s1, (float)s2, (float)s3} * sw);
          u32x2 w; w.x = pk2(xo[0], xo[1]); w.y = pk2(xo[2], xo[3]); GSTF(Xout + (size_t)t * 1024 + col + 4 * g8, w); }
    };
    for (int t = t0; t < T; t += 2 * tstride) {
        body(t, vvA, wq4A, swA, vvB, wq4B, swB);
        if (t + tstride >= T) break;
        body(t + tstride, vvB, wq4B, swB, vvA, wq4A, swA);
    }
#undef PV_STAGE
#undef PV_META
}

constexpr int PH_PER_LAYER = 12, N_PHASES = 1 + DEPTH * PH_PER_LAYER + 1;
struct Args { const void* in[N_INPUTS]; float* out; unsigned char* ws; int ph_lo, ph_hi; };
static_assert(sizeof(Args) == N_INPUTS * 8 + 24, "Args has no padding");

constexpr int PTAB_OFF = LDSCTL_OFF + 1024;
__device__ __forceinline__ unsigned char* getp(LAS unsigned char* lds, int i) {
    asm volatile("" ::: "memory");
    const u32x2 v = *(volatile LAS u32x2*)(lds + PTAB_OFF + 8 * i);
    const unsigned lo = __builtin_amdgcn_readfirstlane(v.x), hi = __builtin_amdgcn_readfirstlane(v.y);
    GAS unsigned char* g = (GAS unsigned char*)(((unsigned long long)hi << 32) | lo);
    return (unsigned char*)g;
}
#define INP(i) ((const float*)getp(lds, (i)))
#define WSB() getp(lds, 30)

#define IN(k) (lo <= (k) && (k) < hi)
#define SEAM(k) do { if (MK_ONE_LAUNCH && IN(k) && IN((k) + 1)) { XcdBarrier b_; b_.bar = (unsigned*)(WSB() + WS_CTL) + CW_BAR; b_.x = xb_xcc_id(); b_.st = MISC + 8; REPS(11) xcd_barrier(b_, (wave_s << 6) | (int)__lane_id()); } } while (0)
#define PH_BEGIN(lv) int tidq; asm volatile("v_mbcnt_lo_u32_b32 %0, -1, 0\n\tv_mbcnt_hi_u32_b32 %0, -1, %0" : "=v"(tidq)); tidq |= wave_s << 6;     \
    asm volatile("" : "+v"(tidq)); const int lane = tidq & 63, wave = __builtin_amdgcn_readfirstlane(tidq >> 6); \
    int G = gridDim.x, bx = blockIdx.x, l = (lv); asm volatile("" : "+s"(G), "+s"(bx), "+s"(l)); const int gw = bx * NWAVES + wave, NGW = G * NWAVES; \
    unsigned char* ws = WSB(); LAS float* wscr = (LAS float*)(lds + RING_OFF + wave * 16384); (void)lane; (void)gw; (void)NGW; (void)ws; (void)wscr; (void)l


constexpr int PI_W = 4512, PI_K = 512, PI_U = 2048, PI_V = 2048, PI_TOTAL = PI_W + PI_K + PI_U + PI_V;
template <int NR> __device__ __forceinline__ void prep_rows_i8(const float* src, size_t src_stride, unsigned char* dst, size_t dst_stride, float* scale_slot  , int lane) {
    f32x4 v[NR][4];
#pragma unroll
    for (int rr = 0; rr < NR; ++rr) { const f32x4* s = (const f32x4*)(src + rr * src_stride) + lane * 4;
#pragma unroll
        for (int j = 0; j < 4; ++j) v[rr][j] = s[j]; }
#pragma unroll
    for (int rr = 0; rr < NR; ++rr) {
        float am = 0.f;
#pragma unroll
        for (int j = 0; j < 4; ++j) am = fmaxf(fmaxf(am, fmaxf(fabsf(v[rr][j][0]), fabsf(v[rr][j][1]))), fmaxf(fabsf(v[rr][j][2]), fabsf(v[rr][j][3])));
#pragma unroll
        for (int o = 1; o < 64; o <<= 1) am = fmaxf(am, __shfl_xor(am, o));
        const float inv = am > 0.f ? 127.f / am : 0.f;
#define Q4(x) ((unsigned)((int)rintf((x)[0] * inv) & 255) | ((unsigned)((int)rintf((x)[1] * inv) & 255) << 8) | ((unsigned)((int)rintf((x)[2] * inv) & 255) << 16) | ((unsigned)((int)rintf((x)[3] * inv) & 255) << 24))
        v4u o; o.x = Q4(v[rr][0]); o.y = Q4(v[rr][1]); o.z = Q4(v[rr][2]); o.w = Q4(v[rr][3]);
#undef Q4
        *(v4u*)(dst + rr * dst_stride) = o;
        if (lane == 0) scale_slot[2 * rr] = am * (1.f / 127.f);
    }
}
template <int NR> __device__ __forceinline__ void prep_rows_i4(const float* src, size_t src_stride, unsigned char* dst, size_t dst_stride, float* scale_slot  , int lane) {
    f32x4 v[NR][4];
#pragma unroll
    for (int rr = 0; rr < NR; ++rr) { const f32x4* s = (const f32x4*)(src + rr * src_stride) + lane * 4;
#pragma unroll
        for (int j = 0; j < 4; ++j) v[rr][j] = s[j]; }
#pragma unroll
    for (int rr = 0; rr < NR; ++rr) {
        float am = 0.f, ss = 0.f;
#pragma unroll
        for (int j = 0; j < 4; ++j) { am = fmaxf(fmaxf(am, fmaxf(fabsf(v[rr][j][0]), fabsf(v[rr][j][1]))), fmaxf(fabsf(v[rr][j][2]), fabsf(v[rr][j][3]))); ss += dot4(v[rr][j], v[rr][j]); }
#pragma unroll
        for (int o = 1; o < 64; o <<= 1) { am = fmaxf(am, __shfl_xor(am, o)); ss += __shfl_xor(ss, o); }
        am = fminf(am, 2.7f * sqrtf(ss * (1.f / 1024.f)));
        const float inv = am > 0.f ? 7.f / am : 0.f;
#define N4(x) ((unsigned)((int)fminf(fmaxf(rintf((x) * inv), -7.f), 7.f) + 8))
#define H4(x) ((unsigned)((int)fminf(fmaxf(rintf((x) * inv), -7.f), 7.f)) & 15u)
#define B4(x, y) (N4(x) | (H4(y) << 4))
        u32x2 o;
        o.x = B4(v[rr][0][0], v[rr][0][1]) | (B4(v[rr][0][2], v[rr][0][3]) << 8) | (B4(v[rr][1][0], v[rr][1][1]) << 16) | (B4(v[rr][1][2], v[rr][1][3]) << 24);
        o.y = B4(v[rr][2][0], v[rr][2][1]) | (B4(v[rr][2][2], v[rr][2][3]) << 8) | (B4(v[rr][3][0], v[rr][3][1]) << 16) | (B4(v[rr][3][2], v[rr][3][3]) << 24);
#undef B4
#undef H4
#undef N4
        *(u32x2*)(dst + rr * dst_stride) = o;
        if (lane == 0) scale_slot[2 * rr] = am * (1.f / 7.f);
    }
}
template <int NR> __device__ __forceinline__ void prep_rows_u4(const float* src, size_t src_stride, unsigned char* dst, size_t dst_stride, float* scale_slot  , int lane) {
    f32x4 v[NR][4];
    const int c = 512 * (lane >> 5) + 8 * (lane & 31);
#pragma unroll
    for (int rr = 0; rr < NR; ++rr) { const float* s = src + rr * src_stride + c;
        v[rr][0] = *(const f32x4*)s; v[rr][1] = *(const f32x4*)(s + 4); v[rr][2] = *(const f32x4*)(s + 256); v[rr][3] = *(const f32x4*)(s + 260); }
#pragma unroll
    for (int rr = 0; rr < NR; ++rr) {
        float am = 0.f, ss = 0.f;
#pragma unroll
        for (int j = 0; j < 4; ++j) { am = fmaxf(fmaxf(am, fmaxf(fabsf(v[rr][j][0]), fabsf(v[rr][j][1]))), fmaxf(fabsf(v[rr][j][2]), fabsf(v[rr][j][3]))); ss += dot4(v[rr][j], v[rr][j]); }
#pragma unroll
        for (int o = 1; o < 64; o <<= 1) { am = fmaxf(am, __shfl_xor(am, o)); ss += __shfl_xor(ss, o); }
        am = fminf(am, 2.7f * sqrtf(ss * (1.f / 1024.f)));
        const float inv = am > 0.f ? 7.f / am : 0.f;
#define N4(x) ((unsigned)((int)fminf(fmaxf(rintf((x) * inv), -7.f), 7.f) + 8))
#define H4(x) ((unsigned)((int)fminf(fmaxf(rintf((x) * inv), -7.f), 7.f)) & 15u)
#define B4(x, y) (N4(x) | (H4(y) << 4))
        u32x2 o;
        o.x = B4(v[rr][0][0], v[rr][2][0]) | (B4(v[rr][0][1], v[rr][2][1]) << 8) | (B4(v[rr][0][2], v[rr][2][2]) << 16) | (B4(v[rr][0][3], v[rr][2][3]) << 24);
        o.y = B4(v[rr][1][0], v[rr][3][0]) | (B4(v[rr][1][1], v[rr][3][1]) << 8) | (B4(v[rr][1][2], v[rr][3][2]) << 16) | (B4(v[rr][1][3], v[rr][3][3]) << 24);
#undef B4
#undef H4
#undef N4
        *(u32x2*)(dst + rr * dst_stride) = o;
        if (lane == 0) scale_slot[2 * rr] = am * (1.f / 7.f);
    }
}
__device__ __forceinline__ void prep_item(LAS unsigned char* lds, unsigned char* ws, LAS float* wscr, int l, int r, int lane) {
    constexpr int I_WIN_ = 16 * 136, I_WQ_ = 12 * 24, I_WKV_ = 4 * 32, I_WA_ = 8 * 32, I_WM_ = 8 * 32, I_WO_ = 16 * 32, I_PW_ = 16 * 32, I_WQK_ = 8 * 32, I_WV_ = 8 * 16;
    static_assert(I_WIN_ + I_WQ_ + I_WKV_ + I_WA_ + I_WM_ + I_WO_ + I_PW_ + I_WQK_ + I_WV_ == PI_W, "weight items");
    unsigned char* wl = ws + WS_W + (size_t)l * W_LAYER;
    if (r < PI_W) {
        if (r < I_WIN_) { const GetWin g{INP(I_WIN) + (size_t)l * D * 4136}; prep_tile(g, (bf16*)(wl + WO_WIN), 1024, 64 * (r / 136), 32 * (r % 136), wscr, lane); return; } r -= I_WIN_;
        if (r < I_WQ_) { const GetWq g{INP(I_WQUP) + (size_t)l * 768 * 768, INP(I_QNG) + l * 768}; prep_tile(g, (bf16*)(wl + WO_WQ), 768, 64 * (r / 24), 32 * (r % 24), wscr, lane); return; } r -= I_WQ_;
        if (r < I_WKV_) { const GetWkv g{INP(I_WKVUP) + (size_t)l * 256 * 1024, INP(I_KVNG) + l * 256}; prep_tile(g, (bf16*)(wl + WO_WKV), 256, 64 * (r / 32), 32 * (r % 32), wscr, lane); return; } r -= I_WKV_;
        if (r < I_WA_) { const GetPlain g{INP(I_WBA) + (size_t)l * 512 * 1024, 1024}; prep_tile(g, (bf16*)(wl + WO_WA), 512, 64 * (r / 32), 32 * (r % 32), wscr, lane); return; } r -= I_WA_;
        if (r < I_WM_) { const GetPlain g{INP(I_WBM) + (size_t)l * 512 * 1024, 1024}; prep_tile(g, (bf16*)(wl + WO_WM), 512, 64 * (r / 32), 32 * (r % 32), wscr, lane); return; } r -= I_WM_;
        if (r < I_WO_) { const GetPlain g{INP(I_WOUT) + (size_t)l * 1024 * 1024, 1024}; prep_tile(g, (bf16*)(wl + WO_WO), 1024, 64 * (r / 32), 32 * (r % 32), wscr, lane); return; } r -= I_WO_;
        if (r < I_PW_) { const GetPlain g{INP(I_PWQ) + (size_t)l * 1024 * 1024, 1024}; prep_tile(g, (bf16*)(wl + WO_PWQ), 1024, 64 * (r / 32), 32 * (r % 32), wscr, lane); return; } r -= I_PW_;
        if (r < I_WQK_) { const GetWqk g{INP(I_WQM) + (size_t)l * 65536, INP(I_WKM) + (size_t)l * 65536}; prep_tile(g, (bf16*)(wl + WO_WQK), 512, 64 * (r / 32), 32 * (r % 32), wscr, lane); return; } r -= I_WQK_;
        { const GetWv g{INP(I_WVM) + (size_t)l * 65536}; prep_tile(g, (bf16*)(wl + WO_WV), 512, 64 * (r / 16), 32 * (r % 16), wscr, lane); }
        return; }
    r -= PI_W;
    if (r < PI_K) { const int o = (r * 64 + lane) * 4;
        const f32x4 v = *(const f32x4*)(INP(I_PKEYS) + (size_t)l * 131072 + o); u32x2 w; w.x = pk2(v[0], v[1]); w.y = pk2(v[2], v[3]);
        *(u32x2*)(wl + WO_KEYB + (size_t)o * 2) = w; return; }
    r -= PI_K;
    float* sc2 = (float*)(ws + WS_USC);
    if (r < PI_U) { const float* pu = INP(I_PU) + (size_t)l * 16777216;
        for (int rr = 0; rr < 8; rr += 8) { const int er = r * 8 + rr; prep_rows_u4<8>(pu + (size_t)er * 1024, 1024, ws + WS_U8 + (size_t)l * 32 * MiB + (size_t)er * 512 + 8 * lane, 512, sc2 + 2 * (l * 16384 + er), lane); }
        return; }
    r -= PI_U;
    { const float* pv = INP(I_PV) + (size_t)l * 16777216;
      for (int rr = 0; rr < 8; rr += 8) { const int er = r * 8 + rr;
          prep_rows_i4<8>(pv + (size_t)er * 1024, 1024, ws + WS_V8 + (size_t)l * 32 * MiB + (size_t)(lane >> 4) * (2 * MiB) + (size_t)er * 128 + 8 * (lane & 15), 128, sc2 + 2 * (l * 16384 + er) + 1, lane); } }
}
template <int lv> __device__ __forceinline__ void layer_phases(LAS unsigned char* lds, volatile LAS unsigned* MISC, const int lo, const int hi, const int wave_s) {
        const int P = 1 + lv * PH_PER_LAYER;
#define WL() (ws + WS_W + (size_t)l * W_LAYER)
#define ADAL() ((const float*)(ws + ADA_OFF) + (size_t)l * 8 * NADA)
#define XA() WSP(bf16, WS_X)
#define XB() (WSP(bf16, WS_X) + (size_t)T * D)
#define WSP(type, off) ((type*)(ws + (off)))
        if (IN(P + 0)) REPS(1) { PH_BEGIN(lv);
            if (lv == 0) rowpass_norm_mod<false>(INP(I_X), INP(I_N1G) + l * D, ADAL() + 0, ADAL() + 1024, WSP(bf16, WS_H), gw, NGW, lane);
            else rowpass_norm_mod<true>(XB(), INP(I_N1G) + l * D, ADAL() + 0, ADAL() + 1024, WSP(bf16, WS_H), gw, NGW, lane); }
        SEAM(P + 0);
        if (IN(P + 1)) REPS(2) { PH_BEGIN(lv);
            if (G == 256) {
                { pg8::Gemm g{WSP(bf16, WS_H), (const bf16*)(WL() + WO_WIN), T, 4096, D}; pg8::StaticOrder S; S.init(T, 4096, G, bx);
                  EpiProj E{WSP(bf16, WS_QLAT), WSP(bf16, WS_KVLAT), WSP(bf16, WS_UM), WSP(bf16, WS_OPRE), WSP(bf16, WS_GA), WSP(bf16, WS_GM), WSP(float, WS_SMALL)};
                  pg8::gemm_phase<EpiProj, pg8::StaticOrder, true, true>(lds + RING_OFF, g, S, E, tidq); }
                { const int kq = bx >> 6;
                  pg8::Gemm g{WSP(bf16, WS_H) + 256 * kq, (const bf16*)(WL() + WO_WIN) + (size_t)4096 * 1024 + 256 * kq, T, 256, 256, 1024}; pg8::StaticOrder S; S.init(T, 256, 64, bx & 63);
                  EpiSmallPart E{WSP(float, WS_SMALLP) + (size_t)kq * T * 64};
                  pg8::gemm_phase<EpiSmallPart, pg8::StaticOrder, true, true>(lds + RING_OFF, g, S, E, tidq); }
            } else {
                pg8::Gemm g{WSP(bf16, WS_H), (const bf16*)(WL() + WO_WIN), T, NPROJ, D}; pg8::StaticOrder S; S.init(T, NPROJ, G, bx);
                EpiProj E{WSP(bf16, WS_QLAT), WSP(bf16, WS_KVLAT), WSP(bf16, WS_UM), WSP(bf16, WS_OPRE), WSP(bf16, WS_GA), WSP(bf16, WS_GM), WSP(float, WS_SMALL)};
                pg8::gemm_phase<EpiProj, pg8::StaticOrder, true, true>(lds + RING_OFF, g, S, E, tidq);
            }
        }
        SEAM(P + 1);
        if (IN(P + 2)) REPS(3) { PH_BEGIN(lv);
            rowpass_mid(WSP(bf16, WS_QLAT), WSP(bf16, WS_KVLAT), WSP(float, WS_SMALL), (G == 256) ? WSP(float, WS_SMALLP) : (const float*)nullptr, WSP(float, WS_COS), WSP(float, WS_SIN), WSP(bf16, WS_UM), INP(I_CONVW) + l * 4 * 512, INP(I_CONVB) + l * 512,
                        INP(I_BI) + l * 4, INP(I_BF) + l * 4, WSP(float, WS_RQ), WSP(float, WS_RKV), WSP(bf16, WS_K), WSP(float, WS_LOGI), WSP(float, WS_LOGF), WSP(bf16, WS_CONV), gw, NGW, lane); }
        SEAM(P + 2);
        if (IN(P + 3)) REPS(4) {
            { PH_BEGIN(lv); pg8::Gemm g{WSP(bf16, WS_QLAT), (const bf16*)(WL() + WO_WQ), T, 768, 768}; pg8::StaticOrder S; S.init(T, 768, G, bx);
              EpiQ E{WSP(bf16, WS_Q), WSP(float, WS_RQ), WSP(float, WS_COS), WSP(float, WS_SIN)}; pg8::gemm_phase<EpiQ, pg8::StaticOrder, true, true>(lds + RING_OFF, g, S, E, tidq); }
            { PH_BEGIN(lv); pg8::Gemm g{WSP(bf16, WS_KVLAT), (const bf16*)(WL() + WO_WKV), T, 1024, 256}; pg8::StaticOrder S; S.init(T, 1024, G, bx);
              EpiKV E{WSP(bf16, WS_K), WSP(bf16, WS_V), WSP(float, WS_RKV)}; pg8::gemm_phase<EpiKV, pg8::StaticOrder, true, true>(lds + RING_OFF, g, S, E, tidq); }
            { PH_BEGIN(lv); const int c = (G == 256) ? (bx >> 7) : 0;
              pg8::Gemm g{WSP(bf16, WS_CONV) + 256 * c, (const bf16*)(WL() + WO_WQK) + (size_t)(512 * c) * 512 + 256 * c, T, 512, 256, 512}; pg8::StaticOrder S;
              if (G == 256) S.init(T, 512, 128, bx & 127); else S.init(T, 512, G, bx);
              pg8::EpiBf16<0> E{WSP(bf16, WS_QKM) + 256 * c, 1024, nullptr, 256, 512, 1.f}; pg8::gemm_phase<pg8::EpiBf16<0>, pg8::StaticOrder, true, true>(lds + RING_OFF, g, S, E, tidq); }
            { PH_BEGIN(lv); if (G != 256) {
              pg8::Gemm g{WSP(bf16, WS_CONV) + 256, (const bf16*)(WL() + WO_WQK) + (size_t)512 * 512 + 256, T, 512, 256, 512}; pg8::StaticOrder S; S.init(T, 512, G, bx);
              pg8::EpiBf16<0> E{WSP(bf16, WS_QKM) + 256, 1024, nullptr, 256, 512, 1.f}; pg8::gemm_phase<pg8::EpiBf16<0>, pg8::StaticOrder, true, true>(lds + RING_OFF, g, S, E, tidq); } }
            { PH_BEGIN(lv);
              pg8::Gemm g{WSP(bf16, WS_UM), (const bf16*)(WL() + WO_WV), T, 256, 256, 512}; pg8::StaticOrder S;
              if (G == 256) S.init(T, 256, 64, bx >= 192 ? bx - 192 : (1 << 20)); else S.init(T, 256, G, bx);
              pg8::EpiBf16<0> E{WSP(bf16, WS_VM), 512, nullptr, 0, 0, 1.f}; pg8::gemm_phase<pg8::EpiBf16<0>, pg8::StaticOrder, true, true>(lds + RING_OFF, g, S, E, tidq); }
            { PH_BEGIN(lv);
              pg8::Gemm g{WSP(bf16, WS_UM) + 256, (const bf16*)(WL() + WO_WV) + (size_t)256 * 512 + 256, T, 256, 256, 512}; pg8::StaticOrder S;
              if (G == 256) S.init(T, 256, 64, bx >= 192 ? bx - 192 : (1 << 20)); else S.init(T, 256, G, bx);
              pg8::EpiBf16<0> E{WSP(bf16, WS_VM) + 256, 512, nullptr, 0, 0, 1.f}; pg8::gemm_phase<pg8::EpiBf16<0>, pg8::StaticOrder, true, true>(lds + RING_OFF, g, S, E, tidq); }
        }
        SEAM(P + 3);
        if (IN(P + 4)) {
            REPS(5) { PH_BEGIN(lv); attn_mfma(WSP(bf16, WS_Q), WSP(bf16, WS_K), WSP(bf16, WS_V), WSP(bf16, WS_AO), lds + RING_OFF, bx, G, tidq); __syncthreads(); }
            REPS(6) { PH_BEGIN(lv); mlstm_mfma(WSP(bf16, WS_QKM), WSP(bf16, WS_VM), WSP(float, WS_LOGI), WSP(float, WS_LOGF), WSP(bf16, WS_CONV), WSP(bf16, WS_OPRE), INP(I_MHG) + l * 512, INP(I_MSKIP) + l * 512,
                          WSP(bf16, WS_OUTM), lds + RING_OFF, bx, G, tidq); }
        }
        SEAM(P + 4);
        if (IN(P + 5)) REPS(7) {
            static_assert(WS_OUTM == WS_AO + (size_t)T * 512 * 2 && WO_WM == WO_WA + 1024 * 512 * 2, "the merge stream needs AO | OUTM and Wa | Wm adjacent");
            { PH_BEGIN(lv); pg8::Gemm g{WSP(bf16, WS_AO), (const bf16*)(WL() + WO_WA), 2 * T, 2048, 512}; MergeOrder S; S.base.init(T, 1024, G, bx);
              EpiMerge2 E{WSP(bf16, WS_MERGED), WSP(bf16, WS_GA), WSP(bf16, WS_GM)}; pg8::gemm_phase<EpiMerge2, MergeOrder, true, true>(lds + RING_OFF, g, S, E, tidq); }
        }
        SEAM(P + 5);
        if (IN(P + 6)) REPS(8) { PH_BEGIN(lv);
            pg8::Gemm g{WSP(bf16, WS_MERGED), (const bf16*)(WL() + WO_WO), T, 1024, 1024}; pg8::StaticOrder S; S.init(T, 1024, G, bx);
            if (lv == 0) { EpiResid<false> E{INP(I_X), XA(), ADAL() + 2048}; pg8::gemm_phase<EpiResid<false>, pg8::StaticOrder, true, true>(lds + RING_OFF, g, S, E, tidq); }
            else { EpiResid<true> E{XB(), XA(), ADAL() + 2048}; pg8::gemm_phase<EpiResid<true>, pg8::StaticOrder, true, true>(lds + RING_OFF, g, S, E, tidq); }
        }
        SEAM(P + 6);
        if (IN(P + 7)) REPS(1) { PH_BEGIN(lv); rowpass_norm_mod<true>(XA(), INP(I_N2G) + l * D, ADAL() + 3072, ADAL() + 4096, WSP(bf16, WS_H), gw, NGW, lane, ws + WS_H8, WSP(float, WS_XS)); }
        SEAM(P + 7);
        if (IN(P + 8)) REPS(9) { PH_BEGIN(lv);
            pg8::Gemm g{WSP(bf16, WS_H), (const bf16*)(WL() + WO_PWQ), T, 1024, 1024}; pg8::StaticOrder S; S.init(T, 1024, G, bx);
            pg8::EpiBf16<0> E{WSP(bf16, WS_PQ), 1024, nullptr, 0, 0, 1.f}; pg8::gemm_phase<pg8::EpiBf16<0>, pg8::StaticOrder, true, true>(lds + RING_OFF, g, S, E, tidq);
        }
        SEAM(P + 8);
        if (IN(P + 9)) REPS(10) { PH_BEGIN(lv);
            peer_route(WSP(bf16, WS_PQ), (const bf16*)(WL() + WO_KEYB), WSP(int, WS_IDX), WSP(float, WS_GATE), lds + RING_OFF, bx, G, tidq); }
        SEAM(P + 9);
        if (IN(P + 10)) REPS(12) { PH_BEGIN(lv);
            int vx, rank, nb; peer_partition((const unsigned*)(ws + WS_CTL) + CW_XC, MISC, bx, G, vx, rank, nb);
            peer_u_i8(ws + WS_H8, WSP(float, WS_XS), WSP(int, WS_IDX), ws + WS_U8 + (size_t)l * 32 * MiB, WSP(f32x2v, WS_USC) + l * 16384, WSP(float, WS_ACT), wscr, vx, rank, nb, tidq); }
        SEAM(P + 10);
        if (IN(P + 11)) REPS(13) { PH_BEGIN(lv);
            int vx, rank, nb; peer_partition((const unsigned*)(ws + WS_CTL) + CW_XC, MISC, bx, G, vx, rank, nb);
            peer_v(WSP(int, WS_IDX), WSP(float, WS_ACT), WSP(float, WS_GATE), ws + WS_V8 + (size_t)l * 32 * MiB, ADAL() + 5120, XA(), XB(), wscr, vx, rank, nb, tidq);
        }
        SEAM(P + 11);
    }

__global__ void __launch_bounds__(NTHREADS, 2) fwd(Args args) {
    extern __shared__ __attribute__((aligned(16))) unsigned char lds_raw[];
    LAS unsigned char* lds = (LAS unsigned char*)lds_raw;
    volatile LAS unsigned* MISC = (volatile LAS unsigned*)(lds + MISC_OFF);
    const int tid = threadIdx.x;
    const int wave_s = __builtin_amdgcn_readfirstlane(tid >> 6);
    for (int u = tid; u < (LDS_BYTES - LDSCTL_OFF) / 4; u += NTHREADS) ((LAS unsigned*)(lds + LDSCTL_OFF))[u] = 0u;
    __syncthreads();
    if (tid == 0) { LAS unsigned long long* pt = (LAS unsigned long long*)(lds + PTAB_OFF);
#pragma unroll
        for (int i = 0; i < N_INPUTS; ++i) pt[i] = (unsigned long long)args.in[i];
        pt[29] = (unsigned long long)args.out; pt[30] = (unsigned long long)args.ws; }
    __syncthreads();
    if (MK_ONE_LAUNCH) (void)xcd_barrier_post((unsigned*)(WSB() + WS_CTL) + CW_BAR, MISC + 8);
    if (MK_ONE_LAUNCH && tid == 0) { const unsigned xc = xb_xcc_id() & 7u; MISC[12] = xb_add((unsigned*)(WSB() + WS_CTL) + CW_XC + 64 * xc, 1u); MISC[13] = xc; }
    __syncthreads();
    const int lo = args.ph_lo, hi = args.ph_hi;

    if (IN(0)) REPS(0) {
        PH_BEGIN(0);
        float* ADA = (float*)(ws + ADA_OFF);
        { const float* c = INP(I_C); const float* wada = INP(I_WADA); const float* bada = INP(I_BADA);
          for (int it = bx; it < DEPTH * 96; it += G) {
            const int ll = it / 96, cg = it % 96; const int n = cg * 64 + lane;
#pragma unroll
            for (int i = 0; i < 16; ++i) { const int e = lane + 64 * i; const int bb = e >> 7, kk = e & 127; const float cv = c[bb * D + wave * 128 + kk]; wscr[e] = cv * sigm(cv); }
            LDS_WAIT();
            const float* w = wada + (size_t)ll * D * NADA + (size_t)(wave * 128) * NADA + n;
            float a[8];
#pragma unroll
            for (int bb = 0; bb < 8; ++bb) a[bb] = 0.f;
#pragma unroll 16
            for (int kk = 0; kk < 128; ++kk) { const float wv = w[(size_t)kk * NADA];
#pragma unroll
                for (int bb = 0; bb < 8; ++bb) a[bb] += wscr[bb * 128 + kk] * wv; }
#pragma unroll
            for (int bb = 0; bb < 8; ++bb) wscr[1024 + bb * 64 + lane] = a[bb];
            __syncthreads();
            { float s = 0.f;
#pragma unroll
              for (int w8 = 0; w8 < 8; ++w8) s += ((const LAS float*)(lds + RING_OFF + w8 * 16384))[1024 + wave * 64 + lane];
              ADA[((size_t)ll * 8 + wave) * NADA + n] = s + bada[ll * NADA + n]; }
            __syncthreads();
          } }
        { const int* pos = (const int*)INP(I_POS); float* COS = (float*)(ws + WS_COS); float* SIN = (float*)(ws + WS_SIN);
          for (int idx = gw * 64 + lane; idx < T * 16; idx += NGW * 64) { const int t = idx >> 4, j = idx & 15;
              const float ang = (float)pos[t] * INV_FREQ[j];
              const double rev = (double)ang * 0.15915494309189535; const float fr = (float)(rev - rint(rev));
              COS[idx] = __builtin_amdgcn_cosf(fr); SIN[idx] = __builtin_amdgcn_sinf(fr); } }
        for (int it = gw; it < DEPTH * PI_TOTAL; it += NGW) prep_item(lds, ws, wscr, it / PI_TOTAL, it % PI_TOTAL, lane);
    }
    SEAM(0);

    layer_phases<0>(lds, MISC, lo, hi, wave_s);
    layer_phases<1>(lds, MISC, lo, hi, wave_s);
    if (IN(N_PHASES - 1)) REPS(1) { PH_BEGIN(0); rowpass_final(XB(), INP(I_FG), (float*)getp(lds, 29), gw, NGW, lane); }
#undef IN
#undef SEAM
}

extern "C" void kernel_launch(void* const* d_in, const int* in_sizes, int n_in, void* d_out, int out_size, void* d_ws, size_t ws_size, hipStream_t stream) {
    static int grid = 0;
    if (grid == 0) {
        if (n_in != N_INPUTS || in_sizes[0] != T * D || out_size != T * D || ws_size < WS_END2) {
            fprintf(stderr, "kernel_launch: unexpected shapes: n_in %d in0 %d out %d ws %zu (need %zu); nothing launched\n", n_in, n_in > 0 ? in_sizes[0] : -1, out_size, ws_size, (size_t)WS_END2); grid = -1; return; }
        int dev = 0, cus = 0, per_cu = 0;
        if (hipGetDevice(&dev) != hipSuccess || hipDeviceGetAttribute(&cus, hipDeviceAttributeMultiprocessorCount, dev) != hipSuccess) { fprintf(stderr, "kernel_launch: device query failed\n"); grid = -1; return; }
        if (hipFuncSetAttribute((const void*)fwd, hipFuncAttributeMaxDynamicSharedMemorySize, LDS_BYTES) != hipSuccess) { fprintf(stderr, "kernel_launch: hipFuncSetAttribute failed\n"); grid = -1; return; }
        if (hipOccupancyMaxActiveBlocksPerMultiprocessor(&per_cu, (const void*)fwd, NTHREADS, LDS_BYTES) != hipSuccess || per_cu < 1)
            fprintf(stderr, "kernel_launch: note: occupancy query reports %d workgroups per CU\n", per_cu);
        (void)hipGetLastError();
        grid = cus;
    }
    if (grid < 0) return;
    if (hipMemsetAsync((char*)d_ws + WS_CTL, 0, CTL_ZERO_BYTES, stream) != hipSuccess) { fprintf(stderr, "kernel_launch: memset failed\n"); return; }
    Args a{};
    for (int i = 0; i < N_INPUTS; ++i) a.in[i] = d_in[i];
    a.out = (float*)d_out; a.ws = (unsigned char*)d_ws;
#if MK_ONE_LAUNCH
    a.ph_lo = 0; a.ph_hi = N_PHASES;
    hipLaunchKernelGGL(fwd, dim3(grid), dim3(NTHREADS), LDS_BYTES, stream, a);
#else
    for (int p = 0; p < N_PHASES; ++p) { a.ph_lo = p; a.ph_hi = p + 1; hipLaunchKernelGGL(fwd, dim3(grid), dim3(NTHREADS), LDS_BYTES, stream, a); }
#endif
    const hipError_t le = hipPeekAtLastError();
    if (le != hipSuccess) fprintf(stderr, "kernel_launch: launch failed: %s\n", hipGetErrorName(le));
}
```

```cpp
#include <hip/hip_runtime.h>
#include <cstdio>
#include <cstdint>
#ifndef WT_STORES
#define WT_STORES 0
#endif
template <class V> __device__ __forceinline__ void st_wt(void* p, const V v) {
    static_assert(sizeof(V) == 16 || sizeof(V) == 8 || sizeof(V) == 4, "store width");
#if WT_STORES
    if constexpr (sizeof(V) == 16) asm volatile("global_store_dwordx4 %0, %1, off sc1\n\ts_nop 1" :: "v"(p), "v"(v) : "memory");
    else if constexpr (sizeof(V) == 8) asm volatile("global_store_dwordx2 %0, %1, off sc1\n\ts_nop 1" :: "v"(p), "v"(v) : "memory");
    else asm volatile("global_store_dword %0, %1, off sc1\n\ts_nop 1" :: "v"(p), "v"(v) : "memory");
#else
    *(V*)p = v;
#endif
}
#define GSTF(ptr, val) st_wt((void*)(ptr), (val))
template <class V> __device__ __forceinline__ void st_plain(void* p, const V v) { *(V*)p = v; }
#define GST(ptr, val) st_plain((void*)(ptr), (val))
namespace pg8 {
#define PG8_LAS __attribute__((address_space(3)))
typedef unsigned short bf16_t;
typedef short bf16x8 __attribute__((ext_vector_type(8)));
typedef float f32x4 __attribute__((ext_vector_type(4)));
typedef unsigned u32x4 __attribute__((ext_vector_type(4)));
constexpr int BM = 256, BK = 64, HALF = 128, HTB = HALF * BK * 2  , STAGE_BYTES = 8 * HTB, NXCD = 8, WGM = 8;

__host__ __device__ __forceinline__ int lds_byte(int r, int c) { const int st = (r >> 4) * 2 + (c >> 5), rr = r & 15, cc = c & 31, ob = rr * 64 + cc * 2; return st * 1024 + (ob ^ (((ob >> 9) & 1) << 5)); }
__host__ __device__ __forceinline__ void stage_rc(int b, int& R, int& C) { const int st = b / 1024, sb = b % 1024, swz = sb ^ (((sb >> 9) & 1) << 5); R = (st >> 1) * 16 + swz / 64; C = (st & 1) * 32 + (swz % 64) / 2; }
__host__ __device__ __forceinline__ int perm32(int rho) { const int n = rho >> 4, i = rho & 15; return 8 * (i >> 2) + 4 * n + (i & 3); }

struct Unit { int pm, pn; };
struct Gemm { const bf16_t* A; const bf16_t* Bt; int M, N, K; int ld = 0; };

struct StaticOrder {
    int nM, nN, nwg, G, c;
    __host__ __device__ void init(int M, int N, int G_, int c_) { nM = M / BM; nN = N / BM; nwg = nM * nN; G = G_; c = c_; }
    __host__ __device__ bool next(int i, Unit& u) const {
        const long L = (long)i * G + c; if (L >= nwg) return false;
        int wgid = (int)L; { const int q = nwg / NXCD, r = nwg % NXCD, xcd = wgid % NXCD, off = wgid / NXCD; wgid = (xcd < r ? xcd * (q + 1) : r * (q + 1) + (xcd - r) * q) + off; }
        const int nig = WGM * nN, gid = wgid / nig, fm = gid * WGM, gsz = (nM - fm) < WGM ? (nM - fm) : WGM;
        u.pm = fm + ((wgid % nig) % gsz); u.pn = (wgid % nig) / gsz; return true;
    }
    __device__ __forceinline__ void a_ready(const Unit&) const {}
    __device__ __forceinline__ void done(const Unit&) const {}
};

__device__ __forceinline__ unsigned cvt_pk_bf16(float lo, float hi) { unsigned r; asm volatile("v_cvt_pk_bf16_f32 %0, %1, %2" : "=v"(r) : "v"(lo), "v"(hi)); return r; }
typedef float f32x2 __attribute__((ext_vector_type(2)));
__device__ __forceinline__ f32x2 gelu_pk(f32x2 v) {
    const f32x2 av = __builtin_elementwise_abs(v), d = av * 0.2316418882f + 1.0f;
    f32x2 t; t.x = __builtin_amdgcn_rcpf(d.x); t.y = __builtin_amdgcn_rcpf(d.y);
    f32x2 q = t * 0.5307027145f + (-0.7265760135f); q = q * t + 0.7107068705f; q = q * t + (-0.142248368f); q = q * t + 0.127414796f; q = q * t;
    const f32x2 s = (v * v) * (-0.72134752044f);
    f32x2 e; e.x = __builtin_amdgcn_exp2f(s.x); e.y = __builtin_amdgcn_exp2f(s.y);
    const f32x2 m = v * (q * e), r = v - m;
    f32x2 o; o.x = v.x < 0.f ? m.x : r.x; o.y = v.y < 0.f ? m.y : r.y; return o;
}

template <int ACT  > struct EpiBf16 {
    static constexpr bool PERM = true, AFTER_DRAIN = false; static_assert(ACT == 0 || ACT == 1, "EpiBf16: ACT is 0 (none) or 1 (gelu_pk)");
    bf16_t* O; int ldc; const float* bias; int split_cols; size_t split_stride; float scale0;
    __device__ __forceinline__ void operator()(const f32x4 (&acc)[2][2][4][2], const Unit& u, int wr, int wc, int fr, int fq) const {
        const int row0 = u.pm * BM + wr * 64 + fr; int colt = u.pn * BM; bf16_t* base = O;
        float sc = 1.f; if (split_cols) { const int t = colt / split_cols; base += (size_t)t * split_stride; colt -= t * split_cols; if (t == 0) sc = scale0; }
        const int col0 = colt + wc * 32 + 8 * fq, bcol0 = u.pn * BM + wc * 32 + 8 * fq;
        f32x4 bv[2][2];
#pragma unroll
        for (int bj = 0; bj < 2; ++bj)
#pragma unroll
            for (int n = 0; n < 2; ++n) bv[bj][n] = bias ? *(const f32x4*)(bias + bcol0 + bj * HALF + 4 * n) : (f32x4){0.f, 0.f, 0.f, 0.f};
#pragma unroll
        for (int ai = 0; ai < 2; ++ai)
#pragma unroll
            for (int m = 0; m < 4; ++m) { bf16_t* rowp = base + (size_t)(row0 + ai * HALF + m * 16) * ldc + col0;
#pragma unroll
                for (int bj = 0; bj < 2; ++bj) { f32x4 v0 = acc[ai][bj][m][0] + bv[bj][0], v1 = acc[ai][bj][m][1] + bv[bj][1];
                    if (ACT == 1) { f32x2 a = gelu_pk((f32x2){v0[0], v0[1]}), b = gelu_pk((f32x2){v0[2], v0[3]}), c = gelu_pk((f32x2){v1[0], v1[1]}), d = gelu_pk((f32x2){v1[2], v1[3]});
                        v0 = (f32x4){a.x, a.y, b.x, b.y}; v1 = (f32x4){c.x, c.y, d.x, d.y}; }
                    v0 = v0 * sc; v1 = v1 * sc; u32x4 w; w.x = cvt_pk_bf16(v0[0], v0[1]); w.y = cvt_pk_bf16(v0[2], v0[3]); w.z = cvt_pk_bf16(v1[0], v1[1]); w.w = cvt_pk_bf16(v1[2], v1[3]);
                    GST(rowp + bj * HALF, w); } }
    }
};


template <class Epi, class Sched, bool ALIGN_EPI = false, bool SP2 = false>
__device__ __forceinline__ void gemm_phase(PG8_LAS unsigned char* lds, const Gemm g, const Sched& S, const Epi& E, const int tid_in) {
    int tid_l = tid_in; asm volatile("" : "+v"(tid_l));
    const int tid = tid_l, wid = __builtin_amdgcn_readfirstlane(tid >> 6), lane = tid & 63, wr = wid >> 2, wc = wid & 3, fr = lane & 15, fq = lane >> 4;
    const int K = g.K, nt = K / BK, LD = g.ld ? g.ld : g.K;
    unsigned voffA[2], voffB[2];
#pragma unroll
    for (int i = 0; i < 2; ++i) { int R, C; stage_rc(tid * 16 + i * 8192, R, C); const int Rb = Epi::PERM ? ((R & ~31) + perm32(R & 31)) : R;
        voffA[i] = (unsigned)(R * LD + C) * 2u; voffB[i] = (unsigned)(Rb * LD + C) * 2u; }
    const size_t kstep = (size_t)(BK * 2);
    const size_t hstep = (size_t)HALF * LD * 2;
    const size_t tstep = 2 * hstep;
    const unsigned ldsw = (unsigned)wid * 1024u;
    const int aoff = lds_byte(wr * 64 + fr, fq * 8), boff = lds_byte(wc * 32 + fr, fq * 8);
#define PG8_SA(b, h) (((b) * 2 + (h)) * HTB)
#define PG8_SB(b, h) ((4 + (b) * 2 + (h)) * HTB)
#define PG8_STAGE(bufoff, gbase, voff) do { _Pragma("unroll") for (int _i = 0; _i < 2; ++_i) \
        __builtin_amdgcn_global_load_lds((const unsigned*)((const char*)(gbase) + (voff)[_i]), (PG8_LAS unsigned*)(lds + (bufoff) + ldsw + _i * 8192), 16, 0, 0); } while (0)
#define PG8_LDA(dst, b, h) do { _Pragma("unroll") for (int m = 0; m < 4; ++m) _Pragma("unroll") for (int k = 0; k < 2; ++k) dst[m][k] = *(const PG8_LAS bf16x8*)(lds + PG8_SA(b, h) + aoff + m * 2048 + k * 1024); } while (0)
#define PG8_LDB(dst, b, h) do { _Pragma("unroll") for (int n = 0; n < 2; ++n) _Pragma("unroll") for (int k = 0; k < 2; ++k) dst[n][k] = *(const PG8_LAS bf16x8*)(lds + PG8_SB(b, h) + boff + n * 2048 + k * 1024); } while (0)
#define PG8_MMA(ai, bj, At, Bt) do { __builtin_amdgcn_s_setprio(1); _Pragma("unroll") for (int m = 0; m < 4; ++m) _Pragma("unroll") for (int n = 0; n < 2; ++n) _Pragma("unroll") for (int k = 0; k < 2; ++k) \
        acc[ai][bj][m][n] = __builtin_amdgcn_mfma_f32_16x16x32_bf16(Bt[n][k], At[m][k], acc[ai][bj][m][n], 0, 0, 0); __builtin_amdgcn_s_setprio(0); } while (0)
#define PG8_WAIT_V(n) asm volatile("s_waitcnt vmcnt(" #n ")" ::: "memory")
#define PG8_WAIT_L(n) asm volatile("s_waitcnt lgkmcnt(" #n ")" ::: "memory")
#define PG8_BAR __builtin_amdgcn_s_barrier()
#define PG8_SCHED __builtin_amdgcn_sched_barrier(0)
    Unit cur, nxt; int ui = 0;
    if (!S.next(0, cur)) return;
    f32x4 acc[2][2][4][2];
#pragma unroll
    for (int a = 0; a < 2; ++a)
#pragma unroll
        for (int b = 0; b < 2; ++b)
#pragma unroll
            for (int m = 0; m < 4; ++m)
#pragma unroll
                for (int n = 0; n < 2; ++n) acc[a][b][m][n] = (f32x4){0.f, 0.f, 0.f, 0.f};
    bf16x8 At[4][2], B0[2][2], B1[2][2];
    const char* cA = (const char*)g.A + (size_t)cur.pm * tstep; const char* cB = (const char*)g.Bt + (size_t)cur.pn * tstep;
    S.a_ready(cur);
    if constexpr (SP2) {
        PG8_STAGE(PG8_SB(0, 0), cB, voffB); PG8_STAGE(PG8_SB(0, 1), cB + hstep, voffB); PG8_STAGE(PG8_SA(0, 0), cA, voffA); PG8_STAGE(PG8_SA(0, 1), cA + hstep, voffA);
        if (wr == 1) PG8_BAR;
        PG8_WAIT_V(2); PG8_BAR;
        PG8_STAGE(PG8_SB(1, 0), cB + kstep, voffB); PG8_STAGE(PG8_SA(1, 0), cA + kstep, voffA); PG8_STAGE(PG8_SB(1, 1), cB + hstep + kstep, voffB);
        PG8_WAIT_V(6); PG8_BAR;
    } else {
        PG8_STAGE(PG8_SB(0, 0), cB, voffB); PG8_STAGE(PG8_SA(0, 0), cA, voffA); PG8_STAGE(PG8_SB(0, 1), cB + hstep, voffB); PG8_STAGE(PG8_SA(0, 1), cA + hstep, voffA);
        if (wr == 1) PG8_BAR;
        PG8_WAIT_V(4); PG8_BAR;
        PG8_STAGE(PG8_SB(1, 0), cB + kstep, voffB); PG8_STAGE(PG8_SA(1, 0), cA + kstep, voffA); PG8_STAGE(PG8_SB(1, 1), cB + hstep + kstep, voffB);
        PG8_WAIT_V(6); PG8_BAR;
    }
    for (;;) {
        const bool has_next = S.next(ui + 1, nxt);
        const char* nA = has_next ? (const char*)g.A + (size_t)nxt.pm * tstep : cA; const char* nB = has_next ? (const char*)g.Bt + (size_t)nxt.pn * tstep : cB;
        for (int t = 0; t < nt; t += 2) {
            const bool last = (t == nt - 2);
            const char* a1 = cA + (size_t)(t + 1) * kstep;
            const char* a2 = last ? nA : cA + (size_t)(t + 2) * kstep; const char* b2 = last ? nB : cB + (size_t)(t + 2) * kstep;
            const char* a3 = a2 + kstep; const char* b3 = b2 + kstep;
            if (last && has_next) S.a_ready(nxt);
            if constexpr (SP2) {
            PG8_LDB(B0, 0, 0); PG8_LDB(B1, 0, 1); PG8_SCHED; PG8_LDA(At, 0, 0); PG8_STAGE(PG8_SA(1, 1), a1 + hstep, voffA);
            PG8_WAIT_V(8); PG8_WAIT_L(0); PG8_BAR; PG8_MMA(0, 0, At, B0); PG8_MMA(0, 1, At, B1); PG8_BAR; PG8_SCHED;
            PG8_LDA(At, 0, 1); PG8_STAGE(PG8_SB(0, 0), b2, voffB); PG8_STAGE(PG8_SB(0, 1), b2 + hstep, voffB); PG8_STAGE(PG8_SA(0, 0), a2, voffA);
            PG8_WAIT_V(8); PG8_WAIT_L(0); PG8_BAR; PG8_MMA(1, 0, At, B0); PG8_MMA(1, 1, At, B1); PG8_BAR; PG8_SCHED;
            PG8_LDB(B0, 1, 0); PG8_LDB(B1, 1, 1); PG8_SCHED; PG8_LDA(At, 1, 0); PG8_STAGE(PG8_SA(0, 1), a2 + hstep, voffA);
            PG8_WAIT_V(8); PG8_WAIT_L(0); PG8_BAR; PG8_MMA(0, 0, At, B0); PG8_MMA(0, 1, At, B1); PG8_BAR; PG8_SCHED;
            PG8_LDA(At, 1, 1); PG8_STAGE(PG8_SB(1, 0), b3, voffB); PG8_STAGE(PG8_SB(1, 1), b3 + hstep, voffB); PG8_STAGE(PG8_SA(1, 0), a3, voffA);
            PG8_WAIT_V(8); PG8_WAIT_L(0); PG8_BAR; PG8_MMA(1, 0, At, B0); PG8_MMA(1, 1, At, B1); PG8_BAR; PG8_SCHED;
            } else {
            PG8_LDB(B0, 0, 0); PG8_SCHED; PG8_LDA(At, 0, 0); PG8_STAGE(PG8_SA(1, 1), a1 + hstep, voffA);
            PG8_WAIT_L(8); PG8_BAR; PG8_WAIT_L(0); PG8_MMA(0, 0, At, B0); PG8_BAR; PG8_SCHED;
            PG8_LDB(B1, 0, 1); PG8_STAGE(PG8_SB(0, 0), b2, voffB);
            PG8_BAR; PG8_WAIT_L(0); PG8_MMA(0, 1, At, B1); PG8_BAR;
            PG8_LDA(At, 0, 1); PG8_STAGE(PG8_SA(0, 0), a2, voffA);
            PG8_BAR; PG8_WAIT_L(0); PG8_MMA(1, 0, At, B0); PG8_BAR; PG8_SCHED;
            PG8_STAGE(PG8_SB(0, 1), b2 + hstep, voffB);
            PG8_WAIT_V(6); PG8_BAR; PG8_MMA(1, 1, At, B1); PG8_BAR;
            PG8_LDB(B0, 1, 0); PG8_SCHED; PG8_LDA(At, 1, 0); PG8_STAGE(PG8_SA(0, 1), a2 + hstep, voffA);
            PG8_WAIT_L(8); PG8_BAR; PG8_WAIT_L(0); PG8_MMA(0, 0, At, B0); PG8_BAR; PG8_SCHED;
            PG8_LDB(B1, 1, 1); PG8_STAGE(PG8_SB(1, 0), b3, voffB);
            PG8_BAR; PG8_WAIT_L(0); PG8_MMA(0, 1, At, B1); PG8_BAR;
            PG8_LDA(At, 1, 1); PG8_STAGE(PG8_SA(1, 0), a3, voffA);
            PG8_BAR; PG8_WAIT_L(0); PG8_MMA(1, 0, At, B0); PG8_BAR; PG8_SCHED;
            PG8_STAGE(PG8_SB(1, 1), b3 + hstep, voffB);
            PG8_WAIT_V(6); PG8_BAR; PG8_MMA(1, 1, At, B1); PG8_BAR;
            }
        }
        if constexpr (ALIGN_EPI) { if (wr == 0) PG8_BAR; }
        if constexpr (!Epi::AFTER_DRAIN) { E(acc, cur, wr, wc, fr, fq); S.done(cur); }
        if (!has_next) break;
#pragma unroll
        for (int a = 0; a < 2; ++a)
#pragma unroll
            for (int b = 0; b < 2; ++b)
#pragma unroll
                for (int m = 0; m < 4; ++m)
#pragma unroll
                    for (int n = 0; n < 2; ++n) acc[a][b][m][n] = (f32x4){0.f, 0.f, 0.f, 0.f};
        cur = nxt; cA = nA; cB = nB; ++ui;
        if constexpr (ALIGN_EPI) { if (wr == 1) PG8_BAR; }
    }
    PG8_WAIT_V(0);
    if constexpr (!ALIGN_EPI) { if (wr == 0) PG8_BAR; }
    PG8_BAR;
    if constexpr (Epi::AFTER_DRAIN) { E.fused(acc, cur, wr, wc, fr, fq, lds, wid, lane); S.done(cur); }
#undef PG8_SA
#undef PG8_SB
#undef PG8_STAGE
#undef PG8_LDA
#undef PG8_LDB
#undef PG8_MMA
#undef PG8_WAIT_V
#undef PG8_WAIT_L
#undef PG8_BAR
#undef PG8_SCHED
}
}
#define GAS __attribute__((address_space(1)))
#define LAS __attribute__((address_space(3)))
typedef unsigned short bf16;
typedef unsigned v4u __attribute__((ext_vector_type(4)));
typedef float f32x4 __attribute__((ext_vector_type(4)));
typedef short bf16x8 __attribute__((ext_vector_type(8)));
typedef GAS unsigned gu32;
typedef GAS unsigned long long gu64;
#define RLX_AGENT __ATOMIC_RELAXED, __HIP_MEMORY_SCOPE_AGENT
#define LDS_WAIT() asm volatile("s_waitcnt lgkmcnt(0)" ::: "memory")
#define VM_WAIT() asm volatile("s_waitcnt vmcnt(0)" ::: "memory")
__device__ __forceinline__ unsigned long long rt() { return __builtin_amdgcn_s_memrealtime(); }
__device__ __forceinline__ unsigned f2bf(float f) { unsigned u = __builtin_bit_cast(unsigned, f); return (u + 0x7fffu + ((u >> 16) & 1u)) >> 16; }
typedef float pk2_f32x2 __attribute__((ext_vector_type(2))); typedef __bf16 pk2_bf16x2 __attribute__((ext_vector_type(2)));
__device__ __forceinline__ unsigned pk2(float lo, float hi) { const pk2_f32x2 v = {lo, hi}; return __builtin_bit_cast(unsigned, __builtin_convertvector(v, pk2_bf16x2)); }

#define XB_TMO      128
#define XB_XCNT(j)  (256  + 64 * (j))
#define XB_XSUB(j)  (1280 + 64 * (j))
#define XB_XGEN(j)  (2304 + 64 * (j))
#define XB_TOP      3328
#define XB_TOPGEN   3392
#define XCD_BAR_WORDS 3456
#define XB_SPIN_CAP (1u << 18)

__device__ __forceinline__ unsigned xb_ld(unsigned* p)              { return __hip_atomic_load(p, __ATOMIC_RELAXED, __HIP_MEMORY_SCOPE_AGENT); }
__device__ __forceinline__ unsigned xb_add(unsigned* p, unsigned v) { return __hip_atomic_fetch_add(p, v, __ATOMIC_RELAXED, __HIP_MEMORY_SCOPE_AGENT); }
__device__ __forceinline__ unsigned xb_xcc_id() { return (unsigned)__builtin_amdgcn_s_getreg((3 << 11) | 20) & 0xFu; }
#define XB_SPIN(cond, bar) do { unsigned _sp = 0; while (cond) { __builtin_amdgcn_s_sleep(1); \
    if ((++_sp & 255u) == 0u) { if (xb_ld(&(bar)[XB_TMO])) break; if (_sp > XB_SPIN_CAP) { atomicAdd(&(bar)[XB_TMO], 1u); break; } } } } while (0)

struct XcdBarrier {
    unsigned* bar; unsigned x;
    volatile LAS unsigned* st;
};

__device__ __forceinline__ XcdBarrier xcd_barrier_post(unsigned* bar, volatile LAS unsigned* st) {
    XcdBarrier b; b.bar = bar; b.x = xb_xcc_id(); b.st = st;
    if (threadIdx.x == 0) (void)xb_add(&bar[XB_XCNT(b.x)], 1u);
    return b;
}
__device__ __forceinline__ void xcd_barrier_complete(unsigned* bar, unsigned x, unsigned& nloc, unsigned& nx) {
    const unsigned G = gridDim.x * gridDim.y * gridDim.z;
    unsigned sum, cnt, mine, sp = 0u;
    for (;;) {
        sum = 0u; cnt = 0u; mine = 0u;
#pragma unroll
        for (unsigned j = 0; j < 16; ++j) { const unsigned c = xb_ld(&bar[XB_XCNT(j)]); sum += c; cnt += (c > 0u) ? 1u : 0u; mine = (j == x) ? c : mine; }
        if (sum == G) break;
        __builtin_amdgcn_s_sleep(1);
        if ((++sp & 255u) == 0u) { if (xb_ld(&bar[XB_TMO])) break; if (sp > XB_SPIN_CAP) { atomicAdd(&bar[XB_TMO], 1u); break; } }
    }
    nloc = mine > 0u ? mine : 1u; nx = cnt > 0u ? cnt : 1u;
}

__device__ __forceinline__ void xcd_barrier(const XcdBarrier& b, const int tid_in) {
    asm volatile("s_waitcnt vmcnt(0)" ::: "memory");
    __syncthreads();
    if (tid_in == 0) {
        unsigned* bar = b.bar;
        __builtin_amdgcn_s_waitcnt(0);
        unsigned nloc = b.st[0], nx = b.st[1];
        if (nloc == 0u) { xcd_barrier_complete(bar, b.x, nloc, nx); b.st[0] = nloc; b.st[1] = nx; }
        const unsigned old = xb_add(&bar[XB_XSUB(b.x)], 1u);
        const unsigned gen = old / nloc;
        if (old + 1u == (gen + 1u) * nloc) {
            __builtin_amdgcn_fence(__ATOMIC_RELEASE, "agent");
            asm volatile("s_waitcnt vmcnt(0)" ::: "memory");
            const unsigned og = xb_add(&bar[XB_TOP], 1u);
            const unsigned tg = og / nx;
            if (og + 1u == (tg + 1u) * nx) xb_add(&bar[XB_TOPGEN], 1u);
            else XB_SPIN(xb_ld(&bar[XB_TOPGEN]) == tg, bar);
            __builtin_amdgcn_fence(__ATOMIC_ACQUIRE, "agent");
            xb_add(&bar[XB_XGEN(b.x)], 1u);
            asm volatile("s_waitcnt vmcnt(0)" ::: "memory");
        } else {
            XB_SPIN(xb_ld(&bar[XB_XGEN(b.x)]) == gen, bar);
            __builtin_amdgcn_fence(__ATOMIC_ACQUIRE, "agent");
            asm volatile("s_waitcnt vmcnt(0)" ::: "memory");
        }
    }
    __syncthreads();
}

#ifndef MK_ONE_LAUNCH
#define MK_ONE_LAUNCH 1
#endif
#ifndef PROBE_REP_MASK
#define PROBE_REP_MASK 0
#endif
#define REPS(bit) _Pragma("unroll") for (int rep_ = 0; rep_ < ((PROBE_REP_MASK >> (bit)) & 1) + 1; ++rep_)
constexpr int NWAVES = 8, NTHREADS = NWAVES * 64;
constexpr int BATCH = 8, SEQ = 2048, T = BATCH * SEQ, D = 1024, DEPTH = 2;
constexpr int NPROJ = 4352;
constexpr int N_INPUTS = 29;
constexpr int NADA = 6144;
constexpr float RMS_EPS = 1e-6f;
constexpr float QSCALE = 0.10206207261596575f * 1.4426950408889634f;
enum { I_X = 0, I_C, I_POS, I_WADA, I_BADA, I_N1G, I_WIN, I_QNG, I_WQUP, I_KVNG, I_WKVUP, I_WBA, I_CONVW, I_CONVB, I_WQM, I_WKM, I_WVM, I_BI, I_BF, I_MHG, I_MSKIP,
       I_WBM, I_WOUT, I_N2G, I_PWQ, I_PKEYS, I_PU, I_PV, I_FG };

constexpr size_t MiB = 1u << 20;
constexpr size_t WS_CTL = 0, CTL_ZERO_BYTES = 1 * MiB;
constexpr int CW_BAR = 4096;
constexpr int CW_XL = 12288, CW_AL = 12288 + 64 * 8;
constexpr int CW_XC = 8192;
constexpr size_t ADA_OFF = 256 * 1024;
constexpr size_t WS_COS = 1 * MiB, WS_SIN = 2 * MiB;
constexpr size_t WS_W = 3 * MiB, W_LAYER = 18 * MiB;
constexpr size_t WO_WIN = 0, WO_WQ = 8912896, WO_WKV = WO_WQ + 1179648, WO_WA = WO_WKV + 524288, WO_WM = WO_WA + 1048576, WO_WO = WO_WM + 1048576,
                 WO_PWQ = WO_WO + 2097152, WO_WQK = WO_PWQ + 2097152, WO_WV = WO_WQK + 1048576, WO_KEYB = WO_WV + 524288;
static_assert(WO_KEYB + 262144 <= W_LAYER, "weights fit");
constexpr size_t WS_X = 40 * MiB, WS_H = 104 * MiB, WS_QLAT = 136 * MiB, WS_KVLAT = 160 * MiB, WS_UM = 168 * MiB, WS_OPRE = 184 * MiB, WS_GA = 200 * MiB, WS_GM = 232 * MiB,
                 WS_SMALL = 264 * MiB, WS_RQ = 268 * MiB, WS_RKV = WS_RQ + 65536, WS_LOGI = WS_RQ + 262144, WS_LOGF = WS_RQ + 524288, WS_Q = 269 * MiB, WS_K = 293 * MiB,
                 WS_V = 317 * MiB, WS_CONV = 333 * MiB, WS_QKM = 349 * MiB, WS_VM = 381 * MiB, WS_AO = 397 * MiB, WS_OUTM = 413 * MiB, WS_U8 = 429 * MiB, WS_V8 = 445 * MiB, WS_END = 493 * MiB;
constexpr size_t WS_H8 = 493 * MiB, WS_XS = WS_RQ + 131072, WS_USC = WS_RQ + 786432;
constexpr size_t WS_END2 = 509 * MiB;
constexpr size_t WS_IDX = 437 * MiB, WS_GATE = 453 * MiB, WS_ACT = WS_OPRE;
constexpr size_t WS_SMALLP = WS_OUTM;
constexpr size_t WS_PQ = WS_GA, WS_MERGED = WS_H;

constexpr int RING_OFF = 0, RING_BYTES = 131072;
constexpr int LDSCTL_OFF = RING_BYTES, MISC_OFF = LDSCTL_OFF + 320;
constexpr int LDS_BYTES = 147456;

typedef float f32x2v __attribute__((ext_vector_type(2)));
typedef unsigned u32x2 __attribute__((ext_vector_type(2)));

#define DPPF_(v, ctrl) __uint_as_float(__builtin_amdgcn_update_dpp(0, __float_as_uint(v), ctrl, 0xf, 0xf, false))
__device__ __forceinline__ float wave_sum(float v) {
    v += DPPF_(v, 0x128); v += DPPF_(v, 0x124); v += DPPF_(v, 0x122); v += DPPF_(v, 0x121);
    { auto r = __builtin_amdgcn_permlane16_swap(__float_as_uint(v), __float_as_uint(v), false, false); v = __uint_as_float(r[0]) + __uint_as_float(r[1]); }
    { auto r = __builtin_amdgcn_permlane32_swap(__float_as_uint(v), __float_as_uint(v), false, false); v = __uint_as_float(r[0]) + __uint_as_float(r[1]); }
    return v;
}
__device__ __forceinline__ float wave_max(float v) {
    v = fmaxf(v, DPPF_(v, 0x128)); v = fmaxf(v, DPPF_(v, 0x124)); v = fmaxf(v, DPPF_(v, 0x122)); v = fmaxf(v, DPPF_(v, 0x121));
    { auto r = __builtin_amdgcn_permlane16_swap(__float_as_uint(v), __float_as_uint(v), false, false); v = fmaxf(__uint_as_float(r[0]), __uint_as_float(r[1])); }
    { auto r = __builtin_amdgcn_permlane32_swap(__float_as_uint(v), __float_as_uint(v), false, false); v = fmaxf(__uint_as_float(r[0]), __uint_as_float(r[1])); }
    return v;
}
__device__ __forceinline__ float bflo(unsigned u) { return __uint_as_float(u << 16); }
__device__ __forceinline__ float bfhi(unsigned u) { return __uint_as_float(u & 0xffff0000u); }
__device__ __forceinline__ float sigm(float x) { return __builtin_amdgcn_rcpf(1.f + __builtin_amdgcn_exp2f(x * -1.4426950408889634f)); }
__device__ __forceinline__ float dot4(f32x4 a, f32x4 b) { return (a.x * b.x + a.y * b.y) + (a.z * b.z + a.w * b.w); }
__device__ __forceinline__ float gelu_erf(float v) {
    const float av = fabsf(v), t = __builtin_amdgcn_rcpf(av * 0.2316418882f + 1.0f);
    float q = t * 0.5307027145f + (-0.7265760135f); q = q * t + 0.7107068705f; q = q * t + (-0.142248368f); q = q * t + 0.127414796f; q = q * t;
    const float e = __builtin_amdgcn_exp2f((v * v) * (-0.72134752044f)), mm = v * (q * e);
    return v < 0.f ? mm : v - mm; }

struct EpiProj {
    static constexpr bool PERM = true, AFTER_DRAIN = false;
    bf16 *qlat, *kvlat, *um, *opre, *ga, *gm; float* small;
    __device__ __forceinline__ void operator()(const f32x4 (&acc)[2][2][4][2], const pg8::Unit& u, int wr, int wc, int fr, int fq) const {
        const int pn = u.pn; bf16* dst; int ld, cb; int mode = 0;
        if (pn < 3) { dst = qlat; ld = 768; cb = pn * 256; }
        else if (pn == 3) { dst = kvlat; ld = 256; cb = 0; }
        else if (pn < 6) { dst = um; ld = 512; cb = (pn - 4) * 256; }
        else if (pn < 8) { dst = opre; ld = 512; cb = (pn - 6) * 256; }
        else if (pn < 12) { dst = ga; ld = 1024; cb = (pn - 8) * 256; mode = 1; }
        else if (pn < 16) { dst = gm; ld = 1024; cb = (pn - 12) * 256; mode = 1; }
        else { dst = nullptr; ld = 0; cb = 0; mode = 2; }
        const int row0 = u.pm * 256 + wr * 64 + fr;
        if (mode == 2) {
            if (wc < 2) {
#pragma unroll
                for (int ai = 0; ai < 2; ++ai)
#pragma unroll
                    for (int m = 0; m < 4; ++m) { float* p = small + (size_t)(row0 + ai * 128 + m * 16) * 64 + wc * 32 + 8 * fq;
                        GST(p, acc[ai][0][m][0]); GST(p + 4, acc[ai][0][m][1]); }
            }
        } else {
#pragma unroll
            for (int ai = 0; ai < 2; ++ai)
#pragma unroll
                for (int m = 0; m < 4; ++m) { bf16* rowp = dst + (size_t)(row0 + ai * 128 + m * 16) * ld + cb + wc * 32 + 8 * fq;
#pragma unroll
                    for (int bj = 0; bj < 2; ++bj) { f32x4 v0 = acc[ai][bj][m][0], v1 = acc[ai][bj][m][1];
                        if (mode == 1) { v0 = (f32x4){sigm(v0[0]), sigm(v0[1]), sigm(v0[2]), sigm(v0[3])}; v1 = (f32x4){sigm(v1[0]), sigm(v1[1]), sigm(v1[2]), sigm(v1[3])}; }
                        v4u w; w.x = pk2(v0[0], v0[1]); w.y = pk2(v0[2], v0[3]); w.z = pk2(v1[0], v1[1]); w.w = pk2(v1[2], v1[3]);
                        GST(rowp + bj * 128, w); } }
        }
    }
};
struct EpiSmallPart {
    static constexpr bool PERM = true, AFTER_DRAIN = false;
    float* part;
    __device__ __forceinline__ void operator()(const f32x4 (&acc)[2][2][4][2], const pg8::Unit& u, int wr, int wc, int fr, int fq) const {
        if (wc >= 2) return;
        const int row0 = u.pm * 256 + wr * 64 + fr;
#pragma unroll
        for (int ai = 0; ai < 2; ++ai)
#pragma unroll
            for (int m = 0; m < 4; ++m) { float* p = part + (size_t)(row0 + ai * 128 + m * 16) * 256 + wc * 32 + 8 * fq;
                GST(p, acc[ai][0][m][0]); GST(p + 4, acc[ai][0][m][1]); }
    }
};
struct EpiQ {
    static constexpr bool PERM = true, AFTER_DRAIN = false;
    bf16* Q; const float* rq; const float* cosT; const float* sinT;
    __device__ __forceinline__ void operator()(const f32x4 (&acc)[2][2][4][2], const pg8::Unit& u, int wr, int wc, int fr, int fq) const {
        const int row0 = u.pm * 256 + wr * 64 + fr;
        int c0b[2], d0b[2];
#pragma unroll
        for (int bj = 0; bj < 2; ++bj) { c0b[bj] = u.pn * 256 + bj * 128 + wc * 32 + 8 * fq; d0b[bj] = c0b[bj] % 96; }
#pragma unroll
        for (int ai = 0; ai < 2; ++ai) {
            float rr[4]; f32x4 csv[4][2], snv[4][2];
#pragma unroll
            for (int m = 0; m < 4; ++m) { const int row = row0 + ai * 128 + m * 16; rr[m] = rq[row];
#pragma unroll
                for (int bj = 0; bj < 2; ++bj) { csv[m][bj] = (f32x4){1.f, 1.f, 1.f, 1.f}; snv[m][bj] = (f32x4){0.f, 0.f, 0.f, 0.f};
                    if (d0b[bj] >= 64) { const int j0 = (d0b[bj] - 64) >> 1; csv[m][bj] = *(const f32x4*)(cosT + (size_t)row * 16 + j0); snv[m][bj] = *(const f32x4*)(sinT + (size_t)row * 16 + j0); } } }
            __builtin_amdgcn_sched_barrier(0);
#pragma unroll
            for (int m = 0; m < 4; ++m) { const int row = row0 + ai * 128 + m * 16; const float r = rr[m];
#pragma unroll
                for (int bj = 0; bj < 2; ++bj) {
                    f32x4 v0 = acc[ai][bj][m][0] * r, v1 = acc[ai][bj][m][1] * r;
                    if (d0b[bj] >= 64) { const f32x4 cs = csv[m][bj], sn = snv[m][bj]; const f32x4 a0 = v0, a1 = v1;
                        v0[0] = a0[0] * cs[0] - a0[1] * sn[0]; v0[1] = a0[1] * cs[0] + a0[0] * sn[0];
                        v0[2] = a0[2] * cs[1] - a0[3] * sn[1]; v0[3] = a0[3] * cs[1] + a0[2] * sn[1];
                        v1[0] = a1[0] * cs[2] - a1[1] * sn[2]; v1[1] = a1[1] * cs[2] + a1[0] * sn[2];
                        v1[2] = a1[2] * cs[3] - a1[3] * sn[3]; v1[3] = a1[3] * cs[3] + a1[2] * sn[3]; }
                    v4u w; w.x = pk2(v0[0], v0[1]); w.y = pk2(v0[2], v0[3]); w.z = pk2(v1[0], v1[1]); w.w = pk2(v1[2], v1[3]);
                    GST(Q + (size_t)row * 768 + c0b[bj], w); } }
        }
    }
};
struct EpiKV {
    static constexpr bool PERM = true, AFTER_DRAIN = false;
    bf16* K; bf16* V; const float* rkv;
    __device__ __forceinline__ void operator()(const f32x4 (&acc)[2][2][4][2], const pg8::Unit& u, int wr, int wc, int fr, int fq) const {
        const int row0 = u.pm * 256 + wr * 64 + fr;
        float rr[2][4];
#pragma unroll
        for (int ai = 0; ai < 2; ++ai)
#pragma unroll
            for (int m = 0; m < 4; ++m) rr[ai][m] = rkv[row0 + ai * 128 + m * 16];
#pragma unroll
        for (int ai = 0; ai < 2; ++ai)
#pragma unroll
            for (int m = 0; m < 4; ++m) { const int row = row0 + ai * 128 + m * 16; const float r = rr[ai][m];
#pragma unroll
                for (int bj = 0; bj < 2; ++bj) { const int c0 = u.pn * 256 + bj * 128 + wc * 32 + 8 * fq;
                    const f32x4 v0 = acc[ai][bj][m][0] * r, v1 = acc[ai][bj][m][1] * r;
                    bf16* dst = (c0 < 512) ? (K + (size_t)row * 768 + 96 * (c0 >> 6) + (c0 & 63)) : (V + (size_t)row * 512 + (c0 - 512));
                    v4u w; w.x = pk2(v0[0], v0[1]); w.y = pk2(v0[2], v0[3]); w.z = pk2(v1[0], v1[1]); w.w = pk2(v1[2], v1[3]);
                    GST(dst, w); } }
    }
};
struct EpiMerge {
    static constexpr bool PERM = true, AFTER_DRAIN = false;
    bf16* Mg; const bf16* gate; int first;
    __device__ __forceinline__ void operator()(const f32x4 (&acc)[2][2][4][2], const pg8::Unit& u, int wr, int wc, int fr, int fq) const {
        const int row0 = u.pm * 256 + wr * 64 + fr, cbase = u.pn * 256 + wc * 32 + 8 * fq;
#pragma unroll
        for (int ai = 0; ai < 2; ++ai) {
            v4u gq[4][2], oq[4][2];
#pragma unroll
            for (int m = 0; m < 4; ++m)
#pragma unroll
                for (int bj = 0; bj < 2; ++bj) { const size_t off = (size_t)(row0 + ai * 128 + m * 16) * 1024 + cbase + bj * 128;
                    gq[m][bj] = *(const v4u*)(gate + off); oq[m][bj] = first ? (v4u){0u, 0u, 0u, 0u} : *(const v4u*)(Mg + off); }
            __builtin_amdgcn_sched_barrier(0);
#pragma unroll
            for (int m = 0; m < 4; ++m)
#pragma unroll
                for (int bj = 0; bj < 2; ++bj) { const size_t off = (size_t)(row0 + ai * 128 + m * 16) * 1024 + cbase + bj * 128;
                    const v4u g = gq[m][bj], o = oq[m][bj];
                    f32x4 v0 = acc[ai][bj][m][0], v1 = acc[ai][bj][m][1];
                    v0[0] = v0[0] * bflo(g.x) + bflo(o.x); v0[1] = v0[1] * bfhi(g.x) + bfhi(o.x); v0[2] = v0[2] * bflo(g.y) + bflo(o.y); v0[3] = v0[3] * bfhi(g.y) + bfhi(o.y);
                    v1[0] = v1[0] * bflo(g.z) + bflo(o.z); v1[1] = v1[1] * bfhi(g.z) + bfhi(o.z); v1[2] = v1[2] * bflo(g.w) + bflo(o.w); v1[3] = v1[3] * bfhi(g.w) + bfhi(o.w);
                    v4u w; w.x = pk2(v0[0], v0[1]); w.y = pk2(v0[2], v0[3]); w.z = pk2(v1[0], v1[1]); w.w = pk2(v1[2], v1[3]);
                    GST(Mg + off, w); }
        }
    }
};
struct MergeOrder {
    pg8::StaticOrder base;
    __device__ __forceinline__ bool next(int i, pg8::Unit& u) const { pg8::Unit v; if (!base.next(i >> 1, v)) return false; u.pm = v.pm + ((i & 1) ? T / 256 : 0); u.pn = v.pn + ((i & 1) ? 4 : 0); return true; }
    __device__ __forceinline__ void a_ready(const pg8::Unit&) const {}
    __device__ __forceinline__ void done(const pg8::Unit&) const {}
};
struct EpiMerge2 {
    static constexpr bool PERM = true, AFTER_DRAIN = false;
    bf16* Mg; const bf16* ga; const bf16* gm;
    __device__ __forceinline__ void operator()(const f32x4 (&acc)[2][2][4][2], const pg8::Unit& u, int wr, int wc, int fr, int fq) const {
        const bool second = u.pn >= 4; const pg8::Unit v{second ? u.pm - T / 256 : u.pm, second ? u.pn - 4 : u.pn};
        const EpiMerge e{Mg, second ? gm : ga, second ? 0 : 1}; e(acc, v, wr, wc, fr, fq); }
};
template <bool XBF> struct EpiResid {
    static constexpr bool PERM = true, AFTER_DRAIN = false;
    const void* xin; bf16* xout; const float* gate;
    __device__ __forceinline__ void operator()(const f32x4 (&acc)[2][2][4][2], const pg8::Unit& u, int wr, int wc, int fr, int fq) const {
        const int row0 = u.pm * 256 + wr * 64 + fr, b = (u.pm * 256) >> 11, cbase = u.pn * 256 + wc * 32 + 8 * fq;
        f32x4 gv[2][2];
#pragma unroll
        for (int bj = 0; bj < 2; ++bj) { const float* gp = gate + (size_t)b * NADA + cbase + bj * 128; gv[bj][0] = *(const f32x4*)gp; gv[bj][1] = *(const f32x4*)(gp + 4); }
#pragma unroll
        for (int ai = 0; ai < 2; ++ai) {
            f32x4 xv[4][2][2];
#pragma unroll
            for (int m = 0; m < 4; ++m)
#pragma unroll
                for (int bj = 0; bj < 2; ++bj) { const size_t off = (size_t)(row0 + ai * 128 + m * 16) * 1024 + cbase + bj * 128;
                    if (XBF) { const v4u w = *(const v4u*)((const bf16*)xin + off); xv[m][bj][0] = (f32x4){bflo(w.x), bfhi(w.x), bflo(w.y), bfhi(w.y)}; xv[m][bj][1] = (f32x4){bflo(w.z), bfhi(w.z), bflo(w.w), bfhi(w.w)}; }
                    else { xv[m][bj][0] = *(const f32x4*)((const float*)xin + off); xv[m][bj][1] = *(const f32x4*)((const float*)xin + off + 4); } }
            __builtin_amdgcn_sched_barrier(0);
#pragma unroll
            for (int m = 0; m < 4; ++m)
#pragma unroll
                for (int bj = 0; bj < 2; ++bj) { const size_t off = (size_t)(row0 + ai * 128 + m * 16) * 1024 + cbase + bj * 128;
                    const f32x4 o0 = xv[m][bj][0] + gv[bj][0] * acc[ai][bj][m][0], o1 = xv[m][bj][1] + gv[bj][1] * acc[ai][bj][m][1];
                    v4u w; w.x = pk2(o0[0], o0[1]); w.y = pk2(o0[2], o0[3]); w.z = pk2(o1[0], o1[1]); w.w = pk2(o1[2], o1[3]);
                    GST(xout + off, w); }
        }
    }
};

template <class Get> __device__ __forceinline__ void prep_tile(const Get& get, bf16* dst, int K, int k0, int n0, LAS float* scr, int lane) {
    float tv[32];
#pragma unroll
    for (int i = 0; i < 32; ++i) tv[i] = get(k0 + 2 * i + (lane >> 5), n0 + (lane & 31));
#pragma unroll
    for (int i = 0; i < 32; ++i) { const int kk = 2 * i + (lane >> 5); scr[kk * 33 + (lane & 31)] = tv[i]; }
    LDS_WAIT(); asm volatile("" ::: "memory");
    const int c = lane & 7;
#pragma unroll
    for (int j = 0; j < 4; ++j) { const int n = (lane >> 3) + 8 * j; const LAS float* s = scr + (8 * c) * 33 + n;
        v4u o; o.x = pk2(s[0 * 33], s[1 * 33]); o.y = pk2(s[2 * 33], s[3 * 33]); o.z = pk2(s[4 * 33], s[5 * 33]); o.w = pk2(s[6 * 33], s[7 * 33]);
        *(GAS v4u*)(dst + (size_t)(n0 + n) * K + k0 + 8 * c) = o; }
    LDS_WAIT(); asm volatile("" ::: "memory");
}
struct GetWin { const float* w; __device__ __forceinline__ float operator()(int k, int n) const {
    int sc; if (n < 1024) sc = n; else if (n < 2048) sc = n + 32; else if (n < 4096) sc = n + 40; else if (n < 4128) sc = n - 3072; else if (n < 4136) sc = n - 2048; else sc = -1;
    return sc < 0 ? 0.f : w[(size_t)k * 4136 + sc]; } };
struct GetWq { const float* w; const float* g; __device__ __forceinline__ float operator()(int k, int n) const {
    const int h = n / 96, dd = n % 96; const int e = dd - 64; const int sd = dd < 64 ? dd : 64 + (e >> 1) + 16 * (e & 1);
    return w[(size_t)k * 768 + h * 96 + sd] * g[k] * QSCALE; } };
struct GetWkv { const float* w; const float* g; __device__ __forceinline__ float operator()(int k, int n) const {
    const int nn = n & 511, h = nn >> 6, c = nn & 63; const int sc = h * 128 + c + ((n >= 512) ? 64 : 0);
    return w[(size_t)k * 1024 + sc] * g[k]; } };
struct GetPlain { const float* w; int N; __device__ __forceinline__ float operator()(int k, int n) const { return w[(size_t)k * N + n]; } };
struct GetWqk { const float* wq; const float* wk; __device__ __forceinline__ float operator()(int k, int n) const {
    const int c = n >> 9, part = (n >> 8) & 1, h = 2 * c + ((n >> 7) & 1), e = n & 127, kh = k >> 7, d = k & 127;
    if (kh != h) return 0.f;
    const size_t off = ((size_t)h * 128 + d) * 128 + e;
    return part ? wk[off] * 0.08838834764831845f : wq[off]; } };
struct GetWv { const float* wv; __device__ __forceinline__ float operator()(int k, int n) const {
    const int h = n >> 7, e = n & 127, kh = k >> 7, d = k & 127;
    return (kh != h) ? 0.f : wv[((size_t)h * 128 + d) * 128 + e]; } };

__device__ const float INV_FREQ[16] = { 1.0f, 0.5623413251903491f, 0.31622776601683794f, 0.1778279410038923f, 0.1f, 0.05623413251903491f, 0.031622776601683794f, 0.01778279410038923f,
    0.01f, 0.005623413251903491f, 0.0031622776601683794f, 0.001778279410038923f, 0.001f, 0.0005623413251903491f, 0.00031622776601683794f, 0.0001778279410038923f };

template <bool XBF> __device__ __forceinline__ void rowpass_norm_mod(const void* xin_, const float* g, const float* ada_shift, const float* ada_scale, bf16* hout, int gw, int NGW, int lane, unsigned char* h8 = nullptr, float* xs = nullptr, int tend = T) {
#define RP_LOAD(dst, row) { if (XBF) { const u32x2* p_ = (const u32x2*)((const bf16*)xin_ + (size_t)(row) * D) + lane; _Pragma("unroll") for (int j = 0; j < 4; ++j) { const u32x2 w_ = p_[64 * j]; dst[j] = (f32x4){bflo(w_.x), bfhi(w_.x), bflo(w_.y), bfhi(w_.y)}; } } \
                          else { const f32x4* p_ = (const f32x4*)((const float*)xin_ + (size_t)(row) * D) + lane; _Pragma("unroll") for (int j = 0; j < 4; ++j) dst[j] = p_[64 * j]; } }
    f32x4 vn[4];
    if (gw < tend) RP_LOAD(vn, gw);
    for (int t = gw; t < tend; t += NGW) {
        const int b = t >> 11;
        f32x4 v[4]; float s = 0.f;
#pragma unroll
        for (int j = 0; j < 4; ++j) { v[j] = vn[j]; s += dot4(v[j], v[j]); }
        { const int tn = (t + NGW < tend) ? t + NGW : t;
          RP_LOAD(vn, tn); }
        const float r = rsqrtf(wave_sum(s) * (1.f / D) + RMS_EPS);
        unsigned long long* o8 = (unsigned long long*)(hout + (size_t)t * D) + lane;
        f32x4 ov[4]; float am = 0.f;
#pragma unroll
        for (int j = 0; j < 4; ++j) { const int col = 4 * lane + 256 * j;
            const f32x4 gg = *(const f32x4*)(g + col), sc = *(const f32x4*)(ada_scale + (size_t)b * NADA + col), sh = *(const f32x4*)(ada_shift + (size_t)b * NADA + col);
            const f32x4 o = v[j] * r * gg * (sc + 1.f) + sh; ov[j] = o;
            am = fmaxf(fmaxf(am, fmaxf(fabsf(o.x), fabsf(o.y))), fmaxf(fabsf(o.z), fabsf(o.w)));
            GSTF(o8 + 64 * j, (unsigned long long)pk2(o.x, o.y) | ((unsigned long long)pk2(o.z, o.w) << 32)); }
        if (h8) {
            am = wave_max(am);
            const float inv = am > 0.f ? 119.f / am : 0.f;
#pragma unroll
            for (int j = 0; j < 4; ++j) { const int q0 = (int)rintf(ov[j].x * inv), q1 = (int)rintf(ov[j].y * inv), q2 = (int)rintf(ov[j].z * inv), q3 = (int)rintf(ov[j].w * inv);
                GSTF((unsigned*)(h8 + (size_t)t * D) + lane + 64 * j, (unsigned)(q0 & 255) | ((unsigned)(q1 & 255) << 8) | ((unsigned)(q2 & 255) << 16) | ((unsigned)(q3 & 255) << 24)); }
            if (lane == 0) xs[t] = am * (1.f / 119.f);
        }
    }
}
__device__ __forceinline__ void rowpass_final(const bf16* xin_, const float* g, float* out, int gw, int NGW, int lane) {
    constexpr bool XBF = true;
    f32x4 vn[4];
    if (gw < T) RP_LOAD(vn, gw);
    for (int t = gw; t < T; t += NGW) {
        f32x4 v[4]; float s = 0.f;
#pragma unroll
        for (int j = 0; j < 4; ++j) { v[j] = vn[j]; s += dot4(v[j], v[j]); }
        { const int tn = (t + NGW < T) ? t + NGW : t;
          RP_LOAD(vn, tn); }
        const float r = rsqrtf(wave_sum(s) * (1.f / D) + RMS_EPS);
        f32x4* o = (f32x4*)(out + (size_t)t * D) + lane;
#pragma unroll
        for (int j = 0; j < 4; ++j) { const f32x4 gg = *(const f32x4*)(g + 4 * lane + 256 * j); o[64 * j] = v[j] * r * gg; }
    }
}
#undef RP_LOAD
__device__ __forceinline__ void rowpass_mid(const bf16* qlat, const bf16* kvlat, const float* small, const float* smallp, const float* cosT, const float* sinT, const bf16* um,
                                            const float* conv_w, const float* conv_b, const float* b_i, const float* b_f,
                                            float* RQ, float* RKV, bf16* K, float* LOGI, float* LOGF, bf16* CONV, int gw, int NGW, int lane, int tend = T) {
    const int c0 = 8 * lane;
    f32x4 cw[4][2], cb[2];
#pragma unroll
    for (int j = 0; j < 4; ++j) { cw[j][0] = *(const f32x4*)(conv_w + j * 512 + c0); cw[j][1] = *(const f32x4*)(conv_w + j * 512 + c0 + 4); }
    cb[0] = *(const f32x4*)(conv_b + c0); cb[1] = *(const f32x4*)(conv_b + c0 + 4);
    const float bsel = (lane >= 32 && lane < 36) ? b_i[lane - 32] : (lane >= 36 && lane < 40) ? b_f[lane - 36] : 0.f;
    for (int tb = gw * 4; tb < tend; tb += NGW * 4) {
        const int pos0 = tb & (SEQ - 1);
        u32x2 qv[4][3], kvv[4]; v4u uw[7]; float sv[4], cs[4], sn[4];
#pragma unroll
        for (int i = 0; i < 4; ++i) { const int t = tb + i; const u32x2* p = (const u32x2*)(qlat + (size_t)t * 768);
#pragma unroll
            for (int j = 0; j < 3; ++j) qv[i][j] = p[lane + 64 * j];
            kvv[i] = ((const u32x2*)(kvlat + (size_t)t * 256))[lane];
            sv[i] = 0.f;
            if (lane < 40) sv[i] = smallp ? ((smallp[(size_t)t * 256 + lane] + smallp[(size_t)t * 256 + 64 + lane]) + (smallp[(size_t)t * 256 + 128 + lane] + smallp[(size_t)t * 256 + 192 + lane]))
                                         : small[(size_t)t * 64 + lane];
            cs[i] = 0.f; sn[i] = 0.f; if (lane < 16) { cs[i] = cosT[(size_t)t * 16 + lane]; sn[i] = sinT[(size_t)t * 16 + lane]; } }
#pragma unroll
        for (int j = 0; j < 7; ++j) { uw[j] = (v4u){0u, 0u, 0u, 0u}; if (pos0 - 3 + j >= 0) uw[j] = *(const v4u*)(um + (size_t)(tb - 3 + j) * 512 + c0); }
#pragma unroll
        for (int i = 0; i < 4; ++i) { const int t = tb + i;
            float s = 0.f;
#pragma unroll
            for (int j = 0; j < 3; ++j) { const u32x2 w = qv[i][j]; const float a = bflo(w.x), b2 = bfhi(w.x), c = bflo(w.y), d = bfhi(w.y); s += (a * a + b2 * b2) + (c * c + d * d); }
            const float rq = rsqrtf(wave_sum(s) * (1.f / 768.f) + RMS_EPS);
            const u32x2 w = kvv[i]; const float a = bflo(w.x), b2 = bfhi(w.x), c = bflo(w.y), d = bfhi(w.y);
            const float rkv = rsqrtf(wave_sum((a * a + b2 * b2) + (c * c + d * d)) * (1.f / 256.f) + RMS_EPS);
            if (lane == 0) { RQ[t] = rq; RKV[t] = rkv; }
            const float x2 = __shfl(sv[i], (lane + 16) & 63);
            if (lane < 16) { const float x1 = sv[i]; const unsigned pk = pk2(x1 * cs[i] - x2 * sn[i], x2 * cs[i] + x1 * sn[i]);
#pragma unroll
                for (int h = 0; h < 8; ++h) ((unsigned*)(K + (size_t)t * 768 + 96 * h + 64))[lane] = pk; }
            else if (lane >= 32 && lane < 36) LOGI[(size_t)t * 4 + (lane - 32)] = sv[i] + bsel;
            else if (lane >= 36 && lane < 40) { const float x = sv[i] + bsel; LOGF[(size_t)t * 4 + (lane - 36)] = fminf(x, 0.f) - log1pf(expf(-fabsf(x))); }
            float acc[8];
            acc[0] = cb[0][0]; acc[1] = cb[0][1]; acc[2] = cb[0][2]; acc[3] = cb[0][3]; acc[4] = cb[1][0]; acc[5] = cb[1][1]; acc[6] = cb[1][2]; acc[7] = cb[1][3];
#pragma unroll
            for (int j = 0; j < 4; ++j) { const v4u u4 = uw[i + j];
                acc[0] += cw[j][0][0] * bflo(u4.x); acc[1] += cw[j][0][1] * bfhi(u4.x); acc[2] += cw[j][0][2] * bflo(u4.y); acc[3] += cw[j][0][3] * bfhi(u4.y);
                acc[4] += cw[j][1][0] * bflo(u4.z); acc[5] += cw[j][1][1] * bfhi(u4.z); acc[6] += cw[j][1][2] * bflo(u4.w); acc[7] += cw[j][1][3] * bfhi(u4.w); }
#pragma unroll
            for (int q = 0; q < 8; ++q) acc[q] = acc[q] * sigm(acc[q]);
            v4u o; o.x = pk2(acc[0], acc[1]); o.y = pk2(acc[2], acc[3]); o.z = pk2(acc[4], acc[5]); o.w = pk2(acc[6], acc[7]);
            GSTF(CONV + (size_t)t * 512 + c0, o); }
    }
}

typedef float f32x16 __attribute__((ext_vector_type(16)));
typedef short s16x4 __attribute__((ext_vector_type(4)));
typedef short v4i16_t __attribute__((ext_vector_type(4)));
typedef float f32x2_t __attribute__((ext_vector_type(2))); typedef __bf16 bf16x2_t __attribute__((ext_vector_type(2)));
__device__ __forceinline__ unsigned cvtpk(float lo, float hi) { f32x2_t v = {lo, hi}; bf16x2_t b = __builtin_convertvector(v, bf16x2_t); return __builtin_bit_cast(unsigned, b); }
__device__ __forceinline__ s16x4 vtr(const LAS unsigned char* p) { return __builtin_bit_cast(s16x4, __builtin_amdgcn_ds_read_tr16_b64_v4i16((LAS v4i16_t*)p)); }
__device__ __forceinline__ bf16x8 pack8(float a0, float a1, float a2, float a3, float a4, float a5, float a6, float a7) {
    v4u p; p.x = cvtpk(a0, a1); p.y = cvtpk(a2, a3); p.z = cvtpk(a4, a5); p.w = cvtpk(a6, a7); return __builtin_bit_cast(bf16x8, p); }
#define MFMA32(a, b, c) __builtin_amdgcn_mfma_f32_32x32x16_bf16((a), (b), (c), 0, 0, 0)
constexpr int AT_KB = 12288, AT_VB = 8192;
__device__ __forceinline__ void attn_mfma(const bf16* Q, const bf16* K, const bf16* V, bf16* AO, LAS unsigned char* lds, int bx, int G, int tid) {
    const int lane = tid & 63, wave = __builtin_amdgcn_readfirstlane(tid >> 6), r = lane & 31, hh = lane >> 5;
    const int i16 = lane & 15, q4 = i16 >> 2, p4 = i16 & 3, blk = (lane >> 4) & 1;
    const int vboff = (4 * hh + q4) * 64 + 32 * blk + 8 * p4;
    const int kr0 = tid / 12, kc0 = tid % 12, kr1 = (tid + 512) / 12, kc1 = (tid + 512) % 12, vr = tid >> 3, vc = tid & 7;
    const int klds0 = (kc0 >> 1) * 2048 + (kc0 & 1) * 1024 + kr0 * 16, klds1 = (kc1 >> 1) * 2048 + (kc1 & 1) * 1024 + kr1 * 16;
    const int vlds = (vc >> 2) * 4096 + (vr >> 4) * 1024 + ((vr >> 3) & 1) * 512 + (vr & 7) * 64 + (vc & 3) * 16;
    for (int pu0 = bx; pu0 < 256; pu0 += G) {
        const int pu = (G == 256) ? (((((pu0 & 7) << 3) | ((pu0 >> 3) & 7)) << 2) | (pu0 >> 6)) : pu0;
        const int bh = pu >> 2, b = bh >> 3, h = bh & 7;
        const bf16* kg = K + ((size_t)b * SEQ) * 768 + h * 96; const bf16* vg = V + ((size_t)b * SEQ) * 512 + h * 64;
        for (int half = 0; half < 2; ++half) {
            const int qb = half == 0 ? 7 - (pu & 3) : (pu & 3);
            const int q0w = qb * 256 + wave * 32, nkt = 4 * (qb + 1), kmax = (q0w + 31) >> 6;
            bf16x8 qf[6];
            { const bf16* qrow = Q + ((size_t)b * SEQ + q0w + r) * 768 + h * 96 + 8 * hh;
#pragma unroll
              for (int s = 0; s < 6; ++s) qf[s] = *(const bf16x8*)(qrow + 16 * s); }
            f32x16 o0, o1;
#pragma unroll
            for (int i = 0; i < 16; ++i) { o0[i] = 0.f; o1[i] = 0.f; }
            float m = 0.f, l = 0.f; f32x16 negm;
#pragma unroll
            for (int i = 0; i < 16; ++i) negm[i] = 0.f;
            v4u ka = *(const v4u*)(kg + (size_t)kr0 * 768 + kc0 * 8), kb2 = (v4u){0u, 0u, 0u, 0u}, va = *(const v4u*)(vg + (size_t)vr * 512 + vc * 8);
            if (tid < 256) kb2 = *(const v4u*)(kg + (size_t)kr1 * 768 + kc1 * 8);
            __syncthreads();
            *(LAS v4u*)(lds + klds0) = ka; if (tid < 256) *(LAS v4u*)(lds + klds1) = kb2; *(LAS v4u*)(lds + 2 * AT_KB + vlds) = va;
            __syncthreads();
            for (int kt = 0; kt < nkt; ++kt) {
                const int buf = kt & 1;
                if (kt + 1 < nkt) { const size_t k1 = (size_t)(kt + 1) * 64;
                    ka = *(const v4u*)(kg + (k1 + kr0) * 768 + kc0 * 8); if (tid < 256) kb2 = *(const v4u*)(kg + (k1 + kr1) * 768 + kc1 * 8); va = *(const v4u*)(vg + (k1 + vr) * 512 + vc * 8); }
                if (kt <= kmax) {
                    const LAS unsigned char* kb_ = lds + buf * AT_KB + hh * 1024 + r * 16; const LAS unsigned char* vb_ = lds + 2 * AT_KB + buf * AT_VB + vboff;
                    f32x16 s0, s1;
                    { bf16x8 kf0[6], kf1[6];
#pragma unroll
                      for (int s = 0; s < 6; ++s) { kf0[s] = *(const LAS bf16x8*)(kb_ + s * 2048); kf1[s] = *(const LAS bf16x8*)(kb_ + s * 2048 + 512); }
                      __builtin_amdgcn_sched_barrier(0);
                      s0 = MFMA32(kf0[0], qf[0], negm); s1 = MFMA32(kf1[0], qf[0], negm);
#pragma unroll
                      for (int s = 1; s < 6; ++s) { s0 = MFMA32(kf0[s], qf[s], s0); s1 = MFMA32(kf1[s], qf[s], s1); } }
                    if (kt * 64 + 63 > q0w) { const int qq = q0w + r - kt * 64;
                        int hq = hh; asm volatile("" : "+v"(hq));
#pragma unroll
                        for (int i = 0; i < 16; ++i) { const int key = (i & 3) + 8 * (i >> 2) + 4 * hq; if (key > qq) s0[i] = -INFINITY; if (key + 32 > qq) s1[i] = -INFINITY; } }
                    float mx = fmaxf(s0[0], s1[0]);
#pragma unroll
                    for (int i = 1; i < 16; ++i) mx = fmaxf(fmaxf(mx, s0[i]), s1[i]);
                    { auto r32 = __builtin_amdgcn_permlane32_swap(__float_as_uint(mx), __float_as_uint(mx), false, false); mx = fmaxf(__uint_as_float(r32[0]), __uint_as_float(r32[1])); }
                    if (kt == 0 || __builtin_amdgcn_ballot_w64(mx > 8.f) != 0ull) {
                        const float d = (kt == 0) ? mx : fmaxf(mx, 0.f), corr = (kt == 0) ? 0.f : __builtin_amdgcn_exp2f(-d);
                        m = (kt == 0) ? mx : m + d; l *= corr;
#pragma unroll
                        for (int i = 0; i < 16; ++i) { o0[i] *= corr; o1[i] *= corr; s0[i] -= d; s1[i] -= d; negm[i] = -m; } }
                    float ps = 0.f;
#pragma unroll
                    for (int i = 0; i < 16; ++i) { s0[i] = __builtin_amdgcn_exp2f(s0[i]); s1[i] = __builtin_amdgcn_exp2f(s1[i]); ps += s0[i] + s1[i]; }
                    l += ps;
                    bf16x8 pf[4];
                    pf[0] = pack8(s0[0], s0[1], s0[2], s0[3], s0[4], s0[5], s0[6], s0[7]); pf[1] = pack8(s0[8], s0[9], s0[10], s0[11], s0[12], s0[13], s0[14], s0[15]);
                    pf[2] = pack8(s1[0], s1[1], s1[2], s1[3], s1[4], s1[5], s1[6], s1[7]); pf[3] = pack8(s1[8], s1[9], s1[10], s1[11], s1[12], s1[13], s1[14], s1[15]);
                    { s16x4 vlo[8], vhi[8];
#pragma unroll
                      for (int ks = 0; ks < 4; ++ks) { vlo[ks] = vtr(vb_ + ks * 1024); vhi[ks] = vtr(vb_ + ks * 1024 + 512); vlo[4 + ks] = vtr(vb_ + 4096 + ks * 1024); vhi[4 + ks] = vtr(vb_ + 4096 + ks * 1024 + 512); }
                      __builtin_amdgcn_sched_barrier(0);
#pragma unroll
                      for (int ks = 0; ks < 4; ++ks) {
                          const bf16x8 a0 = (bf16x8){vlo[ks][0], vlo[ks][1], vlo[ks][2], vlo[ks][3], vhi[ks][0], vhi[ks][1], vhi[ks][2], vhi[ks][3]};
                          const bf16x8 a1 = (bf16x8){vlo[4 + ks][0], vlo[4 + ks][1], vlo[4 + ks][2], vlo[4 + ks][3], vhi[4 + ks][0], vhi[4 + ks][1], vhi[4 + ks][2], vhi[4 + ks][3]};
                          o0 = MFMA32(a0, pf[ks], o0); o1 = MFMA32(a1, pf[ks], o1); } }
                }
                if (kt + 1 < nkt) { LAS unsigned char* nb = lds + (buf ^ 1) * AT_KB; *(LAS v4u*)(nb + klds0) = ka; if (tid < 256) *(LAS v4u*)(nb + klds1) = kb2; *(LAS v4u*)(lds + 2 * AT_KB + (buf ^ 1) * AT_VB + vlds) = va; }
                __syncthreads();
            }
            const float inv = 1.f / (l + __shfl_xor(l, 32));
            bf16* orow = AO + ((size_t)b * SEQ + q0w + r) * 512 + h * 64 + 4 * hh;
#pragma unroll
            for (int g = 0; g < 4; ++g) { u32x2 w0, w1; w0.x = cvtpk(o0[4 * g] * inv, o0[4 * g + 1] * inv); w0.y = cvtpk(o0[4 * g + 2] * inv, o0[4 * g + 3] * inv);
                w1.x = cvtpk(o1[4 * g] * inv, o1[4 * g + 1] * inv); w1.y = cvtpk(o1[4 * g + 2] * inv, o1[4 * g + 3] * inv);
                GST(orow + 8 * g, w0); GST(orow + 32 + 8 * g, w1); }
        }
    }
}


constexpr int ML_KB = 16384, ML_VB = 16384, ML_BUF = 32768, ML_TAB = LDSCTL_OFF + 2048;
__device__ __forceinline__ void mlstm_mfma(const bf16* QKM, const bf16* VM, const float* LOGI, const float* LOGF, const bf16* CONV, const bf16* OPRE, const float* ng, const float* skip,
                                           bf16* OUTM, LAS unsigned char* lds, int bx, int G, int tid) {
    const int lane = tid & 63, wave = __builtin_amdgcn_readfirstlane(tid >> 6), r = lane & 31, hh = lane >> 5;
    const int i16 = lane & 15, q4 = i16 >> 2, p4 = i16 & 3, blk = (lane >> 4) & 1;
    const int vboff = (4 * hh + q4) * 64 + 32 * blk + 8 * p4;
    int goff[4], loff[4];
#pragma unroll
    for (int q = 0; q < 4; ++q) { const int j = 4 * wave + q;
        if (j < 16) { goff[q] = lane * 1024 + 16 * (j >> 1) + 8 * (j & 1); loff[q] = (j >> 1) * 2048 + (j & 1) * 1024; }
        else { const int jv = j - 16, dq = jv >> 2, ks = jv & 3; goff[q] = (16 * ks + 8 * (lane >> 5) + ((lane >> 2) & 7)) * 512 + 32 * dq + 8 * (lane & 3); loff[q] = ML_KB + dq * 4096 + ks * 1024; } }
    const bool kwave = wave < 4;
#define ML_DMA(tile, bufi) do { _Pragma("unroll") for (int q_ = 0; q_ < 4; ++q_) { \
        const bf16* src_ = kwave ? (kg + (size_t)(tile) * 64 * 1024 + goff[q_]) : (vg + (size_t)(tile) * 64 * 512 + goff[q_]); \
        __builtin_amdgcn_global_load_lds((const unsigned*)src_, (LAS unsigned*)(lds + (bufi) * ML_BUF + loff[q_]), 16, 0, 0); } } while (0)
    LAS float* Ftab = (LAS float*)(lds + 3 * ML_BUF); LAS float* Ctab = (LAS float*)(lds + ML_TAB); LAS float* wtot = Ctab + 2048;
    constexpr float L2E = 1.4426950408889634f;
    for (int pu0 = bx; pu0 < 256; pu0 += G) {
        const int pu = (G == 256) ? (((((pu0 & 7) << 2) | ((pu0 >> 3) & 3)) << 3) | (pu0 >> 5)) : pu0;
        const int bh = pu >> 3, p = pu & 7, b = bh >> 2, h = bh & 3;
        __syncthreads();
        { float f4[4], i4[4];
          int tl = tid; asm volatile("" : "+v"(tl));
#pragma unroll
          for (int e = 0; e < 4; ++e) { const size_t row = (size_t)b * SEQ + tl * 4 + e; f4[e] = LOGF[row * 4 + h]; i4[e] = LOGI[row * 4 + h]; }
          f4[1] += f4[0]; f4[2] += f4[1]; f4[3] += f4[2];
          float x = f4[3];
          x += __uint_as_float(__builtin_amdgcn_update_dpp(0, __float_as_uint(x), 0x111, 0xf, 0xf, true)); x += __uint_as_float(__builtin_amdgcn_update_dpp(0, __float_as_uint(x), 0x112, 0xf, 0xf, true));
          x += __uint_as_float(__builtin_amdgcn_update_dpp(0, __float_as_uint(x), 0x114, 0xf, 0xf, true)); x += __uint_as_float(__builtin_amdgcn_update_dpp(0, __float_as_uint(x), 0x118, 0xf, 0xf, true));
          { const float t0 = __uint_as_float(__builtin_amdgcn_readlane(__float_as_uint(x), 15)), t1 = __uint_as_float(__builtin_amdgcn_readlane(__float_as_uint(x), 31)), t2 = __uint_as_float(__builtin_amdgcn_readlane(__float_as_uint(x), 47));
            const int row = lane >> 4; x += (row >= 1 ? t0 : 0.f) + (row >= 2 ? t1 : 0.f) + (row >= 3 ? t2 : 0.f); }
          if (lane == 63) wtot[wave] = x;
          __syncthreads();
          float base = x - f4[3];
          for (int w = 0; w < wave; ++w) base += wtot[w];
#pragma unroll
          for (int e = 0; e < 4; ++e) { const float F = base + f4[e]; Ftab[tid * 4 + e] = F * L2E; Ctab[tid * 4 + e] = (i4[e] - F) * L2E; } }
        __syncthreads();
        const int par = wave >> 2, w4 = wave & 3;
        const int R0a = 128 * p, R0b = 128 * (15 - p);
        const float Fta = Ftab[R0a + 32 * w4 + r], Ft0a = Ftab[R0a + 32 * w4], Ftb = Ftab[R0b + 32 * w4 + r], Ft0b = Ftab[R0b + 32 * w4];
        LAS float* wt = Ctab + 2048 + 64 + wave * 64;
        const bf16* kg = QKM + ((size_t)b * SEQ) * 1024 + 512 + h * 128; const bf16* vg = VM + ((size_t)b * SEQ) * 512 + h * 128;
        __syncthreads();
#pragma unroll 1
        for (int u = 0; u < 2; ++u) {
            const int R0 = u ? R0b : R0a, q0w = R0 + 32 * w4, kmax = (q0w + 31) >> 6, ntile = ((R0 + 127) >> 6) + 1, nit = (ntile + 1) >> 1;
            const float Ft = u ? Ftb : Fta, Ft0 = u ? Ft0b : Ft0a;
            const size_t trow = (size_t)b * SEQ + q0w + r;
            bf16x8 qf[8];
            { const bf16* qrow = QKM + trow * 1024 + h * 128 + 8 * hh;
#pragma unroll
              for (int s = 0; s < 8; ++s) qf[s] = *(const bf16x8*)(qrow + 16 * s); }
            f32x16 o[4];
#pragma unroll
            for (int d = 0; d < 4; ++d)
#pragma unroll
                for (int i = 0; i < 16; ++i) o[d][i] = 0.f;
            float den = 0.f;
            ML_DMA(0, 0); ML_DMA(1, 1);
            asm volatile("s_waitcnt vmcnt(0)" ::: "memory"); asm volatile("s_waitcnt lgkmcnt(0)" ::: "memory"); __builtin_amdgcn_s_barrier(); asm volatile("" ::: "memory");
            for (int it = 0; it < nit; ++it) {
                const int kt = 2 * it + par, buf = kt & 3;
                if (it + 1 < nit) { const int ta = 2 * it + 2, tb = min(2 * it + 3, ntile - 1); ML_DMA(ta, ta & 3); ML_DMA(tb, (2 * it + 3) & 3); }
                if (kt < ntile && kt <= kmax) {
                    const LAS unsigned char* kb_ = lds + buf * ML_BUF + hh * 1024 + r * 16; const LAS unsigned char* vb_ = lds + buf * ML_BUF + ML_KB + vboff;
                    asm volatile("" : "+v"(kb_), "+v"(vb_));
                    f32x16 s0, s1;
#pragma unroll
                    for (int i = 0; i < 16; ++i) { s0[i] = 0.f; s1[i] = 0.f; }
#pragma unroll
                    for (int sh = 0; sh < 2; ++sh) { bf16x8 kf0[4], kf1[4];
#pragma unroll
                      for (int s = 0; s < 4; ++s) { kf0[s] = *(const LAS bf16x8*)(kb_ + (4 * sh + s) * 2048); kf1[s] = *(const LAS bf16x8*)(kb_ + (4 * sh + s) * 2048 + 512); }
                      __builtin_amdgcn_sched_barrier(0);
#pragma unroll
                      for (int s = 0; s < 4; ++s) { s0 = MFMA32(kf0[s], qf[4 * sh + s], s0); s1 = MFMA32(kf1[s], qf[4 * sh + s], s1); } }
                    const int qq = q0w + r - kt * 64;
                    const bool diag = kt * 64 + 63 > q0w;
                    wt[lane] = __builtin_amdgcn_exp2f(Ctab[kt * 64 + lane] + Ft0);
                    LDS_WAIT();
                    const LAS float* ct = wt + 4 * hh;
                    float ps = 0.f;
                    if (diag) {
                        int hq = hh; asm volatile("" : "+v"(hq));
#pragma unroll
                        for (int g = 0; g < 4; ++g) { const f32x4 c0v = *(const LAS f32x4*)(ct + 8 * g), c1v = *(const LAS f32x4*)(ct + 32 + 8 * g);
#pragma unroll
                            for (int e = 0; e < 4; ++e) { const int i = 4 * g + e, key = e + 8 * g + 4 * hq;
                                const float w0 = (key <= qq) ? c0v[e] : 0.f, w1 = (key + 32 <= qq) ? c1v[e] : 0.f;
                                s0[i] *= w0; s1[i] *= w1; ps += s0[i] + s1[i]; } }
                    } else {
#pragma unroll
                        for (int g = 0; g < 4; ++g) { const f32x4 c0v = *(const LAS f32x4*)(ct + 8 * g), c1v = *(const LAS f32x4*)(ct + 32 + 8 * g);
#pragma unroll
                            for (int e = 0; e < 4; ++e) { const int i = 4 * g + e; s0[i] *= c0v[e]; s1[i] *= c1v[e]; ps += s0[i] + s1[i]; } }
                    }
                    den += ps;
                    bf16x8 pf[4];
                    pf[0] = pack8(s0[0], s0[1], s0[2], s0[3], s0[4], s0[5], s0[6], s0[7]); pf[1] = pack8(s0[8], s0[9], s0[10], s0[11], s0[12], s0[13], s0[14], s0[15]);
                    pf[2] = pack8(s1[0], s1[1], s1[2], s1[3], s1[4], s1[5], s1[6], s1[7]); pf[3] = pack8(s1[8], s1[9], s1[10], s1[11], s1[12], s1[13], s1[14], s1[15]);
#pragma unroll
                    for (int ks = 0; ks < 4; ++ks) { s16x4 vlo[4], vhi[4];
#pragma unroll
                        for (int d = 0; d < 4; ++d) { vlo[d] = vtr(vb_ + d * 4096 + ks * 1024); vhi[d] = vtr(vb_ + d * 4096 + ks * 1024 + 512); }
                        __builtin_amdgcn_sched_barrier(0);
#pragma unroll
                        for (int d = 0; d < 4; ++d) { const s16x4 lo = vlo[d], hi = vhi[d];
                            const bf16x8 av = (bf16x8){lo[0], lo[1], lo[2], lo[3], hi[0], hi[1], hi[2], hi[3]};
                            o[d] = MFMA32(av, pf[ks], o[d]); } }
                }
                asm volatile("s_waitcnt vmcnt(0)" ::: "memory");
                asm volatile("s_waitcnt lgkmcnt(0)" ::: "memory"); __builtin_amdgcn_s_barrier(); asm volatile("" ::: "memory");
            }
            { LAS float* xch = (LAS float*)lds + (w4 * 65) * 64 + lane;
              if (par == 1) {
#pragma unroll
                  for (int d = 0; d < 4; ++d)
#pragma unroll
                      for (int i = 0; i < 16; ++i) xch[(16 * d + i) * 64] = o[d][i];
                  xch[64 * 64] = den; }
              __syncthreads();
              if (par == 0) {
#pragma unroll
                  for (int d = 0; d < 4; ++d)
#pragma unroll
                      for (int i = 0; i < 16; ++i) o[d][i] += xch[(16 * d + i) * 64];
                  den += xch[64 * 64];
                const float kap = __builtin_amdgcn_exp2f(Ft - Ft0);
                const float dt = (den + __shfl_xor(den, 32)) * kap;
                const float inv = kap / fmaxf(fabsf(dt), 1.f);
                float sm = 0.f;
#pragma unroll
                for (int d = 0; d < 4; ++d)
#pragma unroll
                    for (int i = 0; i < 16; ++i) { o[d][i] *= inv; sm += o[d][i]; }
                sm += __shfl_xor(sm, 32);
                const float mu = sm * (1.f / 128.f);
                float vs = 0.f;
#pragma unroll
                for (int d = 0; d < 4; ++d)
#pragma unroll
                    for (int i = 0; i < 16; ++i) { const float dlt = o[d][i] - mu; vs += dlt * dlt; }
                vs += __shfl_xor(vs, 32);
                const float rstd = rsqrtf(vs * (1.f / 128.f) + RMS_EPS);
#pragma unroll
                for (int d = 0; d < 4; ++d)
#pragma unroll
                    for (int g = 0; g < 4; ++g) { const int ch = h * 128 + 32 * d + 8 * g + 4 * hh; const size_t off = trow * 512 + ch;
                        const u32x2 cv = *(const u32x2*)(CONV + off), ov = *(const u32x2*)(OPRE + off); const f32x4 gg = *(const f32x4*)(ng + ch), sk = *(const f32x4*)(skip + ch);
                        const float y0 = sigm(bflo(ov.x)) * ((o[d][4 * g] - mu) * rstd * gg[0] + sk[0] * bflo(cv.x)), y1 = sigm(bfhi(ov.x)) * ((o[d][4 * g + 1] - mu) * rstd * gg[1] + sk[1] * bfhi(cv.x));
                        const float y2 = sigm(bflo(ov.y)) * ((o[d][4 * g + 2] - mu) * rstd * gg[2] + sk[2] * bflo(cv.y)), y3 = sigm(bfhi(ov.y)) * ((o[d][4 * g + 3] - mu) * rstd * gg[3] + sk[3] * bfhi(cv.y));
                        u32x2 w; w.x = cvtpk(y0, y1); w.y = cvtpk(y2, y3); GST(OUTM + off, w); }

              }
              __syncthreads(); }
        }
    }
#undef ML_DMA
}

typedef int v4i __attribute__((ext_vector_type(4)));
template <int N> __device__ __forceinline__ void bitonic_sort_desc(float (&v)[N]) {
#pragma unroll
    for (int k = 2; k <= N; k <<= 1)
#pragma unroll
        for (int j = k >> 1; j > 0; j >>= 1)
#pragma unroll
            for (int i = 0; i < N; ++i) { const int l = i ^ j; if (l > i) { const bool desc = ((i & k) == 0); const float a = v[i], b = v[l], hi = fmaxf(a, b), lo = fminf(a, b); v[i] = desc ? hi : lo; v[l] = desc ? lo : hi; } }
}
__device__ __forceinline__ void sort16_desc(float (&v)[16]) {
#define CE(a, b) { const float x_ = v[a], y_ = v[b]; v[a] = fmaxf(x_, y_); v[b] = fminf(x_, y_); }
    CE(0,13) CE(1,12) CE(2,15) CE(3,14) CE(4,8) CE(5,6) CE(7,11) CE(9,10)
    CE(0,5) CE(1,7) CE(2,9) CE(3,4) CE(6,13) CE(8,14) CE(10,15) CE(11,12)
    CE(0,1) CE(2,3) CE(4,5) CE(6,8) CE(7,9) CE(10,11) CE(12,13) CE(14,15)
    CE(0,2) CE(1,3) CE(4,10) CE(5,11) CE(6,7) CE(8,9) CE(12,14) CE(13,15)
    CE(1,2) CE(3,12) CE(4,6) CE(5,7) CE(8,10) CE(9,11) CE(13,14)
    CE(1,4) CE(2,6) CE(5,8) CE(7,10) CE(9,13) CE(11,14)
    CE(2,4) CE(3,6) CE(9,12) CE(11,13)
    CE(3,5) CE(6,8) CE(7,9) CE(10,12)
    CE(3,4) CE(5,6) CE(7,8) CE(9,10) CE(11,12)
    CE(6,7) CE(8,9)
#undef CE
}
__device__ __forceinline__ void bitonic_merge16_desc(float (&a)[16]) {
#pragma unroll
    for (int j = 8; j > 0; j >>= 1)
#pragma unroll
        for (int i = 0; i < 16; ++i) { const int l = i ^ j; if (l > i) { const float x = a[i], y = a[l]; a[i] = fmaxf(x, y); a[l] = fminf(x, y); } }
}
__device__ __forceinline__ void top16_merge(float (&a)[16], const float (&b)[16]) {
#pragma unroll
    for (int i = 0; i < 16; ++i) a[i] = fmaxf(a[i], b[15 - i]);
#pragma unroll
    for (int j = 8; j > 0; j >>= 1)
#pragma unroll
        for (int i = 0; i < 16; ++i) { const int l = i ^ j; if (l > i) { const float x = a[i], y = a[l]; a[i] = fmaxf(x, y); a[l] = fminf(x, y); } }
}
constexpr int PE_EIDX = 0, PE_EGATE = 16384, PE_KEYT = 32768;
__device__ __forceinline__ void peer_route(const bf16* PQ, const bf16* KEYB, int* IDX, float* GATE, LAS unsigned char* lds, int bx, int G, int tid, int upm = -1, int upn = 0) {
    const int lane = tid & 63, wave = __builtin_amdgcn_readfirstlane(tid >> 6), r = lane & 31, hh = lane >> 5;
    LAS unsigned char* keyt = lds + PE_KEYT + (wave * 32 + r) * 32;
    for (int itn = 0;; ++itn) {
        int grp, hsel;
        if (upm < 0) { grp = bx + itn * G; if (grp >= T / 32) break; hsel = wave; }
        else { if (itn >= 2) break; const int it = wave + 8 * itn; grp = upm * 8 + (it & 7); hsel = 2 * upn + (it >> 3); }
        const int t0 = grp * 32;
        { const int h = hsel;
          int rq = r; asm volatile("" : "+v"(rq));
          float top[2][16];
#pragma unroll
          for (int p = 0; p < 2; ++p) {
              bf16x8 qf[4];
              { const bf16* qrow = PQ + (size_t)(t0 + rq) * 1024 + h * 128 + p * 64 + 8 * hh;
#pragma unroll
                for (int s = 0; s < 4; ++s) qf[s] = *(const bf16x8*)(qrow + 16 * s); }
              const bf16* kb = KEYB + ((size_t)(h * 2 + p) * 128 + rq) * 64 + 8 * hh;
              float sv[4][16];
#pragma unroll
              for (int kt = 0; kt < 4; ++kt) { f32x16 acc;
#pragma unroll
                  for (int i = 0; i < 16; ++i) acc[i] = 0.f;
#pragma unroll
                  for (int s = 0; s < 4; ++s) { const bf16x8 a = *(const bf16x8*)(kb + (size_t)(32 * kt) * 64 + 16 * s); acc = MFMA32(a, qf[s], acc); }
#pragma unroll
                  for (int i = 0; i < 16; ++i) { const unsigned key = (unsigned)(32 * kt + (i & 3) + 8 * (i >> 2)) + 4u * (unsigned)hh; sv[kt][i] = __uint_as_float((__float_as_uint(acc[i]) & ~127u) | key); } }
              sort16_desc(sv[0]); sort16_desc(sv[1]); sort16_desc(sv[2]); sort16_desc(sv[3]);
              top16_merge(sv[0], sv[1]); top16_merge(sv[2], sv[3]); top16_merge(sv[0], sv[2]);
              float pr[16];
#pragma unroll
              for (int i = 0; i < 16; ++i) { auto r32 = __builtin_amdgcn_permlane32_swap(__float_as_uint(sv[0][i]), __float_as_uint(sv[0][i]), false, false); pr[i] = __uint_as_float(hh ? r32[0] : r32[1]); }
              top16_merge(sv[0], pr);
#pragma unroll
              for (int i = 0; i < 16; ++i) top[p][i] = sv[0][i];
          }
          if (hh == 0) {
#pragma unroll
              for (int i = 0; i < 16; ++i) { keyt[i] = (unsigned char)(__float_as_uint(top[0][i]) & 127u); keyt[16 + i] = (unsigned char)(__float_as_uint(top[1][i]) & 127u); } }
          float cs[4][16];
#define PSUM(a, b) __uint_as_float((__float_as_uint(top[0][a] + top[1][b]) & ~255u) | (unsigned)(255 - ((a) * 16 + (b))))
#pragma unroll
          for (int b2 = 0; b2 < 16; ++b2) cs[0][b2] = PSUM(0, b2);
#pragma unroll
          for (int b2 = 0; b2 < 8; ++b2) cs[1][b2] = PSUM(1, b2);
#pragma unroll
          for (int a2 = 8; a2 < 16; ++a2) cs[1][8 + (15 - a2)] = PSUM(a2, 0);
#pragma unroll
          for (int b2 = 0; b2 < 5; ++b2) cs[2][b2] = PSUM(2, b2);
#pragma unroll
          for (int b2 = 0; b2 < 4; ++b2) cs[2][5 + b2] = PSUM(3, b2);
#pragma unroll
          for (int b2 = 0; b2 < 3; ++b2) cs[2][9 + b2] = PSUM(4, b2);
          cs[2][12] = PSUM(5, 0); cs[2][13] = PSUM(5, 1); cs[2][14] = PSUM(6, 0); cs[2][15] = PSUM(6, 1);
          cs[3][0] = PSUM(7, 0); cs[3][1] = PSUM(7, 1);
#undef PSUM
#pragma unroll
          for (int i = 2; i < 16; ++i) cs[3][i] = -3.0e38f;
          bitonic_merge16_desc(cs[1]); sort16_desc(cs[2]);
          top16_merge(cs[0], cs[1]); top16_merge(cs[2], cs[3]); top16_merge(cs[0], cs[2]);
          LDS_WAIT();
          float ev[16], den = 0.f; const float mx = __uint_as_float(__float_as_uint(cs[0][0]) & ~255u);
#pragma unroll
          for (int k = 0; k < 16; ++k) { ev[k] = __expf(__uint_as_float(__float_as_uint(cs[0][k]) & ~255u) - mx); den += ev[k]; }
          const float rden = 1.f / den;
          if (hh == 0) {
              int ex[16];
#pragma unroll
              for (int k = 0; k < 16; ++k) { const unsigned code = 255u - (__float_as_uint(cs[0][k]) & 255u); ex[k] = (int)keyt[code >> 4] * 128 + (int)keyt[16 + (code & 15u)]; }
              int* ip = IDX + (size_t)(t0 + r) * 128 + h * 16; float* gp = GATE + (size_t)(t0 + r) * 128 + h * 16;
#pragma unroll
              for (int q = 0; q < 4; ++q) { GST(ip + 4 * q, ((v4i){ex[4 * q], ex[4 * q + 1], ex[4 * q + 2], ex[4 * q + 3]}));
                  GST(gp + 4 * q, ((f32x4){ev[4 * q] * rden, ev[4 * q + 1] * rden, ev[4 * q + 2] * rden, ev[4 * q + 3] * rden})); } }
        }
    }
}
__device__ __forceinline__ void peer_partition(const unsigned* xc_cnt, volatile LAS unsigned* MISC, int bx, int G, int& vx, int& rank, int& nb) {
    bool use_xcc = MK_ONE_LAUNCH != 0; unsigned mine = 0u; const unsigned myx = MISC[13];
    if (use_xcc) { unsigned sum = 0u;
#pragma unroll
        for (unsigned j = 0; j < 8; ++j) { const unsigned c = __hip_atomic_load(xc_cnt + 64 * j, __ATOMIC_RELAXED, __HIP_MEMORY_SCOPE_AGENT); use_xcc = use_xcc && (c > 0u); sum += c; mine = (j == myx) ? c : mine; }
        use_xcc = use_xcc && (sum == (unsigned)G); }
    if (use_xcc) { vx = (int)myx; rank = (int)MISC[12]; nb = (int)mine; } else { vx = bx & 7; rank = bx >> 3; nb = (G - vx + 7) >> 3; }
    vx = __builtin_amdgcn_readfirstlane(vx); rank = __builtin_amdgcn_readfirstlane(rank); nb = __builtin_amdgcn_readfirstlane(nb);
}
__device__ __forceinline__ int dot4_first(int a, int b) { int d; asm("v_dot4_i32_i8 %0, %1, %2, 0" : "=v"(d) : "v"(a), "v"(b)); return d; }
__device__ __forceinline__ int dot8_first(int a, int b) { int d; asm("v_dot8_i32_i4 %0, %1, %2, 0" : "=v"(d) : "v"(a), "v"(b)); return d; }
__device__ __forceinline__ void peer_u_i8(const unsigned char* H8, const float* XS, const int* IDX, const unsigned char* U8, const f32x2v* SC2, float* ACT, LAS float* wscr, int vx, int rank, int nb, int tid) {
    const int lane = tid & 63, wave = __builtin_amdgcn_readfirstlane(tid >> 6), g4 = lane >> 4, c16 = lane & 15;
    const int tstride = nb * 8, par = vx & 1, grp = vx >> 1;
    constexpr int TH = T / 2;
#define U_TOK(tau) (2 * (tau) + par)
    LAS u32x2* clist = (LAS u32x2*)wscr;
    LAS unsigned char* xs = (LAS unsigned char*)(wscr + 1152);
    LAS int* dvl = (LAS int*)(wscr + 2176);
    LAS f32x2v* scl = (LAS f32x2v*)(wscr + 3200);
    const unsigned long long lt = (1ull << lane) - 1ull;
    const unsigned char* ubase = U8 + 16 * c16;
    int ni[8];
    { const int tb = rank * 8 + wave;
#pragma unroll
      for (int j = 0; j < 4; ++j) { const int tj = tb + j * tstride; const bool ok = tj < TH; ni[2 * j] = ok ? IDX[(size_t)U_TOK(tj) * 128 + lane] : 0x7fffffff; ni[2 * j + 1] = ok ? IDX[(size_t)U_TOK(tj) * 128 + 64 + lane] : 0x7fffffff; } }
    for (int tb = rank * 8 + wave; tb < TH; tb += 4 * tstride) {
        int ntot = 0;
#pragma unroll
        for (int j = 0; j < 4; ++j) { const int e0 = ni[2 * j], e1 = ni[2 * j + 1]; const bool f0 = (e0 >> 12) == grp, f1 = (e1 >> 12) == grp;
            const unsigned long long m0 = __ballot(f0), m1 = __ballot(f1); const int n0 = __popcll(m0);
            if (f0) clist[ntot + __popcll(m0 & lt)] = (u32x2){(unsigned)e0 << 9, (unsigned)((j << 10) | (lane << 16))};
            if (f1) clist[ntot + n0 + __popcll(m1 & lt)] = (u32x2){(unsigned)e1 << 9, (unsigned)((j << 10) | ((64 + lane) << 16))};
            ntot += n0 + __popcll(m1); }
        v4u xr[4]; float sx[4];
#pragma unroll
        for (int j = 0; j < 4; ++j) { const int tj = tb + j * tstride, tl = U_TOK(tj < TH ? tj : tb); xr[j] = *(const v4u*)(H8 + (size_t)tl * 1024 + 16 * lane); sx[j] = XS[tl]; }
        { const int tn = tb + 4 * tstride;
#pragma unroll
          for (int j = 0; j < 4; ++j) { const int tj = tn + j * tstride; const bool ok = tj < TH; ni[2 * j] = ok ? IDX[(size_t)U_TOK(tj) * 128 + lane] : 0x7fffffff; ni[2 * j + 1] = ok ? IDX[(size_t)U_TOK(tj) * 128 + 64 + lane] : 0x7fffffff; } }
        if (ntot == 0) continue;
#pragma unroll
        for (int j = 0; j < 4; ++j) {
#define XP_A(w) (((((w) >> 4) & 0x0f0f0f0fu) + (((w) >> 3) & 0x01010101u)) & 0x0f0f0f0fu)
            const v4u w = xr[j]; u32x2 pl, ph;
            pl.x = (w.x & 0x0f0f0f0fu) | ((w.y & 0x0f0f0f0fu) << 4); pl.y = (w.z & 0x0f0f0f0fu) | ((w.w & 0x0f0f0f0fu) << 4);
            ph.x = XP_A(w.x) | (XP_A(w.y) << 4); ph.y = XP_A(w.z) | (XP_A(w.w) << 4);
#undef XP_A
            *(LAS u32x2*)(xs + j * 1024 + 8 * lane) = pl; *(LAS u32x2*)(xs + j * 1024 + 512 + 8 * lane) = ph; }
        LDS_WAIT();
        const int last = ntot - 1, nit = (ntot + 3) >> 2, nit4 = (nit + 3) >> 2;
        { const u32x2 el = clist[last]; asm volatile("" ::: "memory"); if (lane < 32) clist[ntot + lane] = el; asm volatile("" ::: "memory"); }
        const f32x2v sca = SC2[clist[min(lane, last)].x >> 9], scb = SC2[clist[min(lane + 64, last)].x >> 9], scc = SC2[clist[min(lane + 128, last)].x >> 9], scd = SC2[clist[min(lane + 192, last)].x >> 9];
        v4u ub[4][2]; unsigned up[4];
        const LAS u32x2* cq = clist + g4;
#pragma unroll
        for (int k = 0; k < 3; ++k) { const u32x2 en = cq[4 * k]; up[k] = en.y;
#pragma unroll
            for (int jj = 0; jj < 2; ++jj) ub[k][jj] = *(const v4u*)(ubase + en.x + 256 * jj);
            __builtin_amdgcn_sched_barrier(0); }
        scl[lane] = sca; scl[lane + 64] = scb; scl[lane + 128] = scc; scl[lane + 192] = scd;
#pragma unroll 1
        for (int o = 0; o < nit4; ++o) {
            LAS int* dvo = dvl + (o & 3) * 256 + lane;
#pragma unroll
            for (int k = 0; k < 4; ++k) {
                const int i = 4 * o + k;
                { const u32x2 en = cq[4 * (i + 3)]; up[(k + 3) & 3] = en.y;
#pragma unroll
                  for (int jj = 0; jj < 2; ++jj) ub[(k + 3) & 3][jj] = *(const v4u*)(ubase + en.x + 256 * jj); }
                const LAS unsigned char* xp = xs + (up[k] & 0xc00u) + 16 * c16;
                v4u xq[4];
#pragma unroll
                for (int jj = 0; jj < 4; ++jj) xq[jj] = *(const LAS v4u*)(xp + 256 * jj);
                int a0, h0;
#pragma unroll
                for (int jj = 0; jj < 2; ++jj) { const v4u w = ub[k][jj], xl = xq[jj], xh = xq[2 + jj];
                    if (jj == 0) { a0 = dot8_first((int)w.x, (int)xl.x); h0 = dot8_first((int)w.x, (int)xh.x); }
                    else { a0 = __builtin_amdgcn_sdot8((int)w.x, (int)xl.x, a0, false); h0 = __builtin_amdgcn_sdot8((int)w.x, (int)xh.x, h0, false); }
                    a0 = __builtin_amdgcn_sdot8((int)w.y, (int)xl.y, a0, false); h0 = __builtin_amdgcn_sdot8((int)w.y, (int)xh.y, h0, false);
                    a0 = __builtin_amdgcn_sdot8((int)w.z, (int)xl.z, a0, false); h0 = __builtin_amdgcn_sdot8((int)w.z, (int)xh.z, h0, false);
                    a0 = __builtin_amdgcn_sdot8((int)w.w, (int)xl.w, a0, false); h0 = __builtin_amdgcn_sdot8((int)w.w, (int)xh.w, h0, false); }
                dvo[k * 64] = (h0 << 4) + a0;
            }
            if ((o & 3) == 3 || o == nit4 - 1) {
                asm volatile("" ::: "memory");
                const LAS v4i* rp = (const LAS v4i*)(dvl + c16 * 64 + 16 * g4);
                const v4i q0 = rp[0], q1 = rp[1], q2 = rp[2], q3 = rp[3]; const v4i qs = (q0 + q1) + (q2 + q3);
                const int dsum = (qs.x + qs.y) + (qs.z + qs.w);
                const int pown = 4 * (16 * (o >> 2) + c16) + g4;
                if (pown <= last) { const u32x2 eo_ = clist[pown]; const f32x2v sco = pown < 256 ? scl[pown] : SC2[eo_.x >> 9]; const int j = (int)(eo_.y >> 10) & 3, pko = (int)(eo_.y >> 16); const float sxj = j == 0 ? sx[0] : j == 1 ? sx[1] : j == 2 ? sx[2] : sx[3];
                    GST(ACT + (size_t)U_TOK(tb + j * tstride) * 128 + (pko & 127), gelu_erf((float)dsum * sxj * sco.x) * sco.y); }
                asm volatile("" ::: "memory"); }
        }
        LDS_WAIT();
    }
}
#undef U_TOK
__device__ __forceinline__ void peer_v(const int* IDX, const float* ACT, const float* GATE, const unsigned char* V8, const float* gate2, const bf16* Xin, bf16* Xout, LAS float* wscr,
                                       int vx, int rank, int nb, int tid) {
    const int lane = tid & 63, wave = __builtin_amdgcn_readfirstlane(tid >> 6), g8 = lane >> 3, c8 = lane & 7;
    const int tstride = nb * 16;
    LAS int* wl = (LAS int*)wscr; LAS unsigned char* wqb = (LAS unsigned char*)(wscr + 128);
    const unsigned char* vbase = V8 + (size_t)(vx >> 1) * (2 * MiB); const int voff = 16 * c8;
    const int col = 256 * (vx >> 1) + 32 * c8;
    const int wqo0 = (lane & 7) * 16 + (lane >> 3), wqo1 = wqo0 + 8;
    const int t0 = (rank * 8 + wave) * 2 + (vx & 1);
    if (t0 >= T) return;
    const int tlast = t0 + ((T - 1 - t0) / tstride) * tstride;
#define PV_STAGE(tt, I0, I1, A0, A1, VV, WQ4, SW) { \
        float am_ = fmaxf(fabsf(A0), fabsf(A1));   \
        am_ = fmaxf(am_, __uint_as_float(__builtin_amdgcn_update_dpp(0, __float_as_uint(am_), 0x128, 0xf, 0xf, false))); am_ = fmaxf(am_, __uint_as_float(__builtin_amdgcn_update_dpp(0, __float_as_uint(am_), 0x124, 0xf, 0xf, false))); \
        am_ = fmaxf(am_, __uint_as_float(__builtin_amdgcn_update_dpp(0, __float_as_uint(am_), 0x122, 0xf, 0xf, false))); am_ = fmaxf(am_, __uint_as_float(__builtin_amdgcn_update_dpp(0, __float_as_uint(am_), 0x121, 0xf, 0xf, false))); \
        am_ = fmaxf(fmaxf(__uint_as_float(__builtin_amdgcn_readlane(__float_as_uint(am_), 0)), __uint_as_float(__builtin_amdgcn_readlane(__float_as_uint(am_), 16))), \
                    fmaxf(__uint_as_float(__builtin_amdgcn_readlane(__float_as_uint(am_), 32)), __uint_as_float(__builtin_amdgcn_readlane(__float_as_uint(am_), 48)))); \
        const float inv_ = am_ > 0.f ? 127.f * __builtin_amdgcn_rcpf(am_) : 0.f; SW = am_ * (1.f / 127.f); \
        wl[lane] = I0; wl[64 + lane] = I1; wqb[wqo0] = (unsigned char)((int)rintf(A0 * inv_) & 255); wqb[wqo1] = (unsigned char)((int)rintf(A1 * inv_) & 255); \
        LDS_WAIT(); \
        _Pragma("unroll") for (int i_ = 0; i_ < 16; ++i_) { const int e_ = wl[8 * i_ + g8]; VV[i_] = *(const v4u*)(vbase + (size_t)(unsigned)(e_ * 128 + voff)); } \
        WQ4 = *(const LAS v4u*)(wqb + g8 * 16); LDS_WAIT(); }
#define PV_META(tt, I0, I1, A0, A1) { const size_t o_ = (size_t)(tt) * 128; I0 = IDX[o_ + lane]; I1 = IDX[o_ + 64 + lane]; A0 = ACT[o_ + lane] * GATE[o_ + lane]; A1 = ACT[o_ + 64 + lane] * GATE[o_ + 64 + lane]; }
    int i0, i1, j0, j1; float a0, a1, b0, b1;
    v4u vvA[16], vvB[16], wq4A, wq4B; float swA, swB;
    PV_META(t0, i0, i1, a0, a1);
    PV_STAGE(t0, i0, i1, a0, a1, vvA, wq4A, swA);
    { const int t1 = min(t0 + tstride, tlast); PV_META(t1, i0, i1, a0, a1); }
    auto body = [&](const int t, const v4u (&vv)[16], const v4u& wq4, const float& sw, v4u (&vvn)[16], v4u& wq4n, float& swn) __attribute__((always_inline)) {
        const int b = t >> 11, tn = min(t + tstride, tlast), tn2 = min(t + 2 * tstride, tlast);
        PV_META(tn2, j0, j1, b0, b1);
        const u32x2 xw1 = *(const u32x2*)(Xin + (size_t)t * 1024 + col + 4 * g8); const f32x4 g21 = *(const f32x4*)(gate2 + (size_t)b * NADA + col + 4 * g8);
        PV_STAGE(tn, i0, i1, a0, a1, vvn, wq4n, swn);
        i0 = j0; i1 = j1; a0 = b0; a1 = b1;
        int accA[16], accB[16], accw = 0;
#pragma unroll
        for (int q = 0; q < 4; ++q) { const int wq = (int)(q == 0 ? wq4.x : q == 1 ? wq4.y : q == 2 ? wq4.z : wq4.w);
            accw = __builtin_amdgcn_sdot4(wq, 0x01010101, accw, false);
#pragma unroll
            for (int d = 0; d < 4; ++d) {
                const unsigned ra = d == 0 ? vv[4 * q].x : d == 1 ? vv[4 * q].y : d == 2 ? vv[4 * q].z : vv[4 * q].w, rb = d == 0 ? vv[4 * q + 1].x : d == 1 ? vv[4 * q + 1].y : d == 2 ? vv[4 * q + 1].z : vv[4 * q + 1].w;
                const unsigned rc = d == 0 ? vv[4 * q + 2].x : d == 1 ? vv[4 * q + 2].y : d == 2 ? vv[4 * q + 2].z : vv[4 * q + 2].w, rd = d == 0 ? vv[4 * q + 3].x : d == 1 ? vv[4 * q + 3].y : d == 2 ? vv[4 * q + 3].z : vv[4 * q + 3].w;
                const unsigned ab_lo = __builtin_amdgcn_perm(rb, ra, 0x05010400u), ab_hi = __builtin_amdgcn_perm(rb, ra, 0x07030602u), cd_lo = __builtin_amdgcn_perm(rd, rc, 0x05010400u), cd_hi = __builtin_amdgcn_perm(rd, rc, 0x07030602u);
                const unsigned t0 = __builtin_amdgcn_perm(cd_lo, ab_lo, 0x05040100u), t1 = __builtin_amdgcn_perm(cd_lo, ab_lo, 0x07060302u), t2 = __builtin_amdgcn_perm(cd_hi, ab_hi, 0x05040100u), t3 = __builtin_amdgcn_perm(cd_hi, ab_hi, 0x07060302u);
                if (q == 0) { accA[4 * d + 0] = dot4_first((int)t0, wq); accB[4 * d + 0] = dot4_first((int)(t0 & 0x0f0f0f0fu), wq); } else { accA[4 * d + 0] = __builtin_amdgcn_sdot4((int)t0, wq, accA[4 * d + 0], false); accB[4 * d + 0] = __builtin_amdgcn_sdot4((int)(t0 & 0x0f0f0f0fu), wq, accB[4 * d + 0], false); }
                if (q == 0) { accA[4 * d + 1] = dot4_first((int)t1, wq); accB[4 * d + 1] = dot4_first((int)(t1 & 0x0f0f0f0fu), wq); } else { accA[4 * d + 1] = __builtin_amdgcn_sdot4((int)t1, wq, accA[4 * d + 1], false); accB[4 * d + 1] = __builtin_amdgcn_sdot4((int)(t1 & 0x0f0f0f0fu), wq, accB[4 * d + 1], false); }
                if (q == 0) { accA[4 * d + 2] = dot4_first((int)t2, wq); accB[4 * d + 2] = dot4_first((int)(t2 & 0x0f0f0f0fu), wq); } else { accA[4 * d + 2] = __builtin_amdgcn_sdot4((int)t2, wq, accA[4 * d + 2], false); accB[4 * d + 2] = __builtin_amdgcn_sdot4((int)(t2 & 0x0f0f0f0fu), wq, accB[4 * d + 2], false); }
                if (q == 0) { accA[4 * d + 3] = dot4_first((int)t3, wq); accB[4 * d + 3] = dot4_first((int)(t3 & 0x0f0f0f0fu), wq); } else { accA[4 * d + 3] = __builtin_amdgcn_sdot4((int)t3, wq, accA[4 * d + 3], false); accB[4 * d + 3] = __builtin_amdgcn_sdot4((int)(t3 & 0x0f0f0f0fu), wq, accB[4 * d + 3], false); } } }
#define PV_SW16(X, Y) { auto r_ = __builtin_amdgcn_permlane16_swap((unsigned)(X), (unsigned)(Y), false, false); X = (int)(r_[0] + r_[1]); }
#define PV_SW32(X, Y) { auto r_ = __builtin_amdgcn_permlane32_swap((unsigned)(X), (unsigned)(Y), false, false); X = (int)(r_[0] + r_[1]); }
#pragma unroll
        for (int hh = 0; hh < 2; ++hh)
#pragma unroll
            for (int mm = 0; mm < 4; ++mm) { const int mi = 8 * hh + mm; PV_SW16(accA[mi], accA[mi + 4]); PV_SW16(accB[mi], accB[mi + 4]); }
#pragma unroll
        for (int mi = 0; mi < 4; ++mi) { PV_SW32(accA[mi], accA[mi + 8]); PV_SW32(accB[mi], accB[mi + 8]); }
        { const bool b3 = (lane & 8) != 0;
#pragma unroll
          for (int mi = 0; mi < 2; ++mi) {
              { const int keep = b3 ? accA[mi + 2] : accA[mi], send = b3 ? accA[mi] : accA[mi + 2]; accA[mi] = keep + __builtin_amdgcn_update_dpp(0, send, 0x128, 0xf, 0xf, false); }
              { const int keep = b3 ? accB[mi + 2] : accB[mi], send = b3 ? accB[mi] : accB[mi + 2]; accB[mi] = keep + __builtin_amdgcn_update_dpp(0, send, 0x128, 0xf, 0xf, false); } } }
        accw += __builtin_amdgcn_update_dpp(0, accw, 0x128, 0xf, 0xf, false); PV_SW16(accw, accw); PV_SW32(accw, accw);
#undef PV_SW16
#undef PV_SW32
        { const int off8 = 8 * accw;
          const int s0 = accB[0] - off8, s1 = (accA[0] - accB[0]) >> 4, s2 = accB[1] - off8, s3 = (accA[1] - accB[1]) >> 4;
          const f32x4 xo = (f32x4){bflo(xw1.x), bfhi(xw1.x), bflo(xw1.y), bfhi(xw1.y)} + g21 * ((f32x4){(float)s0, (float)s1, (float)s2, (float)s3} * sw);
          u32x2 w; w.x = pk2(xo[0], xo[1]); w.y = pk2(xo[2], xo[3]); GSTF(Xout + (size_t)t * 1024 + col + 4 * g8, w); }
    };
    for (int t = t0; t < T; t += 2 * tstride) {
        body(t, vvA, wq4A, swA, vvB, wq4B, swB);
        if (t + tstride >= T) break;
        body(t + tstride, vvB, wq4B, swB, vvA, wq4A, swA);
    }
#undef PV_STAGE
#undef PV_META
}

constexpr int PH_PER_LAYER = 12, N_PHASES = 1 + DEPTH * PH_PER_LAYER + 1;
struct Args { const void* in[N_INPUTS]; float* out; unsigned char* ws; int ph_lo, ph_hi; };
static_assert(sizeof(Args) == N_INPUTS * 8 + 24, "Args has no padding");

constexpr int PTAB_OFF = LDSCTL_OFF + 1024;
__device__ __forceinline__ unsigned char* getp(LAS unsigned char* lds, int i) {
    asm volatile("" ::: "memory");
    const u32x2 v = *(volatile LAS u32x2*)(lds + PTAB_OFF + 8 * i);
    const unsigned lo = __builtin_amdgcn_readfirstlane(v.x), hi = __builtin_amdgcn_readfirstlane(v.y);
    GAS unsigned char* g = (GAS unsigned char*)(((unsigned long long)hi << 32) | lo);
    return (unsigned char*)g;
}
#define INP(i) ((const float*)getp(lds, (i)))
#define WSB() getp(lds, 30)

#define IN(k) (lo <= (k) && (k) < hi)
__device__ __forceinline__ void xcdl_barrier(unsigned* cnt, unsigned* bar, const int tid_in) {
    asm volatile("s_waitcnt vmcnt(0)" ::: "memory");
    __syncthreads();
    if (tid_in == 0) {
        __builtin_amdgcn_s_waitcnt(0);
        const unsigned old = xb_add(cnt, 1u), target = (old / 32u + 1u) * 32u;
        XB_SPIN(xb_ld(cnt) < target, bar);
        __builtin_amdgcn_fence(__ATOMIC_ACQUIRE, "agent");
        asm volatile("s_waitcnt vmcnt(0)" ::: "memory");
    }
    __syncthreads();
}
#define SEAML(k) do { if (MK_ONE_LAUNCH && IN(k) && IN((k) + 1)) { if (MISC[14]) xcdl_barrier((unsigned*)(WSB() + WS_CTL) + CW_XL + 64 * MISC[13], (unsigned*)(WSB() + WS_CTL) + CW_BAR, (wave_s << 6) | (int)__lane_id()); \
        else { XcdBarrier b_; b_.bar = (unsigned*)(WSB() + WS_CTL) + CW_BAR; b_.x = xb_xcc_id(); b_.st = MISC + 8; xcd_barrier(b_, (wave_s << 6) | (int)__lane_id()); } } } while (0)
#define SEAM(k) do { if (MK_ONE_LAUNCH && IN(k) && IN((k) + 1)) { XcdBarrier b_; b_.bar = (unsigned*)(WSB() + WS_CTL) + CW_BAR; b_.x = xb_xcc_id(); b_.st = MISC + 8; REPS(11) xcd_barrier(b_, (wave_s << 6) | (int)__lane_id()); } } while (0)
#define PH_BEGIN(lv) int tidq; asm volatile("v_mbcnt_lo_u32_b32 %0, -1, 0\n\tv_mbcnt_hi_u32_b32 %0, -1, %0" : "=v"(tidq)); tidq |= wave_s << 6;     \
    asm volatile("" : "+v"(tidq)); const int lane = tidq & 63, wave = __builtin_amdgcn_readfirstlane(tidq >> 6); \
    int G = gridDim.x, bx = blockIdx.x, l = (lv); asm volatile("" : "+s"(G), "+s"(bx), "+s"(l)); const int gw = bx * NWAVES + wave, NGW = G * NWAVES; \
    unsigned char* ws = WSB(); LAS float* wscr = (LAS float*)(lds + RING_OFF + wave * 16384); (void)lane; (void)gw; (void)NGW; (void)ws; (void)wscr; (void)l


constexpr int PI_W = 4512, PI_K = 512, PI_U = 2048, PI_V = 2048, PI_TOTAL = PI_W + PI_K + PI_U + PI_V;
template <int NR> __device__ __forceinline__ void prep_rows_i8(const float* src, size_t src_stride, unsigned char* dst, size_t dst_stride, float* scale_slot  , int lane) {
    f32x4 v[NR][4];
#pragma unroll
    for (int rr = 0; rr < NR; ++rr) { const f32x4* s = (const f32x4*)(src + rr * src_stride) + lane * 4;
#pragma unroll
        for (int j = 0; j < 4; ++j) v[rr][j] = s[j]; }
#pragma unroll
    for (int rr = 0; rr < NR; ++rr) {
        float am = 0.f;
#pragma unroll
        for (int j = 0; j < 4; ++j) am = fmaxf(fmaxf(am, fmaxf(fabsf(v[rr][j][0]), fabsf(v[rr][j][1]))), fmaxf(fabsf(v[rr][j][2]), fabsf(v[rr][j][3])));
        am = wave_max(am);
        const float inv = am > 0.f ? 127.f / am : 0.f;
#define Q4(x) ((unsigned)((int)rintf((x)[0] * inv) & 255) | ((unsigned)((int)rintf((x)[1] * inv) & 255) << 8) | ((unsigned)((int)rintf((x)[2] * inv) & 255) << 16) | ((unsigned)((int)rintf((x)[3] * inv) & 255) << 24))
        v4u o; o.x = Q4(v[rr][0]); o.y = Q4(v[rr][1]); o.z = Q4(v[rr][2]); o.w = Q4(v[rr][3]);
#undef Q4
        *(v4u*)(dst + rr * dst_stride) = o;
        if (lane == 0) scale_slot[2 * rr] = am * (1.f / 127.f);
    }
}
template <int NR> __device__ __forceinline__ void prep_rows_i4(const float* src, size_t src_stride, unsigned char* dst, size_t dst_stride, float* scale_slot  , int lane) {
    f32x4 v[NR][4];
#pragma unroll
    for (int rr = 0; rr < NR; ++rr) { const f32x4* s = (const f32x4*)(src + rr * src_stride) + lane * 4;
#pragma unroll
        for (int j = 0; j < 4; ++j) v[rr][j] = s[j]; }
#pragma unroll
    for (int rr = 0; rr < NR; ++rr) {
        float am = 0.f, ss = 0.f;
#pragma unroll
        for (int j = 0; j < 4; ++j) { am = fmaxf(fmaxf(am, fmaxf(fabsf(v[rr][j][0]), fabsf(v[rr][j][1]))), fmaxf(fabsf(v[rr][j][2]), fabsf(v[rr][j][3]))); ss += dot4(v[rr][j], v[rr][j]); }
        am = wave_max(am); ss = wave_sum(ss);
        am = fminf(am, 2.7f * sqrtf(ss * (1.f / 1024.f)));
        const float inv = am > 0.f ? 7.f / am : 0.f;
#define N4(x) ((unsigned)((int)fminf(fmaxf(rintf((x) * inv), -7.f), 7.f) + 8))
#define H4(x) ((unsigned)((int)fminf(fmaxf(rintf((x) * inv), -7.f), 7.f)) & 15u)
#define B4(x, y) (N4(x) | (H4(y) << 4))
        u32x2 o;
        o.x = B4(v[rr][0][0], v[rr][0][1]) | (B4(v[rr][0][2], v[rr][0][3]) << 8) | (B4(v[rr][1][0], v[rr][1][1]) << 16) | (B4(v[rr][1][2], v[rr][1][3]) << 24);
        o.y = B4(v[rr][2][0], v[rr][2][1]) | (B4(v[rr][2][2], v[rr][2][3]) << 8) | (B4(v[rr][3][0], v[rr][3][1]) << 16) | (B4(v[rr][3][2], v[rr][3][3]) << 24);
#undef B4
#undef H4
#undef N4
        *(u32x2*)(dst + rr * dst_stride) = o;
        if (lane == 0) scale_slot[2 * rr] = am * (1.f / 7.f);
    }
}
template <int NR> __device__ __forceinline__ void prep_rows_u4(const float* src, size_t src_stride, unsigned char* dst, size_t dst_stride, float* scale_slot  , int lane) {
    f32x4 v[NR][4];
#pragma unroll
    for (int rr = 0; rr < NR; ++rr) { const f32x4* s = (const f32x4*)(src + rr * src_stride) + lane * 4;
#pragma unroll
        for (int j = 0; j < 4; ++j) v[rr][j] = s[j]; }
#pragma unroll
    for (int rr = 0; rr < NR; ++rr) {
        float am = 0.f, ss = 0.f;
#pragma unroll
        for (int j = 0; j < 4; ++j) { am = fmaxf(fmaxf(am, fmaxf(fabsf(v[rr][j][0]), fabsf(v[rr][j][1]))), fmaxf(fabsf(v[rr][j][2]), fabsf(v[rr][j][3]))); ss += dot4(v[rr][j], v[rr][j]); }
        am = wave_max(am); ss = wave_sum(ss);
        am = fminf(am, 2.7f * sqrtf(ss * (1.f / 1024.f)));
        const float inv = am > 0.f ? 7.f / am : 0.f;
#define H4(x) ((unsigned)((int)fminf(fmaxf(rintf((x) * inv), -7.f), 7.f)) & 15u)
#define B4(x, y) (H4(x) | (H4(y) << 4))
        u32x2 o;
        o.x = B4(v[rr][0][0], v[rr][1][0]) | (B4(v[rr][0][1], v[rr][1][1]) << 8) | (B4(v[rr][0][2], v[rr][1][2]) << 16) | (B4(v[rr][0][3], v[rr][1][3]) << 24);
        o.y = B4(v[rr][2][0], v[rr][3][0]) | (B4(v[rr][2][1], v[rr][3][1]) << 8) | (B4(v[rr][2][2], v[rr][3][2]) << 16) | (B4(v[rr][2][3], v[rr][3][3]) << 24);
#undef B4
#undef H4
        *(u32x2*)(dst + rr * dst_stride) = o;
        if (lane == 0) scale_slot[2 * rr] = am * (1.f / 7.f);
    }
}
__device__ __forceinline__ void prep_item(LAS unsigned char* lds, unsigned char* ws, LAS float* wscr, int l, int r, int lane) {
    constexpr int I_WIN_ = 16 * 136, I_WQ_ = 12 * 24, I_WKV_ = 4 * 32, I_WA_ = 8 * 32, I_WM_ = 8 * 32, I_WO_ = 16 * 32, I_PW_ = 16 * 32, I_WQK_ = 8 * 32, I_WV_ = 8 * 16;
    static_assert(I_WIN_ + I_WQ_ + I_WKV_ + I_WA_ + I_WM_ + I_WO_ + I_PW_ + I_WQK_ + I_WV_ == PI_W, "weight items");
    unsigned char* wl = ws + WS_W + (size_t)l * W_LAYER;
    if (r < PI_W) {
        if (r < I_WIN_) { const GetWin g{INP(I_WIN) + (size_t)l * D * 4136}; prep_tile(g, (bf16*)(wl + WO_WIN), 1024, 64 * (r / 136), 32 * (r % 136), wscr, lane); return; } r -= I_WIN_;
        if (r < I_WQ_) { const GetWq g{INP(I_WQUP) + (size_t)l * 768 * 768, INP(I_QNG) + l * 768}; prep_tile(g, (bf16*)(wl + WO_WQ), 768, 64 * (r / 24), 32 * (r % 24), wscr, lane); return; } r -= I_WQ_;
        if (r < I_WKV_) { const GetWkv g{INP(I_WKVUP) + (size_t)l * 256 * 1024, INP(I_KVNG) + l * 256}; prep_tile(g, (bf16*)(wl + WO_WKV), 256, 64 * (r / 32), 32 * (r % 32), wscr, lane); return; } r -= I_WKV_;
        if (r < I_WA_) { const GetPlain g{INP(I_WBA) + (size_t)l * 512 * 1024, 1024}; prep_tile(g, (bf16*)(wl + WO_WA), 512, 64 * (r / 32), 32 * (r % 32), wscr, lane); return; } r -= I_WA_;
        if (r < I_WM_) { const GetPlain g{INP(I_WBM) + (size_t)l * 512 * 1024, 1024}; prep_tile(g, (bf16*)(wl + WO_WM), 512, 64 * (r / 32), 32 * (r % 32), wscr, lane); return; } r -= I_WM_;
        if (r < I_WO_) { const GetPlain g{INP(I_WOUT) + (size_t)l * 1024 * 1024, 1024}; prep_tile(g, (bf16*)(wl + WO_WO), 1024, 64 * (r / 32), 32 * (r % 32), wscr, lane); return; } r -= I_WO_;
        if (r < I_PW_) { const GetPlain g{INP(I_PWQ) + (size_t)l * 1024 * 1024, 1024}; prep_tile(g, (bf16*)(wl + WO_PWQ), 1024, 64 * (r / 32), 32 * (r % 32), wscr, lane); return; } r -= I_PW_;
        if (r < I_WQK_) { const GetWqk g{INP(I_WQM) + (size_t)l * 65536, INP(I_WKM) + (size_t)l * 65536}; prep_tile(g, (bf16*)(wl + WO_WQK), 512, 64 * (r / 32), 32 * (r % 32), wscr, lane); return; } r -= I_WQK_;
        { const GetWv g{INP(I_WVM) + (size_t)l * 65536}; prep_tile(g, (bf16*)(wl + WO_WV), 512, 64 * (r / 16), 32 * (r % 16), wscr, lane); }
        return; }
    r -= PI_W;
    if (r < PI_K) { const int o = (r * 64 + lane) * 4;
        const f32x4 v = *(const f32x4*)(INP(I_PKEYS) + (size_t)l * 131072 + o); u32x2 w; w.x = pk2(v[0], v[1]); w.y = pk2(v[2], v[3]);
        *(u32x2*)(wl + WO_KEYB + (size_t)o * 2) = w; return; }
    r -= PI_K;
    float* sc2 = (float*)(ws + WS_USC);
    if (r < PI_U) { const float* pu = INP(I_PU) + (size_t)l * 16777216;
        for (int rr = 0; rr < 8; rr += 8) { const int er = r * 8 + rr; prep_rows_u4<8>(pu + (size_t)er * 1024, 1024, ws + WS_U8 + (size_t)l * 32 * MiB + (size_t)er * 512 + 8 * lane, 512, sc2 + 2 * (l * 16384 + er), lane); }
        return; }
    r -= PI_U;
    { const float* pv = INP(I_PV) + (size_t)l * 16777216;
      for (int rr = 0; rr < 8; rr += 8) { const int er = r * 8 + rr;
          prep_rows_i4<8>(pv + (size_t)er * 1024, 1024, ws + WS_V8 + (size_t)l * 32 * MiB + (size_t)(lane >> 4) * (2 * MiB) + (size_t)er * 128 + 8 * (lane & 15), 128, sc2 + 2 * (l * 16384 + er) + 1, lane); } }
}
template <int lv> __device__ __forceinline__ void layer_phases(LAS unsigned char* lds, volatile LAS unsigned* MISC, const int lo, const int hi, const int wave_s) {
        const int P = 1 + lv * PH_PER_LAYER;
#define WL() (ws + WS_W + (size_t)l * W_LAYER)
#define ADAL() ((const float*)(ws + ADA_OFF) + (size_t)l * 8 * NADA)
#define XA() WSP(bf16, WS_X)
#define XB() (WSP(bf16, WS_X) + (size_t)T * D)
#define WSP(type, off) ((type*)(ws + (off)))
        if (IN(P + 0)) REPS(1) { PH_BEGIN(lv);
            const bool xl = MISC[14] != 0u; const int lw = (bx >> 3) * NWAVES + wave, xb0 = SEQ * (bx & 7);
            const int g0 = xl ? xb0 + lw : gw, gs = xl ? 256 : NGW, te = xl ? xb0 + SEQ : T;
            if (lv == 0) rowpass_norm_mod<false>(INP(I_X), INP(I_N1G) + l * D, ADAL() + 0, ADAL() + 1024, WSP(bf16, WS_H), g0, gs, lane, nullptr, nullptr, te);
            else rowpass_norm_mod<true>(XB(), INP(I_N1G) + l * D, ADAL() + 0, ADAL() + 1024, WSP(bf16, WS_H), g0, gs, lane, nullptr, nullptr, te); }
        SEAML(P + 0);
        if (IN(P + 1)) REPS(2) { PH_BEGIN(lv);
            if (G == 256) {
                { pg8::Gemm g{WSP(bf16, WS_H), (const bf16*)(WL() + WO_WIN), T, 4096, D}; pg8::StaticOrder S; S.init(T, 4096, G, bx);
                  EpiProj E{WSP(bf16, WS_QLAT), WSP(bf16, WS_KVLAT), WSP(bf16, WS_UM), WSP(bf16, WS_OPRE), WSP(bf16, WS_GA), WSP(bf16, WS_GM), WSP(float, WS_SMALL)};
                  pg8::gemm_phase<EpiProj, pg8::StaticOrder, true, true>(lds + RING_OFF, g, S, E, tidq); }
                { const int kq = bx >> 6;
                  pg8::Gemm g{WSP(bf16, WS_H) + 256 * kq, (const bf16*)(WL() + WO_WIN) + (size_t)4096 * 1024 + 256 * kq, T, 256, 256, 1024}; pg8::StaticOrder S; S.init(T, 256, 64, bx & 63);
                  EpiSmallPart E{WSP(float, WS_SMALLP) + kq * 64};
                  pg8::gemm_phase<EpiSmallPart, pg8::StaticOrder, true, true>(lds + RING_OFF, g, S, E, tidq); }
            } else {
                pg8::Gemm g{WSP(bf16, WS_H), (const bf16*)(WL() + WO_WIN), T, NPROJ, D}; pg8::StaticOrder S; S.init(T, NPROJ, G, bx);
                EpiProj E{WSP(bf16, WS_QLAT), WSP(bf16, WS_KVLAT), WSP(bf16, WS_UM), WSP(bf16, WS_OPRE), WSP(bf16, WS_GA), WSP(bf16, WS_GM), WSP(float, WS_SMALL)};
                pg8::gemm_phase<EpiProj, pg8::StaticOrder, true, true>(lds + RING_OFF, g, S, E, tidq);
            }
        }
        SEAML(P + 1);
        if (IN(P + 2)) REPS(3) { PH_BEGIN(lv);
            rowpass_mid(WSP(bf16, WS_QLAT), WSP(bf16, WS_KVLAT), WSP(float, WS_SMALL), (G == 256) ? WSP(float, WS_SMALLP) : (const float*)nullptr, WSP(float, WS_COS), WSP(float, WS_SIN), WSP(bf16, WS_UM), INP(I_CONVW) + l * 4 * 512, INP(I_CONVB) + l * 512,
                        INP(I_BI) + l * 4, INP(I_BF) + l * 4, WSP(float, WS_RQ), WSP(float, WS_RKV), WSP(bf16, WS_K), WSP(float, WS_LOGI), WSP(float, WS_LOGF), WSP(bf16, WS_CONV),
                        MISC[14] ? (SEQ / 4) * (bx & 7) + (bx >> 3) * NWAVES + wave : gw, MISC[14] ? 256 : NGW, lane, MISC[14] ? SEQ * ((bx & 7) + 1) : T); }
        SEAML(P + 2);
        if (IN(P + 3)) REPS(4) {
            { PH_BEGIN(lv); pg8::Gemm g{WSP(bf16, WS_QLAT), (const bf16*)(WL() + WO_WQ), T, 768, 768}; pg8::StaticOrder S; S.init(T, 768, G, bx);
              EpiQ E{WSP(bf16, WS_Q), WSP(float, WS_RQ), WSP(float, WS_COS), WSP(float, WS_SIN)}; pg8::gemm_phase<EpiQ, pg8::StaticOrder, true, true>(lds + RING_OFF, g, S, E, tidq); }
            { PH_BEGIN(lv); pg8::Gemm g{WSP(bf16, WS_KVLAT), (const bf16*)(WL() + WO_WKV), T, 1024, 256}; pg8::StaticOrder S; S.init(T, 1024, G, bx);
              EpiKV E{WSP(bf16, WS_K), WSP(bf16, WS_V), WSP(float, WS_RKV)}; pg8::gemm_phase<EpiKV, pg8::StaticOrder, true, true>(lds + RING_OFF, g, S, E, tidq); }
            { PH_BEGIN(lv); const int c = (G == 256) ? (bx >> 7) : 0;
              pg8::Gemm g{WSP(bf16, WS_CONV) + 256 * c, (const bf16*)(WL() + WO_WQK) + (size_t)(512 * c) * 512 + 256 * c, T, 512, 256, 512}; pg8::StaticOrder S;
              if (G == 256) S.init(T, 512, 128, bx & 127); else S.init(T, 512, G, bx);
              pg8::EpiBf16<0> E{WSP(bf16, WS_QKM) + 256 * c, 1024, nullptr, 256, 512, 1.f}; pg8::gemm_phase<pg8::EpiBf16<0>, pg8::StaticOrder, true, true>(lds + RING_OFF, g, S, E, tidq); }
            { PH_BEGIN(lv); if (G != 256) {
              pg8::Gemm g{WSP(bf16, WS_CONV) + 256, (const bf16*)(WL() + WO_WQK) + (size_t)512 * 512 + 256, T, 512, 256, 512}; pg8::StaticOrder S; S.init(T, 512, G, bx);
              pg8::EpiBf16<0> E{WSP(bf16, WS_QKM) + 256, 1024, nullptr, 256, 512, 1.f}; pg8::gemm_phase<pg8::EpiBf16<0>, pg8::StaticOrder, true, true>(lds + RING_OFF, g, S, E, tidq); } }
            { PH_BEGIN(lv);
              pg8::Gemm g{WSP(bf16, WS_UM), (const bf16*)(WL() + WO_WV), T, 256, 256, 512}; pg8::StaticOrder S;
              if (G == 256) S.init(T, 256, 64, bx >= 192 ? bx - 192 : (1 << 20)); else S.init(T, 256, G, bx);
              pg8::EpiBf16<0> E{WSP(bf16, WS_VM), 512, nullptr, 0, 0, 1.f}; pg8::gemm_phase<pg8::EpiBf16<0>, pg8::StaticOrder, true, true>(lds + RING_OFF, g, S, E, tidq); }
            { PH_BEGIN(lv);
              pg8::Gemm g{WSP(bf16, WS_UM) + 256, (const bf16*)(WL() + WO_WV) + (size_t)256 * 512 + 256, T, 256, 256, 512}; pg8::StaticOrder S;
              if (G == 256) S.init(T, 256, 64, bx >= 192 ? bx - 192 : (1 << 20)); else S.init(T, 256, G, bx);
              pg8::EpiBf16<0> E{WSP(bf16, WS_VM) + 256, 512, nullptr, 0, 0, 1.f}; pg8::gemm_phase<pg8::EpiBf16<0>, pg8::StaticOrder, true, true>(lds + RING_OFF, g, S, E, tidq); }
        }
        SEAML(P + 3);
        if (IN(P + 4)) {
            REPS(5) { PH_BEGIN(lv); attn_mfma(WSP(bf16, WS_Q), WSP(bf16, WS_K), WSP(bf16, WS_V), WSP(bf16, WS_AO), lds + RING_OFF, bx, G, tidq); __syncthreads(); }
            REPS(6) { PH_BEGIN(lv); mlstm_mfma(WSP(bf16, WS_QKM), WSP(bf16, WS_VM), WSP(float, WS_LOGI), WSP(float, WS_LOGF), WSP(bf16, WS_CONV), WSP(bf16, WS_OPRE), INP(I_MHG) + l * 512, INP(I_MSKIP) + l * 512,
                          WSP(bf16, WS_OUTM), lds + RING_OFF, bx, G, tidq); }
        }
        SEAML(P + 4);
        if (IN(P + 5)) REPS(7) {
            static_assert(WS_OUTM == WS_AO + (size_t)T * 512 * 2 && WO_WM == WO_WA + 1024 * 512 * 2, "the merge stream needs AO | OUTM and Wa | Wm adjacent");
            { PH_BEGIN(lv); pg8::Gemm g{WSP(bf16, WS_AO), (const bf16*)(WL() + WO_WA), 2 * T, 2048, 512}; MergeOrder S; S.base.init(T, 1024, G, bx);
              EpiMerge2 E{WSP(bf16, WS_MERGED), WSP(bf16, WS_GA), WSP(bf16, WS_GM)}; pg8::gemm_phase<EpiMerge2, MergeOrder, true, true>(lds + RING_OFF, g, S, E, tidq); }
        }
        SEAML(P + 5);
        if (IN(P + 6)) REPS(8) { PH_BEGIN(lv);
            pg8::Gemm g{WSP(bf16, WS_MERGED), (const bf16*)(WL() + WO_WO), T, 1024, 1024}; pg8::StaticOrder S; S.init(T, 1024, G, bx);
            if (lv == 0) { EpiResid<false> E{INP(I_X), XA(), ADAL() + 2048}; pg8::gemm_phase<EpiResid<false>, pg8::StaticOrder, true, true>(lds + RING_OFF, g, S, E, tidq); }
            else { EpiResid<true> E{XB(), XA(), ADAL() + 2048}; pg8::gemm_phase<EpiResid<true>, pg8::StaticOrder, true, true>(lds + RING_OFF, g, S, E, tidq); }
        }
        SEAML(P + 6);
        if (IN(P + 7)) REPS(1) { PH_BEGIN(lv); const bool xl = MISC[14] != 0u; const int xb0 = SEQ * (bx & 7);
            rowpass_norm_mod<true>(XA(), INP(I_N2G) + l * D, ADAL() + 3072, ADAL() + 4096, WSP(bf16, WS_H), xl ? xb0 + (bx >> 3) * NWAVES + wave : gw, xl ? 256 : NGW, lane, ws + WS_H8, WSP(float, WS_XS), xl ? xb0 + SEQ : T); }
        SEAML(P + 7);
        if (IN(P + 8)) REPS(9) { PH_BEGIN(lv);
            pg8::Gemm g{WSP(bf16, WS_H), (const bf16*)(WL() + WO_PWQ), T, 1024, 1024}; pg8::StaticOrder S; S.init(T, 1024, G, bx);
            pg8::EpiBf16<0> E{WSP(bf16, WS_PQ), 1024, nullptr, 0, 0, 1.f}; pg8::gemm_phase<pg8::EpiBf16<0>, pg8::StaticOrder, true, true>(lds + RING_OFF, g, S, E, tidq);
            if (G == 256) {
                asm volatile("s_waitcnt vmcnt(0)" ::: "memory"); __syncthreads();
                if (tidq == 0) { __builtin_amdgcn_fence(__ATOMIC_ACQUIRE, "agent"); asm volatile("s_waitcnt vmcnt(0)" ::: "memory"); }
                __syncthreads();
                const int upm_ = 8 * (bx & 7) + ((bx >> 3) & 7), upn_ = bx >> 6;
                peer_route(WSP(bf16, WS_PQ), (const bf16*)(WL() + WO_KEYB), WSP(int, WS_IDX), WSP(float, WS_GATE), lds + RING_OFF, bx, G, tidq, upm_, upn_); }
        }
        if (gridDim.x != 256) SEAM(P + 8);
        if (IN(P + 9) && gridDim.x != 256) REPS(10) { PH_BEGIN(lv);
            peer_route(WSP(bf16, WS_PQ), (const bf16*)(WL() + WO_KEYB), WSP(int, WS_IDX), WSP(float, WS_GATE), lds + RING_OFF, bx, G, tidq); }
        SEAM(P + 9);
        if (IN(P + 10)) REPS(12) { PH_BEGIN(lv);
            int vx, rank, nb; peer_partition((const unsigned*)(ws + WS_CTL) + CW_XC, MISC, bx, G, vx, rank, nb);
            peer_u_i8(ws + WS_H8, WSP(float, WS_XS), WSP(int, WS_IDX), ws + WS_U8 + (size_t)l * 32 * MiB, WSP(f32x2v, WS_USC) + l * 16384, WSP(float, WS_ACT), wscr, vx, rank, nb, tidq); }
        SEAM(P + 10);
        if (IN(P + 11)) REPS(13) { PH_BEGIN(lv);
            int vx, rank, nb; peer_partition((const unsigned*)(ws + WS_CTL) + CW_XC, MISC, bx, G, vx, rank, nb);
            peer_v(WSP(int, WS_IDX), WSP(float, WS_ACT), WSP(float, WS_GATE), ws + WS_V8 + (size_t)l * 32 * MiB, ADAL() + 5120, XA(), XB(), wscr, vx, rank, nb, tidq);
        }
        SEAM(P + 11);
    }

__global__ void __launch_bounds__(NTHREADS, 2) fwd(Args args) {
    extern __shared__ __attribute__((aligned(16))) unsigned char lds_raw[];
    LAS unsigned char* lds = (LAS unsigned char*)lds_raw;
    volatile LAS unsigned* MISC = (volatile LAS unsigned*)(lds + MISC_OFF);
    const int tid = threadIdx.x;
    const int wave_s = __builtin_amdgcn_readfirstlane(tid >> 6);
    for (int u = tid; u < (LDS_BYTES - LDSCTL_OFF) / 4; u += NTHREADS) ((LAS unsigned*)(lds + LDSCTL_OFF))[u] = 0u;
    __syncthreads();
    if (tid == 0) { LAS unsigned long long* pt = (LAS unsigned long long*)(lds + PTAB_OFF);
#pragma unroll
        for (int i = 0; i < N_INPUTS; ++i) pt[i] = (unsigned long long)args.in[i];
        pt[29] = (unsigned long long)args.out; pt[30] = (unsigned long long)args.ws; }
    __syncthreads();
    if (MK_ONE_LAUNCH) (void)xcd_barrier_post((unsigned*)(WSB() + WS_CTL) + CW_BAR, MISC + 8);
    if (MK_ONE_LAUNCH && tid == 0) { const unsigned xc = xb_xcc_id() & 7u; MISC[12] = xb_add((unsigned*)(WSB() + WS_CTL) + CW_XC + 64 * xc, 1u); MISC[13] = xc;
        if (xc == (blockIdx.x & 7u)) (void)xb_add((unsigned*)(WSB() + WS_CTL) + CW_AL, 1u); }
    __syncthreads();
    const int lo = args.ph_lo, hi = args.ph_hi;

    if (IN(0)) REPS(0) {
        PH_BEGIN(0);
        float* ADA = (float*)(ws + ADA_OFF);
        { const float* c = INP(I_C); const float* wada = INP(I_WADA); const float* bada = INP(I_BADA);
          for (int it = bx; it < DEPTH * 96; it += G) {
            const int ll = it / 96, cg = it % 96; const int n = cg * 64 + lane;
#pragma unroll
            for (int i = 0; i < 16; ++i) { const int e = lane + 64 * i; const int bb = e >> 7, kk = e & 127; const float cv = c[bb * D + wave * 128 + kk]; wscr[e] = cv * sigm(cv); }
            LDS_WAIT();
            const float* w = wada + (size_t)ll * D * NADA + (size_t)(wave * 128) * NADA + n;
            float a[8];
#pragma unroll
            for (int bb = 0; bb < 8; ++bb) a[bb] = 0.f;
#pragma unroll 32
            for (int kk = 0; kk < 128; ++kk) { const float wv = w[(size_t)kk * NADA];
#pragma unroll
                for (int bb = 0; bb < 8; ++bb) a[bb] += wscr[bb * 128 + kk] * wv; }
#pragma unroll
            for (int bb = 0; bb < 8; ++bb) wscr[1024 + bb * 64 + lane] = a[bb];
            __syncthreads();
            { float s = 0.f;
#pragma unroll
              for (int w8 = 0; w8 < 8; ++w8) s += ((const LAS float*)(lds + RING_OFF + w8 * 16384))[1024 + wave * 64 + lane];
              ADA[((size_t)ll * 8 + wave) * NADA + n] = s + bada[ll * NADA + n]; }
            __syncthreads();
          } }
        { const int* pos = (const int*)INP(I_POS); float* COS = (float*)(ws + WS_COS); float* SIN = (float*)(ws + WS_SIN);
          for (int idx = gw * 64 + lane; idx < T * 16; idx += NGW * 64) { const int t = idx >> 4, j = idx & 15;
              const float ang = (float)pos[t] * INV_FREQ[j];
              const double rev = (double)ang * 0.15915494309189535; const float fr = (float)(rev - rint(rev));
              COS[idx] = __builtin_amdgcn_cosf(fr); SIN[idx] = __builtin_amdgcn_sinf(fr); } }
        for (int it = gw; it < DEPTH * PI_TOTAL; it += NGW) prep_item(lds, ws, wscr, it / PI_TOTAL, it % PI_TOTAL, lane);
    }
    SEAM(0);
    if (MK_ONE_LAUNCH && lo == 0 && hi == N_PHASES) { if (tid == 0) MISC[14] = (gridDim.x == 256 && xb_ld((unsigned*)(WSB() + WS_CTL) + CW_AL) == 256u) ? 1u : 0u; __syncthreads(); }

    layer_phases<0>(lds, MISC, lo, hi, wave_s);
    layer_phases<1>(lds, MISC, lo, hi, wave_s);
    if (IN(N_PHASES - 1)) REPS(1) { PH_BEGIN(0); rowpass_final(XB(), INP(I_FG), (float*)getp(lds, 29), gw, NGW, lane); }
#undef IN
#undef SEAM
}

extern "C" void kernel_launch(void* const* d_in, const int* in_sizes, int n_in, void* d_out, int out_size, void* d_ws, size_t ws_size, hipStream_t stream) {
    static int grid = 0;
    if (grid == 0) {
        if (n_in != N_INPUTS || in_sizes[0] != T * D || out_size != T * D || ws_size < WS_END2) {
            fprintf(stderr, "kernel_launch: unexpected shapes: n_in %d in0 %d out %d ws %zu (need %zu); nothing launched\n", n_in, n_in > 0 ? in_sizes[0] : -1, out_size, ws_size, (size_t)WS_END2); grid = -1; return; }
        int dev = 0, cus = 0, per_cu = 0;
        if (hipGetDevice(&dev) != hipSuccess || hipDeviceGetAttribute(&cus, hipDeviceAttributeMultiprocessorCount, dev) != hipSuccess) { fprintf(stderr, "kernel_launch: device query failed\n"); grid = -1; return; }
        if (hipFuncSetAttribute((const void*)fwd, hipFuncAttributeMaxDynamicSharedMemorySize, LDS_BYTES) != hipSuccess) { fprintf(stderr, "kernel_launch: hipFuncSetAttribute failed\n"); grid = -1; return; }
        if (hipOccupancyMaxActiveBlocksPerMultiprocessor(&per_cu, (const void*)fwd, NTHREADS, LDS_BYTES) != hipSuccess || per_cu < 1)
            fprintf(stderr, "kernel_launch: note: occupancy query reports %d workgroups per CU\n", per_cu);
        (void)hipGetLastError();
        grid = cus;
    }
    if (grid < 0) return;
    if (hipMemsetAsync((char*)d_ws + WS_CTL, 0, CTL_ZERO_BYTES, stream) != hipSuccess) { fprintf(stderr, "kernel_launch: memset failed\n"); return; }
    Args a{};
    for (int i = 0; i < N_INPUTS; ++i) a.in[i] = d_in[i];
    a.out = (float*)d_out; a.ws = (unsigned char*)d_ws;
#if MK_ONE_LAUNCH
    a.ph_lo = 0; a.ph_hi = N_PHASES;
    hipLaunchKernelGGL(fwd, dim3(grid), dim3(NTHREADS), LDS_BYTES, stream, a);
#else
    for (int p = 0; p < N_PHASES; ++p) { a.ph_lo = p; a.ph_hi = p + 1; hipLaunchKernelGGL(fwd, dim3(grid), dim3(NTHREADS), LDS_BYTES, stream, a); }
#endif
    const hipError_t le = hipPeekAtLastError();
    if (le != hipSuccess) fprintf(stderr, "kernel_launch: launch failed: %s\n", hipGetErrorName(le));
}
```
